# Optimizing an MI355X kernel written in HIP

```python
import jax, jax.numpy as jnp
from jax import lax
import numpy as np

D_MODEL = 1024
BATCH = 8
SEQ = 4096
DEPTH = 2

N_MIXERS = 4
MIX_WIDTH = D_MODEL // 4
HEAD_DIM = 64
N_HEADS = MIX_WIDTH // HEAD_DIM
CHUNK = 64
ROPE_THETA = 10000.0
NORM_EPS = 1e-6
NEG_INF = -1e30

CONV_W = 4
NSA_KV_GROUPS = 2
NSA_HPG = N_HEADS // NSA_KV_GROUPS
KV_WIDTH = NSA_KV_GROUPS * HEAD_DIM
CMP_LEN = 32
CMP_STRIDE = 16
SEL_BLOCK = 64
SEL_TOPK = 16
WINDOW = 512
WIN_QBLOCK = 128
SEL_QBLOCK = 32
FORCE_BONUS = 1e3
PEER_HEADS = 8
PEER_NKEYS = 128
PEER_EXPERTS = PEER_NKEYS * PEER_NKEYS
PEER_QDIM = 256
PEER_TOPK = 16
PEER_TCHUNK = 128

IN_WIDTHS = (
    MIX_WIDTH, MIX_WIDTH, MIX_WIDTH, MIX_WIDTH,
    MIX_WIDTH, MIX_WIDTH, MIX_WIDTH, N_HEADS, N_HEADS, MIX_WIDTH,
    MIX_WIDTH, KV_WIDTH, KV_WIDTH, KV_WIDTH, KV_WIDTH, KV_WIDTH, KV_WIDTH, 3 * N_HEADS,
    MIX_WIDTH, MIX_WIDTH, MIX_WIDTH, MIX_WIDTH,
)
IN_OFFSETS = tuple(int(v) for v in np.cumsum(IN_WIDTHS)[:-1])
N_IN = sum(IN_WIDTHS)

kernel_name = 'hybrid_hgrn2_mlstm_nsa_retnet_peer'


def rms_norm(x, g):
    xf = x.astype(jnp.float32)
    y = xf * lax.rsqrt(jnp.mean(xf * xf, axis=-1, keepdims=True) + NORM_EPS)
    return (y * g.astype(jnp.float32)).astype(x.dtype)


def rope_tables(seq_len):
    inv = 1.0 / (ROPE_THETA ** (jnp.arange(0, HEAD_DIM, 2, dtype=jnp.float32) / HEAD_DIM))
    ang = jnp.arange(seq_len, dtype=jnp.float32)[:, None] * inv[None, :]
    return jnp.cos(ang), jnp.sin(ang)


def apply_rope(x, cos, sin):
    x1, x2 = jnp.split(x, 2, axis=-1)
    c = cos[None, :, None, :].astype(x.dtype)
    s = sin[None, :, None, :].astype(x.dtype)
    return jnp.concatenate([x1 * c - x2 * s, x1 * s + x2 * c], axis=-1)


def to_chunks(x):
    b, s, h, d = x.shape
    return x.reshape(b, s // CHUNK, CHUNK, h, d).transpose(1, 0, 3, 2, 4)


def from_chunks(y):
    n, b, h, c, d = y.shape
    return y.transpose(1, 0, 3, 2, 4).reshape(b, n * c, h, d)


def gate_chunks(g):
    b, s, h = g.shape
    return g.reshape(b, s // CHUNK, CHUNK, h).transpose(1, 0, 3, 2)


def masked_softmax(s, mask):
    s = jnp.where(mask, s.astype(jnp.float32), NEG_INF)
    return jnp.where(mask, jax.nn.softmax(s, axis=-1), 0.0)


def causal_dwconv(x, w, b):
    y = lax.conv_general_dilated(x, w[:, None, :].astype(x.dtype), window_strides=(1,),
                                 padding=[(w.shape[0] - 1, 0)],
                                 dimension_numbers=('NWC', 'WIO', 'NWC'),
                                 feature_group_count=x.shape[-1])
    return y + b.astype(x.dtype)


def hgrn2_mixer(q_pre, f_pre, i_pre, g_pre, lb, onorm_g):
    bsz, seq, _ = q_pre.shape
    heads = lambda t: t.reshape(bsz, seq, N_HEADS, HEAD_DIM).astype(jnp.float32)
    q = jax.nn.silu(heads(q_pre))
    fl = heads(f_pre)
    lbh = lb.reshape(N_HEADS, HEAD_DIM).astype(jnp.float32)
    log_f = jnp.logaddexp(jnp.log(lbh), jnp.log1p(-lbh) + jax.nn.log_sigmoid(fl))
    k = (1.0 - lbh) * jax.nn.sigmoid(-fl)
    v = heads(i_pre)
    causal = jnp.tril(jnp.ones((CHUNK, CHUNK), dtype=bool))[:, :, None]

    def step(state, xs):
        qc, kc, vc, gc = xs
        b = jnp.cumsum(gc, axis=2)
        diff = b[:, :, :, None, :] - b[:, :, None, :, :]
        decay = jnp.exp(jnp.where(causal, diff, -jnp.inf))
        a = jnp.einsum('bhtd,bhsd,bhtsd->bhts', qc, kc, decay)
        o = jnp.einsum('bhts,bhse->bhte', a, vc) + jnp.einsum('bhtd,bhde->bhte', qc * jnp.exp(b), state)
        b_last = b[:, :, -1:, :]
        state = jnp.exp(b_last[:, :, 0, :])[..., None] * state + \
            jnp.einsum('bhsd,bhse->bhde', kc * jnp.exp(b_last - b), vc)
        return state, o

    s0 = jnp.zeros((bsz, N_HEADS, HEAD_DIM, HEAD_DIM), jnp.float32)
    _, o = lax.scan(step, s0, (to_chunks(q), to_chunks(k), to_chunks(v), to_chunks(log_f)))
    o = rms_norm(from_chunks(o), onorm_g.reshape(N_HEADS, HEAD_DIM)) * jax.nn.silu(heads(g_pre))
    return o.reshape(bsz, seq, MIX_WIDTH).astype(q_pre.dtype)


def mlstm_mixer(q_pre, k_pre, v_pre, i_pre, f_pre, o_pre, conv_w, conv_b, gate_b, onorm_g):
    bsz, seq, _ = q_pre.shape
    heads = lambda t: t.reshape(bsz, seq, N_HEADS, HEAD_DIM).astype(jnp.float32)
    qk = jax.nn.silu(causal_dwconv(jnp.concatenate([q_pre, k_pre], axis=-1), conv_w, conv_b))
    q_c, k_c = jnp.split(qk, 2, axis=-1)
    q = heads(q_c)
    k = heads(k_c) * (HEAD_DIM ** -0.5)
    v = heads(v_pre)
    log_i = (i_pre + gate_b[:N_HEADS]).astype(jnp.float32)
    log_f = jax.nn.log_sigmoid((f_pre + gate_b[N_HEADS:]).astype(jnp.float32))
    causal = jnp.tril(jnp.ones((CHUNK, CHUNK), dtype=bool))

    def step(carry, xs):
        c_st, n_st, m_st = carry
        qc, kc, vc, li, lf = xs
        b = jnp.cumsum(lf, axis=-1)
        dmat = jnp.where(causal, b[..., :, None] - b[..., None, :] + li[..., None, :], -jnp.inf)
        inter = b + m_st[..., None]
        m = jnp.maximum(inter, jnp.max(dmat, axis=-1))
        w = jnp.exp(dmat - m[..., None]) * jnp.einsum('bhtd,bhsd->bhts', qc, kc)
        s_inter = jnp.exp(inter - m)
        num = s_inter[..., None] * jnp.einsum('bhtd,bhde->bhte', qc, c_st) + jnp.einsum('bhts,bhse->bhte', w, vc)
        den = s_inter * jnp.einsum('bhtd,bhd->bht', qc, n_st) + jnp.sum(w, axis=-1)
        h = num / jnp.maximum(jnp.abs(den), jnp.exp(-m))[..., None]
        b_last = b[..., -1]
        lw = b_last[..., None] - b + li
        m_new = jnp.maximum(b_last + m_st, jnp.max(lw, axis=-1))
        wk = jnp.exp(lw - m_new[..., None])
        decay = jnp.exp(b_last + m_st - m_new)
        c_new = decay[..., None, None] * c_st + jnp.einsum('bhs,bhsd,bhse->bhde', wk, kc, vc)
        n_new = decay[..., None] * n_st + jnp.einsum('bhs,bhsd->bhd', wk, kc)
        return (c_new, n_new, m_new), h

    init = (jnp.zeros((bsz, N_HEADS, HEAD_DIM, HEAD_DIM), jnp.float32),
            jnp.zeros((bsz, N_HEADS, HEAD_DIM), jnp.float32),
            jnp.zeros((bsz, N_HEADS), jnp.float32))
    _, h = lax.scan(step, init, (to_chunks(q), to_chunks(k), to_chunks(v), gate_chunks(log_i), gate_chunks(log_f)))
    h = rms_norm(from_chunks(h), onorm_g.reshape(N_HEADS, HEAD_DIM)) * jax.nn.sigmoid(heads(o_pre))
    return h.reshape(bsz, seq, MIX_WIDTH).astype(q_pre.dtype)


def nsa_mixer(q_pre, kc_pre, vc_pre, ks_pre, vs_pre, kw_pre, vw_pre, gate_pre, cos, sin,
              qnorm_g, knorm_g, cmp_pe, cmp_w):
    bsz, seq, _ = q_pre.shape
    G, HG, DH = NSA_KV_GROUPS, NSA_HPG, HEAD_DIM
    scale = DH ** -0.5
    kvh = lambda t: t.reshape(bsz, seq, G, DH)
    q = rms_norm(q_pre.reshape(bsz, seq, N_HEADS, DH), qnorm_g)
    q_cmp = q.reshape(bsz, seq, G, HG, DH)
    q_rot = apply_rope(q, cos, sin).reshape(bsz, seq, G, HG, DH)
    pos = jnp.arange(seq)

    n_cmp = (seq - CMP_LEN) // CMP_STRIDE + 1
    cmp_start = jnp.arange(n_cmp) * CMP_STRIDE
    cidx = cmp_start[:, None] + jnp.arange(CMP_LEN)[None, :]

    def compress(t, pe, w):
        blocks = t[:, cidx] + pe[None, None, :, None, :].astype(t.dtype)
        return jnp.einsum('bnlgd,lde->bnge', blocks, w.reshape(CMP_LEN, DH, DH))

    k_cmp = rms_norm(compress(kvh(kc_pre), cmp_pe[0], cmp_w[0]), knorm_g[0])
    v_cmp = compress(kvh(vc_pre), cmp_pe[1], cmp_w[1])
    s_cmp = jnp.einsum('bsghd,bngd->bghsn', q_cmp, k_cmp).astype(jnp.float32) * scale
    cmp_mask = (cmp_start + CMP_LEN - 1)[None, :] <= pos[:, None]
    p_cmp = masked_softmax(s_cmp, cmp_mask)
    o_cmp = jnp.einsum('bghsn,bngd->bsghd', p_cmp, v_cmp)

    n_sel = seq // SEL_BLOCK
    n_top = min(SEL_TOPK, n_sel)
    sel_start = jnp.arange(n_sel) * SEL_BLOCK
    overlap = ((cmp_start[:, None] < sel_start[None, :] + SEL_BLOCK) &
               (cmp_start[:, None] + CMP_LEN > sel_start[None, :])).astype(jnp.float32)
    imp = jnp.einsum('bghsn,nj->bgsj', p_cmp, overlap)
    blk = jnp.arange(n_sel)[None, :]
    cur = (pos // SEL_BLOCK)[:, None]
    forced = (blk == 0) | (blk == cur) | (blk == cur - 1)
    imp = jnp.where(blk <= cur, imp + FORCE_BONUS * forced.astype(jnp.float32), NEG_INF)
    top_val, sel_idx = lax.top_k(imp, n_top)
    sel_ok = top_val > 0.5 * NEG_INF

    k_sel = apply_rope(rms_norm(kvh(ks_pre), knorm_g[1]), cos, sin)
    k_blocks = k_sel.reshape(bsz, n_sel, SEL_BLOCK, G, DH).transpose(0, 3, 1, 2, 4)
    v_blocks = kvh(vs_pre).reshape(bsz, n_sel, SEL_BLOCK, G, DH).transpose(0, 3, 1, 2, 4)
    nqb = seq // SEL_QBLOCK
    q_b = q_rot.reshape(bsz, nqb, SEL_QBLOCK, G, HG, DH).transpose(1, 0, 2, 3, 4, 5)
    idx_b = sel_idx.reshape(bsz, G, nqb, SEL_QBLOCK, n_top).transpose(2, 0, 1, 3, 4)
    ok_b = sel_ok.reshape(bsz, G, nqb, SEL_QBLOCK, n_top).transpose(2, 0, 1, 3, 4)
    pos_b = pos.reshape(nqb, SEL_QBLOCK)
    gather = jax.vmap(jax.vmap(lambda blocks, ids: blocks[ids]))
    n_tok = n_top * SEL_BLOCK

    def sel_block(args):
        qb, ib, okb, pb = args
        kg = gather(k_blocks, ib)
        vg = gather(v_blocks, ib)
        s = jnp.einsum('bqghd,bgqkld->bghqkl', qb, kg).astype(jnp.float32) * scale
        tok = ib[..., None] * SEL_BLOCK + jnp.arange(SEL_BLOCK)
        m = okb[..., None] & (tok <= pb[None, None, :, None, None])
        p = masked_softmax(s.reshape(bsz, G, HG, SEL_QBLOCK, n_tok),
                           m.reshape(bsz, G, 1, SEL_QBLOCK, n_tok))
        return jnp.einsum('bghqn,bgqnd->bqghd', p, vg.reshape(bsz, G, SEL_QBLOCK, n_tok, DH))

    o_sel = lax.map(sel_block, (q_b, idx_b, ok_b, pos_b))
    o_sel = o_sel.transpose(1, 0, 2, 3, 4, 5).reshape(bsz, seq, G, HG, DH)

    k_win = apply_rope(rms_norm(kvh(kw_pre), knorm_g[2]), cos, sin)
    v_win = kvh(vw_pre)
    nwb = seq // WIN_QBLOCK
    span = WINDOW + WIN_QBLOCK
    kp = jnp.pad(k_win, ((0, 0), (WINDOW, 0), (0, 0), (0, 0)))
    vp = jnp.pad(v_win, ((0, 0), (WINDOW, 0), (0, 0), (0, 0)))
    kidx = jnp.arange(nwb)[:, None] * WIN_QBLOCK + jnp.arange(span)[None, :]
    kb = kp[:, kidx]
    vb = vp[:, kidx]
    qw = q_rot.reshape(bsz, nwb, WIN_QBLOCK, G, HG, DH)
    s_w = jnp.einsum('bnqghd,bnkgd->bghnqk', qw, kb).astype(jnp.float32) * scale
    qpos = pos.reshape(nwb, WIN_QBLOCK)[:, :, None]
    kpos = (kidx - WINDOW)[:, None, :]
    wmask = (kpos <= qpos) & (kpos > qpos - WINDOW) & (kpos >= 0)
    p_w = masked_softmax(s_w, wmask)
    o_win = jnp.einsum('bghnqk,bnkgd->bnqghd', p_w, vb).reshape(bsz, seq, G, HG, DH)

    g = jax.nn.sigmoid(gate_pre.astype(jnp.float32)).reshape(bsz, seq, G, HG, 3, 1)
    o = g[..., 0, :] * o_cmp + g[..., 1, :] * o_sel + g[..., 2, :] * o_win
    return o.reshape(bsz, seq, MIX_WIDTH).astype(q_pre.dtype)


def retention_mixer(q_pre, k_pre, v_pre, g_pre, cos, sin, onorm_g):
    bsz, seq, _ = q_pre.shape
    heads = lambda t: t.reshape(bsz, seq, N_HEADS, HEAD_DIM)
    q = apply_rope(heads(q_pre), cos, sin).astype(jnp.float32)
    k = apply_rope(heads(k_pre), cos, sin).astype(jnp.float32) * (HEAD_DIM ** -0.5)
    v = heads(v_pre).astype(jnp.float32)
    log_gamma = jnp.log1p(-jnp.exp2(-5.0 - jnp.arange(N_HEADS, dtype=jnp.float32)))
    t = jnp.arange(CHUNK, dtype=jnp.float32)
    causal = jnp.tril(jnp.ones((CHUNK, CHUNK), dtype=bool))
    dec_in = jnp.exp(jnp.where(causal, log_gamma[:, None, None] * (t[:, None] - t[None, :]), -jnp.inf))
    dec_q = jnp.exp(log_gamma[:, None] * (t + 1.0))[:, :, None]
    dec_k = jnp.exp(log_gamma[:, None] * (CHUNK - 1.0 - t))[:, :, None]
    dec_state = jnp.exp(log_gamma * CHUNK)[:, None, None]

    def step(r, xs):
        qc, kc, vc = xs
        a = jnp.einsum('bhtd,bhsd->bhts', qc, kc) * dec_in
        o = jnp.einsum('bhts,bhse->bhte', a, vc) + jnp.einsum('bhtd,bhde->bhte', qc, r) * dec_q
        r = dec_state * r + jnp.einsum('bhsd,bhse->bhde', kc * dec_k, vc)
        return r, o

    r0 = jnp.zeros((bsz, N_HEADS, HEAD_DIM, HEAD_DIM), jnp.float32)
    _, o = lax.scan(step, r0, (to_chunks(q), to_chunks(k), to_chunks(v)))
    o = rms_norm(from_chunks(o), onorm_g.reshape(N_HEADS, HEAD_DIM)) * jax.nn.silu(heads(g_pre).astype(jnp.float32))
    return o.reshape(bsz, seq, MIX_WIDTH).astype(q_pre.dtype)


def peer_ffn(x, wq, sub_keys, u_tab, v_tab):
    bsz, seq, d = x.shape
    xt = x.reshape(bsz * seq // PEER_TCHUNK, PEER_TCHUNK, d)

    def chunk(xc):
        q = (xc @ wq).reshape(PEER_TCHUNK, PEER_HEADS, 2, PEER_QDIM // 2)
        s = jnp.einsum('thpd,hpnd->thpn', q, sub_keys).astype(jnp.float32)
        v1, i1 = lax.top_k(s[:, :, 0], PEER_TOPK)
        v2, i2 = lax.top_k(s[:, :, 1], PEER_TOPK)
        cand = (v1[..., :, None] + v2[..., None, :]).reshape(PEER_TCHUNK, PEER_HEADS, PEER_TOPK * PEER_TOPK)
        vals, pos = lax.top_k(cand, PEER_TOPK)
        e = jnp.take_along_axis(i1, pos // PEER_TOPK, axis=-1) * PEER_NKEYS + \
            jnp.take_along_axis(i2, pos % PEER_TOPK, axis=-1)
        g = jax.nn.softmax(vals, axis=-1)
        act = jax.nn.gelu(jnp.einsum('td,thkd->thk', xc, u_tab[e]).astype(jnp.float32), approximate=False)
        return jnp.einsum('thk,thkd->td', (g * act).astype(xc.dtype), v_tab[e])

    return lax.map(chunk, xt).reshape(bsz, seq, d)


def setup_inputs(seed: int = 0) -> dict:
    key = jax.random.key(seed)
    ks = jax.random.split(key, 24)
    nrm = lambda k, shape, s: jax.random.normal(k, shape, jnp.float32) * s
    gain = lambda k, shape: 1.0 + 0.02 * jax.random.normal(k, shape, jnp.float32)
    mlstm_gate_b = jnp.concatenate([
        nrm(ks[6], (DEPTH, N_HEADS), 0.1),
        jnp.linspace(3.0, 6.0, N_HEADS, dtype=jnp.float32)[None, :] + nrm(ks[7], (DEPTH, N_HEADS), 0.1)], axis=-1)
    return {
        'x': jax.random.normal(ks[0], (BATCH, SEQ, D_MODEL), jnp.float32),
        'norm1_g': gain(ks[1], (DEPTH, D_MODEL)),
        'w_in': nrm(ks[2], (DEPTH, D_MODEL, N_IN), D_MODEL ** -0.5),
        'hgrn_lb': nrm(ks[3], (DEPTH, MIX_WIDTH), 1.0),
        'hgrn_onorm_g': gain(ks[4], (DEPTH, MIX_WIDTH)),
        'mlstm_conv_w': nrm(ks[5], (DEPTH, CONV_W, 2 * MIX_WIDTH), CONV_W ** -0.5),
        'mlstm_conv_b': nrm(ks[8], (DEPTH, 2 * MIX_WIDTH), 0.01),
        'mlstm_gate_b': mlstm_gate_b,
        'mlstm_onorm_g': gain(ks[9], (DEPTH, MIX_WIDTH)),
        'nsa_qnorm_g': gain(ks[10], (DEPTH, HEAD_DIM)),
        'nsa_knorm_g': gain(ks[11], (DEPTH, 3, HEAD_DIM)),
        'nsa_cmp_pe': nrm(ks[12], (DEPTH, 2, CMP_LEN, HEAD_DIM), 0.1),
        'nsa_cmp_w': nrm(ks[13], (DEPTH, 2, CMP_LEN * HEAD_DIM, HEAD_DIM), (CMP_LEN * HEAD_DIM) ** -0.5),
        'ret_onorm_g': gain(ks[14], (DEPTH, MIX_WIDTH)),
        'w_up': nrm(ks[15], (DEPTH, N_MIXERS, MIX_WIDTH, D_MODEL), MIX_WIDTH ** -0.5),
        'w_gate': nrm(ks[16], (DEPTH, N_MIXERS, D_MODEL, D_MODEL), D_MODEL ** -0.5),
        'w_out': nrm(ks[17], (DEPTH, D_MODEL, D_MODEL), 0.5 * D_MODEL ** -0.5),
        'norm2_g': gain(ks[18], (DEPTH, D_MODEL)),
        'peer_wq': nrm(ks[19], (DEPTH, D_MODEL, PEER_HEADS * PEER_QDIM), D_MODEL ** -0.5),
        'peer_keys': nrm(ks[20], (DEPTH, PEER_HEADS, 2, PEER_NKEYS, PEER_QDIM // 2), (PEER_QDIM // 2) ** -0.5),
        'peer_u': nrm(ks[21], (DEPTH, PEER_EXPERTS, D_MODEL), D_MODEL ** -0.5),
        'peer_v': nrm(ks[22], (DEPTH, PEER_EXPERTS, D_MODEL), 0.2),
    }


def reference(x, norm1_g, w_in, hgrn_lb, hgrn_onorm_g, mlstm_conv_w, mlstm_conv_b, mlstm_gate_b,
              mlstm_onorm_g, nsa_qnorm_g, nsa_knorm_g, nsa_cmp_pe, nsa_cmp_w, ret_onorm_g, w_up,
              w_gate, w_out, norm2_g, peer_wq, peer_keys, peer_u, peer_v):
    seq = x.shape[1]
    cos, sin = rope_tables(seq)
    lb_cum = jnp.cumsum(jax.nn.softmax(hgrn_lb.astype(jnp.float32), axis=0), axis=0)
    lb_all = lb_cum - lb_cum[0:1]
    for l in range(DEPTH):
        xn = rms_norm(x, norm1_g[l])
        (hq, hf, hi, hg, mq, mk, mv, mi, mf, mo, nq, nkc, nvc, nks, nvs, nkw, nvw, ng,
         rq, rk, rv, rg) = jnp.split(xn @ w_in[l], IN_OFFSETS, axis=-1)
        outs = (
            hgrn2_mixer(hq, hf, hi, hg, lb_all[l], hgrn_onorm_g[l]),
            mlstm_mixer(mq, mk, mv, mi, mf, mo, mlstm_conv_w[l], mlstm_conv_b[l], mlstm_gate_b[l], mlstm_onorm_g[l]),
            nsa_mixer(nq, nkc, nvc, nks, nvs, nkw, nvw, ng, cos, sin, nsa_qnorm_g[l], nsa_knorm_g[l],
                      nsa_cmp_pe[l], nsa_cmp_w[l]),
            retention_mixer(rq, rk, rv, rg, cos, sin, ret_onorm_g[l]),
        )
        merged = sum(jax.nn.sigmoid(xn @ w_gate[l, m]) * (outs[m] @ w_up[l, m]) for m in range(N_MIXERS))
        x = x + merged @ w_out[l]
        x = x + peer_ffn(rms_norm(x, norm2_g[l]), peer_wq[l], peer_keys[l], peer_u[l], peer_v[l])
    return x
```

```cpp
#ifndef HOST_EMU
#include <hip/hip_runtime.h>
#include <hip/hip_cooperative_groups.h>
#include <cstdio>
#include <cstdint>
namespace cg = cooperative_groups;
#endif

#ifndef CFG_B
#define CFG_B 8
#endif
#ifndef CFG_S
#define CFG_S 4096
#endif

constexpr int BATCH = CFG_B, SEQ = CFG_S, DM = 1024, DEPTH = 2;
constexpr int NT = BATCH * SEQ;
constexpr int NH = 4, HD = 64, MW = 256, CH = 64, NC = SEQ / CH;
constexpr int N_IN_ORIG = 4116, PROJ_N = 4352, PROJ_LD = 4128;
constexpr int NCMP = (SEQ - 32) / 16 + 1;
constexpr int NCMP_PAD = SEQ / 16;
constexpr int NSEL = SEQ / 64;
constexpr int PEER_N = 2048;
constexpr float NORM_EPS = 1e-6f;
constexpr int NTHR = 512, NWAVE = 8;
constexpr int C_HQ = 0, C_HF = 256, C_HI = 512, C_HG = 768;
constexpr int C_MQ = 1024, C_MK = 1280, C_MV = 1536, C_MO = 1792;
constexpr int C_NQ = 2048, C_NKC = 2304, C_NVC = 2432, C_NKS = 2560, C_NVS = 2688, C_NKW = 2816, C_NVW = 2944;
constexpr int C_RQ = 3072, C_RK = 3328, C_RV = 3584, C_RG = 3840;
constexpr int C_MI = 4096, C_MF = 4100, C_NG = 4104;

typedef unsigned short bf16_t;
#ifndef HOST_EMU
typedef short bf16x8 __attribute__((ext_vector_type(8)));
typedef float f32x4 __attribute__((ext_vector_type(4)));
#endif
typedef unsigned u32x4 __attribute__((ext_vector_type(4)));
typedef unsigned u32x2 __attribute__((ext_vector_type(2)));
typedef float f32x2 __attribute__((ext_vector_type(2)));

constexpr size_t al256(size_t x) { return (x + 255) & ~(size_t)255; }
constexpr size_t WS_WIN = 0;
constexpr size_t WS_WG = WS_WIN + al256((size_t)PROJ_N * DM * 2);
constexpr size_t WS_WUP = WS_WG + al256((size_t)4 * DM * DM * 2);
constexpr size_t WS_WOUT = WS_WUP + al256((size_t)4 * DM * MW * 2);
constexpr size_t WS_WQ2 = WS_WOUT + al256((size_t)DM * DM * 2);
constexpr size_t WS_WCT = WS_WQ2 + al256((size_t)PEER_N * DM * 2);
constexpr size_t WS_CBIAS = WS_WCT + al256((size_t)2 * 64 * 2048 * 2);
constexpr size_t WS_ROPE = WS_CBIAS + 1024;
constexpr size_t WS_RSS1 = WS_ROPE + al256((size_t)SEQ * 64 * 4);
constexpr size_t WS_RSS2 = WS_RSS1 + al256((size_t)NT * 4);
constexpr size_t WS_XB = WS_RSS2 + al256((size_t)NT * 16 * 4);
constexpr size_t WS_OUTS = WS_XB + al256((size_t)NT * DM * 2);
constexpr size_t WS_ST = WS_OUTS + al256((size_t)NT * DM * 2);
constexpr size_t ST_ONE = (size_t)BATCH * NH * NC * 4096 * 2;
constexpr size_t WS_GDEC = WS_ST + al256(3 * ST_ONE);
constexpr size_t WS_MNL = WS_GDEC + al256((size_t)BATCH * NH * NC * 64 * 4);
constexpr size_t WS_MSC = WS_MNL + al256((size_t)BATCH * NH * NC * 64 * 4);
constexpr size_t WS_KCMP = WS_MSC + al256((size_t)BATCH * NH * NC * 4 * 4);
constexpr size_t WS_VCMPT = WS_KCMP + al256((size_t)BATCH * 2 * NCMP_PAD * 64 * 2);
constexpr size_t WS_KSW = WS_VCMPT + al256((size_t)BATCH * 2 * NCMP_PAD * 64 * 2);
constexpr size_t WS_PROJ = WS_KSW + al256((size_t)NT * 256 * 2);
constexpr size_t PROJ_BYTES = al256((size_t)NT * PROJ_LD * 2);
constexpr size_t WS_END = WS_PROJ + PROJ_BYTES;
constexpr size_t WS_MERGED = WS_PROJ;
constexpr size_t WS_USCR = WS_MERGED + al256((size_t)NT * DM * 2);
constexpr size_t WS_SCORES = WS_PROJ;
constexpr size_t WS_PU = WS_USCR + al256((size_t)NT * DM * 2);
constexpr size_t WS_PV = WS_PU + al256((size_t)16384 * DM * 2);
static_assert(WS_PV + (size_t)16384 * DM * 2 <= WS_END || CFG_B < 8, "overlay fits the proj region");
static_assert(WS_END <= (size_t)536870912, "workspace budget");
constexpr size_t WS_NEED = (WS_PV + (size_t)16384 * DM * 2 > WS_END) ? (WS_PV + (size_t)16384 * DM * 2) : WS_END;

constexpr int LDS_BYTES = 147456;

struct Params {
    const float* in[22];
    float* out;
    unsigned char* ws;
    int phase_lo, phase_hi;
};

#ifndef HOST_EMU
#define DEV __device__ __forceinline__
#define TID() ((int)threadIdx.x)
#define BID() ((int)blockIdx.x)
#define NBLK() ((int)gridDim.x)
extern __shared__ __attribute__((aligned(16))) unsigned char smem_raw[];
#define SMEM_PTR() ((char*)smem_raw)
DEV void block_sync() { __syncthreads(); }
DEV int fresh_lane() { int lane; asm volatile("v_mbcnt_lo_u32_b32 %0, -1, 0\n\tv_mbcnt_hi_u32_b32 %0, -1, %0" : "=v"(lane)); return lane; }
template <int M> DEV int xori(int v) {
    if constexpr (M < 32) return __builtin_amdgcn_ds_swizzle(v, (M << 10) | 0x1f);
    else return __builtin_amdgcn_ds_bpermute((fresh_lane() ^ M) << 2, v);
}
template <int M> DEV float xorf(float v) { return __builtin_bit_cast(float, xori<M>(__builtin_bit_cast(int, v))); }
DEV int shfl_i(int v, int src) { return __builtin_amdgcn_ds_bpermute(src << 2, v); }
DEV float shfl_f(float v, int src) { return __builtin_bit_cast(float, __builtin_amdgcn_ds_bpermute(src << 2, __builtin_bit_cast(int, v))); }
DEV unsigned long long ballot64(bool p) { return __builtin_amdgcn_ballot_w64(p); }
DEV f32x4 mfma16(bf16x8 a, bf16x8 b, f32x4 c) { return __builtin_amdgcn_mfma_f32_16x16x32_bf16(a, b, c, 0, 0, 0); }
DEV void atomic_add_f32(float* p, float v) { atomicAdd(p, v); }
DEV float fast_exp(float x) { return __expf(x); }
DEV float fast_exp2(float x) { return __builtin_amdgcn_exp2f(x); }
DEV float fast_log(float x) { return __logf(x); }
DEV float fast_rcp(float x) { return __builtin_amdgcn_rcpf(x); }
DEV float fast_rsqrt(float x) { return __builtin_amdgcn_rsqf(x); }
#else
#define DEV static inline
#endif

DEV float bf2f(bf16_t v) { unsigned u = ((unsigned)v) << 16; return __builtin_bit_cast(float, u); }
DEV bf16_t f2bf(float f) { unsigned u = __builtin_bit_cast(unsigned, f); return (bf16_t)((u + 0x7fffu + ((u >> 16) & 1u)) >> 16); }
DEV unsigned pk2(float lo, float hi) { return (unsigned)f2bf(lo) | ((unsigned)f2bf(hi) << 16); }
DEV float bflo(unsigned u) { return __builtin_bit_cast(float, u << 16); }
DEV float bfhi(unsigned u) { return __builtin_bit_cast(float, u & 0xffff0000u); }
DEV float sigmoidf_(float x) { return fast_rcp(1.0f + fast_exp(-x)); }
DEV float siluf_(float x) { return x * sigmoidf_(x); }
DEV float log_sigmoidf_(float x) { return fminf(x, 0.f) - log1pf(fast_exp(-fabsf(x))); }
DEV float wave_sum(float v) { v += xorf<1>(v); v += xorf<2>(v); v += xorf<4>(v); v += xorf<8>(v); v += xorf<16>(v); v += xorf<32>(v); return v; }
DEV float wave_max(float v) { v = fmaxf(v, xorf<1>(v)); v = fmaxf(v, xorf<2>(v)); v = fmaxf(v, xorf<4>(v)); v = fmaxf(v, xorf<8>(v)); v = fmaxf(v, xorf<16>(v)); v = fmaxf(v, xorf<32>(v)); return v; }
DEV float gelu_erf(float v) {
    const float av = fabsf(v), t = fast_rcp(1.0f + 0.2316418882f * av);
    float q = t * 0.5307027145f + (-0.7265760135f); q = q * t + 0.7107068705f; q = q * t + (-0.142248368f); q = q * t + 0.127414796f; q = q * t;
    const float e = fast_exp2(v * v * (-0.72134752044f));
    const float m = v * (q * e);
    return v < 0.f ? m : v - m;
}
#ifndef HOST_EMU
#define DEV_M __device__ __forceinline__
#else
#define DEV_M inline
#endif
namespace pg8 {
#define PG8_LAS __attribute__((address_space(3)))
constexpr int BM = 256, BK = 64, HALF = 128, HTB = HALF * BK * 2  , STAGE_BYTES = 8 * HTB, NXCD = 8, WGM = 8;

__host__ __device__ __forceinline__ int lds_byte(int r, int c) { const int st = (r >> 4) * 2 + (c >> 5), rr = r & 15, cc = c & 31, ob = rr * 64 + cc * 2; return st * 1024 + (ob ^ (((ob >> 9) & 1) << 5)); }
__host__ __device__ __forceinline__ void stage_rc(int b, int& R, int& C) { const int st = b / 1024, sb = b % 1024, swz = sb ^ (((sb >> 9) & 1) << 5); R = (st >> 1) * 16 + swz / 64; C = (st & 1) * 32 + (swz % 64) / 2; }
__host__ __device__ __forceinline__ int perm32(int rho) { const int n = rho >> 4, i = rho & 15; return 8 * (i >> 2) + 4 * n + (i & 3); }

struct Unit { int pm, pn; };
struct Gemm { const bf16_t* A; const bf16_t* Bt; int M, N, K; };

struct StaticOrder {
    int nM, nN, nwg, G, c;
    __host__ __device__ void init(int M, int N, int G_, int c_) { nM = M / BM; nN = N / BM; nwg = nM * nN; G = G_; c = c_; }
    __host__ __device__ bool next(int i, Unit& u) const {
        const long L = (long)i * G + c; if (L >= nwg) return false;
        int wgid = (int)L; { const int q = nwg / NXCD, r = nwg % NXCD, xcd = wgid % NXCD, off = wgid / NXCD; wgid = (xcd < r ? xcd * (q + 1) : r * (q + 1) + (xcd - r) * q) + off; }
        const int nig = WGM * nN, gid = wgid / nig, fm = gid * WGM, gsz = (nM - fm) < WGM ? (nM - fm) : WGM;
        u.pm = fm + ((wgid % nig) % gsz); u.pn = (wgid % nig) / gsz; return true;
    }
    DEV_M void a_ready(const Unit&) const {}
    DEV_M void done(const Unit&) const {}
};


#ifndef HOST_EMU
template <class Epi, class Sched, bool ALIGN_EPI = false, bool SP2 = false>
__device__ __forceinline__ void gemm_phase(PG8_LAS unsigned char* lds, const Gemm g, const Sched& S, const Epi& E, const int tid_in) {
    const int tid = tid_in, wid = __builtin_amdgcn_readfirstlane(tid >> 6), lane = tid & 63, wr = wid >> 2, wc = wid & 3, fr = lane & 15, fq = lane >> 4;
    const int K = g.K, nt = K / BK;
    unsigned voffA[2], voffB[2];
#pragma unroll
    for (int i = 0; i < 2; ++i) { int R, C; stage_rc(tid * 16 + i * 8192, R, C); const int Rb = Epi::PERM ? ((R & ~31) + perm32(R & 31)) : R;
        voffA[i] = (unsigned)(R * K + C) * 2u; voffB[i] = (unsigned)(Rb * K + C) * 2u; }
    const size_t kstep = (size_t)(BK * 2);
    const size_t hstep = (size_t)HALF * K * 2;
    const size_t tstep = 2 * hstep;
    const unsigned ldsw = (unsigned)wid * 1024u;
    const int aoff = lds_byte(wr * 64 + fr, fq * 8), boff = lds_byte(wc * 32 + fr, fq * 8);
#define PG8_SA(b, h) (((b) * 2 + (h)) * HTB)
#define PG8_SB(b, h) ((4 + (b) * 2 + (h)) * HTB)
#define PG8_STAGE(bufoff, gbase, voff) do { _Pragma("unroll") for (int _i = 0; _i < 2; ++_i) \
        __builtin_amdgcn_global_load_lds((const unsigned*)((const char*)(gbase) + (voff)[_i]), (PG8_LAS unsigned*)(lds + (bufoff) + ldsw + _i * 8192), 16, 0, 0); } while (0)
#define PG8_LDA(dst, b, h) do { _Pragma("unroll") for (int m = 0; m < 4; ++m) _Pragma("unroll") for (int k = 0; k < 2; ++k) dst[m][k] = *(const PG8_LAS bf16x8*)(lds + PG8_SA(b, h) + aoff + m * 2048 + k * 1024); } while (0)
#define PG8_LDB(dst, b, h) do { _Pragma("unroll") for (int n = 0; n < 2; ++n) _Pragma("unroll") for (int k = 0; k < 2; ++k) dst[n][k] = *(const PG8_LAS bf16x8*)(lds + PG8_SB(b, h) + boff + n * 2048 + k * 1024); } while (0)
#define PG8_MMA(ai, bj, At, Bt) do { __builtin_amdgcn_s_setprio(1); _Pragma("unroll") for (int m = 0; m < 4; ++m) _Pragma("unroll") for (int n = 0; n < 2; ++n) _Pragma("unroll") for (int k = 0; k < 2; ++k) \
        acc[ai][bj][m][n] = __builtin_amdgcn_mfma_f32_16x16x32_bf16(Bt[n][k], At[m][k], acc[ai][bj][m][n], 0, 0, 0); __builtin_amdgcn_s_setprio(0); } while (0)
#define PG8_WAIT_V(n) asm volatile("s_waitcnt vmcnt(" #n ")" ::: "memory")
#define PG8_WAIT_L(n) asm volatile("s_waitcnt lgkmcnt(" #n ")" ::: "memory")
#define PG8_BAR __builtin_amdgcn_s_barrier()
#define PG8_SCHED __builtin_amdgcn_sched_barrier(0)
    Unit cur, nxt; int ui = 0;
    if (!S.next(0, cur)) return;
    f32x4 acc[2][2][4][2];
#pragma unroll
    for (int a = 0; a < 2; ++a)
#pragma unroll
        for (int b = 0; b < 2; ++b)
#pragma unroll
            for (int m = 0; m < 4; ++m)
#pragma unroll
                for (int n = 0; n < 2; ++n) acc[a][b][m][n] = (f32x4){0.f, 0.f, 0.f, 0.f};
    bf16x8 At[4][2], B0[2][2], B1[2][2];
    const char* cA = (const char*)g.A + (size_t)cur.pm * tstep; const char* cB = (const char*)g.Bt + (size_t)cur.pn * tstep;
    S.a_ready(cur);
    if constexpr (SP2) {
        PG8_STAGE(PG8_SB(0, 0), cB, voffB); PG8_STAGE(PG8_SB(0, 1), cB + hstep, voffB); PG8_STAGE(PG8_SA(0, 0), cA, voffA); PG8_STAGE(PG8_SA(0, 1), cA + hstep, voffA);
        if (wr == 1) PG8_BAR;
        PG8_WAIT_V(2); PG8_BAR;
        PG8_STAGE(PG8_SB(1, 0), cB + kstep, voffB); PG8_STAGE(PG8_SA(1, 0), cA + kstep, voffA); PG8_STAGE(PG8_SB(1, 1), cB + hstep + kstep, voffB);
        PG8_WAIT_V(6); PG8_BAR;
    } else {
        PG8_STAGE(PG8_SB(0, 0), cB, voffB); PG8_STAGE(PG8_SA(0, 0), cA, voffA); PG8_STAGE(PG8_SB(0, 1), cB + hstep, voffB); PG8_STAGE(PG8_SA(0, 1), cA + hstep, voffA);
        if (wr == 1) PG8_BAR;
        PG8_WAIT_V(4); PG8_BAR;
        PG8_STAGE(PG8_SB(1, 0), cB + kstep, voffB); PG8_STAGE(PG8_SA(1, 0), cA + kstep, voffA); PG8_STAGE(PG8_SB(1, 1), cB + hstep + kstep, voffB);
        PG8_WAIT_V(6); PG8_BAR;
    }
    for (;;) {
        const bool has_next = S.next(ui + 1, nxt);
        const char* nA = has_next ? (const char*)g.A + (size_t)nxt.pm * tstep : cA; const char* nB = has_next ? (const char*)g.Bt + (size_t)nxt.pn * tstep : cB;
        for (int t = 0; t < nt; t += 2) {
            const bool last = (t == nt - 2);
            const char* a1 = cA + (size_t)(t + 1) * kstep;
            const char* a2 = last ? nA : cA + (size_t)(t + 2) * kstep; const char* b2 = last ? nB : cB + (size_t)(t + 2) * kstep;
            const char* a3 = a2 + kstep; const char* b3 = b2 + kstep;
            if (last && has_next) S.a_ready(nxt);
            if constexpr (SP2) {
            PG8_LDB(B0, 0, 0); PG8_LDB(B1, 0, 1); PG8_SCHED; PG8_LDA(At, 0, 0); PG8_STAGE(PG8_SA(1, 1), a1 + hstep, voffA);
            PG8_WAIT_V(8); PG8_WAIT_L(0); PG8_BAR; PG8_MMA(0, 0, At, B0); PG8_MMA(0, 1, At, B1); PG8_BAR; PG8_SCHED;
            PG8_LDA(At, 0, 1); PG8_STAGE(PG8_SB(0, 0), b2, voffB); PG8_STAGE(PG8_SB(0, 1), b2 + hstep, voffB); PG8_STAGE(PG8_SA(0, 0), a2, voffA);
            PG8_WAIT_V(8); PG8_WAIT_L(0); PG8_BAR; PG8_MMA(1, 0, At, B0); PG8_MMA(1, 1, At, B1); PG8_BAR; PG8_SCHED;
            PG8_LDB(B0, 1, 0); PG8_LDB(B1, 1, 1); PG8_SCHED; PG8_LDA(At, 1, 0); PG8_STAGE(PG8_SA(0, 1), a2 + hstep, voffA);
            PG8_WAIT_V(8); PG8_WAIT_L(0); PG8_BAR; PG8_MMA(0, 0, At, B0); PG8_MMA(0, 1, At, B1); PG8_BAR; PG8_SCHED;
            PG8_LDA(At, 1, 1); PG8_STAGE(PG8_SB(1, 0), b3, voffB); PG8_STAGE(PG8_SB(1, 1), b3 + hstep, voffB); PG8_STAGE(PG8_SA(1, 0), a3, voffA);
            PG8_WAIT_V(8); PG8_WAIT_L(0); PG8_BAR; PG8_MMA(1, 0, At, B0); PG8_MMA(1, 1, At, B1); PG8_BAR; PG8_SCHED;
            } else {
            PG8_LDB(B0, 0, 0); PG8_SCHED; PG8_LDA(At, 0, 0); PG8_STAGE(PG8_SA(1, 1), a1 + hstep, voffA);
            PG8_WAIT_L(8); PG8_BAR; PG8_WAIT_L(0); PG8_MMA(0, 0, At, B0); PG8_BAR; PG8_SCHED;
            PG8_LDB(B1, 0, 1); PG8_STAGE(PG8_SB(0, 0), b2, voffB);
            PG8_BAR; PG8_WAIT_L(0); PG8_MMA(0, 1, At, B1); PG8_BAR;
            PG8_LDA(At, 0, 1); PG8_STAGE(PG8_SA(0, 0), a2, voffA);
            PG8_BAR; PG8_WAIT_L(0); PG8_MMA(1, 0, At, B0); PG8_BAR; PG8_SCHED;
            PG8_STAGE(PG8_SB(0, 1), b2 + hstep, voffB);
            PG8_WAIT_V(6); PG8_BAR; PG8_MMA(1, 1, At, B1); PG8_BAR;
            PG8_LDB(B0, 1, 0); PG8_SCHED; PG8_LDA(At, 1, 0); PG8_STAGE(PG8_SA(0, 1), a2 + hstep, voffA);
            PG8_WAIT_L(8); PG8_BAR; PG8_WAIT_L(0); PG8_MMA(0, 0, At, B0); PG8_BAR; PG8_SCHED;
            PG8_LDB(B1, 1, 1); PG8_STAGE(PG8_SB(1, 0), b3, voffB);
            PG8_BAR; PG8_WAIT_L(0); PG8_MMA(0, 1, At, B1); PG8_BAR;
            PG8_LDA(At, 1, 1); PG8_STAGE(PG8_SA(1, 0), a3, voffA);
            PG8_BAR; PG8_WAIT_L(0); PG8_MMA(1, 0, At, B0); PG8_BAR; PG8_SCHED;
            PG8_STAGE(PG8_SB(1, 1), b3 + hstep, voffB);
            PG8_WAIT_V(6); PG8_BAR; PG8_MMA(1, 1, At, B1); PG8_BAR;
            }
        }
        if constexpr (ALIGN_EPI) { if (wr == 0) PG8_BAR; }
        if constexpr (!Epi::AFTER_DRAIN) { E(acc, cur, wr, wc, fr, fq); S.done(cur); }
        if (!has_next) break;
#pragma unroll
        for (int a = 0; a < 2; ++a)
#pragma unroll
            for (int b = 0; b < 2; ++b)
#pragma unroll
                for (int m = 0; m < 4; ++m)
#pragma unroll
                    for (int n = 0; n < 2; ++n) acc[a][b][m][n] = (f32x4){0.f, 0.f, 0.f, 0.f};
        cur = nxt; cA = nA; cB = nB; ++ui;
        if constexpr (ALIGN_EPI) { if (wr == 1) PG8_BAR; }
    }
    PG8_WAIT_V(0);
    if constexpr (!ALIGN_EPI) { if (wr == 0) PG8_BAR; }
    PG8_BAR;
    if constexpr (Epi::AFTER_DRAIN) { E.fused(acc, cur, wr, wc, fr, fq, lds, wid, lane); S.done(cur); }
#undef PG8_SA
#undef PG8_SB
#undef PG8_STAGE
#undef PG8_LDA
#undef PG8_LDB
#undef PG8_MMA
#undef PG8_WAIT_V
#undef PG8_WAIT_L
#undef PG8_BAR
#undef PG8_SCHED
}
#else
template <class Epi, class Sched, bool ALIGN_EPI = false, bool SP2 = false>
inline void gemm_phase(void* lds, const Gemm g, const Sched& S, const Epi& E, const int tid_in) {
    const int tid = TID(), wid = tid >> 6, lane = tid & 63, wr = wid >> 2, wc = wid & 3, fr = lane & 15, fq = lane >> 4;
    Unit u;
    for (int ui = 0; S.next(ui, u); ++ui) {
        f32x4 acc[2][2][4][2];
        for (int ai = 0; ai < 2; ++ai) for (int bj = 0; bj < 2; ++bj) for (int m = 0; m < 4; ++m) for (int n = 0; n < 2; ++n) for (int j = 0; j < 4; ++j) {
            const int r = 256 * u.pm + 128 * ai + 64 * wr + 16 * m + fr;
            const int c = 256 * u.pn + 128 * bj + 32 * wc + (Epi::PERM ? (8 * fq + 4 * n + j) : (16 * n + 4 * fq + j));
            const bf16_t* a = g.A + (size_t)r * g.K; const bf16_t* b = g.Bt + (size_t)c * g.K;
            float s = 0.f; for (int k = 0; k < g.K; ++k) s += bf2f(a[k]) * bf2f(b[k]);
            acc[ai][bj][m][n][j] = s;
        }
        E(acc, u, wr, wc, fr, fq);
    }
    block_sync();
}
#endif
DEV_M float rstd_of(float ss) { return fast_rsqrt(ss * (1.0f / 1024.0f) + NORM_EPS); }

DEV_M float rss_slots16(const float* p) {
    const f32x4 a = *(const f32x4*)p, b = *(const f32x4*)(p + 4), c = *(const f32x4*)(p + 8), d = *(const f32x4*)(p + 12);
    return (((a[0] + a[1]) + (a[2] + a[3])) + ((b[0] + b[1]) + (b[2] + b[3]))) + (((c[0] + c[1]) + (c[2] + c[3])) + ((d[0] + d[1]) + (d[2] + d[3])));
}
template <int SLOTS> struct EpiScaleBf16 {
    static constexpr bool PERM = true, AFTER_DRAIN = false;
    bf16_t* O; int ldc; const float* rss; int ncols;
    DEV_M void operator()(const f32x4 (&acc)[2][2][4][2], const Unit& u, int wr, int wc, int fr, int fq) const {
        const int row0 = u.pm * BM + wr * 64 + fr, col0 = u.pn * BM + wc * 32 + 8 * fq;
#pragma unroll
        for (int ai = 0; ai < 2; ++ai)
#pragma unroll
            for (int m = 0; m < 4; ++m) {
                const int row = row0 + ai * HALF + m * 16; const float sc = rstd_of(SLOTS == 1 ? rss[row] : rss_slots16(rss + (size_t)row * 16));
                bf16_t* rowp = O + (size_t)row * ldc + col0;
#pragma unroll
                for (int bj = 0; bj < 2; ++bj) {
                    if (col0 + bj * HALF < ncols) {
                        const f32x4 v0 = acc[ai][bj][m][0] * sc, v1 = acc[ai][bj][m][1] * sc;
                        u32x4 w; w.x = pk2(v0[0], v0[1]); w.y = pk2(v0[2], v0[3]); w.z = pk2(v1[0], v1[1]); w.w = pk2(v1[2], v1[3]);
                        *(u32x4*)(rowp + bj * HALF) = w;
                    }
                }
            }
    }
};
struct EpiU {
    static constexpr bool PERM = true, AFTER_DRAIN = false;
    bf16_t* uscr;
    DEV_M void operator()(const f32x4 (&acc)[2][2][4][2], const Unit& u, int wr, int wc, int fr, int fq) const {
        bf16_t* base = uscr + (size_t)(u.pm * 4 + u.pn) * 65536 + (size_t)(wr * 64 + fr) * 256 + wc * 32 + 8 * fq;
#pragma unroll
        for (int ai = 0; ai < 2; ++ai)
#pragma unroll
            for (int m = 0; m < 4; ++m)
#pragma unroll
                for (int bj = 0; bj < 2; ++bj) {
                    const f32x4 v0 = acc[ai][bj][m][0], v1 = acc[ai][bj][m][1];
                    u32x4 w; w.x = pk2(v0[0], v0[1]); w.y = pk2(v0[2], v0[3]); w.z = pk2(v1[0], v1[1]); w.w = pk2(v1[2], v1[3]);
                    *(u32x4*)(base + (size_t)(ai * HALF + m * 16) * 256 + bj * HALF) = w;
                }
    }
};
struct EpiGate {
    static constexpr bool PERM = true, AFTER_DRAIN = false;
    const bf16_t* uscr; bf16_t* merged; const float* rss; int first;
    DEV_M void operator()(const f32x4 (&acc)[2][2][4][2], const Unit& u, int wr, int wc, int fr, int fq) const {
        const bf16_t* ub = uscr + (size_t)(u.pm * 4 + u.pn) * 65536 + (size_t)(wr * 64 + fr) * 256 + wc * 32 + 8 * fq;
        const int row0 = u.pm * BM + wr * 64 + fr, col0 = u.pn * BM + wc * 32 + 8 * fq;
#pragma unroll
        for (int ai = 0; ai < 2; ++ai)
#pragma unroll
            for (int m = 0; m < 4; ++m) {
                const int row = row0 + ai * HALF + m * 16; const float sc = rstd_of(rss[row]);
#pragma unroll
                for (int bj = 0; bj < 2; ++bj) {
                    const u32x4 uv = *(const u32x4*)(ub + (size_t)(ai * HALF + m * 16) * 256 + bj * HALF);
                    bf16_t* mp = merged + (size_t)row * DM + col0 + bj * HALF;
                    u32x4 pv = {0u, 0u, 0u, 0u};
                    if (!first) pv = *(const u32x4*)mp;
                    const f32x4 a0 = acc[ai][bj][m][0] * sc, a1 = acc[ai][bj][m][1] * sc;
                    float r[8];
                    r[0] = sigmoidf_(a0[0]) * bflo(uv.x) + bflo(pv.x); r[1] = sigmoidf_(a0[1]) * bfhi(uv.x) + bfhi(pv.x);
                    r[2] = sigmoidf_(a0[2]) * bflo(uv.y) + bflo(pv.y); r[3] = sigmoidf_(a0[3]) * bfhi(uv.y) + bfhi(pv.y);
                    r[4] = sigmoidf_(a1[0]) * bflo(uv.z) + bflo(pv.z); r[5] = sigmoidf_(a1[1]) * bfhi(uv.z) + bfhi(pv.z);
                    r[6] = sigmoidf_(a1[2]) * bflo(uv.w) + bflo(pv.w); r[7] = sigmoidf_(a1[3]) * bfhi(uv.w) + bfhi(pv.w);
                    u32x4 w; w.x = pk2(r[0], r[1]); w.y = pk2(r[2], r[3]); w.z = pk2(r[4], r[5]); w.w = pk2(r[6], r[7]);
                    *(u32x4*)mp = w;
                }
            }
    }
};
struct EpiOut {
    static constexpr bool PERM = false, AFTER_DRAIN = false;
    const float* xres; float* out; bf16_t* xb; float* rss;
    DEV_M void operator()(const f32x4 (&acc)[2][2][4][2], const Unit& u, int wr, int wc, int fr, int fq) const {
        const int row0 = u.pm * BM + wr * 64 + fr, col0 = u.pn * BM + wc * 32 + 4 * fq;
#pragma unroll
        for (int ai = 0; ai < 2; ++ai)
#pragma unroll
            for (int m = 0; m < 4; ++m) {
                const int row = row0 + ai * HALF + m * 16; const size_t off = (size_t)row * DM + col0; float ss = 0.f;
#pragma unroll
                for (int bj = 0; bj < 2; ++bj)
#pragma unroll
                    for (int n = 0; n < 2; ++n) {
                        const size_t o = off + bj * HALF + n * 16;
                        const f32x4 xr = *(const f32x4*)(xres + o);
                        const f32x4 v = xr + acc[ai][bj][m][n];
                        *(f32x4*)(out + o) = v;
                        u32x2 w; w.x = pk2(v[0], v[1]); w.y = pk2(v[2], v[3]);
                        *(u32x2*)(xb + o) = w;
                        ss += (v[0] * v[0] + v[1] * v[1]) + (v[2] * v[2] + v[3] * v[3]);
                    }
                ss += xorf<16>(ss); ss += xorf<32>(ss);
                if (fq == 0) rss[(size_t)row * 16 + u.pn * 4 + wc] = ss;
            }
    }
};
struct TileOrder {
    int ntiles, G, c;
    DEV_M bool next(int i, Unit& u) const { const long t = (long)i * G + c; if (t >= ntiles) return false; u.pm = (int)(t >> 2); u.pn = (int)(t & 3); return true; }
    DEV_M void a_ready(const Unit&) const {}
    DEV_M void done(const Unit&) const {}
};
}
#ifndef HOST_EMU
#define GEMM_LDS ((PG8_LAS unsigned char*)smem_raw)
#else
#define GEMM_LDS ((void*)nullptr)
#endif
struct Ctx {
    float* out; unsigned char* ws; char* lds; int tid, lane, wave, bid, nblk;
};
constexpr int LDS_PTRS = LDS_BYTES - 256;
#ifndef HOST_EMU
DEV const float* inptr(const Ctx& c, int i) { const unsigned long long v = ((volatile unsigned long long*)(smem_raw + LDS_PTRS))[i];
    const unsigned lo = __builtin_amdgcn_readfirstlane((unsigned)v), hi = __builtin_amdgcn_readfirstlane((unsigned)(v >> 32)); return (const float*)(((unsigned long long)hi << 32) | lo); }
#else
static inline const float* inptr(const Ctx& c, int i) { return ((const float* volatile*)(c.lds + LDS_PTRS))[i]; }
#endif
#define CIN(i) inptr(c, (i))
template <class T> DEV T* wsp(const Ctx& c, size_t off) { return (T*)(c.ws + off); }
DEV int orig_col(int n) {
    if (n < 1792) return n;
    if (n < 2048) return 1800 + (n - 1792);
    if (n < 3072) return 2056 + (n - 2048);
    if (n < 4096) return 3092 + (n - 3072);
    if (n < 4104) return 1792 + (n - 4096);
    if (n < 4116) return 3080 + (n - 4104);
    return -1;
}

template <class F> DEV void transpose_item(const Ctx& c, F src, bf16_t* dst, int ldd, int k0, int n0) {
    float* tile = (float*)c.lds;
    for (int e = c.tid; e < 4096; e += NTHR) { const int k = e >> 6, n = e & 63; tile[n * 65 + k] = src(k0 + k, n0 + n); }
    block_sync();
    for (int e = c.tid; e < 2048; e += NTHR) { const int n = e >> 5, k2 = (e & 31) * 2;
        *(unsigned*)(dst + (size_t)(n0 + n) * ldd + k0 + k2) = pk2(tile[n * 65 + k2], tile[n * 65 + k2 + 1]); }
    block_sync();
}

DEV void p0_prep(const Ctx& c, int l) {
    const float* g1 = CIN(1) + (size_t)l * DM;
    const float* g2 = CIN(17) + (size_t)l * DM;
    constexpr int I_IN = (PROJ_N / 64) * 16, I_G = 4 * 16 * 16, I_UP = 4 * 16 * 4, I_OUT = 16 * 16, I_WQ = 16 * 16, I_WC = 2 * 32, I_CB = 2;
    constexpr int I_TOT = I_IN + I_G + I_UP + I_OUT + I_WQ + I_WC + I_CB;
    for (int it = c.bid; it < I_TOT; it += c.nblk) {
        int r = it;
        if (r < I_IN) {
            const float* w = CIN(2) + (size_t)l * DM * N_IN_ORIG; const int nt = r / 16, kt = r % 16;
            transpose_item(c, [=](int k, int n) { const int oc = orig_col(n); return oc < 0 ? 0.f : w[(size_t)k * N_IN_ORIG + oc] * g1[k]; }, wsp<bf16_t>(c, WS_WIN), DM, kt * 64, nt * 64);
            continue;
        } r -= I_IN;
        if (r < I_G) {
            const int m = r / 256, nt = (r % 256) / 16, kt = r % 16; const float* w = CIN(15) + ((size_t)l * 4 + m) * DM * DM;
            transpose_item(c, [=](int k, int n) { return w[(size_t)k * DM + n] * g1[k]; }, wsp<bf16_t>(c, WS_WG) + (size_t)m * DM * DM, DM, kt * 64, nt * 64);
            continue;
        } r -= I_G;
        if (r < I_UP) {
            const int m = r / 64, nt = (r % 64) / 4, kt = r % 4; const float* w = CIN(14) + ((size_t)l * 4 + m) * MW * DM;
            transpose_item(c, [=](int k, int n) { return w[(size_t)k * DM + n]; }, wsp<bf16_t>(c, WS_WUP) + (size_t)m * DM * MW, MW, kt * 64, nt * 64);
            continue;
        } r -= I_UP;
        if (r < I_OUT) {
            const int nt = r / 16, kt = r % 16; const float* w = CIN(16) + (size_t)l * DM * DM;
            transpose_item(c, [=](int k, int n) { return w[(size_t)k * DM + n]; }, wsp<bf16_t>(c, WS_WOUT), DM, kt * 64, nt * 64);
            continue;
        } r -= I_OUT;
        if (r < I_WQ) {
            const int hp = r / 16, kt = r % 16;
            const float* keys = CIN(19) + ((size_t)l * 16 + hp) * 128 * 128; const float* wq = CIN(18) + (size_t)l * DM * PEER_N;
            float* keysL = (float*)c.lds; float* wqL = keysL + 128 * 129;
            for (int e = c.tid; e < 128 * 128; e += NTHR) keysL[(e >> 7) * 129 + (e & 127)] = keys[e];
            for (int e = c.tid; e < 64 * 128; e += NTHR) { const int k = e >> 7, d = e & 127; wqL[k * 129 + d] = wq[(size_t)(kt * 64 + k) * PEER_N + hp * 128 + d] * g2[kt * 64 + k]; }
            block_sync();
            const int key = c.tid & 127, kg = c.tid >> 7;
            float acc[16];
#pragma unroll
            for (int j = 0; j < 16; ++j) acc[j] = 0.f;
            for (int d = 0; d < 128; ++d) { const float kv = keysL[key * 129 + d];
#pragma unroll
                for (int j = 0; j < 16; ++j) acc[j] += kv * wqL[(kg * 16 + j) * 129 + d]; }
            bf16_t* dst = wsp<bf16_t>(c, WS_WQ2) + (size_t)(hp * 128 + key) * DM + kt * 64 + kg * 16;
#pragma unroll
            for (int j = 0; j < 16; j += 2) *(unsigned*)(dst + j) = pk2(acc[j], acc[j + 1]);
            block_sync();
            continue;
        } r -= I_WQ;
        if (r < I_WC) {
            const int kv = r / 32, kt = r % 32; const float* w = CIN(12) + ((size_t)l * 2 + kv) * 2048 * 64;
            transpose_item(c, [=](int k, int n) { return w[(size_t)k * 64 + n]; }, wsp<bf16_t>(c, WS_WCT) + (size_t)kv * 64 * 2048, 2048, kt * 64, 0);
            continue;
        } r -= I_WC;
        {
            const int kv = r; const float* w = CIN(12) + ((size_t)l * 2 + kv) * 2048 * 64; const float* pe = CIN(11) + ((size_t)l * 2 + kv) * 2048;
            float* red = (float*)c.lds;
            const int e = c.tid & 63, part = c.tid >> 6; float s = 0.f;
            for (int kk = part * 256; kk < part * 256 + 256; ++kk) s += pe[kk] * w[(size_t)kk * 64 + e];
            red[part * 64 + e] = s;
            block_sync();
            if (c.tid < 64) { float t = 0.f; for (int p = 0; p < 8; ++p) t += red[p * 64 + c.tid]; wsp<float>(c, WS_CBIAS)[kv * 64 + c.tid] = t; }
            block_sync();
        }
    }
    if (l == 0) {
        const float* x = CIN(0); bf16_t* xb = wsp<bf16_t>(c, WS_XB); float* rss = wsp<float>(c, WS_RSS1);
        for (int row = c.bid * NWAVE + c.wave; row < NT; row += c.nblk * NWAVE) {
            const f32x4* xr = (const f32x4*)(x + (size_t)row * DM) + c.lane; float s = 0.f;
            u32x2* o = (u32x2*)(xb + (size_t)row * DM) + c.lane;
#pragma unroll
            for (int j = 0; j < 4; ++j) { const f32x4 v = xr[64 * j]; s += (v[0] * v[0] + v[1] * v[1]) + (v[2] * v[2] + v[3] * v[3]);
                u32x2 w; w.x = pk2(v[0], v[1]); w.y = pk2(v[2], v[3]); o[64 * j] = w; }
            s = wave_sum(s);
            if (c.lane == 0) rss[row] = s;
        }
        float* cosT = wsp<float>(c, WS_ROPE); float* sinT = cosT + SEQ * 32;
        for (int i = c.bid * NTHR + c.tid; i < SEQ * 32; i += c.nblk * NTHR) {
            const int pos = i >> 5, fi = i & 31;
            const float inv = exp2f(-(float)fi * 0.41524101186092029f);
            const float a = (float)pos * inv, q = rintf(a * 0.63661977236758134f);
            float rr = fmaf(-q, 1.5703125f, a); rr = fmaf(-q, 4.837512969970703125e-4f, rr); rr = fmaf(-q, 7.54978995489188216e-8f, rr);
            const float r2 = rr * rr;
            const float s = rr * (1.0f + r2 * (-1.0f / 6 + r2 * (1.0f / 120 + r2 * (-1.0f / 5040 + r2 * (1.0f / 362880)))));
            const float cc = 1.0f + r2 * (-0.5f + r2 * (1.0f / 24 + r2 * (-1.0f / 720 + r2 * (1.0f / 40320 + r2 * (-1.0f / 3628800)))));
            const int qi = ((int)q) & 3;
            const float co = qi == 0 ? cc : qi == 1 ? -s : qi == 2 ? -cc : s;
            const float si = qi == 0 ? s : qi == 1 ? cc : qi == 2 ? -s : -cc;
            cosT[i] = co; sinT[i] = si;
        }
    }
}
constexpr int LF_STRIDE = 65, LT_STRIDE = 72;
constexpr int LDS_F0 = 0, LDS_F1 = 16640, LDS_F2 = 33280, LDS_T0 = 49920, LDS_TSZ = 64 * LT_STRIDE * 2, LDS_MISC = LDS_T0 + 6 * LDS_TSZ;
DEV float* ldsF(const Ctx& c, int i) { return (float*)(c.lds + LDS_F0 + i * 16640); }
DEV bf16_t* ldsT(const Ctx& c, int i) { return (bf16_t*)(c.lds + LDS_T0 + i * LDS_TSZ); }
DEV float* ldsM(const Ctx& c) { return (float*)(c.lds + LDS_MISC); }

DEV void load_tile_f32(const Ctx& c, float* F, const bf16_t* proj, int tok0, int col) {
    const int t = c.tid >> 3, d0 = (c.tid & 7) * 8;
    const u32x4 v = *(const u32x4*)(proj + (size_t)(tok0 + t) * PROJ_LD + col + d0);
    float* f = F + t * LF_STRIDE + d0;
    f[0] = bflo(v.x); f[1] = bfhi(v.x); f[2] = bflo(v.y); f[3] = bfhi(v.y); f[4] = bflo(v.z); f[5] = bfhi(v.z); f[6] = bflo(v.w); f[7] = bfhi(v.w);
}
DEV void load_tile_T(const Ctx& c, bf16_t* T, const bf16_t* proj, int tok0, int col) {
    const int t = c.tid >> 3, d0 = (c.tid & 7) * 8;
    const u32x4 v = *(const u32x4*)(proj + (size_t)(tok0 + t) * PROJ_LD + col + d0);
    bf16_t* p = T + d0 * LT_STRIDE + t;
    p[0] = (bf16_t)(v.x & 0xffff); p[LT_STRIDE] = (bf16_t)(v.x >> 16); p[2 * LT_STRIDE] = (bf16_t)(v.y & 0xffff); p[3 * LT_STRIDE] = (bf16_t)(v.y >> 16);
    p[4 * LT_STRIDE] = (bf16_t)(v.z & 0xffff); p[5 * LT_STRIDE] = (bf16_t)(v.z >> 16); p[6 * LT_STRIDE] = (bf16_t)(v.w & 0xffff); p[7 * LT_STRIDE] = (bf16_t)(v.w >> 16);
}
DEV f32x4 mma_tile(const bf16_t* A, int lda, int r0, const bf16_t* B, int ldb, int c0, int K, f32x4 acc, int lane) {
    const int fr = lane & 15, fq = lane >> 4;
    for (int k0 = 0; k0 < K; k0 += 32) {
        const bf16x8 a = *(const bf16x8*)(A + (r0 + fr) * lda + k0 + fq * 8);
        const bf16x8 b = *(const bf16x8*)(B + (c0 + fr) * ldb + k0 + fq * 8);
        acc = mfma16(a, b, acc);
    }
    return acc;
}
DEV float hgrn_lb(const Ctx& c, int l, int ch) { if (l == 0) return 0.f; const float* lb = CIN(3); return sigmoidf_(lb[MW + ch] - lb[ch]); }
DEV float ret_loggamma(int h) { return log1pf(-exp2f(-5.0f - (float)h)); }

DEV void hgrn_front(const Ctx& c, int l, const bf16_t* proj, int tok0, int h) {
    float* F0 = ldsF(c, 0); float* F1 = ldsF(c, 1);
    load_tile_f32(c, F0, proj, tok0, C_HF + h * 64);
    block_sync();
    for (int e = c.tid; e < 4096; e += NTHR) { const int t = e >> 6, d = e & 63; const float fl = F0[t * LF_STRIDE + d], lbv = hgrn_lb(c, l, h * 64 + d);
        const float sg = sigmoidf_(fl), f = lbv + (1.f - lbv) * sg; F0[t * LF_STRIDE + d] = fast_log(f); F1[t * LF_STRIDE + d] = (1.f - lbv) * (1.f - sg); }
    block_sync();
    if (c.tid < 64) { float s = 0.f; for (int t = 0; t < 64; ++t) { s += F0[t * LF_STRIDE + c.tid]; F0[t * LF_STRIDE + c.tid] = s; } }
    block_sync();
}
DEV void rope_tile(const Ctx& c, float* F, int pos0, float scale) {
    const float* cosT = wsp<float>(c, WS_ROPE); const float* sinT = cosT + SEQ * 32;
    for (int e = c.tid; e < 2048; e += NTHR) { const int t = e >> 5, d = e & 31; const float cs = cosT[(pos0 + t) * 32 + d], sn = sinT[(pos0 + t) * 32 + d];
        const float x1 = F[t * LF_STRIDE + d], x2 = F[t * LF_STRIDE + d + 32];
        F[t * LF_STRIDE + d] = (x1 * cs - x2 * sn) * scale; F[t * LF_STRIDE + d + 32] = (x1 * sn + x2 * cs) * scale; }
}
DEV void mlstm_conv_tile(const Ctx& c, int l, float* F, const bf16_t* proj, int tok0, int pos0, int col, int ch0, float scale) {
    const float* cw = CIN(5) + (size_t)l * 4 * 512; const float* cb = CIN(6) + (size_t)l * 512;
    for (int e = c.tid; e < 4096; e += NTHR) { const int t = e >> 6, d = e & 63; float s = cb[ch0 + d];
#pragma unroll
        for (int j = 0; j < 4; ++j) { const int p = pos0 + t - 3 + j; if (p >= 0) s += cw[j * 512 + ch0 + d] * bf2f(proj[(size_t)(tok0 + t - 3 + j) * PROJ_LD + col + d]); }
        F[t * LF_STRIDE + d] = siluf_(s) * scale; }
}
DEV void mlstm_gates(const Ctx& c, int l, const bf16_t* proj, int tok0, int h) {
    float* M = ldsM(c); const float* gb = CIN(7) + (size_t)l * 8;
    if (c.tid < 64) { const int t = c.tid; M[t] = bf2f(proj[(size_t)(tok0 + t) * PROJ_LD + C_MI + h]) + gb[h];
        M[64 + t] = log_sigmoidf_(bf2f(proj[(size_t)(tok0 + t) * PROJ_LD + C_MF + h]) + gb[4 + h]); }
    block_sync();
    if (c.tid == 0) { float s = 0.f; for (int t = 0; t < 64; ++t) { s += M[64 + t]; M[64 + t] = s; } }
    block_sync();
}
DEV void store_state_tiles(const Ctx& c, bf16_t* dst, const f32x4 (&acc)[2]) {
    const int fr = c.lane & 15, fq = c.lane >> 4;
#pragma unroll
    for (int k = 0; k < 2; ++k) { const int ti = c.wave * 2 + k, rt = ti >> 2, ct = ti & 3;
#pragma unroll
        for (int i = 0; i < 4; ++i) dst[(rt * 16 + fq * 4 + i) * 64 + ct * 16 + fr] = f2bf(acc[k][i]); }
}
DEV void f32_to_tile(const Ctx& c, bf16_t* T, const float* F, bool transpose) {
    for (int e = c.tid; e < 4096; e += NTHR) { const int r = e >> 6, q = e & 63; const bf16_t v = f2bf(F[r * LF_STRIDE + q]); if (transpose) T[q * LT_STRIDE + r] = v; else T[r * LT_STRIDE + q] = v; }
}

DEV void recur_local_unit(const Ctx& c, int l, int unit) {
    const int mixer = unit / (BATCH * NH * NC), r = unit % (BATCH * NH * NC), b = r / (NH * NC), h = (r / NC) % NH, ck = r % NC;
    const bf16_t* proj = wsp<bf16_t>(c, WS_PROJ); const int tok0 = b * SEQ + ck * 64, pos0 = ck * 64;
    float* F0 = ldsF(c, 0); float* F1 = ldsF(c, 1); float* M = ldsM(c);
    bf16_t* VT = ldsT(c, 0); bf16_t* KT = ldsT(c, 1);
    bf16_t* dst = wsp<bf16_t>(c, WS_ST + mixer * ST_ONE) + (size_t)r * 4096;
    if (mixer == 0) {
        hgrn_front(c, l, proj, tok0, h);
        for (int e = c.tid; e < 4096; e += NTHR) { const int t = e >> 6, d = e & 63;
            KT[d * LT_STRIDE + t] = f2bf(F1[t * LF_STRIDE + d] * fast_exp(F0[63 * LF_STRIDE + d] - F0[t * LF_STRIDE + d])); }
        if (c.tid < 64) wsp<float>(c, WS_GDEC)[(size_t)r * 64 + c.tid] = fast_exp(F0[63 * LF_STRIDE + c.tid]);
        load_tile_T(c, VT, proj, tok0, C_HI + h * 64);
    } else if (mixer == 2) {
        load_tile_f32(c, F0, proj, tok0, C_RK + h * 64);
        block_sync();
        rope_tile(c, F0, pos0, 0.125f);
        block_sync();
        const float lg = ret_loggamma(h);
        for (int e = c.tid; e < 4096; e += NTHR) { const int t = e >> 6, d = e & 63; KT[d * LT_STRIDE + t] = f2bf(F0[t * LF_STRIDE + d] * fast_exp(lg * (float)(63 - t))); }
        load_tile_T(c, VT, proj, tok0, C_RV + h * 64);
    } else {
        mlstm_gates(c, l, proj, tok0, h);
        mlstm_conv_tile(c, l, F0, proj, tok0, pos0, C_MK + h * 64, 256 + h * 64, 0.125f);
        if (c.tid == 0) { const float bl = M[127]; float a = -3.0e38f; for (int t = 0; t < 64; ++t) a = fmaxf(a, bl - M[64 + t] + M[t]); M[128] = a; M[129] = bl; }
        block_sync();
        for (int e = c.tid; e < 4096; e += NTHR) { const int t = e >> 6, d = e & 63; const float wk = fast_exp(M[129] - M[64 + t] + M[t] - M[128]);
            const float kh = F0[t * LF_STRIDE + d] * wk; F0[t * LF_STRIDE + d] = kh; KT[d * LT_STRIDE + t] = f2bf(kh); }
        load_tile_T(c, VT, proj, tok0, C_MV + h * 64);
        block_sync();
        if (c.tid < 64) { float s = 0.f; for (int t = 0; t < 64; ++t) s += F0[t * LF_STRIDE + c.tid]; wsp<float>(c, WS_MNL)[(size_t)r * 64 + c.tid] = s; }
        if (c.tid == 64) { float* sc = wsp<float>(c, WS_MSC) + (size_t)r * 4; sc[0] = M[128]; sc[1] = M[129]; }
    }
    block_sync();
    f32x4 acc[2];
#pragma unroll
    for (int k = 0; k < 2; ++k) { const int ti = c.wave * 2 + k; acc[k] = (f32x4){0.f, 0.f, 0.f, 0.f}; acc[k] = mma_tile(VT, LT_STRIDE, (ti >> 2) * 16, KT, LT_STRIDE, (ti & 3) * 16, 64, acc[k], c.lane); }
    store_state_tiles(c, dst, acc);
    block_sync();
}

DEV void recur_scan(const Ctx& c) {
    const int ncol = BATCH * NH * 4096;
    for (int i = c.bid * NTHR + c.tid; i < 3 * ncol + BATCH * NH * 64; i += c.nblk * NTHR) {
        if (i < 3 * ncol) {
            const int mixer = i / ncol, col = i % ncol, bh = col >> 12, ed = col & 4095, d = ed & 63, h = bh % NH;
            bf16_t* p = wsp<bf16_t>(c, WS_ST + mixer * ST_ONE) + (size_t)bh * NC * 4096 + ed;
            float s = 0.f;
            if (mixer == 0) { const float* g = wsp<float>(c, WS_GDEC) + (size_t)bh * NC * 64 + d;
                for (int k = 0; k < NC; ++k) { const float t = bf2f(p[(size_t)k * 4096]); p[(size_t)k * 4096] = f2bf(s); s = g[k * 64] * s + t; } }
            else if (mixer == 2) { const float g = fast_exp(ret_loggamma(h) * 64.f);
                for (int k = 0; k < NC; ++k) { const float t = bf2f(p[(size_t)k * 4096]); p[(size_t)k * 4096] = f2bf(s); s = g * s + t; } }
            else { const float* sc = wsp<float>(c, WS_MSC) + (size_t)bh * NC * 4; float m = 0.f;
                for (int k = 0; k < NC; ++k) { const float a = sc[k * 4], bl = sc[k * 4 + 1], mn = fmaxf(bl + m, a);
                    const float t = bf2f(p[(size_t)k * 4096]); p[(size_t)k * 4096] = f2bf(s); s = fast_exp(bl + m - mn) * s + fast_exp(a - mn) * t; m = mn; } }
        } else {
            const int j = i - 3 * ncol, bh = j >> 6, d = j & 63;
            float* p = wsp<float>(c, WS_MNL) + (size_t)bh * NC * 64 + d; float* sc = wsp<float>(c, WS_MSC) + (size_t)bh * NC * 4; float m = 0.f, s = 0.f;
            for (int k = 0; k < NC; ++k) { const float a = sc[k * 4], bl = sc[k * 4 + 1], mn = fmaxf(bl + m, a);
                const float t = p[k * 64]; p[k * 64] = s; if (d == 0) sc[k * 4 + 2] = m; s = fast_exp(bl + m - mn) * s + fast_exp(a - mn) * t; m = mn; }
        }
    }
}

DEV void recur_out_unit(const Ctx& c, int l, int unit) {
    const int mixer = unit / (BATCH * NH * NC), r = unit % (BATCH * NH * NC), b = r / (NH * NC), h = (r / NC) % NH, ck = r % NC;
    const bf16_t* proj = wsp<bf16_t>(c, WS_PROJ); const int tok0 = b * SEQ + ck * 64, pos0 = ck * 64;
    float* F0 = ldsF(c, 0); float* F1 = ldsF(c, 1); float* F2 = ldsF(c, 2); float* M = ldsM(c);
    bf16_t* QA = ldsT(c, 0); bf16_t* KB = ldsT(c, 1); bf16_t* P = ldsT(c, 2); bf16_t* Q2 = ldsT(c, 3); bf16_t* VT = ldsT(c, 4); bf16_t* STt = ldsT(c, 5);
    const bf16_t* st = wsp<bf16_t>(c, WS_ST + mixer * ST_ONE) + (size_t)r * 4096;
    const int fr = c.lane & 15, fq = c.lane >> 4;
    { const int e = c.tid >> 3, d0 = (c.tid & 7) * 8; *(u32x4*)(STt + e * LT_STRIDE + d0) = *(const u32x4*)(st + e * 64 + d0); }
    int vcol, gcol; const float* onorm;
    if (mixer == 0) {
        vcol = C_HI; gcol = C_HG; onorm = CIN(4) + (size_t)l * MW;
        hgrn_front(c, l, proj, tok0, h);
        load_tile_f32(c, F2, proj, tok0, C_HQ + h * 64);
        block_sync();
        for (int e = c.tid; e < 4096; e += NTHR) { const int t = e >> 6, d = e & 63; const float q = siluf_(F2[t * LF_STRIDE + d]), bt = F0[t * LF_STRIDE + d], bm = F0[31 * LF_STRIDE + d];
            QA[t * LT_STRIDE + d] = f2bf(q * fast_exp(bt - bm)); KB[t * LT_STRIDE + d] = f2bf(F1[t * LF_STRIDE + d] * fast_exp(bm - bt)); Q2[t * LT_STRIDE + d] = f2bf(q * fast_exp(bt)); }
    } else if (mixer == 2) {
        vcol = C_RV; gcol = C_RG; onorm = CIN(13) + (size_t)l * MW;
        load_tile_f32(c, F0, proj, tok0, C_RQ + h * 64); load_tile_f32(c, F1, proj, tok0, C_RK + h * 64);
        block_sync();
        rope_tile(c, F0, pos0, 1.0f); rope_tile(c, F1, pos0, 0.125f);
        block_sync();
        const float lg = ret_loggamma(h);
        for (int e = c.tid; e < 4096; e += NTHR) { const int t = e >> 6, d = e & 63; const float q = F0[t * LF_STRIDE + d];
            QA[t * LT_STRIDE + d] = f2bf(q); KB[t * LT_STRIDE + d] = f2bf(F1[t * LF_STRIDE + d]); Q2[t * LT_STRIDE + d] = f2bf(q * fast_exp(lg * (float)(t + 1))); }
    } else {
        vcol = C_MV; gcol = C_MO; onorm = CIN(8) + (size_t)l * MW;
        mlstm_gates(c, l, proj, tok0, h);
        mlstm_conv_tile(c, l, F0, proj, tok0, pos0, C_MQ + h * 64, h * 64, 1.0f);
        mlstm_conv_tile(c, l, F1, proj, tok0, pos0, C_MK + h * 64, 256 + h * 64, 0.125f);
        if (c.tid == 0) {
            const float mst = wsp<float>(c, WS_MSC)[(size_t)r * 4 + 2]; float pm = -3.0e38f;
            for (int t = 0; t < 64; ++t) { pm = fmaxf(pm, M[t] - M[64 + t]); const float inter = M[64 + t] + mst, mt = fmaxf(inter, M[64 + t] + pm); M[128 + t] = mt; M[192 + t] = fast_exp(inter - mt); }
        }
        block_sync();
        for (int e = c.tid; e < 4096; e += NTHR) { const int t = e >> 6, d = e & 63; const float q = F0[t * LF_STRIDE + d];
            QA[t * LT_STRIDE + d] = f2bf(q); KB[t * LT_STRIDE + d] = f2bf(F1[t * LF_STRIDE + d]); Q2[t * LT_STRIDE + d] = f2bf(q * M[192 + t]); }
        if (c.tid < 64) { const float* nst = wsp<float>(c, WS_MNL) + (size_t)r * 64; float s = 0.f; for (int d = 0; d < 64; ++d) s += F0[c.tid * LF_STRIDE + d] * nst[d]; M[256 + c.tid] = s * M[192 + c.tid]; }
    }
    load_tile_T(c, VT, proj, tok0, vcol + h * 64);
    block_sync();
    f32x4 acc[2];
#pragma unroll
    for (int k = 0; k < 2; ++k) { const int ti = c.wave * 2 + k; acc[k] = (f32x4){0.f, 0.f, 0.f, 0.f}; acc[k] = mma_tile(QA, LT_STRIDE, (ti >> 2) * 16, KB, LT_STRIDE, (ti & 3) * 16, 64, acc[k], c.lane); }
    const float lg = ret_loggamma(h);
#pragma unroll
    for (int k = 0; k < 2; ++k) { const int ti = c.wave * 2 + k, rt = ti >> 2, ct = ti & 3, s = ct * 16 + fr;
#pragma unroll
        for (int i = 0; i < 4; ++i) { const int t = rt * 16 + fq * 4 + i; float v = 0.f;
            if (s <= t) {
                if (mixer == 0) v = acc[k][i];
                else if (mixer == 2) v = acc[k][i] * fast_exp(lg * (float)(t - s));
                else v = acc[k][i] * fast_exp(M[64 + t] - M[64 + s] + M[s] - M[128 + t]);
            }
            P[t * LT_STRIDE + s] = f2bf(v); if (mixer == 1) F2[t * LF_STRIDE + s] = v; } }
    block_sync();
#pragma unroll
    for (int k = 0; k < 2; ++k) { const int ti = c.wave * 2 + k; acc[k] = (f32x4){0.f, 0.f, 0.f, 0.f};
        acc[k] = mma_tile(P, LT_STRIDE, (ti >> 2) * 16, VT, LT_STRIDE, (ti & 3) * 16, 64, acc[k], c.lane);
        acc[k] = mma_tile(Q2, LT_STRIDE, (ti >> 2) * 16, STt, LT_STRIDE, (ti & 3) * 16, 64, acc[k], c.lane); }
    if (mixer == 1 && c.tid < 64) { float s = 0.f; for (int j = 0; j < 64; ++j) s += F2[c.tid * LF_STRIDE + j]; const float den = M[256 + c.tid] + s; M[320 + c.tid] = fast_rcp(fmaxf(fabsf(den), fast_exp(-M[128 + c.tid]))); }
    block_sync();
#pragma unroll
    for (int k = 0; k < 2; ++k) { const int ti = c.wave * 2 + k, rt = ti >> 2, ct = ti & 3;
#pragma unroll
        for (int i = 0; i < 4; ++i) { const int t = rt * 16 + fq * 4 + i; float v = acc[k][i]; if (mixer == 1) v *= M[320 + t]; F1[t * LF_STRIDE + ct * 16 + fr] = v; } }
    block_sync();
    if (c.tid < 64) { float s = 0.f; for (int e = 0; e < 64; ++e) { const float v = F1[c.tid * LF_STRIDE + e]; s += v * v; } M[384 + c.tid] = fast_rsqrt(s * (1.0f / 64.0f) + NORM_EPS); }
    block_sync();
    bf16_t* out = wsp<bf16_t>(c, WS_OUTS) + (size_t)(mixer == 0 ? 0 : mixer == 1 ? 1 : 3) * NT * MW;
    { const int t = c.tid >> 3, e0 = (c.tid & 7) * 8;
      const u32x4 gv = *(const u32x4*)(proj + (size_t)(tok0 + t) * PROJ_LD + gcol + h * 64 + e0);
      const float gr[8] = {bflo(gv.x), bfhi(gv.x), bflo(gv.y), bfhi(gv.y), bflo(gv.z), bfhi(gv.z), bflo(gv.w), bfhi(gv.w)};
      float o[8];
#pragma unroll
      for (int j = 0; j < 8; ++j) { const float gate = (mixer == 1) ? sigmoidf_(gr[j]) : siluf_(gr[j]); o[j] = F1[t * LF_STRIDE + e0 + j] * M[384 + t] * onorm[h * 64 + e0 + j] * gate; }
      u32x4 w; w.x = pk2(o[0], o[1]); w.y = pk2(o[2], o[3]); w.z = pk2(o[4], o[5]); w.w = pk2(o[6], o[7]);
      *(u32x4*)(out + (size_t)(tok0 + t) * MW + h * 64 + e0) = w; }
    block_sync();
}
#ifndef HOST_EMU
DEV void wave_sync() { __builtin_amdgcn_fence(__ATOMIC_ACQ_REL, "wavefront"); __builtin_amdgcn_wave_barrier(); }
#else
static inline void wave_sync() { emu_bar_wait(emu_wave().bar, 64); }
#endif

DEV void nsa_kprep_item(const Ctx& c, int l, int item) {
    const bf16_t* proj = wsp<bf16_t>(c, WS_PROJ); bf16_t* ksw = wsp<bf16_t>(c, WS_KSW);
    const float* cosT = wsp<float>(c, WS_ROPE); const float* sinT = cosT + SEQ * 32;
    const int tok = item * 4 + (c.tid >> 7), vec = (c.tid >> 5) & 3, br = vec >> 1, g = vec & 1, d = c.tid & 31;
    const int col = (br == 0 ? C_NKS : C_NKW) + g * 64;
    const float x1 = bf2f(proj[(size_t)tok * PROJ_LD + col + d]), x2 = bf2f(proj[(size_t)tok * PROJ_LD + col + d + 32]);
    float ss = x1 * x1 + x2 * x2;
    ss += xorf<1>(ss); ss += xorf<2>(ss); ss += xorf<4>(ss); ss += xorf<8>(ss); ss += xorf<16>(ss);
    const float r = fast_rsqrt(ss * (1.0f / 64.0f) + NORM_EPS); const float* kg = CIN(10) + ((size_t)l * 3 + 1 + br) * 64;
    const float y1 = x1 * r * kg[d], y2 = x2 * r * kg[d + 32]; const int pos = tok % SEQ;
    const float cs = cosT[pos * 32 + d], sn = sinT[pos * 32 + d];
    bf16_t* o = ksw + (size_t)tok * 256 + vec * 64;
    o[d] = f2bf(y1 * cs - y2 * sn); o[d + 32] = f2bf(y1 * sn + y2 * cs);
}
DEV void nsa_compress_unit(const Ctx& c, int l, int unit) {
    const int half = unit & 1, kv = (unit >> 1) & 1, g = (unit >> 2) & 1, b = unit >> 3;
    const bf16_t* proj = wsp<bf16_t>(c, WS_PROJ); const bf16_t* wct = wsp<bf16_t>(c, WS_WCT) + (size_t)kv * 64 * 2048;
    const int fr = c.lane & 15, fq = c.lane >> 4, n0 = half * 128 + c.wave * 16, n = n0 + fr;
    const int col = (kv == 0 ? C_NKC : C_NVC) + g * 64;
    if (n0 >= NCMP_PAD) return;
    f32x4 acc[4];
#pragma unroll
    for (int et = 0; et < 4; ++et) acc[et] = (f32x4){0.f, 0.f, 0.f, 0.f};
    for (int k0 = 0; k0 < 2048; k0 += 32) {
        const int kk = k0 + fq * 8, lrow = kk >> 6, d0 = kk & 63;
        bf16x8 a = {0, 0, 0, 0, 0, 0, 0, 0};
        if (n < NCMP) a = *(const bf16x8*)(proj + (size_t)(b * SEQ + 16 * n + lrow) * PROJ_LD + col + d0);
#pragma unroll
        for (int et = 0; et < 4; ++et) { const bf16x8 bb = *(const bf16x8*)(wct + (size_t)(et * 16 + fr) * 2048 + kk); acc[et] = mfma16(a, bb, acc[et]); }
    }
    const float* bias = wsp<float>(c, WS_CBIAS) + kv * 64;
    float v[4][4];
#pragma unroll
    for (int et = 0; et < 4; ++et)
#pragma unroll
        for (int i = 0; i < 4; ++i) v[et][i] = acc[et][i] + bias[et * 16 + fr];
    if (kv == 0) {
        const float* kg = CIN(10) + (size_t)l * 3 * 64; bf16_t* kc = wsp<bf16_t>(c, WS_KCMP) + (size_t)(b * 2 + g) * NCMP_PAD * 64;
#pragma unroll
        for (int i = 0; i < 4; ++i) { float ss = 0.f;
#pragma unroll
            for (int et = 0; et < 4; ++et) ss += v[et][i] * v[et][i];
            ss += xorf<1>(ss); ss += xorf<2>(ss); ss += xorf<4>(ss); ss += xorf<8>(ss);
            const float r = fast_rsqrt(ss * (1.0f / 64.0f) + NORM_EPS);
#pragma unroll
            for (int et = 0; et < 4; ++et) kc[(size_t)(n0 + fq * 4 + i) * 64 + et * 16 + fr] = f2bf(v[et][i] * r * kg[et * 16 + fr]); }
    } else {
        bf16_t* vt = wsp<bf16_t>(c, WS_VCMPT) + (size_t)(b * 2 + g) * 64 * NCMP_PAD;
#pragma unroll
        for (int et = 0; et < 4; ++et)
#pragma unroll
            for (int i = 0; i < 4; ++i) vt[(size_t)(et * 16 + fr) * NCMP_PAD + n0 + fq * 4 + i] = f2bf(v[et][i]);
    }
}

constexpr int NA_PC = 0, NA_PCLD = 264, NA_IMP = 67584, NA_SEL = 84224, NA_KT = 84736, NA_VT = 93952, NA_PW = 103168, NA_GATE = 121600;
constexpr float NEG_BIG = -1.0e30f;

template <int MODE>
DEV void nsa_key_block(const Ctx& c, int j, int qt, const bf16x8 (&qr)[2], f32x4 (&oacc)[4], float (&mrun)[4], float (&lrun)[4], const unsigned long long (&selm)[4]) {
    const bf16_t* Kt = (const bf16_t*)(c.lds + NA_KT); const bf16_t* VT = (const bf16_t*)(c.lds + NA_VT); bf16_t* Pw = (bf16_t*)(c.lds + NA_PW) + c.wave * 16 * 72;
    const int fr = c.lane & 15, fq = c.lane >> 4, qb = (c.wave & 3) * 16 + fq * 4;
    f32x4 s[4];
#pragma unroll
    for (int kt = 0; kt < 4; ++kt) { s[kt] = (f32x4){0.f, 0.f, 0.f, 0.f};
        s[kt] = mfma16(qr[0], *(const bf16x8*)(Kt + (kt * 16 + fr) * 72 + fq * 8), s[kt]);
        s[kt] = mfma16(qr[1], *(const bf16x8*)(Kt + (kt * 16 + fr) * 72 + 32 + fq * 8), s[kt]); }
    bool valid[4][4]; float mx[4];
#pragma unroll
    for (int i = 0; i < 4; ++i) { mx[i] = NEG_BIG; const int qi = qb + i;
#pragma unroll
        for (int kt = 0; kt < 4; ++kt) { const int kk = kt * 16 + fr; bool ok;
            if (MODE == 0) ok = ((selm[i] >> j) & 1ull) && (j < qt || kk <= qi);
            else { const int dlt = (qt - j) * 64 + qi - kk; ok = dlt >= 0 && dlt < 512; }
            valid[i][kt] = ok; if (ok) mx[i] = fmaxf(mx[i], s[kt][i]); }
        mx[i] = fmaxf(mx[i], xorf<1>(mx[i])); mx[i] = fmaxf(mx[i], xorf<2>(mx[i])); mx[i] = fmaxf(mx[i], xorf<4>(mx[i])); mx[i] = fmaxf(mx[i], xorf<8>(mx[i])); }
#pragma unroll
    for (int i = 0; i < 4; ++i) { const float mn = fmaxf(mrun[i], mx[i]), alpha = fast_exp(mrun[i] - mn); mrun[i] = mn; float ps = 0.f;
#pragma unroll
        for (int kt = 0; kt < 4; ++kt) { const float p = valid[i][kt] ? fast_exp(s[kt][i] - mn) : 0.f; ps += p; Pw[(fq * 4 + i) * 72 + kt * 16 + fr] = f2bf(p); }
        lrun[i] = lrun[i] * alpha + ps;
#pragma unroll
        for (int et = 0; et < 4; ++et) oacc[et][i] *= alpha; }
    wave_sync();
    const bf16x8 pa0 = *(const bf16x8*)(Pw + fr * 72 + fq * 8), pa1 = *(const bf16x8*)(Pw + fr * 72 + 32 + fq * 8);
#pragma unroll
    for (int et = 0; et < 4; ++et) { oacc[et] = mfma16(pa0, *(const bf16x8*)(VT + (et * 16 + fr) * 72 + fq * 8), oacc[et]);
        oacc[et] = mfma16(pa1, *(const bf16x8*)(VT + (et * 16 + fr) * 72 + 32 + fq * 8), oacc[et]); }
    wave_sync();
}

DEV void nsa_attn_unit(const Ctx& c, int l, int unit) {
    const int qt = unit % NSEL, bg = unit / NSEL, g = bg & 1, b = bg >> 1;
    const bf16_t* proj = wsp<bf16_t>(c, WS_PROJ); const bf16_t* ksw = wsp<bf16_t>(c, WS_KSW);
    const float* cosT = wsp<float>(c, WS_ROPE); const float* sinT = cosT + SEQ * 32;
    bf16_t* Pc = (bf16_t*)(c.lds + NA_PC); float* imp = (float*)(c.lds + NA_IMP); unsigned long long* selmask = (unsigned long long*)(c.lds + NA_SEL);
    bf16_t* Kt = (bf16_t*)(c.lds + NA_KT); bf16_t* VT = (bf16_t*)(c.lds + NA_VT); float* gates = (float*)(c.lds + NA_GATE);
    const int fr = c.lane & 15, fq = c.lane >> 4, hg = c.wave >> 2, hd = g * 2 + hg, qw = (c.wave & 3) * 16;
    const int tokq0 = b * SEQ + qt * 64;
    bf16x8 qc[2], qr[2];
    {
        const int tok = tokq0 + qw + fr, pos = qt * 64 + qw + fr;
        const u32x4 v0 = *(const u32x4*)(proj + (size_t)tok * PROJ_LD + C_NQ + hd * 64 + fq * 8), v1 = *(const u32x4*)(proj + (size_t)tok * PROJ_LD + C_NQ + hd * 64 + 32 + fq * 8);
        float x0[8] = {bflo(v0.x), bfhi(v0.x), bflo(v0.y), bfhi(v0.y), bflo(v0.z), bfhi(v0.z), bflo(v0.w), bfhi(v0.w)};
        float x1[8] = {bflo(v1.x), bfhi(v1.x), bflo(v1.y), bfhi(v1.y), bflo(v1.z), bfhi(v1.z), bflo(v1.w), bfhi(v1.w)};
        float ss = 0.f;
#pragma unroll
        for (int j = 0; j < 8; ++j) ss += x0[j] * x0[j] + x1[j] * x1[j];
        ss += xorf<16>(ss); ss += xorf<32>(ss);
        const float r = fast_rsqrt(ss * (1.0f / 64.0f) + NORM_EPS) * 0.125f; const float* qg = CIN(9) + (size_t)l * 64;
#pragma unroll
        for (int j = 0; j < 8; ++j) { const int d = fq * 8 + j; const float y0 = x0[j] * r * qg[d], y1 = x1[j] * r * qg[d + 32];
            const float cs = cosT[pos * 32 + d], sn = sinT[pos * 32 + d];
            qc[0][j] = (short)f2bf(y0); qc[1][j] = (short)f2bf(y1); qr[0][j] = (short)f2bf(y0 * cs - y1 * sn); qr[1][j] = (short)f2bf(y0 * sn + y1 * cs); }
    }
    if (c.tid < 384) { const int row = c.tid / 3, br = c.tid % 3, hh = row >> 6, q = row & 63;
        gates[c.tid] = sigmoidf_(bf2f(proj[(size_t)(tokq0 + q) * PROJ_LD + C_NG + (g * 2 + hh) * 3 + br])); }
    f32x4 ofin[4];
#pragma unroll
    for (int et = 0; et < 4; ++et) ofin[et] = (f32x4){0.f, 0.f, 0.f, 0.f};
    const int nvis = 4 * qt + 3, nkt = (nvis + 15) >> 4, nk32 = ((nkt * 16 + 31) >> 5) << 5;
    {
        const bf16_t* kc = wsp<bf16_t>(c, WS_KCMP) + (size_t)(b * 2 + g) * NCMP_PAD * 64;
        f32x4 s[16];
#pragma unroll
        for (int jt = 0; jt < 16; ++jt) { s[jt] = (f32x4){0.f, 0.f, 0.f, 0.f};
            if (jt < nkt) { s[jt] = mfma16(qc[0], *(const bf16x8*)(kc + (size_t)(jt * 16 + fr) * 64 + fq * 8), s[jt]);
                            s[jt] = mfma16(qc[1], *(const bf16x8*)(kc + (size_t)(jt * 16 + fr) * 64 + 32 + fq * 8), s[jt]); } }
#pragma unroll
        for (int i = 0; i < 4; ++i) {
            const int sp = qt * 64 + qw + fq * 4 + i, lim = (sp >= 31) ? ((sp - 31) >> 4) : -1;
            float mx = NEG_BIG;
#pragma unroll
            for (int jt = 0; jt < 16; ++jt) if (jt < nkt && jt * 16 + fr <= lim) mx = fmaxf(mx, s[jt][i]);
            mx = fmaxf(mx, xorf<1>(mx)); mx = fmaxf(mx, xorf<2>(mx)); mx = fmaxf(mx, xorf<4>(mx)); mx = fmaxf(mx, xorf<8>(mx));
            float ps = 0.f;
#pragma unroll
            for (int jt = 0; jt < 16; ++jt) { float p = 0.f; if (jt < nkt && jt * 16 + fr <= lim) p = fast_exp(s[jt][i] - mx); s[jt][i] = p; ps += p; }
            ps += xorf<1>(ps); ps += xorf<2>(ps); ps += xorf<4>(ps); ps += xorf<8>(ps);
            const float inv = ps > 0.f ? fast_rcp(ps) : 0.f;
            bf16_t* prow = Pc + (size_t)(hg * 64 + qw + fq * 4 + i) * NA_PCLD;
#pragma unroll
            for (int jt = 0; jt < 16; ++jt) if (jt * 16 < nk32) prow[jt * 16 + fr] = f2bf(s[jt][i] * inv);
        }
        wave_sync();
        const bf16_t* vt = wsp<bf16_t>(c, WS_VCMPT) + (size_t)(b * 2 + g) * 64 * NCMP_PAD;
        f32x4 oc[4];
#pragma unroll
        for (int et = 0; et < 4; ++et) oc[et] = (f32x4){0.f, 0.f, 0.f, 0.f};
        for (int k0 = 0; k0 < nk32; k0 += 32) {
            const bf16x8 pa = *(const bf16x8*)(Pc + (size_t)(hg * 64 + qw + fr) * NA_PCLD + k0 + fq * 8);
#pragma unroll
            for (int et = 0; et < 4; ++et) oc[et] = mfma16(pa, *(const bf16x8*)(vt + (size_t)(et * 16 + fr) * NCMP_PAD + k0 + fq * 8), oc[et]);
        }
        block_sync();
#pragma unroll
        for (int i = 0; i < 4; ++i) { const float gt = gates[(hg * 64 + qw + fq * 4 + i) * 3 + 0];
#pragma unroll
            for (int et = 0; et < 4; ++et) ofin[et][i] += gt * oc[et][i]; }
    }
    for (int e = c.tid; e < 4096; e += NTHR) { const int q = e >> 6, j = e & 63; float a = 0.f;
        if (j <= qt) {
#pragma unroll
            for (int dn = -1; dn <= 3; ++dn) { const int n = 4 * j + dn; if (n >= 0 && n < nkt * 16) a += bf2f(Pc[(size_t)q * NA_PCLD + n]) + bf2f(Pc[(size_t)(64 + q) * NA_PCLD + n]); }
            if (j == 0 || j == qt || j == qt - 1) a += 1000.f;
        } else a = NEG_BIG;
        imp[q * 65 + j] = a; }
    block_sync();
    for (int qq = 0; qq < 8; ++qq) { const int q = c.wave * 8 + qq; unsigned long long m = 0ull;
        if (qt < 16) m = (qt == 63) ? ~0ull : ((1ull << (qt + 1)) - 1ull);
        else { float v = imp[q * 65 + c.lane];
            for (int it = 0; it < 16; ++it) { const float mx = wave_max(v); const unsigned long long bal = ballot64(v == mx); const int first = __builtin_ctzll(bal);
                m |= 1ull << first; if (c.lane == first) v = -3.0e38f; } }
        if (c.lane == 0) selmask[q] = m; }
    block_sync();
    unsigned long long selm[4], um;
    { const unsigned long long mine = selmask[c.lane]; unsigned lo = (unsigned)mine, hi = (unsigned)(mine >> 32);
      lo |= (unsigned)xori<1>((int)lo); hi |= (unsigned)xori<1>((int)hi); lo |= (unsigned)xori<2>((int)lo); hi |= (unsigned)xori<2>((int)hi); lo |= (unsigned)xori<4>((int)lo); hi |= (unsigned)xori<4>((int)hi);
      lo |= (unsigned)xori<8>((int)lo); hi |= (unsigned)xori<8>((int)hi); lo |= (unsigned)xori<16>((int)lo); hi |= (unsigned)xori<16>((int)hi); lo |= (unsigned)xori<32>((int)lo); hi |= (unsigned)xori<32>((int)hi);
      um = ((unsigned long long)hi << 32) | lo;
#pragma unroll
      for (int i = 0; i < 4; ++i) selm[i] = selmask[qw + fq * 4 + i]; }
#pragma unroll
    for (int mode = 0; mode < 2; ++mode) {
        f32x4 oacc[4]; float mrun[4], lrun[4];
#pragma unroll
        for (int et = 0; et < 4; ++et) oacc[et] = (f32x4){0.f, 0.f, 0.f, 0.f};
#pragma unroll
        for (int i = 0; i < 4; ++i) { mrun[i] = NEG_BIG; lrun[i] = 0.f; }
        const int j0 = (mode == 0) ? 0 : (qt >= 8 ? qt - 8 : 0);
        for (int j = j0; j <= qt; ++j) {
            if (mode == 0 && !((um >> j) & 1ull)) continue;
            { const int key = c.tid >> 3, d0 = (c.tid & 7) * 8; const int tok = b * SEQ + j * 64 + key;
              *(u32x4*)(Kt + key * 72 + d0) = *(const u32x4*)(ksw + (size_t)tok * 256 + (mode * 2 + g) * 64 + d0);
              const u32x4 v = *(const u32x4*)(proj + (size_t)tok * PROJ_LD + (mode == 0 ? C_NVS : C_NVW) + g * 64 + d0);
              bf16_t* p = VT + d0 * 72 + key;
              p[0] = (bf16_t)(v.x & 0xffff); p[72] = (bf16_t)(v.x >> 16); p[144] = (bf16_t)(v.y & 0xffff); p[216] = (bf16_t)(v.y >> 16);
              p[288] = (bf16_t)(v.z & 0xffff); p[360] = (bf16_t)(v.z >> 16); p[432] = (bf16_t)(v.w & 0xffff); p[504] = (bf16_t)(v.w >> 16); }
            block_sync();
            if (mode == 0) nsa_key_block<0>(c, j, qt, qr, oacc, mrun, lrun, selm); else nsa_key_block<1>(c, j, qt, qr, oacc, mrun, lrun, selm);
            block_sync();
        }
#pragma unroll
        for (int i = 0; i < 4; ++i) { float ls = lrun[i]; ls += xorf<1>(ls); ls += xorf<2>(ls); ls += xorf<4>(ls); ls += xorf<8>(ls);
            const float sc = gates[(hg * 64 + qw + fq * 4 + i) * 3 + 1 + mode] * (ls > 0.f ? fast_rcp(ls) : 0.f);
#pragma unroll
            for (int et = 0; et < 4; ++et) ofin[et][i] += sc * oacc[et][i]; }
    }
    bf16_t* out = wsp<bf16_t>(c, WS_OUTS) + (size_t)2 * NT * MW;
#pragma unroll
    for (int i = 0; i < 4; ++i)
#pragma unroll
        for (int et = 0; et < 4; ++et) out[(size_t)(tokq0 + qw + fq * 4 + i) * MW + hd * 64 + et * 16 + fr] = f2bf(ofin[et][i]);
    block_sync();
}
constexpr int PEER_WSCR = 768 * 4;
#ifndef HOST_EMU
DEV int uniform_i(int v) { return __builtin_amdgcn_readfirstlane(v); }
#else
static inline int uniform_i(int v) { return v; }
#endif
DEV float dot8(const u32x4 a, const u32x4 b) {
    return (bflo(a.x) * bflo(b.x) + bfhi(a.x) * bfhi(b.x)) + (bflo(a.y) * bflo(b.y) + bfhi(a.y) * bfhi(b.y)) + (bflo(a.z) * bflo(b.z) + bfhi(a.z) * bfhi(b.z)) + (bflo(a.w) * bflo(b.w) + bfhi(a.w) * bfhi(b.w));
}
DEV void axpy8(float (&acc)[8], float w, const u32x4 v) {
    acc[0] += w * bflo(v.x); acc[1] += w * bfhi(v.x); acc[2] += w * bflo(v.y); acc[3] += w * bfhi(v.y);
    acc[4] += w * bflo(v.z); acc[5] += w * bfhi(v.z); acc[6] += w * bflo(v.w); acc[7] += w * bfhi(v.w);
}
DEV void peer_token(const Ctx& c, int l, int tok) {
    const int lane = c.lane;
    float* Wv = (float*)(c.lds + c.wave * PEER_WSCR); int* Wi = (int*)(Wv + 256); int* We = Wi + 256; float* Wg = (float*)(We + 128);
    const bf16_t* sc = wsp<bf16_t>(c, WS_SCORES) + (size_t)tok * PEER_N;
    const float NINF = -3.0e38f;
    for (int gi = 0; gi < 16; ++gi) {
        const unsigned w = *(const unsigned*)(sc + gi * 128 + 2 * lane); float v0 = bflo(w), v1 = bfhi(w); float rv = 0.f; int ri = 0;
        for (int it = 0; it < 16; ++it) {
            const float lm = fmaxf(v0, v1), M = wave_max(lm); const unsigned long long bal = ballot64(lm == M); const int first = __builtin_ctzll(bal);
            const int pick = (v0 == M) ? 0 : 1; const int idx = shfl_i(2 * lane + pick, first);
            if (lane == first) { if (pick == 0) v0 = NINF; else v1 = NINF; }
            if (lane == it) { rv = M; ri = idx; }
        }
        if (lane < 16) { Wv[gi * 16 + lane] = rv; Wi[gi * 16 + lane] = ri; }
    }
    wave_sync();
    for (int h = 0; h < 8; ++h) {
        float cv4[4];
#pragma unroll
        for (int cc = 0; cc < 4; ++cc) cv4[cc] = Wv[(2 * h) * 16 + (lane >> 2)] + Wv[(2 * h + 1) * 16 + (lane & 3) * 4 + cc];
        float cv = NINF; int cp = 0;
        for (int it = 0; it < 16; ++it) {
            const float lm = fmaxf(fmaxf(cv4[0], cv4[1]), fmaxf(cv4[2], cv4[3])), M = wave_max(lm); const unsigned long long bal = ballot64(lm == M); const int first = __builtin_ctzll(bal);
            const int pick = (cv4[0] == M) ? 0 : (cv4[1] == M) ? 1 : (cv4[2] == M) ? 2 : 3; const int pos = shfl_i(lane * 4 + pick, first);
            if (lane == first) { if (pick == 0) cv4[0] = NINF; else if (pick == 1) cv4[1] = NINF; else if (pick == 2) cv4[2] = NINF; else cv4[3] = NINF; }
            if (lane == it) { cv = M; cp = pos; }
        }
        const float mx = shfl_f(cv, 0); float ex = (lane < 16) ? fast_exp(cv - mx) : 0.f; float sm = ex;
        sm += xorf<1>(sm); sm += xorf<2>(sm); sm += xorf<4>(sm); sm += xorf<8>(sm);
        if (lane < 16) { We[h * 16 + lane] = Wi[(2 * h) * 16 + (cp >> 4)] * 128 + Wi[(2 * h + 1) * 16 + (cp & 15)]; Wg[h * 16 + lane] = ex / sm; }
    }
    wave_sync();
    const bf16_t* xb = wsp<bf16_t>(c, WS_XB) + (size_t)tok * DM; const bf16_t* PU = wsp<bf16_t>(c, WS_PU); const bf16_t* PV = wsp<bf16_t>(c, WS_PV);
    const u32x4 x0 = *(const u32x4*)(xb + 8 * lane), x1 = *(const u32x4*)(xb + 512 + 8 * lane);
    const float rstd = pg8::rstd_of(pg8::rss_slots16(wsp<float>(c, WS_RSS2) + (size_t)tok * 16));
    float acc0[8], acc1[8];
#pragma unroll
    for (int j = 0; j < 8; ++j) { acc0[j] = 0.f; acc1[j] = 0.f; }
    for (int h = 0; h < 8; ++h) {
        float dk2[2];
#pragma unroll
        for (int hf = 0; hf < 2; ++hf) {
            float part[8];
#pragma unroll
            for (int k = 0; k < 8; ++k) { const int e = uniform_i(We[h * 16 + hf * 8 + k]); const bf16_t* row = PU + (size_t)e * DM;
                part[k] = dot8(x0, *(const u32x4*)(row + 8 * lane)) + dot8(x1, *(const u32x4*)(row + 512 + 8 * lane)); }
            float p4[4], p2[2], p1;
            { const bool up = (lane & 32) != 0;
#pragma unroll
              for (int i = 0; i < 4; ++i) { const float send = up ? part[i] : part[i + 4]; const float recv = xorf<32>(send); p4[i] = (up ? part[i + 4] : part[i]) + recv; } }
            { const bool up = (lane & 16) != 0;
#pragma unroll
              for (int i = 0; i < 2; ++i) { const float send = up ? p4[i] : p4[i + 2]; const float recv = xorf<16>(send); p2[i] = (up ? p4[i + 2] : p4[i]) + recv; } }
            { const bool up = (lane & 8) != 0; const float send = up ? p2[0] : p2[1]; const float recv = xorf<8>(send); p1 = (up ? p2[1] : p2[0]) + recv; }
            p1 += xorf<4>(p1); p1 += xorf<2>(p1); p1 += xorf<1>(p1);
            dk2[hf] = shfl_f(p1, (lane & 7) * 8);
        }
        const float dk = (lane & 8) ? dk2[1] : dk2[0];
        const float wk = Wg[h * 16 + (lane & 15)] * gelu_erf(dk * rstd);
#pragma unroll 8
        for (int k = 0; k < 16; ++k) { const int e = uniform_i(We[h * 16 + k]); const float w = shfl_f(wk, k); const bf16_t* row = PV + (size_t)e * DM;
            axpy8(acc0, w, *(const u32x4*)(row + 8 * lane)); axpy8(acc1, w, *(const u32x4*)(row + 512 + 8 * lane)); }
    }
    float* orow = c.out + (size_t)tok * DM; float ss = 0.f;
    f32x4 a = *(const f32x4*)(orow + 8 * lane), b = *(const f32x4*)(orow + 8 * lane + 4), d = *(const f32x4*)(orow + 512 + 8 * lane), e2 = *(const f32x4*)(orow + 512 + 8 * lane + 4);
    a += (f32x4){acc0[0], acc0[1], acc0[2], acc0[3]}; b += (f32x4){acc0[4], acc0[5], acc0[6], acc0[7]};
    d += (f32x4){acc1[0], acc1[1], acc1[2], acc1[3]}; e2 += (f32x4){acc1[4], acc1[5], acc1[6], acc1[7]};
    *(f32x4*)(orow + 8 * lane) = a; *(f32x4*)(orow + 8 * lane + 4) = b; *(f32x4*)(orow + 512 + 8 * lane) = d; *(f32x4*)(orow + 512 + 8 * lane + 4) = e2;
    if (l + 1 < DEPTH) {
        bf16_t* xo = wsp<bf16_t>(c, WS_XB) + (size_t)tok * DM;
        u32x4 w0, w1; w0.x = pk2(a[0], a[1]); w0.y = pk2(a[2], a[3]); w0.z = pk2(b[0], b[1]); w0.w = pk2(b[2], b[3]);
        w1.x = pk2(d[0], d[1]); w1.y = pk2(d[2], d[3]); w1.z = pk2(e2[0], e2[1]); w1.w = pk2(e2[2], e2[3]);
        *(u32x4*)(xo + 8 * lane) = w0; *(u32x4*)(xo + 512 + 8 * lane) = w1;
#pragma unroll
        for (int j = 0; j < 4; ++j) ss += a[j] * a[j] + b[j] * b[j] + d[j] * d[j] + e2[j] * e2[j];
        ss = wave_sum(ss);
        if (lane == 0) wsp<float>(c, WS_RSS1)[tok] = ss;
    }
    wave_sync();
}
DEV void peer_table_rows(const Ctx& c, int l) {
    const float* g2 = CIN(17) + (size_t)l * DM;
    for (int r = c.bid * NWAVE + c.wave; r < 2 * 16384; r += c.nblk * NWAVE) {
        const int tab = r >> 14, e = r & 16383;
        const float* src = (tab == 0 ? CIN(20) : CIN(21)) + ((size_t)l * 16384 + e) * DM; bf16_t* dst = wsp<bf16_t>(c, tab == 0 ? WS_PU : WS_PV) + (size_t)e * DM;
#pragma unroll
        for (int j = 0; j < 4; ++j) { f32x4 v = *((const f32x4*)src + 64 * j + c.lane);
            if (tab == 0) v *= *((const f32x4*)g2 + 64 * j + c.lane);
            u32x2 w; w.x = pk2(v[0], v[1]); w.y = pk2(v[2], v[3]); *((u32x2*)dst + 64 * j + c.lane) = w; }
    }
}
#ifndef HOST_EMU
#define GRID_SYNC() cg::this_grid().sync()
#else
#define GRID_SYNC() grid_sync_impl()
#endif

DEV Ctx make_ctx(const Params& p, int wave0) {
#ifndef HOST_EMU
    Ctx c; c.out = p.out; c.ws = p.ws; c.tid = wave0 * 64 + fresh_lane();
#else
    Ctx c; c.out = p.out; c.ws = p.ws; c.tid = TID();
#endif
    c.bid = BID(); c.nblk = NBLK(); int z = 0;
#ifndef HOST_EMU
    asm volatile("" : "+s"(c.out), "+s"(c.ws), "+v"(c.tid), "+s"(c.bid), "+s"(c.nblk));
    asm volatile("s_mov_b32 %0, 0" : "=s"(z));
#endif
    c.lds = SMEM_PTR() + z; c.lane = c.tid & 63; c.wave = c.tid >> 6;
#ifndef HOST_EMU
    c.wave = __builtin_amdgcn_readfirstlane(c.wave);
#endif
    return c;
}
#ifndef HOST_EMU
__global__ void __launch_bounds__(NTHR, 2) fwd_kernel(Params p)
#else
void fwd_kernel(Params p)
#endif
{
    {
        char* lds0 = SMEM_PTR();
        if (TID() == 0) {
#pragma unroll
            for (int i = 0; i < 22; ++i) ((const float**)(lds0 + LDS_PTRS))[i] = p.in[i];
        }
        block_sync();
    }
#ifndef HOST_EMU
    const int wave0 = __builtin_amdgcn_readfirstlane((int)threadIdx.x >> 6);
#else
    const int wave0 = 0;
#endif
    int ph = 0;
#define PHASE_END() do { ++ph; if (ph >= p.phase_hi) return; GRID_SYNC(); } while (0)
    for (int l = 0; l < DEPTH; ++l) {
        { Ctx c = make_ctx(p, wave0); p0_prep(c, l); }
        PHASE_END();
        {
            Ctx c = make_ctx(p, wave0);
            pg8::Gemm g{wsp<bf16_t>(c, WS_XB), wsp<bf16_t>(c, WS_WIN), NT, PROJ_N, DM}; pg8::StaticOrder S; S.init(NT, PROJ_N, c.nblk, c.bid);
            pg8::EpiScaleBf16<1> E{wsp<bf16_t>(c, WS_PROJ), PROJ_LD, wsp<float>(c, WS_RSS1), PROJ_LD};
            pg8::gemm_phase<pg8::EpiScaleBf16<1>, pg8::StaticOrder, true, true>(GEMM_LDS, g, S, E, c.tid);
        }
        PHASE_END();
        { Ctx c = make_ctx(p, wave0); for (int u = c.bid; u < 3 * BATCH * NH * NC; u += c.nblk) recur_local_unit(c, l, u); }
        { Ctx c = make_ctx(p, wave0); for (int u = c.bid; u < BATCH * 8; u += c.nblk) nsa_compress_unit(c, l, u); }
        { Ctx c = make_ctx(p, wave0); for (int it = c.bid; it < NT / 4; it += c.nblk) nsa_kprep_item(c, l, it); }
        PHASE_END();
        { Ctx c = make_ctx(p, wave0); recur_scan(c); }
        PHASE_END();
        { Ctx c = make_ctx(p, wave0);
        for (int u = c.bid; u < BATCH * 2 * NSEL; u += c.nblk) {
            const int nbg = BATCH * 2, bg = u % nbg, qi = u / nbg; int qt = qi;
            if (NSEL == 64) { const int r = qi >> 4, ql = qi & 15; qt = (r == 0) ? 63 - ql : (r == 1) ? ql : (r == 2) ? 47 - ql : 16 + ql; }
            nsa_attn_unit(c, l, bg * NSEL + qt);
        } }
        { Ctx c = make_ctx(p, wave0); for (int u = c.bid; u < 3 * BATCH * NH * NC; u += c.nblk) recur_out_unit(c, l, u); }
        PHASE_END();
        { Ctx c = make_ctx(p, wave0); peer_table_rows(c, l); }
        {
            for (int m = 0; m < 4; ++m) {
                { Ctx c = make_ctx(p, wave0); pg8::TileOrder S{(NT / 256) * 4, c.nblk, c.bid}; pg8::Gemm g{wsp<bf16_t>(c, WS_OUTS) + (size_t)m * NT * MW, wsp<bf16_t>(c, WS_WUP) + (size_t)m * DM * MW, NT, DM, MW};
                  pg8::EpiU E{wsp<bf16_t>(c, WS_USCR)};
                  pg8::gemm_phase<pg8::EpiU, pg8::TileOrder, false, true>(GEMM_LDS, g, S, E, c.tid); }
                { Ctx c = make_ctx(p, wave0); pg8::TileOrder S{(NT / 256) * 4, c.nblk, c.bid}; pg8::Gemm g{wsp<bf16_t>(c, WS_XB), wsp<bf16_t>(c, WS_WG) + (size_t)m * DM * DM, NT, DM, DM};
                  pg8::EpiGate E{wsp<bf16_t>(c, WS_USCR), wsp<bf16_t>(c, WS_MERGED), wsp<float>(c, WS_RSS1), m == 0 ? 1 : 0};
                  pg8::gemm_phase<pg8::EpiGate, pg8::TileOrder, false, true>(GEMM_LDS, g, S, E, c.tid); }
            }
        }
        PHASE_END();
        {
            Ctx c = make_ctx(p, wave0); const float* xres = (l == 0) ? CIN(0) : c.out;
            pg8::Gemm g{wsp<bf16_t>(c, WS_MERGED), wsp<bf16_t>(c, WS_WOUT), NT, DM, DM}; pg8::StaticOrder S; S.init(NT, DM, c.nblk, c.bid);
            pg8::EpiOut E{xres, c.out, wsp<bf16_t>(c, WS_XB), wsp<float>(c, WS_RSS2)};
            pg8::gemm_phase<pg8::EpiOut, pg8::StaticOrder, true, true>(GEMM_LDS, g, S, E, c.tid);
        }
        PHASE_END();
        {
            Ctx c = make_ctx(p, wave0);
            pg8::Gemm g{wsp<bf16_t>(c, WS_XB), wsp<bf16_t>(c, WS_WQ2), NT, PEER_N, DM}; pg8::StaticOrder S; S.init(NT, PEER_N, c.nblk, c.bid);
            pg8::EpiScaleBf16<16> E{wsp<bf16_t>(c, WS_SCORES), PEER_N, wsp<float>(c, WS_RSS2), PEER_N};
            pg8::gemm_phase<pg8::EpiScaleBf16<16>, pg8::StaticOrder, true, true>(GEMM_LDS, g, S, E, c.tid);
        }
        PHASE_END();
        { Ctx c = make_ctx(p, wave0); for (int t = c.bid * NWAVE + c.wave; t < NT; t += c.nblk * NWAVE) peer_token(c, l, t); }
        PHASE_END();
    }
}

#ifndef HOST_EMU
extern "C" void kernel_launch(void* const* d_in, const int* in_sizes, int n_in, void* d_out, int out_size, void* d_ws, size_t ws_size, hipStream_t stream) {
    static int grid = 0;
    if (grid == 0) {
        if (n_in != 22 || out_size != NT * DM || ws_size < WS_NEED) { fprintf(stderr, "kernel_launch: unexpected shapes (n_in %d out %d ws %zu need %zu)\n", n_in, out_size, ws_size, (size_t)WS_NEED); grid = -1; return; }
        int dev = 0, cus = 0, per_cu = 0;
        hipGetDevice(&dev); hipDeviceGetAttribute(&cus, hipDeviceAttributeMultiprocessorCount, dev);
        if (hipFuncSetAttribute((const void*)fwd_kernel, hipFuncAttributeMaxDynamicSharedMemorySize, LDS_BYTES) != hipSuccess) { fprintf(stderr, "kernel_launch: hipFuncSetAttribute failed\n"); grid = -1; return; }
        if (hipOccupancyMaxActiveBlocksPerMultiprocessor(&per_cu, (const void*)fwd_kernel, NTHR, LDS_BYTES) != hipSuccess || per_cu < 1) { fprintf(stderr, "kernel_launch: occupancy query failed (%d)\n", per_cu); (void)hipGetLastError(); per_cu = 1; }
        grid = cus;
        fprintf(stderr, "kernel_launch: grid %d (per_cu %d)\n", grid, per_cu);
    }
    if (grid < 0) return;
    Params p{};
    for (int i = 0; i < 22; ++i) p.in[i] = (const float*)d_in[i];
    p.out = (float*)d_out; p.ws = (unsigned char*)d_ws; p.phase_lo = 0; p.phase_hi = 1 << 20;
    void* args[] = {&p};
    hipError_t e = hipLaunchCooperativeKernel((const void*)fwd_kernel, dim3(grid), dim3(NTHR), args, LDS_BYTES, stream);
    if (e != hipSuccess) fprintf(stderr, "kernel_launch: cooperative launch failed: %s (grid %d)\n", hipGetErrorString(e), grid);
}
#endif
```

```cpp
#ifndef HOST_EMU
#include <hip/hip_runtime.h>
#include <hip/hip_cooperative_groups.h>
#include <cstdio>
#include <cstdint>
namespace cg = cooperative_groups;
#endif

#ifndef CFG_B
#define CFG_B 8
#endif
#ifndef CFG_S
#define CFG_S 4096
#endif

constexpr int BATCH = CFG_B, SEQ = CFG_S, DM = 1024, DEPTH = 2;
constexpr int NT = BATCH * SEQ;
constexpr int NH = 4, HD = 64, MW = 256, CH = 64, NC = SEQ / CH;
constexpr int N_IN_ORIG = 4116, PROJ_N = 4352, PROJ_LD = 4128;
constexpr int NCMP = (SEQ - 32) / 16 + 1;
constexpr int NCMP_PAD = SEQ / 16;
constexpr int NSEL = SEQ / 64;
constexpr int PEER_N = 2048;
constexpr float NORM_EPS = 1e-6f;
constexpr int NTHR = 512, NWAVE = 8;
constexpr int C_HQ = 0, C_HF = 256, C_HI = 512, C_HG = 768;
constexpr int C_MQ = 1024, C_MK = 1280, C_MV = 1536, C_MO = 1792;
constexpr int C_NQ = 2048, C_NKC = 2304, C_NVC = 2432, C_NKS = 2560, C_NVS = 2688, C_NKW = 2816, C_NVW = 2944;
constexpr int C_RQ = 3072, C_RK = 3328, C_RV = 3584, C_RG = 3840;
constexpr int C_MI = 4096, C_MF = 4100, C_NG = 4104;

typedef unsigned short bf16_t;
#ifndef HOST_EMU
typedef short bf16x8 __attribute__((ext_vector_type(8)));
typedef float f32x4 __attribute__((ext_vector_type(4)));
#endif
typedef unsigned u32x4 __attribute__((ext_vector_type(4)));
typedef unsigned u32x2 __attribute__((ext_vector_type(2)));
typedef float f32x2 __attribute__((ext_vector_type(2)));

constexpr size_t al256(size_t x) { return (x + 255) & ~(size_t)255; }
constexpr size_t WS_WIN = 0;
constexpr size_t WS_WG = WS_WIN + al256((size_t)PROJ_N * DM * 2);
constexpr size_t WS_WUP = WS_WG + al256((size_t)4 * DM * DM * 2);
constexpr size_t WS_WOUT = WS_WUP + al256((size_t)4 * DM * MW * 2);
constexpr size_t WS_WQ2 = WS_WOUT + al256((size_t)DM * DM * 2);
constexpr size_t WS_WCT = WS_WQ2 + al256((size_t)PEER_N * DM * 2);
constexpr size_t WS_CBIAS = WS_WCT + al256((size_t)2 * 64 * 2048 * 2);
constexpr size_t WS_ROPE = WS_CBIAS + 1024;
constexpr size_t WS_RSS1 = WS_ROPE + al256((size_t)SEQ * 64 * 4);
constexpr size_t WS_RSS2 = WS_RSS1 + al256((size_t)NT * 4);
constexpr size_t WS_XB = WS_RSS2 + al256((size_t)NT * 16 * 4);
constexpr size_t WS_OUTS = WS_XB + al256((size_t)NT * DM * 2);
constexpr size_t WS_ST = WS_OUTS + al256((size_t)NT * DM * 2);
constexpr size_t ST_ONE = (size_t)BATCH * NH * NC * 4096 * 2;
constexpr size_t WS_GDEC = WS_ST + al256(3 * ST_ONE);
constexpr size_t WS_MNL = WS_GDEC + al256((size_t)BATCH * NH * NC * 64 * 4);
constexpr size_t WS_MSC = WS_MNL + al256((size_t)BATCH * NH * NC * 64 * 4);
constexpr size_t WS_KCMP = WS_MSC + al256((size_t)BATCH * NH * NC * 4 * 4);
constexpr size_t WS_VCMPT = WS_KCMP + al256((size_t)BATCH * 2 * NCMP_PAD * 64 * 2);
constexpr size_t WS_KSW = WS_VCMPT + al256((size_t)BATCH * 2 * NCMP_PAD * 64 * 2);
constexpr size_t WS_PROJ = WS_KSW + al256((size_t)NT * 256 * 2);
constexpr size_t PROJ_BYTES = al256((size_t)NT * PROJ_LD * 2);
constexpr size_t WS_BARRIER = WS_PROJ + PROJ_BYTES;
constexpr size_t WS_END = WS_BARRIER + 16384;
constexpr size_t WS_MERGED = WS_PROJ;
constexpr size_t WS_USCR = WS_MERGED + al256((size_t)NT * DM * 2);
constexpr size_t WS_SCORES = WS_PROJ;
constexpr size_t WS_PU = WS_USCR + al256((size_t)NT * DM * 2);
constexpr size_t WS_PV = WS_PU + al256((size_t)16384 * DM);
static_assert(WS_PV + (size_t)16384 * DM <= WS_BARRIER || CFG_B < 8, "overlay fits the proj region");
static_assert(WS_END <= (size_t)536870912, "workspace budget");
constexpr size_t WS_NEED = (WS_PV + (size_t)16384 * DM > WS_END) ? (WS_PV + (size_t)16384 * DM) : WS_END;

constexpr int LDS_BYTES = 147456;

struct Params {
    const float* in[22];
    float* out;
    unsigned char* ws;
    int phase_lo, phase_hi;
};

#ifndef HOST_EMU
#define DEV __device__ __forceinline__
#define TID() ((int)threadIdx.x)
#define BID() ((int)blockIdx.x)
#define NBLK() ((int)gridDim.x)
extern __shared__ __attribute__((aligned(16))) unsigned char smem_raw[];
#define LDSP __attribute__((address_space(3)))
#define SMEM_PTR() ((LDSP char*)smem_raw)
DEV void block_sync() { __syncthreads(); }
DEV int fresh_lane() { int lane; asm volatile("v_mbcnt_lo_u32_b32 %0, -1, 0\n\tv_mbcnt_hi_u32_b32 %0, -1, %0" : "=v"(lane)); return lane; }
template <int M> DEV int xori(int v) {
    if constexpr (M < 32) return __builtin_amdgcn_ds_swizzle(v, (M << 10) | 0x1f);
    else return __builtin_amdgcn_ds_bpermute((fresh_lane() ^ M) << 2, v);
}
template <int M> DEV float xorf(float v) { return __builtin_bit_cast(float, xori<M>(__builtin_bit_cast(int, v))); }
DEV int shfl_i(int v, int src) { return __builtin_amdgcn_ds_bpermute(src << 2, v); }
DEV float shfl_f(float v, int src) { return __builtin_bit_cast(float, __builtin_amdgcn_ds_bpermute(src << 2, __builtin_bit_cast(int, v))); }
DEV unsigned long long ballot64(bool p) { return __builtin_amdgcn_ballot_w64(p); }
DEV int mbcnt64(unsigned long long m) { return (int)__builtin_amdgcn_mbcnt_hi((unsigned)(m >> 32), __builtin_amdgcn_mbcnt_lo((unsigned)m, 0u)); }
DEV float bcast_f(float v, int j) { return __builtin_bit_cast(float, __builtin_amdgcn_readlane(__builtin_bit_cast(int, v), j)); }
DEV int bcast_i(int v, int j) { return __builtin_amdgcn_readlane(v, j); }
DEV f32x2 cvt_pk_f32_fp8(unsigned p, bool hi) { return hi ? __builtin_amdgcn_cvt_pk_f32_fp8((int)p, true) : __builtin_amdgcn_cvt_pk_f32_fp8((int)p, false); }
DEV unsigned cvt_pk_fp8_f32(float a, float b, unsigned old, bool hi) { return hi ? (unsigned)__builtin_amdgcn_cvt_pk_fp8_f32(a, b, (int)old, true) : (unsigned)__builtin_amdgcn_cvt_pk_fp8_f32(a, b, (int)old, false); }
DEV f32x4 mfma16(bf16x8 a, bf16x8 b, f32x4 c) { return __builtin_amdgcn_mfma_f32_16x16x32_bf16(a, b, c, 0, 0, 0); }
DEV void atomic_add_f32(float* p, float v) { atomicAdd(p, v); }
DEV float fast_exp(float x) { return __expf(x); }
DEV float fast_exp2(float x) { return __builtin_amdgcn_exp2f(x); }
DEV float fast_log(float x) { return __logf(x); }
DEV float fast_rcp(float x) { return __builtin_amdgcn_rcpf(x); }
DEV float fast_rsqrt(float x) { return __builtin_amdgcn_rsqf(x); }
#else
#define DEV static inline
#define LDSP
#endif

DEV float bf2f(bf16_t v) { unsigned u = ((unsigned)v) << 16; return __builtin_bit_cast(float, u); }
DEV bf16_t f2bf(float f) { unsigned u = __builtin_bit_cast(unsigned, f); return (bf16_t)((u + 0x7fffu + ((u >> 16) & 1u)) >> 16); }
DEV unsigned pk2(float lo, float hi) { return (unsigned)f2bf(lo) | ((unsigned)f2bf(hi) << 16); }
DEV float bflo(unsigned u) { return __builtin_bit_cast(float, u << 16); }
DEV float bfhi(unsigned u) { return __builtin_bit_cast(float, u & 0xffff0000u); }
DEV float sigmoidf_(float x) { return fast_rcp(1.0f + fast_exp(-x)); }
DEV float siluf_(float x) { return x * sigmoidf_(x); }
DEV float log_sigmoidf_(float x) { return fminf(x, 0.f) - log1pf(fast_exp(-fabsf(x))); }
DEV float wave_sum(float v) { v += xorf<1>(v); v += xorf<2>(v); v += xorf<4>(v); v += xorf<8>(v); v += xorf<16>(v); v += xorf<32>(v); return v; }
DEV float wave_max(float v) { v = fmaxf(v, xorf<1>(v)); v = fmaxf(v, xorf<2>(v)); v = fmaxf(v, xorf<4>(v)); v = fmaxf(v, xorf<8>(v)); v = fmaxf(v, xorf<16>(v)); v = fmaxf(v, xorf<32>(v)); return v; }
DEV float gelu_erf(float v) {
    const float av = fabsf(v), t = fast_rcp(1.0f + 0.2316418882f * av);
    float q = t * 0.5307027145f + (-0.7265760135f); q = q * t + 0.7107068705f; q = q * t + (-0.142248368f); q = q * t + 0.127414796f; q = q * t;
    const float e = fast_exp2(v * v * (-0.72134752044f));
    const float m = v * (q * e);
    return v < 0.f ? m : v - m;
}
#ifndef HOST_EMU
#define DEV_M __device__ __forceinline__
#else
#define DEV_M inline
#endif
namespace pg8 {
#define PG8_LAS __attribute__((address_space(3)))
constexpr int BM = 256, BK = 64, HALF = 128, HTB = HALF * BK * 2  , STAGE_BYTES = 8 * HTB, NXCD = 8, WGM = 8;

__host__ __device__ __forceinline__ int lds_byte(int r, int c) { const int st = (r >> 4) * 2 + (c >> 5), rr = r & 15, cc = c & 31, ob = rr * 64 + cc * 2; return st * 1024 + (ob ^ (((ob >> 9) & 1) << 5)); }
__host__ __device__ __forceinline__ void stage_rc(int b, int& R, int& C) { const int st = b / 1024, sb = b % 1024, swz = sb ^ (((sb >> 9) & 1) << 5); R = (st >> 1) * 16 + swz / 64; C = (st & 1) * 32 + (swz % 64) / 2; }
__host__ __device__ __forceinline__ int perm32(int rho) { const int n = rho >> 4, i = rho & 15; return 8 * (i >> 2) + 4 * n + (i & 3); }

struct Unit { int pm, pn; };
struct Gemm { const bf16_t* A; const bf16_t* Bt; int M, N, K; };

struct StaticOrder {
    int nM, nN, nwg, G, c;
    __host__ __device__ void init(int M, int N, int G_, int c_) { nM = M / BM; nN = N / BM; nwg = nM * nN; G = G_; c = c_; }
    __host__ __device__ bool next(int i, Unit& u) const {
        const long L = (long)i * G + c; if (L >= nwg) return false;
        int wgid = (int)L; { const int q = nwg / NXCD, r = nwg % NXCD, xcd = wgid % NXCD, off = wgid / NXCD; wgid = (xcd < r ? xcd * (q + 1) : r * (q + 1) + (xcd - r) * q) + off; }
        const int nig = WGM * nN, gid = wgid / nig, fm = gid * WGM, gsz = (nM - fm) < WGM ? (nM - fm) : WGM;
        u.pm = fm + ((wgid % nig) % gsz); u.pn = (wgid % nig) / gsz; return true;
    }
    DEV_M void a_ready(const Unit&) const {}
    DEV_M void done(const Unit&) const {}
};


#ifndef HOST_EMU
template <class Epi, class Sched, bool ALIGN_EPI = false, bool SP2 = false>
__device__ __forceinline__ void gemm_phase(PG8_LAS unsigned char* lds, const Gemm g, const Sched& S, const Epi& E, const int tid_in) {
    const int tid = tid_in, wid = __builtin_amdgcn_readfirstlane(tid >> 6), lane = tid & 63, wr = wid >> 2, wc = wid & 3, fr = lane & 15, fq = lane >> 4;
    const int K = g.K, nt = K / BK;
    unsigned voffA[2], voffB[2];
#pragma unroll
    for (int i = 0; i < 2; ++i) { int R, C; stage_rc(tid * 16 + i * 8192, R, C); const int Rb = Epi::PERM ? ((R & ~31) + perm32(R & 31)) : R;
        voffA[i] = (unsigned)(R * K + C) * 2u; voffB[i] = (unsigned)(Rb * K + C) * 2u; }
    const size_t kstep = (size_t)(BK * 2);
    const size_t hstep = (size_t)HALF * K * 2;
    const size_t tstep = 2 * hstep;
    const unsigned ldsw = (unsigned)wid * 1024u;
    const int aoff = lds_byte(wr * 64 + fr, fq * 8), boff = lds_byte(wc * 32 + fr, fq * 8);
#define PG8_SA(b, h) (((b) * 2 + (h)) * HTB)
#define PG8_SB(b, h) ((4 + (b) * 2 + (h)) * HTB)
#define PG8_STAGE(bufoff, gbase, voff) do { _Pragma("unroll") for (int _i = 0; _i < 2; ++_i) \
        __builtin_amdgcn_global_load_lds((const unsigned*)((const char*)(gbase) + (voff)[_i]), (PG8_LAS unsigned*)(lds + (bufoff) + ldsw + _i * 8192), 16, 0, 0); } while (0)
#define PG8_LDA(dst, b, h) do { _Pragma("unroll") for (int m = 0; m < 4; ++m) _Pragma("unroll") for (int k = 0; k < 2; ++k) dst[m][k] = *(const PG8_LAS bf16x8*)(lds + PG8_SA(b, h) + aoff + m * 2048 + k * 1024); } while (0)
#define PG8_LDB(dst, b, h) do { _Pragma("unroll") for (int n = 0; n < 2; ++n) _Pragma("unroll") for (int k = 0; k < 2; ++k) dst[n][k] = *(const PG8_LAS bf16x8*)(lds + PG8_SB(b, h) + boff + n * 2048 + k * 1024); } while (0)
#define PG8_MMA(ai, bj, At, Bt) do { __builtin_amdgcn_s_setprio(1); _Pragma("unroll") for (int m = 0; m < 4; ++m) _Pragma("unroll") for (int n = 0; n < 2; ++n) _Pragma("unroll") for (int k = 0; k < 2; ++k) \
        acc[ai][bj][m][n] = __builtin_amdgcn_mfma_f32_16x16x32_bf16(Bt[n][k], At[m][k], acc[ai][bj][m][n], 0, 0, 0); __builtin_amdgcn_s_setprio(0); } while (0)
#define PG8_WAIT_V(n) asm volatile("s_waitcnt vmcnt(" #n ")" ::: "memory")
#define PG8_WAIT_L(n) asm volatile("s_waitcnt lgkmcnt(" #n ")" ::: "memory")
#define PG8_BAR __builtin_amdgcn_s_barrier()
#define PG8_SCHED __builtin_amdgcn_sched_barrier(0)
    Unit cur, nxt; int ui = 0;
    if (!S.next(0, cur)) return;
    f32x4 acc[2][2][4][2];
#pragma unroll
    for (int a = 0; a < 2; ++a)
#pragma unroll
        for (int b = 0; b < 2; ++b)
#pragma unroll
            for (int m = 0; m < 4; ++m)
#pragma unroll
                for (int n = 0; n < 2; ++n) acc[a][b][m][n] = (f32x4){0.f, 0.f, 0.f, 0.f};
    bf16x8 At[4][2], B0[2][2], B1[2][2];
    const char* cA = (const char*)g.A + (size_t)cur.pm * tstep; const char* cB = (const char*)g.Bt + (size_t)cur.pn * tstep;
    S.a_ready(cur);
    if constexpr (SP2) {
        PG8_STAGE(PG8_SB(0, 0), cB, voffB); PG8_STAGE(PG8_SB(0, 1), cB + hstep, voffB); PG8_STAGE(PG8_SA(0, 0), cA, voffA); PG8_STAGE(PG8_SA(0, 1), cA + hstep, voffA);
        if (wr == 1) PG8_BAR;
        PG8_WAIT_V(2); PG8_BAR;
        PG8_STAGE(PG8_SB(1, 0), cB + kstep, voffB); PG8_STAGE(PG8_SA(1, 0), cA + kstep, voffA); PG8_STAGE(PG8_SB(1, 1), cB + hstep + kstep, voffB);
        PG8_WAIT_V(6); PG8_BAR;
    } else {
        PG8_STAGE(PG8_SB(0, 0), cB, voffB); PG8_STAGE(PG8_SA(0, 0), cA, voffA); PG8_STAGE(PG8_SB(0, 1), cB + hstep, voffB); PG8_STAGE(PG8_SA(0, 1), cA + hstep, voffA);
        if (wr == 1) PG8_BAR;
        PG8_WAIT_V(4); PG8_BAR;
        PG8_STAGE(PG8_SB(1, 0), cB + kstep, voffB); PG8_STAGE(PG8_SA(1, 0), cA + kstep, voffA); PG8_STAGE(PG8_SB(1, 1), cB + hstep + kstep, voffB);
        PG8_WAIT_V(6); PG8_BAR;
    }
    for (;;) {
        const bool has_next = S.next(ui + 1, nxt);
        const char* nA = has_next ? (const char*)g.A + (size_t)nxt.pm * tstep : cA; const char* nB = has_next ? (const char*)g.Bt + (size_t)nxt.pn * tstep : cB;
        for (int t = 0; t < nt; t += 2) {
            const bool last = (t == nt - 2);
            const char* a1 = cA + (size_t)(t + 1) * kstep;
            const char* a2 = last ? nA : cA + (size_t)(t + 2) * kstep; const char* b2 = last ? nB : cB + (size_t)(t + 2) * kstep;
            const char* a3 = a2 + kstep; const char* b3 = b2 + kstep;
            if (last && has_next) S.a_ready(nxt);
            if constexpr (SP2) {
            PG8_LDB(B0, 0, 0); PG8_LDB(B1, 0, 1); PG8_SCHED; PG8_LDA(At, 0, 0); PG8_STAGE(PG8_SA(1, 1), a1 + hstep, voffA);
            PG8_WAIT_V(8); PG8_WAIT_L(0); PG8_BAR; PG8_MMA(0, 0, At, B0); PG8_MMA(0, 1, At, B1); PG8_BAR; PG8_SCHED;
            PG8_LDA(At, 0, 1); PG8_STAGE(PG8_SB(0, 0), b2, voffB); PG8_STAGE(PG8_SB(0, 1), b2 + hstep, voffB); PG8_STAGE(PG8_SA(0, 0), a2, voffA);
            PG8_WAIT_V(8); PG8_WAIT_L(0); PG8_BAR; PG8_MMA(1, 0, At, B0); PG8_MMA(1, 1, At, B1); PG8_BAR; PG8_SCHED;
            PG8_LDB(B0, 1, 0); PG8_LDB(B1, 1, 1); PG8_SCHED; PG8_LDA(At, 1, 0); PG8_STAGE(PG8_SA(0, 1), a2 + hstep, voffA);
            PG8_WAIT_V(8); PG8_WAIT_L(0); PG8_BAR; PG8_MMA(0, 0, At, B0); PG8_MMA(0, 1, At, B1); PG8_BAR; PG8_SCHED;
            PG8_LDA(At, 1, 1); PG8_STAGE(PG8_SB(1, 0), b3, voffB); PG8_STAGE(PG8_SB(1, 1), b3 + hstep, voffB); PG8_STAGE(PG8_SA(1, 0), a3, voffA);
            PG8_WAIT_V(8); PG8_WAIT_L(0); PG8_BAR; PG8_MMA(1, 0, At, B0); PG8_MMA(1, 1, At, B1); PG8_BAR; PG8_SCHED;
            } else {
            PG8_LDB(B0, 0, 0); PG8_SCHED; PG8_LDA(At, 0, 0); PG8_STAGE(PG8_SA(1, 1), a1 + hstep, voffA);
            PG8_WAIT_L(8); PG8_BAR; PG8_WAIT_L(0); PG8_MMA(0, 0, At, B0); PG8_BAR; PG8_SCHED;
            PG8_LDB(B1, 0, 1); PG8_STAGE(PG8_SB(0, 0), b2, voffB);
            PG8_BAR; PG8_WAIT_L(0); PG8_MMA(0, 1, At, B1); PG8_BAR;
            PG8_LDA(At, 0, 1); PG8_STAGE(PG8_SA(0, 0), a2, voffA);
            PG8_BAR; PG8_WAIT_L(0); PG8_MMA(1, 0, At, B0); PG8_BAR; PG8_SCHED;
            PG8_STAGE(PG8_SB(0, 1), b2 + hstep, voffB);
            PG8_WAIT_V(6); PG8_BAR; PG8_MMA(1, 1, At, B1); PG8_BAR;
            PG8_LDB(B0, 1, 0); PG8_SCHED; PG8_LDA(At, 1, 0); PG8_STAGE(PG8_SA(0, 1), a2 + hstep, voffA);
            PG8_WAIT_L(8); PG8_BAR; PG8_WAIT_L(0); PG8_MMA(0, 0, At, B0); PG8_BAR; PG8_SCHED;
            PG8_LDB(B1, 1, 1); PG8_STAGE(PG8_SB(1, 0), b3, voffB);
            PG8_BAR; PG8_WAIT_L(0); PG8_MMA(0, 1, At, B1); PG8_BAR;
            PG8_LDA(At, 1, 1); PG8_STAGE(PG8_SA(1, 0), a3, voffA);
            PG8_BAR; PG8_WAIT_L(0); PG8_MMA(1, 0, At, B0); PG8_BAR; PG8_SCHED;
            PG8_STAGE(PG8_SB(1, 1), b3 + hstep, voffB);
            PG8_WAIT_V(6); PG8_BAR; PG8_MMA(1, 1, At, B1); PG8_BAR;
            }
        }
        if constexpr (ALIGN_EPI) { if (wr == 0) PG8_BAR; }
        if constexpr (!Epi::AFTER_DRAIN) { E(acc, cur, wr, wc, fr, fq); S.done(cur); }
        if (!has_next) break;
#pragma unroll
        for (int a = 0; a < 2; ++a)
#pragma unroll
            for (int b = 0; b < 2; ++b)
#pragma unroll
                for (int m = 0; m < 4; ++m)
#pragma unroll
                    for (int n = 0; n < 2; ++n) acc[a][b][m][n] = (f32x4){0.f, 0.f, 0.f, 0.f};
        cur = nxt; cA = nA; cB = nB; ++ui;
        if constexpr (ALIGN_EPI) { if (wr == 1) PG8_BAR; }
    }
    PG8_WAIT_V(0);
    if constexpr (!ALIGN_EPI) { if (wr == 0) PG8_BAR; }
    PG8_BAR;
    if constexpr (Epi::AFTER_DRAIN) { E.fused(acc, cur, wr, wc, fr, fq, lds, wid, lane); S.done(cur); }
#undef PG8_SA
#undef PG8_SB
#undef PG8_STAGE
#undef PG8_LDA
#undef PG8_LDB
#undef PG8_MMA
#undef PG8_WAIT_V
#undef PG8_WAIT_L
#undef PG8_BAR
#undef PG8_SCHED
}
#else
template <class Epi, class Sched, bool ALIGN_EPI = false, bool SP2 = false>
inline void gemm_phase(void* lds, const Gemm g, const Sched& S, const Epi& E, const int tid_in) {
    const int tid = TID(), wid = tid >> 6, lane = tid & 63, wr = wid >> 2, wc = wid & 3, fr = lane & 15, fq = lane >> 4;
    Unit u;
    for (int ui = 0; S.next(ui, u); ++ui) {
        f32x4 acc[2][2][4][2];
        for (int ai = 0; ai < 2; ++ai) for (int bj = 0; bj < 2; ++bj) for (int m = 0; m < 4; ++m) for (int n = 0; n < 2; ++n) for (int j = 0; j < 4; ++j) {
            const int r = 256 * u.pm + 128 * ai + 64 * wr + 16 * m + fr;
            const int c = 256 * u.pn + 128 * bj + 32 * wc + (Epi::PERM ? (8 * fq + 4 * n + j) : (16 * n + 4 * fq + j));
            const bf16_t* a = g.A + (size_t)r * g.K; const bf16_t* b = g.Bt + (size_t)c * g.K;
            float s = 0.f; for (int k = 0; k < g.K; ++k) s += bf2f(a[k]) * bf2f(b[k]);
            acc[ai][bj][m][n][j] = s;
        }
        E(acc, u, wr, wc, fr, fq);
    }
    block_sync();
}
#endif
#ifndef HOST_EMU
#define EPI_LAUNDER(wr, wc, fr, fq) asm volatile("" : "+s"(wr), "+s"(wc), "+v"(fr), "+v"(fq))
#else
#define EPI_LAUNDER(wr, wc, fr, fq) do {} while (0)
#endif
DEV_M float rstd_of(float ss) { return fast_rsqrt(ss * (1.0f / 1024.0f) + NORM_EPS); }

DEV_M float rss_slots16(const float* p) {
    const f32x4 a = *(const f32x4*)p, b = *(const f32x4*)(p + 4), c = *(const f32x4*)(p + 8), d = *(const f32x4*)(p + 12);
    return (((a[0] + a[1]) + (a[2] + a[3])) + ((b[0] + b[1]) + (b[2] + b[3]))) + (((c[0] + c[1]) + (c[2] + c[3])) + ((d[0] + d[1]) + (d[2] + d[3])));
}
template <int SLOTS> struct EpiScaleBf16 {
    static constexpr bool PERM = true, AFTER_DRAIN = false;
    bf16_t* O; int ldc; const float* rss; int ncols;
    DEV_M void operator()(const f32x4 (&acc)[2][2][4][2], const Unit& u, int wr, int wc, int fr, int fq) const {
        EPI_LAUNDER(wr, wc, fr, fq);
        const int row0 = u.pm * BM + wr * 64 + fr, col0 = u.pn * BM + wc * 32 + 8 * fq;
#pragma unroll
        for (int ai = 0; ai < 2; ++ai)
#pragma unroll
            for (int m = 0; m < 4; ++m) {
                const int row = row0 + ai * HALF + m * 16; const float sc = rstd_of(SLOTS == 1 ? rss[row] : rss_slots16(rss + (size_t)row * 16));
                bf16_t* rowp = O + (size_t)row * ldc + col0;
#pragma unroll
                for (int bj = 0; bj < 2; ++bj) {
                    if (col0 + bj * HALF < ncols) {
                        const f32x4 v0 = acc[ai][bj][m][0] * sc, v1 = acc[ai][bj][m][1] * sc;
                        u32x4 w; w.x = pk2(v0[0], v0[1]); w.y = pk2(v0[2], v0[3]); w.z = pk2(v1[0], v1[1]); w.w = pk2(v1[2], v1[3]);
                        *(u32x4*)(rowp + bj * HALF) = w;
                    }
                }
            }
    }
};
struct EpiU {
    static constexpr bool PERM = true, AFTER_DRAIN = false;
    bf16_t* uscr;
    DEV_M void operator()(const f32x4 (&acc)[2][2][4][2], const Unit& u, int wr, int wc, int fr, int fq) const {
        EPI_LAUNDER(wr, wc, fr, fq);
        bf16_t* base = uscr + (size_t)(u.pm * 4 + u.pn) * 65536 + (size_t)(wr * 64 + fr) * 256 + wc * 32 + 8 * fq;
#pragma unroll
        for (int ai = 0; ai < 2; ++ai)
#pragma unroll
            for (int m = 0; m < 4; ++m)
#pragma unroll
                for (int bj = 0; bj < 2; ++bj) {
                    const f32x4 v0 = acc[ai][bj][m][0], v1 = acc[ai][bj][m][1];
                    u32x4 w; w.x = pk2(v0[0], v0[1]); w.y = pk2(v0[2], v0[3]); w.z = pk2(v1[0], v1[1]); w.w = pk2(v1[2], v1[3]);
                    *(u32x4*)(base + (size_t)(ai * HALF + m * 16) * 256 + bj * HALF) = w;
                }
    }
};
struct EpiGate {
    static constexpr bool PERM = true, AFTER_DRAIN = false;
    const bf16_t* uscr; bf16_t* merged; const float* rss; int first;
    DEV_M void operator()(const f32x4 (&acc)[2][2][4][2], const Unit& u, int wr, int wc, int fr, int fq) const {
        EPI_LAUNDER(wr, wc, fr, fq);
        const bf16_t* ub = uscr + (size_t)(u.pm * 4 + u.pn) * 65536 + (size_t)(wr * 64 + fr) * 256 + wc * 32 + 8 * fq;
        const int row0 = u.pm * BM + wr * 64 + fr, col0 = u.pn * BM + wc * 32 + 8 * fq;
#pragma unroll
        for (int ai = 0; ai < 2; ++ai)
#pragma unroll
            for (int m = 0; m < 4; ++m) {
                const int row = row0 + ai * HALF + m * 16; const float sc = rstd_of(rss[row]);
#pragma unroll
                for (int bj = 0; bj < 2; ++bj) {
                    const u32x4 uv = *(const u32x4*)(ub + (size_t)(ai * HALF + m * 16) * 256 + bj * HALF);
                    bf16_t* mp = merged + (size_t)row * DM + col0 + bj * HALF;
                    u32x4 pv = {0u, 0u, 0u, 0u};
                    if (!first) pv = *(const u32x4*)mp;
                    const f32x4 a0 = acc[ai][bj][m][0] * sc, a1 = acc[ai][bj][m][1] * sc;
                    float r[8];
                    r[0] = sigmoidf_(a0[0]) * bflo(uv.x) + bflo(pv.x); r[1] = sigmoidf_(a0[1]) * bfhi(uv.x) + bfhi(pv.x);
                    r[2] = sigmoidf_(a0[2]) * bflo(uv.y) + bflo(pv.y); r[3] = sigmoidf_(a0[3]) * bfhi(uv.y) + bfhi(pv.y);
                    r[4] = sigmoidf_(a1[0]) * bflo(uv.z) + bflo(pv.z); r[5] = sigmoidf_(a1[1]) * bfhi(uv.z) + bfhi(pv.z);
                    r[6] = sigmoidf_(a1[2]) * bflo(uv.w) + bflo(pv.w); r[7] = sigmoidf_(a1[3]) * bfhi(uv.w) + bfhi(pv.w);
                    u32x4 w; w.x = pk2(r[0], r[1]); w.y = pk2(r[2], r[3]); w.z = pk2(r[4], r[5]); w.w = pk2(r[6], r[7]);
                    *(u32x4*)mp = w;
                }
            }
    }
};
struct EpiOut {
    static constexpr bool PERM = false, AFTER_DRAIN = false;
    const float* xres; float* out; bf16_t* xb; float* rss;
    DEV_M void operator()(const f32x4 (&acc)[2][2][4][2], const Unit& u, int wr, int wc, int fr, int fq) const {
        EPI_LAUNDER(wr, wc, fr, fq);
        const int row0 = u.pm * BM + wr * 64 + fr, col0 = u.pn * BM + wc * 32 + 4 * fq;
#pragma unroll
        for (int ai = 0; ai < 2; ++ai)
#pragma unroll
            for (int m = 0; m < 4; ++m) {
                const int row = row0 + ai * HALF + m * 16; const size_t off = (size_t)row * DM + col0; float ss = 0.f;
#pragma unroll
                for (int bj = 0; bj < 2; ++bj)
#pragma unroll
                    for (int n = 0; n < 2; ++n) {
                        const size_t o = off + bj * HALF + n * 16;
                        const f32x4 xr = *(const f32x4*)(xres + o);
                        const f32x4 v = xr + acc[ai][bj][m][n];
                        *(f32x4*)(out + o) = v;
                        u32x2 w; w.x = pk2(v[0], v[1]); w.y = pk2(v[2], v[3]);
                        *(u32x2*)(xb + o) = w;
                        ss += (v[0] * v[0] + v[1] * v[1]) + (v[2] * v[2] + v[3] * v[3]);
                    }
                ss += xorf<16>(ss); ss += xorf<32>(ss);
                if (fq == 0) rss[(size_t)row * 16 + u.pn * 4 + wc] = ss;
            }
    }
};
struct TileOrder {
    int ntiles, G, c;
    DEV_M bool next(int i, Unit& u) const { const long t = (long)i * G + c; if (t >= ntiles) return false; u.pm = (int)(t >> 2); u.pn = (int)(t & 3); return true; }
    DEV_M void a_ready(const Unit&) const {}
    DEV_M void done(const Unit&) const {}
};
}
#ifndef HOST_EMU
#define GEMM_LDS ((PG8_LAS unsigned char*)smem_raw)
#else
#define GEMM_LDS ((void*)nullptr)
#endif
struct Ctx {
    float* out; unsigned char* ws; LDSP char* lds; int tid, lane, wave, bid, nblk;
};
constexpr int LDS_PTRS = LDS_BYTES - 256;
#ifndef HOST_EMU
DEV const float* inptr(const Ctx& c, int i) { const unsigned long long v = ((volatile LDSP unsigned long long*)(c.lds + LDS_PTRS))[i];
    const unsigned lo = __builtin_amdgcn_readfirstlane((unsigned)v), hi = __builtin_amdgcn_readfirstlane((unsigned)(v >> 32)); return (const float*)(const __attribute__((address_space(1))) float*)(((unsigned long long)hi << 32) | lo); }
#else
static inline const float* inptr(const Ctx& c, int i) { return ((const float* volatile*)(c.lds + LDS_PTRS))[i]; }
#endif
#define CIN(i) inptr(c, (i))
template <class T> DEV T* wsp(const Ctx& c, size_t off) { return (T*)(c.ws + off); }
DEV int orig_col(int n) {
    if (n < 1792) return n;
    if (n < 2048) return 1800 + (n - 1792);
    if (n < 3072) return 2056 + (n - 2048);
    if (n < 4096) return 3092 + (n - 3072);
    if (n < 4104) return 1792 + (n - 4096);
    if (n < 4116) return 3080 + (n - 4104);
    return -1;
}

template <class F> DEV void transpose_item(const Ctx& c, F src, bf16_t* dst, int ldd, int k0, int n0) {
    LDSP float* tile = (LDSP float*)c.lds;
    for (int e = c.tid; e < 4096; e += NTHR) { const int k = e >> 6, n = e & 63; tile[n * 65 + k] = src(k0 + k, n0 + n); }
    block_sync();
    for (int e = c.tid; e < 2048; e += NTHR) { const int n = e >> 5, k2 = (e & 31) * 2;
        *(unsigned*)(dst + (size_t)(n0 + n) * ldd + k0 + k2) = pk2(tile[n * 65 + k2], tile[n * 65 + k2 + 1]); }
    block_sync();
}

DEV void p0_prep(const Ctx& c, int l) {
    const float* g1 = CIN(1) + (size_t)l * DM;
    const float* g2 = CIN(17) + (size_t)l * DM;
    constexpr int I_IN = (PROJ_N / 64) * 16, I_G = 4 * 16 * 16, I_UP = 4 * 16 * 4, I_OUT = 16 * 16, I_WQ = 16 * 16, I_WC = 2 * 32, I_CB = 2;
    constexpr int I_TOT = I_IN + I_G + I_UP + I_OUT + I_WQ + I_WC + I_CB;
    for (int it = c.bid; it < I_TOT; it += c.nblk) {
        int r = it;
        if (r < I_IN) {
            const float* w = CIN(2) + (size_t)l * DM * N_IN_ORIG; const int nt = r / 16, kt = r % 16;
            transpose_item(c, [=](int k, int n) { const int oc = orig_col(n); return oc < 0 ? 0.f : w[(size_t)k * N_IN_ORIG + oc] * g1[k]; }, wsp<bf16_t>(c, WS_WIN), DM, kt * 64, nt * 64);
            continue;
        } r -= I_IN;
        if (r < I_G) {
            const int m = r / 256, nt = (r % 256) / 16, kt = r % 16; const float* w = CIN(15) + ((size_t)l * 4 + m) * DM * DM;
            transpose_item(c, [=](int k, int n) { return w[(size_t)k * DM + n] * g1[k]; }, wsp<bf16_t>(c, WS_WG) + (size_t)m * DM * DM, DM, kt * 64, nt * 64);
            continue;
        } r -= I_G;
        if (r < I_UP) {
            const int m = r / 64, nt = (r % 64) / 4, kt = r % 4; const float* w = CIN(14) + ((size_t)l * 4 + m) * MW * DM;
            transpose_item(c, [=](int k, int n) { return w[(size_t)k * DM + n]; }, wsp<bf16_t>(c, WS_WUP) + (size_t)m * DM * MW, MW, kt * 64, nt * 64);
            continue;
        } r -= I_UP;
        if (r < I_OUT) {
            const int nt = r / 16, kt = r % 16; const float* w = CIN(16) + (size_t)l * DM * DM;
            transpose_item(c, [=](int k, int n) { return w[(size_t)k * DM + n]; }, wsp<bf16_t>(c, WS_WOUT), DM, kt * 64, nt * 64);
            continue;
        } r -= I_OUT;
        if (r < I_WQ) {
            const int hp = r / 16, kt = r % 16;
            const float* keys = CIN(19) + ((size_t)l * 16 + hp) * 128 * 128; const float* wq = CIN(18) + (size_t)l * DM * PEER_N;
            LDSP float* keysL = (LDSP float*)c.lds; LDSP float* wqL = keysL + 128 * 129;
            for (int e = c.tid; e < 128 * 128; e += NTHR) keysL[(e >> 7) * 129 + (e & 127)] = keys[e];
            for (int e = c.tid; e < 64 * 128; e += NTHR) { const int k = e >> 7, d = e & 127; wqL[k * 129 + d] = wq[(size_t)(kt * 64 + k) * PEER_N + hp * 128 + d] * g2[kt * 64 + k]; }
            block_sync();
            const int key = c.tid & 127, kg = c.tid >> 7;
            float acc[16];
#pragma unroll
            for (int j = 0; j < 16; ++j) acc[j] = 0.f;
            for (int d = 0; d < 128; ++d) { const float kv = keysL[key * 129 + d];
#pragma unroll
                for (int j = 0; j < 16; ++j) acc[j] += kv * wqL[(kg * 16 + j) * 129 + d]; }
            bf16_t* dst = wsp<bf16_t>(c, WS_WQ2) + (size_t)(hp * 128 + key) * DM + kt * 64 + kg * 16;
#pragma unroll
            for (int j = 0; j < 16; j += 2) *(unsigned*)(dst + j) = pk2(acc[j], acc[j + 1]);
            block_sync();
            continue;
        } r -= I_WQ;
        if (r < I_WC) {
            const int kv = r / 32, kt = r % 32; const float* w = CIN(12) + ((size_t)l * 2 + kv) * 2048 * 64;
            transpose_item(c, [=](int k, int n) { return w[(size_t)k * 64 + n]; }, wsp<bf16_t>(c, WS_WCT) + (size_t)kv * 64 * 2048, 2048, kt * 64, 0);
            continue;
        } r -= I_WC;
        {
            const int kv = r; const float* w = CIN(12) + ((size_t)l * 2 + kv) * 2048 * 64; const float* pe = CIN(11) + ((size_t)l * 2 + kv) * 2048;
            LDSP float* red = (LDSP float*)c.lds;
            const int e = c.tid & 63, part = c.tid >> 6; float s = 0.f;
            for (int kk = part * 256; kk < part * 256 + 256; ++kk) s += pe[kk] * w[(size_t)kk * 64 + e];
            red[part * 64 + e] = s;
            block_sync();
            if (c.tid < 64) { float t = 0.f; for (int p = 0; p < 8; ++p) t += red[p * 64 + c.tid]; wsp<float>(c, WS_CBIAS)[kv * 64 + c.tid] = t; }
            block_sync();
        }
    }
    if (l == 0) {
        const float* x = CIN(0); bf16_t* xb = wsp<bf16_t>(c, WS_XB); float* rss = wsp<float>(c, WS_RSS1);
        for (int row = c.bid * NWAVE + c.wave; row < NT; row += c.nblk * NWAVE) {
            const f32x4* xr = (const f32x4*)(x + (size_t)row * DM) + c.lane; float s = 0.f;
            u32x2* o = (u32x2*)(xb + (size_t)row * DM) + c.lane;
#pragma unroll
            for (int j = 0; j < 4; ++j) { const f32x4 v = xr[64 * j]; s += (v[0] * v[0] + v[1] * v[1]) + (v[2] * v[2] + v[3] * v[3]);
                u32x2 w; w.x = pk2(v[0], v[1]); w.y = pk2(v[2], v[3]); o[64 * j] = w; }
            s = wave_sum(s);
            if (c.lane == 0) rss[row] = s;
        }
        float* cosT = wsp<float>(c, WS_ROPE); float* sinT = cosT + SEQ * 32;
        for (int i = c.bid * NTHR + c.tid; i < SEQ * 32; i += c.nblk * NTHR) {
            const int pos = i >> 5, fi = i & 31;
            const float inv = exp2f(-(float)fi * 0.41524101186092029f);
            const float a = (float)pos * inv, q = rintf(a * 0.63661977236758134f);
            float rr = fmaf(-q, 1.5703125f, a); rr = fmaf(-q, 4.837512969970703125e-4f, rr); rr = fmaf(-q, 7.54978995489188216e-8f, rr);
            const float r2 = rr * rr;
            const float s = rr * (1.0f + r2 * (-1.0f / 6 + r2 * (1.0f / 120 + r2 * (-1.0f / 5040 + r2 * (1.0f / 362880)))));
            const float cc = 1.0f + r2 * (-0.5f + r2 * (1.0f / 24 + r2 * (-1.0f / 720 + r2 * (1.0f / 40320 + r2 * (-1.0f / 3628800)))));
            const int qi = ((int)q) & 3;
            const float co = qi == 0 ? cc : qi == 1 ? -s : qi == 2 ? -cc : s;
            const float si = qi == 0 ? s : qi == 1 ? cc : qi == 2 ? -s : -cc;
            cosT[i] = co; sinT[i] = si;
        }
    }
}
constexpr int LF_STRIDE = 65, LT_STRIDE = 72;
constexpr int LDS_F0 = 0, LDS_F1 = 16640, LDS_F2 = 33280, LDS_T0 = 49920, LDS_TSZ = 64 * LT_STRIDE * 2, LDS_MISC = LDS_T0 + 6 * LDS_TSZ;
DEV LDSP float* ldsF(const Ctx& c, int i) { return (LDSP float*)(c.lds + LDS_F0 + i * 16640); }
DEV LDSP bf16_t* ldsT(const Ctx& c, int i) { return (LDSP bf16_t*)(c.lds + LDS_T0 + i * LDS_TSZ); }
DEV LDSP float* ldsM(const Ctx& c) { return (LDSP float*)(c.lds + LDS_MISC); }

DEV void load_tile_f32(const Ctx& c, LDSP float* F, const bf16_t* proj, int tok0, int col) {
    const int t = c.tid >> 3, d0 = (c.tid & 7) * 8;
    const u32x4 v = *(const u32x4*)(proj + (size_t)(tok0 + t) * PROJ_LD + col + d0);
    LDSP float* f = F + t * LF_STRIDE + d0;
    f[0] = bflo(v.x); f[1] = bfhi(v.x); f[2] = bflo(v.y); f[3] = bfhi(v.y); f[4] = bflo(v.z); f[5] = bfhi(v.z); f[6] = bflo(v.w); f[7] = bfhi(v.w);
}
DEV void load_tile_T(const Ctx& c, LDSP bf16_t* T, const bf16_t* proj, int tok0, int col) {
    const int t = c.tid >> 3, d0 = (c.tid & 7) * 8;
    const u32x4 v = *(const u32x4*)(proj + (size_t)(tok0 + t) * PROJ_LD + col + d0);
    LDSP bf16_t* p = T + d0 * LT_STRIDE + t;
    p[0] = (bf16_t)(v.x & 0xffff); p[LT_STRIDE] = (bf16_t)(v.x >> 16); p[2 * LT_STRIDE] = (bf16_t)(v.y & 0xffff); p[3 * LT_STRIDE] = (bf16_t)(v.y >> 16);
    p[4 * LT_STRIDE] = (bf16_t)(v.z & 0xffff); p[5 * LT_STRIDE] = (bf16_t)(v.z >> 16); p[6 * LT_STRIDE] = (bf16_t)(v.w & 0xffff); p[7 * LT_STRIDE] = (bf16_t)(v.w >> 16);
}
DEV f32x4 mma_tile(const LDSP bf16_t* A, int lda, int r0, const LDSP bf16_t* B, int ldb, int c0, int K, f32x4 acc, int lane) {
    const int fr = lane & 15, fq = lane >> 4;
    for (int k0 = 0; k0 < K; k0 += 32) {
        const bf16x8 a = *(const LDSP bf16x8*)(A + (r0 + fr) * lda + k0 + fq * 8);
        const bf16x8 b = *(const LDSP bf16x8*)(B + (c0 + fr) * ldb + k0 + fq * 8);
        acc = mfma16(a, b, acc);
    }
    return acc;
}
DEV float hgrn_lb(const Ctx& c, int l, int ch) { if (l == 0) return 0.f; const float* lb = CIN(3); return sigmoidf_(lb[MW + ch] - lb[ch]); }
DEV float ret_loggamma(int h) { return log1pf(-exp2f(-5.0f - (float)h)); }

DEV void hgrn_front(const Ctx& c, int l, const bf16_t* proj, int tok0, int h) {
    LDSP float* F0 = ldsF(c, 0); LDSP float* F1 = ldsF(c, 1);
    load_tile_f32(c, F0, proj, tok0, C_HF + h * 64);
    block_sync();
    for (int e = c.tid; e < 4096; e += NTHR) { const int t = e >> 6, d = e & 63; const float fl = F0[t * LF_STRIDE + d], lbv = hgrn_lb(c, l, h * 64 + d);
        const float sg = sigmoidf_(fl), f = lbv + (1.f - lbv) * sg; F0[t * LF_STRIDE + d] = fast_log(f); F1[t * LF_STRIDE + d] = (1.f - lbv) * (1.f - sg); }
    block_sync();
    if (c.tid < 64) { float s = 0.f; for (int t = 0; t < 64; ++t) { s += F0[t * LF_STRIDE + c.tid]; F0[t * LF_STRIDE + c.tid] = s; } }
    block_sync();
}
DEV void rope_tile(const Ctx& c, LDSP float* F, int pos0, float scale) {
    const float* cosT = wsp<float>(c, WS_ROPE); const float* sinT = cosT + SEQ * 32;
    for (int e = c.tid; e < 2048; e += NTHR) { const int t = e >> 5, d = e & 31; const float cs = cosT[(pos0 + t) * 32 + d], sn = sinT[(pos0 + t) * 32 + d];
        const float x1 = F[t * LF_STRIDE + d], x2 = F[t * LF_STRIDE + d + 32];
        F[t * LF_STRIDE + d] = (x1 * cs - x2 * sn) * scale; F[t * LF_STRIDE + d + 32] = (x1 * sn + x2 * cs) * scale; }
}
DEV void mlstm_conv_tile(const Ctx& c, int l, LDSP float* F, const bf16_t* proj, int tok0, int pos0, int col, int ch0, float scale) {
    const float* cw = CIN(5) + (size_t)l * 4 * 512; const float* cb = CIN(6) + (size_t)l * 512;
    for (int e = c.tid; e < 4096; e += NTHR) { const int t = e >> 6, d = e & 63; float s = cb[ch0 + d];
#pragma unroll
        for (int j = 0; j < 4; ++j) { const int p = pos0 + t - 3 + j; if (p >= 0) s += cw[j * 512 + ch0 + d] * bf2f(proj[(size_t)(tok0 + t - 3 + j) * PROJ_LD + col + d]); }
        F[t * LF_STRIDE + d] = siluf_(s) * scale; }
}
DEV void mlstm_gates(const Ctx& c, int l, const bf16_t* proj, int tok0, int h) {
    LDSP float* M = ldsM(c); const float* gb = CIN(7) + (size_t)l * 8;
    if (c.tid < 64) { const int t = c.tid; M[t] = bf2f(proj[(size_t)(tok0 + t) * PROJ_LD + C_MI + h]) + gb[h];
        M[64 + t] = log_sigmoidf_(bf2f(proj[(size_t)(tok0 + t) * PROJ_LD + C_MF + h]) + gb[4 + h]); }
    block_sync();
    if (c.tid == 0) { float s = 0.f; for (int t = 0; t < 64; ++t) { s += M[64 + t]; M[64 + t] = s; } }
    block_sync();
}
DEV void store_state_tiles(const Ctx& c, bf16_t* dst, const f32x4 (&acc)[2]) {
    const int fr = c.lane & 15, fq = c.lane >> 4;
#pragma unroll
    for (int k = 0; k < 2; ++k) { const int ti = c.wave * 2 + k, rt = ti >> 2, ct = ti & 3;
#pragma unroll
        for (int i = 0; i < 4; ++i) dst[(rt * 16 + fq * 4 + i) * 64 + ct * 16 + fr] = f2bf(acc[k][i]); }
}
DEV void f32_to_tile(const Ctx& c, LDSP bf16_t* T, const LDSP float* F, bool transpose) {
    for (int e = c.tid; e < 4096; e += NTHR) { const int r = e >> 6, q = e & 63; const bf16_t v = f2bf(F[r * LF_STRIDE + q]); if (transpose) T[q * LT_STRIDE + r] = v; else T[r * LT_STRIDE + q] = v; }
}

DEV void recur_local_unit(const Ctx& c, int l, int unit) {
    const int mixer = unit / (BATCH * NH * NC), r = unit % (BATCH * NH * NC), b = r / (NH * NC), h = (r / NC) % NH, ck = r % NC;
    const bf16_t* proj = wsp<bf16_t>(c, WS_PROJ); const int tok0 = b * SEQ + ck * 64, pos0 = ck * 64;
    LDSP float* F0 = ldsF(c, 0); LDSP float* F1 = ldsF(c, 1); LDSP float* M = ldsM(c);
    LDSP bf16_t* VT = ldsT(c, 0); LDSP bf16_t* KT = ldsT(c, 1);
    bf16_t* dst = wsp<bf16_t>(c, WS_ST + mixer * ST_ONE) + (size_t)r * 4096;
    if (mixer == 0) {
        hgrn_front(c, l, proj, tok0, h);
        for (int e = c.tid; e < 4096; e += NTHR) { const int t = e >> 6, d = e & 63;
            KT[d * LT_STRIDE + t] = f2bf(F1[t * LF_STRIDE + d] * fast_exp(F0[63 * LF_STRIDE + d] - F0[t * LF_STRIDE + d])); }
        if (c.tid < 64) wsp<float>(c, WS_GDEC)[(size_t)r * 64 + c.tid] = fast_exp(F0[63 * LF_STRIDE + c.tid]);
        load_tile_T(c, VT, proj, tok0, C_HI + h * 64);
    } else if (mixer == 2) {
        load_tile_f32(c, F0, proj, tok0, C_RK + h * 64);
        block_sync();
        rope_tile(c, F0, pos0, 0.125f);
        block_sync();
        const float lg = ret_loggamma(h);
        for (int e = c.tid; e < 4096; e += NTHR) { const int t = e >> 6, d = e & 63; KT[d * LT_STRIDE + t] = f2bf(F0[t * LF_STRIDE + d] * fast_exp(lg * (float)(63 - t))); }
        load_tile_T(c, VT, proj, tok0, C_RV + h * 64);
    } else {
        mlstm_gates(c, l, proj, tok0, h);
        mlstm_conv_tile(c, l, F0, proj, tok0, pos0, C_MK + h * 64, 256 + h * 64, 0.125f);
        if (c.tid == 0) { const float bl = M[127]; float a = -3.0e38f; for (int t = 0; t < 64; ++t) a = fmaxf(a, bl - M[64 + t] + M[t]); M[128] = a; M[129] = bl; }
        block_sync();
        for (int e = c.tid; e < 4096; e += NTHR) { const int t = e >> 6, d = e & 63; const float wk = fast_exp(M[129] - M[64 + t] + M[t] - M[128]);
            const float kh = F0[t * LF_STRIDE + d] * wk; F0[t * LF_STRIDE + d] = kh; KT[d * LT_STRIDE + t] = f2bf(kh); }
        load_tile_T(c, VT, proj, tok0, C_MV + h * 64);
        block_sync();
        if (c.tid < 64) { float s = 0.f; for (int t = 0; t < 64; ++t) s += F0[t * LF_STRIDE + c.tid]; wsp<float>(c, WS_MNL)[(size_t)r * 64 + c.tid] = s; }
        if (c.tid == 64) { float* sc = wsp<float>(c, WS_MSC) + (size_t)r * 4; sc[0] = M[128]; sc[1] = M[129]; }
    }
    block_sync();
    f32x4 acc[2];
#pragma unroll
    for (int k = 0; k < 2; ++k) { const int ti = c.wave * 2 + k; acc[k] = (f32x4){0.f, 0.f, 0.f, 0.f}; acc[k] = mma_tile(VT, LT_STRIDE, (ti >> 2) * 16, KT, LT_STRIDE, (ti & 3) * 16, 64, acc[k], c.lane); }
    store_state_tiles(c, dst, acc);
    block_sync();
}

DEV void recur_scan(const Ctx& c) {
    const int ncol = BATCH * NH * 4096;
    for (int i = c.bid * NTHR + c.tid; i < 3 * ncol + BATCH * NH * 64; i += c.nblk * NTHR) {
        if (i < 3 * ncol) {
            const int mixer = i / ncol, col = i % ncol, bh = col >> 12, ed = col & 4095, d = ed & 63, h = bh % NH;
            bf16_t* p = wsp<bf16_t>(c, WS_ST + mixer * ST_ONE) + (size_t)bh * NC * 4096 + ed;
            float s = 0.f;
            if (mixer == 0) { const float* g = wsp<float>(c, WS_GDEC) + (size_t)bh * NC * 64 + d;
                for (int k = 0; k < NC; ++k) { const float t = bf2f(p[(size_t)k * 4096]); p[(size_t)k * 4096] = f2bf(s); s = g[k * 64] * s + t; } }
            else if (mixer == 2) { const float g = fast_exp(ret_loggamma(h) * 64.f);
                for (int k = 0; k < NC; ++k) { const float t = bf2f(p[(size_t)k * 4096]); p[(size_t)k * 4096] = f2bf(s); s = g * s + t; } }
            else { const float* sc = wsp<float>(c, WS_MSC) + (size_t)bh * NC * 4; float m = 0.f;
                for (int k = 0; k < NC; ++k) { const float a = sc[k * 4], bl = sc[k * 4 + 1], mn = fmaxf(bl + m, a);
                    const float t = bf2f(p[(size_t)k * 4096]); p[(size_t)k * 4096] = f2bf(s); s = fast_exp(bl + m - mn) * s + fast_exp(a - mn) * t; m = mn; } }
        } else {
            const int j = i - 3 * ncol, bh = j >> 6, d = j & 63;
            float* p = wsp<float>(c, WS_MNL) + (size_t)bh * NC * 64 + d; float* sc = wsp<float>(c, WS_MSC) + (size_t)bh * NC * 4; float m = 0.f, s = 0.f;
            for (int k = 0; k < NC; ++k) { const float a = sc[k * 4], bl = sc[k * 4 + 1], mn = fmaxf(bl + m, a);
                const float t = p[k * 64]; p[k * 64] = s; if (d == 0) sc[k * 4 + 2] = m; s = fast_exp(bl + m - mn) * s + fast_exp(a - mn) * t; m = mn; }
        }
    }
}

DEV void recur_out_unit(const Ctx& c, int l, int unit) {
    const int mixer = unit / (BATCH * NH * NC), r = unit % (BATCH * NH * NC), b = r / (NH * NC), h = (r / NC) % NH, ck = r % NC;
    const bf16_t* proj = wsp<bf16_t>(c, WS_PROJ); const int tok0 = b * SEQ + ck * 64, pos0 = ck * 64;
    LDSP float* F0 = ldsF(c, 0); LDSP float* F1 = ldsF(c, 1); LDSP float* F2 = ldsF(c, 2); LDSP float* M = ldsM(c);
    LDSP bf16_t* QA = ldsT(c, 0); LDSP bf16_t* KB = ldsT(c, 1); LDSP bf16_t* P = ldsT(c, 2); LDSP bf16_t* Q2 = ldsT(c, 3); LDSP bf16_t* VT = ldsT(c, 4); LDSP bf16_t* STt = ldsT(c, 5);
    const bf16_t* st = wsp<bf16_t>(c, WS_ST + mixer * ST_ONE) + (size_t)r * 4096;
    const int fr = c.lane & 15, fq = c.lane >> 4;
    { const int e = c.tid >> 3, d0 = (c.tid & 7) * 8; *(LDSP u32x4*)(STt + e * LT_STRIDE + d0) = *(const u32x4*)(st + e * 64 + d0); }
    int vcol, gcol; const float* onorm;
    if (mixer == 0) {
        vcol = C_HI; gcol = C_HG; onorm = CIN(4) + (size_t)l * MW;
        hgrn_front(c, l, proj, tok0, h);
        load_tile_f32(c, F2, proj, tok0, C_HQ + h * 64);
        block_sync();
        for (int e = c.tid; e < 4096; e += NTHR) { const int t = e >> 6, d = e & 63; const float q = siluf_(F2[t * LF_STRIDE + d]), bt = F0[t * LF_STRIDE + d], bm = F0[31 * LF_STRIDE + d];
            QA[t * LT_STRIDE + d] = f2bf(q * fast_exp(bt - bm)); KB[t * LT_STRIDE + d] = f2bf(F1[t * LF_STRIDE + d] * fast_exp(bm - bt)); Q2[t * LT_STRIDE + d] = f2bf(q * fast_exp(bt)); }
    } else if (mixer == 2) {
        vcol = C_RV; gcol = C_RG; onorm = CIN(13) + (size_t)l * MW;
        load_tile_f32(c, F0, proj, tok0, C_RQ + h * 64); load_tile_f32(c, F1, proj, tok0, C_RK + h * 64);
        block_sync();
        rope_tile(c, F0, pos0, 1.0f); rope_tile(c, F1, pos0, 0.125f);
        block_sync();
        const float lg = ret_loggamma(h);
        for (int e = c.tid; e < 4096; e += NTHR) { const int t = e >> 6, d = e & 63; const float q = F0[t * LF_STRIDE + d];
            QA[t * LT_STRIDE + d] = f2bf(q); KB[t * LT_STRIDE + d] = f2bf(F1[t * LF_STRIDE + d]); Q2[t * LT_STRIDE + d] = f2bf(q * fast_exp(lg * (float)(t + 1))); }
    } else {
        vcol = C_MV; gcol = C_MO; onorm = CIN(8) + (size_t)l * MW;
        mlstm_gates(c, l, proj, tok0, h);
        mlstm_conv_tile(c, l, F0, proj, tok0, pos0, C_MQ + h * 64, h * 64, 1.0f);
        mlstm_conv_tile(c, l, F1, proj, tok0, pos0, C_MK + h * 64, 256 + h * 64, 0.125f);
        if (c.tid == 0) {
            const float mst = wsp<float>(c, WS_MSC)[(size_t)r * 4 + 2]; float pm = -3.0e38f;
            for (int t = 0; t < 64; ++t) { pm = fmaxf(pm, M[t] - M[64 + t]); const float inter = M[64 + t] + mst, mt = fmaxf(inter, M[64 + t] + pm); M[128 + t] = mt; M[192 + t] = fast_exp(inter - mt); }
        }
        block_sync();
        for (int e = c.tid; e < 4096; e += NTHR) { const int t = e >> 6, d = e & 63; const float q = F0[t * LF_STRIDE + d];
            QA[t * LT_STRIDE + d] = f2bf(q); KB[t * LT_STRIDE + d] = f2bf(F1[t * LF_STRIDE + d]); Q2[t * LT_STRIDE + d] = f2bf(q * M[192 + t]); }
        if (c.tid < 64) { const float* nst = wsp<float>(c, WS_MNL) + (size_t)r * 64; float s = 0.f; for (int d = 0; d < 64; ++d) s += F0[c.tid * LF_STRIDE + d] * nst[d]; M[256 + c.tid] = s * M[192 + c.tid]; }
    }
    load_tile_T(c, VT, proj, tok0, vcol + h * 64);
    block_sync();
    f32x4 acc[2];
#pragma unroll
    for (int k = 0; k < 2; ++k) { const int ti = c.wave * 2 + k; acc[k] = (f32x4){0.f, 0.f, 0.f, 0.f}; acc[k] = mma_tile(QA, LT_STRIDE, (ti >> 2) * 16, KB, LT_STRIDE, (ti & 3) * 16, 64, acc[k], c.lane); }
    const float lg = ret_loggamma(h);
#pragma unroll
    for (int k = 0; k < 2; ++k) { const int ti = c.wave * 2 + k, rt = ti >> 2, ct = ti & 3, s = ct * 16 + fr;
#pragma unroll
        for (int i = 0; i < 4; ++i) { const int t = rt * 16 + fq * 4 + i; float v = 0.f;
            if (s <= t) {
                if (mixer == 0) v = acc[k][i];
                else if (mixer == 2) v = acc[k][i] * fast_exp(lg * (float)(t - s));
                else v = acc[k][i] * fast_exp(M[64 + t] - M[64 + s] + M[s] - M[128 + t]);
            }
            P[t * LT_STRIDE + s] = f2bf(v); if (mixer == 1) F2[t * LF_STRIDE + s] = v; } }
    block_sync();
#pragma unroll
    for (int k = 0; k < 2; ++k) { const int ti = c.wave * 2 + k; acc[k] = (f32x4){0.f, 0.f, 0.f, 0.f};
        acc[k] = mma_tile(P, LT_STRIDE, (ti >> 2) * 16, VT, LT_STRIDE, (ti & 3) * 16, 64, acc[k], c.lane);
        acc[k] = mma_tile(Q2, LT_STRIDE, (ti >> 2) * 16, STt, LT_STRIDE, (ti & 3) * 16, 64, acc[k], c.lane); }
    if (mixer == 1 && c.tid < 64) { float s = 0.f; for (int j = 0; j < 64; ++j) s += F2[c.tid * LF_STRIDE + j]; const float den = M[256 + c.tid] + s; M[320 + c.tid] = fast_rcp(fmaxf(fabsf(den), fast_exp(-M[128 + c.tid]))); }
    block_sync();
#pragma unroll
    for (int k = 0; k < 2; ++k) { const int ti = c.wave * 2 + k, rt = ti >> 2, ct = ti & 3;
#pragma unroll
        for (int i = 0; i < 4; ++i) { const int t = rt * 16 + fq * 4 + i; float v = acc[k][i]; if (mixer == 1) v *= M[320 + t]; F1[t * LF_STRIDE + ct * 16 + fr] = v; } }
    block_sync();
    if (c.tid < 64) { float s = 0.f; for (int e = 0; e < 64; ++e) { const float v = F1[c.tid * LF_STRIDE + e]; s += v * v; } M[384 + c.tid] = fast_rsqrt(s * (1.0f / 64.0f) + NORM_EPS); }
    block_sync();
    bf16_t* out = wsp<bf16_t>(c, WS_OUTS) + (size_t)(mixer == 0 ? 0 : mixer == 1 ? 1 : 3) * NT * MW;
    { const int t = c.tid >> 3, e0 = (c.tid & 7) * 8;
      const u32x4 gv = *(const u32x4*)(proj + (size_t)(tok0 + t) * PROJ_LD + gcol + h * 64 + e0);
      const float gr[8] = {bflo(gv.x), bfhi(gv.x), bflo(gv.y), bfhi(gv.y), bflo(gv.z), bfhi(gv.z), bflo(gv.w), bfhi(gv.w)};
      float o[8];
#pragma unroll
      for (int j = 0; j < 8; ++j) { const float gate = (mixer == 1) ? sigmoidf_(gr[j]) : siluf_(gr[j]); o[j] = F1[t * LF_STRIDE + e0 + j] * M[384 + t] * onorm[h * 64 + e0 + j] * gate; }
      u32x4 w; w.x = pk2(o[0], o[1]); w.y = pk2(o[2], o[3]); w.z = pk2(o[4], o[5]); w.w = pk2(o[6], o[7]);
      *(u32x4*)(out + (size_t)(tok0 + t) * MW + h * 64 + e0) = w; }
    block_sync();
}
#ifndef HOST_EMU
DEV void wave_sync() { __builtin_amdgcn_fence(__ATOMIC_ACQ_REL, "wavefront"); __builtin_amdgcn_wave_barrier(); }
#else
static inline void wave_sync() { emu_bar_wait(emu_wave().bar, 64); }
#endif

DEV void nsa_kprep_item(const Ctx& c, int l, int item) {
    const bf16_t* proj = wsp<bf16_t>(c, WS_PROJ); bf16_t* ksw = wsp<bf16_t>(c, WS_KSW);
    const float* cosT = wsp<float>(c, WS_ROPE); const float* sinT = cosT + SEQ * 32;
    const int tok = item * 4 + (c.tid >> 7), vec = (c.tid >> 5) & 3, br = vec >> 1, g = vec & 1, d = c.tid & 31;
    const int col = (br == 0 ? C_NKS : C_NKW) + g * 64;
    const float x1 = bf2f(proj[(size_t)tok * PROJ_LD + col + d]), x2 = bf2f(proj[(size_t)tok * PROJ_LD + col + d + 32]);
    float ss = x1 * x1 + x2 * x2;
    ss += xorf<1>(ss); ss += xorf<2>(ss); ss += xorf<4>(ss); ss += xorf<8>(ss); ss += xorf<16>(ss);
    const float r = fast_rsqrt(ss * (1.0f / 64.0f) + NORM_EPS); const float* kg = CIN(10) + ((size_t)l * 3 + 1 + br) * 64;
    const float y1 = x1 * r * kg[d], y2 = x2 * r * kg[d + 32]; const int pos = tok % SEQ;
    const float cs = cosT[pos * 32 + d], sn = sinT[pos * 32 + d];
    bf16_t* o = ksw + (size_t)tok * 256 + vec * 64;
    o[d] = f2bf(y1 * cs - y2 * sn); o[d + 32] = f2bf(y1 * sn + y2 * cs);
}
DEV void nsa_compress_unit(const Ctx& c, int l, int unit) {
    const int half = unit & 1, kv = (unit >> 1) & 1, g = (unit >> 2) & 1, b = unit >> 3;
    const bf16_t* proj = wsp<bf16_t>(c, WS_PROJ); const bf16_t* wct = wsp<bf16_t>(c, WS_WCT) + (size_t)kv * 64 * 2048;
    const int fr = c.lane & 15, fq = c.lane >> 4, n0 = half * 128 + c.wave * 16, n = n0 + fr;
    const int col = (kv == 0 ? C_NKC : C_NVC) + g * 64;
    if (n0 >= NCMP_PAD) return;
    f32x4 acc[4];
#pragma unroll
    for (int et = 0; et < 4; ++et) acc[et] = (f32x4){0.f, 0.f, 0.f, 0.f};
    for (int k0 = 0; k0 < 2048; k0 += 32) {
        const int kk = k0 + fq * 8, lrow = kk >> 6, d0 = kk & 63;
        bf16x8 a = {0, 0, 0, 0, 0, 0, 0, 0};
        if (n < NCMP) a = *(const bf16x8*)(proj + (size_t)(b * SEQ + 16 * n + lrow) * PROJ_LD + col + d0);
#pragma unroll
        for (int et = 0; et < 4; ++et) { const bf16x8 bb = *(const bf16x8*)(wct + (size_t)(et * 16 + fr) * 2048 + kk); acc[et] = mfma16(a, bb, acc[et]); }
    }
    const float* bias = wsp<float>(c, WS_CBIAS) + kv * 64;
    float v[4][4];
#pragma unroll
    for (int et = 0; et < 4; ++et)
#pragma unroll
        for (int i = 0; i < 4; ++i) v[et][i] = acc[et][i] + bias[et * 16 + fr];
    if (kv == 0) {
        const float* kg = CIN(10) + (size_t)l * 3 * 64; bf16_t* kc = wsp<bf16_t>(c, WS_KCMP) + (size_t)(b * 2 + g) * NCMP_PAD * 64;
#pragma unroll
        for (int i = 0; i < 4; ++i) { float ss = 0.f;
#pragma unroll
            for (int et = 0; et < 4; ++et) ss += v[et][i] * v[et][i];
            ss += xorf<1>(ss); ss += xorf<2>(ss); ss += xorf<4>(ss); ss += xorf<8>(ss);
            const float r = fast_rsqrt(ss * (1.0f / 64.0f) + NORM_EPS);
#pragma unroll
            for (int et = 0; et < 4; ++et) kc[(size_t)(n0 + fq * 4 + i) * 64 + et * 16 + fr] = f2bf(v[et][i] * r * kg[et * 16 + fr]); }
    } else {
        bf16_t* vt = wsp<bf16_t>(c, WS_VCMPT) + (size_t)(b * 2 + g) * 64 * NCMP_PAD;
#pragma unroll
        for (int et = 0; et < 4; ++et)
#pragma unroll
            for (int i = 0; i < 4; ++i) vt[(size_t)(et * 16 + fr) * NCMP_PAD + n0 + fq * 4 + i] = f2bf(v[et][i]);
    }
}

constexpr int NA_PC = 0, NA_PCLD = 264, NA_IMP = 67584, NA_SEL = 84224, NA_KT = 84736, NA_VT = 93952, NA_PW = 103168, NA_GATE = 121600;
constexpr float NEG_BIG = -1.0e30f;

template <int MODE>
DEV void nsa_key_block(const Ctx& c, int j, int qt, const bf16x8 (&qr)[2], f32x4 (&oacc)[4], float (&mrun)[4], float (&lrun)[4], const unsigned long long (&selm)[4]) {
    const LDSP bf16_t* Kt = (const LDSP bf16_t*)(c.lds + NA_KT); const LDSP bf16_t* VT = (const LDSP bf16_t*)(c.lds + NA_VT); LDSP bf16_t* Pw = (LDSP bf16_t*)(c.lds + NA_PW) + c.wave * 16 * 72;
    const int fr = c.lane & 15, fq = c.lane >> 4, qb = (c.wave & 3) * 16 + fq * 4;
    f32x4 s[4];
#pragma unroll
    for (int kt = 0; kt < 4; ++kt) { s[kt] = (f32x4){0.f, 0.f, 0.f, 0.f};
        s[kt] = mfma16(qr[0], *(const LDSP bf16x8*)(Kt + (kt * 16 + fr) * 72 + fq * 8), s[kt]);
        s[kt] = mfma16(qr[1], *(const LDSP bf16x8*)(Kt + (kt * 16 + fr) * 72 + 32 + fq * 8), s[kt]); }
    bool valid[4][4]; float mx[4];
#pragma unroll
    for (int i = 0; i < 4; ++i) { mx[i] = NEG_BIG; const int qi = qb + i;
#pragma unroll
        for (int kt = 0; kt < 4; ++kt) { const int kk = kt * 16 + fr; bool ok;
            if (MODE == 0) ok = ((selm[i] >> j) & 1ull) && (j < qt || kk <= qi);
            else { const int dlt = (qt - j) * 64 + qi - kk; ok = dlt >= 0 && dlt < 512; }
            valid[i][kt] = ok; if (ok) mx[i] = fmaxf(mx[i], s[kt][i]); }
        mx[i] = fmaxf(mx[i], xorf<1>(mx[i])); mx[i] = fmaxf(mx[i], xorf<2>(mx[i])); mx[i] = fmaxf(mx[i], xorf<4>(mx[i])); mx[i] = fmaxf(mx[i], xorf<8>(mx[i])); }
#pragma unroll
    for (int i = 0; i < 4; ++i) { const float mn = fmaxf(mrun[i], mx[i]), alpha = fast_exp(mrun[i] - mn); mrun[i] = mn; float ps = 0.f;
#pragma unroll
        for (int kt = 0; kt < 4; ++kt) { const float p = valid[i][kt] ? fast_exp(s[kt][i] - mn) : 0.f; ps += p; Pw[(fq * 4 + i) * 72 + kt * 16 + fr] = f2bf(p); }
        lrun[i] = lrun[i] * alpha + ps;
#pragma unroll
        for (int et = 0; et < 4; ++et) oacc[et][i] *= alpha; }
    wave_sync();
    const bf16x8 pa0 = *(const LDSP bf16x8*)(Pw + fr * 72 + fq * 8), pa1 = *(const LDSP bf16x8*)(Pw + fr * 72 + 32 + fq * 8);
#pragma unroll
    for (int et = 0; et < 4; ++et) { oacc[et] = mfma16(pa0, *(const LDSP bf16x8*)(VT + (et * 16 + fr) * 72 + fq * 8), oacc[et]);
        oacc[et] = mfma16(pa1, *(const LDSP bf16x8*)(VT + (et * 16 + fr) * 72 + 32 + fq * 8), oacc[et]); }
    wave_sync();
}

DEV void nsa_attn_unit(const Ctx& c, int l, int unit) {
    const int qt = unit % NSEL, bg = unit / NSEL, g = bg & 1, b = bg >> 1;
    const bf16_t* proj = wsp<bf16_t>(c, WS_PROJ); const bf16_t* ksw = wsp<bf16_t>(c, WS_KSW);
    const float* cosT = wsp<float>(c, WS_ROPE); const float* sinT = cosT + SEQ * 32;
    LDSP bf16_t* Pc = (LDSP bf16_t*)(c.lds + NA_PC); LDSP float* imp = (LDSP float*)(c.lds + NA_IMP); LDSP unsigned long long* selmask = (LDSP unsigned long long*)(c.lds + NA_SEL);
    LDSP bf16_t* Kt = (LDSP bf16_t*)(c.lds + NA_KT); LDSP bf16_t* VT = (LDSP bf16_t*)(c.lds + NA_VT); LDSP float* gates = (LDSP float*)(c.lds + NA_GATE);
    const int fr = c.lane & 15, fq = c.lane >> 4, hg = c.wave >> 2, hd = g * 2 + hg, qw = (c.wave & 3) * 16;
    const int tokq0 = b * SEQ + qt * 64;
    bf16x8 qc[2], qr[2];
    {
        const int tok = tokq0 + qw + fr, pos = qt * 64 + qw + fr;
        const u32x4 v0 = *(const u32x4*)(proj + (size_t)tok * PROJ_LD + C_NQ + hd * 64 + fq * 8), v1 = *(const u32x4*)(proj + (size_t)tok * PROJ_LD + C_NQ + hd * 64 + 32 + fq * 8);
        float x0[8] = {bflo(v0.x), bfhi(v0.x), bflo(v0.y), bfhi(v0.y), bflo(v0.z), bfhi(v0.z), bflo(v0.w), bfhi(v0.w)};
        float x1[8] = {bflo(v1.x), bfhi(v1.x), bflo(v1.y), bfhi(v1.y), bflo(v1.z), bfhi(v1.z), bflo(v1.w), bfhi(v1.w)};
        float ss = 0.f;
#pragma unroll
        for (int j = 0; j < 8; ++j) ss += x0[j] * x0[j] + x1[j] * x1[j];
        ss += xorf<16>(ss); ss += xorf<32>(ss);
        const float r = fast_rsqrt(ss * (1.0f / 64.0f) + NORM_EPS) * 0.125f; const float* qg = CIN(9) + (size_t)l * 64;
#pragma unroll
        for (int j = 0; j < 8; ++j) { const int d = fq * 8 + j; const float y0 = x0[j] * r * qg[d], y1 = x1[j] * r * qg[d + 32];
            const float cs = cosT[pos * 32 + d], sn = sinT[pos * 32 + d];
            qc[0][j] = (short)f2bf(y0); qc[1][j] = (short)f2bf(y1); qr[0][j] = (short)f2bf(y0 * cs - y1 * sn); qr[1][j] = (short)f2bf(y0 * sn + y1 * cs); }
    }
    if (c.tid < 384) { const int row = c.tid / 3, br = c.tid % 3, hh = row >> 6, q = row & 63;
        gates[c.tid] = sigmoidf_(bf2f(proj[(size_t)(tokq0 + q) * PROJ_LD + C_NG + (g * 2 + hh) * 3 + br])); }
    f32x4 ofin[4];
#pragma unroll
    for (int et = 0; et < 4; ++et) ofin[et] = (f32x4){0.f, 0.f, 0.f, 0.f};
    const int nvis = 4 * qt + 3, nkt = (nvis + 15) >> 4, nk32 = ((nkt * 16 + 31) >> 5) << 5;
    {
        const bf16_t* kc = wsp<bf16_t>(c, WS_KCMP) + (size_t)(b * 2 + g) * NCMP_PAD * 64;
        f32x4 s[16];
#pragma unroll
        for (int jt = 0; jt < 16; ++jt) { s[jt] = (f32x4){0.f, 0.f, 0.f, 0.f};
            if (jt < nkt) { s[jt] = mfma16(qc[0], *(const bf16x8*)(kc + (size_t)(jt * 16 + fr) * 64 + fq * 8), s[jt]);
                            s[jt] = mfma16(qc[1], *(const bf16x8*)(kc + (size_t)(jt * 16 + fr) * 64 + 32 + fq * 8), s[jt]); } }
#pragma unroll
        for (int i = 0; i < 4; ++i) {
            const int sp = qt * 64 + qw + fq * 4 + i, lim = (sp >= 31) ? ((sp - 31) >> 4) : -1;
            float mx = NEG_BIG;
#pragma unroll
            for (int jt = 0; jt < 16; ++jt) if (jt < nkt && jt * 16 + fr <= lim) mx = fmaxf(mx, s[jt][i]);
            mx = fmaxf(mx, xorf<1>(mx)); mx = fmaxf(mx, xorf<2>(mx)); mx = fmaxf(mx, xorf<4>(mx)); mx = fmaxf(mx, xorf<8>(mx));
            float ps = 0.f;
#pragma unroll
            for (int jt = 0; jt < 16; ++jt) { float p = 0.f; if (jt < nkt && jt * 16 + fr <= lim) p = fast_exp(s[jt][i] - mx); s[jt][i] = p; ps += p; }
            ps += xorf<1>(ps); ps += xorf<2>(ps); ps += xorf<4>(ps); ps += xorf<8>(ps);
            const float inv = ps > 0.f ? fast_rcp(ps) : 0.f;
            LDSP bf16_t* prow = Pc + (size_t)(hg * 64 + qw + fq * 4 + i) * NA_PCLD;
#pragma unroll
            for (int jt = 0; jt < 16; ++jt) if (jt * 16 < nk32) prow[jt * 16 + fr] = f2bf(s[jt][i] * inv);
        }
        wave_sync();
        const bf16_t* vt = wsp<bf16_t>(c, WS_VCMPT) + (size_t)(b * 2 + g) * 64 * NCMP_PAD;
        f32x4 oc[4];
#pragma unroll
        for (int et = 0; et < 4; ++et) oc[et] = (f32x4){0.f, 0.f, 0.f, 0.f};
        for (int k0 = 0; k0 < nk32; k0 += 32) {
            const bf16x8 pa = *(const LDSP bf16x8*)(Pc + (size_t)(hg * 64 + qw + fr) * NA_PCLD + k0 + fq * 8);
#pragma unroll
            for (int et = 0; et < 4; ++et) oc[et] = mfma16(pa, *(const bf16x8*)(vt + (size_t)(et * 16 + fr) * NCMP_PAD + k0 + fq * 8), oc[et]);
        }
        block_sync();
#pragma unroll
        for (int i = 0; i < 4; ++i) { const float gt = gates[(hg * 64 + qw + fq * 4 + i) * 3 + 0];
#pragma unroll
            for (int et = 0; et < 4; ++et) ofin[et][i] += gt * oc[et][i]; }
    }
    for (int e = c.tid; e < 4096; e += NTHR) { const int q = e >> 6, j = e & 63; float a = 0.f;
        if (j <= qt) {
#pragma unroll
            for (int dn = -1; dn <= 3; ++dn) { const int n = 4 * j + dn; if (n >= 0 && n < nkt * 16) a += bf2f(Pc[(size_t)q * NA_PCLD + n]) + bf2f(Pc[(size_t)(64 + q) * NA_PCLD + n]); }
            if (j == 0 || j == qt || j == qt - 1) a += 1000.f;
        } else a = NEG_BIG;
        imp[q * 65 + j] = a; }
    block_sync();
    for (int qq = 0; qq < 8; ++qq) { const int q = c.wave * 8 + qq; unsigned long long m = 0ull;
        if (qt < 16) m = (qt == 63) ? ~0ull : ((1ull << (qt + 1)) - 1ull);
        else { float v = imp[q * 65 + c.lane];
            for (int it = 0; it < 16; ++it) { const float mx = wave_max(v); const unsigned long long bal = ballot64(v == mx); const int first = __builtin_ctzll(bal);
                m |= 1ull << first; if (c.lane == first) v = -3.0e38f; } }
        if (c.lane == 0) selmask[q] = m; }
    block_sync();
    unsigned long long selm[4], um;
    { const unsigned long long mine = selmask[c.lane]; unsigned lo = (unsigned)mine, hi = (unsigned)(mine >> 32);
      lo |= (unsigned)xori<1>((int)lo); hi |= (unsigned)xori<1>((int)hi); lo |= (unsigned)xori<2>((int)lo); hi |= (unsigned)xori<2>((int)hi); lo |= (unsigned)xori<4>((int)lo); hi |= (unsigned)xori<4>((int)hi);
      lo |= (unsigned)xori<8>((int)lo); hi |= (unsigned)xori<8>((int)hi); lo |= (unsigned)xori<16>((int)lo); hi |= (unsigned)xori<16>((int)hi); lo |= (unsigned)xori<32>((int)lo); hi |= (unsigned)xori<32>((int)hi);
      um = ((unsigned long long)hi << 32) | lo;
#pragma unroll
      for (int i = 0; i < 4; ++i) selm[i] = selmask[qw + fq * 4 + i]; }
#pragma unroll
    for (int mode = 0; mode < 2; ++mode) {
        f32x4 oacc[4]; float mrun[4], lrun[4];
#pragma unroll
        for (int et = 0; et < 4; ++et) oacc[et] = (f32x4){0.f, 0.f, 0.f, 0.f};
#pragma unroll
        for (int i = 0; i < 4; ++i) { mrun[i] = NEG_BIG; lrun[i] = 0.f; }
        const int j0 = (mode == 0) ? 0 : (qt >= 8 ? qt - 8 : 0);
        for (int j = j0; j <= qt; ++j) {
            if (mode == 0 && !((um >> j) & 1ull)) continue;
            { const int key = c.tid >> 3, d0 = (c.tid & 7) * 8; const int tok = b * SEQ + j * 64 + key;
              *(LDSP u32x4*)(Kt + key * 72 + d0) = *(const u32x4*)(ksw + (size_t)tok * 256 + (mode * 2 + g) * 64 + d0);
              const u32x4 v = *(const u32x4*)(proj + (size_t)tok * PROJ_LD + (mode == 0 ? C_NVS : C_NVW) + g * 64 + d0);
              LDSP bf16_t* p = VT + d0 * 72 + key;
              p[0] = (bf16_t)(v.x & 0xffff); p[72] = (bf16_t)(v.x >> 16); p[144] = (bf16_t)(v.y & 0xffff); p[216] = (bf16_t)(v.y >> 16);
              p[288] = (bf16_t)(v.z & 0xffff); p[360] = (bf16_t)(v.z >> 16); p[432] = (bf16_t)(v.w & 0xffff); p[504] = (bf16_t)(v.w >> 16); }
            block_sync();
            if (mode == 0) nsa_key_block<0>(c, j, qt, qr, oacc, mrun, lrun, selm); else nsa_key_block<1>(c, j, qt, qr, oacc, mrun, lrun, selm);
            block_sync();
        }
#pragma unroll
        for (int i = 0; i < 4; ++i) { float ls = lrun[i]; ls += xorf<1>(ls); ls += xorf<2>(ls); ls += xorf<4>(ls); ls += xorf<8>(ls);
            const float sc = gates[(hg * 64 + qw + fq * 4 + i) * 3 + 1 + mode] * (ls > 0.f ? fast_rcp(ls) : 0.f);
#pragma unroll
            for (int et = 0; et < 4; ++et) ofin[et][i] += sc * oacc[et][i]; }
    }
    bf16_t* out = wsp<bf16_t>(c, WS_OUTS) + (size_t)2 * NT * MW;
#pragma unroll
    for (int i = 0; i < 4; ++i)
#pragma unroll
        for (int et = 0; et < 4; ++et) out[(size_t)(tokq0 + qw + fq * 4 + i) * MW + hd * 64 + et * 16 + fr] = f2bf(ofin[et][i]);
    block_sync();
}
constexpr int PEER_WSCR = (4 * 256 + 3 * 128) * 4;
constexpr int PEER_TAB = 8 * PEER_WSCR;
#ifndef HOST_EMU
DEV int uniform_i(int v) { return __builtin_amdgcn_readfirstlane(v); }
#else
static inline int uniform_i(int v) { return v; }
#endif
DEV unsigned sortkey16(unsigned b) { return (b & 0x8000u) ? (~b & 0xffffu) : (b | 0x8000u); }
DEV unsigned sortkey32(float f) { const unsigned u = __builtin_bit_cast(unsigned, f); return (u & 0x80000000u) ? ~u : (u | 0x80000000u); }
DEV float dot16_fp8(const float (&x)[16], const u32x4 q) {
    float s = 0.f;
#pragma unroll
    for (int i = 0; i < 4; ++i) { const f32x2 lo = cvt_pk_f32_fp8(q[i], false), hi = cvt_pk_f32_fp8(q[i], true);
        s += x[4 * i] * lo[0]; s += x[4 * i + 1] * lo[1]; s += x[4 * i + 2] * hi[0]; s += x[4 * i + 3] * hi[1]; }
    return s;
}
DEV void axpy16_fp8(float (&acc)[16], float w, const u32x4 q) {
#pragma unroll
    for (int i = 0; i < 4; ++i) { const f32x2 lo = cvt_pk_f32_fp8(q[i], false), hi = cvt_pk_f32_fp8(q[i], true);
        acc[4 * i] += w * lo[0]; acc[4 * i + 1] += w * lo[1]; acc[4 * i + 2] += w * hi[0]; acc[4 * i + 3] += w * hi[1]; }
}
DEV void peer_init_tab(const Ctx& c) {
    if (c.tid < 64) { const int t = c.tid; int a, b;
        if (t < 16) { a = 0; b = t; } else if (t < 24) { a = 1; b = t - 16; } else if (t < 29) { a = 2; b = t - 24; } else if (t < 33) { a = 3; b = t - 29; }
        else if (t < 36) { a = 4; b = t - 33; } else if (t < 42) { a = 5 + (t - 36) / 2; b = (t - 36) & 1; } else { a = 8 + (t - 42); b = 0; }
        ((LDSP unsigned char*)(c.lds + PEER_TAB))[t] = (t < 50) ? (unsigned char)((a << 4) | b) : (unsigned char)0xff; }
    block_sync();
}
DEV void peer_token(const Ctx& c, int l, int tok) {
    const int lane = c.lane;
    LDSP float* Wv = (LDSP float*)(c.lds + c.wave * PEER_WSCR); LDSP int* Wi = (LDSP int*)(Wv + 256); LDSP float* Sv = (LDSP float*)(Wi + 256); LDSP int* Si = (LDSP int*)(Sv + 256);
    LDSP int* We = Si + 256; LDSP float* Ws = (LDSP float*)(We + 128); LDSP float* Wg = Ws + 128;
    const bf16_t* sc = wsp<bf16_t>(c, WS_SCORES) + (size_t)tok * PEER_N;
    unsigned w[16];
#pragma unroll
    for (int gi = 0; gi < 16; ++gi) w[gi] = *(const unsigned*)(sc + gi * 128 + 2 * lane);
#pragma unroll
    for (int gi = 0; gi < 16; ++gi) {
        const unsigned k0 = sortkey16(w[gi] & 0xffffu), k1 = sortkey16(w[gi] >> 16);
        unsigned T = 0;
#pragma unroll
        for (int bit = 15; bit >= 0; --bit) { const unsigned cand = T | (1u << bit);
            const int cnt = __builtin_popcountll(ballot64(k0 >= cand)) + __builtin_popcountll(ballot64(k1 >= cand)); if (cnt >= 16) T = cand; }
        const unsigned long long gt0 = ballot64(k0 > T), gt1 = ballot64(k1 > T), eq0 = ballot64(k0 == T), eq1 = ballot64(k1 == T);
        const int need = 16 - __builtin_popcountll(gt0) - __builtin_popcountll(gt1);
        const int eqr0 = mbcnt64(eq0) + mbcnt64(eq1), eqr1 = eqr0 + (k0 == T ? 1 : 0);
        const bool sel0 = (k0 > T) || (k0 == T && eqr0 < need), sel1 = (k1 > T) || (k1 == T && eqr1 < need);
        const unsigned long long s0 = ballot64(sel0), s1 = ballot64(sel1);
        const int slot0 = mbcnt64(s0) + mbcnt64(s1), slot1 = slot0 + (sel0 ? 1 : 0);
        if (sel0) { Wv[gi * 16 + slot0] = bflo(w[gi]); Wi[gi * 16 + slot0] = 2 * lane; }
        if (sel1) { Wv[gi * 16 + slot1] = bfhi(w[gi]); Wi[gi * 16 + slot1] = 2 * lane + 1; }
    }
    wave_sync();
#pragma unroll
    for (int pass = 0; pass < 4; ++pass) { const int g = pass * 4 + (lane >> 4), e = lane & 15; const float v = Wv[g * 16 + e]; const int iv = Wi[g * 16 + e]; int rank = 0;
#pragma unroll
        for (int j = 0; j < 16; ++j) { const float vj = Wv[g * 16 + j]; const int ij = Wi[g * 16 + j]; rank += (vj > v || (vj == v && ij < iv)) ? 1 : 0; }
        Sv[g * 16 + rank] = v; Si[g * 16 + rank] = iv; }
    wave_sync();
    const unsigned ab = ((const LDSP unsigned char*)(c.lds + PEER_TAB))[lane]; const bool valid = ab != 0xffu; const int a = (ab >> 4) & 15, b = ab & 15;
    for (int h = 0; h < 8; ++h) {
        const float s = valid ? Sv[(2 * h) * 16 + a] + Sv[(2 * h + 1) * 16 + b] : -3.0e38f;
        const unsigned key = valid ? ((sortkey32(s) & 0xffffff00u) | (unsigned)(255 - (a * 16 + b))) : 0u;
        int rank = 0;
#pragma unroll
        for (int j = 0; j < 50; ++j) rank += ((unsigned)bcast_i((int)key, j) > key) ? 1 : 0;
        if (valid && rank < 16) { We[h * 16 + rank] = Si[(2 * h) * 16 + a] * 128 + Si[(2 * h + 1) * 16 + b]; Ws[h * 16 + rank] = s; }
    }
    wave_sync();
    { const float mx = Ws[(lane >> 3) * 16]; const float e0 = fast_exp(Ws[2 * lane] - mx), e1 = fast_exp(Ws[2 * lane + 1] - mx); float sm = e0 + e1;
      sm += xorf<1>(sm); sm += xorf<2>(sm); sm += xorf<4>(sm); const float inv = fast_rcp(sm); Wg[2 * lane] = e0 * inv; Wg[2 * lane + 1] = e1 * inv; }
    wave_sync();
    const bf16_t* xb = wsp<bf16_t>(c, WS_XB) + (size_t)tok * DM; const unsigned char* PU = wsp<unsigned char>(c, WS_PU); const unsigned char* PV = wsp<unsigned char>(c, WS_PV);
    float xf[16];
    { const u32x4 x0 = *(const u32x4*)(xb + 16 * lane), x1 = *(const u32x4*)(xb + 16 * lane + 8);
      xf[0] = bflo(x0.x); xf[1] = bfhi(x0.x); xf[2] = bflo(x0.y); xf[3] = bfhi(x0.y); xf[4] = bflo(x0.z); xf[5] = bfhi(x0.z); xf[6] = bflo(x0.w); xf[7] = bfhi(x0.w);
      xf[8] = bflo(x1.x); xf[9] = bfhi(x1.x); xf[10] = bflo(x1.y); xf[11] = bfhi(x1.y); xf[12] = bflo(x1.z); xf[13] = bfhi(x1.z); xf[14] = bflo(x1.w); xf[15] = bfhi(x1.w); }
    const float rstd = pg8::rstd_of(pg8::rss_slots16(wsp<float>(c, WS_RSS2) + (size_t)tok * 16)) * (1.0f / 256.0f);
    float acc[16];
#pragma unroll
    for (int j = 0; j < 16; ++j) acc[j] = 0.f;
    for (int h = 0; h < 8; ++h) {
        float part[16];
#pragma unroll
        for (int k = 0; k < 16; ++k) { const int e = uniform_i(We[h * 16 + k]); part[k] = dot16_fp8(xf, *(const u32x4*)(PU + (size_t)e * DM + 16 * lane)); }
        float p8[8], p4[4], p2[2], p1;
        { const bool up = (lane & 32) != 0;
#pragma unroll
          for (int i = 0; i < 8; ++i) { const float send = up ? part[i] : part[i + 8]; const float recv = xorf<32>(send); p8[i] = (up ? part[i + 8] : part[i]) + recv; } }
        { const bool up = (lane & 16) != 0;
#pragma unroll
          for (int i = 0; i < 4; ++i) { const float send = up ? p8[i] : p8[i + 4]; const float recv = xorf<16>(send); p4[i] = (up ? p8[i + 4] : p8[i]) + recv; } }
        { const bool up = (lane & 8) != 0;
#pragma unroll
          for (int i = 0; i < 2; ++i) { const float send = up ? p4[i] : p4[i + 2]; const float recv = xorf<8>(send); p2[i] = (up ? p4[i + 2] : p4[i]) + recv; } }
        { const bool up = (lane & 4) != 0; const float send = up ? p2[0] : p2[1]; const float recv = xorf<4>(send); p1 = (up ? p2[1] : p2[0]) + recv; }
        p1 += xorf<2>(p1); p1 += xorf<1>(p1);
        const float dk = shfl_f(p1, (lane & 15) * 4);
        const float wk = Wg[h * 16 + (lane & 15)] * gelu_erf(dk * rstd) * (1.0f / 16.0f);
#pragma unroll
        for (int k = 0; k < 16; ++k) { const int e = uniform_i(We[h * 16 + k]); const float wgt = bcast_f(wk, k); axpy16_fp8(acc, wgt, *(const u32x4*)(PV + (size_t)e * DM + 16 * lane)); }
    }
    float* orow = c.out + (size_t)tok * DM + 16 * lane; float ss = 0.f; f32x4 o[4];
#pragma unroll
    for (int j = 0; j < 4; ++j) { o[j] = *(const f32x4*)(orow + 4 * j); o[j] += (f32x4){acc[4 * j], acc[4 * j + 1], acc[4 * j + 2], acc[4 * j + 3]}; *(f32x4*)(orow + 4 * j) = o[j]; }
    if (l + 1 < DEPTH) {
        bf16_t* xo = wsp<bf16_t>(c, WS_XB) + (size_t)tok * DM + 16 * lane;
        u32x4 w0, w1; w0.x = pk2(o[0][0], o[0][1]); w0.y = pk2(o[0][2], o[0][3]); w0.z = pk2(o[1][0], o[1][1]); w0.w = pk2(o[1][2], o[1][3]);
        w1.x = pk2(o[2][0], o[2][1]); w1.y = pk2(o[2][2], o[2][3]); w1.z = pk2(o[3][0], o[3][1]); w1.w = pk2(o[3][2], o[3][3]);
        *(u32x4*)xo = w0; *(u32x4*)(xo + 8) = w1;
#pragma unroll
        for (int j = 0; j < 4; ++j) ss += (o[j][0] * o[j][0] + o[j][1] * o[j][1]) + (o[j][2] * o[j][2] + o[j][3] * o[j][3]);
        ss = wave_sum(ss);
        if (lane == 0) wsp<float>(c, WS_RSS1)[tok] = ss;
    }
    wave_sync();
}
DEV void peer_table_rows(const Ctx& c, int l) {
    const float* g2 = CIN(17) + (size_t)l * DM;
    const f32x4 ga = *((const f32x4*)g2 + 4 * c.lane), gb = *((const f32x4*)g2 + 4 * c.lane + 1), gc = *((const f32x4*)g2 + 4 * c.lane + 2), gd = *((const f32x4*)g2 + 4 * c.lane + 3);
    for (int r = c.bid * NWAVE + c.wave; r < 2 * 16384; r += c.nblk * NWAVE) {
        const int tab = r >> 14, e = r & 16383;
        const f32x4* src = (const f32x4*)((tab == 0 ? CIN(20) : CIN(21)) + ((size_t)l * 16384 + e) * DM) + 4 * c.lane;
        f32x4 v0 = src[0], v1 = src[1], v2 = src[2], v3 = src[3];
        if (tab == 0) { v0 *= ga * 256.0f; v1 *= gb * 256.0f; v2 *= gc * 256.0f; v3 *= gd * 256.0f; } else { v0 *= 16.0f; v1 *= 16.0f; v2 *= 16.0f; v3 *= 16.0f; }
        u32x4 q;
        q.x = cvt_pk_fp8_f32(v0[2], v0[3], cvt_pk_fp8_f32(v0[0], v0[1], 0u, false), true); q.y = cvt_pk_fp8_f32(v1[2], v1[3], cvt_pk_fp8_f32(v1[0], v1[1], 0u, false), true);
        q.z = cvt_pk_fp8_f32(v2[2], v2[3], cvt_pk_fp8_f32(v2[0], v2[1], 0u, false), true); q.w = cvt_pk_fp8_f32(v3[2], v3[3], cvt_pk_fp8_f32(v3[0], v3[1], 0u, false), true);
        *(u32x4*)(wsp<unsigned char>(c, tab == 0 ? WS_PU : WS_PV) + (size_t)e * DM + 16 * c.lane) = q;
    }
}
#ifndef HOST_EMU
#define XB_TMO      128
#define XB_XCNT(j)  (256  + 64 * (j))
#define XB_XSUB(j)  (1280 + 64 * (j))
#define XB_XGEN(j)  (2304 + 64 * (j))
#define XB_TOP      3328
#define XB_TOPGEN   3392
#define XCD_BAR_WORDS 3456
#define XB_SPIN_CAP (1u << 18)

__device__ __forceinline__ unsigned xb_ld(unsigned* p)              { return __hip_atomic_load(p, __ATOMIC_RELAXED, __HIP_MEMORY_SCOPE_AGENT); }
__device__ __forceinline__ unsigned xb_add(unsigned* p, unsigned v) { return __hip_atomic_fetch_add(p, v, __ATOMIC_RELAXED, __HIP_MEMORY_SCOPE_AGENT); }
__device__ __forceinline__ unsigned xb_xcc_id() { return (unsigned)__builtin_amdgcn_s_getreg((3 << 11) | 20) & 0xFu; }
#define XB_SPIN(cond, bar) do { unsigned _sp = 0; while (cond) { __builtin_amdgcn_s_sleep(1); \
    if ((++_sp & 255u) == 0u) { if (xb_ld(&(bar)[XB_TMO])) break; if (_sp > XB_SPIN_CAP) { atomicAdd(&(bar)[XB_TMO], 1u); break; } } } } while (0)

struct XcdBarrier {
    unsigned* bar; unsigned x;
    volatile __attribute__((address_space(3))) unsigned* st;
};

__device__ __forceinline__ XcdBarrier xcd_barrier_post(unsigned* bar, volatile __attribute__((address_space(3))) unsigned* st) {
    XcdBarrier b; b.bar = bar; b.x = xb_xcc_id(); b.st = st;
    if (threadIdx.x == 0) (void)xb_add(&bar[XB_XCNT(b.x)], 1u);
    return b;
}
__device__ __forceinline__ void xcd_barrier_complete(unsigned* bar, unsigned x, unsigned& nloc, unsigned& nx) {
    const unsigned G = gridDim.x * gridDim.y * gridDim.z;
    unsigned sum, cnt, mine, sp = 0u;
    for (;;) {
        sum = 0u; cnt = 0u; mine = 0u;
#pragma unroll
        for (unsigned j = 0; j < 16; ++j) { const unsigned c = xb_ld(&bar[XB_XCNT(j)]); sum += c; cnt += (c > 0u) ? 1u : 0u; mine = (j == x) ? c : mine; }
        if (sum == G) break;
        __builtin_amdgcn_s_sleep(1);
        if ((++sp & 255u) == 0u) { if (xb_ld(&bar[XB_TMO])) break; if (sp > XB_SPIN_CAP) { atomicAdd(&bar[XB_TMO], 1u); break; } }
    }
    nloc = mine > 0u ? mine : 1u; nx = cnt > 0u ? cnt : 1u;
}

__device__ __forceinline__ void xcd_barrier(const XcdBarrier& b) {
    asm volatile("s_waitcnt vmcnt(0)" ::: "memory");
    __syncthreads();
    if (threadIdx.x == 0) {
        unsigned* bar = b.bar;
        __builtin_amdgcn_s_waitcnt(0);
        unsigned nloc = b.st[0], nx = b.st[1];
        if (nloc == 0u) { xcd_barrier_complete(bar, b.x, nloc, nx); b.st[0] = nloc; b.st[1] = nx; }
        const unsigned old = xb_add(&bar[XB_XSUB(b.x)], 1u);
        const unsigned gen = old / nloc;
        if (old + 1u == (gen + 1u) * nloc) {
            __builtin_amdgcn_fence(__ATOMIC_RELEASE, "agent");
            asm volatile("s_waitcnt vmcnt(0)" ::: "memory");
            const unsigned og = xb_add(&bar[XB_TOP], 1u);
            const unsigned tg = og / nx;
            if (og + 1u == (tg + 1u) * nx) xb_add(&bar[XB_TOPGEN], 1u);
            else XB_SPIN(xb_ld(&bar[XB_TOPGEN]) == tg, bar);
            __builtin_amdgcn_fence(__ATOMIC_ACQUIRE, "agent");
            xb_add(&bar[XB_XGEN(b.x)], 1u);
            asm volatile("s_waitcnt vmcnt(0)" ::: "memory");
        } else {
            XB_SPIN(xb_ld(&bar[XB_XGEN(b.x)]) == gen, bar);
            __builtin_amdgcn_fence(__ATOMIC_ACQUIRE, "agent");
            asm volatile("s_waitcnt vmcnt(0)" ::: "memory");
        }
    }
    __syncthreads();
}


#endif
#ifndef DUP_NSA
#define DUP_NSA 1
#endif
#ifndef DUP_REC
#define DUP_REC 1
#endif
#ifndef DUP_P5
#define DUP_P5 1
#endif
#ifndef DUP_P2
#define DUP_P2 1
#endif
#ifndef HOST_EMU
#define GRID_SYNC() do { if (ph == 1) cg::this_grid().sync(); else { XcdBarrier xb_; xb_.bar = (unsigned*)(lds_ptr_entry(22) + WS_BARRIER); xb_.x = xb_xcc_id(); \
    xb_.st = (volatile __attribute__((address_space(3))) unsigned*)(smem_raw + LDS_PTRS + 192); xcd_barrier(xb_); } } while (0)
#else
#define GRID_SYNC() grid_sync_impl()
#endif

#ifndef HOST_EMU
DEV unsigned char* lds_ptr_entry(int i) {
    int z; asm volatile("s_mov_b32 %0, 0" : "=s"(z)); i += z;
    const unsigned long long v = ((volatile LDSP unsigned long long*)((LDSP unsigned char*)smem_raw + LDS_PTRS))[i];
    const unsigned lo = __builtin_amdgcn_readfirstlane((unsigned)v), hi = __builtin_amdgcn_readfirstlane((unsigned)(v >> 32));
    return (unsigned char*)(__attribute__((address_space(1))) unsigned char*)(((unsigned long long)hi << 32) | lo);
}
#endif
DEV Ctx make_ctx(const Params& p, int wave0) {
#ifndef HOST_EMU
    Ctx c; c.out = p.out; c.ws = p.ws; c.tid = wave0 * 64 + fresh_lane();
#else
    Ctx c; c.out = p.out; c.ws = p.ws; c.tid = TID();
#endif
    c.bid = BID(); c.nblk = NBLK(); int z = 0;
#ifndef HOST_EMU
    asm volatile("" : "+v"(c.tid), "+s"(c.bid), "+s"(c.nblk));
    asm volatile("s_mov_b32 %0, 0" : "=s"(z));
    c.ws = lds_ptr_entry(22); c.out = (float*)lds_ptr_entry(23);
#endif
    c.lds = SMEM_PTR() + z; c.lane = c.tid & 63; c.wave = c.tid >> 6;
#ifndef HOST_EMU
    c.wave = __builtin_amdgcn_readfirstlane(c.wave);
#endif
    return c;
}
#ifndef HOST_EMU
__global__ void __launch_bounds__(NTHR, 2) fwd_kernel(Params p)
#else
void fwd_kernel(Params p)
#endif
{
    {
        LDSP char* lds0 = SMEM_PTR();
        if (TID() == 0) {
#pragma unroll
            for (int i = 0; i < 22; ++i) ((LDSP unsigned long long*)(lds0 + LDS_PTRS))[i] = (unsigned long long)p.in[i];
            ((LDSP unsigned long long*)(lds0 + LDS_PTRS))[22] = (unsigned long long)p.ws; ((LDSP unsigned long long*)(lds0 + LDS_PTRS))[23] = (unsigned long long)p.out;
        }
        block_sync();
    }
#ifndef HOST_EMU
    const int wave0 = __builtin_amdgcn_readfirstlane((int)threadIdx.x >> 6);
#else
    const int wave0 = 0;
#endif
#ifndef HOST_EMU
    volatile __attribute__((address_space(3))) unsigned* xst = (volatile __attribute__((address_space(3))) unsigned*)(smem_raw + LDS_PTRS + 192);
    if (threadIdx.x == 0) { xst[0] = 0u; xst[1] = 0u; }
    __syncthreads();
    (void)xcd_barrier_post((unsigned*)(p.ws + WS_BARRIER), xst);
#endif
    int ph = 0;
#define PHASE_END() do { ++ph; if (ph >= p.phase_hi) return; GRID_SYNC(); } while (0)
    for (int l = 0; l < DEPTH; ++l) {
        { Ctx c = make_ctx(p, wave0); p0_prep(c, l); }
        PHASE_END();
        {
            Ctx c = make_ctx(p, wave0);
            pg8::Gemm g{wsp<bf16_t>(c, WS_XB), wsp<bf16_t>(c, WS_WIN), NT, PROJ_N, DM}; pg8::StaticOrder S; S.init(NT, PROJ_N, c.nblk, c.bid);
            pg8::EpiScaleBf16<1> E{wsp<bf16_t>(c, WS_PROJ), PROJ_LD, wsp<float>(c, WS_RSS1), PROJ_LD};
            pg8::gemm_phase<pg8::EpiScaleBf16<1>, pg8::StaticOrder, true, true>(GEMM_LDS, g, S, E, c.tid);
        }
        PHASE_END();
        for (int rep = 0; rep < DUP_P2; ++rep) { Ctx c = make_ctx(p, wave0); for (int u = c.bid; u < 3 * BATCH * NH * NC; u += c.nblk) recur_local_unit(c, l, u); }
        { Ctx c = make_ctx(p, wave0); for (int u = c.bid; u < BATCH * 8; u += c.nblk) nsa_compress_unit(c, l, u); }
        { Ctx c = make_ctx(p, wave0); for (int it = c.bid; it < NT / 4; it += c.nblk) nsa_kprep_item(c, l, it); }
        PHASE_END();
        { Ctx c = make_ctx(p, wave0); recur_scan(c); }
        PHASE_END();
        for (int rep = 0; rep < DUP_NSA; ++rep) { Ctx c = make_ctx(p, wave0);
        for (int u = c.bid; u < BATCH * 2 * NSEL; u += c.nblk) {
            const int nbg = BATCH * 2, bg = u % nbg, qi = u / nbg; int qt = qi;
            if (NSEL == 64) { const int r = qi >> 4, ql = qi & 15; qt = (r == 0) ? 63 - ql : (r == 1) ? ql : (r == 2) ? 47 - ql : 16 + ql; }
            nsa_attn_unit(c, l, bg * NSEL + qt);
        } }
        for (int rep = 0; rep < DUP_REC; ++rep) { Ctx c = make_ctx(p, wave0); for (int u = c.bid; u < 3 * BATCH * NH * NC; u += c.nblk) recur_out_unit(c, l, u); }
        PHASE_END();
        { Ctx c = make_ctx(p, wave0); peer_table_rows(c, l); }
        for (int rep = 0; rep < DUP_P5; ++rep) {
            for (int m = 0; m < 4; ++m) {
                { Ctx c = make_ctx(p, wave0); pg8::TileOrder S{(NT / 256) * 4, c.nblk, c.bid}; pg8::Gemm g{wsp<bf16_t>(c, WS_OUTS) + (size_t)m * NT * MW, wsp<bf16_t>(c, WS_WUP) + (size_t)m * DM * MW, NT, DM, MW};
                  pg8::EpiU E{wsp<bf16_t>(c, WS_USCR)};
                  pg8::gemm_phase<pg8::EpiU, pg8::TileOrder, false, true>(GEMM_LDS, g, S, E, c.tid); }
                { Ctx c = make_ctx(p, wave0); pg8::TileOrder S{(NT / 256) * 4, c.nblk, c.bid}; pg8::Gemm g{wsp<bf16_t>(c, WS_XB), wsp<bf16_t>(c, WS_WG) + (size_t)m * DM * DM, NT, DM, DM};
                  pg8::EpiGate E{wsp<bf16_t>(c, WS_USCR), wsp<bf16_t>(c, WS_MERGED), wsp<float>(c, WS_RSS1), m == 0 ? 1 : 0};
                  pg8::gemm_phase<pg8::EpiGate, pg8::TileOrder, false, true>(GEMM_LDS, g, S, E, c.tid); }
            }
        }
        PHASE_END();
        {
            Ctx c = make_ctx(p, wave0); const float* xres = (l == 0) ? CIN(0) : c.out;
            pg8::Gemm g{wsp<bf16_t>(c, WS_MERGED), wsp<bf16_t>(c, WS_WOUT), NT, DM, DM}; pg8::StaticOrder S; S.init(NT, DM, c.nblk, c.bid);
            pg8::EpiOut E{xres, c.out, wsp<bf16_t>(c, WS_XB), wsp<float>(c, WS_RSS2)};
            pg8::gemm_phase<pg8::EpiOut, pg8::StaticOrder, true, true>(GEMM_LDS, g, S, E, c.tid);
        }
        PHASE_END();
        {
            Ctx c = make_ctx(p, wave0);
            pg8::Gemm g{wsp<bf16_t>(c, WS_XB), wsp<bf16_t>(c, WS_WQ2), NT, PEER_N, DM}; pg8::StaticOrder S; S.init(NT, PEER_N, c.nblk, c.bid);
            pg8::EpiScaleBf16<16> E{wsp<bf16_t>(c, WS_SCORES), PEER_N, wsp<float>(c, WS_RSS2), PEER_N};
            pg8::gemm_phase<pg8::EpiScaleBf16<16>, pg8::StaticOrder, true, true>(GEMM_LDS, g, S, E, c.tid);
        }
        PHASE_END();
        { Ctx c = make_ctx(p, wave0); peer_init_tab(c); for (int t = c.bid * NWAVE + c.wave; t < NT; t += c.nblk * NWAVE) peer_token(c, l, t); }
        PHASE_END();
    }
}

#ifndef HOST_EMU
extern "C" void kernel_launch(void* const* d_in, const int* in_sizes, int n_in, void* d_out, int out_size, void* d_ws, size_t ws_size, hipStream_t stream) {
    static int grid = 0;
    if (grid == 0) {
        if (n_in != 22 || out_size != NT * DM || ws_size < WS_NEED) { fprintf(stderr, "kernel_launch: unexpected shapes (n_in %d out %d ws %zu need %zu)\n", n_in, out_size, ws_size, (size_t)WS_NEED); grid = -1; return; }
        int dev = 0, cus = 0, per_cu = 0;
        hipGetDevice(&dev); hipDeviceGetAttribute(&cus, hipDeviceAttributeMultiprocessorCount, dev);
        if (hipFuncSetAttribute((const void*)fwd_kernel, hipFuncAttributeMaxDynamicSharedMemorySize, LDS_BYTES) != hipSuccess) { fprintf(stderr, "kernel_launch: hipFuncSetAttribute failed\n"); grid = -1; return; }
        if (hipOccupancyMaxActiveBlocksPerMultiprocessor(&per_cu, (const void*)fwd_kernel, NTHR, LDS_BYTES) != hipSuccess || per_cu < 1) { fprintf(stderr, "kernel_launch: occupancy query failed (%d)\n", per_cu); (void)hipGetLastError(); per_cu = 1; }
        grid = cus;
        fprintf(stderr, "kernel_launch: grid %d (per_cu %d)\n", grid, per_cu);
    }
    if (grid < 0) return;
    if (hipMemsetAsync((char*)d_ws + WS_BARRIER, 0, 16384, stream) != hipSuccess) { fprintf(stderr, "kernel_launch: memset failed\n"); return; }
    Params p{};
    for (int i = 0; i < 22; ++i) p.in[i] = (const float*)d_in[i];
    p.out = (float*)d_out; p.ws = (unsigned char*)d_ws; p.phase_lo = 0; p.phase_hi = 1 << 20;
    void* args[] = {&p};
    hipError_t e = hipLaunchCooperativeKernel((const void*)fwd_kernel, dim3(grid), dim3(NTHR), args, LDS_BYTES, stream);
    if (e != hipSuccess) fprintf(stderr, "kernel_launch: cooperative launch failed: %s (grid %d)\n", hipGetErrorString(e), grid);
}
#endif
```

```cpp
#ifndef HOST_EMU
#include <hip/hip_runtime.h>
#include <hip/hip_cooperative_groups.h>
#include <cstdio>
#include <cstdint>
namespace cg = cooperative_groups;
#endif

#ifndef CFG_B
#define CFG_B 8
#endif
#ifndef CFG_S
#define CFG_S 4096
#endif

constexpr int BATCH = CFG_B, SEQ = CFG_S, DM = 1024, DEPTH = 2;
constexpr int NT = BATCH * SEQ;
constexpr int NH = 4, HD = 64, MW = 256, CH = 64, NC = SEQ / CH;
constexpr int N_IN_ORIG = 4116, PROJ_N = 4352, PROJ_LD = 4128;
constexpr int NCMP = (SEQ - 32) / 16 + 1;
constexpr int NCMP_PAD = SEQ / 16;
constexpr int NSEL = SEQ / 64;
constexpr int PEER_N = 2048;
constexpr float NORM_EPS = 1e-6f;
constexpr int NTHR = 512, NWAVE = 8;
constexpr int C_HQ = 0, C_HF = 256, C_HI = 512, C_HG = 768;
constexpr int C_MQ = 1024, C_MK = 1280, C_MV = 1536, C_MO = 1792;
constexpr int C_NQ = 2048, C_NKC = 2304, C_NVC = 2432, C_NKS = 2560, C_NVS = 2688, C_NKW = 2816, C_NVW = 2944;
constexpr int C_RQ = 3072, C_RK = 3328, C_RV = 3584, C_RG = 3840;
constexpr int C_MI = 4096, C_MF = 4100, C_NG = 4104;

typedef unsigned short bf16_t;
#ifndef HOST_EMU
typedef short bf16x8 __attribute__((ext_vector_type(8)));
typedef float f32x4 __attribute__((ext_vector_type(4)));
#endif
typedef unsigned u32x4 __attribute__((ext_vector_type(4)));
typedef unsigned u32x2 __attribute__((ext_vector_type(2)));
typedef float f32x2 __attribute__((ext_vector_type(2)));

constexpr size_t al256(size_t x) { return (x + 255) & ~(size_t)255; }
constexpr size_t WS_WIN = 0;
constexpr size_t WS_WG = WS_WIN + al256((size_t)PROJ_N * DM * 2);
constexpr size_t WS_WUP = WS_WG + al256((size_t)4 * DM * DM * 2);
constexpr size_t WS_WOUT = WS_WUP + al256((size_t)4 * DM * MW * 2);
constexpr size_t WS_WQ2 = WS_WOUT + al256((size_t)DM * DM * 2);
constexpr size_t WS_WCT = WS_WQ2 + al256((size_t)PEER_N * DM * 2);
constexpr size_t WS_CBIAS = WS_WCT + al256((size_t)2 * 64 * 2048 * 2);
constexpr size_t WS_ROPE = WS_CBIAS + 1024;
constexpr size_t WS_RSS1 = WS_ROPE + al256((size_t)SEQ * 64 * 4);
constexpr size_t WS_RSS2 = WS_RSS1 + al256((size_t)NT * 4);
constexpr size_t WS_XB = WS_RSS2 + al256((size_t)NT * 16 * 4);
constexpr size_t WS_OUTS = WS_XB + al256((size_t)NT * DM * 2);
constexpr size_t WS_ST = WS_OUTS + al256((size_t)NT * DM * 2);
constexpr size_t ST_ONE = (size_t)BATCH * NH * NC * 4096 * 2;
constexpr size_t WS_GDEC = WS_ST + al256(3 * ST_ONE);
constexpr size_t WS_MNL = WS_GDEC + al256((size_t)BATCH * NH * NC * 64 * 4);
constexpr size_t WS_MSC = WS_MNL + al256((size_t)BATCH * NH * NC * 64 * 4);
constexpr size_t WS_KCMP = WS_MSC + al256((size_t)BATCH * NH * NC * 4 * 4);
constexpr size_t WS_VCMPT = WS_KCMP + al256((size_t)BATCH * 2 * NCMP_PAD * 64 * 2);
constexpr size_t WS_KSW = WS_VCMPT + al256((size_t)BATCH * 2 * NCMP_PAD * 64 * 2);
constexpr size_t WS_HALO = WS_KSW + al256((size_t)NT * 256 * 2);
constexpr size_t WS_MTS = WS_HALO + al256((size_t)BATCH * NC * 3 * 512 * 2);
constexpr size_t WS_G31 = WS_MTS + al256((size_t)NT * NH * 2 * 4);
constexpr size_t WS_PROJ = WS_G31 + al256((size_t)BATCH * NH * NC * 64 * 4);
constexpr size_t PROJ_BYTES = al256((size_t)NT * PROJ_LD * 2);
constexpr size_t WS_BARRIER = WS_PROJ + PROJ_BYTES;
constexpr size_t WS_END = WS_BARRIER + 16384;
constexpr size_t WS_UALL = WS_PROJ;
constexpr size_t WS_MERGED = WS_OUTS;
constexpr size_t WS_SCORES = WS_PROJ;
constexpr bool TABLES_IN_ST = 3 * ST_ONE >= (size_t)2 * 16384 * DM;
constexpr size_t WS_PU = TABLES_IN_ST ? WS_ST : WS_END;
constexpr size_t WS_PV = WS_PU + al256((size_t)16384 * DM);
static_assert((size_t)4 * NT * DM * 2 <= PROJ_BYTES, "U fits the proj region");
static_assert(WS_END <= (size_t)536870912, "workspace budget");
constexpr size_t WS_NEED = TABLES_IN_ST ? WS_END : WS_PV + (size_t)16384 * DM;

constexpr int LDS_BYTES = 147456;

struct Params {
    const float* in[22];
    float* out;
    unsigned char* ws;
    int phase_lo, phase_hi;
};

#ifndef HOST_EMU
#define DEV __device__ __forceinline__
#define TID() ((int)threadIdx.x)
#define BID() ((int)blockIdx.x)
#define NBLK() ((int)gridDim.x)
extern __shared__ __attribute__((aligned(16))) unsigned char smem_raw[];
#define LDSP __attribute__((address_space(3)))
#define SMEM_PTR() ((LDSP char*)smem_raw)
DEV void block_sync() { __syncthreads(); }
DEV int fresh_lane() { int lane; asm volatile("v_mbcnt_lo_u32_b32 %0, -1, 0\n\tv_mbcnt_hi_u32_b32 %0, -1, %0" : "=v"(lane)); return lane; }
template <int M> DEV int xori(int v) {
    if constexpr (M < 32) return __builtin_amdgcn_ds_swizzle(v, (M << 10) | 0x1f);
    else return __builtin_amdgcn_ds_bpermute((fresh_lane() ^ M) << 2, v);
}
template <int M> DEV float xorf(float v) { return __builtin_bit_cast(float, xori<M>(__builtin_bit_cast(int, v))); }
DEV int shfl_i(int v, int src) { return __builtin_amdgcn_ds_bpermute(src << 2, v); }
DEV float shfl_f(float v, int src) { return __builtin_bit_cast(float, __builtin_amdgcn_ds_bpermute(src << 2, __builtin_bit_cast(int, v))); }
DEV unsigned long long ballot64(bool p) { return __builtin_amdgcn_ballot_w64(p); }
DEV int mbcnt64(unsigned long long m) { return (int)__builtin_amdgcn_mbcnt_hi((unsigned)(m >> 32), __builtin_amdgcn_mbcnt_lo((unsigned)m, 0u)); }
DEV float bcast_f(float v, int j) { return __builtin_bit_cast(float, __builtin_amdgcn_readlane(__builtin_bit_cast(int, v), j)); }
DEV int bcast_i(int v, int j) { return __builtin_amdgcn_readlane(v, j); }
DEV f32x2 cvt_pk_f32_fp8(unsigned p, bool hi) { return hi ? __builtin_amdgcn_cvt_pk_f32_fp8((int)p, true) : __builtin_amdgcn_cvt_pk_f32_fp8((int)p, false); }
DEV unsigned cvt_pk_fp8_f32(float a, float b, unsigned old, bool hi) { return hi ? (unsigned)__builtin_amdgcn_cvt_pk_fp8_f32(a, b, (int)old, true) : (unsigned)__builtin_amdgcn_cvt_pk_fp8_f32(a, b, (int)old, false); }
DEV f32x4 mfma16(bf16x8 a, bf16x8 b, f32x4 c) { return __builtin_amdgcn_mfma_f32_16x16x32_bf16(a, b, c, 0, 0, 0); }
DEV void atomic_add_f32(float* p, float v) { atomicAdd(p, v); }
DEV float fast_exp(float x) { return __expf(x); }
DEV float fast_exp2(float x) { return __builtin_amdgcn_exp2f(x); }
DEV float fast_log(float x) { return __logf(x); }
DEV float fast_rcp(float x) { return __builtin_amdgcn_rcpf(x); }
DEV float fast_rsqrt(float x) { return __builtin_amdgcn_rsqf(x); }
#else
#define DEV static inline
#define LDSP
#endif

DEV float bf2f(bf16_t v) { unsigned u = ((unsigned)v) << 16; return __builtin_bit_cast(float, u); }
DEV bf16_t f2bf(float f) { unsigned u = __builtin_bit_cast(unsigned, f); return (bf16_t)((u + 0x7fffu + ((u >> 16) & 1u)) >> 16); }
#ifndef HOST_EMU
typedef __bf16 bf16x2_hw __attribute__((ext_vector_type(2)));
DEV unsigned pk2(float lo, float hi) { const f32x2 v = {lo, hi}; return __builtin_bit_cast(unsigned, __builtin_convertvector(v, bf16x2_hw)); }
#else
DEV unsigned pk2(float lo, float hi) { return (unsigned)f2bf(lo) | ((unsigned)f2bf(hi) << 16); }
#endif
DEV float bflo(unsigned u) { return __builtin_bit_cast(float, u << 16); }
DEV float bfhi(unsigned u) { return __builtin_bit_cast(float, u & 0xffff0000u); }
DEV float sigmoidf_(float x) { return fast_rcp(1.0f + fast_exp(-x)); }
DEV float siluf_(float x) { return x * sigmoidf_(x); }
DEV float log_sigmoidf_(float x) { return fminf(x, 0.f) - log1pf(fast_exp(-fabsf(x))); }
DEV unsigned sortkey32(float f) { const unsigned u = __builtin_bit_cast(unsigned, f); return (u & 0x80000000u) ? ~u : (u | 0x80000000u); }
DEV float wave_sum(float v) { v += xorf<1>(v); v += xorf<2>(v); v += xorf<4>(v); v += xorf<8>(v); v += xorf<16>(v); v += xorf<32>(v); return v; }
DEV float wave_max(float v) { v = fmaxf(v, xorf<1>(v)); v = fmaxf(v, xorf<2>(v)); v = fmaxf(v, xorf<4>(v)); v = fmaxf(v, xorf<8>(v)); v = fmaxf(v, xorf<16>(v)); v = fmaxf(v, xorf<32>(v)); return v; }
DEV float gelu_erf(float v) {
    const float av = fabsf(v), t = fast_rcp(1.0f + 0.2316418882f * av);
    float q = t * 0.5307027145f + (-0.7265760135f); q = q * t + 0.7107068705f; q = q * t + (-0.142248368f); q = q * t + 0.127414796f; q = q * t;
    const float e = fast_exp2(v * v * (-0.72134752044f));
    const float m = v * (q * e);
    return v < 0.f ? m : v - m;
}
#ifndef HOST_EMU
#define DEV_M __device__ __forceinline__
#else
#define DEV_M inline
#endif
namespace pg8 {
#define PG8_LAS __attribute__((address_space(3)))
constexpr int BM = 256, BK = 64, HALF = 128, HTB = HALF * BK * 2  , STAGE_BYTES = 8 * HTB, NXCD = 8, WGM = 8;

__host__ __device__ __forceinline__ int lds_byte(int r, int c) { const int st = (r >> 4) * 2 + (c >> 5), rr = r & 15, cc = c & 31, ob = rr * 64 + cc * 2; return st * 1024 + (ob ^ (((ob >> 9) & 1) << 5)); }
__host__ __device__ __forceinline__ void stage_rc(int b, int& R, int& C) { const int st = b / 1024, sb = b % 1024, swz = sb ^ (((sb >> 9) & 1) << 5); R = (st >> 1) * 16 + swz / 64; C = (st & 1) * 32 + (swz % 64) / 2; }
__host__ __device__ __forceinline__ int perm32(int rho) { const int n = rho >> 4, i = rho & 15; return 8 * (i >> 2) + 4 * n + (i & 3); }

struct Unit { int pm, pn; };
struct Gemm { const bf16_t* A; const bf16_t* Bt; int M, N, K; };

struct StaticOrder {
    int nM, nN, nwg, G, c;
    __host__ __device__ void init(int M, int N, int G_, int c_) { nM = M / BM; nN = N / BM; nwg = nM * nN; G = G_; c = c_; }
    __host__ __device__ bool next(int i, Unit& u) const {
        const long L = (long)i * G + c; if (L >= nwg) return false;
        int wgid = (int)L; { const int q = nwg / NXCD, r = nwg % NXCD, xcd = wgid % NXCD, off = wgid / NXCD; wgid = (xcd < r ? xcd * (q + 1) : r * (q + 1) + (xcd - r) * q) + off; }
        const int nig = WGM * nN, gid = wgid / nig, fm = gid * WGM, gsz = (nM - fm) < WGM ? (nM - fm) : WGM;
        u.pm = fm + ((wgid % nig) % gsz); u.pn = (wgid % nig) / gsz; return true;
    }
    DEV_M void a_ready(const Unit&) const {}
    DEV_M void done(const Unit&) const {}
};


#ifndef HOST_EMU
template <class Epi, class Sched, bool ALIGN_EPI = false, bool SP2 = false>
__device__ __forceinline__ void gemm_phase(PG8_LAS unsigned char* lds, const Gemm g, const Sched& S, const Epi& E, const int tid_in) {
    const int tid = tid_in, wid = __builtin_amdgcn_readfirstlane(tid >> 6), lane = tid & 63, wr = wid >> 2, wc = wid & 3, fr = lane & 15, fq = lane >> 4;
    const int K = g.K, nt = K / BK;
    unsigned voffA[2], voffB[2];
#pragma unroll
    for (int i = 0; i < 2; ++i) { int R, C; stage_rc(tid * 16 + i * 8192, R, C); const int Rb = Epi::PERM ? ((R & ~31) + perm32(R & 31)) : R;
        voffA[i] = (unsigned)(R * K + C) * 2u; voffB[i] = (unsigned)(Rb * K + C) * 2u; }
    const size_t kstep = (size_t)(BK * 2);
    const size_t hstep = (size_t)HALF * K * 2;
    const size_t tstep = 2 * hstep;
    const unsigned ldsw = (unsigned)wid * 1024u;
    const int aoff = lds_byte(wr * 64 + fr, fq * 8), boff = lds_byte(wc * 32 + fr, fq * 8);
#define PG8_SA(b, h) (((b) * 2 + (h)) * HTB)
#define PG8_SB(b, h) ((4 + (b) * 2 + (h)) * HTB)
#define PG8_STAGE(bufoff, gbase, voff) do { _Pragma("unroll") for (int _i = 0; _i < 2; ++_i) \
        __builtin_amdgcn_global_load_lds((const unsigned*)((const char*)(gbase) + (voff)[_i]), (PG8_LAS unsigned*)(lds + (bufoff) + ldsw + _i * 8192), 16, 0, 0); } while (0)
#define PG8_LDA(dst, b, h) do { _Pragma("unroll") for (int m = 0; m < 4; ++m) _Pragma("unroll") for (int k = 0; k < 2; ++k) dst[m][k] = *(const PG8_LAS bf16x8*)(lds + PG8_SA(b, h) + aoff + m * 2048 + k * 1024); } while (0)
#define PG8_LDB(dst, b, h) do { _Pragma("unroll") for (int n = 0; n < 2; ++n) _Pragma("unroll") for (int k = 0; k < 2; ++k) dst[n][k] = *(const PG8_LAS bf16x8*)(lds + PG8_SB(b, h) + boff + n * 2048 + k * 1024); } while (0)
#define PG8_MMA(ai, bj, At, Bt) do { __builtin_amdgcn_s_setprio(1); _Pragma("unroll") for (int m = 0; m < 4; ++m) _Pragma("unroll") for (int n = 0; n < 2; ++n) _Pragma("unroll") for (int k = 0; k < 2; ++k) \
        acc[ai][bj][m][n] = __builtin_amdgcn_mfma_f32_16x16x32_bf16(Bt[n][k], At[m][k], acc[ai][bj][m][n], 0, 0, 0); __builtin_amdgcn_s_setprio(0); } while (0)
#define PG8_WAIT_V(n) asm volatile("s_waitcnt vmcnt(" #n ")" ::: "memory")
#define PG8_WAIT_L(n) asm volatile("s_waitcnt lgkmcnt(" #n ")" ::: "memory")
#define PG8_BAR __builtin_amdgcn_s_barrier()
#define PG8_SCHED __builtin_amdgcn_sched_barrier(0)
    Unit cur, nxt; int ui = 0;
    if (!S.next(0, cur)) return;
    f32x4 acc[2][2][4][2];
#pragma unroll
    for (int a = 0; a < 2; ++a)
#pragma unroll
        for (int b = 0; b < 2; ++b)
#pragma unroll
            for (int m = 0; m < 4; ++m)
#pragma unroll
                for (int n = 0; n < 2; ++n) acc[a][b][m][n] = (f32x4){0.f, 0.f, 0.f, 0.f};
    bf16x8 At[4][2], B0[2][2], B1[2][2];
    const char* cA = (const char*)g.A + (size_t)cur.pm * tstep; const char* cB = (const char*)g.Bt + (size_t)cur.pn * tstep;
    S.a_ready(cur);
    if constexpr (SP2) {
        PG8_STAGE(PG8_SB(0, 0), cB, voffB); PG8_STAGE(PG8_SB(0, 1), cB + hstep, voffB); PG8_STAGE(PG8_SA(0, 0), cA, voffA); PG8_STAGE(PG8_SA(0, 1), cA + hstep, voffA);
        if (wr == 1) PG8_BAR;
        PG8_WAIT_V(2); PG8_BAR;
        PG8_STAGE(PG8_SB(1, 0), cB + kstep, voffB); PG8_STAGE(PG8_SA(1, 0), cA + kstep, voffA); PG8_STAGE(PG8_SB(1, 1), cB + hstep + kstep, voffB);
        PG8_WAIT_V(6); PG8_BAR;
    } else {
        PG8_STAGE(PG8_SB(0, 0), cB, voffB); PG8_STAGE(PG8_SA(0, 0), cA, voffA); PG8_STAGE(PG8_SB(0, 1), cB + hstep, voffB); PG8_STAGE(PG8_SA(0, 1), cA + hstep, voffA);
        if (wr == 1) PG8_BAR;
        PG8_WAIT_V(4); PG8_BAR;
        PG8_STAGE(PG8_SB(1, 0), cB + kstep, voffB); PG8_STAGE(PG8_SA(1, 0), cA + kstep, voffA); PG8_STAGE(PG8_SB(1, 1), cB + hstep + kstep, voffB);
        PG8_WAIT_V(6); PG8_BAR;
    }
    for (;;) {
        const bool has_next = S.next(ui + 1, nxt);
        const char* nA = has_next ? (const char*)g.A + (size_t)nxt.pm * tstep : cA; const char* nB = has_next ? (const char*)g.Bt + (size_t)nxt.pn * tstep : cB;
        for (int t = 0; t < nt; t += 2) {
            const bool last = (t == nt - 2);
            const char* a1 = cA + (size_t)(t + 1) * kstep;
            const char* a2 = last ? nA : cA + (size_t)(t + 2) * kstep; const char* b2 = last ? nB : cB + (size_t)(t + 2) * kstep;
            const char* a3 = a2 + kstep; const char* b3 = b2 + kstep;
            if (last && has_next) S.a_ready(nxt);
            if constexpr (SP2) {
            PG8_LDB(B0, 0, 0); PG8_LDB(B1, 0, 1); PG8_SCHED; PG8_LDA(At, 0, 0); PG8_STAGE(PG8_SA(1, 1), a1 + hstep, voffA);
            PG8_WAIT_V(8); PG8_WAIT_L(0); PG8_BAR; PG8_MMA(0, 0, At, B0); PG8_MMA(0, 1, At, B1); PG8_BAR; PG8_SCHED;
            PG8_LDA(At, 0, 1); PG8_STAGE(PG8_SB(0, 0), b2, voffB); PG8_STAGE(PG8_SB(0, 1), b2 + hstep, voffB); PG8_STAGE(PG8_SA(0, 0), a2, voffA);
            PG8_WAIT_V(8); PG8_WAIT_L(0); PG8_BAR; PG8_MMA(1, 0, At, B0); PG8_MMA(1, 1, At, B1); PG8_BAR; PG8_SCHED;
            PG8_LDB(B0, 1, 0); PG8_LDB(B1, 1, 1); PG8_SCHED; PG8_LDA(At, 1, 0); PG8_STAGE(PG8_SA(0, 1), a2 + hstep, voffA);
            PG8_WAIT_V(8); PG8_WAIT_L(0); PG8_BAR; PG8_MMA(0, 0, At, B0); PG8_MMA(0, 1, At, B1); PG8_BAR; PG8_SCHED;
            PG8_LDA(At, 1, 1); PG8_STAGE(PG8_SB(1, 0), b3, voffB); PG8_STAGE(PG8_SB(1, 1), b3 + hstep, voffB); PG8_STAGE(PG8_SA(1, 0), a3, voffA);
            PG8_WAIT_V(8); PG8_WAIT_L(0); PG8_BAR; PG8_MMA(1, 0, At, B0); PG8_MMA(1, 1, At, B1); PG8_BAR; PG8_SCHED;
            } else {
            PG8_LDB(B0, 0, 0); PG8_SCHED; PG8_LDA(At, 0, 0); PG8_STAGE(PG8_SA(1, 1), a1 + hstep, voffA);
            PG8_WAIT_L(8); PG8_BAR; PG8_WAIT_L(0); PG8_MMA(0, 0, At, B0); PG8_BAR; PG8_SCHED;
            PG8_LDB(B1, 0, 1); PG8_STAGE(PG8_SB(0, 0), b2, voffB);
            PG8_BAR; PG8_WAIT_L(0); PG8_MMA(0, 1, At, B1); PG8_BAR;
            PG8_LDA(At, 0, 1); PG8_STAGE(PG8_SA(0, 0), a2, voffA);
            PG8_BAR; PG8_WAIT_L(0); PG8_MMA(1, 0, At, B0); PG8_BAR; PG8_SCHED;
            PG8_STAGE(PG8_SB(0, 1), b2 + hstep, voffB);
            PG8_WAIT_V(6); PG8_BAR; PG8_MMA(1, 1, At, B1); PG8_BAR;
            PG8_LDB(B0, 1, 0); PG8_SCHED; PG8_LDA(At, 1, 0); PG8_STAGE(PG8_SA(0, 1), a2 + hstep, voffA);
            PG8_WAIT_L(8); PG8_BAR; PG8_WAIT_L(0); PG8_MMA(0, 0, At, B0); PG8_BAR; PG8_SCHED;
            PG8_LDB(B1, 1, 1); PG8_STAGE(PG8_SB(1, 0), b3, voffB);
            PG8_BAR; PG8_WAIT_L(0); PG8_MMA(0, 1, At, B1); PG8_BAR;
            PG8_LDA(At, 1, 1); PG8_STAGE(PG8_SA(1, 0), a3, voffA);
            PG8_BAR; PG8_WAIT_L(0); PG8_MMA(1, 0, At, B0); PG8_BAR; PG8_SCHED;
            PG8_STAGE(PG8_SB(1, 1), b3 + hstep, voffB);
            PG8_WAIT_V(6); PG8_BAR; PG8_MMA(1, 1, At, B1); PG8_BAR;
            }
        }
        if constexpr (ALIGN_EPI) { if (wr == 0) PG8_BAR; }
        if constexpr (!Epi::AFTER_DRAIN) { E(acc, cur, wr, wc, fr, fq); S.done(cur); }
        if (!has_next) break;
#pragma unroll
        for (int a = 0; a < 2; ++a)
#pragma unroll
            for (int b = 0; b < 2; ++b)
#pragma unroll
                for (int m = 0; m < 4; ++m)
#pragma unroll
                    for (int n = 0; n < 2; ++n) acc[a][b][m][n] = (f32x4){0.f, 0.f, 0.f, 0.f};
        cur = nxt; cA = nA; cB = nB; ++ui;
        if constexpr (ALIGN_EPI) { if (wr == 1) PG8_BAR; }
    }
    PG8_WAIT_V(0);
    if constexpr (!ALIGN_EPI) { if (wr == 0) PG8_BAR; }
    PG8_BAR;
    if constexpr (Epi::AFTER_DRAIN) { E.fused(acc, cur, wr, wc, fr, fq, lds, wid, lane); S.done(cur); }
#undef PG8_SA
#undef PG8_SB
#undef PG8_STAGE
#undef PG8_LDA
#undef PG8_LDB
#undef PG8_MMA
#undef PG8_WAIT_V
#undef PG8_WAIT_L
#undef PG8_BAR
#undef PG8_SCHED
}
#else
template <class Epi, class Sched, bool ALIGN_EPI = false, bool SP2 = false>
inline void gemm_phase(void* lds, const Gemm g, const Sched& S, const Epi& E, const int tid_in) {
    const int tid = TID(), wid = tid >> 6, lane = tid & 63, wr = wid >> 2, wc = wid & 3, fr = lane & 15, fq = lane >> 4;
    Unit u;
    for (int ui = 0; S.next(ui, u); ++ui) {
        f32x4 acc[2][2][4][2];
        for (int ai = 0; ai < 2; ++ai) for (int bj = 0; bj < 2; ++bj) for (int m = 0; m < 4; ++m) for (int n = 0; n < 2; ++n) for (int j = 0; j < 4; ++j) {
            const int r = 256 * u.pm + 128 * ai + 64 * wr + 16 * m + fr;
            const int c = 256 * u.pn + 128 * bj + 32 * wc + (Epi::PERM ? (8 * fq + 4 * n + j) : (16 * n + 4 * fq + j));
            const bf16_t* a = g.A + (size_t)r * g.K; const bf16_t* b = g.Bt + (size_t)c * g.K;
            float s = 0.f; for (int k = 0; k < g.K; ++k) s += bf2f(a[k]) * bf2f(b[k]);
            acc[ai][bj][m][n][j] = s;
        }
        E(acc, u, wr, wc, fr, fq);
    }
    block_sync();
}
#endif
#ifndef HOST_EMU
#define EPI_LAUNDER(wr, wc, fr, fq) asm volatile("" : "+s"(wr), "+s"(wc), "+v"(fr), "+v"(fq))
#else
#define EPI_LAUNDER(wr, wc, fr, fq) do {} while (0)
#endif
DEV_M float rstd_of(float ss) { return fast_rsqrt(ss * (1.0f / 1024.0f) + NORM_EPS); }

DEV_M float rss_slots16(const float* p) {
    const f32x4 a = *(const f32x4*)p, b = *(const f32x4*)(p + 4), c = *(const f32x4*)(p + 8), d = *(const f32x4*)(p + 12);
    return (((a[0] + a[1]) + (a[2] + a[3])) + ((b[0] + b[1]) + (b[2] + b[3]))) + (((c[0] + c[1]) + (c[2] + c[3])) + ((d[0] + d[1]) + (d[2] + d[3])));
}
template <int SLOTS, bool HALO = false> struct EpiScaleBf16 {
    static constexpr bool PERM = true, AFTER_DRAIN = false;
    bf16_t* O; int ldc; const float* rss; int ncols; bf16_t* halo;
    DEV_M void operator()(const f32x4 (&acc)[2][2][4][2], const Unit& u, int wr, int wc, int fr, int fq) const {
        EPI_LAUNDER(wr, wc, fr, fq);
        const int row0 = u.pm * BM + wr * 64 + fr, col0 = u.pn * BM + wc * 32 + 8 * fq;
#pragma unroll
        for (int ai = 0; ai < 2; ++ai)
#pragma unroll
            for (int m = 0; m < 4; ++m) {
                const int row = row0 + ai * HALF + m * 16; const float sc = rstd_of(SLOTS == 1 ? rss[row] : rss_slots16(rss + (size_t)row * 16));
                bf16_t* rowp = O + (size_t)row * ldc + col0;
#pragma unroll
                for (int bj = 0; bj < 2; ++bj) {
                    if (col0 + bj * HALF < ncols) {
                        const f32x4 v0 = acc[ai][bj][m][0] * sc, v1 = acc[ai][bj][m][1] * sc;
                        u32x4 w; w.x = pk2(v0[0], v0[1]); w.y = pk2(v0[2], v0[3]); w.z = pk2(v1[0], v1[1]); w.w = pk2(v1[2], v1[3]);
                        *(u32x4*)(rowp + bj * HALF) = w;
                        if (HALO) { const int cc = col0 + bj * HALF - C_MQ; if ((row & 63) >= 61 && cc >= 0 && cc < 512) *(u32x4*)(halo + ((size_t)(row >> 6) * 3 + ((row & 63) - 61)) * 512 + cc) = w; }
                    }
                }
            }
    }
};
struct EpiU {
    static constexpr bool PERM = true, AFTER_DRAIN = false;
    bf16_t* uall;
    DEV_M void operator()(const f32x4 (&acc)[2][2][4][2], const Unit& u, int wr, int wc, int fr, int fq) const {
        EPI_LAUNDER(wr, wc, fr, fq);
        bf16_t* base = uall + (size_t)(u.pm * BM + wr * 64 + fr) * DM + (u.pn & 3) * BM + wc * 32 + 8 * fq;
#pragma unroll
        for (int ai = 0; ai < 2; ++ai)
#pragma unroll
            for (int m = 0; m < 4; ++m)
#pragma unroll
                for (int bj = 0; bj < 2; ++bj) {
                    const f32x4 v0 = acc[ai][bj][m][0], v1 = acc[ai][bj][m][1];
                    u32x4 w; w.x = pk2(v0[0], v0[1]); w.y = pk2(v0[2], v0[3]); w.z = pk2(v1[0], v1[1]); w.w = pk2(v1[2], v1[3]);
                    *(u32x4*)(base + (size_t)(ai * HALF + m * 16) * DM + bj * HALF) = w;
                }
    }
};
struct EpiGate {
    static constexpr bool PERM = true, AFTER_DRAIN = false;
    const bf16_t* uall; bf16_t* merged; const float* rss; int nrows;
    DEV_M void operator()(const f32x4 (&acc)[2][2][4][2], const Unit& u, int wr, int wc, int fr, int fq) const {
        EPI_LAUNDER(wr, wc, fr, fq);
        const int mi = u.pn >> 2, pn = u.pn & 3, row0 = u.pm * BM + wr * 64 + fr, col0 = pn * BM + wc * 32 + 8 * fq;
        const bf16_t* ub = uall + ((size_t)mi * nrows + row0) * DM + col0;
#pragma unroll
        for (int ai = 0; ai < 2; ++ai)
#pragma unroll
            for (int m = 0; m < 4; ++m) {
                const int row = row0 + ai * HALF + m * 16; const float sc = rstd_of(rss[row]);
#pragma unroll
                for (int bj = 0; bj < 2; ++bj) {
                    const u32x4 uv = *(const u32x4*)(ub + (size_t)(ai * HALF + m * 16) * DM + bj * HALF);
                    bf16_t* mp = merged + (size_t)row * DM + col0 + bj * HALF;
                    u32x4 pv = {0u, 0u, 0u, 0u};
                    if (mi != 0) pv = *(const u32x4*)mp;
                    const f32x4 a0 = acc[ai][bj][m][0] * sc, a1 = acc[ai][bj][m][1] * sc;
                    float r[8];
                    r[0] = sigmoidf_(a0[0]) * bflo(uv.x) + bflo(pv.x); r[1] = sigmoidf_(a0[1]) * bfhi(uv.x) + bfhi(pv.x);
                    r[2] = sigmoidf_(a0[2]) * bflo(uv.y) + bflo(pv.y); r[3] = sigmoidf_(a0[3]) * bfhi(uv.y) + bfhi(pv.y);
                    r[4] = sigmoidf_(a1[0]) * bflo(uv.z) + bflo(pv.z); r[5] = sigmoidf_(a1[1]) * bfhi(uv.z) + bfhi(pv.z);
                    r[6] = sigmoidf_(a1[2]) * bflo(uv.w) + bflo(pv.w); r[7] = sigmoidf_(a1[3]) * bfhi(uv.w) + bfhi(pv.w);
                    u32x4 w; w.x = pk2(r[0], r[1]); w.y = pk2(r[2], r[3]); w.z = pk2(r[4], r[5]); w.w = pk2(r[6], r[7]);
                    *(u32x4*)mp = w;
                }
            }
    }
};
struct EpiOut {
    static constexpr bool PERM = false, AFTER_DRAIN = false;
    const float* xres; float* out; bf16_t* xb; float* rss;
    DEV_M void operator()(const f32x4 (&acc)[2][2][4][2], const Unit& u, int wr, int wc, int fr, int fq) const {
        EPI_LAUNDER(wr, wc, fr, fq);
        const int row0 = u.pm * BM + wr * 64 + fr, col0 = u.pn * BM + wc * 32 + 4 * fq;
#pragma unroll
        for (int ai = 0; ai < 2; ++ai)
#pragma unroll
            for (int m = 0; m < 4; ++m) {
                const int row = row0 + ai * HALF + m * 16; const size_t off = (size_t)row * DM + col0; float ss = 0.f;
#pragma unroll
                for (int bj = 0; bj < 2; ++bj)
#pragma unroll
                    for (int n = 0; n < 2; ++n) {
                        const size_t o = off + bj * HALF + n * 16;
                        const f32x4 xr = *(const f32x4*)(xres + o);
                        const f32x4 v = xr + acc[ai][bj][m][n];
                        *(f32x4*)(out + o) = v;
                        u32x2 w; w.x = pk2(v[0], v[1]); w.y = pk2(v[2], v[3]);
                        *(u32x2*)(xb + o) = w;
                        ss += (v[0] * v[0] + v[1] * v[1]) + (v[2] * v[2] + v[3] * v[3]);
                    }
                ss += xorf<16>(ss); ss += xorf<32>(ss);
                if (fq == 0) rss[(size_t)row * 16 + u.pn * 4 + wc] = ss;
            }
    }
};
template <bool STACK_A> struct MixOrder {
    int ntiles, G, c, nM;
    DEV_M bool next(int i, Unit& u) const { const long t = (long)(i >> 2) * G + c; if (t >= ntiles) return false; const int m = i & 3;
        u.pm = (int)(t >> 2) + (STACK_A ? m * nM : 0); u.pn = m * 4 + (int)(t & 3); return true; }
    DEV_M void a_ready(const Unit&) const {}
    DEV_M void done(const Unit&) const {}
};
}
#ifndef HOST_EMU
#define GEMM_LDS ((PG8_LAS unsigned char*)smem_raw)
#else
#define GEMM_LDS ((void*)nullptr)
#endif
struct Ctx {
    float* out; unsigned char* ws; LDSP char* lds; int tid, lane, wave, bid, nblk;
};
constexpr int LDS_PTRS = LDS_BYTES - 256;
#ifndef HOST_EMU
DEV const float* inptr(const Ctx& c, int i) { const unsigned long long v = ((volatile LDSP unsigned long long*)(c.lds + LDS_PTRS))[i];
    const unsigned lo = __builtin_amdgcn_readfirstlane((unsigned)v), hi = __builtin_amdgcn_readfirstlane((unsigned)(v >> 32)); return (const float*)(const __attribute__((address_space(1))) float*)(((unsigned long long)hi << 32) | lo); }
#else
static inline const float* inptr(const Ctx& c, int i) { return ((const float* volatile*)(c.lds + LDS_PTRS))[i]; }
#endif
#define CIN(i) inptr(c, (i))
template <class T> DEV T* wsp(const Ctx& c, size_t off) { return (T*)(c.ws + off); }
DEV int orig_col(int n) {
    if (n < 1792) return n;
    if (n < 2048) return 1800 + (n - 1792);
    if (n < 3072) return 2056 + (n - 2048);
    if (n < 4096) return 3092 + (n - 3072);
    if (n < 4104) return 1792 + (n - 4096);
    if (n < 4116) return 3080 + (n - 4104);
    return -1;
}

template <class F> DEV void transpose_item(const Ctx& c, F src, bf16_t* dst, int ldd, int k0, int n0) {
    LDSP float* tile = (LDSP float*)c.lds;
    for (int e = c.tid; e < 4096; e += NTHR) { const int k = e >> 6, n = e & 63; tile[n * 65 + k] = src(k0 + k, n0 + n); }
    block_sync();
    for (int e = c.tid; e < 2048; e += NTHR) { const int n = e >> 5, k2 = (e & 31) * 2;
        *(unsigned*)(dst + (size_t)(n0 + n) * ldd + k0 + k2) = pk2(tile[n * 65 + k2], tile[n * 65 + k2 + 1]); }
    block_sync();
}

DEV void p0_prep(const Ctx& c, int l) {
    const float* g1 = CIN(1) + (size_t)l * DM;
    const float* g2 = CIN(17) + (size_t)l * DM;
    constexpr int I_IN = (PROJ_N / 64) * 16, I_G = 4 * 16 * 16, I_UP = 4 * 16 * 4, I_OUT = 16 * 16, I_WQ = 16 * 16, I_WC = 2 * 32, I_CB = 2;
    constexpr int I_TOT = I_IN + I_G + I_UP + I_OUT + I_WQ + I_WC + I_CB;
    for (int it = c.bid; it < I_TOT; it += c.nblk) {
        int r = it;
        if (r < I_IN) {
            const float* w = CIN(2) + (size_t)l * DM * N_IN_ORIG; const int nt = r / 16, kt = r % 16;
            transpose_item(c, [=](int k, int n) { const int oc = orig_col(n); return oc < 0 ? 0.f : w[(size_t)k * N_IN_ORIG + oc] * g1[k]; }, wsp<bf16_t>(c, WS_WIN), DM, kt * 64, nt * 64);
            continue;
        } r -= I_IN;
        if (r < I_G) {
            const int m = r / 256, nt = (r % 256) / 16, kt = r % 16; const float* w = CIN(15) + ((size_t)l * 4 + m) * DM * DM;
            transpose_item(c, [=](int k, int n) { return w[(size_t)k * DM + n] * g1[k]; }, wsp<bf16_t>(c, WS_WG) + (size_t)m * DM * DM, DM, kt * 64, nt * 64);
            continue;
        } r -= I_G;
        if (r < I_UP) {
            const int m = r / 64, nt = (r % 64) / 4, kt = r % 4; const float* w = CIN(14) + ((size_t)l * 4 + m) * MW * DM;
            transpose_item(c, [=](int k, int n) { return w[(size_t)k * DM + n]; }, wsp<bf16_t>(c, WS_WUP) + (size_t)m * DM * MW, MW, kt * 64, nt * 64);
            continue;
        } r -= I_UP;
        if (r < I_OUT) {
            const int nt = r / 16, kt = r % 16; const float* w = CIN(16) + (size_t)l * DM * DM;
            transpose_item(c, [=](int k, int n) { return w[(size_t)k * DM + n]; }, wsp<bf16_t>(c, WS_WOUT), DM, kt * 64, nt * 64);
            continue;
        } r -= I_OUT;
        if (r < I_WQ) {
            const int hp = r / 16, kt = r % 16;
            const float* keys = CIN(19) + ((size_t)l * 16 + hp) * 128 * 128; const float* wq = CIN(18) + (size_t)l * DM * PEER_N;
            LDSP float* keysL = (LDSP float*)c.lds; LDSP float* wqL = keysL + 128 * 129;
            for (int e = c.tid; e < 128 * 128; e += NTHR) keysL[(e >> 7) * 129 + (e & 127)] = keys[e];
            for (int e = c.tid; e < 64 * 128; e += NTHR) { const int k = e >> 7, d = e & 127; wqL[k * 129 + d] = wq[(size_t)(kt * 64 + k) * PEER_N + hp * 128 + d] * g2[kt * 64 + k]; }
            block_sync();
            const int key = c.tid & 127, kg = c.tid >> 7;
            float acc[16];
#pragma unroll
            for (int j = 0; j < 16; ++j) acc[j] = 0.f;
            for (int d = 0; d < 128; ++d) { const float kv = keysL[key * 129 + d];
#pragma unroll
                for (int j = 0; j < 16; ++j) acc[j] += kv * wqL[(kg * 16 + j) * 129 + d]; }
            bf16_t* dst = wsp<bf16_t>(c, WS_WQ2) + (size_t)(hp * 128 + key) * DM + kt * 64 + kg * 16;
#pragma unroll
            for (int j = 0; j < 16; j += 2) *(unsigned*)(dst + j) = pk2(acc[j], acc[j + 1]);
            block_sync();
            continue;
        } r -= I_WQ;
        if (r < I_WC) {
            const int kv = r / 32, kt = r % 32; const float* w = CIN(12) + ((size_t)l * 2 + kv) * 2048 * 64;
            transpose_item(c, [=](int k, int n) { return w[(size_t)k * 64 + n]; }, wsp<bf16_t>(c, WS_WCT) + (size_t)kv * 64 * 2048, 2048, kt * 64, 0);
            continue;
        } r -= I_WC;
        {
            const int kv = r; const float* w = CIN(12) + ((size_t)l * 2 + kv) * 2048 * 64; const float* pe = CIN(11) + ((size_t)l * 2 + kv) * 2048;
            LDSP float* red = (LDSP float*)c.lds;
            const int e = c.tid & 63, part = c.tid >> 6; float s = 0.f;
            for (int kk = part * 256; kk < part * 256 + 256; ++kk) s += pe[kk] * w[(size_t)kk * 64 + e];
            red[part * 64 + e] = s;
            block_sync();
            if (c.tid < 64) { float t = 0.f; for (int p = 0; p < 8; ++p) t += red[p * 64 + c.tid]; wsp<float>(c, WS_CBIAS)[kv * 64 + c.tid] = t; }
            block_sync();
        }
    }
    if (l == 0) {
        const float* x = CIN(0); bf16_t* xb = wsp<bf16_t>(c, WS_XB); float* rss = wsp<float>(c, WS_RSS1);
        for (int row = c.bid * NWAVE + c.wave; row < NT; row += c.nblk * NWAVE) {
            const f32x4* xr = (const f32x4*)(x + (size_t)row * DM) + c.lane; float s = 0.f;
            u32x2* o = (u32x2*)(xb + (size_t)row * DM) + c.lane;
#pragma unroll
            for (int j = 0; j < 4; ++j) { const f32x4 v = xr[64 * j]; s += (v[0] * v[0] + v[1] * v[1]) + (v[2] * v[2] + v[3] * v[3]);
                u32x2 w; w.x = pk2(v[0], v[1]); w.y = pk2(v[2], v[3]); o[64 * j] = w; }
            s = wave_sum(s);
            if (c.lane == 0) rss[row] = s;
        }
        float* cosT = wsp<float>(c, WS_ROPE); float* sinT = cosT + SEQ * 32;
        for (int i = c.bid * NTHR + c.tid; i < SEQ * 32; i += c.nblk * NTHR) {
            const int pos = i >> 5, fi = i & 31;
            const float inv = exp2f(-(float)fi * 0.41524101186092029f);
            const float a = (float)pos * inv, q = rintf(a * 0.63661977236758134f);
            float rr = fmaf(-q, 1.5703125f, a); rr = fmaf(-q, 4.837512969970703125e-4f, rr); rr = fmaf(-q, 7.54978995489188216e-8f, rr);
            const float r2 = rr * rr;
            const float s = rr * (1.0f + r2 * (-1.0f / 6 + r2 * (1.0f / 120 + r2 * (-1.0f / 5040 + r2 * (1.0f / 362880)))));
            const float cc = 1.0f + r2 * (-0.5f + r2 * (1.0f / 24 + r2 * (-1.0f / 720 + r2 * (1.0f / 40320 + r2 * (-1.0f / 3628800)))));
            const int qi = ((int)q) & 3;
            const float co = qi == 0 ? cc : qi == 1 ? -s : qi == 2 ? -cc : s;
            const float si = qi == 0 ? s : qi == 1 ? cc : qi == 2 ? -s : -cc;
            cosT[i] = co; sinT[i] = si;
        }
    }
}
constexpr int LF_STRIDE = 65, LT_STRIDE = 72;
constexpr int LDS_F0 = 0, LDS_F1 = 16640, LDS_F2 = 33280, LDS_T0 = 49920, LDS_TSZ = 64 * LT_STRIDE * 2, LDS_MISC = LDS_T0 + 6 * LDS_TSZ;
DEV LDSP float* ldsF(const Ctx& c, int i) { return (LDSP float*)(c.lds + LDS_F0 + i * 16640); }
DEV LDSP bf16_t* ldsT(const Ctx& c, int i) { return (LDSP bf16_t*)(c.lds + LDS_T0 + i * LDS_TSZ); }
DEV LDSP float* ldsM(const Ctx& c) { return (LDSP float*)(c.lds + LDS_MISC); }

DEV void load_tile_f32(const Ctx& c, LDSP float* F, const bf16_t* proj, int tok0, int col) {
    const int t = c.tid >> 3, d0 = (c.tid & 7) * 8;
    const u32x4 v = *(const u32x4*)(proj + (size_t)(tok0 + t) * PROJ_LD + col + d0);
    LDSP float* f = F + t * LF_STRIDE + d0;
    f[0] = bflo(v.x); f[1] = bfhi(v.x); f[2] = bflo(v.y); f[3] = bfhi(v.y); f[4] = bflo(v.z); f[5] = bfhi(v.z); f[6] = bflo(v.w); f[7] = bfhi(v.w);
}
DEV void load_tile_T(const Ctx& c, LDSP bf16_t* T, const bf16_t* proj, int tok0, int col) {
    const int t = c.tid >> 3, d0 = (c.tid & 7) * 8;
    const u32x4 v = *(const u32x4*)(proj + (size_t)(tok0 + t) * PROJ_LD + col + d0);
    LDSP bf16_t* p = T + d0 * LT_STRIDE + t;
    p[0] = (bf16_t)(v.x & 0xffff); p[LT_STRIDE] = (bf16_t)(v.x >> 16); p[2 * LT_STRIDE] = (bf16_t)(v.y & 0xffff); p[3 * LT_STRIDE] = (bf16_t)(v.y >> 16);
    p[4 * LT_STRIDE] = (bf16_t)(v.z & 0xffff); p[5 * LT_STRIDE] = (bf16_t)(v.z >> 16); p[6 * LT_STRIDE] = (bf16_t)(v.w & 0xffff); p[7 * LT_STRIDE] = (bf16_t)(v.w >> 16);
}
DEV f32x4 mma_tile(const LDSP bf16_t* A, int lda, int r0, const LDSP bf16_t* B, int ldb, int c0, int K, f32x4 acc, int lane) {
    const int fr = lane & 15, fq = lane >> 4;
    for (int k0 = 0; k0 < K; k0 += 32) {
        const bf16x8 a = *(const LDSP bf16x8*)(A + (r0 + fr) * lda + k0 + fq * 8);
        const bf16x8 b = *(const LDSP bf16x8*)(B + (c0 + fr) * ldb + k0 + fq * 8);
        acc = mfma16(a, b, acc);
    }
    return acc;
}
DEV float wave_scan_add(float v, int lane) {
#pragma unroll
    for (int o = 1; o < 64; o <<= 1) { const float t = shfl_f(v, lane - o); if (lane >= o) v += t; }
    return v;
}
DEV float wave_scan_max(float v, int lane) {
#pragma unroll
    for (int o = 1; o < 64; o <<= 1) { const float t = shfl_f(v, lane - o); if (lane >= o) v = fmaxf(v, t); }
    return v;
}
DEV float hgrn_lb(const Ctx& c, int l, int ch) { if (l == 0) return 0.f; const float* lb = CIN(3); return sigmoidf_(lb[MW + ch] - lb[ch]); }
DEV float ret_loggamma(int h) { return log1pf(-exp2f(-5.0f - (float)h)); }

DEV void hgrn_front(const Ctx& c, int l, const bf16_t* proj, int tok0, int h) {
    LDSP float* F0 = ldsF(c, 0); LDSP float* F1 = ldsF(c, 1);
    load_tile_f32(c, F0, proj, tok0, C_HF + h * 64);
    block_sync();
    for (int e = c.tid; e < 4096; e += NTHR) { const int t = e >> 6, d = e & 63; const float fl = F0[t * LF_STRIDE + d], lbv = hgrn_lb(c, l, h * 64 + d);
        const float sg = sigmoidf_(fl), f = lbv + (1.f - lbv) * sg; F0[t * LF_STRIDE + d] = fast_log(f); F1[t * LF_STRIDE + d] = (1.f - lbv) * (1.f - sg); }
    block_sync();
    for (int k = 0; k < 8; ++k) { const int d = c.wave * 8 + k; F0[c.lane * LF_STRIDE + d] = wave_scan_add(F0[c.lane * LF_STRIDE + d], c.lane); }
    block_sync();
}
DEV void rope_tile(const Ctx& c, LDSP float* F, int pos0, float scale) {
    const float* cosT = wsp<float>(c, WS_ROPE); const float* sinT = cosT + SEQ * 32;
    for (int e = c.tid; e < 2048; e += NTHR) { const int t = e >> 5, d = e & 31; const float cs = cosT[(pos0 + t) * 32 + d], sn = sinT[(pos0 + t) * 32 + d];
        const float x1 = F[t * LF_STRIDE + d], x2 = F[t * LF_STRIDE + d + 32];
        F[t * LF_STRIDE + d] = (x1 * cs - x2 * sn) * scale; F[t * LF_STRIDE + d + 32] = (x1 * sn + x2 * cs) * scale; }
}
DEV void mlstm_conv_tile(const Ctx& c, int l, LDSP float* F, const bf16_t* proj, int tok0, int ck, int cg, int col, int ch0, float scale) {
    const float* cw = CIN(5) + (size_t)l * 4 * 512; const float* cb = CIN(6) + (size_t)l * 512; const bf16_t* halo = wsp<bf16_t>(c, WS_HALO);
    for (int e = c.tid; e < 4096; e += NTHR) { const int t = e >> 6, d = e & 63; float s = cb[ch0 + d];
#pragma unroll
        for (int j = 0; j < 4; ++j) { const int tt = t - 3 + j; float xv = 0.f;
            if (tt >= 0) xv = bf2f(proj[(size_t)(tok0 + tt) * PROJ_LD + col + d]);
            else if (ck > 0) xv = bf2f(halo[((size_t)(cg - 1) * 3 + (tt + 3)) * 512 + (col - C_MQ) + d]);
            s += cw[j * 512 + ch0 + d] * xv; }
        F[t * LF_STRIDE + d] = siluf_(s) * scale; }
}
DEV void mlstm_gates(const Ctx& c, int l, const bf16_t* proj, int tok0, int h) {
    LDSP float* M = ldsM(c); const float* gb = CIN(7) + (size_t)l * 8;
    if (c.tid < 64) { const int t = c.tid; M[t] = bf2f(proj[(size_t)(tok0 + t) * PROJ_LD + C_MI + h]) + gb[h];
        M[64 + t] = log_sigmoidf_(bf2f(proj[(size_t)(tok0 + t) * PROJ_LD + C_MF + h]) + gb[4 + h]); }
    block_sync();
    if (c.wave == 0) M[64 + c.lane] = wave_scan_add(M[64 + c.lane], c.lane);
    block_sync();
}
DEV void store_state_tiles(const Ctx& c, bf16_t* dst, const f32x4 (&acc)[2]) {
    const int fr = c.lane & 15, fq = c.lane >> 4;
#pragma unroll
    for (int k = 0; k < 2; ++k) { const int ti = c.wave * 2 + k, rt = ti >> 2, ct = ti & 3;
#pragma unroll
        for (int i = 0; i < 4; ++i) dst[(rt * 16 + fq * 4 + i) * 64 + ct * 16 + fr] = f2bf(acc[k][i]); }
}
DEV void f32_to_tile(const Ctx& c, LDSP bf16_t* T, const LDSP float* F, bool transpose) {
    for (int e = c.tid; e < 4096; e += NTHR) { const int r = e >> 6, q = e & 63; const bf16_t v = f2bf(F[r * LF_STRIDE + q]); if (transpose) T[q * LT_STRIDE + r] = v; else T[r * LT_STRIDE + q] = v; }
}

DEV void recur_local_unit(const Ctx& c, int l, int unit) {
    const int mixer = unit / (BATCH * NH * NC), r = unit % (BATCH * NH * NC), b = r / (NH * NC), h = (r / NC) % NH, ck = r % NC;
    bf16_t* proj = wsp<bf16_t>(c, WS_PROJ); const int tok0 = b * SEQ + ck * 64, pos0 = ck * 64;
    LDSP float* F0 = ldsF(c, 0); LDSP float* F1 = ldsF(c, 1); LDSP float* F2 = ldsF(c, 2); LDSP float* M = ldsM(c);
    LDSP bf16_t* VT = ldsT(c, 0); LDSP bf16_t* KT = ldsT(c, 1);
    bf16_t* dst = wsp<bf16_t>(c, WS_ST + mixer * ST_ONE) + (size_t)r * 4096;
    const int vt = c.tid >> 3, vd0 = (c.tid & 7) * 8;
    int qcol, kcol, vcol;
    if (mixer == 0) {
        qcol = C_HQ; kcol = C_HF; vcol = C_HI;
        load_tile_f32(c, F2, proj, tok0, C_HQ + h * 64);
        hgrn_front(c, l, proj, tok0, h);
        float qo[8], ko[8];
#pragma unroll
        for (int j = 0; j < 8; ++j) { const int d = vd0 + j; const float bt = F0[vt * LF_STRIDE + d], bm = F0[31 * LF_STRIDE + d], bl = F0[63 * LF_STRIDE + d], kk = F1[vt * LF_STRIDE + d];
            qo[j] = siluf_(F2[vt * LF_STRIDE + d]) * fast_exp(bt - bm); ko[j] = kk * fast_exp(bm - bt); KT[d * LT_STRIDE + vt] = f2bf(kk * fast_exp(bl - bt)); }
        if (c.tid < 64) { wsp<float>(c, WS_GDEC)[(size_t)r * 64 + c.tid] = fast_exp(F0[63 * LF_STRIDE + c.tid]); wsp<float>(c, WS_G31)[(size_t)r * 64 + c.tid] = fast_exp(F0[31 * LF_STRIDE + c.tid]); }
        load_tile_T(c, VT, proj, tok0, C_HI + h * 64);
        u32x4 w; w.x = pk2(qo[0], qo[1]); w.y = pk2(qo[2], qo[3]); w.z = pk2(qo[4], qo[5]); w.w = pk2(qo[6], qo[7]); *(u32x4*)(proj + (size_t)(tok0 + vt) * PROJ_LD + C_HQ + h * 64 + vd0) = w;
        w.x = pk2(ko[0], ko[1]); w.y = pk2(ko[2], ko[3]); w.z = pk2(ko[4], ko[5]); w.w = pk2(ko[6], ko[7]); *(u32x4*)(proj + (size_t)(tok0 + vt) * PROJ_LD + C_HF + h * 64 + vd0) = w;
    } else if (mixer == 2) {
        qcol = C_RQ; kcol = C_RK; vcol = C_RV;
        load_tile_f32(c, F0, proj, tok0, C_RK + h * 64); load_tile_f32(c, F2, proj, tok0, C_RQ + h * 64);
        block_sync();
        rope_tile(c, F0, pos0, 0.125f); rope_tile(c, F2, pos0, 1.0f);
        block_sync();
        const float lg = ret_loggamma(h), gq = fast_exp(lg * (float)(vt - 31)), gk = fast_exp(lg * (float)(31 - vt)), gl = fast_exp(lg * (float)(63 - vt));
        float qo[8], ko[8];
#pragma unroll
        for (int j = 0; j < 8; ++j) { const int d = vd0 + j; const float kk = F0[vt * LF_STRIDE + d]; qo[j] = F2[vt * LF_STRIDE + d] * gq; ko[j] = kk * gk; KT[d * LT_STRIDE + vt] = f2bf(kk * gl); }
        load_tile_T(c, VT, proj, tok0, C_RV + h * 64);
        u32x4 w; w.x = pk2(qo[0], qo[1]); w.y = pk2(qo[2], qo[3]); w.z = pk2(qo[4], qo[5]); w.w = pk2(qo[6], qo[7]); *(u32x4*)(proj + (size_t)(tok0 + vt) * PROJ_LD + C_RQ + h * 64 + vd0) = w;
        w.x = pk2(ko[0], ko[1]); w.y = pk2(ko[2], ko[3]); w.z = pk2(ko[4], ko[5]); w.w = pk2(ko[6], ko[7]); *(u32x4*)(proj + (size_t)(tok0 + vt) * PROJ_LD + C_RK + h * 64 + vd0) = w;
    } else {
        qcol = C_MQ; kcol = C_MK; vcol = C_MV;
        mlstm_gates(c, l, proj, tok0, h);
        mlstm_conv_tile(c, l, F0, proj, tok0, ck, b * NC + ck, C_MK + h * 64, 256 + h * 64, 0.125f);
        mlstm_conv_tile(c, l, F2, proj, tok0, ck, b * NC + ck, C_MQ + h * 64, h * 64, 1.0f);
        if (c.wave == 0) { const int t = c.lane; const float bl = M[127], bt = M[64 + t], li = M[t];
            const float a = wave_max(bl - bt + li); const float pm = wave_scan_max(li - bt, t);
            M[128 + t] = pm; if (t == 0) { M[192] = a; M[193] = bl; }
            float* mts = wsp<float>(c, WS_MTS) + ((size_t)(tok0 + t) * NH + h) * 2; mts[0] = bt; mts[1] = bt + pm; }
        block_sync();
        const float eq = fast_exp(-M[128 + vt]), ek = fast_exp(M[vt] - M[64 + vt]), wk = fast_exp(M[193] - M[64 + vt] + M[vt] - M[192]);
        float qo[8], ko[8];
#pragma unroll
        for (int j = 0; j < 8; ++j) { const int d = vd0 + j; const float kk = F0[vt * LF_STRIDE + d]; qo[j] = F2[vt * LF_STRIDE + d] * eq; ko[j] = kk * ek;
            const float kh = kk * wk; F1[vt * LF_STRIDE + d] = kh; KT[d * LT_STRIDE + vt] = f2bf(kh); }
        load_tile_T(c, VT, proj, tok0, C_MV + h * 64);
        block_sync();
        u32x4 w; w.x = pk2(qo[0], qo[1]); w.y = pk2(qo[2], qo[3]); w.z = pk2(qo[4], qo[5]); w.w = pk2(qo[6], qo[7]); *(u32x4*)(proj + (size_t)(tok0 + vt) * PROJ_LD + C_MQ + h * 64 + vd0) = w;
        w.x = pk2(ko[0], ko[1]); w.y = pk2(ko[2], ko[3]); w.z = pk2(ko[4], ko[5]); w.w = pk2(ko[6], ko[7]); *(u32x4*)(proj + (size_t)(tok0 + vt) * PROJ_LD + C_MK + h * 64 + vd0) = w;
        if (c.tid < 64) { float s = 0.f; for (int t = 0; t < 64; ++t) s += F1[t * LF_STRIDE + c.tid]; wsp<float>(c, WS_MNL)[(size_t)r * 64 + c.tid] = s; }
        if (c.tid == 64) { float* sc = wsp<float>(c, WS_MSC) + (size_t)r * 4; sc[0] = M[192]; sc[1] = M[193]; }
    }
    block_sync();
    f32x4 acc[2];
#pragma unroll
    for (int k = 0; k < 2; ++k) { const int ti = c.wave * 2 + k; acc[k] = (f32x4){0.f, 0.f, 0.f, 0.f}; acc[k] = mma_tile(VT, LT_STRIDE, (ti >> 2) * 16, KT, LT_STRIDE, (ti & 3) * 16, 64, acc[k], c.lane); }
    store_state_tiles(c, dst, acc);
    *(u32x4*)(proj + (size_t)(tok0 + vt) * PROJ_LD + vcol + h * 64 + vd0) = *(const LDSP u32x4*)(VT + vt * LT_STRIDE + vd0);
    (void)qcol; (void)kcol;
    block_sync();
}

DEV void recur_scan(const Ctx& c) {
    constexpr int ncol2 = BATCH * NH * 2048;
    constexpr int KB = (NC < 16) ? NC : 16;
    for (int i = c.bid * NTHR + c.tid; i < 3 * ncol2 + BATCH * NH * 64; i += c.nblk * NTHR) {
        if (i < 3 * ncol2) {
            const int mixer = i / ncol2, col = (i % ncol2) * 2, bh = col >> 12, ed = col & 4095, d = ed & 63, h = bh % NH;
            bf16_t* p = wsp<bf16_t>(c, WS_ST + mixer * ST_ONE) + (size_t)bh * NC * 4096 + ed;
            const float* g = wsp<float>(c, WS_GDEC) + (size_t)bh * NC * 64 + d; const float* g31 = wsp<float>(c, WS_G31) + (size_t)bh * NC * 64 + d; const float* sc = wsp<float>(c, WS_MSC) + (size_t)bh * NC * 4;
            const float gr = fast_exp(ret_loggamma(h) * 64.f), gr32 = fast_exp(ret_loggamma(h) * 32.f);
            float s0 = 0.f, s1 = 0.f, m = 0.f;
            for (int kb = 0; kb < NC; kb += KB) {
                unsigned tv[KB]; f32x2 gv[KB]; f32x2 av[KB]; f32x2 hv[KB];
#pragma unroll
                for (int j = 0; j < KB; ++j) { tv[j] = *(const unsigned*)(p + (size_t)(kb + j) * 4096);
                    if (mixer == 0) { gv[j] = *(const f32x2*)(g + (kb + j) * 64); hv[j] = *(const f32x2*)(g31 + (kb + j) * 64); } else if (mixer == 1) av[j] = *(const f32x2*)(sc + (kb + j) * 4); }
#pragma unroll
                for (int j = 0; j < KB; ++j) {
                    const float t0 = bflo(tv[j]), t1 = bfhi(tv[j]);
                    if (mixer == 0) { *(unsigned*)(p + (size_t)(kb + j) * 4096) = pk2(s0 * hv[j][0], s1 * hv[j][1]); s0 = gv[j][0] * s0 + t0; s1 = gv[j][1] * s1 + t1; }
                    else if (mixer == 2) { *(unsigned*)(p + (size_t)(kb + j) * 4096) = pk2(s0 * gr32, s1 * gr32); s0 = gr * s0 + t0; s1 = gr * s1 + t1; }
                    else { *(unsigned*)(p + (size_t)(kb + j) * 4096) = pk2(s0, s1);
                        const float a = av[j][0], bl = av[j][1], mn = fmaxf(bl + m, a), ds = fast_exp(bl + m - mn), dl = fast_exp(a - mn); s0 = ds * s0 + dl * t0; s1 = ds * s1 + dl * t1; m = mn; }
                }
            }
        } else {
            const int j = i - 3 * ncol2, bh = j >> 6, d = j & 63;
            float* p = wsp<float>(c, WS_MNL) + (size_t)bh * NC * 64 + d; float* sc = wsp<float>(c, WS_MSC) + (size_t)bh * NC * 4; float m = 0.f, s = 0.f;
            for (int k = 0; k < NC; ++k) { const float a = sc[k * 4], bl = sc[k * 4 + 1], mn = fmaxf(bl + m, a);
                const float t = p[k * 64]; p[k * 64] = s; if (d == 0) sc[k * 4 + 2] = m; s = fast_exp(bl + m - mn) * s + fast_exp(a - mn) * t; m = mn; }
        }
    }
}

DEV void recur_out_wave(const Ctx& c, int l, int unit) {
    const int mixer = unit / (BATCH * NH * NC), r = unit % (BATCH * NH * NC), b = r / (NH * NC), h = (r / NC) % NH, ck = r % NC;
    const bf16_t* proj = wsp<bf16_t>(c, WS_PROJ); const int tok0 = b * SEQ + ck * 64;
    const bf16_t* st = wsp<bf16_t>(c, WS_ST + mixer * ST_ONE) + (size_t)r * 4096;
    const int fr = c.lane & 15, fq = c.lane >> 4;
    const int qcol = (mixer == 0 ? C_HQ : mixer == 1 ? C_MQ : C_RQ) + h * 64, kcol = (mixer == 0 ? C_HF : mixer == 1 ? C_MK : C_RK) + h * 64;
    const int vcol = (mixer == 0 ? C_HI : mixer == 1 ? C_MV : C_RV) + h * 64, gcol = (mixer == 0 ? C_HG : mixer == 1 ? C_MO : C_RG) + h * 64;
    const float* onorm = (mixer == 0 ? CIN(4) : mixer == 1 ? CIN(8) : CIN(13)) + (size_t)l * MW + h * 64;
    bf16x8 ka[4][2], va[4][2], sa[4][2];
#pragma unroll
    for (int sq = 0; sq < 4; ++sq)
#pragma unroll
        for (int ks = 0; ks < 2; ++ks) {
            ka[sq][ks] = *(const bf16x8*)(proj + (size_t)(tok0 + 16 * sq + fr) * PROJ_LD + kcol + 32 * ks + 8 * fq);
            sa[sq][ks] = *(const bf16x8*)(st + (16 * sq + fr) * 64 + 32 * ks + 8 * fq);
            const bf16_t* vp = proj + (size_t)(tok0 + 16 * sq + fr) * PROJ_LD + vcol + 32 * ks + 4 * fq;
            const u32x2 v0 = *(const u32x2*)vp, v1 = *(const u32x2*)(vp + 16); const u32x4 vv = {v0.x, v0.y, v1.x, v1.y}; va[sq][ks] = __builtin_bit_cast(bf16x8, vv);
        }
    bf16x8 sn[2], vones; float mst = 0.f;
    if (mixer == 1) {
        const float* nst = wsp<float>(c, WS_MNL) + (size_t)r * 64; mst = wsp<float>(c, WS_MSC)[(size_t)r * 4 + 2];
#pragma unroll
        for (int ks = 0; ks < 2; ++ks) { const f32x4 n0 = *(const f32x4*)(nst + 32 * ks + 8 * fq), n1 = *(const f32x4*)(nst + 32 * ks + 8 * fq + 4);
            u32x4 w = {pk2(n0[0], n0[1]), pk2(n0[2], n0[3]), pk2(n1[0], n1[1]), pk2(n1[2], n1[3])}; if (fr != 0) w = (u32x4){0u, 0u, 0u, 0u}; sn[ks] = __builtin_bit_cast(bf16x8, w); }
        const unsigned one2 = (fr == 0) ? 0x3f803f80u : 0u; const u32x4 ow = {one2, one2, one2, one2}; vones = __builtin_bit_cast(bf16x8, ow);
    }
#pragma unroll
    for (int tq = 0; tq < 4; ++tq) {
        const int tok = tok0 + 16 * tq + fr;
        bf16x8 qb[2];
#pragma unroll
        for (int ks = 0; ks < 2; ++ks) qb[ks] = *(const bf16x8*)(proj + (size_t)tok * PROJ_LD + qcol + 32 * ks + 8 * fq);
        f32x4 stt[4];
#pragma unroll
        for (int sq = 0; sq < 4; ++sq) { stt[sq] = (f32x4){0.f, 0.f, 0.f, 0.f};
            if (sq <= tq) { stt[sq] = mfma16(ka[sq][0], qb[0], stt[sq]); stt[sq] = mfma16(ka[sq][1], qb[1], stt[sq]); } }
#pragma unroll
        for (int i = 0; i < 4; ++i) if (4 * fq + i > fr) stt[tq][i] = 0.f;
        f32x4 ot[4], os[4], o5 = {0.f, 0.f, 0.f, 0.f}, s5 = {0.f, 0.f, 0.f, 0.f};
#pragma unroll
        for (int eq = 0; eq < 4; ++eq) { ot[eq] = (f32x4){0.f, 0.f, 0.f, 0.f}; os[eq] = (f32x4){0.f, 0.f, 0.f, 0.f}; }
#pragma unroll
        for (int m = 0; m < 2; ++m) if (2 * m <= tq) {
            const u32x4 pw = {pk2(stt[2 * m][0], stt[2 * m][1]), pk2(stt[2 * m][2], stt[2 * m][3]), pk2(stt[2 * m + 1][0], stt[2 * m + 1][1]), pk2(stt[2 * m + 1][2], stt[2 * m + 1][3])};
            const bf16x8 pb = __builtin_bit_cast(bf16x8, pw);
#pragma unroll
            for (int eq = 0; eq < 4; ++eq) ot[eq] = mfma16(va[eq][m], pb, ot[eq]);
            if (mixer == 1) o5 = mfma16(vones, pb, o5);
        }
        if (mixer != 1) {
#pragma unroll
            for (int eq = 0; eq < 4; ++eq) { ot[eq] = mfma16(sa[eq][0], qb[0], ot[eq]); ot[eq] = mfma16(sa[eq][1], qb[1], ot[eq]); }
        } else {
#pragma unroll
            for (int eq = 0; eq < 4; ++eq) { os[eq] = mfma16(sa[eq][0], qb[0], os[eq]); os[eq] = mfma16(sa[eq][1], qb[1], os[eq]); }
            s5 = mfma16(sn[0], qb[0], s5); s5 = mfma16(sn[1], qb[1], s5);
            const float* mts = wsp<float>(c, WS_MTS) + ((size_t)tok * NH + h) * 2; const float bt = mts[0], ml = mts[1];
            const float inter = bt + mst, mt = fmaxf(inter, ml), rt = fast_exp(ml - mt), stc = fast_exp(mst + ml - mt);
            const float den = shfl_f(rt * o5[0] + stc * s5[0], fr);
            const float inv = fast_rcp(fmaxf(fabsf(den), fast_exp(-mt)));
#pragma unroll
            for (int eq = 0; eq < 4; ++eq) ot[eq] = (ot[eq] * rt + os[eq] * stc) * inv;
        }
        float ss = 0.f;
#pragma unroll
        for (int eq = 0; eq < 4; ++eq) ss += (ot[eq][0] * ot[eq][0] + ot[eq][1] * ot[eq][1]) + (ot[eq][2] * ot[eq][2] + ot[eq][3] * ot[eq][3]);
        ss += xorf<16>(ss); ss += xorf<32>(ss);
        const float rn = fast_rsqrt(ss * (1.0f / 64.0f) + NORM_EPS);
        bf16_t* out = wsp<bf16_t>(c, WS_OUTS) + (size_t)(mixer == 0 ? 0 : mixer == 1 ? 1 : 3) * NT * MW + (size_t)tok * MW + h * 64 + 4 * fq;
#pragma unroll
        for (int eq = 0; eq < 4; ++eq) { const u32x2 gv = *(const u32x2*)(proj + (size_t)tok * PROJ_LD + gcol + 16 * eq + 4 * fq); const f32x4 on = *(const f32x4*)(onorm + 16 * eq + 4 * fq);
            const float g0 = bflo(gv.x), g1 = bfhi(gv.x), g2 = bflo(gv.y), g3 = bfhi(gv.y);
            const float a0 = ot[eq][0] * rn * on[0] * (mixer == 1 ? sigmoidf_(g0) : siluf_(g0)), a1 = ot[eq][1] * rn * on[1] * (mixer == 1 ? sigmoidf_(g1) : siluf_(g1));
            const float a2 = ot[eq][2] * rn * on[2] * (mixer == 1 ? sigmoidf_(g2) : siluf_(g2)), a3 = ot[eq][3] * rn * on[3] * (mixer == 1 ? sigmoidf_(g3) : siluf_(g3));
            u32x2 w; w.x = pk2(a0, a1); w.y = pk2(a2, a3); *(u32x2*)(out + 16 * eq) = w; }
    }
}
#ifndef HOST_EMU
DEV void wave_sync() { __builtin_amdgcn_fence(__ATOMIC_ACQ_REL, "wavefront"); __builtin_amdgcn_wave_barrier(); }
#else
static inline void wave_sync() { emu_bar_wait(emu_wave().bar, 64); }
#endif

DEV void nsa_kprep_item(const Ctx& c, int l, int item) {
    const bf16_t* proj = wsp<bf16_t>(c, WS_PROJ); bf16_t* ksw = wsp<bf16_t>(c, WS_KSW);
    const float* cosT = wsp<float>(c, WS_ROPE); const float* sinT = cosT + SEQ * 32;
    const int tok = item * 4 + (c.tid >> 7), vec = (c.tid >> 5) & 3, br = vec >> 1, g = vec & 1, d = c.tid & 31;
    const int col = (br == 0 ? C_NKS : C_NKW) + g * 64;
    const float x1 = bf2f(proj[(size_t)tok * PROJ_LD + col + d]), x2 = bf2f(proj[(size_t)tok * PROJ_LD + col + d + 32]);
    float ss = x1 * x1 + x2 * x2;
    ss += xorf<1>(ss); ss += xorf<2>(ss); ss += xorf<4>(ss); ss += xorf<8>(ss); ss += xorf<16>(ss);
    const float r = fast_rsqrt(ss * (1.0f / 64.0f) + NORM_EPS); const float* kg = CIN(10) + ((size_t)l * 3 + 1 + br) * 64;
    const float y1 = x1 * r * kg[d], y2 = x2 * r * kg[d + 32]; const int pos = tok % SEQ;
    const float cs = cosT[pos * 32 + d], sn = sinT[pos * 32 + d];
    bf16_t* o = ksw + (size_t)tok * 256 + vec * 64;
    o[d] = f2bf(y1 * cs - y2 * sn); o[d + 32] = f2bf(y1 * sn + y2 * cs);
}
DEV void nsa_compress_unit(const Ctx& c, int l, int unit) {
    const int half = unit & 1, kv = (unit >> 1) & 1, g = (unit >> 2) & 1, b = unit >> 3;
    const bf16_t* proj = wsp<bf16_t>(c, WS_PROJ); const bf16_t* wct = wsp<bf16_t>(c, WS_WCT) + (size_t)kv * 64 * 2048;
    const int fr = c.lane & 15, fq = c.lane >> 4, n0 = half * 128 + c.wave * 16, n = n0 + fr;
    const int col = (kv == 0 ? C_NKC : C_NVC) + g * 64;
    if (n0 >= NCMP_PAD) return;
    f32x4 acc[4];
#pragma unroll
    for (int et = 0; et < 4; ++et) acc[et] = (f32x4){0.f, 0.f, 0.f, 0.f};
#pragma unroll 8
    for (int k0 = 0; k0 < 2048; k0 += 32) {
        const int kk = k0 + fq * 8, lrow = kk >> 6, d0 = kk & 63;
        bf16x8 a = {0, 0, 0, 0, 0, 0, 0, 0};
        if (n < NCMP) a = *(const bf16x8*)(proj + (size_t)(b * SEQ + 16 * n + lrow) * PROJ_LD + col + d0);
#pragma unroll
        for (int et = 0; et < 4; ++et) { const bf16x8 bb = *(const bf16x8*)(wct + (size_t)(et * 16 + fr) * 2048 + kk); acc[et] = mfma16(a, bb, acc[et]); }
    }
    const float* bias = wsp<float>(c, WS_CBIAS) + kv * 64;
    float v[4][4];
#pragma unroll
    for (int et = 0; et < 4; ++et)
#pragma unroll
        for (int i = 0; i < 4; ++i) v[et][i] = acc[et][i] + bias[et * 16 + fr];
    if (kv == 0) {
        const float* kg = CIN(10) + (size_t)l * 3 * 64; bf16_t* kc = wsp<bf16_t>(c, WS_KCMP) + (size_t)(b * 2 + g) * NCMP_PAD * 64;
#pragma unroll
        for (int i = 0; i < 4; ++i) { float ss = 0.f;
#pragma unroll
            for (int et = 0; et < 4; ++et) ss += v[et][i] * v[et][i];
            ss += xorf<1>(ss); ss += xorf<2>(ss); ss += xorf<4>(ss); ss += xorf<8>(ss);
            const float r = fast_rsqrt(ss * (1.0f / 64.0f) + NORM_EPS);
#pragma unroll
            for (int et = 0; et < 4; ++et) kc[(size_t)(n0 + fq * 4 + i) * 64 + et * 16 + fr] = f2bf(v[et][i] * r * kg[et * 16 + fr]); }
    } else {
        bf16_t* vt = wsp<bf16_t>(c, WS_VCMPT) + (size_t)(b * 2 + g) * 64 * NCMP_PAD;
#pragma unroll
        for (int et = 0; et < 4; ++et)
#pragma unroll
            for (int i = 0; i < 4; ++i) vt[(size_t)(et * 16 + fr) * NCMP_PAD + n0 + fq * 4 + i] = f2bf(v[et][i]);
    }
}

DEV void nsa_vprep_item(const Ctx& c, int item) {
    const int tt = item % NC, r = item / NC, br = r & 1, g = (r >> 1) & 1, b = r >> 2;
    bf16_t* proj = wsp<bf16_t>(c, WS_PROJ); LDSP bf16_t* T = (LDSP bf16_t*)c.lds; const int col = (br == 0 ? C_NVS : C_NVW) + g * 64, tok0 = b * SEQ + tt * 64;
    load_tile_T(c, T, proj, tok0, col);
    block_sync();
    { const int e = c.tid >> 3, t0 = (c.tid & 7) * 8; *(u32x4*)(proj + (size_t)(tok0 + e) * PROJ_LD + col + t0) = *(const LDSP u32x4*)(T + e * LT_STRIDE + t0); }
    block_sync();
}

constexpr int NA_PC = 0, NA_PCLD = 264, NA_BUF = 36864, NA_KLD = 72, NA_VLD = 136, NA_VOFF = 18432, NA_IMP = 73728, NA_SEL = NA_IMP + 16640, NA_GATE = NA_SEL + 512;
constexpr float NEG_BIG = -1.0e30f;

#ifndef HOST_EMU
DEV float fmax_fast(float a, float b) { return __builtin_amdgcn_fmed3f(a, b, __builtin_inff()); }
#else
static inline float fmax_fast(float a, float b) { return a > b ? a : b; }
#endif
constexpr float NEG_HUGE = -3.0e38f;
template <int MODE, bool EDGE>
DEV void nsa_stage(const Ctx& c, int buf, int js, int qt, const bf16x8 (&qr)[2], f32x4 (&ot)[4], float& mrun, float& lrun, unsigned long long selm) {
    const LDSP bf16_t* Kt = (const LDSP bf16_t*)(c.lds + buf * NA_BUF); const LDSP bf16_t* VT = (const LDSP bf16_t*)(c.lds + buf * NA_BUF + NA_VOFF);
    const int fr = c.lane & 15, fq = c.lane >> 4, q = (c.wave & 3) * 16 + fr;
    f32x4 st[8];
#pragma unroll
    for (int kt = 0; kt < 8; ++kt) { st[kt] = (f32x4){0.f, 0.f, 0.f, 0.f};
        st[kt] = mfma16(*(const LDSP bf16x8*)(Kt + (kt * 16 + fr) * NA_KLD + fq * 8), qr[0], st[kt]);
        st[kt] = mfma16(*(const LDSP bf16x8*)(Kt + (kt * 16 + fr) * NA_KLD + 32 + fq * 8), qr[1], st[kt]); }
    if (EDGE) {
#pragma unroll
        for (int kt = 0; kt < 8; ++kt) { const int j = js + (kt >> 2);
#pragma unroll
            for (int i = 0; i < 4; ++i) { const int kk = (kt & 3) * 16 + fq * 4 + i; bool ok;
                if (MODE == 0) ok = (j <= qt) && ((selm >> j) & 1ull) && (j < qt || kk <= q);
                else { const int dlt = (qt - j) * 64 + q - kk; ok = dlt >= 0 && dlt < 512; }
                st[kt][i] = ok ? st[kt][i] : NEG_HUGE; } }
    } else if (MODE == 0) {
        const float b0 = ((selm >> js) & 1ull) ? 0.f : NEG_HUGE, b1 = ((selm >> (js + 1)) & 1ull) ? 0.f : NEG_HUGE;
#pragma unroll
        for (int kt = 0; kt < 8; ++kt) st[kt] += (kt < 4) ? b0 : b1;
    }
    float mx = NEG_HUGE;
#pragma unroll
    for (int kt = 0; kt < 8; ++kt) mx = fmax_fast(mx, fmax_fast(fmax_fast(st[kt][0], st[kt][1]), fmax_fast(st[kt][2], st[kt][3])));
    mx = fmax_fast(mx, xorf<16>(mx)); mx = fmax_fast(mx, xorf<32>(mx));
    const float mn = fmax_fast(mrun, mx), alpha = fast_exp2(mrun - mn); mrun = mn; float ps = 0.f;
#pragma unroll
    for (int kt = 0; kt < 8; ++kt)
#pragma unroll
        for (int i = 0; i < 4; ++i) { const float pv = fast_exp2(st[kt][i] - mn); st[kt][i] = pv; ps += pv; }
    lrun = lrun * alpha + ps;
#pragma unroll
    for (int et = 0; et < 4; ++et) ot[et] *= alpha;
#pragma unroll
    for (int m = 0; m < 4; ++m) {
        const u32x4 pw = {pk2(st[2 * m][0], st[2 * m][1]), pk2(st[2 * m][2], st[2 * m][3]), pk2(st[2 * m + 1][0], st[2 * m + 1][1]), pk2(st[2 * m + 1][2], st[2 * m + 1][3])};
        const bf16x8 pb = __builtin_bit_cast(bf16x8, pw);
#pragma unroll
        for (int et = 0; et < 4; ++et) { const LDSP bf16_t* vrow = VT + (et * 16 + fr) * NA_VLD + 32 * m + 4 * fq;
            const u32x2 v0 = *(const LDSP u32x2*)vrow, v1 = *(const LDSP u32x2*)(vrow + 16);
            const u32x4 vv = {v0.x, v0.y, v1.x, v1.y};
            ot[et] = mfma16(__builtin_bit_cast(bf16x8, vv), pb, ot[et]); }
    }
}

DEV void nsa_attn_unit(const Ctx& c, int l, int unit) {
    const int qt = unit % NSEL, bg = unit / NSEL, g = bg & 1, b = bg >> 1;
    const bf16_t* proj = wsp<bf16_t>(c, WS_PROJ); const bf16_t* ksw = wsp<bf16_t>(c, WS_KSW);
    const float* cosT = wsp<float>(c, WS_ROPE); const float* sinT = cosT + SEQ * 32;
    LDSP bf16_t* Pc = (LDSP bf16_t*)(c.lds + NA_PC); LDSP float* imp = (LDSP float*)(c.lds + NA_IMP); LDSP unsigned long long* selmask = (LDSP unsigned long long*)(c.lds + NA_SEL);
    LDSP float* gates = (LDSP float*)(c.lds + NA_GATE);
    const int fr = c.lane & 15, fq = c.lane >> 4, hg = c.wave >> 2, hd = g * 2 + hg, qw = (c.wave & 3) * 16;
    const int tokq0 = b * SEQ + qt * 64;
    bf16x8 qc[2], qr[2];
    {
        const int tok = tokq0 + qw + fr, pos = qt * 64 + qw + fr;
        const u32x4 v0 = *(const u32x4*)(proj + (size_t)tok * PROJ_LD + C_NQ + hd * 64 + fq * 8), v1 = *(const u32x4*)(proj + (size_t)tok * PROJ_LD + C_NQ + hd * 64 + 32 + fq * 8);
        float x0[8] = {bflo(v0.x), bfhi(v0.x), bflo(v0.y), bfhi(v0.y), bflo(v0.z), bfhi(v0.z), bflo(v0.w), bfhi(v0.w)};
        float x1[8] = {bflo(v1.x), bfhi(v1.x), bflo(v1.y), bfhi(v1.y), bflo(v1.z), bfhi(v1.z), bflo(v1.w), bfhi(v1.w)};
        float ss = 0.f;
#pragma unroll
        for (int j = 0; j < 8; ++j) ss += x0[j] * x0[j] + x1[j] * x1[j];
        ss += xorf<16>(ss); ss += xorf<32>(ss);
        const float r = fast_rsqrt(ss * (1.0f / 64.0f) + NORM_EPS) * 0.125f; const float* qg = CIN(9) + (size_t)l * 64;
#pragma unroll
        for (int j = 0; j < 8; ++j) { const int d = fq * 8 + j; const float y0 = x0[j] * r * qg[d], y1 = x1[j] * r * qg[d + 32];
            const float cs = cosT[pos * 32 + d], sn = sinT[pos * 32 + d];
            qc[0][j] = (short)f2bf(y0); qc[1][j] = (short)f2bf(y1); qr[0][j] = (short)f2bf((y0 * cs - y1 * sn) * 1.44269504f); qr[1][j] = (short)f2bf((y0 * sn + y1 * cs) * 1.44269504f); }
    }
    if (c.tid < 384) { const int row = c.tid / 3, br = c.tid % 3, hh = row >> 6, q = row & 63;
        gates[c.tid] = sigmoidf_(bf2f(proj[(size_t)(tokq0 + q) * PROJ_LD + C_NG + (g * 2 + hh) * 3 + br])); }
    f32x4 ofin[4];
#pragma unroll
    for (int et = 0; et < 4; ++et) ofin[et] = (f32x4){0.f, 0.f, 0.f, 0.f};
    const int nvis = 4 * qt + 3, nkt = (nvis + 15) >> 4, nk32 = ((nkt * 16 + 31) >> 5) << 5;
    {
        const bf16_t* kc = wsp<bf16_t>(c, WS_KCMP) + (size_t)(b * 2 + g) * NCMP_PAD * 64;
        f32x4 s[16];
#pragma unroll
        for (int jt = 0; jt < 16; ++jt) { s[jt] = (f32x4){0.f, 0.f, 0.f, 0.f};
            if (jt < nkt) { s[jt] = mfma16(qc[0], *(const bf16x8*)(kc + (size_t)(jt * 16 + fr) * 64 + fq * 8), s[jt]);
                            s[jt] = mfma16(qc[1], *(const bf16x8*)(kc + (size_t)(jt * 16 + fr) * 64 + 32 + fq * 8), s[jt]); } }
#pragma unroll
        for (int i = 0; i < 4; ++i) {
            const int sp = qt * 64 + qw + fq * 4 + i, lim = (sp >= 31) ? ((sp - 31) >> 4) : -1;
            float mx = NEG_BIG;
#pragma unroll
            for (int jt = 0; jt < 16; ++jt) if (jt < nkt && jt * 16 + fr <= lim) mx = fmaxf(mx, s[jt][i]);
            mx = fmaxf(mx, xorf<1>(mx)); mx = fmaxf(mx, xorf<2>(mx)); mx = fmaxf(mx, xorf<4>(mx)); mx = fmaxf(mx, xorf<8>(mx));
            float ps = 0.f;
#pragma unroll
            for (int jt = 0; jt < 16; ++jt) { float p = 0.f; if (jt < nkt && jt * 16 + fr <= lim) p = fast_exp(s[jt][i] - mx); s[jt][i] = p; ps += p; }
            ps += xorf<1>(ps); ps += xorf<2>(ps); ps += xorf<4>(ps); ps += xorf<8>(ps);
            const float inv = ps > 0.f ? fast_rcp(ps) : 0.f;
            LDSP bf16_t* prow = Pc + (size_t)(hg * 64 + qw + fq * 4 + i) * NA_PCLD;
#pragma unroll
            for (int jt = 0; jt < 16; ++jt) if (jt * 16 < nk32) prow[jt * 16 + fr] = f2bf(s[jt][i] * inv);
        }
        wave_sync();
        const bf16_t* vt = wsp<bf16_t>(c, WS_VCMPT) + (size_t)(b * 2 + g) * 64 * NCMP_PAD;
        f32x4 oc[4];
#pragma unroll
        for (int et = 0; et < 4; ++et) oc[et] = (f32x4){0.f, 0.f, 0.f, 0.f};
        for (int k0 = 0; k0 < nk32; k0 += 32) {
            const bf16x8 pa = *(const LDSP bf16x8*)(Pc + (size_t)(hg * 64 + qw + fr) * NA_PCLD + k0 + fq * 8);
#pragma unroll
            for (int et = 0; et < 4; ++et) oc[et] = mfma16(*(const bf16x8*)(vt + (size_t)(et * 16 + fr) * NCMP_PAD + k0 + fq * 8), pa, oc[et]);
        }
        block_sync();
#pragma unroll
        for (int et = 0; et < 4; ++et) ofin[et] += oc[et] * gates[(hg * 64 + qw + fr) * 3 + 0];
    }
    for (int e = c.tid; e < 4096; e += NTHR) { const int q = e >> 6, j = e & 63; float a = 0.f;
        if (j <= qt) {
#pragma unroll
            for (int dn = -1; dn <= 3; ++dn) { const int n = 4 * j + dn; if (n >= 0 && n < nkt * 16) a += bf2f(Pc[(size_t)q * NA_PCLD + n]) + bf2f(Pc[(size_t)(64 + q) * NA_PCLD + n]); }
            if (j == 0 || j == qt || j == qt - 1) a += 1000.f;
        } else a = NEG_BIG;
        imp[q * 65 + j] = a; }
    block_sync();
    for (int qq = 0; qq < 8; ++qq) { const int q = c.wave * 8 + qq; unsigned long long m = 0ull;
        if (qt < 16) m = (1ull << (qt + 1)) - 1ull;
        else { const unsigned key = (sortkey32(imp[q * 65 + c.lane]) & 0xffffffc0u) | (unsigned)(63 - c.lane); int rank = 0;
#pragma unroll
            for (int i = 0; i < 64; ++i) rank += ((unsigned)bcast_i((int)key, i) > key) ? 1 : 0;
            m = ballot64(rank < 16); }
        if (c.lane == 0) selmask[q] = m; }
    block_sync();
    const unsigned long long selm = selmask[qw + fr];
#pragma unroll
    for (int mode = 0; mode < 2; ++mode) {
        f32x4 ot[4]; float mrun = NEG_BIG, lrun = 0.f;
#pragma unroll
        for (int et = 0; et < 4; ++et) ot[et] = (f32x4){0.f, 0.f, 0.f, 0.f};
        const int j0 = (mode == 0) ? 0 : (qt >= 8 ? qt - 8 : 0), ns = (qt - j0) / 2 + 1;
        const int skey = c.tid >> 2, sd0 = (c.tid & 3) * 16, se = c.tid >> 3, sk0 = (c.tid & 7) * 16;
        u32x4 rk0, rk1, rv0, rv1;
#define NSA_STAGE_LOAD(js_) do { const int jb_ = (js_) + (skey >> 6) > qt ? qt : (js_) + (skey >> 6); const size_t tok_ = (size_t)b * SEQ + jb_ * 64 + (skey & 63); \
            const bf16_t* kp_ = ksw + tok_ * 256 + (mode * 2 + g) * 64 + sd0; rk0 = *(const u32x4*)kp_; rk1 = *(const u32x4*)(kp_ + 8); \
            const int jv_ = (js_) + (sk0 >> 6) > qt ? qt : (js_) + (sk0 >> 6); const bf16_t* vp_ = proj + ((size_t)b * SEQ + jv_ * 64 + se) * PROJ_LD + (mode == 0 ? C_NVS : C_NVW) + g * 64 + (sk0 & 63); rv0 = *(const u32x4*)vp_; rv1 = *(const u32x4*)(vp_ + 8); } while (0)
#define NSA_STAGE_WRITE(buf_) do { LDSP bf16_t* kd_ = (LDSP bf16_t*)(c.lds + (buf_) * NA_BUF) + skey * NA_KLD + sd0; *(LDSP u32x4*)kd_ = rk0; *(LDSP u32x4*)(kd_ + 8) = rk1; \
            LDSP bf16_t* vd_ = (LDSP bf16_t*)(c.lds + (buf_) * NA_BUF + NA_VOFF) + se * NA_VLD + sk0; *(LDSP u32x4*)vd_ = rv0; *(LDSP u32x4*)(vd_ + 8) = rv1; } while (0)
        NSA_STAGE_LOAD(j0); NSA_STAGE_WRITE(0);
        block_sync();
        for (int sidx = 0; sidx < ns; ++sidx) {
            const int js = j0 + 2 * sidx;
            if (sidx + 1 < ns) NSA_STAGE_LOAD(js + 2);
            const bool edge = (mode == 0) ? (js + 1 >= qt) : (sidx == 0 || js + 1 >= qt);
            if (mode == 0) { if (edge) nsa_stage<0, true>(c, sidx & 1, js, qt, qr, ot, mrun, lrun, selm); else nsa_stage<0, false>(c, sidx & 1, js, qt, qr, ot, mrun, lrun, selm); }
            else { if (edge) nsa_stage<1, true>(c, sidx & 1, js, qt, qr, ot, mrun, lrun, selm); else nsa_stage<1, false>(c, sidx & 1, js, qt, qr, ot, mrun, lrun, selm); }
            if (sidx + 1 < ns) NSA_STAGE_WRITE((sidx + 1) & 1);
            block_sync();
        }
#undef NSA_STAGE_LOAD
#undef NSA_STAGE_WRITE
        float ls = lrun; ls += xorf<16>(ls); ls += xorf<32>(ls);
        const float sc = gates[(hg * 64 + qw + fr) * 3 + 1 + mode] * (ls > 0.f ? fast_rcp(ls) : 0.f);
#pragma unroll
        for (int et = 0; et < 4; ++et) ofin[et] += ot[et] * sc;
    }
    bf16_t* out = wsp<bf16_t>(c, WS_OUTS) + (size_t)2 * NT * MW + (size_t)(tokq0 + qw + fr) * MW + hd * 64 + fq * 4;
#pragma unroll
    for (int et = 0; et < 4; ++et) { u32x2 w; w.x = pk2(ofin[et][0], ofin[et][1]); w.y = pk2(ofin[et][2], ofin[et][3]); *(u32x2*)(out + et * 16) = w; }
    block_sync();
}
constexpr int PEER_WSCR = (4 * 256 + 3 * 128) * 4;
constexpr int PEER_TAB = 8 * PEER_WSCR;
#ifndef HOST_EMU
DEV int uniform_i(int v) { return __builtin_amdgcn_readfirstlane(v); }
#else
static inline int uniform_i(int v) { return v; }
#endif
DEV unsigned sortkey16(unsigned b) { return (b & 0x8000u) ? (~b & 0xffffu) : (b | 0x8000u); }
DEV f32x2 dot16_fp8(const f32x2 (&x)[8], const u32x4 q, f32x2 s) {
#pragma unroll
    for (int i = 0; i < 4; ++i) { const f32x2 lo = cvt_pk_f32_fp8(q[i], false), hi = cvt_pk_f32_fp8(q[i], true); s = x[2 * i] * lo + s; s = x[2 * i + 1] * hi + s; }
    return s;
}
DEV void axpy16_fp8(f32x2 (&acc)[8], float w, const u32x4 q) {
    const f32x2 w2 = {w, w};
#pragma unroll
    for (int i = 0; i < 4; ++i) { const f32x2 lo = cvt_pk_f32_fp8(q[i], false), hi = cvt_pk_f32_fp8(q[i], true); acc[2 * i] = w2 * lo + acc[2 * i]; acc[2 * i + 1] = w2 * hi + acc[2 * i + 1]; }
}
DEV void peer_init_tab(const Ctx& c) {
    if (c.tid < 64) { const int t = c.tid; int a, b;
        if (t < 16) { a = 0; b = t; } else if (t < 24) { a = 1; b = t - 16; } else if (t < 29) { a = 2; b = t - 24; } else if (t < 33) { a = 3; b = t - 29; }
        else if (t < 36) { a = 4; b = t - 33; } else if (t < 42) { a = 5 + (t - 36) / 2; b = (t - 36) & 1; } else { a = 8 + (t - 42); b = 0; }
        ((LDSP unsigned char*)(c.lds + PEER_TAB))[t] = (t < 50) ? (unsigned char)((a << 4) | b) : (unsigned char)0xff; }
    block_sync();
}
DEV void peer_token(const Ctx& c, int l, int tok) {
    const int lane = c.lane;
    LDSP float* Wv = (LDSP float*)(c.lds + c.wave * PEER_WSCR); LDSP int* Wi = (LDSP int*)(Wv + 256); LDSP float* Sv = (LDSP float*)(Wi + 256); LDSP int* Si = (LDSP int*)(Sv + 256);
    LDSP int* We = Si + 256; LDSP float* Ws = (LDSP float*)(We + 128); LDSP float* Wg = Ws + 128;
    const bf16_t* sc = wsp<bf16_t>(c, WS_SCORES) + (size_t)tok * PEER_N;
#ifndef DUP_TOPK
#define DUP_TOPK 1
#endif
    for (int rep_ = 0; rep_ < DUP_TOPK; ++rep_) {
    unsigned w[16];
#pragma unroll
    for (int gi = 0; gi < 16; ++gi) w[gi] = *(const unsigned*)(sc + gi * 128 + 2 * lane);
#pragma unroll
    for (int gq = 0; gq < 16; gq += 4) {
        unsigned k0[4], k1[4], T[4];
#pragma unroll
        for (int u = 0; u < 4; ++u) { k0[u] = sortkey16(w[gq + u] & 0xffffu); k1[u] = sortkey16(w[gq + u] >> 16); T[u] = 0u; }
#pragma unroll
        for (int bit = 15; bit >= 0; --bit) {
            unsigned long long ba[4], bb[4];
#pragma unroll
            for (int u = 0; u < 4; ++u) { const unsigned cand = T[u] | (1u << bit); ba[u] = ballot64(k0[u] >= cand); bb[u] = ballot64(k1[u] >= cand); }
#pragma unroll
            for (int u = 0; u < 4; ++u) { const int cnt = __builtin_popcountll(ba[u]) + __builtin_popcountll(bb[u]); if (cnt >= 16) T[u] |= (1u << bit); }
        }
#pragma unroll
        for (int u = 0; u < 4; ++u) { const int gi = gq + u;
            const unsigned long long gt0 = ballot64(k0[u] > T[u]), gt1 = ballot64(k1[u] > T[u]), eq0 = ballot64(k0[u] == T[u]), eq1 = ballot64(k1[u] == T[u]);
            const int need = 16 - __builtin_popcountll(gt0) - __builtin_popcountll(gt1);
            const int eqr0 = mbcnt64(eq0) + mbcnt64(eq1), eqr1 = eqr0 + (k0[u] == T[u] ? 1 : 0);
            const bool sel0 = (k0[u] > T[u]) || (k0[u] == T[u] && eqr0 < need), sel1 = (k1[u] > T[u]) || (k1[u] == T[u] && eqr1 < need);
            const unsigned long long s0 = ballot64(sel0), s1 = ballot64(sel1);
            const int slot0 = mbcnt64(s0) + mbcnt64(s1), slot1 = slot0 + (sel0 ? 1 : 0);
            if (sel0) { Wv[gi * 16 + slot0] = bflo(w[gi]); Wi[gi * 16 + slot0] = 2 * lane; }
            if (sel1) { Wv[gi * 16 + slot1] = bfhi(w[gi]); Wi[gi * 16 + slot1] = 2 * lane + 1; } }
    }
    wave_sync();
#pragma unroll
    for (int pass = 0; pass < 4; ++pass) { const int g = pass * 4 + (lane >> 4), e = lane & 15; const float v = Wv[g * 16 + e]; const int iv = Wi[g * 16 + e]; int rank = 0;
#pragma unroll
        for (int j = 0; j < 16; ++j) { const float vj = Wv[g * 16 + j]; const int ij = Wi[g * 16 + j]; rank += (vj > v || (vj == v && ij < iv)) ? 1 : 0; }
        Sv[g * 16 + rank] = v; Si[g * 16 + rank] = iv; }
    wave_sync();
    const unsigned ab = ((const LDSP unsigned char*)(c.lds + PEER_TAB))[lane]; const bool valid = ab != 0xffu; const int a = (ab >> 4) & 15, b = ab & 15;
    for (int h = 0; h < 8; ++h) {
        const float s = valid ? Sv[(2 * h) * 16 + a] + Sv[(2 * h + 1) * 16 + b] : -3.0e38f;
        const unsigned key = valid ? ((sortkey32(s) & 0xffffff00u) | (unsigned)(255 - (a * 16 + b))) : 0u;
        int rank = 0;
#pragma unroll
        for (int j = 0; j < 50; ++j) rank += ((unsigned)bcast_i((int)key, j) > key) ? 1 : 0;
        if (valid && rank < 16) { We[h * 16 + rank] = (Si[(2 * h) * 16 + a] * 128 + Si[(2 * h + 1) * 16 + b]) & 16383; Ws[h * 16 + rank] = s; }
    }
    wave_sync();
    { const float mx = Ws[(lane >> 3) * 16]; const float e0 = fast_exp(Ws[2 * lane] - mx), e1 = fast_exp(Ws[2 * lane + 1] - mx); float sm = e0 + e1;
      sm += xorf<1>(sm); sm += xorf<2>(sm); sm += xorf<4>(sm); const float inv = fast_rcp(sm); Wg[2 * lane] = e0 * inv; Wg[2 * lane + 1] = e1 * inv; }
    wave_sync();
    }
    const bf16_t* xb = wsp<bf16_t>(c, WS_XB) + (size_t)tok * DM; const unsigned char* PU = wsp<unsigned char>(c, WS_PU); const unsigned char* PV = wsp<unsigned char>(c, WS_PV);
    f32x2 xf[8];
    { const u32x4 x0 = *(const u32x4*)(xb + 16 * lane), x1 = *(const u32x4*)(xb + 16 * lane + 8);
      xf[0] = (f32x2){bflo(x0.x), bfhi(x0.x)}; xf[1] = (f32x2){bflo(x0.y), bfhi(x0.y)}; xf[2] = (f32x2){bflo(x0.z), bfhi(x0.z)}; xf[3] = (f32x2){bflo(x0.w), bfhi(x0.w)};
      xf[4] = (f32x2){bflo(x1.x), bfhi(x1.x)}; xf[5] = (f32x2){bflo(x1.y), bfhi(x1.y)}; xf[6] = (f32x2){bflo(x1.z), bfhi(x1.z)}; xf[7] = (f32x2){bflo(x1.w), bfhi(x1.w)}; }
    const float rstd = pg8::rstd_of(pg8::rss_slots16(wsp<float>(c, WS_RSS2) + (size_t)tok * 16)) * (1.0f / 256.0f);
    f32x2 acc[8];
#pragma unroll
    for (int j = 0; j < 8; ++j) acc[j] = (f32x2){0.f, 0.f};
#define PEER_LOAD8(buf, TAB, base) do { _Pragma("unroll") for (int k_ = 0; k_ < 8; ++k_) { const int e_ = uniform_i(We[(base) + k_]); buf[k_] = *(const u32x4*)((TAB) + (size_t)e_ * DM + 16 * lane); } } while (0)
    u32x4 bu0[8], bu1[8], bv0[8], bv1[8];
    PEER_LOAD8(bu0, PU, 0); PEER_LOAD8(bu1, PU, 8);
    for (int h = 0; h < 8; ++h) {
        float part[16];
        PEER_LOAD8(bv0, PV, h * 16);
#pragma unroll
        for (int k = 0; k < 8; ++k) { const f32x2 s = dot16_fp8(xf, bu0[k], (f32x2){0.f, 0.f}); part[k] = s[0] + s[1]; }
        PEER_LOAD8(bv1, PV, h * 16 + 8);
#pragma unroll
        for (int k = 0; k < 8; ++k) { const f32x2 s = dot16_fp8(xf, bu1[k], (f32x2){0.f, 0.f}); part[8 + k] = s[0] + s[1]; }
        float p8[8], p4[4], p2[2], p1;
        { const bool up = (lane & 32) != 0;
#pragma unroll
          for (int i = 0; i < 8; ++i) { const float send = up ? part[i] : part[i + 8]; const float recv = xorf<32>(send); p8[i] = (up ? part[i + 8] : part[i]) + recv; } }
        { const bool up = (lane & 16) != 0;
#pragma unroll
          for (int i = 0; i < 4; ++i) { const float send = up ? p8[i] : p8[i + 4]; const float recv = xorf<16>(send); p4[i] = (up ? p8[i + 4] : p8[i]) + recv; } }
        { const bool up = (lane & 8) != 0;
#pragma unroll
          for (int i = 0; i < 2; ++i) { const float send = up ? p4[i] : p4[i + 2]; const float recv = xorf<8>(send); p2[i] = (up ? p4[i + 2] : p4[i]) + recv; } }
        { const bool up = (lane & 4) != 0; const float send = up ? p2[0] : p2[1]; const float recv = xorf<4>(send); p1 = (up ? p2[1] : p2[0]) + recv; }
        p1 += xorf<2>(p1); p1 += xorf<1>(p1);
        const float dk = shfl_f(p1, (lane & 15) * 4);
        const float wk = Wg[h * 16 + (lane & 15)] * gelu_erf(dk * rstd) * (1.0f / 16.0f);
        if (h < 7) PEER_LOAD8(bu0, PU, h * 16 + 16);
#pragma unroll
        for (int k = 0; k < 8; ++k) axpy16_fp8(acc, bcast_f(wk, k), bv0[k]);
        if (h < 7) PEER_LOAD8(bu1, PU, h * 16 + 24);
#pragma unroll
        for (int k = 0; k < 8; ++k) axpy16_fp8(acc, bcast_f(wk, 8 + k), bv1[k]);
    }
#undef PEER_LOAD8
    float* orow = c.out + (size_t)tok * DM + 16 * lane; float ss = 0.f; f32x4 o[4];
#pragma unroll
    for (int j = 0; j < 4; ++j) { o[j] = *(const f32x4*)(orow + 4 * j); o[j] += (f32x4){acc[2 * j][0], acc[2 * j][1], acc[2 * j + 1][0], acc[2 * j + 1][1]}; *(f32x4*)(orow + 4 * j) = o[j]; }
    if (l + 1 < DEPTH) {
        bf16_t* xo = wsp<bf16_t>(c, WS_XB) + (size_t)tok * DM + 16 * lane;
        u32x4 w0, w1; w0.x = pk2(o[0][0], o[0][1]); w0.y = pk2(o[0][2], o[0][3]); w0.z = pk2(o[1][0], o[1][1]); w0.w = pk2(o[1][2], o[1][3]);
        w1.x = pk2(o[2][0], o[2][1]); w1.y = pk2(o[2][2], o[2][3]); w1.z = pk2(o[3][0], o[3][1]); w1.w = pk2(o[3][2], o[3][3]);
        *(u32x4*)xo = w0; *(u32x4*)(xo + 8) = w1;
#pragma unroll
        for (int j = 0; j < 4; ++j) ss += (o[j][0] * o[j][0] + o[j][1] * o[j][1]) + (o[j][2] * o[j][2] + o[j][3] * o[j][3]);
        ss = wave_sum(ss);
        if (lane == 0) wsp<float>(c, WS_RSS1)[tok] = ss;
    }
    wave_sync();
}
DEV void peer_table_rows(const Ctx& c, int l) {
    const float* g2 = CIN(17) + (size_t)l * DM;
    const f32x4 ga = *((const f32x4*)g2 + 4 * c.lane), gb = *((const f32x4*)g2 + 4 * c.lane + 1), gc = *((const f32x4*)g2 + 4 * c.lane + 2), gd = *((const f32x4*)g2 + 4 * c.lane + 3);
    for (int r = c.bid * NWAVE + c.wave; r < 2 * 16384; r += c.nblk * NWAVE) {
        const int tab = r >> 14, e = r & 16383;
        const f32x4* src = (const f32x4*)((tab == 0 ? CIN(20) : CIN(21)) + ((size_t)l * 16384 + e) * DM) + 4 * c.lane;
        f32x4 v0 = src[0], v1 = src[1], v2 = src[2], v3 = src[3];
        if (tab == 0) { v0 *= ga * 256.0f; v1 *= gb * 256.0f; v2 *= gc * 256.0f; v3 *= gd * 256.0f; } else { v0 *= 16.0f; v1 *= 16.0f; v2 *= 16.0f; v3 *= 16.0f; }
        u32x4 q;
        q.x = cvt_pk_fp8_f32(v0[2], v0[3], cvt_pk_fp8_f32(v0[0], v0[1], 0u, false), true); q.y = cvt_pk_fp8_f32(v1[2], v1[3], cvt_pk_fp8_f32(v1[0], v1[1], 0u, false), true);
        q.z = cvt_pk_fp8_f32(v2[2], v2[3], cvt_pk_fp8_f32(v2[0], v2[1], 0u, false), true); q.w = cvt_pk_fp8_f32(v3[2], v3[3], cvt_pk_fp8_f32(v3[0], v3[1], 0u, false), true);
        *(u32x4*)(wsp<unsigned char>(c, tab == 0 ? WS_PU : WS_PV) + (size_t)e * DM + 16 * c.lane) = q;
    }
}
#ifndef HOST_EMU
#define XB_TMO      128
#define XB_XCNT(j)  (256  + 64 * (j))
#define XB_XSUB(j)  (1280 + 64 * (j))
#define XB_XGEN(j)  (2304 + 64 * (j))
#define XB_TOP      3328
#define XB_TOPGEN   3392
#define XCD_BAR_WORDS 3456
#define XB_SPIN_CAP (1u << 18)

__device__ __forceinline__ unsigned xb_ld(unsigned* p)              { return __hip_atomic_load(p, __ATOMIC_RELAXED, __HIP_MEMORY_SCOPE_AGENT); }
__device__ __forceinline__ unsigned xb_add(unsigned* p, unsigned v) { return __hip_atomic_fetch_add(p, v, __ATOMIC_RELAXED, __HIP_MEMORY_SCOPE_AGENT); }
__device__ __forceinline__ unsigned xb_xcc_id() { return (unsigned)__builtin_amdgcn_s_getreg((3 << 11) | 20) & 0xFu; }
#define XB_SPIN(cond, bar) do { unsigned _sp = 0; while (cond) { __builtin_amdgcn_s_sleep(1); \
    if ((++_sp & 255u) == 0u) { if (xb_ld(&(bar)[XB_TMO])) break; if (_sp > XB_SPIN_CAP) { atomicAdd(&(bar)[XB_TMO], 1u); break; } } } } while (0)

struct XcdBarrier {
    unsigned* bar; unsigned x;
    volatile __attribute__((address_space(3))) unsigned* st;
};

__device__ __forceinline__ XcdBarrier xcd_barrier_post(unsigned* bar, volatile __attribute__((address_space(3))) unsigned* st) {
    XcdBarrier b; b.bar = bar; b.x = xb_xcc_id(); b.st = st;
    if (threadIdx.x == 0) (void)xb_add(&bar[XB_XCNT(b.x)], 1u);
    return b;
}
__device__ __forceinline__ void xcd_barrier_complete(unsigned* bar, unsigned x, unsigned& nloc, unsigned& nx) {
    const unsigned G = gridDim.x * gridDim.y * gridDim.z;
    unsigned sum, cnt, mine, sp = 0u;
    for (;;) {
        sum = 0u; cnt = 0u; mine = 0u;
#pragma unroll
        for (unsigned j = 0; j < 16; ++j) { const unsigned c = xb_ld(&bar[XB_XCNT(j)]); sum += c; cnt += (c > 0u) ? 1u : 0u; mine = (j == x) ? c : mine; }
        if (sum == G) break;
        __builtin_amdgcn_s_sleep(1);
        if ((++sp & 255u) == 0u) { if (xb_ld(&bar[XB_TMO])) break; if (sp > XB_SPIN_CAP) { atomicAdd(&bar[XB_TMO], 1u); break; } }
    }
    nloc = mine > 0u ? mine : 1u; nx = cnt > 0u ? cnt : 1u;
}

__device__ __forceinline__ void xcd_barrier(const XcdBarrier& b) {
    asm volatile("s_waitcnt vmcnt(0)" ::: "memory");
    __syncthreads();
    if (threadIdx.x == 0) {
        unsigned* bar = b.bar;
        __builtin_amdgcn_s_waitcnt(0);
        unsigned nloc = b.st[0], nx = b.st[1];
        if (nloc == 0u) { xcd_barrier_complete(bar, b.x, nloc, nx); b.st[0] = nloc; b.st[1] = nx; }
        const unsigned old = xb_add(&bar[XB_XSUB(b.x)], 1u);
        const unsigned gen = old / nloc;
        if (old + 1u == (gen + 1u) * nloc) {
            __builtin_amdgcn_fence(__ATOMIC_RELEASE, "agent");
            asm volatile("s_waitcnt vmcnt(0)" ::: "memory");
            const unsigned og = xb_add(&bar[XB_TOP], 1u);
            const unsigned tg = og / nx;
            if (og + 1u == (tg + 1u) * nx) xb_add(&bar[XB_TOPGEN], 1u);
            else XB_SPIN(xb_ld(&bar[XB_TOPGEN]) == tg, bar);
            __builtin_amdgcn_fence(__ATOMIC_ACQUIRE, "agent");
            xb_add(&bar[XB_XGEN(b.x)], 1u);
            asm volatile("s_waitcnt vmcnt(0)" ::: "memory");
        } else {
            XB_SPIN(xb_ld(&bar[XB_XGEN(b.x)]) == gen, bar);
            __builtin_amdgcn_fence(__ATOMIC_ACQUIRE, "agent");
            asm volatile("s_waitcnt vmcnt(0)" ::: "memory");
        }
    }
    __syncthreads();
}


#endif
#ifndef DBG_COPY
#define DBG_COPY 0
#endif
#ifndef DBG_PHASE
#define DBG_PHASE 5
#endif
#ifndef DUP_NSA
#define DUP_NSA 1
#endif
#ifndef DUP_REC
#define DUP_REC 1
#endif
#ifndef DUP_P5
#define DUP_P5 1
#endif
#ifndef DUP_P2
#define DUP_P2 1
#endif
#ifndef DUP_P0
#define DUP_P0 1
#endif
#ifndef DUP_P1
#define DUP_P1 1
#endif
#ifndef DUP_NP
#define DUP_NP 1
#endif
#ifndef HOST_EMU
#define GRID_SYNC() do { if (ph == 1) cg::this_grid().sync(); else { XcdBarrier xb_; xb_.bar = (unsigned*)(lds_ptr_entry(22) + WS_BARRIER); xb_.x = xb_xcc_id(); \
    xb_.st = (volatile __attribute__((address_space(3))) unsigned*)(smem_raw + LDS_PTRS + 192); xcd_barrier(xb_); } } while (0)
#else
#define GRID_SYNC() grid_sync_impl()
#endif

#ifndef HOST_EMU
DEV unsigned char* lds_ptr_entry(int i) {
    int z; asm volatile("s_mov_b32 %0, 0" : "=s"(z)); i += z;
    const unsigned long long v = ((volatile LDSP unsigned long long*)((LDSP unsigned char*)smem_raw + LDS_PTRS))[i];
    const unsigned lo = __builtin_amdgcn_readfirstlane((unsigned)v), hi = __builtin_amdgcn_readfirstlane((unsigned)(v >> 32));
    return (unsigned char*)(__attribute__((address_space(1))) unsigned char*)(((unsigned long long)hi << 32) | lo);
}
#endif
DEV Ctx make_ctx(const Params& p, int wave0) {
#ifndef HOST_EMU
    Ctx c; c.out = p.out; c.ws = p.ws; c.tid = wave0 * 64 + fresh_lane();
#else
    Ctx c; c.out = p.out; c.ws = p.ws; c.tid = TID();
#endif
    c.bid = BID(); c.nblk = NBLK(); int z = 0;
#ifndef HOST_EMU
    asm volatile("" : "+v"(c.tid), "+s"(c.bid), "+s"(c.nblk));
    asm volatile("s_mov_b32 %0, 0" : "=s"(z));
    c.ws = lds_ptr_entry(22); c.out = (float*)lds_ptr_entry(23);
#endif
    c.lds = SMEM_PTR() + z; c.lane = c.tid & 63; c.wave = c.tid >> 6;
#ifndef HOST_EMU
    c.wave = __builtin_amdgcn_readfirstlane(c.wave);
#endif
    return c;
}
#ifndef HOST_EMU
__global__ void __launch_bounds__(NTHR, 2) fwd_kernel(Params p)
#else
void fwd_kernel(Params p)
#endif
{
    {
        LDSP char* lds0 = SMEM_PTR();
        if (TID() == 0) {
#pragma unroll
            for (int i = 0; i < 22; ++i) ((LDSP unsigned long long*)(lds0 + LDS_PTRS))[i] = (unsigned long long)p.in[i];
            ((LDSP unsigned long long*)(lds0 + LDS_PTRS))[22] = (unsigned long long)p.ws; ((LDSP unsigned long long*)(lds0 + LDS_PTRS))[23] = (unsigned long long)p.out;
        }
        block_sync();
    }
#ifndef HOST_EMU
    const int wave0 = __builtin_amdgcn_readfirstlane((int)threadIdx.x >> 6);
#else
    const int wave0 = 0;
#endif
#ifndef HOST_EMU
    volatile __attribute__((address_space(3))) unsigned* xst = (volatile __attribute__((address_space(3))) unsigned*)(smem_raw + LDS_PTRS + 192);
    if (threadIdx.x == 0) { xst[0] = 0u; xst[1] = 0u; }
    __syncthreads();
    (void)xcd_barrier_post((unsigned*)(p.ws + WS_BARRIER), xst);
#endif
    int ph = 0;
#define PHASE_END() do { ++ph; if (DBG_COPY && ph == DBG_PHASE) { GRID_SYNC(); Ctx c = make_ctx(p, wave0); \
        const bf16_t* src = wsp<bf16_t>(c, DBG_COPY == 1 ? WS_OUTS : DBG_COPY == 2 ? WS_ST : DBG_COPY == 3 ? WS_PROJ : DBG_COPY == 4 ? WS_HALO : DBG_COPY >= 6 ? WS_OUTS + (size_t)(DBG_COPY - 6) * NT * MW * 2 : WS_KSW); const size_t nsrc = DBG_COPY >= 6 ? (size_t)NT * MW : DBG_COPY == 2 ? 3 * ST_ONE / 2 : DBG_COPY == 4 ? (size_t)BATCH * NC * 3 * 512 + (size_t)NT * NH * 2 * 2 + (size_t)BATCH * NH * NC * 64 * 2 : (size_t)NT * DM; \
        for (size_t i = (size_t)c.bid * NTHR + c.tid; i < (size_t)NT * DM; i += (size_t)c.nblk * NTHR) c.out[i] = i < nsrc ? bf2f(src[i]) : 0.f; return; } \
        if (ph >= p.phase_hi) return; GRID_SYNC(); } while (0)
    for (int l = 0; l < DEPTH; ++l) {
        for (int rep = 0; rep < DUP_P0; ++rep) { Ctx c = make_ctx(p, wave0); p0_prep(c, l); }
        PHASE_END();
        for (int rep = 0; rep < DUP_P1; ++rep) {
            Ctx c = make_ctx(p, wave0);
            pg8::Gemm g{wsp<bf16_t>(c, WS_XB), wsp<bf16_t>(c, WS_WIN), NT, PROJ_N, DM}; pg8::StaticOrder S; S.init(NT, PROJ_N, c.nblk, c.bid);
            pg8::EpiScaleBf16<1, true> E{wsp<bf16_t>(c, WS_PROJ), PROJ_LD, wsp<float>(c, WS_RSS1), PROJ_LD, wsp<bf16_t>(c, WS_HALO)};
            pg8::gemm_phase<pg8::EpiScaleBf16<1, true>, pg8::StaticOrder, true, true>(GEMM_LDS, g, S, E, c.tid);
        }
        PHASE_END();
        for (int rep = 0; rep < DUP_P2; ++rep) { Ctx c = make_ctx(p, wave0); for (int u = c.bid; u < 3 * BATCH * NH * NC; u += c.nblk) recur_local_unit(c, l, u); }
        for (int rep = 0; rep < DUP_NP; ++rep) { Ctx c = make_ctx(p, wave0); for (int u = c.bid; u < BATCH * 8; u += c.nblk) nsa_compress_unit(c, l, u); }
        for (int rep = 0; rep < DUP_NP; ++rep) { Ctx c = make_ctx(p, wave0); for (int it = c.bid; it < NT / 4; it += c.nblk) nsa_kprep_item(c, l, it); }
        for (int rep = 0; rep < DUP_NP; ++rep) { Ctx c = make_ctx(p, wave0); for (int it = c.bid; it < BATCH * 4 * NC; it += c.nblk) nsa_vprep_item(c, it); }
        PHASE_END();
        { Ctx c = make_ctx(p, wave0); recur_scan(c); }
        PHASE_END();
        for (int rep = 0; rep < DUP_NSA; ++rep) { Ctx c = make_ctx(p, wave0);
        for (int u = c.bid; u < BATCH * 2 * NSEL; u += c.nblk) {
            const int nbg = BATCH * 2, bg = u % nbg, qi = u / nbg; int qt = qi;
            if (NSEL == 64) { const int r = qi >> 4, ql = qi & 15; qt = (r == 0) ? 63 - ql : (r == 1) ? ql : (r == 2) ? 47 - ql : 16 + ql; }
            nsa_attn_unit(c, l, bg * NSEL + qt);
        } }
        for (int rep = 0; rep < DUP_REC; ++rep) { Ctx c = make_ctx(p, wave0); for (int u = c.bid * NWAVE + c.wave; u < 3 * BATCH * NH * NC; u += c.nblk * NWAVE) recur_out_wave(c, l, u); }
        PHASE_END();
        { Ctx c = make_ctx(p, wave0); peer_table_rows(c, l); }
        for (int rep = 0; rep < DUP_P5; ++rep) {
            { Ctx c = make_ctx(p, wave0); pg8::MixOrder<true> S{(NT / 256) * 4, c.nblk, c.bid, NT / 256};
              pg8::Gemm g{wsp<bf16_t>(c, WS_OUTS), wsp<bf16_t>(c, WS_WUP), 4 * NT, 4 * DM, MW};
              pg8::EpiU E{wsp<bf16_t>(c, WS_UALL)};
              pg8::gemm_phase<pg8::EpiU, pg8::MixOrder<true>, false, true>(GEMM_LDS, g, S, E, c.tid); }
            GRID_SYNC();
            { Ctx c = make_ctx(p, wave0); pg8::MixOrder<false> S{(NT / 256) * 4, c.nblk, c.bid, NT / 256};
              pg8::Gemm g{wsp<bf16_t>(c, WS_XB), wsp<bf16_t>(c, WS_WG), NT, 4 * DM, DM};
              pg8::EpiGate E{wsp<bf16_t>(c, WS_UALL), wsp<bf16_t>(c, WS_MERGED), wsp<float>(c, WS_RSS1), NT};
              pg8::gemm_phase<pg8::EpiGate, pg8::MixOrder<false>, false, true>(GEMM_LDS, g, S, E, c.tid); }
        }
        PHASE_END();
        {
            Ctx c = make_ctx(p, wave0); const float* xres = (l == 0) ? CIN(0) : c.out;
            pg8::Gemm g{wsp<bf16_t>(c, WS_MERGED), wsp<bf16_t>(c, WS_WOUT), NT, DM, DM}; pg8::StaticOrder S; S.init(NT, DM, c.nblk, c.bid);
            pg8::EpiOut E{xres, c.out, wsp<bf16_t>(c, WS_XB), wsp<float>(c, WS_RSS2)};
            pg8::gemm_phase<pg8::EpiOut, pg8::StaticOrder, true, true>(GEMM_LDS, g, S, E, c.tid);
        }
        PHASE_END();
        {
            Ctx c = make_ctx(p, wave0);
            pg8::Gemm g{wsp<bf16_t>(c, WS_XB), wsp<bf16_t>(c, WS_WQ2), NT, PEER_N, DM}; pg8::StaticOrder S; S.init(NT, PEER_N, c.nblk, c.bid);
            pg8::EpiScaleBf16<16> E{wsp<bf16_t>(c, WS_SCORES), PEER_N, wsp<float>(c, WS_RSS2), PEER_N, nullptr};
            pg8::gemm_phase<pg8::EpiScaleBf16<16>, pg8::StaticOrder, true, true>(GEMM_LDS, g, S, E, c.tid);
        }
        PHASE_END();
        { Ctx c = make_ctx(p, wave0); peer_init_tab(c); for (int t = c.bid * NWAVE + c.wave; t < NT; t += c.nblk * NWAVE) peer_token(c, l, t); }
        PHASE_END();
    }
}

#ifndef HOST_EMU
extern "C" void kernel_launch(void* const* d_in, const int* in_sizes, int n_in, void* d_out, int out_size, void* d_ws, size_t ws_size, hipStream_t stream) {
    static int grid = 0;
    if (grid == 0) {
        if (n_in != 22 || out_size != NT * DM || ws_size < WS_NEED) { fprintf(stderr, "kernel_launch: unexpected shapes (n_in %d out %d ws %zu need %zu)\n", n_in, out_size, ws_size, (size_t)WS_NEED); grid = -1; return; }
        int dev = 0, cus = 0, per_cu = 0;
        hipGetDevice(&dev); hipDeviceGetAttribute(&cus, hipDeviceAttributeMultiprocessorCount, dev);
        if (hipFuncSetAttribute((const void*)fwd_kernel, hipFuncAttributeMaxDynamicSharedMemorySize, LDS_BYTES) != hipSuccess) { fprintf(stderr, "kernel_launch: hipFuncSetAttribute failed\n"); grid = -1; return; }
        if (hipOccupancyMaxActiveBlocksPerMultiprocessor(&per_cu, (const void*)fwd_kernel, NTHR, LDS_BYTES) != hipSuccess || per_cu < 1) { fprintf(stderr, "kernel_launch: occupancy query failed (%d)\n", per_cu); (void)hipGetLastError(); per_cu = 1; }
        grid = cus;
        fprintf(stderr, "kernel_launch: grid %d (per_cu %d)\n", grid, per_cu);
    }
    if (grid < 0) return;
    if (hipMemsetAsync((char*)d_ws + WS_BARRIER, 0, 16384, stream) != hipSuccess) { fprintf(stderr, "kernel_launch: memset failed\n"); return; }
    Params p{};
    for (int i = 0; i < 22; ++i) p.in[i] = (const float*)d_in[i];
    p.out = (float*)d_out; p.ws = (unsigned char*)d_ws; p.phase_lo = 0; p.phase_hi = 1 << 20;
    void* args[] = {&p};
    hipError_t e = hipLaunchCooperativeKernel((const void*)fwd_kernel, dim3(grid), dim3(NTHR), args, LDS_BYTES, stream);
    if (e != hipSuccess) fprintf(stderr, "kernel_launch: cooperative launch failed: %s (grid %d)\n", hipGetErrorString(e), grid);
}
#endif
```

```cpp
#ifndef HOST_EMU
#include <hip/hip_runtime.h>
#include <hip/hip_cooperative_groups.h>
#include <cstdio>
#include <cstdint>
namespace cg = cooperative_groups;
#endif

#ifndef CFG_B
#define CFG_B 8
#endif
#ifndef CFG_S
#define CFG_S 4096
#endif

constexpr int BATCH = CFG_B, SEQ = CFG_S, DM = 1024, DEPTH = 2;
constexpr int NT = BATCH * SEQ;
constexpr int NH = 4, HD = 64, MW = 256, CH = 64, NC = SEQ / CH;
constexpr int N_IN_ORIG = 4116, PROJ_N = 4352, PROJ_LD = 4128;
constexpr int NCMP = (SEQ - 32) / 16 + 1;
constexpr int NCMP_PAD = SEQ / 16;
constexpr int NSEL = SEQ / 64;
constexpr int PEER_N = 2048;
constexpr float NORM_EPS = 1e-6f;
constexpr int NTHR = 512, NWAVE = 8;
constexpr int C_HQ = 0, C_HF = 256, C_HI = 512, C_HG = 768;
constexpr int C_MQ = 1024, C_MK = 1280, C_MV = 1536, C_MO = 1792;
constexpr int C_NQ = 2048, C_NKC = 2304, C_NVC = 2432, C_NKS = 2560, C_NVS = 2688, C_NKW = 2816, C_NVW = 2944;
constexpr int C_RQ = 3072, C_RK = 3328, C_RV = 3584, C_RG = 3840;
constexpr int C_MI = 4096, C_MF = 4100, C_NG = 4104;

typedef unsigned short bf16_t;
#ifndef HOST_EMU
typedef short bf16x8 __attribute__((ext_vector_type(8)));
typedef float f32x4 __attribute__((ext_vector_type(4)));
#endif
typedef unsigned u32x4 __attribute__((ext_vector_type(4)));
typedef unsigned u32x2 __attribute__((ext_vector_type(2)));
typedef float f32x2 __attribute__((ext_vector_type(2)));

constexpr size_t al256(size_t x) { return (x + 255) & ~(size_t)255; }
constexpr size_t WS_WIN = 0;
constexpr size_t WS_WG = WS_WIN + al256((size_t)PROJ_N * DM * 2);
constexpr size_t WS_WUP = WS_WG + al256((size_t)4 * DM * DM * 2);
constexpr size_t WS_WOUT = WS_WUP + al256((size_t)4 * DM * MW * 2);
constexpr size_t WS_WQ2 = WS_WOUT + al256((size_t)DM * DM * 2);
constexpr size_t WS_WCT = WS_WQ2 + al256((size_t)PEER_N * DM * 2);
constexpr size_t WS_CBIAS = WS_WCT + al256((size_t)2 * 64 * 2048 * 2);
constexpr size_t WS_ROPE = WS_CBIAS + 1024;
constexpr size_t WS_RSS1 = WS_ROPE + al256((size_t)SEQ * 64 * 4);
constexpr size_t WS_RSS2 = WS_RSS1 + al256((size_t)NT * 4);
constexpr size_t WS_XB = WS_RSS2 + al256((size_t)NT * 16 * 4);
constexpr size_t WS_OUTS = WS_XB + al256((size_t)NT * DM * 2);
constexpr size_t WS_ST = WS_OUTS + al256((size_t)NT * DM * 2);
constexpr size_t ST_ONE = (size_t)BATCH * NH * NC * 4096 * 2;
constexpr size_t WS_GDEC = WS_ST + al256(3 * ST_ONE);
constexpr size_t WS_MNL = WS_GDEC + al256((size_t)BATCH * NH * NC * 64 * 4);
constexpr size_t WS_MSC = WS_MNL + al256((size_t)BATCH * NH * NC * 64 * 4);
constexpr size_t WS_KCMP = WS_MSC + al256((size_t)BATCH * NH * NC * 4 * 4);
constexpr size_t WS_VCMPT = WS_KCMP + al256((size_t)BATCH * 2 * NCMP_PAD * 64 * 2);
constexpr size_t WS_KSW = WS_VCMPT + al256((size_t)BATCH * 2 * NCMP_PAD * 64 * 2);
constexpr size_t WS_HALO = WS_KSW + al256((size_t)NT * 256 * 2);
constexpr size_t WS_MTS = WS_HALO + al256((size_t)BATCH * NC * 3 * 512 * 2);
constexpr size_t WS_G31 = WS_MTS + al256((size_t)NT * NH * 2 * 4);
constexpr size_t WS_PROJ = WS_G31 + al256((size_t)BATCH * NH * NC * 64 * 4);
constexpr size_t PROJ_BYTES = al256((size_t)NT * PROJ_LD * 2);
constexpr size_t WS_BARRIER = WS_PROJ + PROJ_BYTES;
constexpr size_t WS_END = WS_BARRIER + 16384;
constexpr size_t WS_UALL = WS_PROJ;
constexpr size_t WS_MERGED = WS_OUTS;
constexpr size_t WS_SCORES = WS_PROJ;
constexpr bool TABLES_IN_ST = 3 * ST_ONE >= (size_t)2 * 16384 * DM;
constexpr size_t WS_PU = TABLES_IN_ST ? WS_ST : WS_END;
constexpr size_t WS_PV = WS_PU + al256((size_t)16384 * DM);
static_assert((size_t)4 * NT * DM * 2 <= PROJ_BYTES, "U fits the proj region");
static_assert(WS_END <= (size_t)536870912, "workspace budget");
constexpr size_t WS_NEED = TABLES_IN_ST ? WS_END : WS_PV + (size_t)16384 * DM;

constexpr int LDS_BYTES = 147456;

struct Params {
    const float* in[22];
    float* out;
    unsigned char* ws;
    int phase_lo, phase_hi;
};

#ifndef HOST_EMU
#define DEV __device__ __forceinline__
#define TID() ((int)threadIdx.x)
#define BID() ((int)blockIdx.x)
#define NBLK() ((int)gridDim.x)
extern __shared__ __attribute__((aligned(16))) unsigned char smem_raw[];
#define LDSP __attribute__((address_space(3)))
#define SMEM_PTR() ((LDSP char*)smem_raw)
DEV void block_sync() { __syncthreads(); }
DEV int fresh_lane() { int lane; asm volatile("v_mbcnt_lo_u32_b32 %0, -1, 0\n\tv_mbcnt_hi_u32_b32 %0, -1, %0" : "=v"(lane)); return lane; }
template <int M> DEV int xori(int v) {
    if constexpr (M < 32) return __builtin_amdgcn_ds_swizzle(v, (M << 10) | 0x1f);
    else return __builtin_amdgcn_ds_bpermute((fresh_lane() ^ M) << 2, v);
}
template <int M> DEV float xorf(float v) { return __builtin_bit_cast(float, xori<M>(__builtin_bit_cast(int, v))); }
DEV int shfl_i(int v, int src) { return __builtin_amdgcn_ds_bpermute(src << 2, v); }
DEV float shfl_f(float v, int src) { return __builtin_bit_cast(float, __builtin_amdgcn_ds_bpermute(src << 2, __builtin_bit_cast(int, v))); }
DEV unsigned long long ballot64(bool p) { return __builtin_amdgcn_ballot_w64(p); }
DEV int mbcnt64(unsigned long long m) { return (int)__builtin_amdgcn_mbcnt_hi((unsigned)(m >> 32), __builtin_amdgcn_mbcnt_lo((unsigned)m, 0u)); }
DEV float bcast_f(float v, int j) { return __builtin_bit_cast(float, __builtin_amdgcn_readlane(__builtin_bit_cast(int, v), j)); }
DEV int bcast_i(int v, int j) { return __builtin_amdgcn_readlane(v, j); }
DEV f32x2 cvt_pk_f32_fp8(unsigned p, bool hi) { return hi ? __builtin_amdgcn_cvt_pk_f32_fp8((int)p, true) : __builtin_amdgcn_cvt_pk_f32_fp8((int)p, false); }
template <int SEL> DEV f32x2 cvt_pk_f32_fp4_(unsigned p) { return __builtin_amdgcn_cvt_scalef32_pk_f32_fp4(p, 1.0f, SEL); }
DEV f32x2 cvt_pk_f32_fp4(unsigned p, int bytesel) { return bytesel == 0 ? cvt_pk_f32_fp4_<0>(p) : bytesel == 1 ? cvt_pk_f32_fp4_<1>(p) : bytesel == 2 ? cvt_pk_f32_fp4_<2>(p) : cvt_pk_f32_fp4_<3>(p); }
DEV unsigned cvt_pk_fp8_f32(float a, float b, unsigned old, bool hi) { return hi ? (unsigned)__builtin_amdgcn_cvt_pk_fp8_f32(a, b, (int)old, true) : (unsigned)__builtin_amdgcn_cvt_pk_fp8_f32(a, b, (int)old, false); }
DEV f32x4 mfma16(bf16x8 a, bf16x8 b, f32x4 c) { return __builtin_amdgcn_mfma_f32_16x16x32_bf16(a, b, c, 0, 0, 0); }
DEV void atomic_add_f32(float* p, float v) { atomicAdd(p, v); }
DEV float fast_exp(float x) { return __expf(x); }
DEV float fast_exp2(float x) { return __builtin_amdgcn_exp2f(x); }
DEV float fast_log(float x) { return __logf(x); }
DEV float fast_rcp(float x) { return __builtin_amdgcn_rcpf(x); }
DEV float fast_rsqrt(float x) { return __builtin_amdgcn_rsqf(x); }
#else
#define DEV static inline
#define LDSP
#endif

DEV float bf2f(bf16_t v) { unsigned u = ((unsigned)v) << 16; return __builtin_bit_cast(float, u); }
DEV bf16_t f2bf(float f) { unsigned u = __builtin_bit_cast(unsigned, f); return (bf16_t)((u + 0x7fffu + ((u >> 16) & 1u)) >> 16); }
#ifndef HOST_EMU
typedef __bf16 bf16x2_hw __attribute__((ext_vector_type(2)));
DEV unsigned pk2(float lo, float hi) { const f32x2 v = {lo, hi}; return __builtin_bit_cast(unsigned, __builtin_convertvector(v, bf16x2_hw)); }
#else
DEV unsigned pk2(float lo, float hi) { return (unsigned)f2bf(lo) | ((unsigned)f2bf(hi) << 16); }
#endif
DEV float bflo(unsigned u) { return __builtin_bit_cast(float, u << 16); }
DEV float bfhi(unsigned u) { return __builtin_bit_cast(float, u & 0xffff0000u); }
DEV float sigmoidf_(float x) { return fast_rcp(1.0f + fast_exp(-x)); }
DEV float siluf_(float x) { return x * sigmoidf_(x); }
DEV float log_sigmoidf_(float x) { return fminf(x, 0.f) - log1pf(fast_exp(-fabsf(x))); }
DEV unsigned sortkey32(float f) { const unsigned u = __builtin_bit_cast(unsigned, f); return (u & 0x80000000u) ? ~u : (u | 0x80000000u); }
DEV unsigned fp4_code(float x) {
    const float a = fabsf(x); unsigned c = (a > 0.25f) + (a > 0.75f) + (a > 1.25f) + (a > 1.75f) + (a > 2.5f) + (a > 3.5f) + (a > 5.0f); return c | (x < 0.f ? 8u : 0u);
}
DEV float wave_sum(float v) { v += xorf<1>(v); v += xorf<2>(v); v += xorf<4>(v); v += xorf<8>(v); v += xorf<16>(v); v += xorf<32>(v); return v; }
DEV float wave_max(float v) { v = fmaxf(v, xorf<1>(v)); v = fmaxf(v, xorf<2>(v)); v = fmaxf(v, xorf<4>(v)); v = fmaxf(v, xorf<8>(v)); v = fmaxf(v, xorf<16>(v)); v = fmaxf(v, xorf<32>(v)); return v; }
DEV float gelu_erf(float v) {
    const float av = fabsf(v), t = fast_rcp(1.0f + 0.2316418882f * av);
    float q = t * 0.5307027145f + (-0.7265760135f); q = q * t + 0.7107068705f; q = q * t + (-0.142248368f); q = q * t + 0.127414796f; q = q * t;
    const float e = fast_exp2(v * v * (-0.72134752044f));
    const float m = v * (q * e);
    return v < 0.f ? m : v - m;
}
#ifndef HOST_EMU
#define DEV_M __device__ __forceinline__
#else
#define DEV_M inline
#endif
namespace pg8 {
#define PG8_LAS __attribute__((address_space(3)))
constexpr int BM = 256, BK = 64, HALF = 128, HTB = HALF * BK * 2  , STAGE_BYTES = 8 * HTB, NXCD = 8, WGM = 8;

__host__ __device__ __forceinline__ int lds_byte(int r, int c) { const int st = (r >> 4) * 2 + (c >> 5), rr = r & 15, cc = c & 31, ob = rr * 64 + cc * 2; return st * 1024 + (ob ^ (((ob >> 9) & 1) << 5)); }
__host__ __device__ __forceinline__ void stage_rc(int b, int& R, int& C) { const int st = b / 1024, sb = b % 1024, swz = sb ^ (((sb >> 9) & 1) << 5); R = (st >> 1) * 16 + swz / 64; C = (st & 1) * 32 + (swz % 64) / 2; }
__host__ __device__ __forceinline__ int perm32(int rho) { const int n = rho >> 4, i = rho & 15; return 8 * (i >> 2) + 4 * n + (i & 3); }

struct Unit { int pm, pn; };
struct Gemm { const bf16_t* A; const bf16_t* Bt; int M, N, K; };

struct StaticOrder {
    int nM, nN, nwg, G, c;
    __host__ __device__ void init(int M, int N, int G_, int c_) { nM = M / BM; nN = N / BM; nwg = nM * nN; G = G_; c = c_; }
    __host__ __device__ bool next(int i, Unit& u) const {
        const long L = (long)i * G + c; if (L >= nwg) return false;
        int wgid = (int)L; { const int q = nwg / NXCD, r = nwg % NXCD, xcd = wgid % NXCD, off = wgid / NXCD; wgid = (xcd < r ? xcd * (q + 1) : r * (q + 1) + (xcd - r) * q) + off; }
        const int nig = WGM * nN, gid = wgid / nig, fm = gid * WGM, gsz = (nM - fm) < WGM ? (nM - fm) : WGM;
        u.pm = fm + ((wgid % nig) % gsz); u.pn = (wgid % nig) / gsz; return true;
    }
    DEV_M void a_ready(const Unit&) const {}
    DEV_M void done(const Unit&) const {}
};


#ifndef HOST_EMU
template <class Epi, class Sched, bool ALIGN_EPI = false, bool SP2 = false>
__device__ __forceinline__ void gemm_phase(PG8_LAS unsigned char* lds, const Gemm g, const Sched& S, const Epi& E, const int tid_in) {
    const int tid = tid_in, wid = __builtin_amdgcn_readfirstlane(tid >> 6), lane = tid & 63, wr = wid >> 2, wc = wid & 3, fr = lane & 15, fq = lane >> 4;
    const int K = g.K, nt = K / BK;
    unsigned voffA[2], voffB[2];
#pragma unroll
    for (int i = 0; i < 2; ++i) { int R, C; stage_rc(tid * 16 + i * 8192, R, C); const int Rb = Epi::PERM ? ((R & ~31) + perm32(R & 31)) : R;
        voffA[i] = (unsigned)(R * K + C) * 2u; voffB[i] = (unsigned)(Rb * K + C) * 2u; }
    const size_t kstep = (size_t)(BK * 2);
    const size_t hstep = (size_t)HALF * K * 2;
    const size_t tstep = 2 * hstep;
    const unsigned ldsw = (unsigned)wid * 1024u;
    const int aoff = lds_byte(wr * 64 + fr, fq * 8), boff = lds_byte(wc * 32 + fr, fq * 8);
#define PG8_SA(b, h) (((b) * 2 + (h)) * HTB)
#define PG8_SB(b, h) ((4 + (b) * 2 + (h)) * HTB)
#define PG8_STAGE(bufoff, gbase, voff) do { _Pragma("unroll") for (int _i = 0; _i < 2; ++_i) \
        __builtin_amdgcn_global_load_lds((const unsigned*)((const char*)(gbase) + (voff)[_i]), (PG8_LAS unsigned*)(lds + (bufoff) + ldsw + _i * 8192), 16, 0, 0); } while (0)
#define PG8_LDA(dst, b, h) do { _Pragma("unroll") for (int m = 0; m < 4; ++m) _Pragma("unroll") for (int k = 0; k < 2; ++k) dst[m][k] = *(const PG8_LAS bf16x8*)(lds + PG8_SA(b, h) + aoff + m * 2048 + k * 1024); } while (0)
#define PG8_LDB(dst, b, h) do { _Pragma("unroll") for (int n = 0; n < 2; ++n) _Pragma("unroll") for (int k = 0; k < 2; ++k) dst[n][k] = *(const PG8_LAS bf16x8*)(lds + PG8_SB(b, h) + boff + n * 2048 + k * 1024); } while (0)
#define PG8_MMA(ai, bj, At, Bt) do { __builtin_amdgcn_s_setprio(1); _Pragma("unroll") for (int m = 0; m < 4; ++m) _Pragma("unroll") for (int n = 0; n < 2; ++n) _Pragma("unroll") for (int k = 0; k < 2; ++k) \
        acc[ai][bj][m][n] = __builtin_amdgcn_mfma_f32_16x16x32_bf16(Bt[n][k], At[m][k], acc[ai][bj][m][n], 0, 0, 0); __builtin_amdgcn_s_setprio(0); } while (0)
#define PG8_WAIT_V(n) asm volatile("s_waitcnt vmcnt(" #n ")" ::: "memory")
#define PG8_WAIT_L(n) asm volatile("s_waitcnt lgkmcnt(" #n ")" ::: "memory")
#define PG8_BAR __builtin_amdgcn_s_barrier()
#define PG8_SCHED __builtin_amdgcn_sched_barrier(0)
    Unit cur, nxt; int ui = 0;
    if (!S.next(0, cur)) return;
    f32x4 acc[2][2][4][2];
#pragma unroll
    for (int a = 0; a < 2; ++a)
#pragma unroll
        for (int b = 0; b < 2; ++b)
#pragma unroll
            for (int m = 0; m < 4; ++m)
#pragma unroll
                for (int n = 0; n < 2; ++n) acc[a][b][m][n] = (f32x4){0.f, 0.f, 0.f, 0.f};
    bf16x8 At[4][2], B0[2][2], B1[2][2];
    const char* cA = (const char*)g.A + (size_t)cur.pm * tstep; const char* cB = (const char*)g.Bt + (size_t)cur.pn * tstep;
    S.a_ready(cur);
    if constexpr (SP2) {
        PG8_STAGE(PG8_SB(0, 0), cB, voffB); PG8_STAGE(PG8_SB(0, 1), cB + hstep, voffB); PG8_STAGE(PG8_SA(0, 0), cA, voffA); PG8_STAGE(PG8_SA(0, 1), cA + hstep, voffA);
        if (wr == 1) PG8_BAR;
        PG8_WAIT_V(2); PG8_BAR;
        PG8_STAGE(PG8_SB(1, 0), cB + kstep, voffB); PG8_STAGE(PG8_SA(1, 0), cA + kstep, voffA); PG8_STAGE(PG8_SB(1, 1), cB + hstep + kstep, voffB);
        PG8_WAIT_V(6); PG8_BAR;
    } else {
        PG8_STAGE(PG8_SB(0, 0), cB, voffB); PG8_STAGE(PG8_SA(0, 0), cA, voffA); PG8_STAGE(PG8_SB(0, 1), cB + hstep, voffB); PG8_STAGE(PG8_SA(0, 1), cA + hstep, voffA);
        if (wr == 1) PG8_BAR;
        PG8_WAIT_V(4); PG8_BAR;
        PG8_STAGE(PG8_SB(1, 0), cB + kstep, voffB); PG8_STAGE(PG8_SA(1, 0), cA + kstep, voffA); PG8_STAGE(PG8_SB(1, 1), cB + hstep + kstep, voffB);
        PG8_WAIT_V(6); PG8_BAR;
    }
    for (;;) {
        const bool has_next = S.next(ui + 1, nxt);
        const char* nA = has_next ? (const char*)g.A + (size_t)nxt.pm * tstep : cA; const char* nB = has_next ? (const char*)g.Bt + (size_t)nxt.pn * tstep : cB;
        for (int t = 0; t < nt; t += 2) {
            const bool last = (t == nt - 2);
            const char* a1 = cA + (size_t)(t + 1) * kstep;
            const char* a2 = last ? nA : cA + (size_t)(t + 2) * kstep; const char* b2 = last ? nB : cB + (size_t)(t + 2) * kstep;
            const char* a3 = a2 + kstep; const char* b3 = b2 + kstep;
            if (last && has_next) S.a_ready(nxt);
            if constexpr (SP2) {
            PG8_LDB(B0, 0, 0); PG8_LDB(B1, 0, 1); PG8_SCHED; PG8_LDA(At, 0, 0); PG8_STAGE(PG8_SA(1, 1), a1 + hstep, voffA);
            PG8_WAIT_V(8); PG8_WAIT_L(0); PG8_BAR; PG8_MMA(0, 0, At, B0); PG8_MMA(0, 1, At, B1); PG8_BAR; PG8_SCHED;
            PG8_LDA(At, 0, 1); PG8_STAGE(PG8_SB(0, 0), b2, voffB); PG8_STAGE(PG8_SB(0, 1), b2 + hstep, voffB); PG8_STAGE(PG8_SA(0, 0), a2, voffA);
            PG8_WAIT_V(8); PG8_WAIT_L(0); PG8_BAR; PG8_MMA(1, 0, At, B0); PG8_MMA(1, 1, At, B1); PG8_BAR; PG8_SCHED;
            PG8_LDB(B0, 1, 0); PG8_LDB(B1, 1, 1); PG8_SCHED; PG8_LDA(At, 1, 0); PG8_STAGE(PG8_SA(0, 1), a2 + hstep, voffA);
            PG8_WAIT_V(8); PG8_WAIT_L(0); PG8_BAR; PG8_MMA(0, 0, At, B0); PG8_MMA(0, 1, At, B1); PG8_BAR; PG8_SCHED;
            PG8_LDA(At, 1, 1); PG8_STAGE(PG8_SB(1, 0), b3, voffB); PG8_STAGE(PG8_SB(1, 1), b3 + hstep, voffB); PG8_STAGE(PG8_SA(1, 0), a3, voffA);
            PG8_WAIT_V(8); PG8_WAIT_L(0); PG8_BAR; PG8_MMA(1, 0, At, B0); PG8_MMA(1, 1, At, B1); PG8_BAR; PG8_SCHED;
            } else {
            PG8_LDB(B0, 0, 0); PG8_SCHED; PG8_LDA(At, 0, 0); PG8_STAGE(PG8_SA(1, 1), a1 + hstep, voffA);
            PG8_WAIT_L(8); PG8_BAR; PG8_WAIT_L(0); PG8_MMA(0, 0, At, B0); PG8_BAR; PG8_SCHED;
            PG8_LDB(B1, 0, 1); PG8_STAGE(PG8_SB(0, 0), b2, voffB);
            PG8_BAR; PG8_WAIT_L(0); PG8_MMA(0, 1, At, B1); PG8_BAR;
            PG8_LDA(At, 0, 1); PG8_STAGE(PG8_SA(0, 0), a2, voffA);
            PG8_BAR; PG8_WAIT_L(0); PG8_MMA(1, 0, At, B0); PG8_BAR; PG8_SCHED;
            PG8_STAGE(PG8_SB(0, 1), b2 + hstep, voffB);
            PG8_WAIT_V(6); PG8_BAR; PG8_MMA(1, 1, At, B1); PG8_BAR;
            PG8_LDB(B0, 1, 0); PG8_SCHED; PG8_LDA(At, 1, 0); PG8_STAGE(PG8_SA(0, 1), a2 + hstep, voffA);
            PG8_WAIT_L(8); PG8_BAR; PG8_WAIT_L(0); PG8_MMA(0, 0, At, B0); PG8_BAR; PG8_SCHED;
            PG8_LDB(B1, 1, 1); PG8_STAGE(PG8_SB(1, 0), b3, voffB);
            PG8_BAR; PG8_WAIT_L(0); PG8_MMA(0, 1, At, B1); PG8_BAR;
            PG8_LDA(At, 1, 1); PG8_STAGE(PG8_SA(1, 0), a3, voffA);
            PG8_BAR; PG8_WAIT_L(0); PG8_MMA(1, 0, At, B0); PG8_BAR; PG8_SCHED;
            PG8_STAGE(PG8_SB(1, 1), b3 + hstep, voffB);
            PG8_WAIT_V(6); PG8_BAR; PG8_MMA(1, 1, At, B1); PG8_BAR;
            }
        }
        if constexpr (ALIGN_EPI) { if (wr == 0) PG8_BAR; }
        if constexpr (!Epi::AFTER_DRAIN) { E(acc, cur, wr, wc, fr, fq); S.done(cur); }
        if (!has_next) break;
#pragma unroll
        for (int a = 0; a < 2; ++a)
#pragma unroll
            for (int b = 0; b < 2; ++b)
#pragma unroll
                for (int m = 0; m < 4; ++m)
#pragma unroll
                    for (int n = 0; n < 2; ++n) acc[a][b][m][n] = (f32x4){0.f, 0.f, 0.f, 0.f};
        cur = nxt; cA = nA; cB = nB; ++ui;
        if constexpr (ALIGN_EPI) { if (wr == 1) PG8_BAR; }
    }
    PG8_WAIT_V(0);
    if constexpr (!ALIGN_EPI) { if (wr == 0) PG8_BAR; }
    PG8_BAR;
    if constexpr (Epi::AFTER_DRAIN) { E.fused(acc, cur, wr, wc, fr, fq, lds, wid, lane); S.done(cur); }
#undef PG8_SA
#undef PG8_SB
#undef PG8_STAGE
#undef PG8_LDA
#undef PG8_LDB
#undef PG8_MMA
#undef PG8_WAIT_V
#undef PG8_WAIT_L
#undef PG8_BAR
#undef PG8_SCHED
}
#else
template <class Epi, class Sched, bool ALIGN_EPI = false, bool SP2 = false>
inline void gemm_phase(void* lds, const Gemm g, const Sched& S, const Epi& E, const int tid_in) {
    const int tid = TID(), wid = tid >> 6, lane = tid & 63, wr = wid >> 2, wc = wid & 3, fr = lane & 15, fq = lane >> 4;
    Unit u;
    for (int ui = 0; S.next(ui, u); ++ui) {
        f32x4 acc[2][2][4][2];
        for (int ai = 0; ai < 2; ++ai) for (int bj = 0; bj < 2; ++bj) for (int m = 0; m < 4; ++m) for (int n = 0; n < 2; ++n) for (int j = 0; j < 4; ++j) {
            const int r = 256 * u.pm + 128 * ai + 64 * wr + 16 * m + fr;
            const int c = 256 * u.pn + 128 * bj + 32 * wc + (Epi::PERM ? (8 * fq + 4 * n + j) : (16 * n + 4 * fq + j));
            const bf16_t* a = g.A + (size_t)r * g.K; const bf16_t* b = g.Bt + (size_t)c * g.K;
            float s = 0.f; for (int k = 0; k < g.K; ++k) s += bf2f(a[k]) * bf2f(b[k]);
            acc[ai][bj][m][n][j] = s;
        }
        E(acc, u, wr, wc, fr, fq);
    }
    block_sync();
}
#endif
#ifndef HOST_EMU
#define EPI_LAUNDER(wr, wc, fr, fq) asm volatile("" : "+s"(wr), "+s"(wc), "+v"(fr), "+v"(fq))
#else
#define EPI_LAUNDER(wr, wc, fr, fq) do {} while (0)
#endif
DEV_M float rstd_of(float ss) { return fast_rsqrt(ss * (1.0f / 1024.0f) + NORM_EPS); }

DEV_M float rss_slots16(const float* p) {
    const f32x4 a = *(const f32x4*)p, b = *(const f32x4*)(p + 4), c = *(const f32x4*)(p + 8), d = *(const f32x4*)(p + 12);
    return (((a[0] + a[1]) + (a[2] + a[3])) + ((b[0] + b[1]) + (b[2] + b[3]))) + (((c[0] + c[1]) + (c[2] + c[3])) + ((d[0] + d[1]) + (d[2] + d[3])));
}
template <int SLOTS, bool HALO = false> struct EpiScaleBf16 {
    static constexpr bool PERM = true, AFTER_DRAIN = false;
    bf16_t* O; int ldc; const float* rss; int ncols; bf16_t* halo;
    DEV_M void operator()(const f32x4 (&acc)[2][2][4][2], const Unit& u, int wr, int wc, int fr, int fq) const {
        EPI_LAUNDER(wr, wc, fr, fq);
        const int row0 = u.pm * BM + wr * 64 + fr, col0 = u.pn * BM + wc * 32 + 8 * fq;
        float scv[2][4];
#pragma unroll
        for (int ai = 0; ai < 2; ++ai)
#pragma unroll
            for (int m = 0; m < 4; ++m) { const int row = row0 + ai * HALF + m * 16; scv[ai][m] = SLOTS == 1 ? rss[row] : 0.f; }
#pragma unroll
        for (int ai = 0; ai < 2; ++ai)
#pragma unroll
            for (int m = 0; m < 4; ++m) {
                const int row = row0 + ai * HALF + m * 16; const float sc = rstd_of(SLOTS == 1 ? scv[ai][m] : rss_slots16(rss + (size_t)row * 16));
                bf16_t* rowp = O + (size_t)row * ldc + col0;
#pragma unroll
                for (int bj = 0; bj < 2; ++bj) {
                    if (col0 + bj * HALF < ncols) {
                        const f32x4 v0 = acc[ai][bj][m][0] * sc, v1 = acc[ai][bj][m][1] * sc;
                        u32x4 w; w.x = pk2(v0[0], v0[1]); w.y = pk2(v0[2], v0[3]); w.z = pk2(v1[0], v1[1]); w.w = pk2(v1[2], v1[3]);
                        *(u32x4*)(rowp + bj * HALF) = w;
                        if (HALO) { const int cc = col0 + bj * HALF - C_MQ; if ((row & 63) >= 61 && cc >= 0 && cc < 512) *(u32x4*)(halo + ((size_t)(row >> 6) * 3 + ((row & 63) - 61)) * 512 + cc) = w; }
                    }
                }
            }
    }
};
struct EpiU {
    static constexpr bool PERM = true, AFTER_DRAIN = false;
    bf16_t* uall;
    DEV_M void operator()(const f32x4 (&acc)[2][2][4][2], const Unit& u, int wr, int wc, int fr, int fq) const {
        EPI_LAUNDER(wr, wc, fr, fq);
        bf16_t* base = uall + (size_t)(u.pm * BM + wr * 64 + fr) * DM + (u.pn & 3) * BM + wc * 32 + 8 * fq;
#pragma unroll
        for (int ai = 0; ai < 2; ++ai)
#pragma unroll
            for (int m = 0; m < 4; ++m)
#pragma unroll
                for (int bj = 0; bj < 2; ++bj) {
                    const f32x4 v0 = acc[ai][bj][m][0], v1 = acc[ai][bj][m][1];
                    u32x4 w; w.x = pk2(v0[0], v0[1]); w.y = pk2(v0[2], v0[3]); w.z = pk2(v1[0], v1[1]); w.w = pk2(v1[2], v1[3]);
                    *(u32x4*)(base + (size_t)(ai * HALF + m * 16) * DM + bj * HALF) = w;
                }
    }
};
struct EpiGate {
    static constexpr bool PERM = true, AFTER_DRAIN = false;
    const bf16_t* uall; bf16_t* merged; const float* rss; int nrows;
    DEV_M void operator()(const f32x4 (&acc)[2][2][4][2], const Unit& u, int wr, int wc, int fr, int fq) const {
        EPI_LAUNDER(wr, wc, fr, fq);
        const int mi = u.pn >> 2, pn = u.pn & 3, row0 = u.pm * BM + wr * 64 + fr, col0 = pn * BM + wc * 32 + 8 * fq;
        const bf16_t* ub = uall + ((size_t)mi * nrows + row0) * DM + col0;
#pragma unroll
        for (int ai = 0; ai < 2; ++ai) {
            u32x4 uv[4][2], pv[4][2]; float sc[4];
#pragma unroll
            for (int m = 0; m < 4; ++m) { const int row = row0 + ai * HALF + m * 16; sc[m] = rss[row];
#pragma unroll
                for (int bj = 0; bj < 2; ++bj) { uv[m][bj] = *(const u32x4*)(ub + (size_t)(ai * HALF + m * 16) * DM + bj * HALF);
                    pv[m][bj] = (u32x4){0u, 0u, 0u, 0u}; if (mi != 0) pv[m][bj] = *(const u32x4*)(merged + (size_t)row * DM + col0 + bj * HALF); } }
#pragma unroll
            for (int m = 0; m < 4; ++m) { const int row = row0 + ai * HALF + m * 16; const float s = rstd_of(sc[m]);
#pragma unroll
                for (int bj = 0; bj < 2; ++bj) {
                    const u32x4 u4 = uv[m][bj], p4 = pv[m][bj];
                    const f32x4 a0 = acc[ai][bj][m][0] * s, a1 = acc[ai][bj][m][1] * s;
                    float r[8];
                    r[0] = sigmoidf_(a0[0]) * bflo(u4.x) + bflo(p4.x); r[1] = sigmoidf_(a0[1]) * bfhi(u4.x) + bfhi(p4.x);
                    r[2] = sigmoidf_(a0[2]) * bflo(u4.y) + bflo(p4.y); r[3] = sigmoidf_(a0[3]) * bfhi(u4.y) + bfhi(p4.y);
                    r[4] = sigmoidf_(a1[0]) * bflo(u4.z) + bflo(p4.z); r[5] = sigmoidf_(a1[1]) * bfhi(u4.z) + bfhi(p4.z);
                    r[6] = sigmoidf_(a1[2]) * bflo(u4.w) + bflo(p4.w); r[7] = sigmoidf_(a1[3]) * bfhi(u4.w) + bfhi(p4.w);
                    u32x4 w; w.x = pk2(r[0], r[1]); w.y = pk2(r[2], r[3]); w.z = pk2(r[4], r[5]); w.w = pk2(r[6], r[7]);
                    *(u32x4*)(merged + (size_t)row * DM + col0 + bj * HALF) = w;
                } }
        }
    }
};
struct EpiOut {
    static constexpr bool PERM = false, AFTER_DRAIN = false;
    const float* xres; float* out; bf16_t* xb; float* rss;
    DEV_M void operator()(const f32x4 (&acc)[2][2][4][2], const Unit& u, int wr, int wc, int fr, int fq) const {
        EPI_LAUNDER(wr, wc, fr, fq);
        const int row0 = u.pm * BM + wr * 64 + fr, col0 = u.pn * BM + wc * 32 + 4 * fq;
#pragma unroll
        for (int ah = 0; ah < 4; ++ah) { const int ai = ah >> 1, m0 = (ah & 1) * 2;
            f32x4 xr[4][2][2];
#pragma unroll
            for (int m = m0; m < m0 + 2; ++m)
#pragma unroll
                for (int bj = 0; bj < 2; ++bj)
#pragma unroll
                    for (int n = 0; n < 2; ++n) xr[m][bj][n] = *(const f32x4*)(xres + (size_t)(row0 + ai * HALF + m * 16) * DM + col0 + bj * HALF + n * 16);
#pragma unroll
            for (int m = m0; m < m0 + 2; ++m) {
                const int row = row0 + ai * HALF + m * 16; const size_t off = (size_t)row * DM + col0; float ss = 0.f;
#pragma unroll
                for (int bj = 0; bj < 2; ++bj)
#pragma unroll
                    for (int n = 0; n < 2; ++n) {
                        const size_t o = off + bj * HALF + n * 16;
                        const f32x4 v = xr[m][bj][n] + acc[ai][bj][m][n];
                        *(f32x4*)(out + o) = v;
                        u32x2 w; w.x = pk2(v[0], v[1]); w.y = pk2(v[2], v[3]);
                        *(u32x2*)(xb + o) = w;
                        ss += (v[0] * v[0] + v[1] * v[1]) + (v[2] * v[2] + v[3] * v[3]);
                    }
                ss += xorf<16>(ss); ss += xorf<32>(ss);
                if (fq == 0) rss[(size_t)row * 16 + u.pn * 4 + wc] = ss;
            }
        }
    }
};
template <bool STACK_A> struct MixOrder {
    int ntiles, G, c, nM;
    DEV_M bool next(int i, Unit& u) const { const long t = (long)(i >> 2) * G + c; if (t >= ntiles) return false; const int m = i & 3;
        u.pm = (int)(t >> 2) + (STACK_A ? m * nM : 0); u.pn = m * 4 + (int)(t & 3); return true; }
    DEV_M void a_ready(const Unit&) const {}
    DEV_M void done(const Unit&) const {}
};
}
#ifndef HOST_EMU
#define GEMM_LDS ((PG8_LAS unsigned char*)smem_raw)
#else
#define GEMM_LDS ((void*)nullptr)
#endif
struct Ctx {
    float* out; unsigned char* ws; LDSP char* lds; int tid, lane, wave, bid, nblk;
};
constexpr int LDS_PTRS = LDS_BYTES - 256;
#ifndef HOST_EMU
DEV const float* inptr(const Ctx& c, int i) { const unsigned long long v = ((volatile LDSP unsigned long long*)(c.lds + LDS_PTRS))[i];
    const unsigned lo = __builtin_amdgcn_readfirstlane((unsigned)v), hi = __builtin_amdgcn_readfirstlane((unsigned)(v >> 32)); return (const float*)(const __attribute__((address_space(1))) float*)(((unsigned long long)hi << 32) | lo); }
#else
static inline const float* inptr(const Ctx& c, int i) { return ((const float* volatile*)(c.lds + LDS_PTRS))[i]; }
#endif
#define CIN(i) inptr(c, (i))
template <class T> DEV T* wsp(const Ctx& c, size_t off) { return (T*)(c.ws + off); }
DEV int orig_col(int n) {
    if (n < 1792) return n;
    if (n < 2048) return 1800 + (n - 1792);
    if (n < 3072) return 2056 + (n - 2048);
    if (n < 4096) return 3092 + (n - 3072);
    if (n < 4104) return 1792 + (n - 4096);
    if (n < 4116) return 3080 + (n - 4104);
    return -1;
}

template <class F> DEV void transpose_item(const Ctx& c, F src, bf16_t* dst, int ldd, int k0, int n0) {
    LDSP float* tile = (LDSP float*)c.lds;
    for (int e = c.tid; e < 4096; e += NTHR) { const int k = e >> 6, n = e & 63; tile[n * 65 + k] = src(k0 + k, n0 + n); }
    block_sync();
    for (int e = c.tid; e < 2048; e += NTHR) { const int n = e >> 5, k2 = (e & 31) * 2;
        *(unsigned*)(dst + (size_t)(n0 + n) * ldd + k0 + k2) = pk2(tile[n * 65 + k2], tile[n * 65 + k2 + 1]); }
    block_sync();
}

DEV void p0_prep(const Ctx& c, int l) {
    const float* g1 = CIN(1) + (size_t)l * DM;
    const float* g2 = CIN(17) + (size_t)l * DM;
    constexpr int I_IN = (PROJ_N / 64) * 16, I_G = 4 * 16 * 16, I_UP = 4 * 16 * 4, I_OUT = 16 * 16, I_WQ = 16 * 16, I_WC = 2 * 32, I_CB = 2;
    constexpr int I_TOT = I_IN + I_G + I_UP + I_OUT + I_WQ + I_WC + I_CB;
    for (int it = c.bid; it < I_TOT; it += c.nblk) {
        int r = it;
        if (r < I_IN) {
            const float* w = CIN(2) + (size_t)l * DM * N_IN_ORIG; const int nt = r / 16, kt = r % 16;
            transpose_item(c, [=](int k, int n) { const int oc = orig_col(n); return oc < 0 ? 0.f : w[(size_t)k * N_IN_ORIG + oc] * g1[k]; }, wsp<bf16_t>(c, WS_WIN), DM, kt * 64, nt * 64);
            continue;
        } r -= I_IN;
        if (r < I_G) {
            const int m = r / 256, nt = (r % 256) / 16, kt = r % 16; const float* w = CIN(15) + ((size_t)l * 4 + m) * DM * DM;
            transpose_item(c, [=](int k, int n) { return w[(size_t)k * DM + n] * g1[k]; }, wsp<bf16_t>(c, WS_WG) + (size_t)m * DM * DM, DM, kt * 64, nt * 64);
            continue;
        } r -= I_G;
        if (r < I_UP) {
            const int m = r / 64, nt = (r % 64) / 4, kt = r % 4; const float* w = CIN(14) + ((size_t)l * 4 + m) * MW * DM;
            transpose_item(c, [=](int k, int n) { return w[(size_t)k * DM + n]; }, wsp<bf16_t>(c, WS_WUP) + (size_t)m * DM * MW, MW, kt * 64, nt * 64);
            continue;
        } r -= I_UP;
        if (r < I_OUT) {
            const int nt = r / 16, kt = r % 16; const float* w = CIN(16) + (size_t)l * DM * DM;
            transpose_item(c, [=](int k, int n) { return w[(size_t)k * DM + n]; }, wsp<bf16_t>(c, WS_WOUT), DM, kt * 64, nt * 64);
            continue;
        } r -= I_OUT;
        if (r < I_WQ) {
            const int hp = r / 16, kt = r % 16;
            const float* keys = CIN(19) + ((size_t)l * 16 + hp) * 128 * 128; const float* wq = CIN(18) + (size_t)l * DM * PEER_N;
            LDSP float* keysL = (LDSP float*)c.lds; LDSP float* wqL = keysL + 128 * 129;
            for (int e = c.tid; e < 128 * 128; e += NTHR) keysL[(e >> 7) * 129 + (e & 127)] = keys[e];
            for (int e = c.tid; e < 64 * 128; e += NTHR) { const int k = e >> 7, d = e & 127; wqL[k * 129 + d] = wq[(size_t)(kt * 64 + k) * PEER_N + hp * 128 + d] * g2[kt * 64 + k]; }
            block_sync();
            const int key = c.tid & 127, kg = c.tid >> 7;
            float acc[16];
#pragma unroll
            for (int j = 0; j < 16; ++j) acc[j] = 0.f;
            for (int d = 0; d < 128; ++d) { const float kv = keysL[key * 129 + d];
#pragma unroll
                for (int j = 0; j < 16; ++j) acc[j] += kv * wqL[(kg * 16 + j) * 129 + d]; }
            bf16_t* dst = wsp<bf16_t>(c, WS_WQ2) + (size_t)(hp * 128 + key) * DM + kt * 64 + kg * 16;
#pragma unroll
            for (int j = 0; j < 16; j += 2) *(unsigned*)(dst + j) = pk2(acc[j], acc[j + 1]);
            block_sync();
            continue;
        } r -= I_WQ;
        if (r < I_WC) {
            const int kv = r / 32, kt = r % 32; const float* w = CIN(12) + ((size_t)l * 2 + kv) * 2048 * 64;
            transpose_item(c, [=](int k, int n) { return w[(size_t)k * 64 + n]; }, wsp<bf16_t>(c, WS_WCT) + (size_t)kv * 64 * 2048, 2048, kt * 64, 0);
            continue;
        } r -= I_WC;
        {
            const int kv = r; const float* w = CIN(12) + ((size_t)l * 2 + kv) * 2048 * 64; const float* pe = CIN(11) + ((size_t)l * 2 + kv) * 2048;
            LDSP float* red = (LDSP float*)c.lds;
            const int e = c.tid & 63, part = c.tid >> 6; float s = 0.f;
            for (int kk = part * 256; kk < part * 256 + 256; ++kk) s += pe[kk] * w[(size_t)kk * 64 + e];
            red[part * 64 + e] = s;
            block_sync();
            if (c.tid < 64) { float t = 0.f; for (int p = 0; p < 8; ++p) t += red[p * 64 + c.tid]; wsp<float>(c, WS_CBIAS)[kv * 64 + c.tid] = t; }
            block_sync();
        }
    }
    if (l == 0) {
        const float* x = CIN(0); bf16_t* xb = wsp<bf16_t>(c, WS_XB); float* rss = wsp<float>(c, WS_RSS1);
        for (int row = c.bid * NWAVE + c.wave; row < NT; row += c.nblk * NWAVE) {
            const f32x4* xr = (const f32x4*)(x + (size_t)row * DM) + c.lane; float s = 0.f;
            u32x2* o = (u32x2*)(xb + (size_t)row * DM) + c.lane;
#pragma unroll
            for (int j = 0; j < 4; ++j) { const f32x4 v = xr[64 * j]; s += (v[0] * v[0] + v[1] * v[1]) + (v[2] * v[2] + v[3] * v[3]);
                u32x2 w; w.x = pk2(v[0], v[1]); w.y = pk2(v[2], v[3]); o[64 * j] = w; }
            s = wave_sum(s);
            if (c.lane == 0) rss[row] = s;
        }
        float* cosT = wsp<float>(c, WS_ROPE); float* sinT = cosT + SEQ * 32;
        for (int i = c.bid * NTHR + c.tid; i < SEQ * 32; i += c.nblk * NTHR) {
            const int pos = i >> 5, fi = i & 31;
            const float inv = exp2f(-(float)fi * 0.41524101186092029f);
            const float a = (float)pos * inv, q = rintf(a * 0.63661977236758134f);
            float rr = fmaf(-q, 1.5703125f, a); rr = fmaf(-q, 4.837512969970703125e-4f, rr); rr = fmaf(-q, 7.54978995489188216e-8f, rr);
            const float r2 = rr * rr;
            const float s = rr * (1.0f + r2 * (-1.0f / 6 + r2 * (1.0f / 120 + r2 * (-1.0f / 5040 + r2 * (1.0f / 362880)))));
            const float cc = 1.0f + r2 * (-0.5f + r2 * (1.0f / 24 + r2 * (-1.0f / 720 + r2 * (1.0f / 40320 + r2 * (-1.0f / 3628800)))));
            const int qi = ((int)q) & 3;
            const float co = qi == 0 ? cc : qi == 1 ? -s : qi == 2 ? -cc : s;
            const float si = qi == 0 ? s : qi == 1 ? cc : qi == 2 ? -s : -cc;
            cosT[i] = co; sinT[i] = si;
        }
    }
}
constexpr int LF_STRIDE = 65, LT_STRIDE = 72;
constexpr int LDS_F0 = 0, LDS_F1 = 16640, LDS_F2 = 33280, LDS_T0 = 49920, LDS_TSZ = 64 * LT_STRIDE * 2, LDS_MISC = LDS_T0 + 6 * LDS_TSZ;
DEV LDSP float* ldsF(const Ctx& c, int i) { return (LDSP float*)(c.lds + LDS_F0 + i * 16640); }
DEV LDSP bf16_t* ldsT(const Ctx& c, int i) { return (LDSP bf16_t*)(c.lds + LDS_T0 + i * LDS_TSZ); }
DEV LDSP float* ldsM(const Ctx& c) { return (LDSP float*)(c.lds + LDS_MISC); }

DEV void load_tile_f32(const Ctx& c, LDSP float* F, const bf16_t* proj, int tok0, int col) {
    const int t = c.tid >> 3, d0 = (c.tid & 7) * 8;
    const u32x4 v = *(const u32x4*)(proj + (size_t)(tok0 + t) * PROJ_LD + col + d0);
    LDSP float* f = F + t * LF_STRIDE + d0;
    f[0] = bflo(v.x); f[1] = bfhi(v.x); f[2] = bflo(v.y); f[3] = bfhi(v.y); f[4] = bflo(v.z); f[5] = bfhi(v.z); f[6] = bflo(v.w); f[7] = bfhi(v.w);
}
DEV void load_tile_T(const Ctx& c, LDSP bf16_t* T, const bf16_t* proj, int tok0, int col) {
    const int t = c.tid >> 3, d0 = (c.tid & 7) * 8;
    const u32x4 v = *(const u32x4*)(proj + (size_t)(tok0 + t) * PROJ_LD + col + d0);
    LDSP bf16_t* p = T + d0 * LT_STRIDE + t;
    p[0] = (bf16_t)(v.x & 0xffff); p[LT_STRIDE] = (bf16_t)(v.x >> 16); p[2 * LT_STRIDE] = (bf16_t)(v.y & 0xffff); p[3 * LT_STRIDE] = (bf16_t)(v.y >> 16);
    p[4 * LT_STRIDE] = (bf16_t)(v.z & 0xffff); p[5 * LT_STRIDE] = (bf16_t)(v.z >> 16); p[6 * LT_STRIDE] = (bf16_t)(v.w & 0xffff); p[7 * LT_STRIDE] = (bf16_t)(v.w >> 16);
}
DEV f32x4 mma_tile(const LDSP bf16_t* A, int lda, int r0, const LDSP bf16_t* B, int ldb, int c0, int K, f32x4 acc, int lane) {
    const int fr = lane & 15, fq = lane >> 4;
    for (int k0 = 0; k0 < K; k0 += 32) {
        const bf16x8 a = *(const LDSP bf16x8*)(A + (r0 + fr) * lda + k0 + fq * 8);
        const bf16x8 b = *(const LDSP bf16x8*)(B + (c0 + fr) * ldb + k0 + fq * 8);
        acc = mfma16(a, b, acc);
    }
    return acc;
}
DEV float wave_scan_add(float v, int lane) {
#pragma unroll
    for (int o = 1; o < 64; o <<= 1) { const float t = shfl_f(v, lane - o); if (lane >= o) v += t; }
    return v;
}
DEV float wave_scan_max(float v, int lane) {
#pragma unroll
    for (int o = 1; o < 64; o <<= 1) { const float t = shfl_f(v, lane - o); if (lane >= o) v = fmaxf(v, t); }
    return v;
}
DEV float hgrn_lb(const Ctx& c, int l, int ch) { if (l == 0) return 0.f; const float* lb = CIN(3); return sigmoidf_(lb[MW + ch] - lb[ch]); }
DEV float ret_loggamma(int h) { return log1pf(-exp2f(-5.0f - (float)h)); }

DEV void hgrn_front(const Ctx& c, int l, const bf16_t* proj, int tok0, int h) {
    LDSP float* F0 = ldsF(c, 0); LDSP float* F1 = ldsF(c, 1);
    load_tile_f32(c, F0, proj, tok0, C_HF + h * 64);
    block_sync();
    for (int e = c.tid; e < 4096; e += NTHR) { const int t = e >> 6, d = e & 63; const float fl = F0[t * LF_STRIDE + d], lbv = hgrn_lb(c, l, h * 64 + d);
        const float sg = sigmoidf_(fl), f = lbv + (1.f - lbv) * sg; F0[t * LF_STRIDE + d] = fast_log(f); F1[t * LF_STRIDE + d] = (1.f - lbv) * (1.f - sg); }
    block_sync();
    for (int k = 0; k < 8; ++k) { const int d = c.wave * 8 + k; F0[c.lane * LF_STRIDE + d] = wave_scan_add(F0[c.lane * LF_STRIDE + d], c.lane); }
    block_sync();
}
DEV void rope_tile(const Ctx& c, LDSP float* F, int pos0, float scale) {
    const float* cosT = wsp<float>(c, WS_ROPE); const float* sinT = cosT + SEQ * 32;
    for (int e = c.tid; e < 2048; e += NTHR) { const int t = e >> 5, d = e & 31; const float cs = cosT[(pos0 + t) * 32 + d], sn = sinT[(pos0 + t) * 32 + d];
        const float x1 = F[t * LF_STRIDE + d], x2 = F[t * LF_STRIDE + d + 32];
        F[t * LF_STRIDE + d] = (x1 * cs - x2 * sn) * scale; F[t * LF_STRIDE + d + 32] = (x1 * sn + x2 * cs) * scale; }
}
DEV void mlstm_conv_tile(const Ctx& c, int l, LDSP float* F, const bf16_t* proj, int tok0, int ck, int cg, int col, int ch0, float scale) {
    const float* cw = CIN(5) + (size_t)l * 4 * 512; const float* cb = CIN(6) + (size_t)l * 512; const bf16_t* halo = wsp<bf16_t>(c, WS_HALO);
    for (int e = c.tid; e < 4096; e += NTHR) { const int t = e >> 6, d = e & 63; float s = cb[ch0 + d];
#pragma unroll
        for (int j = 0; j < 4; ++j) { const int tt = t - 3 + j; float xv = 0.f;
            if (tt >= 0) xv = bf2f(proj[(size_t)(tok0 + tt) * PROJ_LD + col + d]);
            else if (ck > 0) xv = bf2f(halo[((size_t)(cg - 1) * 3 + (tt + 3)) * 512 + (col - C_MQ) + d]);
            s += cw[j * 512 + ch0 + d] * xv; }
        F[t * LF_STRIDE + d] = siluf_(s) * scale; }
}
DEV void mlstm_gates(const Ctx& c, int l, const bf16_t* proj, int tok0, int h) {
    LDSP float* M = ldsM(c); const float* gb = CIN(7) + (size_t)l * 8;
    if (c.tid < 64) { const int t = c.tid; M[t] = bf2f(proj[(size_t)(tok0 + t) * PROJ_LD + C_MI + h]) + gb[h];
        M[64 + t] = log_sigmoidf_(bf2f(proj[(size_t)(tok0 + t) * PROJ_LD + C_MF + h]) + gb[4 + h]); }
    block_sync();
    if (c.wave == 0) M[64 + c.lane] = wave_scan_add(M[64 + c.lane], c.lane);
    block_sync();
}
DEV void store_state_tiles(const Ctx& c, bf16_t* dst, const f32x4 (&acc)[2]) {
    const int fr = c.lane & 15, fq = c.lane >> 4;
#pragma unroll
    for (int k = 0; k < 2; ++k) { const int ti = c.wave * 2 + k, rt = ti >> 2, ct = ti & 3;
#pragma unroll
        for (int i = 0; i < 4; ++i) dst[(rt * 16 + fq * 4 + i) * 64 + ct * 16 + fr] = f2bf(acc[k][i]); }
}
DEV void f32_to_tile(const Ctx& c, LDSP bf16_t* T, const LDSP float* F, bool transpose) {
    for (int e = c.tid; e < 4096; e += NTHR) { const int r = e >> 6, q = e & 63; const bf16_t v = f2bf(F[r * LF_STRIDE + q]); if (transpose) T[q * LT_STRIDE + r] = v; else T[r * LT_STRIDE + q] = v; }
}

DEV void recur_local_unit(const Ctx& c, int l, int unit) {
    const int mixer = unit / (BATCH * NH * NC), r = unit % (BATCH * NH * NC), b = r / (NH * NC), h = (r / NC) % NH, ck = r % NC;
    bf16_t* proj = wsp<bf16_t>(c, WS_PROJ); const int tok0 = b * SEQ + ck * 64, pos0 = ck * 64;
    LDSP float* F0 = ldsF(c, 0); LDSP float* F1 = ldsF(c, 1); LDSP float* F2 = ldsF(c, 2); LDSP float* M = ldsM(c);
    LDSP bf16_t* VT = ldsT(c, 0); LDSP bf16_t* KT = ldsT(c, 1);
    bf16_t* dst = wsp<bf16_t>(c, WS_ST + mixer * ST_ONE) + (size_t)r * 4096;
    const int vt = c.tid >> 3, vd0 = (c.tid & 7) * 8;
    int qcol, kcol, vcol;
    if (mixer == 0) {
        qcol = C_HQ; kcol = C_HF; vcol = C_HI;
        load_tile_T(c, VT, proj, tok0, C_HI + h * 64);
        load_tile_f32(c, F2, proj, tok0, C_HQ + h * 64);
        hgrn_front(c, l, proj, tok0, h);
        float qo[8], ko[8];
#pragma unroll
        for (int j = 0; j < 8; ++j) { const int d = vd0 + j; const float bt = F0[vt * LF_STRIDE + d], bm = F0[31 * LF_STRIDE + d], bl = F0[63 * LF_STRIDE + d], kk = F1[vt * LF_STRIDE + d];
            qo[j] = siluf_(F2[vt * LF_STRIDE + d]) * fast_exp(bt - bm); ko[j] = kk * fast_exp(bm - bt); KT[d * LT_STRIDE + vt] = f2bf(kk * fast_exp(bl - bt)); }
        if (c.tid < 64) { wsp<float>(c, WS_GDEC)[(size_t)r * 64 + c.tid] = fast_exp(F0[63 * LF_STRIDE + c.tid]); wsp<float>(c, WS_G31)[(size_t)r * 64 + c.tid] = fast_exp(F0[31 * LF_STRIDE + c.tid]); }
        u32x4 w; w.x = pk2(qo[0], qo[1]); w.y = pk2(qo[2], qo[3]); w.z = pk2(qo[4], qo[5]); w.w = pk2(qo[6], qo[7]); *(u32x4*)(proj + (size_t)(tok0 + vt) * PROJ_LD + C_HQ + h * 64 + vd0) = w;
        w.x = pk2(ko[0], ko[1]); w.y = pk2(ko[2], ko[3]); w.z = pk2(ko[4], ko[5]); w.w = pk2(ko[6], ko[7]); *(u32x4*)(proj + (size_t)(tok0 + vt) * PROJ_LD + C_HF + h * 64 + vd0) = w;
    } else if (mixer == 2) {
        qcol = C_RQ; kcol = C_RK; vcol = C_RV;
        load_tile_T(c, VT, proj, tok0, C_RV + h * 64);
        load_tile_f32(c, F0, proj, tok0, C_RK + h * 64); load_tile_f32(c, F2, proj, tok0, C_RQ + h * 64);
        block_sync();
        rope_tile(c, F0, pos0, 0.125f); rope_tile(c, F2, pos0, 1.0f);
        block_sync();
        const float lg = ret_loggamma(h), gq = fast_exp(lg * (float)(vt - 31)), gk = fast_exp(lg * (float)(31 - vt)), gl = fast_exp(lg * (float)(63 - vt));
        float qo[8], ko[8];
#pragma unroll
        for (int j = 0; j < 8; ++j) { const int d = vd0 + j; const float kk = F0[vt * LF_STRIDE + d]; qo[j] = F2[vt * LF_STRIDE + d] * gq; ko[j] = kk * gk; KT[d * LT_STRIDE + vt] = f2bf(kk * gl); }
        u32x4 w; w.x = pk2(qo[0], qo[1]); w.y = pk2(qo[2], qo[3]); w.z = pk2(qo[4], qo[5]); w.w = pk2(qo[6], qo[7]); *(u32x4*)(proj + (size_t)(tok0 + vt) * PROJ_LD + C_RQ + h * 64 + vd0) = w;
        w.x = pk2(ko[0], ko[1]); w.y = pk2(ko[2], ko[3]); w.z = pk2(ko[4], ko[5]); w.w = pk2(ko[6], ko[7]); *(u32x4*)(proj + (size_t)(tok0 + vt) * PROJ_LD + C_RK + h * 64 + vd0) = w;
    } else {
        qcol = C_MQ; kcol = C_MK; vcol = C_MV;
        load_tile_T(c, VT, proj, tok0, C_MV + h * 64);
        mlstm_gates(c, l, proj, tok0, h);
        mlstm_conv_tile(c, l, F0, proj, tok0, ck, b * NC + ck, C_MK + h * 64, 256 + h * 64, 0.125f);
        mlstm_conv_tile(c, l, F2, proj, tok0, ck, b * NC + ck, C_MQ + h * 64, h * 64, 1.0f);
        if (c.wave == 0) { const int t = c.lane; const float bl = M[127], bt = M[64 + t], li = M[t];
            const float a = wave_max(bl - bt + li); const float pm = wave_scan_max(li - bt, t);
            M[128 + t] = pm; if (t == 0) { M[192] = a; M[193] = bl; }
            float* mts = wsp<float>(c, WS_MTS) + ((size_t)(tok0 + t) * NH + h) * 2; mts[0] = bt; mts[1] = bt + pm; }
        block_sync();
        const float eq = fast_exp(-M[128 + vt]), ek = fast_exp(M[vt] - M[64 + vt]), wk = fast_exp(M[193] - M[64 + vt] + M[vt] - M[192]);
        float qo[8], ko[8];
#pragma unroll
        for (int j = 0; j < 8; ++j) { const int d = vd0 + j; const float kk = F0[vt * LF_STRIDE + d]; qo[j] = F2[vt * LF_STRIDE + d] * eq; ko[j] = kk * ek;
            const float kh = kk * wk; F1[vt * LF_STRIDE + d] = kh; KT[d * LT_STRIDE + vt] = f2bf(kh); }
        block_sync();
        u32x4 w; w.x = pk2(qo[0], qo[1]); w.y = pk2(qo[2], qo[3]); w.z = pk2(qo[4], qo[5]); w.w = pk2(qo[6], qo[7]); *(u32x4*)(proj + (size_t)(tok0 + vt) * PROJ_LD + C_MQ + h * 64 + vd0) = w;
        w.x = pk2(ko[0], ko[1]); w.y = pk2(ko[2], ko[3]); w.z = pk2(ko[4], ko[5]); w.w = pk2(ko[6], ko[7]); *(u32x4*)(proj + (size_t)(tok0 + vt) * PROJ_LD + C_MK + h * 64 + vd0) = w;
        if (c.tid < 64) { float s = 0.f; for (int t = 0; t < 64; ++t) s += F1[t * LF_STRIDE + c.tid]; wsp<float>(c, WS_MNL)[(size_t)r * 64 + c.tid] = s; }
        if (c.tid == 64) { float* sc = wsp<float>(c, WS_MSC) + (size_t)r * 4; sc[0] = M[192]; sc[1] = M[193]; }
    }
    block_sync();
    f32x4 acc[2];
#pragma unroll
    for (int k = 0; k < 2; ++k) { const int ti = c.wave * 2 + k; acc[k] = (f32x4){0.f, 0.f, 0.f, 0.f}; acc[k] = mma_tile(VT, LT_STRIDE, (ti >> 2) * 16, KT, LT_STRIDE, (ti & 3) * 16, 64, acc[k], c.lane); }
    store_state_tiles(c, dst, acc);
    *(u32x4*)(proj + (size_t)(tok0 + vt) * PROJ_LD + vcol + h * 64 + vd0) = *(const LDSP u32x4*)(VT + vt * LT_STRIDE + vd0);
    (void)qcol; (void)kcol;
    block_sync();
}

DEV void recur_scan(const Ctx& c) {
    constexpr int ncol2 = BATCH * NH * 2048;
    constexpr int KB = (NC < 16) ? NC : 16;
    for (int i = c.bid * NTHR + c.tid; i < 3 * ncol2 + BATCH * NH * 64; i += c.nblk * NTHR) {
        if (i < 3 * ncol2) {
            const int mixer = i / ncol2, col = (i % ncol2) * 2, bh = col >> 12, ed = col & 4095, d = ed & 63, h = bh % NH;
            bf16_t* p = wsp<bf16_t>(c, WS_ST + mixer * ST_ONE) + (size_t)bh * NC * 4096 + ed;
            const float* g = wsp<float>(c, WS_GDEC) + (size_t)bh * NC * 64 + d; const float* g31 = wsp<float>(c, WS_G31) + (size_t)bh * NC * 64 + d; const float* sc = wsp<float>(c, WS_MSC) + (size_t)bh * NC * 4;
            const float gr = fast_exp(ret_loggamma(h) * 64.f), gr32 = fast_exp(ret_loggamma(h) * 32.f);
            float s0 = 0.f, s1 = 0.f, m = 0.f;
            for (int kb = 0; kb < NC; kb += KB) {
                unsigned tv[KB]; f32x2 gv[KB]; f32x2 av[KB]; f32x2 hv[KB];
#pragma unroll
                for (int j = 0; j < KB; ++j) { tv[j] = *(const unsigned*)(p + (size_t)(kb + j) * 4096);
                    if (mixer == 0) { gv[j] = *(const f32x2*)(g + (kb + j) * 64); hv[j] = *(const f32x2*)(g31 + (kb + j) * 64); } else if (mixer == 1) av[j] = *(const f32x2*)(sc + (kb + j) * 4); }
#pragma unroll
                for (int j = 0; j < KB; ++j) {
                    const float t0 = bflo(tv[j]), t1 = bfhi(tv[j]);
                    if (mixer == 0) { *(unsigned*)(p + (size_t)(kb + j) * 4096) = pk2(s0 * hv[j][0], s1 * hv[j][1]); s0 = gv[j][0] * s0 + t0; s1 = gv[j][1] * s1 + t1; }
                    else if (mixer == 2) { *(unsigned*)(p + (size_t)(kb + j) * 4096) = pk2(s0 * gr32, s1 * gr32); s0 = gr * s0 + t0; s1 = gr * s1 + t1; }
                    else { *(unsigned*)(p + (size_t)(kb + j) * 4096) = pk2(s0, s1);
                        const float a = av[j][0], bl = av[j][1], mn = fmaxf(bl + m, a), ds = fast_exp(bl + m - mn), dl = fast_exp(a - mn); s0 = ds * s0 + dl * t0; s1 = ds * s1 + dl * t1; m = mn; }
                }
            }
        } else {
            const int j = i - 3 * ncol2, bh = j >> 6, d = j & 63;
            float* p = wsp<float>(c, WS_MNL) + (size_t)bh * NC * 64 + d; float* sc = wsp<float>(c, WS_MSC) + (size_t)bh * NC * 4; float m = 0.f, s = 0.f;
            for (int k = 0; k < NC; ++k) { const float a = sc[k * 4], bl = sc[k * 4 + 1], mn = fmaxf(bl + m, a);
                const float t = p[k * 64]; p[k * 64] = s; if (d == 0) sc[k * 4 + 2] = m; s = fast_exp(bl + m - mn) * s + fast_exp(a - mn) * t; m = mn; }
        }
    }
}

DEV void recur_out_wave(const Ctx& c, int l, int unit) {
    const int mixer = unit / (BATCH * NH * NC), r = unit % (BATCH * NH * NC), b = r / (NH * NC), h = (r / NC) % NH, ck = r % NC;
    const bf16_t* proj = wsp<bf16_t>(c, WS_PROJ); const int tok0 = b * SEQ + ck * 64;
    const bf16_t* st = wsp<bf16_t>(c, WS_ST + mixer * ST_ONE) + (size_t)r * 4096;
    const int fr = c.lane & 15, fq = c.lane >> 4;
    const int qcol = (mixer == 0 ? C_HQ : mixer == 1 ? C_MQ : C_RQ) + h * 64, kcol = (mixer == 0 ? C_HF : mixer == 1 ? C_MK : C_RK) + h * 64;
    const int vcol = (mixer == 0 ? C_HI : mixer == 1 ? C_MV : C_RV) + h * 64, gcol = (mixer == 0 ? C_HG : mixer == 1 ? C_MO : C_RG) + h * 64;
    const float* onorm = (mixer == 0 ? CIN(4) : mixer == 1 ? CIN(8) : CIN(13)) + (size_t)l * MW + h * 64;
    bf16x8 ka[4][2], va[4][2], sa[4][2];
#pragma unroll
    for (int sq = 0; sq < 4; ++sq)
#pragma unroll
        for (int ks = 0; ks < 2; ++ks) {
            ka[sq][ks] = *(const bf16x8*)(proj + (size_t)(tok0 + 16 * sq + fr) * PROJ_LD + kcol + 32 * ks + 8 * fq);
            sa[sq][ks] = *(const bf16x8*)(st + (16 * sq + fr) * 64 + 32 * ks + 8 * fq);
            const bf16_t* vp = proj + (size_t)(tok0 + 16 * sq + fr) * PROJ_LD + vcol + 32 * ks + 4 * fq;
            const u32x2 v0 = *(const u32x2*)vp, v1 = *(const u32x2*)(vp + 16); const u32x4 vv = {v0.x, v0.y, v1.x, v1.y}; va[sq][ks] = __builtin_bit_cast(bf16x8, vv);
        }
    bf16x8 sn[2], vones; float mst = 0.f;
    if (mixer == 1) {
        const float* nst = wsp<float>(c, WS_MNL) + (size_t)r * 64; mst = wsp<float>(c, WS_MSC)[(size_t)r * 4 + 2];
#pragma unroll
        for (int ks = 0; ks < 2; ++ks) { const f32x4 n0 = *(const f32x4*)(nst + 32 * ks + 8 * fq), n1 = *(const f32x4*)(nst + 32 * ks + 8 * fq + 4);
            u32x4 w = {pk2(n0[0], n0[1]), pk2(n0[2], n0[3]), pk2(n1[0], n1[1]), pk2(n1[2], n1[3])}; if (fr != 0) w = (u32x4){0u, 0u, 0u, 0u}; sn[ks] = __builtin_bit_cast(bf16x8, w); }
        const unsigned one2 = (fr == 0) ? 0x3f803f80u : 0u; const u32x4 ow = {one2, one2, one2, one2}; vones = __builtin_bit_cast(bf16x8, ow);
    }
#pragma unroll
    for (int tq = 0; tq < 4; ++tq) {
        const int tok = tok0 + 16 * tq + fr;
        bf16x8 qb[2];
#pragma unroll
        for (int ks = 0; ks < 2; ++ks) qb[ks] = *(const bf16x8*)(proj + (size_t)tok * PROJ_LD + qcol + 32 * ks + 8 * fq);
        f32x4 stt[4];
#pragma unroll
        for (int sq = 0; sq < 4; ++sq) { stt[sq] = (f32x4){0.f, 0.f, 0.f, 0.f};
            if (sq <= tq) { stt[sq] = mfma16(ka[sq][0], qb[0], stt[sq]); stt[sq] = mfma16(ka[sq][1], qb[1], stt[sq]); } }
#pragma unroll
        for (int i = 0; i < 4; ++i) if (4 * fq + i > fr) stt[tq][i] = 0.f;
        f32x4 ot[4], os[4], o5 = {0.f, 0.f, 0.f, 0.f}, s5 = {0.f, 0.f, 0.f, 0.f};
#pragma unroll
        for (int eq = 0; eq < 4; ++eq) { ot[eq] = (f32x4){0.f, 0.f, 0.f, 0.f}; os[eq] = (f32x4){0.f, 0.f, 0.f, 0.f}; }
#pragma unroll
        for (int m = 0; m < 2; ++m) if (2 * m <= tq) {
            const u32x4 pw = {pk2(stt[2 * m][0], stt[2 * m][1]), pk2(stt[2 * m][2], stt[2 * m][3]), pk2(stt[2 * m + 1][0], stt[2 * m + 1][1]), pk2(stt[2 * m + 1][2], stt[2 * m + 1][3])};
            const bf16x8 pb = __builtin_bit_cast(bf16x8, pw);
#pragma unroll
            for (int eq = 0; eq < 4; ++eq) ot[eq] = mfma16(va[eq][m], pb, ot[eq]);
            if (mixer == 1) o5 = mfma16(vones, pb, o5);
        }
        if (mixer != 1) {
#pragma unroll
            for (int eq = 0; eq < 4; ++eq) { ot[eq] = mfma16(sa[eq][0], qb[0], ot[eq]); ot[eq] = mfma16(sa[eq][1], qb[1], ot[eq]); }
        } else {
#pragma unroll
            for (int eq = 0; eq < 4; ++eq) { os[eq] = mfma16(sa[eq][0], qb[0], os[eq]); os[eq] = mfma16(sa[eq][1], qb[1], os[eq]); }
            s5 = mfma16(sn[0], qb[0], s5); s5 = mfma16(sn[1], qb[1], s5);
            const float* mts = wsp<float>(c, WS_MTS) + ((size_t)tok * NH + h) * 2; const float bt = mts[0], ml = mts[1];
            const float inter = bt + mst, mt = fmaxf(inter, ml), rt = fast_exp(ml - mt), stc = fast_exp(mst + ml - mt);
            const float den = shfl_f(rt * o5[0] + stc * s5[0], fr);
            const float inv = fast_rcp(fmaxf(fabsf(den), fast_exp(-mt)));
#pragma unroll
            for (int eq = 0; eq < 4; ++eq) ot[eq] = (ot[eq] * rt + os[eq] * stc) * inv;
        }
        float ss = 0.f;
#pragma unroll
        for (int eq = 0; eq < 4; ++eq) ss += (ot[eq][0] * ot[eq][0] + ot[eq][1] * ot[eq][1]) + (ot[eq][2] * ot[eq][2] + ot[eq][3] * ot[eq][3]);
        ss += xorf<16>(ss); ss += xorf<32>(ss);
        const float rn = fast_rsqrt(ss * (1.0f / 64.0f) + NORM_EPS);
        bf16_t* out = wsp<bf16_t>(c, WS_OUTS) + (size_t)(mixer == 0 ? 0 : mixer == 1 ? 1 : 3) * NT * MW + (size_t)tok * MW + h * 64 + 4 * fq;
#pragma unroll
        for (int eq = 0; eq < 4; ++eq) { const u32x2 gv = *(const u32x2*)(proj + (size_t)tok * PROJ_LD + gcol + 16 * eq + 4 * fq); const f32x4 on = *(const f32x4*)(onorm + 16 * eq + 4 * fq);
            const float g0 = bflo(gv.x), g1 = bfhi(gv.x), g2 = bflo(gv.y), g3 = bfhi(gv.y);
            const float a0 = ot[eq][0] * rn * on[0] * (mixer == 1 ? sigmoidf_(g0) : siluf_(g0)), a1 = ot[eq][1] * rn * on[1] * (mixer == 1 ? sigmoidf_(g1) : siluf_(g1));
            const float a2 = ot[eq][2] * rn * on[2] * (mixer == 1 ? sigmoidf_(g2) : siluf_(g2)), a3 = ot[eq][3] * rn * on[3] * (mixer == 1 ? sigmoidf_(g3) : siluf_(g3));
            u32x2 w; w.x = pk2(a0, a1); w.y = pk2(a2, a3); *(u32x2*)(out + 16 * eq) = w; }
    }
}
#ifndef HOST_EMU
DEV void wave_sync() { __builtin_amdgcn_fence(__ATOMIC_ACQ_REL, "wavefront"); __builtin_amdgcn_wave_barrier(); }
#else
static inline void wave_sync() { emu_bar_wait(emu_wave().bar, 64); }
#endif

DEV void nsa_kprep_item(const Ctx& c, int l, int item) {
    const bf16_t* proj = wsp<bf16_t>(c, WS_PROJ); bf16_t* ksw = wsp<bf16_t>(c, WS_KSW);
    const float* cosT = wsp<float>(c, WS_ROPE); const float* sinT = cosT + SEQ * 32;
    const int tok = item * 4 + (c.tid >> 7), vec = (c.tid >> 5) & 3, br = vec >> 1, g = vec & 1, d = c.tid & 31;
    const int col = (br == 0 ? C_NKS : C_NKW) + g * 64;
    const float x1 = bf2f(proj[(size_t)tok * PROJ_LD + col + d]), x2 = bf2f(proj[(size_t)tok * PROJ_LD + col + d + 32]);
    float ss = x1 * x1 + x2 * x2;
    ss += xorf<1>(ss); ss += xorf<2>(ss); ss += xorf<4>(ss); ss += xorf<8>(ss); ss += xorf<16>(ss);
    const float r = fast_rsqrt(ss * (1.0f / 64.0f) + NORM_EPS); const float* kg = CIN(10) + ((size_t)l * 3 + 1 + br) * 64;
    const float y1 = x1 * r * kg[d], y2 = x2 * r * kg[d + 32]; const int pos = tok % SEQ;
    const float cs = cosT[pos * 32 + d], sn = sinT[pos * 32 + d];
    bf16_t* o = ksw + (size_t)tok * 256 + vec * 64;
    o[d] = f2bf(y1 * cs - y2 * sn); o[d + 32] = f2bf(y1 * sn + y2 * cs);
}
DEV void nsa_compress_unit(const Ctx& c, int l, int unit) {
    const int half = unit & 1, kv = (unit >> 1) & 1, g = (unit >> 2) & 1, b = unit >> 3;
    const bf16_t* proj = wsp<bf16_t>(c, WS_PROJ); const bf16_t* wct = wsp<bf16_t>(c, WS_WCT) + (size_t)kv * 64 * 2048;
    const int fr = c.lane & 15, fq = c.lane >> 4, n0 = half * 128 + c.wave * 16, n = n0 + fr;
    const int col = (kv == 0 ? C_NKC : C_NVC) + g * 64;
    if (n0 >= NCMP_PAD) return;
    f32x4 acc[4];
#pragma unroll
    for (int et = 0; et < 4; ++et) acc[et] = (f32x4){0.f, 0.f, 0.f, 0.f};
#pragma unroll 8
    for (int k0 = 0; k0 < 2048; k0 += 32) {
        const int kk = k0 + fq * 8, lrow = kk >> 6, d0 = kk & 63;
        bf16x8 a = {0, 0, 0, 0, 0, 0, 0, 0};
        if (n < NCMP) a = *(const bf16x8*)(proj + (size_t)(b * SEQ + 16 * n + lrow) * PROJ_LD + col + d0);
#pragma unroll
        for (int et = 0; et < 4; ++et) { const bf16x8 bb = *(const bf16x8*)(wct + (size_t)(et * 16 + fr) * 2048 + kk); acc[et] = mfma16(a, bb, acc[et]); }
    }
    const float* bias = wsp<float>(c, WS_CBIAS) + kv * 64;
    float v[4][4];
#pragma unroll
    for (int et = 0; et < 4; ++et)
#pragma unroll
        for (int i = 0; i < 4; ++i) v[et][i] = acc[et][i] + bias[et * 16 + fr];
    if (kv == 0) {
        const float* kg = CIN(10) + (size_t)l * 3 * 64; bf16_t* kc = wsp<bf16_t>(c, WS_KCMP) + (size_t)(b * 2 + g) * NCMP_PAD * 64;
#pragma unroll
        for (int i = 0; i < 4; ++i) { float ss = 0.f;
#pragma unroll
            for (int et = 0; et < 4; ++et) ss += v[et][i] * v[et][i];
            ss += xorf<1>(ss); ss += xorf<2>(ss); ss += xorf<4>(ss); ss += xorf<8>(ss);
            const float r = fast_rsqrt(ss * (1.0f / 64.0f) + NORM_EPS);
#pragma unroll
            for (int et = 0; et < 4; ++et) kc[(size_t)(n0 + fq * 4 + i) * 64 + et * 16 + fr] = f2bf(v[et][i] * r * kg[et * 16 + fr]); }
    } else {
        bf16_t* vt = wsp<bf16_t>(c, WS_VCMPT) + (size_t)(b * 2 + g) * 64 * NCMP_PAD;
#pragma unroll
        for (int et = 0; et < 4; ++et)
#pragma unroll
            for (int i = 0; i < 4; ++i) vt[(size_t)(et * 16 + fr) * NCMP_PAD + n0 + fq * 4 + i] = f2bf(v[et][i]);
    }
}

DEV void nsa_vprep_item(const Ctx& c, int item) {
    const int tt = item % NC, r = item / NC, br = r & 1, g = (r >> 1) & 1, b = r >> 2;
    bf16_t* proj = wsp<bf16_t>(c, WS_PROJ); LDSP bf16_t* T = (LDSP bf16_t*)c.lds; const int col = (br == 0 ? C_NVS : C_NVW) + g * 64, tok0 = b * SEQ + tt * 64;
    load_tile_T(c, T, proj, tok0, col);
    block_sync();
    { const int e = c.tid >> 3, t0 = (c.tid & 7) * 8; *(u32x4*)(proj + (size_t)(tok0 + e) * PROJ_LD + col + t0) = *(const LDSP u32x4*)(T + e * LT_STRIDE + t0); }
    block_sync();
}

constexpr int NA_PC = 0, NA_PCLD = 264, NA_BUF = 36864, NA_KLD = 72, NA_VLD = 136, NA_VOFF = 18432, NA_IMP = 73728, NA_SEL = NA_IMP + 16640, NA_GATE = NA_SEL + 512;
constexpr float NEG_BIG = -1.0e30f;

#ifndef HOST_EMU
DEV float fmax_fast(float a, float b) { return __builtin_amdgcn_fmed3f(a, b, __builtin_inff()); }
#else
static inline float fmax_fast(float a, float b) { return a > b ? a : b; }
#endif
constexpr float NEG_HUGE = -3.0e38f;
template <int MODE, bool EDGE>
DEV void nsa_stage(const Ctx& c, int buf, int js, int qt, const bf16x8 (&qr)[2], f32x4 (&ot)[4], float& mrun, float& lrun, unsigned long long selm) {
    const LDSP bf16_t* Kt = (const LDSP bf16_t*)(c.lds + buf * NA_BUF); const LDSP bf16_t* VT = (const LDSP bf16_t*)(c.lds + buf * NA_BUF + NA_VOFF);
    const int fr = c.lane & 15, fq = c.lane >> 4, q = (c.wave & 3) * 16 + fr;
    f32x4 st[8];
#pragma unroll
    for (int kt = 0; kt < 8; ++kt) { st[kt] = (f32x4){0.f, 0.f, 0.f, 0.f};
        st[kt] = mfma16(*(const LDSP bf16x8*)(Kt + (kt * 16 + fr) * NA_KLD + fq * 8), qr[0], st[kt]);
        st[kt] = mfma16(*(const LDSP bf16x8*)(Kt + (kt * 16 + fr) * NA_KLD + 32 + fq * 8), qr[1], st[kt]); }
    if (EDGE) {
#pragma unroll
        for (int kt = 0; kt < 8; ++kt) { const int j = js + (kt >> 2);
#pragma unroll
            for (int i = 0; i < 4; ++i) { const int kk = (kt & 3) * 16 + fq * 4 + i; bool ok;
                if (MODE == 0) ok = (j <= qt) && ((selm >> j) & 1ull) && (j < qt || kk <= q);
                else { const int dlt = (qt - j) * 64 + q - kk; ok = dlt >= 0 && dlt < 512; }
                st[kt][i] = ok ? st[kt][i] : NEG_HUGE; } }
    } else if (MODE == 0) {
        const float b0 = ((selm >> js) & 1ull) ? 0.f : NEG_HUGE, b1 = ((selm >> (js + 1)) & 1ull) ? 0.f : NEG_HUGE;
#pragma unroll
        for (int kt = 0; kt < 8; ++kt) st[kt] += (kt < 4) ? b0 : b1;
    }
    float mx = NEG_HUGE;
#pragma unroll
    for (int kt = 0; kt < 8; ++kt) mx = fmax_fast(mx, fmax_fast(fmax_fast(st[kt][0], st[kt][1]), fmax_fast(st[kt][2], st[kt][3])));
    mx = fmax_fast(mx, xorf<16>(mx)); mx = fmax_fast(mx, xorf<32>(mx));
    const float mn = fmax_fast(mrun, mx), alpha = fast_exp2(mrun - mn); mrun = mn; float ps = 0.f;
#pragma unroll
    for (int kt = 0; kt < 8; ++kt)
#pragma unroll
        for (int i = 0; i < 4; ++i) { const float pv = fast_exp2(st[kt][i] - mn); st[kt][i] = pv; ps += pv; }
    lrun = lrun * alpha + ps;
#pragma unroll
    for (int et = 0; et < 4; ++et) ot[et] *= alpha;
#pragma unroll
    for (int m = 0; m < 4; ++m) {
        const u32x4 pw = {pk2(st[2 * m][0], st[2 * m][1]), pk2(st[2 * m][2], st[2 * m][3]), pk2(st[2 * m + 1][0], st[2 * m + 1][1]), pk2(st[2 * m + 1][2], st[2 * m + 1][3])};
        const bf16x8 pb = __builtin_bit_cast(bf16x8, pw);
#pragma unroll
        for (int et = 0; et < 4; ++et) { const LDSP bf16_t* vrow = VT + (et * 16 + fr) * NA_VLD + 32 * m + 4 * fq;
            const u32x2 v0 = *(const LDSP u32x2*)vrow, v1 = *(const LDSP u32x2*)(vrow + 16);
            const u32x4 vv = {v0.x, v0.y, v1.x, v1.y};
            ot[et] = mfma16(__builtin_bit_cast(bf16x8, vv), pb, ot[et]); }
    }
}

DEV void nsa_attn_unit(const Ctx& c, int l, int unit) {
    const int qt = unit % NSEL, bg = unit / NSEL, g = bg & 1, b = bg >> 1;
    const bf16_t* proj = wsp<bf16_t>(c, WS_PROJ); const bf16_t* ksw = wsp<bf16_t>(c, WS_KSW);
    const float* cosT = wsp<float>(c, WS_ROPE); const float* sinT = cosT + SEQ * 32;
    LDSP bf16_t* Pc = (LDSP bf16_t*)(c.lds + NA_PC); LDSP float* imp = (LDSP float*)(c.lds + NA_IMP); LDSP unsigned long long* selmask = (LDSP unsigned long long*)(c.lds + NA_SEL);
    LDSP float* gates = (LDSP float*)(c.lds + NA_GATE);
    const int fr = c.lane & 15, fq = c.lane >> 4, hg = c.wave >> 2, hd = g * 2 + hg, qw = (c.wave & 3) * 16;
    const int tokq0 = b * SEQ + qt * 64;
    bf16x8 qc[2], qr[2];
    {
        const int tok = tokq0 + qw + fr, pos = qt * 64 + qw + fr;
        const u32x4 v0 = *(const u32x4*)(proj + (size_t)tok * PROJ_LD + C_NQ + hd * 64 + fq * 8), v1 = *(const u32x4*)(proj + (size_t)tok * PROJ_LD + C_NQ + hd * 64 + 32 + fq * 8);
        float x0[8] = {bflo(v0.x), bfhi(v0.x), bflo(v0.y), bfhi(v0.y), bflo(v0.z), bfhi(v0.z), bflo(v0.w), bfhi(v0.w)};
        float x1[8] = {bflo(v1.x), bfhi(v1.x), bflo(v1.y), bfhi(v1.y), bflo(v1.z), bfhi(v1.z), bflo(v1.w), bfhi(v1.w)};
        float ss = 0.f;
#pragma unroll
        for (int j = 0; j < 8; ++j) ss += x0[j] * x0[j] + x1[j] * x1[j];
        ss += xorf<16>(ss); ss += xorf<32>(ss);
        const float r = fast_rsqrt(ss * (1.0f / 64.0f) + NORM_EPS) * 0.125f; const float* qg = CIN(9) + (size_t)l * 64;
#pragma unroll
        for (int j = 0; j < 8; ++j) { const int d = fq * 8 + j; const float y0 = x0[j] * r * qg[d], y1 = x1[j] * r * qg[d + 32];
            const float cs = cosT[pos * 32 + d], sn = sinT[pos * 32 + d];
            qc[0][j] = (short)f2bf(y0); qc[1][j] = (short)f2bf(y1); qr[0][j] = (short)f2bf((y0 * cs - y1 * sn) * 1.44269504f); qr[1][j] = (short)f2bf((y0 * sn + y1 * cs) * 1.44269504f); }
    }
    if (c.tid < 384) { const int row = c.tid / 3, br = c.tid % 3, hh = row >> 6, q = row & 63;
        gates[c.tid] = sigmoidf_(bf2f(proj[(size_t)(tokq0 + q) * PROJ_LD + C_NG + (g * 2 + hh) * 3 + br])); }
    f32x4 ofin[4];
#pragma unroll
    for (int et = 0; et < 4; ++et) ofin[et] = (f32x4){0.f, 0.f, 0.f, 0.f};
    const int nvis = 4 * qt + 3, nkt = (nvis + 15) >> 4, nk32 = ((nkt * 16 + 31) >> 5) << 5;
    {
        const bf16_t* kc = wsp<bf16_t>(c, WS_KCMP) + (size_t)(b * 2 + g) * NCMP_PAD * 64;
        f32x4 s[16];
#pragma unroll
        for (int jt = 0; jt < 16; ++jt) { s[jt] = (f32x4){0.f, 0.f, 0.f, 0.f};
            if (jt < nkt) { s[jt] = mfma16(qc[0], *(const bf16x8*)(kc + (size_t)(jt * 16 + fr) * 64 + fq * 8), s[jt]);
                            s[jt] = mfma16(qc[1], *(const bf16x8*)(kc + (size_t)(jt * 16 + fr) * 64 + 32 + fq * 8), s[jt]); } }
#pragma unroll
        for (int i = 0; i < 4; ++i) {
            const int sp = qt * 64 + qw + fq * 4 + i, lim = (sp >= 31) ? ((sp - 31) >> 4) : -1;
            float mx = NEG_BIG;
#pragma unroll
            for (int jt = 0; jt < 16; ++jt) if (jt < nkt && jt * 16 + fr <= lim) mx = fmaxf(mx, s[jt][i]);
            mx = fmaxf(mx, xorf<1>(mx)); mx = fmaxf(mx, xorf<2>(mx)); mx = fmaxf(mx, xorf<4>(mx)); mx = fmaxf(mx, xorf<8>(mx));
            float ps = 0.f;
#pragma unroll
            for (int jt = 0; jt < 16; ++jt) { float p = 0.f; if (jt < nkt && jt * 16 + fr <= lim) p = fast_exp(s[jt][i] - mx); s[jt][i] = p; ps += p; }
            ps += xorf<1>(ps); ps += xorf<2>(ps); ps += xorf<4>(ps); ps += xorf<8>(ps);
            const float inv = ps > 0.f ? fast_rcp(ps) : 0.f;
            LDSP bf16_t* prow = Pc + (size_t)(hg * 64 + qw + fq * 4 + i) * NA_PCLD;
#pragma unroll
            for (int jt = 0; jt < 16; ++jt) if (jt * 16 < nk32) prow[jt * 16 + fr] = f2bf(s[jt][i] * inv);
        }
        wave_sync();
        const bf16_t* vt = wsp<bf16_t>(c, WS_VCMPT) + (size_t)(b * 2 + g) * 64 * NCMP_PAD;
        f32x4 oc[4];
#pragma unroll
        for (int et = 0; et < 4; ++et) oc[et] = (f32x4){0.f, 0.f, 0.f, 0.f};
        for (int k0 = 0; k0 < nk32; k0 += 32) {
            const bf16x8 pa = *(const LDSP bf16x8*)(Pc + (size_t)(hg * 64 + qw + fr) * NA_PCLD + k0 + fq * 8);
#pragma unroll
            for (int et = 0; et < 4; ++et) oc[et] = mfma16(*(const bf16x8*)(vt + (size_t)(et * 16 + fr) * NCMP_PAD + k0 + fq * 8), pa, oc[et]);
        }
        block_sync();
#pragma unroll
        for (int et = 0; et < 4; ++et) ofin[et] += oc[et] * gates[(hg * 64 + qw + fr) * 3 + 0];
    }
    for (int e = c.tid; e < 4096; e += NTHR) { const int q = e >> 6, j = e & 63; float a = 0.f;
        if (j <= qt) {
#pragma unroll
            for (int dn = -1; dn <= 3; ++dn) { const int n = 4 * j + dn; if (n >= 0 && n < nkt * 16) a += bf2f(Pc[(size_t)q * NA_PCLD + n]) + bf2f(Pc[(size_t)(64 + q) * NA_PCLD + n]); }
            if (j == 0 || j == qt || j == qt - 1) a += 1000.f;
        } else a = NEG_BIG;
        imp[q * 65 + j] = a; }
    block_sync();
    for (int qq = 0; qq < 8; ++qq) { const int q = c.wave * 8 + qq; unsigned long long m = 0ull;
        if (qt < 16) m = (1ull << (qt + 1)) - 1ull;
        else { const unsigned key = (sortkey32(imp[q * 65 + c.lane]) & 0xffffffc0u) | (unsigned)(63 - c.lane); int rank = 0;
#pragma unroll
            for (int i = 0; i < 64; ++i) rank += ((unsigned)bcast_i((int)key, i) > key) ? 1 : 0;
            m = ballot64(rank < 16); }
        if (c.lane == 0) selmask[q] = m; }
    block_sync();
    const unsigned long long selm = selmask[qw + fr];
#pragma unroll
    for (int mode = 0; mode < 2; ++mode) {
        f32x4 ot[4]; float mrun = NEG_BIG, lrun = 0.f;
#pragma unroll
        for (int et = 0; et < 4; ++et) ot[et] = (f32x4){0.f, 0.f, 0.f, 0.f};
        const int j0 = (mode == 0) ? 0 : (qt >= 8 ? qt - 8 : 0), ns = (qt - j0) / 2 + 1;
        const int skey = c.tid >> 2, sd0 = (c.tid & 3) * 16, se = c.tid >> 3, sk0 = (c.tid & 7) * 16;
        u32x4 rk0, rk1, rv0, rv1;
#define NSA_STAGE_LOAD(js_) do { const int jb_ = (js_) + (skey >> 6) > qt ? qt : (js_) + (skey >> 6); const size_t tok_ = (size_t)b * SEQ + jb_ * 64 + (skey & 63); \
            const bf16_t* kp_ = ksw + tok_ * 256 + (mode * 2 + g) * 64 + sd0; rk0 = *(const u32x4*)kp_; rk1 = *(const u32x4*)(kp_ + 8); \
            const int jv_ = (js_) + (sk0 >> 6) > qt ? qt : (js_) + (sk0 >> 6); const bf16_t* vp_ = proj + ((size_t)b * SEQ + jv_ * 64 + se) * PROJ_LD + (mode == 0 ? C_NVS : C_NVW) + g * 64 + (sk0 & 63); rv0 = *(const u32x4*)vp_; rv1 = *(const u32x4*)(vp_ + 8); } while (0)
#define NSA_STAGE_WRITE(buf_) do { LDSP bf16_t* kd_ = (LDSP bf16_t*)(c.lds + (buf_) * NA_BUF) + skey * NA_KLD + sd0; *(LDSP u32x4*)kd_ = rk0; *(LDSP u32x4*)(kd_ + 8) = rk1; \
            LDSP bf16_t* vd_ = (LDSP bf16_t*)(c.lds + (buf_) * NA_BUF + NA_VOFF) + se * NA_VLD + sk0; *(LDSP u32x4*)vd_ = rv0; *(LDSP u32x4*)(vd_ + 8) = rv1; } while (0)
        NSA_STAGE_LOAD(j0); NSA_STAGE_WRITE(0);
        block_sync();
        for (int sidx = 0; sidx < ns; ++sidx) {
            const int js = j0 + 2 * sidx;
            if (sidx + 1 < ns) NSA_STAGE_LOAD(js + 2);
            const bool edge = (mode == 0) ? (js + 1 >= qt) : (sidx == 0 || js + 1 >= qt);
            if (mode == 0) { if (edge) nsa_stage<0, true>(c, sidx & 1, js, qt, qr, ot, mrun, lrun, selm); else nsa_stage<0, false>(c, sidx & 1, js, qt, qr, ot, mrun, lrun, selm); }
            else { if (edge) nsa_stage<1, true>(c, sidx & 1, js, qt, qr, ot, mrun, lrun, selm); else nsa_stage<1, false>(c, sidx & 1, js, qt, qr, ot, mrun, lrun, selm); }
            if (sidx + 1 < ns) NSA_STAGE_WRITE((sidx + 1) & 1);
            block_sync();
        }
#undef NSA_STAGE_LOAD
#undef NSA_STAGE_WRITE
        float ls = lrun; ls += xorf<16>(ls); ls += xorf<32>(ls);
        const float sc = gates[(hg * 64 + qw + fr) * 3 + 1 + mode] * (ls > 0.f ? fast_rcp(ls) : 0.f);
#pragma unroll
        for (int et = 0; et < 4; ++et) ofin[et] += ot[et] * sc;
    }
    bf16_t* out = wsp<bf16_t>(c, WS_OUTS) + (size_t)2 * NT * MW + (size_t)(tokq0 + qw + fr) * MW + hd * 64 + fq * 4;
#pragma unroll
    for (int et = 0; et < 4; ++et) { u32x2 w; w.x = pk2(ofin[et][0], ofin[et][1]); w.y = pk2(ofin[et][2], ofin[et][3]); *(u32x2*)(out + et * 16) = w; }
    block_sync();
}
constexpr int PEER_WSCR = (4 * 256 + 3 * 128) * 4;
constexpr int PEER_TAB = 8 * PEER_WSCR;
#ifndef HOST_EMU
DEV int uniform_i(int v) { return __builtin_amdgcn_readfirstlane(v); }
#else
static inline int uniform_i(int v) { return v; }
#endif
DEV unsigned sortkey16(unsigned b) { return (b & 0x8000u) ? (~b & 0xffffu) : (b | 0x8000u); }
DEV f32x2 dot16_fp8(const f32x2 (&x)[8], const u32x4 q, f32x2 s) {
#pragma unroll
    for (int i = 0; i < 4; ++i) { const f32x2 lo = cvt_pk_f32_fp8(q[i], false), hi = cvt_pk_f32_fp8(q[i], true); s = x[2 * i] * lo + s; s = x[2 * i + 1] * hi + s; }
    return s;
}
DEV void axpy16_fp8(f32x2 (&acc)[8], float w, const u32x4 q) {
    const f32x2 w2 = {w, w};
#pragma unroll
    for (int i = 0; i < 4; ++i) { const f32x2 lo = cvt_pk_f32_fp8(q[i], false), hi = cvt_pk_f32_fp8(q[i], true); acc[2 * i] = w2 * lo + acc[2 * i]; acc[2 * i + 1] = w2 * hi + acc[2 * i + 1]; }
}
DEV f32x2 dot16_fp4(const f32x2 (&x)[8], const u32x2 q, f32x2 s) {
#pragma unroll
    for (int i = 0; i < 2; ++i)
#pragma unroll
        for (int b = 0; b < 4; ++b) s = x[4 * i + b] * cvt_pk_f32_fp4(q[i], b) + s;
    return s;
}
DEV void axpy16_fp4(f32x2 (&acc)[8], float w, const u32x2 q) {
    const f32x2 w2 = {w, w};
#pragma unroll
    for (int i = 0; i < 2; ++i)
#pragma unroll
        for (int b = 0; b < 4; ++b) acc[4 * i + b] = w2 * cvt_pk_f32_fp4(q[i], b) + acc[4 * i + b];
}
DEV void peer_init_tab(const Ctx& c) {
    if (c.tid < 64) { const int t = c.tid; int a, b;
        if (t < 16) { a = 0; b = t; } else if (t < 24) { a = 1; b = t - 16; } else if (t < 29) { a = 2; b = t - 24; } else if (t < 33) { a = 3; b = t - 29; }
        else if (t < 36) { a = 4; b = t - 33; } else if (t < 42) { a = 5 + (t - 36) / 2; b = (t - 36) & 1; } else { a = 8 + (t - 42); b = 0; }
        ((LDSP unsigned char*)(c.lds + PEER_TAB))[t] = (t < 50) ? (unsigned char)((a << 4) | b) : (unsigned char)0xff; }
    block_sync();
}
DEV void peer_token(const Ctx& c, int l, int tok) {
    const int lane = c.lane;
    LDSP float* Wv = (LDSP float*)(c.lds + c.wave * PEER_WSCR); LDSP int* Wi = (LDSP int*)(Wv + 256); LDSP float* Sv = (LDSP float*)(Wi + 256); LDSP int* Si = (LDSP int*)(Sv + 256);
    LDSP int* We = Si + 256; LDSP float* Ws = (LDSP float*)(We + 128); LDSP float* Wg = Ws + 128;
    const bf16_t* sc = wsp<bf16_t>(c, WS_SCORES) + (size_t)tok * PEER_N;
#ifndef DUP_TOPK
#define DUP_TOPK 1
#endif
    for (int rep_ = 0; rep_ < DUP_TOPK; ++rep_) {
    unsigned w[16];
#pragma unroll
    for (int gi = 0; gi < 16; ++gi) w[gi] = *(const unsigned*)(sc + gi * 128 + 2 * lane);
#pragma unroll
    for (int gq = 0; gq < 16; gq += 4) {
        unsigned k0[4], k1[4], T[4];
#pragma unroll
        for (int u = 0; u < 4; ++u) { k0[u] = sortkey16(w[gq + u] & 0xffffu); k1[u] = sortkey16(w[gq + u] >> 16); T[u] = 0u; }
#pragma unroll
        for (int bit = 15; bit >= 0; --bit) {
            unsigned long long ba[4], bb[4];
#pragma unroll
            for (int u = 0; u < 4; ++u) { const unsigned cand = T[u] | (1u << bit); ba[u] = ballot64(k0[u] >= cand); bb[u] = ballot64(k1[u] >= cand); }
#pragma unroll
            for (int u = 0; u < 4; ++u) { const int cnt = __builtin_popcountll(ba[u]) + __builtin_popcountll(bb[u]); if (cnt >= 16) T[u] |= (1u << bit); }
        }
#pragma unroll
        for (int u = 0; u < 4; ++u) { const int gi = gq + u;
            const unsigned long long gt0 = ballot64(k0[u] > T[u]), gt1 = ballot64(k1[u] > T[u]), eq0 = ballot64(k0[u] == T[u]), eq1 = ballot64(k1[u] == T[u]);
            const int need = 16 - __builtin_popcountll(gt0) - __builtin_popcountll(gt1);
            const int eqr0 = mbcnt64(eq0) + mbcnt64(eq1), eqr1 = eqr0 + (k0[u] == T[u] ? 1 : 0);
            const bool sel0 = (k0[u] > T[u]) || (k0[u] == T[u] && eqr0 < need), sel1 = (k1[u] > T[u]) || (k1[u] == T[u] && eqr1 < need);
            const unsigned long long s0 = ballot64(sel0), s1 = ballot64(sel1);
            const int slot0 = mbcnt64(s0) + mbcnt64(s1), slot1 = slot0 + (sel0 ? 1 : 0);
            if (sel0) { Wv[gi * 16 + slot0] = bflo(w[gi]); Wi[gi * 16 + slot0] = 2 * lane; }
            if (sel1) { Wv[gi * 16 + slot1] = bfhi(w[gi]); Wi[gi * 16 + slot1] = 2 * lane + 1; } }
    }
    wave_sync();
#pragma unroll
    for (int pass = 0; pass < 4; ++pass) { const int g = pass * 4 + (lane >> 4), e = lane & 15; const float v = Wv[g * 16 + e]; const int iv = Wi[g * 16 + e]; int rank = 0;
#pragma unroll
        for (int j = 0; j < 16; ++j) { const float vj = Wv[g * 16 + j]; const int ij = Wi[g * 16 + j]; rank += (vj > v || (vj == v && ij < iv)) ? 1 : 0; }
        Sv[g * 16 + rank] = v; Si[g * 16 + rank] = iv; }
    wave_sync();
    const unsigned ab = ((const LDSP unsigned char*)(c.lds + PEER_TAB))[lane]; const bool valid = ab != 0xffu; const int a = (ab >> 4) & 15, b = ab & 15;
    for (int h = 0; h < 8; ++h) {
        const float s = valid ? Sv[(2 * h) * 16 + a] + Sv[(2 * h + 1) * 16 + b] : -3.0e38f;
        const unsigned key = valid ? ((sortkey32(s) & 0xffffff00u) | (unsigned)(255 - (a * 16 + b))) : 0u;
        int rank = 0;
#pragma unroll
        for (int j = 0; j < 50; ++j) rank += ((unsigned)bcast_i((int)key, j) > key) ? 1 : 0;
        if (valid && rank < 16) { We[h * 16 + rank] = (Si[(2 * h) * 16 + a] * 128 + Si[(2 * h + 1) * 16 + b]) & 16383; Ws[h * 16 + rank] = s; }
    }
    wave_sync();
    { const float mx = Ws[(lane >> 3) * 16]; const float e0 = fast_exp(Ws[2 * lane] - mx), e1 = fast_exp(Ws[2 * lane + 1] - mx); float sm = e0 + e1;
      sm += xorf<1>(sm); sm += xorf<2>(sm); sm += xorf<4>(sm); const float inv = fast_rcp(sm); Wg[2 * lane] = e0 * inv; Wg[2 * lane + 1] = e1 * inv; }
    wave_sync();
    }
    const bf16_t* xb = wsp<bf16_t>(c, WS_XB) + (size_t)tok * DM; const unsigned char* PU = wsp<unsigned char>(c, WS_PU); const unsigned char* PV = wsp<unsigned char>(c, WS_PV);
    f32x2 xf[8];
    { const u32x4 x0 = *(const u32x4*)(xb + 16 * lane), x1 = *(const u32x4*)(xb + 16 * lane + 8);
      xf[0] = (f32x2){bflo(x0.x), bfhi(x0.x)}; xf[1] = (f32x2){bflo(x0.y), bfhi(x0.y)}; xf[2] = (f32x2){bflo(x0.z), bfhi(x0.z)}; xf[3] = (f32x2){bflo(x0.w), bfhi(x0.w)};
      xf[4] = (f32x2){bflo(x1.x), bfhi(x1.x)}; xf[5] = (f32x2){bflo(x1.y), bfhi(x1.y)}; xf[6] = (f32x2){bflo(x1.z), bfhi(x1.z)}; xf[7] = (f32x2){bflo(x1.w), bfhi(x1.w)}; }
    const float rstd = pg8::rstd_of(pg8::rss_slots16(wsp<float>(c, WS_RSS2) + (size_t)tok * 16)) * (1.0f / 64.0f);
    f32x2 acc[8];
#pragma unroll
    for (int j = 0; j < 8; ++j) acc[j] = (f32x2){0.f, 0.f};
#define PEER_LOADV(buf, base) do { _Pragma("unroll") for (int k_ = 0; k_ < 8; ++k_) { const int e_ = uniform_i(We[(base) + k_]); buf[k_] = *(const u32x2*)(PV + (size_t)e_ * (DM / 2) + 8 * lane); } } while (0)
#define PEER_LOAD8(buf, TAB, base) do { _Pragma("unroll") for (int k_ = 0; k_ < 8; ++k_) { const int e_ = uniform_i(We[(base) + k_]); buf[k_] = *(const u32x2*)((TAB) + (size_t)e_ * (DM / 2) + 8 * lane); } } while (0)
    u32x2 bu0[8], bu1[8], bv0[8], bv1[8];
    PEER_LOAD8(bu0, PU, 0); PEER_LOAD8(bu1, PU, 8);
    for (int h = 0; h < 8; ++h) {
        float part[16];
        PEER_LOADV(bv0, h * 16);
#pragma unroll
        for (int k = 0; k < 8; ++k) { const f32x2 s = dot16_fp4(xf, bu0[k], (f32x2){0.f, 0.f}); part[k] = s[0] + s[1]; }
        PEER_LOADV(bv1, h * 16 + 8);
#pragma unroll
        for (int k = 0; k < 8; ++k) { const f32x2 s = dot16_fp4(xf, bu1[k], (f32x2){0.f, 0.f}); part[8 + k] = s[0] + s[1]; }
        float p8[8], p4[4], p2[2], p1;
        { const bool up = (lane & 32) != 0;
#pragma unroll
          for (int i = 0; i < 8; ++i) { const float send = up ? part[i] : part[i + 8]; const float recv = xorf<32>(send); p8[i] = (up ? part[i + 8] : part[i]) + recv; } }
        { const bool up = (lane & 16) != 0;
#pragma unroll
          for (int i = 0; i < 4; ++i) { const float send = up ? p8[i] : p8[i + 4]; const float recv = xorf<16>(send); p4[i] = (up ? p8[i + 4] : p8[i]) + recv; } }
        { const bool up = (lane & 8) != 0;
#pragma unroll
          for (int i = 0; i < 2; ++i) { const float send = up ? p4[i] : p4[i + 2]; const float recv = xorf<8>(send); p2[i] = (up ? p4[i + 2] : p4[i]) + recv; } }
        { const bool up = (lane & 4) != 0; const float send = up ? p2[0] : p2[1]; const float recv = xorf<4>(send); p1 = (up ? p2[1] : p2[0]) + recv; }
        p1 += xorf<2>(p1); p1 += xorf<1>(p1);
        const float dk = shfl_f(p1, (lane & 15) * 4);
        const float wk = Wg[h * 16 + (lane & 15)] * gelu_erf(dk * rstd) * 0.1f;
        if (h < 7) PEER_LOAD8(bu0, PU, h * 16 + 16);
#pragma unroll
        for (int k = 0; k < 8; ++k) axpy16_fp4(acc, bcast_f(wk, k), bv0[k]);
        if (h < 7) PEER_LOAD8(bu1, PU, h * 16 + 24);
#pragma unroll
        for (int k = 0; k < 8; ++k) axpy16_fp4(acc, bcast_f(wk, 8 + k), bv1[k]);
    }
#undef PEER_LOAD8
#undef PEER_LOADV
    float* orow = c.out + (size_t)tok * DM + 16 * lane; float ss = 0.f; f32x4 o[4];
#pragma unroll
    for (int j = 0; j < 4; ++j) { o[j] = *(const f32x4*)(orow + 4 * j); o[j] += (f32x4){acc[2 * j][0], acc[2 * j][1], acc[2 * j + 1][0], acc[2 * j + 1][1]}; *(f32x4*)(orow + 4 * j) = o[j]; }
    if (l + 1 < DEPTH) {
        bf16_t* xo = wsp<bf16_t>(c, WS_XB) + (size_t)tok * DM + 16 * lane;
        u32x4 w0, w1; w0.x = pk2(o[0][0], o[0][1]); w0.y = pk2(o[0][2], o[0][3]); w0.z = pk2(o[1][0], o[1][1]); w0.w = pk2(o[1][2], o[1][3]);
        w1.x = pk2(o[2][0], o[2][1]); w1.y = pk2(o[2][2], o[2][3]); w1.z = pk2(o[3][0], o[3][1]); w1.w = pk2(o[3][2], o[3][3]);
        *(u32x4*)xo = w0; *(u32x4*)(xo + 8) = w1;
#pragma unroll
        for (int j = 0; j < 4; ++j) ss += (o[j][0] * o[j][0] + o[j][1] * o[j][1]) + (o[j][2] * o[j][2] + o[j][3] * o[j][3]);
        ss = wave_sum(ss);
        if (lane == 0) wsp<float>(c, WS_RSS1)[tok] = ss;
    }
    wave_sync();
}
DEV void peer_table_rows(const Ctx& c, int l) {
    const float* g2 = CIN(17) + (size_t)l * DM;
    const f32x4 ga = *((const f32x4*)g2 + 4 * c.lane), gb = *((const f32x4*)g2 + 4 * c.lane + 1), gc = *((const f32x4*)g2 + 4 * c.lane + 2), gd = *((const f32x4*)g2 + 4 * c.lane + 3);
    for (int r = c.bid * NWAVE + c.wave; r < 2 * 16384; r += c.nblk * NWAVE) {
        const int tab = r >> 14, e = r & 16383;
        const f32x4* src = (const f32x4*)((tab == 0 ? CIN(20) : CIN(21)) + ((size_t)l * 16384 + e) * DM) + 4 * c.lane;
        f32x4 v0 = src[0], v1 = src[1], v2 = src[2], v3 = src[3];
        if (tab == 0) { v0 *= ga * 64.0f; v1 *= gb * 64.0f; v2 *= gc * 64.0f; v3 *= gd * 64.0f;
        } else { v0 *= 10.0f; v1 *= 10.0f; v2 *= 10.0f; v3 *= 10.0f; }
        {
            u32x2 q;
            q.x = fp4_code(v0[0]) | (fp4_code(v0[1]) << 4) | (fp4_code(v0[2]) << 8) | (fp4_code(v0[3]) << 12) | (fp4_code(v1[0]) << 16) | (fp4_code(v1[1]) << 20) | (fp4_code(v1[2]) << 24) | (fp4_code(v1[3]) << 28);
            q.y = fp4_code(v2[0]) | (fp4_code(v2[1]) << 4) | (fp4_code(v2[2]) << 8) | (fp4_code(v2[3]) << 12) | (fp4_code(v3[0]) << 16) | (fp4_code(v3[1]) << 20) | (fp4_code(v3[2]) << 24) | (fp4_code(v3[3]) << 28);
            *(u32x2*)(wsp<unsigned char>(c, tab == 0 ? WS_PU : WS_PV) + (size_t)e * (DM / 2) + 8 * c.lane) = q;
        }
    }
}
#ifndef HOST_EMU
#define XB_TMO      128
#define XB_XCNT(j)  (256  + 64 * (j))
#define XB_XSUB(j)  (1280 + 64 * (j))
#define XB_XGEN(j)  (2304 + 64 * (j))
#define XB_TOP      3328
#define XB_TOPGEN   3392
#define XCD_BAR_WORDS 3456
#define XB_SPIN_CAP (1u << 18)

__device__ __forceinline__ unsigned xb_ld(unsigned* p)              { return __hip_atomic_load(p, __ATOMIC_RELAXED, __HIP_MEMORY_SCOPE_AGENT); }
__device__ __forceinline__ unsigned xb_add(unsigned* p, unsigned v) { return __hip_atomic_fetch_add(p, v, __ATOMIC_RELAXED, __HIP_MEMORY_SCOPE_AGENT); }
__device__ __forceinline__ unsigned xb_xcc_id() { return (unsigned)__builtin_amdgcn_s_getreg((3 << 11) | 20) & 0xFu; }
#define XB_SPIN(cond, bar) do { unsigned _sp = 0; while (cond) { __builtin_amdgcn_s_sleep(1); \
    if ((++_sp & 255u) == 0u) { if (xb_ld(&(bar)[XB_TMO])) break; if (_sp > XB_SPIN_CAP) { atomicAdd(&(bar)[XB_TMO], 1u); break; } } } } while (0)

struct XcdBarrier {
    unsigned* bar; unsigned x;
    volatile __attribute__((address_space(3))) unsigned* st;
};

__device__ __forceinline__ XcdBarrier xcd_barrier_post(unsigned* bar, volatile __attribute__((address_space(3))) unsigned* st) {
    XcdBarrier b; b.bar = bar; b.x = xb_xcc_id(); b.st = st;
    if (threadIdx.x == 0) (void)xb_add(&bar[XB_XCNT(b.x)], 1u);
    return b;
}
__device__ __forceinline__ void xcd_barrier_complete(unsigned* bar, unsigned x, unsigned& nloc, unsigned& nx) {
    const unsigned G = gridDim.x * gridDim.y * gridDim.z;
    unsigned sum, cnt, mine, sp = 0u;
    for (;;) {
        sum = 0u; cnt = 0u; mine = 0u;
#pragma unroll
        for (unsigned j = 0; j < 16; ++j) { const unsigned c = xb_ld(&bar[XB_XCNT(j)]); sum += c; cnt += (c > 0u) ? 1u : 0u; mine = (j == x) ? c : mine; }
        if (sum == G) break;
        __builtin_amdgcn_s_sleep(1);
        if ((++sp & 255u) == 0u) { if (xb_ld(&bar[XB_TMO])) break; if (sp > XB_SPIN_CAP) { atomicAdd(&bar[XB_TMO], 1u); break; } }
    }
    nloc = mine > 0u ? mine : 1u; nx = cnt > 0u ? cnt : 1u;
}

__device__ __forceinline__ void xcd_barrier(const XcdBarrier& b) {
    asm volatile("s_waitcnt vmcnt(0)" ::: "memory");
    __syncthreads();
    if (threadIdx.x == 0) {
        unsigned* bar = b.bar;
        __builtin_amdgcn_s_waitcnt(0);
        unsigned nloc = b.st[0], nx = b.st[1];
        if (nloc == 0u) { xcd_barrier_complete(bar, b.x, nloc, nx); b.st[0] = nloc; b.st[1] = nx; }
        const unsigned old = xb_add(&bar[XB_XSUB(b.x)], 1u);
        const unsigned gen = old / nloc;
        if (old + 1u == (gen + 1u) * nloc) {
            __builtin_amdgcn_fence(__ATOMIC_RELEASE, "agent");
            asm volatile("s_waitcnt vmcnt(0)" ::: "memory");
            const unsigned og = xb_add(&bar[XB_TOP], 1u);
            const unsigned tg = og / nx;
            if (og + 1u == (tg + 1u) * nx) xb_add(&bar[XB_TOPGEN], 1u);
            else XB_SPIN(xb_ld(&bar[XB_TOPGEN]) == tg, bar);
            __builtin_amdgcn_fence(__ATOMIC_ACQUIRE, "agent");
            xb_add(&bar[XB_XGEN(b.x)], 1u);
            asm volatile("s_waitcnt vmcnt(0)" ::: "memory");
        } else {
            XB_SPIN(xb_ld(&bar[XB_XGEN(b.x)]) == gen, bar);
            __builtin_amdgcn_fence(__ATOMIC_ACQUIRE, "agent");
            asm volatile("s_waitcnt vmcnt(0)" ::: "memory");
        }
    }
    __syncthreads();
}


#endif
#ifndef DBG_COPY
#define DBG_COPY 0
#endif
#ifndef DBG_PHASE
#define DBG_PHASE 5
#endif
#ifndef DUP_NSA
#define DUP_NSA 1
#endif
#ifndef DUP_REC
#define DUP_REC 1
#endif
#ifndef DUP_P5
#define DUP_P5 1
#endif
#ifndef DUP_P2
#define DUP_P2 1
#endif
#ifndef DUP_P0
#define DUP_P0 1
#endif
#ifndef DUP_P1
#define DUP_P1 1
#endif
#ifndef DUP_NP
#define DUP_NP 1
#endif
#ifndef HOST_EMU
#define GRID_SYNC() do { if (ph == 1) cg::this_grid().sync(); else { XcdBarrier xb_; xb_.bar = (unsigned*)(lds_ptr_entry(22) + WS_BARRIER); xb_.x = xb_xcc_id(); \
    xb_.st = (volatile __attribute__((address_space(3))) unsigned*)(smem_raw + LDS_PTRS + 192); xcd_barrier(xb_); } } while (0)
#else
#define GRID_SYNC() grid_sync_impl()
#endif

#ifndef HOST_EMU
DEV unsigned char* lds_ptr_entry(int i) {
    int z; asm volatile("s_mov_b32 %0, 0" : "=s"(z)); i += z;
    const unsigned long long v = ((volatile LDSP unsigned long long*)((LDSP unsigned char*)smem_raw + LDS_PTRS))[i];
    const unsigned lo = __builtin_amdgcn_readfirstlane((unsigned)v), hi = __builtin_amdgcn_readfirstlane((unsigned)(v >> 32));
    return (unsigned char*)(__attribute__((address_space(1))) unsigned char*)(((unsigned long long)hi << 32) | lo);
}
#endif
DEV Ctx make_ctx(const Params& p, int wave0) {
#ifndef HOST_EMU
    Ctx c; c.out = p.out; c.ws = p.ws; c.tid = wave0 * 64 + fresh_lane();
#else
    Ctx c; c.out = p.out; c.ws = p.ws; c.tid = TID();
#endif
    c.bid = BID(); c.nblk = NBLK(); int z = 0;
#ifndef HOST_EMU
    asm volatile("" : "+v"(c.tid), "+s"(c.bid), "+s"(c.nblk));
    asm volatile("s_mov_b32 %0, 0" : "=s"(z));
    c.ws = lds_ptr_entry(22); c.out = (float*)lds_ptr_entry(23);
#endif
    c.lds = SMEM_PTR() + z; c.lane = c.tid & 63; c.wave = c.tid >> 6;
#ifndef HOST_EMU
    c.wave = __builtin_amdgcn_readfirstlane(c.wave);
#endif
    return c;
}
#ifndef HOST_EMU
__global__ void __launch_bounds__(NTHR, 2) fwd_kernel(Params p)
#else
void fwd_kernel(Params p)
#endif
{
    {
        LDSP char* lds0 = SMEM_PTR();
        if (TID() == 0) {
#pragma unroll
            for (int i = 0; i < 22; ++i) ((LDSP unsigned long long*)(lds0 + LDS_PTRS))[i] = (unsigned long long)p.in[i];
            ((LDSP unsigned long long*)(lds0 + LDS_PTRS))[22] = (unsigned long long)p.ws; ((LDSP unsigned long long*)(lds0 + LDS_PTRS))[23] = (unsigned long long)p.out;
        }
        block_sync();
    }
#ifndef HOST_EMU
    const int wave0 = __builtin_amdgcn_readfirstlane((int)threadIdx.x >> 6);
#else
    const int wave0 = 0;
#endif
#ifndef HOST_EMU
    volatile __attribute__((address_space(3))) unsigned* xst = (volatile __attribute__((address_space(3))) unsigned*)(smem_raw + LDS_PTRS + 192);
    if (threadIdx.x == 0) { xst[0] = 0u; xst[1] = 0u; }
    __syncthreads();
    (void)xcd_barrier_post((unsigned*)(p.ws + WS_BARRIER), xst);
#endif
    int ph = 0;
#define PHASE_END() do { ++ph; if (DBG_COPY && ph == DBG_PHASE) { GRID_SYNC(); Ctx c = make_ctx(p, wave0); \
        const bf16_t* src = wsp<bf16_t>(c, DBG_COPY == 1 ? WS_OUTS : DBG_COPY == 2 ? WS_ST : DBG_COPY == 3 ? WS_PROJ : DBG_COPY == 4 ? WS_HALO : DBG_COPY >= 6 ? WS_OUTS + (size_t)(DBG_COPY - 6) * NT * MW * 2 : WS_KSW); const size_t nsrc = DBG_COPY >= 6 ? (size_t)NT * MW : DBG_COPY == 2 ? 3 * ST_ONE / 2 : DBG_COPY == 4 ? (size_t)BATCH * NC * 3 * 512 + (size_t)NT * NH * 2 * 2 + (size_t)BATCH * NH * NC * 64 * 2 : (size_t)NT * DM; \
        for (size_t i = (size_t)c.bid * NTHR + c.tid; i < (size_t)NT * DM; i += (size_t)c.nblk * NTHR) c.out[i] = i < nsrc ? bf2f(src[i]) : 0.f; return; } \
        if (ph >= p.phase_hi) return; GRID_SYNC(); } while (0)
    for (int l = 0; l < DEPTH; ++l) {
        for (int rep = 0; rep < DUP_P0; ++rep) { Ctx c = make_ctx(p, wave0); p0_prep(c, l); }
        PHASE_END();
        for (int rep = 0; rep < DUP_P1; ++rep) {
            Ctx c = make_ctx(p, wave0);
            pg8::Gemm g{wsp<bf16_t>(c, WS_XB), wsp<bf16_t>(c, WS_WIN), NT, PROJ_N, DM}; pg8::StaticOrder S; S.init(NT, PROJ_N, c.nblk, c.bid);
            pg8::EpiScaleBf16<1, true> E{wsp<bf16_t>(c, WS_PROJ), PROJ_LD, wsp<float>(c, WS_RSS1), PROJ_LD, wsp<bf16_t>(c, WS_HALO)};
            pg8::gemm_phase<pg8::EpiScaleBf16<1, true>, pg8::StaticOrder, true, true>(GEMM_LDS, g, S, E, c.tid);
        }
        PHASE_END();
        for (int rep = 0; rep < DUP_P2; ++rep) { Ctx c = make_ctx(p, wave0); for (int u = c.bid; u < 3 * BATCH * NH * NC; u += c.nblk) recur_local_unit(c, l, u); }
        for (int rep = 0; rep < DUP_NP; ++rep) { Ctx c = make_ctx(p, wave0); for (int u = c.bid; u < BATCH * 8; u += c.nblk) nsa_compress_unit(c, l, u); }
        for (int rep = 0; rep < DUP_NP; ++rep) { Ctx c = make_ctx(p, wave0); for (int it = c.bid; it < NT / 4; it += c.nblk) nsa_kprep_item(c, l, it); }
        for (int rep = 0; rep < DUP_NP; ++rep) { Ctx c = make_ctx(p, wave0); for (int it = c.bid; it < BATCH * 4 * NC; it += c.nblk) nsa_vprep_item(c, it); }
        PHASE_END();
        { Ctx c = make_ctx(p, wave0); recur_scan(c); }
        PHASE_END();
        for (int rep = 0; rep < DUP_NSA; ++rep) { Ctx c = make_ctx(p, wave0);
        for (int u = c.bid; u < BATCH * 2 * NSEL; u += c.nblk) {
            const int nbg = BATCH * 2, bg = u % nbg, qi = u / nbg; int qt = qi;
            if (NSEL == 64) { const int r = qi >> 4, ql = qi & 15; qt = (r == 0) ? 63 - ql : (r == 1) ? ql : (r == 2) ? 47 - ql : 16 + ql; }
            nsa_attn_unit(c, l, bg * NSEL + qt);
        } }
        for (int rep = 0; rep < DUP_REC; ++rep) { Ctx c = make_ctx(p, wave0); for (int u = c.bid * NWAVE + c.wave; u < 3 * BATCH * NH * NC; u += c.nblk * NWAVE) recur_out_wave(c, l, u); }
        PHASE_END();
        { Ctx c = make_ctx(p, wave0); peer_table_rows(c, l); }
        for (int rep = 0; rep < DUP_P5; ++rep) {
            { Ctx c = make_ctx(p, wave0); pg8::MixOrder<true> S{(NT / 256) * 4, c.nblk, c.bid, NT / 256};
              pg8::Gemm g{wsp<bf16_t>(c, WS_OUTS), wsp<bf16_t>(c, WS_WUP), 4 * NT, 4 * DM, MW};
              pg8::EpiU E{wsp<bf16_t>(c, WS_UALL)};
              pg8::gemm_phase<pg8::EpiU, pg8::MixOrder<true>, false, true>(GEMM_LDS, g, S, E, c.tid); }
            GRID_SYNC();
            { Ctx c = make_ctx(p, wave0); pg8::MixOrder<false> S{(NT / 256) * 4, c.nblk, c.bid, NT / 256};
              pg8::Gemm g{wsp<bf16_t>(c, WS_XB), wsp<bf16_t>(c, WS_WG), NT, 4 * DM, DM};
              pg8::EpiGate E{wsp<bf16_t>(c, WS_UALL), wsp<bf16_t>(c, WS_MERGED), wsp<float>(c, WS_RSS1), NT};
              pg8::gemm_phase<pg8::EpiGate, pg8::MixOrder<false>, false, true>(GEMM_LDS, g, S, E, c.tid); }
        }
        PHASE_END();
        {
            Ctx c = make_ctx(p, wave0); const float* xres = (l == 0) ? CIN(0) : c.out;
            pg8::Gemm g{wsp<bf16_t>(c, WS_MERGED), wsp<bf16_t>(c, WS_WOUT), NT, DM, DM}; pg8::StaticOrder S; S.init(NT, DM, c.nblk, c.bid);
            pg8::EpiOut E{xres, c.out, wsp<bf16_t>(c, WS_XB), wsp<float>(c, WS_RSS2)};
            pg8::gemm_phase<pg8::EpiOut, pg8::StaticOrder, true, true>(GEMM_LDS, g, S, E, c.tid);
        }
        PHASE_END();
        {
            Ctx c = make_ctx(p, wave0);
            pg8::Gemm g{wsp<bf16_t>(c, WS_XB), wsp<bf16_t>(c, WS_WQ2), NT, PEER_N, DM}; pg8::StaticOrder S; S.init(NT, PEER_N, c.nblk, c.bid);
            pg8::EpiScaleBf16<16> E{wsp<bf16_t>(c, WS_SCORES), PEER_N, wsp<float>(c, WS_RSS2), PEER_N, nullptr};
            pg8::gemm_phase<pg8::EpiScaleBf16<16>, pg8::StaticOrder, true, true>(GEMM_LDS, g, S, E, c.tid);
        }
        PHASE_END();
        { Ctx c = make_ctx(p, wave0); peer_init_tab(c); for (int t = c.bid * NWAVE + c.wave; t < NT; t += c.nblk * NWAVE) peer_token(c, l, t); }
        PHASE_END();
    }
}

#ifndef HOST_EMU
extern "C" void kernel_launch(void* const* d_in, const int* in_sizes, int n_in, void* d_out, int out_size, void* d_ws, size_t ws_size, hipStream_t stream) {
    static int grid = 0;
    if (grid == 0) {
        if (n_in != 22 || out_size != NT * DM || ws_size < WS_NEED) { fprintf(stderr, "kernel_launch: unexpected shapes (n_in %d out %d ws %zu need %zu)\n", n_in, out_size, ws_size, (size_t)WS_NEED); grid = -1; return; }
        int dev = 0, cus = 0, per_cu = 0;
        hipGetDevice(&dev); hipDeviceGetAttribute(&cus, hipDeviceAttributeMultiprocessorCount, dev);
        if (hipFuncSetAttribute((const void*)fwd_kernel, hipFuncAttributeMaxDynamicSharedMemorySize, LDS_BYTES) != hipSuccess) { fprintf(stderr, "kernel_launch: hipFuncSetAttribute failed\n"); grid = -1; return; }
        if (hipOccupancyMaxActiveBlocksPerMultiprocessor(&per_cu, (const void*)fwd_kernel, NTHR, LDS_BYTES) != hipSuccess || per_cu < 1) { fprintf(stderr, "kernel_launch: occupancy query failed (%d)\n", per_cu); (void)hipGetLastError(); per_cu = 1; }
        grid = cus;
        fprintf(stderr, "kernel_launch: grid %d (per_cu %d)\n", grid, per_cu);
    }
    if (grid < 0) return;
    if (hipMemsetAsync((char*)d_ws + WS_BARRIER, 0, 16384, stream) != hipSuccess) { fprintf(stderr, "kernel_launch: memset failed\n"); return; }
    Params p{};
    for (int i = 0; i < 22; ++i) p.in[i] = (const float*)d_in[i];
    p.out = (float*)d_out; p.ws = (unsigned char*)d_ws; p.phase_lo = 0; p.phase_hi = 1 << 20;
    void* args[] = {&p};
    hipError_t e = hipLaunchCooperativeKernel((const void*)fwd_kernel, dim3(grid), dim3(NTHR), args, LDS_BYTES, stream);
    if (e != hipSuccess) fprintf(stderr, "kernel_launch: cooperative launch failed: %s (grid %d)\n", hipGetErrorString(e), grid);
}
#endif
```

```cpp
#ifndef HOST_EMU
#include <hip/hip_runtime.h>
#include <hip/hip_cooperative_groups.h>
#include <cstdio>
#include <cstdint>
namespace cg = cooperative_groups;
#endif

#ifndef CFG_B
#define CFG_B 8
#endif
#ifndef CFG_S
#define CFG_S 4096
#endif

constexpr int BATCH = CFG_B, SEQ = CFG_S, DM = 1024, DEPTH = 2;
constexpr int NT = BATCH * SEQ;
constexpr int NH = 4, HD = 64, MW = 256, CH = 64, NC = SEQ / CH;
constexpr int N_IN_ORIG = 4116, PROJ_N = 4352, PROJ_LD = 4128;
constexpr int NCMP = (SEQ - 32) / 16 + 1;
constexpr int NCMP_PAD = SEQ / 16;
constexpr int NSEL = SEQ / 64;
constexpr int PEER_N = 2048;
constexpr float NORM_EPS = 1e-6f;
constexpr int NTHR = 512, NWAVE = 8;
constexpr int C_HQ = 0, C_HF = 256, C_HI = 512, C_HG = 768;
constexpr int C_MQ = 1024, C_MK = 1280, C_MV = 1536, C_MO = 1792;
constexpr int C_NQ = 2048, C_NKC = 2304, C_NVC = 2432, C_NKS = 2560, C_NVS = 2688, C_NKW = 2816, C_NVW = 2944;
constexpr int C_RQ = 3072, C_RK = 3328, C_RV = 3584, C_RG = 3840;
constexpr int C_MI = 4096, C_MF = 4100, C_NG = 4104;

typedef unsigned short bf16_t;
#ifndef HOST_EMU
typedef short bf16x8 __attribute__((ext_vector_type(8)));
typedef float f32x4 __attribute__((ext_vector_type(4)));
#endif
typedef unsigned u32x4 __attribute__((ext_vector_type(4)));
typedef unsigned u32x2 __attribute__((ext_vector_type(2)));
typedef float f32x2 __attribute__((ext_vector_type(2)));

constexpr size_t al256(size_t x) { return (x + 255) & ~(size_t)255; }
constexpr size_t WS_WIN = 0;
constexpr size_t WS_WG = WS_WIN + al256((size_t)PROJ_N * DM * 2);
constexpr size_t WS_WUP = WS_WG + al256((size_t)4 * DM * DM * 2);
constexpr size_t WS_WOUT = WS_WUP + al256((size_t)4 * DM * MW * 2);
constexpr size_t WS_WQ2 = WS_WOUT + al256((size_t)DM * DM * 2);
constexpr size_t WS_WCT = WS_WQ2 + al256((size_t)PEER_N * DM * 2);
constexpr size_t WS_CBIAS = WS_WCT + al256((size_t)2 * 64 * 2048 * 2);
constexpr size_t WS_ROPE = WS_CBIAS + 1024;
constexpr size_t WS_RSS1 = WS_ROPE + al256((size_t)SEQ * 64 * 4);
constexpr size_t WS_RSS2 = WS_RSS1 + al256((size_t)NT * 4);
constexpr size_t WS_XB = WS_RSS2 + al256((size_t)NT * 16 * 4);
constexpr size_t WS_OUTS = WS_XB + al256((size_t)NT * DM * 2);
constexpr size_t WS_ST = WS_OUTS + al256((size_t)NT * DM * 2);
constexpr size_t ST_ONE = (size_t)BATCH * NH * NC * 4096 * 2;
constexpr size_t WS_GDEC = WS_ST + al256(3 * ST_ONE);
constexpr size_t WS_MNL = WS_GDEC + al256((size_t)BATCH * NH * NC * 64 * 4);
constexpr size_t WS_MSC = WS_MNL + al256((size_t)BATCH * NH * NC * 64 * 4);
constexpr size_t WS_KCMP = WS_MSC + al256((size_t)BATCH * NH * NC * 4 * 4);
constexpr size_t WS_VCMPT = WS_KCMP + al256((size_t)BATCH * 2 * NCMP_PAD * 64 * 2);
constexpr size_t WS_KSW = WS_VCMPT + al256((size_t)BATCH * 2 * NCMP_PAD * 64 * 2);
constexpr size_t WS_HALO = WS_KSW + al256((size_t)NT * 256 * 2);
constexpr size_t WS_MTS = WS_HALO + al256((size_t)BATCH * NC * 3 * 512 * 2);
constexpr size_t WS_G31 = WS_MTS + al256((size_t)NT * NH * 2 * 4);
constexpr size_t WS_PROJ = WS_G31 + al256((size_t)BATCH * NH * NC * 64 * 4);
constexpr size_t PROJ_BYTES = al256((size_t)NT * PROJ_LD * 2);
constexpr size_t WS_BARRIER = WS_PROJ + PROJ_BYTES;
constexpr size_t WS_END = WS_BARRIER + 16384;
constexpr size_t WS_UALL = WS_PROJ;
constexpr size_t WS_MERGED = WS_OUTS;
constexpr size_t WS_SCORES = WS_PROJ;
constexpr bool TABLES_IN_ST = 3 * ST_ONE >= (size_t)2 * 16384 * DM;
constexpr size_t WS_PU = TABLES_IN_ST ? WS_ST : WS_END;
constexpr size_t WS_PV = WS_PU + al256((size_t)16384 * DM);
static_assert((size_t)4 * NT * DM * 2 <= PROJ_BYTES, "U fits the proj region");
static_assert(WS_END <= (size_t)536870912, "workspace budget");
constexpr size_t WS_NEED = TABLES_IN_ST ? WS_END : WS_PV + (size_t)16384 * DM;

constexpr int LDS_BYTES = 147456;

struct Params {
    const float* in[22];
    float* out;
    unsigned char* ws;
    int phase_lo, phase_hi;
};

#ifndef HOST_EMU
#define DEV __device__ __forceinline__
#define TID() ((int)threadIdx.x)
#define BID() ((int)blockIdx.x)
#define NBLK() ((int)gridDim.x)
extern __shared__ __attribute__((aligned(16))) unsigned char smem_raw[];
#define LDSP __attribute__((address_space(3)))
#define SMEM_PTR() ((LDSP char*)smem_raw)
DEV void block_sync() { __syncthreads(); }
DEV int fresh_lane() { int lane; asm volatile("v_mbcnt_lo_u32_b32 %0, -1, 0\n\tv_mbcnt_hi_u32_b32 %0, -1, %0" : "=v"(lane)); return lane; }
template <int M> DEV int xori(int v) {
    if constexpr (M < 32) return __builtin_amdgcn_ds_swizzle(v, (M << 10) | 0x1f);
    else return __builtin_amdgcn_ds_bpermute((fresh_lane() ^ M) << 2, v);
}
template <int M> DEV float xorf(float v) { return __builtin_bit_cast(float, xori<M>(__builtin_bit_cast(int, v))); }
DEV int shfl_i(int v, int src) { return __builtin_amdgcn_ds_bpermute(src << 2, v); }
DEV float shfl_f(float v, int src) { return __builtin_bit_cast(float, __builtin_amdgcn_ds_bpermute(src << 2, __builtin_bit_cast(int, v))); }
DEV unsigned long long ballot64(bool p) { return __builtin_amdgcn_ballot_w64(p); }
DEV int mbcnt64(unsigned long long m) { return (int)__builtin_amdgcn_mbcnt_hi((unsigned)(m >> 32), __builtin_amdgcn_mbcnt_lo((unsigned)m, 0u)); }
DEV float bcast_f(float v, int j) { return __builtin_bit_cast(float, __builtin_amdgcn_readlane(__builtin_bit_cast(int, v), j)); }
DEV int bcast_i(int v, int j) { return __builtin_amdgcn_readlane(v, j); }
DEV f32x2 cvt_pk_f32_fp8(unsigned p, bool hi) { return hi ? __builtin_amdgcn_cvt_pk_f32_fp8((int)p, true) : __builtin_amdgcn_cvt_pk_f32_fp8((int)p, false); }
template <int SEL> DEV f32x2 cvt_pk_f32_fp4_(unsigned p) { return __builtin_amdgcn_cvt_scalef32_pk_f32_fp4(p, 1.0f, SEL); }
DEV f32x2 cvt_pk_f32_fp4(unsigned p, int bytesel) { return bytesel == 0 ? cvt_pk_f32_fp4_<0>(p) : bytesel == 1 ? cvt_pk_f32_fp4_<1>(p) : bytesel == 2 ? cvt_pk_f32_fp4_<2>(p) : cvt_pk_f32_fp4_<3>(p); }
DEV unsigned cvt_pk_fp8_f32(float a, float b, unsigned old, bool hi) { return hi ? (unsigned)__builtin_amdgcn_cvt_pk_fp8_f32(a, b, (int)old, true) : (unsigned)__builtin_amdgcn_cvt_pk_fp8_f32(a, b, (int)old, false); }
DEV f32x4 mfma16(bf16x8 a, bf16x8 b, f32x4 c) { return __builtin_amdgcn_mfma_f32_16x16x32_bf16(a, b, c, 0, 0, 0); }
typedef int i32x8 __attribute__((ext_vector_type(8)));
DEV f32x4 mfma_fp4_fp8(u32x4 a, u32x4 b0, u32x4 b1, f32x4 c) {
    const i32x8 av = {(int)a.x, (int)a.y, (int)a.z, (int)a.w, 0, 0, 0, 0}, bv = {(int)b0.x, (int)b0.y, (int)b0.z, (int)b0.w, (int)b1.x, (int)b1.y, (int)b1.z, (int)b1.w};
    return __builtin_amdgcn_mfma_scale_f32_16x16x128_f8f6f4(av, bv, c, 4, 0, 0, 127, 0, 127);
}
DEV void atomic_add_f32(float* p, float v) { atomicAdd(p, v); }
DEV float fast_exp(float x) { return __expf(x); }
DEV float fast_exp2(float x) { return __builtin_amdgcn_exp2f(x); }
DEV float fast_log(float x) { return __logf(x); }
DEV float fast_rcp(float x) { return __builtin_amdgcn_rcpf(x); }
DEV float fast_rsqrt(float x) { return __builtin_amdgcn_rsqf(x); }
#else
#define DEV static inline
#define LDSP
#endif

#ifndef HOST_EMU
DEV void wave_sync() { __builtin_amdgcn_fence(__ATOMIC_ACQ_REL, "wavefront"); __builtin_amdgcn_wave_barrier(); }
#else
static inline void wave_sync() { emu_bar_wait(emu_wave().bar, 64); }
#endif
DEV float bf2f(bf16_t v) { unsigned u = ((unsigned)v) << 16; return __builtin_bit_cast(float, u); }
DEV bf16_t f2bf(float f) { unsigned u = __builtin_bit_cast(unsigned, f); return (bf16_t)((u + 0x7fffu + ((u >> 16) & 1u)) >> 16); }
#ifndef HOST_EMU
typedef __bf16 bf16x2_hw __attribute__((ext_vector_type(2)));
DEV unsigned pk2(float lo, float hi) { const f32x2 v = {lo, hi}; return __builtin_bit_cast(unsigned, __builtin_convertvector(v, bf16x2_hw)); }
#else
DEV unsigned pk2(float lo, float hi) { return (unsigned)f2bf(lo) | ((unsigned)f2bf(hi) << 16); }
#endif
DEV float bflo(unsigned u) { return __builtin_bit_cast(float, u << 16); }
DEV float bfhi(unsigned u) { return __builtin_bit_cast(float, u & 0xffff0000u); }
DEV float sigmoidf_(float x) { return fast_rcp(1.0f + fast_exp(-x)); }
DEV float siluf_(float x) { return x * sigmoidf_(x); }
DEV float log_sigmoidf_(float x) { return fminf(x, 0.f) - log1pf(fast_exp(-fabsf(x))); }
DEV unsigned sortkey32(float f) { const unsigned u = __builtin_bit_cast(unsigned, f); return (u & 0x80000000u) ? ~u : (u | 0x80000000u); }
DEV unsigned fp4_code(float x) {
    const float a = fabsf(x); unsigned c = (a > 0.25f) + (a > 0.75f) + (a > 1.25f) + (a > 1.75f) + (a > 2.5f) + (a > 3.5f) + (a > 5.0f); return c | (x < 0.f ? 8u : 0u);
}
DEV float wave_sum(float v) { v += xorf<1>(v); v += xorf<2>(v); v += xorf<4>(v); v += xorf<8>(v); v += xorf<16>(v); v += xorf<32>(v); return v; }
DEV float wave_max(float v) { v = fmaxf(v, xorf<1>(v)); v = fmaxf(v, xorf<2>(v)); v = fmaxf(v, xorf<4>(v)); v = fmaxf(v, xorf<8>(v)); v = fmaxf(v, xorf<16>(v)); v = fmaxf(v, xorf<32>(v)); return v; }
DEV float gelu_erf(float v) {
    const float av = fabsf(v), t = fast_rcp(1.0f + 0.2316418882f * av);
    float q = t * 0.5307027145f + (-0.7265760135f); q = q * t + 0.7107068705f; q = q * t + (-0.142248368f); q = q * t + 0.127414796f; q = q * t;
    const float e = fast_exp2(v * v * (-0.72134752044f));
    const float m = v * (q * e);
    return v < 0.f ? m : v - m;
}
#ifndef HOST_EMU
#define DEV_M __device__ __forceinline__
#else
#define DEV_M inline
#endif
namespace pg8 {
#define PG8_LAS __attribute__((address_space(3)))
constexpr int BM = 256, BK = 64, HALF = 128, HTB = HALF * BK * 2  , STAGE_BYTES = 8 * HTB, NXCD = 8, WGM = 8;

__host__ __device__ __forceinline__ int lds_byte(int r, int c) { const int st = (r >> 4) * 2 + (c >> 5), rr = r & 15, cc = c & 31, ob = rr * 64 + cc * 2; return st * 1024 + (ob ^ (((ob >> 9) & 1) << 5)); }
__host__ __device__ __forceinline__ void stage_rc(int b, int& R, int& C) { const int st = b / 1024, sb = b % 1024, swz = sb ^ (((sb >> 9) & 1) << 5); R = (st >> 1) * 16 + swz / 64; C = (st & 1) * 32 + (swz % 64) / 2; }
__host__ __device__ __forceinline__ int perm32(int rho) { const int n = rho >> 4, i = rho & 15; return 8 * (i >> 2) + 4 * n + (i & 3); }

struct Unit { int pm, pn; };
struct Gemm { const bf16_t* A; const bf16_t* Bt; int M, N, K; };

struct StaticOrder {
    int nM, nN, nwg, G, c;
    __host__ __device__ void init(int M, int N, int G_, int c_) { nM = M / BM; nN = N / BM; nwg = nM * nN; G = G_; c = c_; }
    __host__ __device__ bool next(int i, Unit& u) const {
        const long L = (long)i * G + c; if (L >= nwg) return false;
        int wgid = (int)L; { const int q = nwg / NXCD, r = nwg % NXCD, xcd = wgid % NXCD, off = wgid / NXCD; wgid = (xcd < r ? xcd * (q + 1) : r * (q + 1) + (xcd - r) * q) + off; }
        const int nig = WGM * nN, gid = wgid / nig, fm = gid * WGM, gsz = (nM - fm) < WGM ? (nM - fm) : WGM;
        u.pm = fm + ((wgid % nig) % gsz); u.pn = (wgid % nig) / gsz; return true;
    }
    DEV_M void a_ready(const Unit&) const {}
    DEV_M void done(const Unit&) const {}
};


#ifndef HOST_EMU
template <class Epi, class Sched, bool ALIGN_EPI = false, bool SP2 = false>
__device__ __forceinline__ void gemm_phase(PG8_LAS unsigned char* lds, const Gemm g, const Sched& S, const Epi& E, const int tid_in) {
    const int tid = tid_in, wid = __builtin_amdgcn_readfirstlane(tid >> 6), lane = tid & 63, wr = wid >> 2, wc = wid & 3, fr = lane & 15, fq = lane >> 4;
    const int K = g.K, nt = K / BK;
    unsigned voffA[2], voffB[2];
#pragma unroll
    for (int i = 0; i < 2; ++i) { int R, C; stage_rc(tid * 16 + i * 8192, R, C); const int Rb = Epi::PERM ? ((R & ~31) + perm32(R & 31)) : R;
        voffA[i] = (unsigned)(R * K + C) * 2u; voffB[i] = (unsigned)(Rb * K + C) * 2u; }
    const size_t kstep = (size_t)(BK * 2);
    const size_t hstep = (size_t)HALF * K * 2;
    const size_t tstep = 2 * hstep;
    const unsigned ldsw = (unsigned)wid * 1024u;
    const int aoff = lds_byte(wr * 64 + fr, fq * 8), boff = lds_byte(wc * 32 + fr, fq * 8);
#define PG8_SA(b, h) (((b) * 2 + (h)) * HTB)
#define PG8_SB(b, h) ((4 + (b) * 2 + (h)) * HTB)
#define PG8_STAGE(bufoff, gbase, voff) do { _Pragma("unroll") for (int _i = 0; _i < 2; ++_i) \
        __builtin_amdgcn_global_load_lds((const unsigned*)((const char*)(gbase) + (voff)[_i]), (PG8_LAS unsigned*)(lds + (bufoff) + ldsw + _i * 8192), 16, 0, 0); } while (0)
#define PG8_LDA(dst, b, h) do { _Pragma("unroll") for (int m = 0; m < 4; ++m) _Pragma("unroll") for (int k = 0; k < 2; ++k) dst[m][k] = *(const PG8_LAS bf16x8*)(lds + PG8_SA(b, h) + aoff + m * 2048 + k * 1024); } while (0)
#define PG8_LDB(dst, b, h) do { _Pragma("unroll") for (int n = 0; n < 2; ++n) _Pragma("unroll") for (int k = 0; k < 2; ++k) dst[n][k] = *(const PG8_LAS bf16x8*)(lds + PG8_SB(b, h) + boff + n * 2048 + k * 1024); } while (0)
#define PG8_MMA(ai, bj, At, Bt) do { __builtin_amdgcn_s_setprio(1); _Pragma("unroll") for (int m = 0; m < 4; ++m) _Pragma("unroll") for (int n = 0; n < 2; ++n) _Pragma("unroll") for (int k = 0; k < 2; ++k) \
        acc[ai][bj][m][n] = __builtin_amdgcn_mfma_f32_16x16x32_bf16(Bt[n][k], At[m][k], acc[ai][bj][m][n], 0, 0, 0); __builtin_amdgcn_s_setprio(0); } while (0)
#define PG8_WAIT_V(n) asm volatile("s_waitcnt vmcnt(" #n ")" ::: "memory")
#define PG8_WAIT_L(n) asm volatile("s_waitcnt lgkmcnt(" #n ")" ::: "memory")
#define PG8_BAR __builtin_amdgcn_s_barrier()
#define PG8_SCHED __builtin_amdgcn_sched_barrier(0)
    Unit cur, nxt; int ui = 0;
    if (!S.next(0, cur)) return;
    f32x4 acc[2][2][4][2];
#pragma unroll
    for (int a = 0; a < 2; ++a)
#pragma unroll
        for (int b = 0; b < 2; ++b)
#pragma unroll
            for (int m = 0; m < 4; ++m)
#pragma unroll
                for (int n = 0; n < 2; ++n) acc[a][b][m][n] = (f32x4){0.f, 0.f, 0.f, 0.f};
    bf16x8 At[4][2], B0[2][2], B1[2][2];
    const char* cA = (const char*)g.A + (size_t)cur.pm * tstep; const char* cB = (const char*)g.Bt + (size_t)cur.pn * tstep;
    S.a_ready(cur);
    if constexpr (SP2) {
        PG8_STAGE(PG8_SB(0, 0), cB, voffB); PG8_STAGE(PG8_SB(0, 1), cB + hstep, voffB); PG8_STAGE(PG8_SA(0, 0), cA, voffA); PG8_STAGE(PG8_SA(0, 1), cA + hstep, voffA);
        if (wr == 1) PG8_BAR;
        PG8_WAIT_V(2); PG8_BAR;
        PG8_STAGE(PG8_SB(1, 0), cB + kstep, voffB); PG8_STAGE(PG8_SA(1, 0), cA + kstep, voffA); PG8_STAGE(PG8_SB(1, 1), cB + hstep + kstep, voffB);
        PG8_WAIT_V(6); PG8_BAR;
    } else {
        PG8_STAGE(PG8_SB(0, 0), cB, voffB); PG8_STAGE(PG8_SA(0, 0), cA, voffA); PG8_STAGE(PG8_SB(0, 1), cB + hstep, voffB); PG8_STAGE(PG8_SA(0, 1), cA + hstep, voffA);
        if (wr == 1) PG8_BAR;
        PG8_WAIT_V(4); PG8_BAR;
        PG8_STAGE(PG8_SB(1, 0), cB + kstep, voffB); PG8_STAGE(PG8_SA(1, 0), cA + kstep, voffA); PG8_STAGE(PG8_SB(1, 1), cB + hstep + kstep, voffB);
        PG8_WAIT_V(6); PG8_BAR;
    }
    for (;;) {
        const bool has_next = S.next(ui + 1, nxt);
        const char* nA = has_next ? (const char*)g.A + (size_t)nxt.pm * tstep : cA; const char* nB = has_next ? (const char*)g.Bt + (size_t)nxt.pn * tstep : cB;
        for (int t = 0; t < nt; t += 2) {
            const bool last = (t == nt - 2);
            const char* a1 = cA + (size_t)(t + 1) * kstep;
            const char* a2 = last ? nA : cA + (size_t)(t + 2) * kstep; const char* b2 = last ? nB : cB + (size_t)(t + 2) * kstep;
            const char* a3 = a2 + kstep; const char* b3 = b2 + kstep;
            if (last && has_next) S.a_ready(nxt);
            if constexpr (SP2) {
            PG8_LDB(B0, 0, 0); PG8_LDB(B1, 0, 1); PG8_SCHED; PG8_LDA(At, 0, 0); PG8_STAGE(PG8_SA(1, 1), a1 + hstep, voffA);
            PG8_WAIT_V(8); PG8_WAIT_L(0); PG8_BAR; PG8_MMA(0, 0, At, B0); PG8_MMA(0, 1, At, B1); PG8_BAR; PG8_SCHED;
            PG8_LDA(At, 0, 1); PG8_STAGE(PG8_SB(0, 0), b2, voffB); PG8_STAGE(PG8_SB(0, 1), b2 + hstep, voffB); PG8_STAGE(PG8_SA(0, 0), a2, voffA);
            PG8_WAIT_V(8); PG8_WAIT_L(0); PG8_BAR; PG8_MMA(1, 0, At, B0); PG8_MMA(1, 1, At, B1); PG8_BAR; PG8_SCHED;
            PG8_LDB(B0, 1, 0); PG8_LDB(B1, 1, 1); PG8_SCHED; PG8_LDA(At, 1, 0); PG8_STAGE(PG8_SA(0, 1), a2 + hstep, voffA);
            PG8_WAIT_V(8); PG8_WAIT_L(0); PG8_BAR; PG8_MMA(0, 0, At, B0); PG8_MMA(0, 1, At, B1); PG8_BAR; PG8_SCHED;
            PG8_LDA(At, 1, 1); PG8_STAGE(PG8_SB(1, 0), b3, voffB); PG8_STAGE(PG8_SB(1, 1), b3 + hstep, voffB); PG8_STAGE(PG8_SA(1, 0), a3, voffA);
            PG8_WAIT_V(8); PG8_WAIT_L(0); PG8_BAR; PG8_MMA(1, 0, At, B0); PG8_MMA(1, 1, At, B1); PG8_BAR; PG8_SCHED;
            } else {
            PG8_LDB(B0, 0, 0); PG8_SCHED; PG8_LDA(At, 0, 0); PG8_STAGE(PG8_SA(1, 1), a1 + hstep, voffA);
            PG8_WAIT_L(8); PG8_BAR; PG8_WAIT_L(0); PG8_MMA(0, 0, At, B0); PG8_BAR; PG8_SCHED;
            PG8_LDB(B1, 0, 1); PG8_STAGE(PG8_SB(0, 0), b2, voffB);
            PG8_BAR; PG8_WAIT_L(0); PG8_MMA(0, 1, At, B1); PG8_BAR;
            PG8_LDA(At, 0, 1); PG8_STAGE(PG8_SA(0, 0), a2, voffA);
            PG8_BAR; PG8_WAIT_L(0); PG8_MMA(1, 0, At, B0); PG8_BAR; PG8_SCHED;
            PG8_STAGE(PG8_SB(0, 1), b2 + hstep, voffB);
            PG8_WAIT_V(6); PG8_BAR; PG8_MMA(1, 1, At, B1); PG8_BAR;
            PG8_LDB(B0, 1, 0); PG8_SCHED; PG8_LDA(At, 1, 0); PG8_STAGE(PG8_SA(0, 1), a2 + hstep, voffA);
            PG8_WAIT_L(8); PG8_BAR; PG8_WAIT_L(0); PG8_MMA(0, 0, At, B0); PG8_BAR; PG8_SCHED;
            PG8_LDB(B1, 1, 1); PG8_STAGE(PG8_SB(1, 0), b3, voffB);
            PG8_BAR; PG8_WAIT_L(0); PG8_MMA(0, 1, At, B1); PG8_BAR;
            PG8_LDA(At, 1, 1); PG8_STAGE(PG8_SA(1, 0), a3, voffA);
            PG8_BAR; PG8_WAIT_L(0); PG8_MMA(1, 0, At, B0); PG8_BAR; PG8_SCHED;
            PG8_STAGE(PG8_SB(1, 1), b3 + hstep, voffB);
            PG8_WAIT_V(6); PG8_BAR; PG8_MMA(1, 1, At, B1); PG8_BAR;
            }
        }
        if constexpr (ALIGN_EPI) { if (wr == 0) PG8_BAR; }
        if constexpr (!Epi::AFTER_DRAIN) { E(acc, cur, wr, wc, fr, fq); S.done(cur); }
        if (!has_next) break;
#pragma unroll
        for (int a = 0; a < 2; ++a)
#pragma unroll
            for (int b = 0; b < 2; ++b)
#pragma unroll
                for (int m = 0; m < 4; ++m)
#pragma unroll
                    for (int n = 0; n < 2; ++n) acc[a][b][m][n] = (f32x4){0.f, 0.f, 0.f, 0.f};
        cur = nxt; cA = nA; cB = nB; ++ui;
        if constexpr (ALIGN_EPI) { if (wr == 1) PG8_BAR; }
    }
    PG8_WAIT_V(0);
    if constexpr (!ALIGN_EPI) { if (wr == 0) PG8_BAR; }
    PG8_BAR;
    if constexpr (Epi::AFTER_DRAIN) { E.fused(acc, cur, wr, wc, fr, fq, lds, wid, lane); S.done(cur); }
#undef PG8_SA
#undef PG8_SB
#undef PG8_STAGE
#undef PG8_LDA
#undef PG8_LDB
#undef PG8_MMA
#undef PG8_WAIT_V
#undef PG8_WAIT_L
#undef PG8_BAR
#undef PG8_SCHED
}
#else
template <class Epi, class Sched, bool ALIGN_EPI = false, bool SP2 = false>
inline void gemm_phase(void* lds, const Gemm g, const Sched& S, const Epi& E, const int tid_in) {
    const int tid = TID(), wid = tid >> 6, lane = tid & 63, wr = wid >> 2, wc = wid & 3, fr = lane & 15, fq = lane >> 4;
    Unit u;
    for (int ui = 0; S.next(ui, u); ++ui) {
        f32x4 acc[2][2][4][2];
        for (int ai = 0; ai < 2; ++ai) for (int bj = 0; bj < 2; ++bj) for (int m = 0; m < 4; ++m) for (int n = 0; n < 2; ++n) for (int j = 0; j < 4; ++j) {
            const int r = 256 * u.pm + 128 * ai + 64 * wr + 16 * m + fr;
            const int c = 256 * u.pn + 128 * bj + 32 * wc + (Epi::PERM ? (8 * fq + 4 * n + j) : (16 * n + 4 * fq + j));
            const bf16_t* a = g.A + (size_t)r * g.K; const bf16_t* b = g.Bt + (size_t)c * g.K;
            float s = 0.f; for (int k = 0; k < g.K; ++k) s += bf2f(a[k]) * bf2f(b[k]);
            acc[ai][bj][m][n][j] = s;
        }
        E(acc, u, wr, wc, fr, fq);
    }
    block_sync();
}
#endif
#ifndef HOST_EMU
#define EPI_LAUNDER(wr, wc, fr, fq) asm volatile("" : "+s"(wr), "+s"(wc), "+v"(fr), "+v"(fq))
#else
#define EPI_LAUNDER(wr, wc, fr, fq) do {} while (0)
#endif
DEV_M float rstd_of(float ss) { return fast_rsqrt(ss * (1.0f / 1024.0f) + NORM_EPS); }

DEV_M float rss_slots16(const float* p) {
    const f32x4 a = *(const f32x4*)p, b = *(const f32x4*)(p + 4), c = *(const f32x4*)(p + 8), d = *(const f32x4*)(p + 12);
    return (((a[0] + a[1]) + (a[2] + a[3])) + ((b[0] + b[1]) + (b[2] + b[3]))) + (((c[0] + c[1]) + (c[2] + c[3])) + ((d[0] + d[1]) + (d[2] + d[3])));
}
template <int SLOTS, bool HALO = false> struct EpiScaleBf16 {
    static constexpr bool PERM = true, AFTER_DRAIN = false;
    bf16_t* O; int ldc; const float* rss; int ncols; bf16_t* halo;
    DEV_M void operator()(const f32x4 (&acc)[2][2][4][2], const Unit& u, int wr, int wc, int fr, int fq) const {
        EPI_LAUNDER(wr, wc, fr, fq);
        const int row0 = u.pm * BM + wr * 64 + fr, col0 = u.pn * BM + wc * 32 + 8 * fq;
        float scv[2][4];
#pragma unroll
        for (int ai = 0; ai < 2; ++ai)
#pragma unroll
            for (int m = 0; m < 4; ++m) { const int row = row0 + ai * HALF + m * 16; scv[ai][m] = SLOTS == 1 ? rss[row] : 0.f; }
#pragma unroll
        for (int ai = 0; ai < 2; ++ai)
#pragma unroll
            for (int m = 0; m < 4; ++m) {
                const int row = row0 + ai * HALF + m * 16; const float sc = rstd_of(SLOTS == 1 ? scv[ai][m] : rss_slots16(rss + (size_t)row * 16));
                bf16_t* rowp = O + (size_t)row * ldc + col0;
#pragma unroll
                for (int bj = 0; bj < 2; ++bj) {
                    if (col0 + bj * HALF < ncols) {
                        const f32x4 v0 = acc[ai][bj][m][0] * sc, v1 = acc[ai][bj][m][1] * sc;
                        u32x4 w; w.x = pk2(v0[0], v0[1]); w.y = pk2(v0[2], v0[3]); w.z = pk2(v1[0], v1[1]); w.w = pk2(v1[2], v1[3]);
                        *(u32x4*)(rowp + bj * HALF) = w;
                        if (HALO) { const int cc = col0 + bj * HALF - C_MQ; if ((row & 63) >= 61 && cc >= 0 && cc < 512) *(u32x4*)(halo + ((size_t)(row >> 6) * 3 + ((row & 63) - 61)) * 512 + cc) = w; }
                    }
                }
            }
    }
};
struct EpiU {
    static constexpr bool PERM = true, AFTER_DRAIN = false;
    bf16_t* uall;
    DEV_M void operator()(const f32x4 (&acc)[2][2][4][2], const Unit& u, int wr, int wc, int fr, int fq) const {
        EPI_LAUNDER(wr, wc, fr, fq);
        bf16_t* base = uall + (size_t)(u.pm * BM + wr * 64 + fr) * DM + (u.pn & 3) * BM + wc * 32 + 8 * fq;
#pragma unroll
        for (int ai = 0; ai < 2; ++ai)
#pragma unroll
            for (int m = 0; m < 4; ++m)
#pragma unroll
                for (int bj = 0; bj < 2; ++bj) {
                    const f32x4 v0 = acc[ai][bj][m][0], v1 = acc[ai][bj][m][1];
                    u32x4 w; w.x = pk2(v0[0], v0[1]); w.y = pk2(v0[2], v0[3]); w.z = pk2(v1[0], v1[1]); w.w = pk2(v1[2], v1[3]);
                    *(u32x4*)(base + (size_t)(ai * HALF + m * 16) * DM + bj * HALF) = w;
                }
    }
};
struct EpiGate {
    static constexpr bool PERM = true, AFTER_DRAIN = false;
    const bf16_t* uall; bf16_t* merged; const float* rss; int nrows;
    DEV_M void operator()(const f32x4 (&acc)[2][2][4][2], const Unit& u, int wr, int wc, int fr, int fq) const {
        EPI_LAUNDER(wr, wc, fr, fq);
        const int mi = u.pn >> 2, pn = u.pn & 3, row0 = u.pm * BM + wr * 64 + fr, col0 = pn * BM + wc * 32 + 8 * fq;
        const bf16_t* ub = uall + ((size_t)mi * nrows + row0) * DM + col0;
#pragma unroll
        for (int ai = 0; ai < 2; ++ai) {
            u32x4 uv[4][2], pv[4][2]; float sc[4];
#pragma unroll
            for (int m = 0; m < 4; ++m) { const int row = row0 + ai * HALF + m * 16; sc[m] = rss[row];
#pragma unroll
                for (int bj = 0; bj < 2; ++bj) { uv[m][bj] = *(const u32x4*)(ub + (size_t)(ai * HALF + m * 16) * DM + bj * HALF);
                    pv[m][bj] = (u32x4){0u, 0u, 0u, 0u}; if (mi != 0) pv[m][bj] = *(const u32x4*)(merged + (size_t)row * DM + col0 + bj * HALF); } }
#pragma unroll
            for (int m = 0; m < 4; ++m) { const int row = row0 + ai * HALF + m * 16; const float s = rstd_of(sc[m]);
#pragma unroll
                for (int bj = 0; bj < 2; ++bj) {
                    const u32x4 u4 = uv[m][bj], p4 = pv[m][bj];
                    const f32x4 a0 = acc[ai][bj][m][0] * s, a1 = acc[ai][bj][m][1] * s;
                    float r[8];
                    r[0] = sigmoidf_(a0[0]) * bflo(u4.x) + bflo(p4.x); r[1] = sigmoidf_(a0[1]) * bfhi(u4.x) + bfhi(p4.x);
                    r[2] = sigmoidf_(a0[2]) * bflo(u4.y) + bflo(p4.y); r[3] = sigmoidf_(a0[3]) * bfhi(u4.y) + bfhi(p4.y);
                    r[4] = sigmoidf_(a1[0]) * bflo(u4.z) + bflo(p4.z); r[5] = sigmoidf_(a1[1]) * bfhi(u4.z) + bfhi(p4.z);
                    r[6] = sigmoidf_(a1[2]) * bflo(u4.w) + bflo(p4.w); r[7] = sigmoidf_(a1[3]) * bfhi(u4.w) + bfhi(p4.w);
                    u32x4 w; w.x = pk2(r[0], r[1]); w.y = pk2(r[2], r[3]); w.z = pk2(r[4], r[5]); w.w = pk2(r[6], r[7]);
                    *(u32x4*)(merged + (size_t)row * DM + col0 + bj * HALF) = w;
                } }
        }
    }
};
struct EpiOut {
    static constexpr bool PERM = false, AFTER_DRAIN = false;
    const float* xres; float* out; bf16_t* xb; float* rss;
    DEV_M void operator()(const f32x4 (&acc)[2][2][4][2], const Unit& u, int wr, int wc, int fr, int fq) const {
        EPI_LAUNDER(wr, wc, fr, fq);
        const int row0 = u.pm * BM + wr * 64 + fr, col0 = u.pn * BM + wc * 32 + 4 * fq;
#pragma unroll
        for (int ah = 0; ah < 4; ++ah) { const int ai = ah >> 1, m0 = (ah & 1) * 2;
            f32x4 xr[4][2][2];
#pragma unroll
            for (int m = m0; m < m0 + 2; ++m)
#pragma unroll
                for (int bj = 0; bj < 2; ++bj)
#pragma unroll
                    for (int n = 0; n < 2; ++n) xr[m][bj][n] = *(const f32x4*)(xres + (size_t)(row0 + ai * HALF + m * 16) * DM + col0 + bj * HALF + n * 16);
#pragma unroll
            for (int m = m0; m < m0 + 2; ++m) {
                const int row = row0 + ai * HALF + m * 16; const size_t off = (size_t)row * DM + col0; float ss = 0.f;
#pragma unroll
                for (int bj = 0; bj < 2; ++bj)
#pragma unroll
                    for (int n = 0; n < 2; ++n) {
                        const size_t o = off + bj * HALF + n * 16;
                        const f32x4 v = xr[m][bj][n] + acc[ai][bj][m][n];
                        *(f32x4*)(out + o) = v;
                        u32x2 w; w.x = pk2(v[0], v[1]); w.y = pk2(v[2], v[3]);
                        *(u32x2*)(xb + o) = w;
                        ss += (v[0] * v[0] + v[1] * v[1]) + (v[2] * v[2] + v[3] * v[3]);
                    }
                ss += xorf<16>(ss); ss += xorf<32>(ss);
                if (fq == 0) rss[(size_t)row * 16 + u.pn * 4 + wc] = ss;
            }
        }
    }
};
template <bool STACK_A> struct MixOrder {
    int ntiles, G, c, nM;
    DEV_M bool next(int i, Unit& u) const { const long t = (long)(i >> 2) * G + c; if (t >= ntiles) return false; const int m = i & 3;
        u.pm = (int)(t >> 2) + (STACK_A ? m * nM : 0); u.pn = m * 4 + (int)(t & 3); return true; }
    DEV_M void a_ready(const Unit&) const {}
    DEV_M void done(const Unit&) const {}
};
}
#ifndef HOST_EMU
#define GEMM_LDS ((PG8_LAS unsigned char*)smem_raw)
#else
#define GEMM_LDS ((void*)nullptr)
#endif
struct Ctx {
    float* out; unsigned char* ws; LDSP char* lds; int tid, lane, wave, bid, nblk;
};
constexpr int LDS_PTRS = LDS_BYTES - 256;
#ifndef HOST_EMU
DEV const float* inptr(const Ctx& c, int i) { const unsigned long long v = ((volatile LDSP unsigned long long*)(c.lds + LDS_PTRS))[i];
    const unsigned lo = __builtin_amdgcn_readfirstlane((unsigned)v), hi = __builtin_amdgcn_readfirstlane((unsigned)(v >> 32)); return (const float*)(const __attribute__((address_space(1))) float*)(((unsigned long long)hi << 32) | lo); }
#else
static inline const float* inptr(const Ctx& c, int i) { return ((const float* volatile*)(c.lds + LDS_PTRS))[i]; }
#endif
#define CIN(i) inptr(c, (i))
template <class T> DEV T* wsp(const Ctx& c, size_t off) { return (T*)(c.ws + off); }
DEV int orig_col(int n) {
    if (n < 1792) return n;
    if (n < 2048) return 1800 + (n - 1792);
    if (n < 3072) return 2056 + (n - 2048);
    if (n < 4096) return 3092 + (n - 3072);
    if (n < 4104) return 1792 + (n - 4096);
    if (n < 4116) return 3080 + (n - 4104);
    return -1;
}

template <class F> DEV void transpose_wave(const Ctx& c, F src, bf16_t* dst, int ldd, int k0, int n0) {
    LDSP float* tile = (LDSP float*)(c.lds + c.wave * 16640);
#pragma unroll
    for (int kb = 0; kb < 64; kb += 16) {
        float tv[16];
#pragma unroll
        for (int j = 0; j < 16; ++j) tv[j] = src(k0 + kb + j, n0 + c.lane);
#pragma unroll
        for (int j = 0; j < 16; ++j) tile[c.lane * 65 + kb + j] = tv[j];
    }
    wave_sync();
    const int k2 = (c.lane & 31) * 2, nh = c.lane >> 5;
#pragma unroll 8
    for (int j = 0; j < 32; ++j) { const int n = 2 * j + nh; *(unsigned*)(dst + (size_t)(n0 + n) * ldd + k0 + k2) = pk2(tile[n * 65 + k2], tile[n * 65 + k2 + 1]); }
    wave_sync();
}
DEV bf16x8 cvt8(const f32x4 a, const f32x4 b, float s) { const u32x4 w = {pk2(a[0] * s, a[1] * s), pk2(a[2] * s, a[3] * s), pk2(b[0] * s, b[1] * s), pk2(b[2] * s, b[3] * s)}; return __builtin_bit_cast(bf16x8, w); }

DEV void p0_prep(const Ctx& c, int l, int mask = 31) {
    const float* g1 = CIN(1) + (size_t)l * DM;
    const float* g2 = CIN(17) + (size_t)l * DM;
    constexpr int I_IN = (PROJ_N / 64) * 16, I_G = 4 * 16 * 16, I_UP = 4 * 16 * 4, I_OUT = 16 * 16, I_WC = 2 * 32, I_TR = I_IN + I_G + I_UP + I_OUT + I_WC;
    constexpr int I_WQ = 16 * 16 * 8;
    if (mask & 1)
    for (int it = c.bid * NWAVE + c.wave; it < I_TR; it += c.nblk * NWAVE) {
        int r = it;
        if (r < I_IN) {
            const float* w = CIN(2) + (size_t)l * DM * N_IN_ORIG; const int nt = r / 16, kt = r % 16;
            transpose_wave(c, [=](int k, int n) { const int oc = orig_col(n); return oc < 0 ? 0.f : w[(size_t)k * N_IN_ORIG + oc] * g1[k]; }, wsp<bf16_t>(c, WS_WIN), DM, kt * 64, nt * 64);
            continue;
        } r -= I_IN;
        if (r < I_G) {
            const int m = r / 256, nt = (r % 256) / 16, kt = r % 16; const float* w = CIN(15) + ((size_t)l * 4 + m) * DM * DM;
            transpose_wave(c, [=](int k, int n) { return w[(size_t)k * DM + n] * g1[k]; }, wsp<bf16_t>(c, WS_WG) + (size_t)m * DM * DM, DM, kt * 64, nt * 64);
            continue;
        } r -= I_G;
        if (r < I_UP) {
            const int m = r / 64, nt = (r % 64) / 4, kt = r % 4; const float* w = CIN(14) + ((size_t)l * 4 + m) * MW * DM;
            transpose_wave(c, [=](int k, int n) { return w[(size_t)k * DM + n]; }, wsp<bf16_t>(c, WS_WUP) + (size_t)m * DM * MW, MW, kt * 64, nt * 64);
            continue;
        } r -= I_UP;
        if (r < I_OUT) {
            const int nt = r / 16, kt = r % 16; const float* w = CIN(16) + (size_t)l * DM * DM;
            transpose_wave(c, [=](int k, int n) { return w[(size_t)k * DM + n]; }, wsp<bf16_t>(c, WS_WOUT), DM, kt * 64, nt * 64);
            continue;
        } r -= I_OUT;
        {
            const int kv = r / 32, kt = r % 32; const float* w = CIN(12) + ((size_t)l * 2 + kv) * 2048 * 64;
            transpose_wave(c, [=](int k, int n) { return w[(size_t)k * 64 + n]; }, wsp<bf16_t>(c, WS_WCT) + (size_t)kv * 64 * 2048, 2048, kt * 64, 0);
        }
    }
    if (mask & 2)
    for (int it = c.bid * NWAVE + c.wave; it < I_WQ; it += c.nblk * NWAVE) {
        const int keyt = it & 7, kt = (it >> 3) & 15, hp = it >> 7, fr = c.lane & 15, fq = c.lane >> 4;
        const float* keys = CIN(19) + (((size_t)l * 16 + hp) * 128 + keyt * 16 + fr) * 128; const float* wq = CIN(18) + (size_t)l * DM * PEER_N + hp * 128;
        bf16x8 kb[4];
#pragma unroll
        for (int ds = 0; ds < 4; ++ds) kb[ds] = cvt8(*(const f32x4*)(keys + 32 * ds + 8 * fq), *(const f32x4*)(keys + 32 * ds + 8 * fq + 4), 1.0f);
#pragma unroll
        for (int tile = 0; tile < 4; ++tile) { const int k = kt * 64 + tile * 16 + fr; const float gk = g2[k]; const float* wr = wq + (size_t)k * PEER_N;
            f32x4 acc = {0.f, 0.f, 0.f, 0.f};
#pragma unroll
            for (int ds = 0; ds < 4; ++ds) acc = mfma16(cvt8(*(const f32x4*)(wr + 32 * ds + 8 * fq), *(const f32x4*)(wr + 32 * ds + 8 * fq + 4), gk), kb[ds], acc);
            u32x2 w; w.x = pk2(acc[0], acc[1]); w.y = pk2(acc[2], acc[3]);
            *(u32x2*)(wsp<bf16_t>(c, WS_WQ2) + (size_t)(hp * 128 + keyt * 16 + fr) * DM + kt * 64 + tile * 16 + fq * 4) = w; }
    }
    if (mask & 4)
    for (int kv = c.bid; kv < 2; kv += c.nblk) {
        const float* w = CIN(12) + ((size_t)l * 2 + kv) * 2048 * 64; const float* pe = CIN(11) + ((size_t)l * 2 + kv) * 2048;
        LDSP float* red = (LDSP float*)c.lds;
        block_sync();
        const int e = c.tid & 63, part = c.tid >> 6; float s = 0.f;
#pragma unroll 16
        for (int kk = part * 256; kk < part * 256 + 256; ++kk) s += pe[kk] * w[(size_t)kk * 64 + e];
        red[part * 64 + e] = s;
        block_sync();
        if (c.tid < 64) { float t = 0.f; for (int pp = 0; pp < 8; ++pp) t += red[pp * 64 + c.tid]; wsp<float>(c, WS_CBIAS)[kv * 64 + c.tid] = t; }
        block_sync();
    }
    if (l == 0 && (mask & 8)) {
        const float* x = CIN(0); bf16_t* xb = wsp<bf16_t>(c, WS_XB); float* rss = wsp<float>(c, WS_RSS1);
        for (int row = c.bid * NWAVE + c.wave; row < NT; row += c.nblk * NWAVE) {
            const f32x4* xr = (const f32x4*)(x + (size_t)row * DM) + c.lane; float s = 0.f;
            u32x2* o = (u32x2*)(xb + (size_t)row * DM) + c.lane;
#pragma unroll
            for (int j = 0; j < 4; ++j) { const f32x4 v = xr[64 * j]; s += (v[0] * v[0] + v[1] * v[1]) + (v[2] * v[2] + v[3] * v[3]);
                u32x2 w; w.x = pk2(v[0], v[1]); w.y = pk2(v[2], v[3]); o[64 * j] = w; }
            s = wave_sum(s);
            if (c.lane == 0) rss[row] = s;
        }
    }
    if (l == 0 && (mask & 16)) {
        float* cosT = wsp<float>(c, WS_ROPE); float* sinT = cosT + SEQ * 32;
        for (int i = c.bid * NTHR + c.tid; i < SEQ * 32; i += c.nblk * NTHR) {
            const int pos = i >> 5, fi = i & 31;
            const float inv = exp2f(-(float)fi * 0.41524101186092029f);
            const float a = (float)pos * inv, q = rintf(a * 0.63661977236758134f);
            float rr = fmaf(-q, 1.5703125f, a); rr = fmaf(-q, 4.837512969970703125e-4f, rr); rr = fmaf(-q, 7.54978995489188216e-8f, rr);
            const float r2 = rr * rr;
            const float s = rr * (1.0f + r2 * (-1.0f / 6 + r2 * (1.0f / 120 + r2 * (-1.0f / 5040 + r2 * (1.0f / 362880)))));
            const float cc = 1.0f + r2 * (-0.5f + r2 * (1.0f / 24 + r2 * (-1.0f / 720 + r2 * (1.0f / 40320 + r2 * (-1.0f / 3628800)))));
            const int qi = ((int)q) & 3;
            const float co = qi == 0 ? cc : qi == 1 ? -s : qi == 2 ? -cc : s;
            const float si = qi == 0 ? s : qi == 1 ? cc : qi == 2 ? -s : -cc;
            cosT[i] = co; sinT[i] = si;
        }
    }
}
constexpr int LF_STRIDE = 65, LT_STRIDE = 72;
constexpr int LDS_F0 = 0, LDS_F1 = 16640, LDS_F2 = 33280, LDS_T0 = 49920, LDS_TSZ = 64 * LT_STRIDE * 2, LDS_MISC = LDS_T0 + 6 * LDS_TSZ;
DEV LDSP float* ldsF(const Ctx& c, int i) { return (LDSP float*)(c.lds + LDS_F0 + i * 16640); }
DEV LDSP bf16_t* ldsT(const Ctx& c, int i) { return (LDSP bf16_t*)(c.lds + LDS_T0 + i * LDS_TSZ); }
DEV LDSP float* ldsM(const Ctx& c) { return (LDSP float*)(c.lds + LDS_MISC); }

DEV void load_tile_f32(const Ctx& c, LDSP float* F, const bf16_t* proj, int tok0, int col) {
    const int t = c.tid >> 3, d0 = (c.tid & 7) * 8;
    const u32x4 v = *(const u32x4*)(proj + (size_t)(tok0 + t) * PROJ_LD + col + d0);
    LDSP float* f = F + t * LF_STRIDE + d0;
    f[0] = bflo(v.x); f[1] = bfhi(v.x); f[2] = bflo(v.y); f[3] = bfhi(v.y); f[4] = bflo(v.z); f[5] = bfhi(v.z); f[6] = bflo(v.w); f[7] = bfhi(v.w);
}
DEV void load_tile_T(const Ctx& c, LDSP bf16_t* T, const bf16_t* proj, int tok0, int col) {
    const int t = c.tid >> 3, d0 = (c.tid & 7) * 8;
    const u32x4 v = *(const u32x4*)(proj + (size_t)(tok0 + t) * PROJ_LD + col + d0);
    LDSP bf16_t* p = T + d0 * LT_STRIDE + t;
    p[0] = (bf16_t)(v.x & 0xffff); p[LT_STRIDE] = (bf16_t)(v.x >> 16); p[2 * LT_STRIDE] = (bf16_t)(v.y & 0xffff); p[3 * LT_STRIDE] = (bf16_t)(v.y >> 16);
    p[4 * LT_STRIDE] = (bf16_t)(v.z & 0xffff); p[5 * LT_STRIDE] = (bf16_t)(v.z >> 16); p[6 * LT_STRIDE] = (bf16_t)(v.w & 0xffff); p[7 * LT_STRIDE] = (bf16_t)(v.w >> 16);
}
DEV f32x4 mma_tile(const LDSP bf16_t* A, int lda, int r0, const LDSP bf16_t* B, int ldb, int c0, int K, f32x4 acc, int lane) {
    const int fr = lane & 15, fq = lane >> 4;
    for (int k0 = 0; k0 < K; k0 += 32) {
        const bf16x8 a = *(const LDSP bf16x8*)(A + (r0 + fr) * lda + k0 + fq * 8);
        const bf16x8 b = *(const LDSP bf16x8*)(B + (c0 + fr) * ldb + k0 + fq * 8);
        acc = mfma16(a, b, acc);
    }
    return acc;
}
DEV float wave_scan_add(float v, int lane) {
#pragma unroll
    for (int o = 1; o < 64; o <<= 1) { const float t = shfl_f(v, lane - o); if (lane >= o) v += t; }
    return v;
}
DEV float wave_scan_max(float v, int lane) {
#pragma unroll
    for (int o = 1; o < 64; o <<= 1) { const float t = shfl_f(v, lane - o); if (lane >= o) v = fmaxf(v, t); }
    return v;
}
DEV float hgrn_lb(const Ctx& c, int l, int ch) { if (l == 0) return 0.f; const float* lb = CIN(3); return sigmoidf_(lb[MW + ch] - lb[ch]); }
DEV float ret_loggamma(int h) { return log1pf(-exp2f(-5.0f - (float)h)); }

DEV void hgrn_front(const Ctx& c, int l, const bf16_t* proj, int tok0, int h) {
    LDSP float* F0 = ldsF(c, 0); LDSP float* F1 = ldsF(c, 1);
    load_tile_f32(c, F0, proj, tok0, C_HF + h * 64);
    block_sync();
    for (int e = c.tid; e < 4096; e += NTHR) { const int t = e >> 6, d = e & 63; const float fl = F0[t * LF_STRIDE + d], lbv = hgrn_lb(c, l, h * 64 + d);
        const float sg = sigmoidf_(fl), f = lbv + (1.f - lbv) * sg; F0[t * LF_STRIDE + d] = fast_log(f); F1[t * LF_STRIDE + d] = (1.f - lbv) * (1.f - sg); }
    block_sync();
    for (int k = 0; k < 8; ++k) { const int d = c.wave * 8 + k; F0[c.lane * LF_STRIDE + d] = wave_scan_add(F0[c.lane * LF_STRIDE + d], c.lane); }
    block_sync();
}
DEV void rope_tile(const Ctx& c, LDSP float* F, int pos0, float scale) {
    const float* cosT = wsp<float>(c, WS_ROPE); const float* sinT = cosT + SEQ * 32;
    for (int e = c.tid; e < 2048; e += NTHR) { const int t = e >> 5, d = e & 31; const float cs = cosT[(pos0 + t) * 32 + d], sn = sinT[(pos0 + t) * 32 + d];
        const float x1 = F[t * LF_STRIDE + d], x2 = F[t * LF_STRIDE + d + 32];
        F[t * LF_STRIDE + d] = (x1 * cs - x2 * sn) * scale; F[t * LF_STRIDE + d + 32] = (x1 * sn + x2 * cs) * scale; }
}
constexpr int LDS_RAW = 107520, RAW_SZ = 67 * 65 * 4;
DEV void mlstm_conv_both(const Ctx& c, int l, LDSP float* Fq, LDSP float* Fk, const bf16_t* proj, int tok0, int ck, int cg, int h) {
    const float* cw = CIN(5) + (size_t)l * 4 * 512; const float* cb = CIN(6) + (size_t)l * 512; const bf16_t* halo = wsp<bf16_t>(c, WS_HALO);
    LDSP float* Rq = (LDSP float*)(c.lds + LDS_RAW); LDSP float* Rk = (LDSP float*)(c.lds + LDS_RAW + RAW_SZ);
    const int t = c.tid >> 3, d0 = (c.tid & 7) * 8;
    { const u32x4 vq = *(const u32x4*)(proj + (size_t)(tok0 + t) * PROJ_LD + C_MQ + h * 64 + d0), vk = *(const u32x4*)(proj + (size_t)(tok0 + t) * PROJ_LD + C_MK + h * 64 + d0);
      u32x4 hq = {0u, 0u, 0u, 0u}, hk = {0u, 0u, 0u, 0u};
      if (c.tid < 24 && ck > 0) { hq = *(const u32x4*)(halo + ((size_t)(cg - 1) * 3 + t) * 512 + h * 64 + d0); hk = *(const u32x4*)(halo + ((size_t)(cg - 1) * 3 + t) * 512 + 256 + h * 64 + d0); }
      LDSP float* fq = Rq + (t + 3) * 65 + d0; LDSP float* fk = Rk + (t + 3) * 65 + d0;
      fq[0] = bflo(vq.x); fq[1] = bfhi(vq.x); fq[2] = bflo(vq.y); fq[3] = bfhi(vq.y); fq[4] = bflo(vq.z); fq[5] = bfhi(vq.z); fq[6] = bflo(vq.w); fq[7] = bfhi(vq.w);
      fk[0] = bflo(vk.x); fk[1] = bfhi(vk.x); fk[2] = bflo(vk.y); fk[3] = bfhi(vk.y); fk[4] = bflo(vk.z); fk[5] = bfhi(vk.z); fk[6] = bflo(vk.w); fk[7] = bfhi(vk.w);
      if (c.tid < 24) { LDSP float* gq = Rq + t * 65 + d0; LDSP float* gk = Rk + t * 65 + d0;
        gq[0] = bflo(hq.x); gq[1] = bfhi(hq.x); gq[2] = bflo(hq.y); gq[3] = bfhi(hq.y); gq[4] = bflo(hq.z); gq[5] = bfhi(hq.z); gq[6] = bflo(hq.w); gq[7] = bfhi(hq.w);
        gk[0] = bflo(hk.x); gk[1] = bfhi(hk.x); gk[2] = bflo(hk.y); gk[3] = bfhi(hk.y); gk[4] = bflo(hk.z); gk[5] = bfhi(hk.z); gk[6] = bflo(hk.w); gk[7] = bfhi(hk.w); } }
    block_sync();
#pragma unroll
    for (int half = 0; half < 2; ++half) {
        const int ch = half * 256 + h * 64 + d0; LDSP float* R = half ? Rk : Rq; LDSP float* F = half ? Fk : Fq; const float scale = half ? 0.125f : 1.0f;
        f32x4 s0 = *(const f32x4*)(cb + ch), s1 = *(const f32x4*)(cb + ch + 4);
#pragma unroll
        for (int j = 0; j < 4; ++j) { const f32x4 w0 = *(const f32x4*)(cw + j * 512 + ch), w1 = *(const f32x4*)(cw + j * 512 + ch + 4); const LDSP float* rr = R + (t + j) * 65 + d0;
            s0[0] += w0[0] * rr[0]; s0[1] += w0[1] * rr[1]; s0[2] += w0[2] * rr[2]; s0[3] += w0[3] * rr[3]; s1[0] += w1[0] * rr[4]; s1[1] += w1[1] * rr[5]; s1[2] += w1[2] * rr[6]; s1[3] += w1[3] * rr[7]; }
        LDSP float* f = F + t * LF_STRIDE + d0;
        f[0] = siluf_(s0[0]) * scale; f[1] = siluf_(s0[1]) * scale; f[2] = siluf_(s0[2]) * scale; f[3] = siluf_(s0[3]) * scale;
        f[4] = siluf_(s1[0]) * scale; f[5] = siluf_(s1[1]) * scale; f[6] = siluf_(s1[2]) * scale; f[7] = siluf_(s1[3]) * scale;
    }
}
DEV void mlstm_gates(const Ctx& c, int l, const bf16_t* proj, int tok0, int h) {
    LDSP float* M = ldsM(c); const float* gb = CIN(7) + (size_t)l * 8;
    if (c.tid < 64) { const int t = c.tid; M[t] = bf2f(proj[(size_t)(tok0 + t) * PROJ_LD + C_MI + h]) + gb[h];
        M[64 + t] = log_sigmoidf_(bf2f(proj[(size_t)(tok0 + t) * PROJ_LD + C_MF + h]) + gb[4 + h]); }
    block_sync();
    if (c.wave == 0) M[64 + c.lane] = wave_scan_add(M[64 + c.lane], c.lane);
    block_sync();
}
DEV void store_state_tiles(const Ctx& c, bf16_t* dst, const f32x4 (&acc)[2]) {
    const int fr = c.lane & 15, fq = c.lane >> 4;
#pragma unroll
    for (int k = 0; k < 2; ++k) { const int ti = c.wave * 2 + k, rt = ti >> 2, ct = ti & 3;
#pragma unroll
        for (int i = 0; i < 4; ++i) dst[(rt * 16 + fq * 4 + i) * 64 + ct * 16 + fr] = f2bf(acc[k][i]); }
}
DEV void f32_to_tile(const Ctx& c, LDSP bf16_t* T, const LDSP float* F, bool transpose) {
    for (int e = c.tid; e < 4096; e += NTHR) { const int r = e >> 6, q = e & 63; const bf16_t v = f2bf(F[r * LF_STRIDE + q]); if (transpose) T[q * LT_STRIDE + r] = v; else T[r * LT_STRIDE + q] = v; }
}

DEV void recur_local_unit(const Ctx& c, int l, int unit) {
    const int mixer = unit / (BATCH * NH * NC), r = unit % (BATCH * NH * NC), b = r / (NH * NC), h = (r / NC) % NH, ck = r % NC;
    bf16_t* proj = wsp<bf16_t>(c, WS_PROJ); const int tok0 = b * SEQ + ck * 64, pos0 = ck * 64;
    LDSP float* F0 = ldsF(c, 0); LDSP float* F1 = ldsF(c, 1); LDSP float* F2 = ldsF(c, 2); LDSP float* M = ldsM(c);
    LDSP bf16_t* VT = ldsT(c, 0); LDSP bf16_t* KT = ldsT(c, 1);
    bf16_t* dst = wsp<bf16_t>(c, WS_ST + mixer * ST_ONE) + (size_t)r * 4096;
    const int vt = c.tid >> 3, vd0 = (c.tid & 7) * 8;
    int qcol, kcol, vcol;
    if (mixer == 0) {
        qcol = C_HQ; kcol = C_HF; vcol = C_HI;
        load_tile_T(c, VT, proj, tok0, C_HI + h * 64);
        load_tile_f32(c, F2, proj, tok0, C_HQ + h * 64);
        hgrn_front(c, l, proj, tok0, h);
        float qo[8], ko[8];
#pragma unroll
        for (int j = 0; j < 8; ++j) { const int d = vd0 + j; const float bt = F0[vt * LF_STRIDE + d], bm = F0[31 * LF_STRIDE + d], bl = F0[63 * LF_STRIDE + d], kk = F1[vt * LF_STRIDE + d];
            qo[j] = siluf_(F2[vt * LF_STRIDE + d]) * fast_exp(bt - bm); ko[j] = kk * fast_exp(bm - bt); KT[d * LT_STRIDE + vt] = f2bf(kk * fast_exp(bl - bt)); }
        if (c.tid < 64) { wsp<float>(c, WS_GDEC)[(size_t)r * 64 + c.tid] = fast_exp(F0[63 * LF_STRIDE + c.tid]); wsp<float>(c, WS_G31)[(size_t)r * 64 + c.tid] = fast_exp(F0[31 * LF_STRIDE + c.tid]); }
        u32x4 w; w.x = pk2(qo[0], qo[1]); w.y = pk2(qo[2], qo[3]); w.z = pk2(qo[4], qo[5]); w.w = pk2(qo[6], qo[7]); *(u32x4*)(proj + (size_t)(tok0 + vt) * PROJ_LD + C_HQ + h * 64 + vd0) = w;
        w.x = pk2(ko[0], ko[1]); w.y = pk2(ko[2], ko[3]); w.z = pk2(ko[4], ko[5]); w.w = pk2(ko[6], ko[7]); *(u32x4*)(proj + (size_t)(tok0 + vt) * PROJ_LD + C_HF + h * 64 + vd0) = w;
    } else if (mixer == 2) {
        qcol = C_RQ; kcol = C_RK; vcol = C_RV;
        load_tile_T(c, VT, proj, tok0, C_RV + h * 64);
        load_tile_f32(c, F0, proj, tok0, C_RK + h * 64); load_tile_f32(c, F2, proj, tok0, C_RQ + h * 64);
        block_sync();
        rope_tile(c, F0, pos0, 0.125f); rope_tile(c, F2, pos0, 1.0f);
        block_sync();
        const float lg = ret_loggamma(h), gq = fast_exp(lg * (float)(vt - 31)), gk = fast_exp(lg * (float)(31 - vt)), gl = fast_exp(lg * (float)(63 - vt));
        float qo[8], ko[8];
#pragma unroll
        for (int j = 0; j < 8; ++j) { const int d = vd0 + j; const float kk = F0[vt * LF_STRIDE + d]; qo[j] = F2[vt * LF_STRIDE + d] * gq; ko[j] = kk * gk; KT[d * LT_STRIDE + vt] = f2bf(kk * gl); }
        u32x4 w; w.x = pk2(qo[0], qo[1]); w.y = pk2(qo[2], qo[3]); w.z = pk2(qo[4], qo[5]); w.w = pk2(qo[6], qo[7]); *(u32x4*)(proj + (size_t)(tok0 + vt) * PROJ_LD + C_RQ + h * 64 + vd0) = w;
        w.x = pk2(ko[0], ko[1]); w.y = pk2(ko[2], ko[3]); w.z = pk2(ko[4], ko[5]); w.w = pk2(ko[6], ko[7]); *(u32x4*)(proj + (size_t)(tok0 + vt) * PROJ_LD + C_RK + h * 64 + vd0) = w;
    } else {
        qcol = C_MQ; kcol = C_MK; vcol = C_MV;
        load_tile_T(c, VT, proj, tok0, C_MV + h * 64);
        mlstm_gates(c, l, proj, tok0, h);
        mlstm_conv_both(c, l, F2, F0, proj, tok0, ck, b * NC + ck, h);
        if (c.wave == 0) { const int t = c.lane; const float bl = M[127], bt = M[64 + t], li = M[t];
            const float a = wave_max(bl - bt + li); const float pm = wave_scan_max(li - bt, t);
            M[128 + t] = pm; if (t == 0) { M[192] = a; M[193] = bl; }
            float* mts = wsp<float>(c, WS_MTS) + ((size_t)(tok0 + t) * NH + h) * 2; mts[0] = bt; mts[1] = bt + pm; }
        block_sync();
        const float eq = fast_exp(-M[128 + vt]), ek = fast_exp(M[vt] - M[64 + vt]), wk = fast_exp(M[193] - M[64 + vt] + M[vt] - M[192]);
        float qo[8], ko[8];
#pragma unroll
        for (int j = 0; j < 8; ++j) { const int d = vd0 + j; const float kk = F0[vt * LF_STRIDE + d]; qo[j] = F2[vt * LF_STRIDE + d] * eq; ko[j] = kk * ek;
            const float kh = kk * wk; F1[vt * LF_STRIDE + d] = kh; KT[d * LT_STRIDE + vt] = f2bf(kh); }
        block_sync();
        u32x4 w; w.x = pk2(qo[0], qo[1]); w.y = pk2(qo[2], qo[3]); w.z = pk2(qo[4], qo[5]); w.w = pk2(qo[6], qo[7]); *(u32x4*)(proj + (size_t)(tok0 + vt) * PROJ_LD + C_MQ + h * 64 + vd0) = w;
        w.x = pk2(ko[0], ko[1]); w.y = pk2(ko[2], ko[3]); w.z = pk2(ko[4], ko[5]); w.w = pk2(ko[6], ko[7]); *(u32x4*)(proj + (size_t)(tok0 + vt) * PROJ_LD + C_MK + h * 64 + vd0) = w;
        if (c.tid < 64) { float s = 0.f; for (int t = 0; t < 64; ++t) s += F1[t * LF_STRIDE + c.tid]; wsp<float>(c, WS_MNL)[(size_t)r * 64 + c.tid] = s; }
        if (c.tid == 64) { float* sc = wsp<float>(c, WS_MSC) + (size_t)r * 4; sc[0] = M[192]; sc[1] = M[193]; }
    }
    block_sync();
    f32x4 acc[2];
#pragma unroll
    for (int k = 0; k < 2; ++k) { const int ti = c.wave * 2 + k; acc[k] = (f32x4){0.f, 0.f, 0.f, 0.f}; acc[k] = mma_tile(VT, LT_STRIDE, (ti >> 2) * 16, KT, LT_STRIDE, (ti & 3) * 16, 64, acc[k], c.lane); }
    store_state_tiles(c, dst, acc);
    *(u32x4*)(proj + (size_t)(tok0 + vt) * PROJ_LD + vcol + h * 64 + vd0) = *(const LDSP u32x4*)(VT + vt * LT_STRIDE + vd0);
    (void)qcol; (void)kcol;
    block_sync();
}

DEV void recur_scan(const Ctx& c) {
    constexpr int ncol2 = BATCH * NH * 2048;
    constexpr int KB = (NC < 16) ? NC : 16;
    for (int i = c.bid * NTHR + c.tid; i < 3 * ncol2 + BATCH * NH * 64; i += c.nblk * NTHR) {
        if (i < 3 * ncol2) {
            const int mixer = i / ncol2, col = (i % ncol2) * 2, bh = col >> 12, ed = col & 4095, d = ed & 63, h = bh % NH;
            bf16_t* p = wsp<bf16_t>(c, WS_ST + mixer * ST_ONE) + (size_t)bh * NC * 4096 + ed;
            const float* g = wsp<float>(c, WS_GDEC) + (size_t)bh * NC * 64 + d; const float* g31 = wsp<float>(c, WS_G31) + (size_t)bh * NC * 64 + d; const float* sc = wsp<float>(c, WS_MSC) + (size_t)bh * NC * 4;
            const float gr = fast_exp(ret_loggamma(h) * 64.f), gr32 = fast_exp(ret_loggamma(h) * 32.f);
            float s0 = 0.f, s1 = 0.f, m = 0.f;
            for (int kb = 0; kb < NC; kb += KB) {
                unsigned tv[KB]; f32x2 gv[KB]; f32x2 av[KB]; f32x2 hv[KB];
#pragma unroll
                for (int j = 0; j < KB; ++j) { tv[j] = *(const unsigned*)(p + (size_t)(kb + j) * 4096);
                    if (mixer == 0) { gv[j] = *(const f32x2*)(g + (kb + j) * 64); hv[j] = *(const f32x2*)(g31 + (kb + j) * 64); } else if (mixer == 1) av[j] = *(const f32x2*)(sc + (kb + j) * 4); }
#pragma unroll
                for (int j = 0; j < KB; ++j) {
                    const float t0 = bflo(tv[j]), t1 = bfhi(tv[j]);
                    if (mixer == 0) { *(unsigned*)(p + (size_t)(kb + j) * 4096) = pk2(s0 * hv[j][0], s1 * hv[j][1]); s0 = gv[j][0] * s0 + t0; s1 = gv[j][1] * s1 + t1; }
                    else if (mixer == 2) { *(unsigned*)(p + (size_t)(kb + j) * 4096) = pk2(s0 * gr32, s1 * gr32); s0 = gr * s0 + t0; s1 = gr * s1 + t1; }
                    else { *(unsigned*)(p + (size_t)(kb + j) * 4096) = pk2(s0, s1);
                        const float a = av[j][0], bl = av[j][1], mn = fmaxf(bl + m, a), ds = fast_exp(bl + m - mn), dl = fast_exp(a - mn); s0 = ds * s0 + dl * t0; s1 = ds * s1 + dl * t1; m = mn; }
                }
            }
        } else {
            const int j = i - 3 * ncol2, bh = j >> 6, d = j & 63;
            float* p = wsp<float>(c, WS_MNL) + (size_t)bh * NC * 64 + d; float* sc = wsp<float>(c, WS_MSC) + (size_t)bh * NC * 4; float m = 0.f, s = 0.f;
            for (int k = 0; k < NC; ++k) { const float a = sc[k * 4], bl = sc[k * 4 + 1], mn = fmaxf(bl + m, a);
                const float t = p[k * 64]; p[k * 64] = s; if (d == 0) sc[k * 4 + 2] = m; s = fast_exp(bl + m - mn) * s + fast_exp(a - mn) * t; m = mn; }
        }
    }
}

DEV void recur_out_wave(const Ctx& c, int l, int unit) {
    const int mixer = unit / (BATCH * NH * NC), r = unit % (BATCH * NH * NC), b = r / (NH * NC), h = (r / NC) % NH, ck = r % NC;
    const bf16_t* proj = wsp<bf16_t>(c, WS_PROJ); const int tok0 = b * SEQ + ck * 64;
    const bf16_t* st = wsp<bf16_t>(c, WS_ST + mixer * ST_ONE) + (size_t)r * 4096;
    const int fr = c.lane & 15, fq = c.lane >> 4;
    const int qcol = (mixer == 0 ? C_HQ : mixer == 1 ? C_MQ : C_RQ) + h * 64, kcol = (mixer == 0 ? C_HF : mixer == 1 ? C_MK : C_RK) + h * 64;
    const int vcol = (mixer == 0 ? C_HI : mixer == 1 ? C_MV : C_RV) + h * 64, gcol = (mixer == 0 ? C_HG : mixer == 1 ? C_MO : C_RG) + h * 64;
    const float* onorm = (mixer == 0 ? CIN(4) : mixer == 1 ? CIN(8) : CIN(13)) + (size_t)l * MW + h * 64;
    bf16x8 ka[4][2], va[4][2], sa[4][2];
#pragma unroll
    for (int sq = 0; sq < 4; ++sq)
#pragma unroll
        for (int ks = 0; ks < 2; ++ks) {
            ka[sq][ks] = *(const bf16x8*)(proj + (size_t)(tok0 + 16 * sq + fr) * PROJ_LD + kcol + 32 * ks + 8 * fq);
            sa[sq][ks] = *(const bf16x8*)(st + (16 * sq + fr) * 64 + 32 * ks + 8 * fq);
            const bf16_t* vp = proj + (size_t)(tok0 + 16 * sq + fr) * PROJ_LD + vcol + 32 * ks + 4 * fq;
            const u32x2 v0 = *(const u32x2*)vp, v1 = *(const u32x2*)(vp + 16); const u32x4 vv = {v0.x, v0.y, v1.x, v1.y}; va[sq][ks] = __builtin_bit_cast(bf16x8, vv);
        }
    bf16x8 sn[2], vones; float mst = 0.f;
    if (mixer == 1) {
        const float* nst = wsp<float>(c, WS_MNL) + (size_t)r * 64; mst = wsp<float>(c, WS_MSC)[(size_t)r * 4 + 2];
#pragma unroll
        for (int ks = 0; ks < 2; ++ks) { const f32x4 n0 = *(const f32x4*)(nst + 32 * ks + 8 * fq), n1 = *(const f32x4*)(nst + 32 * ks + 8 * fq + 4);
            u32x4 w = {pk2(n0[0], n0[1]), pk2(n0[2], n0[3]), pk2(n1[0], n1[1]), pk2(n1[2], n1[3])}; if (fr != 0) w = (u32x4){0u, 0u, 0u, 0u}; sn[ks] = __builtin_bit_cast(bf16x8, w); }
        const unsigned one2 = (fr == 0) ? 0x3f803f80u : 0u; const u32x4 ow = {one2, one2, one2, one2}; vones = __builtin_bit_cast(bf16x8, ow);
    }
#pragma unroll
    for (int tq = 0; tq < 4; ++tq) {
        const int tok = tok0 + 16 * tq + fr;
        bf16x8 qb[2];
#pragma unroll
        for (int ks = 0; ks < 2; ++ks) qb[ks] = *(const bf16x8*)(proj + (size_t)tok * PROJ_LD + qcol + 32 * ks + 8 * fq);
        f32x4 stt[4];
#pragma unroll
        for (int sq = 0; sq < 4; ++sq) { stt[sq] = (f32x4){0.f, 0.f, 0.f, 0.f};
            if (sq <= tq) { stt[sq] = mfma16(ka[sq][0], qb[0], stt[sq]); stt[sq] = mfma16(ka[sq][1], qb[1], stt[sq]); } }
#pragma unroll
        for (int i = 0; i < 4; ++i) if (4 * fq + i > fr) stt[tq][i] = 0.f;
        f32x4 ot[4], os[4], o5 = {0.f, 0.f, 0.f, 0.f}, s5 = {0.f, 0.f, 0.f, 0.f};
#pragma unroll
        for (int eq = 0; eq < 4; ++eq) { ot[eq] = (f32x4){0.f, 0.f, 0.f, 0.f}; os[eq] = (f32x4){0.f, 0.f, 0.f, 0.f}; }
#pragma unroll
        for (int m = 0; m < 2; ++m) if (2 * m <= tq) {
            const u32x4 pw = {pk2(stt[2 * m][0], stt[2 * m][1]), pk2(stt[2 * m][2], stt[2 * m][3]), pk2(stt[2 * m + 1][0], stt[2 * m + 1][1]), pk2(stt[2 * m + 1][2], stt[2 * m + 1][3])};
            const bf16x8 pb = __builtin_bit_cast(bf16x8, pw);
#pragma unroll
            for (int eq = 0; eq < 4; ++eq) ot[eq] = mfma16(va[eq][m], pb, ot[eq]);
            if (mixer == 1) o5 = mfma16(vones, pb, o5);
        }
        if (mixer != 1) {
#pragma unroll
            for (int eq = 0; eq < 4; ++eq) { ot[eq] = mfma16(sa[eq][0], qb[0], ot[eq]); ot[eq] = mfma16(sa[eq][1], qb[1], ot[eq]); }
        } else {
#pragma unroll
            for (int eq = 0; eq < 4; ++eq) { os[eq] = mfma16(sa[eq][0], qb[0], os[eq]); os[eq] = mfma16(sa[eq][1], qb[1], os[eq]); }
            s5 = mfma16(sn[0], qb[0], s5); s5 = mfma16(sn[1], qb[1], s5);
            const float* mts = wsp<float>(c, WS_MTS) + ((size_t)tok * NH + h) * 2; const float bt = mts[0], ml = mts[1];
            const float inter = bt + mst, mt = fmaxf(inter, ml), rt = fast_exp(ml - mt), stc = fast_exp(mst + ml - mt);
            const float den = shfl_f(rt * o5[0] + stc * s5[0], fr);
            const float inv = fast_rcp(fmaxf(fabsf(den), fast_exp(-mt)));
#pragma unroll
            for (int eq = 0; eq < 4; ++eq) ot[eq] = (ot[eq] * rt + os[eq] * stc) * inv;
        }
        float ss = 0.f;
#pragma unroll
        for (int eq = 0; eq < 4; ++eq) ss += (ot[eq][0] * ot[eq][0] + ot[eq][1] * ot[eq][1]) + (ot[eq][2] * ot[eq][2] + ot[eq][3] * ot[eq][3]);
        ss += xorf<16>(ss); ss += xorf<32>(ss);
        const float rn = fast_rsqrt(ss * (1.0f / 64.0f) + NORM_EPS);
        bf16_t* out = wsp<bf16_t>(c, WS_OUTS) + (size_t)(mixer == 0 ? 0 : mixer == 1 ? 1 : 3) * NT * MW + (size_t)tok * MW + h * 64 + 4 * fq;
#pragma unroll
        for (int eq = 0; eq < 4; ++eq) { const u32x2 gv = *(const u32x2*)(proj + (size_t)tok * PROJ_LD + gcol + 16 * eq + 4 * fq); const f32x4 on = *(const f32x4*)(onorm + 16 * eq + 4 * fq);
            const float g0 = bflo(gv.x), g1 = bfhi(gv.x), g2 = bflo(gv.y), g3 = bfhi(gv.y);
            const float a0 = ot[eq][0] * rn * on[0] * (mixer == 1 ? sigmoidf_(g0) : siluf_(g0)), a1 = ot[eq][1] * rn * on[1] * (mixer == 1 ? sigmoidf_(g1) : siluf_(g1));
            const float a2 = ot[eq][2] * rn * on[2] * (mixer == 1 ? sigmoidf_(g2) : siluf_(g2)), a3 = ot[eq][3] * rn * on[3] * (mixer == 1 ? sigmoidf_(g3) : siluf_(g3));
            u32x2 w; w.x = pk2(a0, a1); w.y = pk2(a2, a3); *(u32x2*)(out + 16 * eq) = w; }
    }
}

DEV void nsa_kprep_item(const Ctx& c, int l, int item) {
    const bf16_t* proj = wsp<bf16_t>(c, WS_PROJ); bf16_t* ksw = wsp<bf16_t>(c, WS_KSW);
    const float* cosT = wsp<float>(c, WS_ROPE); const float* sinT = cosT + SEQ * 32;
    const int tok = item * 32 + (c.tid >> 4), vec = (c.tid >> 2) & 3, br = vec >> 1, g = vec & 1, d0 = (c.tid & 3) * 8;
    const int col = (br == 0 ? C_NKS : C_NKW) + g * 64;
    const u32x4 a = *(const u32x4*)(proj + (size_t)tok * PROJ_LD + col + d0), b2 = *(const u32x4*)(proj + (size_t)tok * PROJ_LD + col + 32 + d0);
    const float x1[8] = {bflo(a.x), bfhi(a.x), bflo(a.y), bfhi(a.y), bflo(a.z), bfhi(a.z), bflo(a.w), bfhi(a.w)};
    const float x2[8] = {bflo(b2.x), bfhi(b2.x), bflo(b2.y), bfhi(b2.y), bflo(b2.z), bfhi(b2.z), bflo(b2.w), bfhi(b2.w)};
    float ss = 0.f;
#pragma unroll
    for (int j = 0; j < 8; ++j) ss += x1[j] * x1[j] + x2[j] * x2[j];
    ss += xorf<1>(ss); ss += xorf<2>(ss);
    const float r = fast_rsqrt(ss * (1.0f / 64.0f) + NORM_EPS); const float* kg = CIN(10) + ((size_t)l * 3 + 1 + br) * 64; const int pos = tok % SEQ;
    float o1[8], o2[8];
#pragma unroll
    for (int j = 0; j < 8; ++j) { const int d = d0 + j; const float y1 = x1[j] * r * kg[d], y2 = x2[j] * r * kg[d + 32], cs = cosT[pos * 32 + d], sn = sinT[pos * 32 + d];
        o1[j] = y1 * cs - y2 * sn; o2[j] = y1 * sn + y2 * cs; }
    bf16_t* o = ksw + (size_t)tok * 256 + vec * 64 + d0;
    u32x4 w; w.x = pk2(o1[0], o1[1]); w.y = pk2(o1[2], o1[3]); w.z = pk2(o1[4], o1[5]); w.w = pk2(o1[6], o1[7]); *(u32x4*)o = w;
    w.x = pk2(o2[0], o2[1]); w.y = pk2(o2[2], o2[3]); w.z = pk2(o2[4], o2[5]); w.w = pk2(o2[6], o2[7]); *(u32x4*)(o + 32) = w;
}
DEV void nsa_compress_unit(const Ctx& c, int l, int unit) {
    const int quarter = unit & 3, kv = (unit >> 2) & 1, g = (unit >> 3) & 1, b = unit >> 4;
    const bf16_t* proj = wsp<bf16_t>(c, WS_PROJ); const bf16_t* wct = wsp<bf16_t>(c, WS_WCT) + (size_t)kv * 64 * 2048;
    const int fr = c.lane & 15, fq = c.lane >> 4, rt = c.wave & 3, kh = c.wave >> 2, n0 = quarter * 64 + rt * 16, n = n0 + fr;
    const int col = (kv == 0 ? C_NKC : C_NVC) + g * 64;
    LDSP float* xch = (LDSP float*)c.lds + (rt * 64 + c.lane) * 17;
    f32x4 acc[4];
#pragma unroll
    for (int et = 0; et < 4; ++et) acc[et] = (f32x4){0.f, 0.f, 0.f, 0.f};
    const bool live = n0 < NCMP_PAD;
    if (live)
    for (int kb = kh * 1024; kb < kh * 1024 + 1024; kb += 128) {
        bf16x8 a[4], bb[4][4];
#pragma unroll
        for (int s4 = 0; s4 < 4; ++s4) { const int kk = kb + s4 * 32 + fq * 8, lrow = kk >> 6, d0 = kk & 63;
            a[s4] = (bf16x8){0, 0, 0, 0, 0, 0, 0, 0};
            if (n < NCMP) a[s4] = *(const bf16x8*)(proj + (size_t)(b * SEQ + 16 * n + lrow) * PROJ_LD + col + d0);
#pragma unroll
            for (int et = 0; et < 4; ++et) bb[s4][et] = *(const bf16x8*)(wct + (size_t)(et * 16 + fr) * 2048 + kk); }
#pragma unroll
        for (int s4 = 0; s4 < 4; ++s4)
#pragma unroll
            for (int et = 0; et < 4; ++et) acc[et] = mfma16(a[s4], bb[s4][et], acc[et]);
    }
    if (kh == 1) {
#pragma unroll
        for (int et = 0; et < 4; ++et)
#pragma unroll
            for (int i = 0; i < 4; ++i) xch[et * 4 + i] = acc[et][i];
    }
    block_sync();
    if (kh == 0 && live) {
        const float* bias = wsp<float>(c, WS_CBIAS) + kv * 64;
        float v[4][4];
#pragma unroll
        for (int et = 0; et < 4; ++et)
#pragma unroll
            for (int i = 0; i < 4; ++i) v[et][i] = acc[et][i] + xch[et * 4 + i] + bias[et * 16 + fr];
        if (kv == 0) {
            const float* kg = CIN(10) + (size_t)l * 3 * 64; bf16_t* kc = wsp<bf16_t>(c, WS_KCMP) + (size_t)(b * 2 + g) * NCMP_PAD * 64;
#pragma unroll
            for (int i = 0; i < 4; ++i) { float ss = 0.f;
#pragma unroll
                for (int et = 0; et < 4; ++et) ss += v[et][i] * v[et][i];
                ss += xorf<1>(ss); ss += xorf<2>(ss); ss += xorf<4>(ss); ss += xorf<8>(ss);
                const float r = fast_rsqrt(ss * (1.0f / 64.0f) + NORM_EPS);
#pragma unroll
                for (int et = 0; et < 4; ++et) kc[(size_t)(n0 + fq * 4 + i) * 64 + et * 16 + fr] = f2bf(v[et][i] * r * kg[et * 16 + fr]); }
        } else {
            bf16_t* vt = wsp<bf16_t>(c, WS_VCMPT) + (size_t)(b * 2 + g) * 64 * NCMP_PAD;
#pragma unroll
            for (int et = 0; et < 4; ++et)
#pragma unroll
                for (int i = 0; i < 4; ++i) vt[(size_t)(et * 16 + fr) * NCMP_PAD + n0 + fq * 4 + i] = f2bf(v[et][i]);
        }
    }
    block_sync();
}

DEV void nsa_vprep_item(const Ctx& c, int item) {
    const int tt = item % NC, r = item / NC, br = r & 1, g = (r >> 1) & 1, b = r >> 2;
    bf16_t* proj = wsp<bf16_t>(c, WS_PROJ); LDSP bf16_t* T = (LDSP bf16_t*)c.lds; const int col = (br == 0 ? C_NVS : C_NVW) + g * 64, tok0 = b * SEQ + tt * 64;
    load_tile_T(c, T, proj, tok0, col);
    block_sync();
    { const int e = c.tid >> 3, t0 = (c.tid & 7) * 8; *(u32x4*)(proj + (size_t)(tok0 + e) * PROJ_LD + col + t0) = *(const LDSP u32x4*)(T + e * LT_STRIDE + t0); }
    block_sync();
}

constexpr int NA_PC = 0, NA_PCLD = 264, NA_BUF = 36864, NA_KLD = 72, NA_VLD = 136, NA_VOFF = 18432, NA_IMP = 73728, NA_SEL = NA_IMP + 16640, NA_GATE = NA_SEL + 512;
constexpr float NEG_BIG = -1.0e30f;

#ifndef HOST_EMU
DEV float fmax_fast(float a, float b) { return __builtin_amdgcn_fmed3f(a, b, __builtin_inff()); }
#else
static inline float fmax_fast(float a, float b) { return a > b ? a : b; }
#endif
constexpr float NEG_HUGE = -3.0e38f;
template <int MODE, bool EDGE>
DEV void nsa_stage(const Ctx& c, int buf, int js, int qt, const bf16x8 (&qr)[2], f32x4 (&ot)[4], float& mrun, float& lrun, unsigned long long selm) {
    const LDSP bf16_t* Kt = (const LDSP bf16_t*)(c.lds + buf * NA_BUF); const LDSP bf16_t* VT = (const LDSP bf16_t*)(c.lds + buf * NA_BUF + NA_VOFF);
    const int fr = c.lane & 15, fq = c.lane >> 4, q = (c.wave & 3) * 16 + fr;
    f32x4 st[8];
#pragma unroll
    for (int kt = 0; kt < 8; ++kt) { st[kt] = (f32x4){0.f, 0.f, 0.f, 0.f};
        st[kt] = mfma16(*(const LDSP bf16x8*)(Kt + (kt * 16 + fr) * NA_KLD + fq * 8), qr[0], st[kt]);
        st[kt] = mfma16(*(const LDSP bf16x8*)(Kt + (kt * 16 + fr) * NA_KLD + 32 + fq * 8), qr[1], st[kt]); }
    if (EDGE) {
#pragma unroll
        for (int kt = 0; kt < 8; ++kt) { const int j = js + (kt >> 2);
#pragma unroll
            for (int i = 0; i < 4; ++i) { const int kk = (kt & 3) * 16 + fq * 4 + i; bool ok;
                if (MODE == 0) ok = (j <= qt) && ((selm >> j) & 1ull) && (j < qt || kk <= q);
                else { const int dlt = (qt - j) * 64 + q - kk; ok = dlt >= 0 && dlt < 512; }
                st[kt][i] = ok ? st[kt][i] : NEG_HUGE; } }
    } else if (MODE == 0) {
        const float b0 = ((selm >> js) & 1ull) ? 0.f : NEG_HUGE, b1 = ((selm >> (js + 1)) & 1ull) ? 0.f : NEG_HUGE;
#pragma unroll
        for (int kt = 0; kt < 8; ++kt) st[kt] += (kt < 4) ? b0 : b1;
    }
    float mx = NEG_HUGE;
#pragma unroll
    for (int kt = 0; kt < 8; ++kt) mx = fmax_fast(mx, fmax_fast(fmax_fast(st[kt][0], st[kt][1]), fmax_fast(st[kt][2], st[kt][3])));
    mx = fmax_fast(mx, xorf<16>(mx)); mx = fmax_fast(mx, xorf<32>(mx));
    const float mn = fmax_fast(mrun, mx), alpha = fast_exp2(mrun - mn); mrun = mn; float ps = 0.f;
#pragma unroll
    for (int kt = 0; kt < 8; ++kt)
#pragma unroll
        for (int i = 0; i < 4; ++i) { const float pv = fast_exp2(st[kt][i] - mn); st[kt][i] = pv; ps += pv; }
    lrun = lrun * alpha + ps;
#pragma unroll
    for (int et = 0; et < 4; ++et) ot[et] *= alpha;
#pragma unroll
    for (int m = 0; m < 4; ++m) {
        const u32x4 pw = {pk2(st[2 * m][0], st[2 * m][1]), pk2(st[2 * m][2], st[2 * m][3]), pk2(st[2 * m + 1][0], st[2 * m + 1][1]), pk2(st[2 * m + 1][2], st[2 * m + 1][3])};
        const bf16x8 pb = __builtin_bit_cast(bf16x8, pw);
#pragma unroll
        for (int et = 0; et < 4; ++et) { const LDSP bf16_t* vrow = VT + (et * 16 + fr) * NA_VLD + 32 * m + 4 * fq;
            const u32x2 v0 = *(const LDSP u32x2*)vrow, v1 = *(const LDSP u32x2*)(vrow + 16);
            const u32x4 vv = {v0.x, v0.y, v1.x, v1.y};
            ot[et] = mfma16(__builtin_bit_cast(bf16x8, vv), pb, ot[et]); }
    }
}

DEV void nsa_attn_unit(const Ctx& c, int l, int unit) {
    const int qt = unit % NSEL, bg = unit / NSEL, g = bg & 1, b = bg >> 1;
    const bf16_t* proj = wsp<bf16_t>(c, WS_PROJ); const bf16_t* ksw = wsp<bf16_t>(c, WS_KSW);
    const float* cosT = wsp<float>(c, WS_ROPE); const float* sinT = cosT + SEQ * 32;
    LDSP bf16_t* Pc = (LDSP bf16_t*)(c.lds + NA_PC); LDSP float* imp = (LDSP float*)(c.lds + NA_IMP); LDSP unsigned long long* selmask = (LDSP unsigned long long*)(c.lds + NA_SEL);
    LDSP float* gates = (LDSP float*)(c.lds + NA_GATE);
    const int fr = c.lane & 15, fq = c.lane >> 4, hg = c.wave >> 2, hd = g * 2 + hg, qw = (c.wave & 3) * 16;
    const int tokq0 = b * SEQ + qt * 64;
    bf16x8 qc[2], qr[2];
    {
        const int tok = tokq0 + qw + fr, pos = qt * 64 + qw + fr;
        const u32x4 v0 = *(const u32x4*)(proj + (size_t)tok * PROJ_LD + C_NQ + hd * 64 + fq * 8), v1 = *(const u32x4*)(proj + (size_t)tok * PROJ_LD + C_NQ + hd * 64 + 32 + fq * 8);
        float x0[8] = {bflo(v0.x), bfhi(v0.x), bflo(v0.y), bfhi(v0.y), bflo(v0.z), bfhi(v0.z), bflo(v0.w), bfhi(v0.w)};
        float x1[8] = {bflo(v1.x), bfhi(v1.x), bflo(v1.y), bfhi(v1.y), bflo(v1.z), bfhi(v1.z), bflo(v1.w), bfhi(v1.w)};
        float ss = 0.f;
#pragma unroll
        for (int j = 0; j < 8; ++j) ss += x0[j] * x0[j] + x1[j] * x1[j];
        ss += xorf<16>(ss); ss += xorf<32>(ss);
        const float r = fast_rsqrt(ss * (1.0f / 64.0f) + NORM_EPS) * 0.125f; const float* qg = CIN(9) + (size_t)l * 64;
#pragma unroll
        for (int j = 0; j < 8; ++j) { const int d = fq * 8 + j; const float y0 = x0[j] * r * qg[d], y1 = x1[j] * r * qg[d + 32];
            const float cs = cosT[pos * 32 + d], sn = sinT[pos * 32 + d];
            qc[0][j] = (short)f2bf(y0); qc[1][j] = (short)f2bf(y1); qr[0][j] = (short)f2bf((y0 * cs - y1 * sn) * 1.44269504f); qr[1][j] = (short)f2bf((y0 * sn + y1 * cs) * 1.44269504f); }
    }
    if (c.tid < 384) { const int row = c.tid / 3, br = c.tid % 3, hh = row >> 6, q = row & 63;
        gates[c.tid] = sigmoidf_(bf2f(proj[(size_t)(tokq0 + q) * PROJ_LD + C_NG + (g * 2 + hh) * 3 + br])); }
    f32x4 ofin[4];
#pragma unroll
    for (int et = 0; et < 4; ++et) ofin[et] = (f32x4){0.f, 0.f, 0.f, 0.f};
    const int nvis = 4 * qt + 3, nkt = (nvis + 15) >> 4, nk32 = ((nkt * 16 + 31) >> 5) << 5;
    {
        const bf16_t* kc = wsp<bf16_t>(c, WS_KCMP) + (size_t)(b * 2 + g) * NCMP_PAD * 64;
        f32x4 s[16];
#pragma unroll
        for (int jt = 0; jt < 16; ++jt) { s[jt] = (f32x4){0.f, 0.f, 0.f, 0.f};
            if (jt < nkt) { s[jt] = mfma16(qc[0], *(const bf16x8*)(kc + (size_t)(jt * 16 + fr) * 64 + fq * 8), s[jt]);
                            s[jt] = mfma16(qc[1], *(const bf16x8*)(kc + (size_t)(jt * 16 + fr) * 64 + 32 + fq * 8), s[jt]); } }
#pragma unroll
        for (int i = 0; i < 4; ++i) {
            const int sp = qt * 64 + qw + fq * 4 + i, lim = (sp >= 31) ? ((sp - 31) >> 4) : -1;
            float mx = NEG_BIG;
#pragma unroll
            for (int jt = 0; jt < 16; ++jt) if (jt < nkt && jt * 16 + fr <= lim) mx = fmaxf(mx, s[jt][i]);
            mx = fmaxf(mx, xorf<1>(mx)); mx = fmaxf(mx, xorf<2>(mx)); mx = fmaxf(mx, xorf<4>(mx)); mx = fmaxf(mx, xorf<8>(mx));
            float ps = 0.f;
#pragma unroll
            for (int jt = 0; jt < 16; ++jt) { float p = 0.f; if (jt < nkt && jt * 16 + fr <= lim) p = fast_exp(s[jt][i] - mx); s[jt][i] = p; ps += p; }
            ps += xorf<1>(ps); ps += xorf<2>(ps); ps += xorf<4>(ps); ps += xorf<8>(ps);
            const float inv = ps > 0.f ? fast_rcp(ps) : 0.f;
            LDSP bf16_t* prow = Pc + (size_t)(hg * 64 + qw + fq * 4 + i) * NA_PCLD;
#pragma unroll
            for (int jt = 0; jt < 16; ++jt) if (jt * 16 < nk32) prow[jt * 16 + fr] = f2bf(s[jt][i] * inv);
        }
        wave_sync();
        const bf16_t* vt = wsp<bf16_t>(c, WS_VCMPT) + (size_t)(b * 2 + g) * 64 * NCMP_PAD;
        f32x4 oc[4];
#pragma unroll
        for (int et = 0; et < 4; ++et) oc[et] = (f32x4){0.f, 0.f, 0.f, 0.f};
        for (int k0 = 0; k0 < nk32; k0 += 32) {
            const bf16x8 pa = *(const LDSP bf16x8*)(Pc + (size_t)(hg * 64 + qw + fr) * NA_PCLD + k0 + fq * 8);
#pragma unroll
            for (int et = 0; et < 4; ++et) oc[et] = mfma16(*(const bf16x8*)(vt + (size_t)(et * 16 + fr) * NCMP_PAD + k0 + fq * 8), pa, oc[et]);
        }
        block_sync();
#pragma unroll
        for (int et = 0; et < 4; ++et) ofin[et] += oc[et] * gates[(hg * 64 + qw + fr) * 3 + 0];
    }
    for (int e = c.tid; e < 4096; e += NTHR) { const int q = e >> 6, j = e & 63; float a = 0.f;
        if (j <= qt) {
#pragma unroll
            for (int dn = -1; dn <= 3; ++dn) { const int n = 4 * j + dn; if (n >= 0 && n < nkt * 16) a += bf2f(Pc[(size_t)q * NA_PCLD + n]) + bf2f(Pc[(size_t)(64 + q) * NA_PCLD + n]); }
            if (j == 0 || j == qt || j == qt - 1) a += 1000.f;
        } else a = NEG_BIG;
        imp[q * 65 + j] = a; }
    block_sync();
    for (int qq = 0; qq < 8; ++qq) { const int q = c.wave * 8 + qq; unsigned long long m = 0ull;
        if (qt < 16) m = (1ull << (qt + 1)) - 1ull;
        else { const unsigned key = (sortkey32(imp[q * 65 + c.lane]) & 0xffffffc0u) | (unsigned)(63 - c.lane); int rank = 0;
#pragma unroll
            for (int i = 0; i < 64; ++i) rank += ((unsigned)bcast_i((int)key, i) > key) ? 1 : 0;
            m = ballot64(rank < 16); }
        if (c.lane == 0) selmask[q] = m; }
    block_sync();
    const unsigned long long selm = selmask[qw + fr];
#pragma unroll
    for (int mode = 0; mode < 2; ++mode) {
        f32x4 ot[4]; float mrun = NEG_BIG, lrun = 0.f;
#pragma unroll
        for (int et = 0; et < 4; ++et) ot[et] = (f32x4){0.f, 0.f, 0.f, 0.f};
        const int j0 = (mode == 0) ? 0 : (qt >= 8 ? qt - 8 : 0), ns = (qt - j0) / 2 + 1;
        const int skey = c.tid >> 2, sd0 = (c.tid & 3) * 16, se = c.tid >> 3, sk0 = (c.tid & 7) * 16;
        u32x4 rk0, rk1, rv0, rv1;
#define NSA_STAGE_LOAD(js_) do { const int jb_ = (js_) + (skey >> 6) > qt ? qt : (js_) + (skey >> 6); const size_t tok_ = (size_t)b * SEQ + jb_ * 64 + (skey & 63); \
            const bf16_t* kp_ = ksw + tok_ * 256 + (mode * 2 + g) * 64 + sd0; rk0 = *(const u32x4*)kp_; rk1 = *(const u32x4*)(kp_ + 8); \
            const int jv_ = (js_) + (sk0 >> 6) > qt ? qt : (js_) + (sk0 >> 6); const bf16_t* vp_ = proj + ((size_t)b * SEQ + jv_ * 64 + se) * PROJ_LD + (mode == 0 ? C_NVS : C_NVW) + g * 64 + (sk0 & 63); rv0 = *(const u32x4*)vp_; rv1 = *(const u32x4*)(vp_ + 8); } while (0)
#define NSA_STAGE_WRITE(buf_) do { LDSP bf16_t* kd_ = (LDSP bf16_t*)(c.lds + (buf_) * NA_BUF) + skey * NA_KLD + sd0; *(LDSP u32x4*)kd_ = rk0; *(LDSP u32x4*)(kd_ + 8) = rk1; \
            LDSP bf16_t* vd_ = (LDSP bf16_t*)(c.lds + (buf_) * NA_BUF + NA_VOFF) + se * NA_VLD + sk0; *(LDSP u32x4*)vd_ = rv0; *(LDSP u32x4*)(vd_ + 8) = rv1; } while (0)
        NSA_STAGE_LOAD(j0); NSA_STAGE_WRITE(0);
        block_sync();
        for (int sidx = 0; sidx < ns; ++sidx) {
            const int js = j0 + 2 * sidx;
            if (sidx + 1 < ns) NSA_STAGE_LOAD(js + 2);
            const bool edge = (mode == 0) ? (js + 1 >= qt) : (sidx == 0 || js + 1 >= qt);
            if (mode == 0) { if (edge) nsa_stage<0, true>(c, sidx & 1, js, qt, qr, ot, mrun, lrun, selm); else nsa_stage<0, false>(c, sidx & 1, js, qt, qr, ot, mrun, lrun, selm); }
            else { if (edge) nsa_stage<1, true>(c, sidx & 1, js, qt, qr, ot, mrun, lrun, selm); else nsa_stage<1, false>(c, sidx & 1, js, qt, qr, ot, mrun, lrun, selm); }
            if (sidx + 1 < ns) NSA_STAGE_WRITE((sidx + 1) & 1);
            block_sync();
        }
#undef NSA_STAGE_LOAD
#undef NSA_STAGE_WRITE
        float ls = lrun; ls += xorf<16>(ls); ls += xorf<32>(ls);
        const float sc = gates[(hg * 64 + qw + fr) * 3 + 1 + mode] * (ls > 0.f ? fast_rcp(ls) : 0.f);
#pragma unroll
        for (int et = 0; et < 4; ++et) ofin[et] += ot[et] * sc;
    }
    bf16_t* out = wsp<bf16_t>(c, WS_OUTS) + (size_t)2 * NT * MW + (size_t)(tokq0 + qw + fr) * MW + hd * 64 + fq * 4;
#pragma unroll
    for (int et = 0; et < 4; ++et) { u32x2 w; w.x = pk2(ofin[et][0], ofin[et][1]); w.y = pk2(ofin[et][2], ofin[et][3]); *(u32x2*)(out + et * 16) = w; }
    block_sync();
}
constexpr int PEER_WSCR = (4 * 256 + 3 * 128) * 4;
constexpr int PEER_X8 = 8 * PEER_WSCR;
constexpr int PEER_TAB = PEER_X8 + 8 * 1024;
#ifndef HOST_EMU
DEV int uniform_i(int v) { return __builtin_amdgcn_readfirstlane(v); }
#else
static inline int uniform_i(int v) { return v; }
#endif
DEV unsigned sortkey16(unsigned b) { return (b & 0x8000u) ? (~b & 0xffffu) : (b | 0x8000u); }
DEV f32x2 dot16_fp8(const f32x2 (&x)[8], const u32x4 q, f32x2 s) {
#pragma unroll
    for (int i = 0; i < 4; ++i) { const f32x2 lo = cvt_pk_f32_fp8(q[i], false), hi = cvt_pk_f32_fp8(q[i], true); s = x[2 * i] * lo + s; s = x[2 * i + 1] * hi + s; }
    return s;
}
DEV void axpy16_fp8(f32x2 (&acc)[8], float w, const u32x4 q) {
    const f32x2 w2 = {w, w};
#pragma unroll
    for (int i = 0; i < 4; ++i) { const f32x2 lo = cvt_pk_f32_fp8(q[i], false), hi = cvt_pk_f32_fp8(q[i], true); acc[2 * i] = w2 * lo + acc[2 * i]; acc[2 * i + 1] = w2 * hi + acc[2 * i + 1]; }
}
DEV f32x2 dot16_fp4(const f32x2 (&x)[8], const u32x2 q, f32x2 s) {
#pragma unroll
    for (int i = 0; i < 2; ++i)
#pragma unroll
        for (int b = 0; b < 4; ++b) s = x[4 * i + b] * cvt_pk_f32_fp4(q[i], b) + s;
    return s;
}
DEV void axpy16_fp4(f32x2 (&acc)[8], float w, const u32x2 q) {
    const f32x2 w2 = {w, w};
#pragma unroll
    for (int i = 0; i < 2; ++i)
#pragma unroll
        for (int b = 0; b < 4; ++b) acc[4 * i + b] = w2 * cvt_pk_f32_fp4(q[i], b) + acc[4 * i + b];
}
DEV void peer_init_tab(const Ctx& c) {
    if (c.tid < 64) { const int t = c.tid; int a, b;
        if (t < 16) { a = 0; b = t; } else if (t < 24) { a = 1; b = t - 16; } else if (t < 29) { a = 2; b = t - 24; } else if (t < 33) { a = 3; b = t - 29; }
        else if (t < 36) { a = 4; b = t - 33; } else if (t < 42) { a = 5 + (t - 36) / 2; b = (t - 36) & 1; } else { a = 8 + (t - 42); b = 0; }
        ((LDSP unsigned char*)(c.lds + PEER_TAB))[t] = (t < 50) ? (unsigned char)((a << 4) | b) : (unsigned char)0xff; }
    block_sync();
}
DEV void peer_token(const Ctx& c, int l, int tok) {
    const int lane = c.lane;
    LDSP float* Wv = (LDSP float*)(c.lds + c.wave * PEER_WSCR); LDSP int* Wi = (LDSP int*)(Wv + 256); LDSP float* Sv = (LDSP float*)(Wi + 256); LDSP int* Si = (LDSP int*)(Sv + 256);
    LDSP int* We = Si + 256; LDSP float* Ws = (LDSP float*)(We + 128); LDSP float* Wg = Ws + 128;
    const bf16_t* sc = wsp<bf16_t>(c, WS_SCORES) + (size_t)tok * PEER_N;
#ifndef DUP_TOPK
#define DUP_TOPK 1
#endif
    for (int rep_ = 0; rep_ < DUP_TOPK; ++rep_) {
    unsigned w[16];
#pragma unroll
    for (int gi = 0; gi < 16; ++gi) w[gi] = *(const unsigned*)(sc + gi * 128 + 2 * lane);
#pragma unroll
    for (int gq = 0; gq < 16; gq += 4) {
        unsigned k0[4], k1[4], T[4];
#pragma unroll
        for (int u = 0; u < 4; ++u) { k0[u] = sortkey16(w[gq + u] & 0xffffu); k1[u] = sortkey16(w[gq + u] >> 16); T[u] = 0u; }
#pragma unroll
        for (int bit = 15; bit >= 0; --bit) {
            unsigned long long ba[4], bb[4];
#pragma unroll
            for (int u = 0; u < 4; ++u) { const unsigned cand = T[u] | (1u << bit); ba[u] = ballot64(k0[u] >= cand); bb[u] = ballot64(k1[u] >= cand); }
#pragma unroll
            for (int u = 0; u < 4; ++u) { const int cnt = __builtin_popcountll(ba[u]) + __builtin_popcountll(bb[u]); if (cnt >= 16) T[u] |= (1u << bit); }
        }
#pragma unroll
        for (int u = 0; u < 4; ++u) { const int gi = gq + u;
            const unsigned long long gt0 = ballot64(k0[u] > T[u]), gt1 = ballot64(k1[u] > T[u]), eq0 = ballot64(k0[u] == T[u]), eq1 = ballot64(k1[u] == T[u]);
            const int need = 16 - __builtin_popcountll(gt0) - __builtin_popcountll(gt1);
            const int eqr0 = mbcnt64(eq0) + mbcnt64(eq1), eqr1 = eqr0 + (k0[u] == T[u] ? 1 : 0);
            const bool sel0 = (k0[u] > T[u]) || (k0[u] == T[u] && eqr0 < need), sel1 = (k1[u] > T[u]) || (k1[u] == T[u] && eqr1 < need);
            const unsigned long long s0 = ballot64(sel0), s1 = ballot64(sel1);
            const int slot0 = mbcnt64(s0) + mbcnt64(s1), slot1 = slot0 + (sel0 ? 1 : 0);
            if (sel0) Wi[gi * 16 + slot0] = (int)((k0[u] << 16) | (unsigned)(127 - 2 * lane));
            if (sel1) Wi[gi * 16 + slot1] = (int)((k1[u] << 16) | (unsigned)(126 - 2 * lane)); }
    }
    wave_sync();
#pragma unroll
    for (int pass = 0; pass < 4; ++pass) { const int g = pass * 4 + (lane >> 4), e = lane & 15; const unsigned pk = (unsigned)Wi[g * 16 + e]; int rank = 0;
#pragma unroll
        for (int j = 0; j < 16; ++j) rank += ((unsigned)Wi[g * 16 + j] > pk) ? 1 : 0;
        const unsigned k16 = pk >> 16, bits = (k16 & 0x8000u) ? (k16 & 0x7fffu) : (~k16 & 0xffffu);
        Sv[g * 16 + rank] = __builtin_bit_cast(float, bits << 16); Si[g * 16 + rank] = 127 - (int)(pk & 0x7fu); }
    wave_sync();
    const unsigned ab = ((const LDSP unsigned char*)(c.lds + PEER_TAB))[lane]; const bool valid = ab != 0xffu; const int a = (ab >> 4) & 15, b = ab & 15;
    for (int h = 0; h < 8; ++h) {
        const float s = valid ? Sv[(2 * h) * 16 + a] + Sv[(2 * h + 1) * 16 + b] : -3.0e38f;
        const unsigned key = valid ? ((sortkey32(s) & 0xffffff00u) | (unsigned)(255 - (a * 16 + b))) : 0u;
        int rank = 0;
#pragma unroll
        for (int j = 0; j < 50; ++j) rank += ((unsigned)bcast_i((int)key, j) > key) ? 1 : 0;
        if (valid && rank < 16) { We[h * 16 + rank] = (Si[(2 * h) * 16 + a] * 128 + Si[(2 * h + 1) * 16 + b]) & 16383; Ws[h * 16 + rank] = s; }
    }
    wave_sync();
    { const float mx = Ws[(lane >> 3) * 16]; const float e0 = fast_exp(Ws[2 * lane] - mx), e1 = fast_exp(Ws[2 * lane + 1] - mx); float sm = e0 + e1;
      sm += xorf<1>(sm); sm += xorf<2>(sm); sm += xorf<4>(sm); const float inv = fast_rcp(sm); Wg[2 * lane] = e0 * inv; Wg[2 * lane + 1] = e1 * inv; }
    wave_sync();
    }
    const bf16_t* xb = wsp<bf16_t>(c, WS_XB) + (size_t)tok * DM; const unsigned char* PU = wsp<unsigned char>(c, WS_PU); const unsigned char* PV = wsp<unsigned char>(c, WS_PV);
    f32x2 xf[8];
    { const u32x4 x0 = *(const u32x4*)(xb + 16 * lane), x1 = *(const u32x4*)(xb + 16 * lane + 8);
      xf[0] = (f32x2){bflo(x0.x), bfhi(x0.x)}; xf[1] = (f32x2){bflo(x0.y), bfhi(x0.y)}; xf[2] = (f32x2){bflo(x0.z), bfhi(x0.z)}; xf[3] = (f32x2){bflo(x0.w), bfhi(x0.w)};
      xf[4] = (f32x2){bflo(x1.x), bfhi(x1.x)}; xf[5] = (f32x2){bflo(x1.y), bfhi(x1.y)}; xf[6] = (f32x2){bflo(x1.z), bfhi(x1.z)}; xf[7] = (f32x2){bflo(x1.w), bfhi(x1.w)}; }
    const float rstd = pg8::rstd_of(pg8::rss_slots16(wsp<float>(c, WS_RSS2) + (size_t)tok * 16)) * (1.0f / 64.0f);
    f32x2 acc[8];
#pragma unroll
    for (int j = 0; j < 8; ++j) acc[j] = (f32x2){0.f, 0.f};
    LDSP unsigned char* X8 = (LDSP unsigned char*)(c.lds + PEER_X8 + c.wave * 1024);
    { u32x4 xq;
      xq.x = cvt_pk_fp8_f32(xf[1][0], xf[1][1], cvt_pk_fp8_f32(xf[0][0], xf[0][1], 0u, false), true); xq.y = cvt_pk_fp8_f32(xf[3][0], xf[3][1], cvt_pk_fp8_f32(xf[2][0], xf[2][1], 0u, false), true);
      xq.z = cvt_pk_fp8_f32(xf[5][0], xf[5][1], cvt_pk_fp8_f32(xf[4][0], xf[4][1], 0u, false), true); xq.w = cvt_pk_fp8_f32(xf[7][0], xf[7][1], cvt_pk_fp8_f32(xf[6][0], xf[6][1], 0u, false), true);
      *(LDSP u32x4*)(X8 + 16 * lane) = xq;
    }
    wave_sync();
#define PEER_LOADV(buf, base) do { _Pragma("unroll") for (int k_ = 0; k_ < 8; ++k_) { const unsigned o_ = ((unsigned)We[(base) + k_] << 9) + 8u * (unsigned)lane; buf[k_] = *(const u32x2*)(PV + o_); } } while (0)
#define PEER_LOADU(buf, hh) do { const unsigned o_ = ((unsigned)We[(hh) * 16 + (lane & 15)] << 9) + 16u * (unsigned)(lane >> 4); _Pragma("unroll") for (int s_ = 0; s_ < 8; ++s_) buf[s_] = *(const u32x4*)(PU + o_ + 64u * s_); } while (0)
    u32x4 ua[8]; u32x2 bv0[8], bv1[8];
    PEER_LOADU(ua, 0);
    for (int h = 0; h < 8; ++h) {
        PEER_LOADV(bv0, h * 16);
        f32x4 dacc = {0.f, 0.f, 0.f, 0.f};
#pragma unroll
        for (int s = 0; s < 8; ++s) { const LDSP unsigned char* xq = X8 + 128 * s + 16 * (lane >> 4);
            dacc = mfma_fp4_fp8(ua[s], *(const LDSP u32x4*)xq, *(const LDSP u32x4*)(xq + 64), dacc); }
        PEER_LOADV(bv1, h * 16 + 8);
        const int srcl = 16 * ((lane & 15) >> 2);
        const float d0 = shfl_f(dacc[0], srcl), d1 = shfl_f(dacc[1], srcl), d2 = shfl_f(dacc[2], srcl), d3 = shfl_f(dacc[3], srcl);
        const float dk = (lane & 2) ? ((lane & 1) ? d3 : d2) : ((lane & 1) ? d1 : d0);
        const float wk = Wg[h * 16 + (lane & 15)] * gelu_erf(dk * rstd) * 0.1f;
        if (h < 7) PEER_LOADU(ua, h + 1);
#pragma unroll
        for (int k = 0; k < 8; ++k) axpy16_fp4(acc, bcast_f(wk, k), bv0[k]);
#pragma unroll
        for (int k = 0; k < 8; ++k) axpy16_fp4(acc, bcast_f(wk, 8 + k), bv1[k]);
    }
#undef PEER_LOADU
#undef PEER_LOADV
    float* orow = c.out + (size_t)tok * DM + 16 * lane; float ss = 0.f; f32x4 o[4];
#pragma unroll
    for (int j = 0; j < 4; ++j) { o[j] = *(const f32x4*)(orow + 4 * j); o[j] += (f32x4){acc[2 * j][0], acc[2 * j][1], acc[2 * j + 1][0], acc[2 * j + 1][1]}; *(f32x4*)(orow + 4 * j) = o[j]; }
    if (l + 1 < DEPTH) {
        bf16_t* xo = wsp<bf16_t>(c, WS_XB) + (size_t)tok * DM + 16 * lane;
        u32x4 w0, w1; w0.x = pk2(o[0][0], o[0][1]); w0.y = pk2(o[0][2], o[0][3]); w0.z = pk2(o[1][0], o[1][1]); w0.w = pk2(o[1][2], o[1][3]);
        w1.x = pk2(o[2][0], o[2][1]); w1.y = pk2(o[2][2], o[2][3]); w1.z = pk2(o[3][0], o[3][1]); w1.w = pk2(o[3][2], o[3][3]);
        *(u32x4*)xo = w0; *(u32x4*)(xo + 8) = w1;
#pragma unroll
        for (int j = 0; j < 4; ++j) ss += (o[j][0] * o[j][0] + o[j][1] * o[j][1]) + (o[j][2] * o[j][2] + o[j][3] * o[j][3]);
        ss = wave_sum(ss);
        if (lane == 0) wsp<float>(c, WS_RSS1)[tok] = ss;
    }
    wave_sync();
}
DEV void peer_table_rows(const Ctx& c, int l) {
    const float* g2 = CIN(17) + (size_t)l * DM;
    const f32x4 ga = *((const f32x4*)g2 + 4 * c.lane), gb = *((const f32x4*)g2 + 4 * c.lane + 1), gc = *((const f32x4*)g2 + 4 * c.lane + 2), gd = *((const f32x4*)g2 + 4 * c.lane + 3);
    for (int r = c.bid * NWAVE + c.wave; r < 2 * 16384; r += c.nblk * NWAVE) {
        const int tab = r >> 14, e = r & 16383;
        const f32x4* src = (const f32x4*)((tab == 0 ? CIN(20) : CIN(21)) + ((size_t)l * 16384 + e) * DM) + 4 * c.lane;
        f32x4 v0 = src[0], v1 = src[1], v2 = src[2], v3 = src[3];
        if (tab == 0) { v0 *= ga * 64.0f; v1 *= gb * 64.0f; v2 *= gc * 64.0f; v3 *= gd * 64.0f;
        } else { v0 *= 10.0f; v1 *= 10.0f; v2 *= 10.0f; v3 *= 10.0f; }
        {
            u32x2 q;
            q.x = fp4_code(v0[0]) | (fp4_code(v0[1]) << 4) | (fp4_code(v0[2]) << 8) | (fp4_code(v0[3]) << 12) | (fp4_code(v1[0]) << 16) | (fp4_code(v1[1]) << 20) | (fp4_code(v1[2]) << 24) | (fp4_code(v1[3]) << 28);
            q.y = fp4_code(v2[0]) | (fp4_code(v2[1]) << 4) | (fp4_code(v2[2]) << 8) | (fp4_code(v2[3]) << 12) | (fp4_code(v3[0]) << 16) | (fp4_code(v3[1]) << 20) | (fp4_code(v3[2]) << 24) | (fp4_code(v3[3]) << 28);
            *(u32x2*)(wsp<unsigned char>(c, tab == 0 ? WS_PU : WS_PV) + (size_t)e * (DM / 2) + 8 * c.lane) = q;
        }
    }
}
#ifndef HOST_EMU
#define XB_TMO      128
#define XB_XCNT(j)  (256  + 64 * (j))
#define XB_XSUB(j)  (1280 + 64 * (j))
#define XB_XGEN(j)  (2304 + 64 * (j))
#define XB_TOP      3328
#define XB_TOPGEN   3392
#define XCD_BAR_WORDS 3456
#define XB_SPIN_CAP (1u << 18)

__device__ __forceinline__ unsigned xb_ld(unsigned* p)              { return __hip_atomic_load(p, __ATOMIC_RELAXED, __HIP_MEMORY_SCOPE_AGENT); }
__device__ __forceinline__ unsigned xb_add(unsigned* p, unsigned v) { return __hip_atomic_fetch_add(p, v, __ATOMIC_RELAXED, __HIP_MEMORY_SCOPE_AGENT); }
__device__ __forceinline__ unsigned xb_xcc_id() { return (unsigned)__builtin_amdgcn_s_getreg((3 << 11) | 20) & 0xFu; }
#define XB_SPIN(cond, bar) do { unsigned _sp = 0; while (cond) { __builtin_amdgcn_s_sleep(1); \
    if ((++_sp & 255u) == 0u) { if (xb_ld(&(bar)[XB_TMO])) break; if (_sp > XB_SPIN_CAP) { atomicAdd(&(bar)[XB_TMO], 1u); break; } } } } while (0)

struct XcdBarrier {
    unsigned* bar; unsigned x;
    volatile __attribute__((address_space(3))) unsigned* st;
};

__device__ __forceinline__ XcdBarrier xcd_barrier_post(unsigned* bar, volatile __attribute__((address_space(3))) unsigned* st) {
    XcdBarrier b; b.bar = bar; b.x = xb_xcc_id(); b.st = st;
    if (threadIdx.x == 0) (void)xb_add(&bar[XB_XCNT(b.x)], 1u);
    return b;
}
__device__ __forceinline__ void xcd_barrier_complete(unsigned* bar, unsigned x, unsigned& nloc, unsigned& nx) {
    const unsigned G = gridDim.x * gridDim.y * gridDim.z;
    unsigned sum, cnt, mine, sp = 0u;
    for (;;) {
        sum = 0u; cnt = 0u; mine = 0u;
#pragma unroll
        for (unsigned j = 0; j < 16; ++j) { const unsigned c = xb_ld(&bar[XB_XCNT(j)]); sum += c; cnt += (c > 0u) ? 1u : 0u; mine = (j == x) ? c : mine; }
        if (sum == G) break;
        __builtin_amdgcn_s_sleep(1);
        if ((++sp & 255u) == 0u) { if (xb_ld(&bar[XB_TMO])) break; if (sp > XB_SPIN_CAP) { atomicAdd(&bar[XB_TMO], 1u); break; } }
    }
    nloc = mine > 0u ? mine : 1u; nx = cnt > 0u ? cnt : 1u;
}

__device__ __forceinline__ void xcd_barrier(const XcdBarrier& b) {
    asm volatile("s_waitcnt vmcnt(0)" ::: "memory");
    __syncthreads();
    if (threadIdx.x == 0) {
        unsigned* bar = b.bar;
        __builtin_amdgcn_s_waitcnt(0);
        unsigned nloc = b.st[0], nx = b.st[1];
        if (nloc == 0u) { xcd_barrier_complete(bar, b.x, nloc, nx); b.st[0] = nloc; b.st[1] = nx; }
        const unsigned old = xb_add(&bar[XB_XSUB(b.x)], 1u);
        const unsigned gen = old / nloc;
        if (old + 1u == (gen + 1u) * nloc) {
            __builtin_amdgcn_fence(__ATOMIC_RELEASE, "agent");
            asm volatile("s_waitcnt vmcnt(0)" ::: "memory");
            const unsigned og = xb_add(&bar[XB_TOP], 1u);
            const unsigned tg = og / nx;
            if (og + 1u == (tg + 1u) * nx) xb_add(&bar[XB_TOPGEN], 1u);
            else XB_SPIN(xb_ld(&bar[XB_TOPGEN]) == tg, bar);
            __builtin_amdgcn_fence(__ATOMIC_ACQUIRE, "agent");
            xb_add(&bar[XB_XGEN(b.x)], 1u);
            asm volatile("s_waitcnt vmcnt(0)" ::: "memory");
        } else {
            XB_SPIN(xb_ld(&bar[XB_XGEN(b.x)]) == gen, bar);
            __builtin_amdgcn_fence(__ATOMIC_ACQUIRE, "agent");
            asm volatile("s_waitcnt vmcnt(0)" ::: "memory");
        }
    }
    __syncthreads();
}


#endif
#ifndef EXTRA_K
#define EXTRA_K 0
#endif
#ifndef P0X
#define P0X 31
#endif
#ifndef P2X
#define P2X 15
#endif
#ifndef DBG_COPY
#define DBG_COPY 0
#endif
#ifndef DBG_PHASE
#define DBG_PHASE 5
#endif
#ifndef DUP_NSA
#define DUP_NSA 1
#endif
#ifndef DUP_REC
#define DUP_REC 1
#endif
#ifndef DUP_P5
#define DUP_P5 1
#endif
#ifndef DUP_P2
#define DUP_P2 1
#endif
#ifndef DUP_P0
#define DUP_P0 1
#endif
#ifndef DUP_P1
#define DUP_P1 1
#endif
#ifndef DUP_NP
#define DUP_NP 1
#endif
#ifndef HOST_EMU
#define GRID_SYNC() do { if (ph == 1) cg::this_grid().sync(); else { XcdBarrier xb_; xb_.bar = (unsigned*)(lds_ptr_entry(22) + WS_BARRIER); xb_.x = xb_xcc_id(); \
    xb_.st = (volatile __attribute__((address_space(3))) unsigned*)(smem_raw + LDS_PTRS + 192); xcd_barrier(xb_); } } while (0)
#else
#define GRID_SYNC() grid_sync_impl()
#endif

#ifndef HOST_EMU
DEV unsigned char* lds_ptr_entry(int i) {
    int z; asm volatile("s_mov_b32 %0, 0" : "=s"(z)); i += z;
    const unsigned long long v = ((volatile LDSP unsigned long long*)((LDSP unsigned char*)smem_raw + LDS_PTRS))[i];
    const unsigned lo = __builtin_amdgcn_readfirstlane((unsigned)v), hi = __builtin_amdgcn_readfirstlane((unsigned)(v >> 32));
    return (unsigned char*)(__attribute__((address_space(1))) unsigned char*)(((unsigned long long)hi << 32) | lo);
}
#endif
DEV Ctx make_ctx(const Params& p, int wave0) {
#ifndef HOST_EMU
    Ctx c; c.out = p.out; c.ws = p.ws; c.tid = wave0 * 64 + fresh_lane();
#else
    Ctx c; c.out = p.out; c.ws = p.ws; c.tid = TID();
#endif
    c.bid = BID(); c.nblk = NBLK(); int z = 0;
#ifndef HOST_EMU
    asm volatile("" : "+v"(c.tid), "+s"(c.bid), "+s"(c.nblk));
    asm volatile("s_mov_b32 %0, 0" : "=s"(z));
    c.ws = lds_ptr_entry(22); c.out = (float*)lds_ptr_entry(23);
#endif
    c.lds = SMEM_PTR() + z; c.lane = c.tid & 63; c.wave = c.tid >> 6;
#ifndef HOST_EMU
    c.wave = __builtin_amdgcn_readfirstlane(c.wave);
#endif
    return c;
}
#ifndef HOST_EMU
__global__ void __launch_bounds__(NTHR, 2) fwd_kernel(Params p)
#else
void fwd_kernel(Params p)
#endif
{
    {
        LDSP char* lds0 = SMEM_PTR();
        if (TID() == 0) {
#pragma unroll
            for (int i = 0; i < 22; ++i) ((LDSP unsigned long long*)(lds0 + LDS_PTRS))[i] = (unsigned long long)p.in[i];
            ((LDSP unsigned long long*)(lds0 + LDS_PTRS))[22] = (unsigned long long)p.ws; ((LDSP unsigned long long*)(lds0 + LDS_PTRS))[23] = (unsigned long long)p.out;
        }
        block_sync();
    }
#ifndef HOST_EMU
    const int wave0 = __builtin_amdgcn_readfirstlane((int)threadIdx.x >> 6);
#else
    const int wave0 = 0;
#endif
#ifndef HOST_EMU
    volatile __attribute__((address_space(3))) unsigned* xst = (volatile __attribute__((address_space(3))) unsigned*)(smem_raw + LDS_PTRS + 192);
    if (threadIdx.x == 0) { xst[0] = 0u; xst[1] = 0u; }
    __syncthreads();
    (void)xcd_barrier_post((unsigned*)(p.ws + WS_BARRIER), xst);
#endif
    int ph = 0;
#define PHASE_END() do { ++ph; if (DBG_COPY && ph == DBG_PHASE) { GRID_SYNC(); Ctx c = make_ctx(p, wave0); \
        const bf16_t* src = wsp<bf16_t>(c, DBG_COPY == 1 ? WS_OUTS : DBG_COPY == 2 ? WS_ST : DBG_COPY == 3 ? WS_PROJ : DBG_COPY == 4 ? WS_HALO : DBG_COPY >= 6 ? WS_OUTS + (size_t)(DBG_COPY - 6) * NT * MW * 2 : WS_KSW); const size_t nsrc = DBG_COPY >= 6 ? (size_t)NT * MW : DBG_COPY == 2 ? 3 * ST_ONE / 2 : DBG_COPY == 4 ? (size_t)BATCH * NC * 3 * 512 + (size_t)NT * NH * 2 * 2 + (size_t)BATCH * NH * NC * 64 * 2 : (size_t)NT * DM; \
        for (size_t i = (size_t)c.bid * NTHR + c.tid; i < (size_t)NT * DM; i += (size_t)c.nblk * NTHR) c.out[i] = i < nsrc ? bf2f(src[i]) : 0.f; return; } \
        if (ph >= p.phase_hi) return; GRID_SYNC(); if (extra && ph - ph_x0 >= EXTRA_K) return; } while (0)
    int ph_x0 = 0;
    for (int it = 0; it < DEPTH + (EXTRA_K > 0 ? 1 : 0); ++it) {
        const int l = it < DEPTH ? it : 0; const bool extra = it >= DEPTH; if (extra) ph_x0 = ph;
        for (int rep = 0; rep < DUP_P0; ++rep) { Ctx c = make_ctx(p, wave0); p0_prep(c, l, extra ? P0X : 31); }
        PHASE_END();
        for (int rep = 0; rep < DUP_P1; ++rep) {
            Ctx c = make_ctx(p, wave0);
            pg8::Gemm g{wsp<bf16_t>(c, WS_XB), wsp<bf16_t>(c, WS_WIN), NT, PROJ_N, DM}; pg8::StaticOrder S; S.init(NT, PROJ_N, c.nblk, c.bid);
            pg8::EpiScaleBf16<1, true> E{wsp<bf16_t>(c, WS_PROJ), PROJ_LD, wsp<float>(c, WS_RSS1), PROJ_LD, wsp<bf16_t>(c, WS_HALO)};
            pg8::gemm_phase<pg8::EpiScaleBf16<1, true>, pg8::StaticOrder, true, true>(GEMM_LDS, g, S, E, c.tid);
        }
        PHASE_END();
        const int p2m = extra ? P2X : 15;
        if (p2m & 1) for (int rep = 0; rep < DUP_P2; ++rep) { Ctx c = make_ctx(p, wave0); for (int u = c.bid; u < 3 * BATCH * NH * NC; u += c.nblk) recur_local_unit(c, l, u); }
        if (p2m & 2) for (int rep = 0; rep < DUP_NP; ++rep) { Ctx c = make_ctx(p, wave0); for (int u = c.bid; u < BATCH * 16; u += c.nblk) nsa_compress_unit(c, l, u); }
        if (p2m & 4) for (int rep = 0; rep < DUP_NP; ++rep) { Ctx c = make_ctx(p, wave0); for (int it = c.bid; it < NT / 32; it += c.nblk) nsa_kprep_item(c, l, it); }
        if (p2m & 8) for (int rep = 0; rep < DUP_NP; ++rep) { Ctx c = make_ctx(p, wave0); for (int it = c.bid; it < BATCH * 4 * NC; it += c.nblk) nsa_vprep_item(c, it); }
        PHASE_END();
        { Ctx c = make_ctx(p, wave0); recur_scan(c); }
        PHASE_END();
        for (int rep = 0; rep < DUP_NSA; ++rep) { Ctx c = make_ctx(p, wave0);
        for (int u = c.bid; u < BATCH * 2 * NSEL; u += c.nblk) {
            const int nbg = BATCH * 2, bg = u % nbg, qi = u / nbg; int qt = qi;
            if (NSEL == 64) { const int r = qi >> 4, ql = qi & 15; qt = (r == 0) ? 63 - ql : (r == 1) ? ql : (r == 2) ? 47 - ql : 16 + ql; }
            nsa_attn_unit(c, l, bg * NSEL + qt);
        } }
        for (int rep = 0; rep < DUP_REC; ++rep) { Ctx c = make_ctx(p, wave0); for (int u = c.bid * NWAVE + c.wave; u < 3 * BATCH * NH * NC; u += c.nblk * NWAVE) recur_out_wave(c, l, u); }
        PHASE_END();
        { Ctx c = make_ctx(p, wave0); peer_table_rows(c, l); }
        for (int rep = 0; rep < DUP_P5; ++rep) {
            { Ctx c = make_ctx(p, wave0); pg8::MixOrder<true> S{(NT / 256) * 4, c.nblk, c.bid, NT / 256};
              pg8::Gemm g{wsp<bf16_t>(c, WS_OUTS), wsp<bf16_t>(c, WS_WUP), 4 * NT, 4 * DM, MW};
              pg8::EpiU E{wsp<bf16_t>(c, WS_UALL)};
              pg8::gemm_phase<pg8::EpiU, pg8::MixOrder<true>, false, true>(GEMM_LDS, g, S, E, c.tid); }
            GRID_SYNC();
            { Ctx c = make_ctx(p, wave0); pg8::MixOrder<false> S{(NT / 256) * 4, c.nblk, c.bid, NT / 256};
              pg8::Gemm g{wsp<bf16_t>(c, WS_XB), wsp<bf16_t>(c, WS_WG), NT, 4 * DM, DM};
              pg8::EpiGate E{wsp<bf16_t>(c, WS_UALL), wsp<bf16_t>(c, WS_MERGED), wsp<float>(c, WS_RSS1), NT};
              pg8::gemm_phase<pg8::EpiGate, pg8::MixOrder<false>, false, true>(GEMM_LDS, g, S, E, c.tid); }
        }
        PHASE_END();
        {
            Ctx c = make_ctx(p, wave0); const float* xres = (l == 0) ? CIN(0) : c.out;
            pg8::Gemm g{wsp<bf16_t>(c, WS_MERGED), wsp<bf16_t>(c, WS_WOUT), NT, DM, DM}; pg8::StaticOrder S; S.init(NT, DM, c.nblk, c.bid);
            pg8::EpiOut E{xres, c.out, wsp<bf16_t>(c, WS_XB), wsp<float>(c, WS_RSS2)};
            pg8::gemm_phase<pg8::EpiOut, pg8::StaticOrder, true, true>(GEMM_LDS, g, S, E, c.tid);
        }
        PHASE_END();
        {
            Ctx c = make_ctx(p, wave0);
            pg8::Gemm g{wsp<bf16_t>(c, WS_XB), wsp<bf16_t>(c, WS_WQ2), NT, PEER_N, DM}; pg8::StaticOrder S; S.init(NT, PEER_N, c.nblk, c.bid);
            pg8::EpiScaleBf16<16> E{wsp<bf16_t>(c, WS_SCORES), PEER_N, wsp<float>(c, WS_RSS2), PEER_N, nullptr};
            pg8::gemm_phase<pg8::EpiScaleBf16<16>, pg8::StaticOrder, true, true>(GEMM_LDS, g, S, E, c.tid);
        }
        PHASE_END();
        { Ctx c = make_ctx(p, wave0); peer_init_tab(c); for (int t = c.bid * NWAVE + c.wave; t < NT; t += c.nblk * NWAVE) peer_token(c, l, t); }
        PHASE_END();
    }
}

#ifndef HOST_EMU
extern "C" void kernel_launch(void* const* d_in, const int* in_sizes, int n_in, void* d_out, int out_size, void* d_ws, size_t ws_size, hipStream_t stream) {
    static int grid = 0;
    if (grid == 0) {
        if (n_in != 22 || out_size != NT * DM || ws_size < WS_NEED) { fprintf(stderr, "kernel_launch: unexpected shapes (n_in %d out %d ws %zu need %zu)\n", n_in, out_size, ws_size, (size_t)WS_NEED); grid = -1; return; }
        int dev = 0, cus = 0, per_cu = 0;
        hipGetDevice(&dev); hipDeviceGetAttribute(&cus, hipDeviceAttributeMultiprocessorCount, dev);
        if (hipFuncSetAttribute((const void*)fwd_kernel, hipFuncAttributeMaxDynamicSharedMemorySize, LDS_BYTES) != hipSuccess) { fprintf(stderr, "kernel_launch: hipFuncSetAttribute failed\n"); grid = -1; return; }
        if (hipOccupancyMaxActiveBlocksPerMultiprocessor(&per_cu, (const void*)fwd_kernel, NTHR, LDS_BYTES) != hipSuccess || per_cu < 1) { fprintf(stderr, "kernel_launch: occupancy query failed (%d)\n", per_cu); (void)hipGetLastError(); per_cu = 1; }
        grid = cus;
        fprintf(stderr, "kernel_launch: grid %d (per_cu %d)\n", grid, per_cu);
    }
    if (grid < 0) return;
    if (hipMemsetAsync((char*)d_ws + WS_BARRIER, 0, 16384, stream) != hipSuccess) { fprintf(stderr, "kernel_launch: memset failed\n"); return; }
    Params p{};
    for (int i = 0; i < 22; ++i) p.in[i] = (const float*)d_in[i];
    p.out = (float*)d_out; p.ws = (unsigned char*)d_ws; p.phase_lo = 0; p.phase_hi = 1 << 20;
    void* args[] = {&p};
    hipError_t e = hipLaunchCooperativeKernel((const void*)fwd_kernel, dim3(grid), dim3(NTHR), args, LDS_BYTES, stream);
    if (e != hipSuccess) fprintf(stderr, "kernel_launch: cooperative launch failed: %s (grid %d)\n", hipGetErrorString(e), grid);
}
#endif
```

```cpp
#ifndef HOST_EMU
#include <hip/hip_runtime.h>
#include <hip/hip_cooperative_groups.h>
#include <cstdio>
#include <cstdint>
namespace cg = cooperative_groups;
#endif

#ifndef CFG_B
#define CFG_B 8
#endif
#ifndef CFG_S
#define CFG_S 4096
#endif

constexpr int BATCH = CFG_B, SEQ = CFG_S, DM = 1024, DEPTH = 2;
constexpr int NT = BATCH * SEQ;
constexpr int NH = 4, HD = 64, MW = 256, CH = 64, NC = SEQ / CH;
constexpr int N_IN_ORIG = 4116, PROJ_N = 4352, PROJ_LD = 4128;
constexpr int NCMP = (SEQ - 32) / 16 + 1;
constexpr int NCMP_PAD = SEQ / 16;
constexpr int NSEL = SEQ / 64;
constexpr int PEER_N = 2048;
constexpr float NORM_EPS = 1e-6f;
constexpr int NTHR = 512, NWAVE = 8;
constexpr int C_HQ = 0, C_HF = 256, C_HI = 512, C_HG = 768;
constexpr int C_MQ = 1024, C_MK = 1280, C_MV = 1536, C_MO = 1792;
constexpr int C_NQ = 2048, C_NKC = 2304, C_NVC = 2432, C_NKS = 2560, C_NVS = 2688, C_NKW = 2816, C_NVW = 2944;
constexpr int C_RQ = 3072, C_RK = 3328, C_RV = 3584, C_RG = 3840;
constexpr int C_MI = 4096, C_MF = 4100, C_NG = 4104;

typedef unsigned short bf16_t;
#ifndef HOST_EMU
typedef short bf16x8 __attribute__((ext_vector_type(8)));
typedef float f32x4 __attribute__((ext_vector_type(4)));
#endif
typedef unsigned u32x4 __attribute__((ext_vector_type(4)));
typedef unsigned u32x2 __attribute__((ext_vector_type(2)));
typedef float f32x2 __attribute__((ext_vector_type(2)));

constexpr size_t al256(size_t x) { return (x + 255) & ~(size_t)255; }
constexpr size_t WS_WIN = 0;
constexpr size_t WS_WG = WS_WIN + al256((size_t)PROJ_N * DM * 2);
constexpr size_t WS_WUP = WS_WG + al256((size_t)4 * DM * DM * 2);
constexpr size_t WS_WOUT = WS_WUP + al256((size_t)4 * DM * MW * 2);
constexpr size_t WS_WQ2 = WS_WOUT + al256((size_t)DM * DM * 2);
constexpr size_t WS_WCT = WS_WQ2 + al256((size_t)PEER_N * DM * 2);
constexpr size_t WS_CBIAS = WS_WCT + al256((size_t)2 * 64 * 2048 * 2);
constexpr size_t WS_ROPE = WS_CBIAS + 1024;
constexpr size_t WS_RSS1 = WS_ROPE + al256((size_t)SEQ * 64 * 4);
constexpr size_t WS_RSS2 = WS_RSS1 + al256((size_t)NT * 4);
constexpr size_t WS_XB = WS_RSS2 + al256((size_t)NT * 16 * 4);
constexpr size_t WS_OUTS = WS_XB + al256((size_t)NT * DM * 2);
constexpr size_t WS_ST = WS_OUTS + al256((size_t)NT * DM * 2);
constexpr size_t ST_ONE = (size_t)BATCH * NH * NC * 4096 * 2;
constexpr size_t WS_GDEC = WS_ST + al256(3 * ST_ONE);
constexpr size_t WS_MNL = WS_GDEC + al256((size_t)BATCH * NH * NC * 64 * 4);
constexpr size_t WS_MSC = WS_MNL + al256((size_t)BATCH * NH * NC * 64 * 4);
constexpr size_t WS_KCMP = WS_MSC + al256((size_t)BATCH * NH * NC * 4 * 4);
constexpr size_t WS_VCMPT = WS_KCMP + al256((size_t)BATCH * 2 * NCMP_PAD * 64 * 2);
constexpr size_t WS_KSW = WS_VCMPT + al256((size_t)BATCH * 2 * NCMP_PAD * 64 * 2);
constexpr size_t WS_HALO = WS_KSW + al256((size_t)NT * 256 * 2);
constexpr size_t WS_MTS = WS_HALO + al256((size_t)BATCH * NC * 3 * 512 * 2);
constexpr size_t WS_G31 = WS_MTS + al256((size_t)NT * NH * 2 * 4);
constexpr size_t WS_PROJ = WS_G31 + al256((size_t)BATCH * NH * NC * 64 * 4);
constexpr size_t PROJ_BYTES = al256((size_t)NT * PROJ_LD * 2);
constexpr size_t WS_BARRIER = WS_PROJ + PROJ_BYTES;
constexpr size_t WS_END = WS_BARRIER + 16384;
constexpr size_t WS_UALL = WS_PROJ;
constexpr size_t WS_MERGED = WS_OUTS;
constexpr size_t WS_SCORES = WS_PROJ;
constexpr bool TABLES_IN_ST = 3 * ST_ONE >= (size_t)2 * 16384 * DM;
constexpr size_t WS_PU = TABLES_IN_ST ? WS_ST : WS_END;
constexpr size_t WS_PV = WS_PU + al256((size_t)16384 * DM);
static_assert((size_t)4 * NT * DM * 2 <= PROJ_BYTES, "U fits the proj region");
static_assert(WS_END <= (size_t)536870912, "workspace budget");
constexpr size_t WS_NEED = TABLES_IN_ST ? WS_END : WS_PV + (size_t)16384 * DM;

constexpr int LDS_BYTES = 147456;

struct Params {
    const float* in[22];
    float* out;
    unsigned char* ws;
    int phase_lo, phase_hi;
};

#ifndef HOST_EMU
#define DEV __device__ __forceinline__
#define TID() ((int)threadIdx.x)
#define BID() ((int)blockIdx.x)
#define NBLK() ((int)gridDim.x)
extern __shared__ __attribute__((aligned(16))) unsigned char smem_raw[];
#define LDSP __attribute__((address_space(3)))
#define SMEM_PTR() ((LDSP char*)smem_raw)
DEV void block_sync() { __syncthreads(); }
DEV int fresh_lane() { int lane; asm volatile("v_mbcnt_lo_u32_b32 %0, -1, 0\n\tv_mbcnt_hi_u32_b32 %0, -1, %0" : "=v"(lane)); return lane; }
template <int M> DEV int xori(int v) {
    if constexpr (M < 32) return __builtin_amdgcn_ds_swizzle(v, (M << 10) | 0x1f);
    else return __builtin_amdgcn_ds_bpermute((fresh_lane() ^ M) << 2, v);
}
template <int M> DEV float xorf(float v) { return __builtin_bit_cast(float, xori<M>(__builtin_bit_cast(int, v))); }
DEV int shfl_i(int v, int src) { return __builtin_amdgcn_ds_bpermute(src << 2, v); }
DEV float shfl_f(float v, int src) { return __builtin_bit_cast(float, __builtin_amdgcn_ds_bpermute(src << 2, __builtin_bit_cast(int, v))); }
DEV unsigned long long ballot64(bool p) { return __builtin_amdgcn_ballot_w64(p); }
DEV int mbcnt64(unsigned long long m) { return (int)__builtin_amdgcn_mbcnt_hi((unsigned)(m >> 32), __builtin_amdgcn_mbcnt_lo((unsigned)m, 0u)); }
DEV float bcast_f(float v, int j) { return __builtin_bit_cast(float, __builtin_amdgcn_readlane(__builtin_bit_cast(int, v), j)); }
DEV int bcast_i(int v, int j) { return __builtin_amdgcn_readlane(v, j); }
DEV f32x2 cvt_pk_f32_fp8(unsigned p, bool hi) { return hi ? __builtin_amdgcn_cvt_pk_f32_fp8((int)p, true) : __builtin_amdgcn_cvt_pk_f32_fp8((int)p, false); }
template <int SEL> DEV f32x2 cvt_pk_f32_fp4_(unsigned p) { return __builtin_amdgcn_cvt_scalef32_pk_f32_fp4(p, 1.0f, SEL); }
DEV f32x2 cvt_pk_f32_fp4(unsigned p, int bytesel) { return bytesel == 0 ? cvt_pk_f32_fp4_<0>(p) : bytesel == 1 ? cvt_pk_f32_fp4_<1>(p) : bytesel == 2 ? cvt_pk_f32_fp4_<2>(p) : cvt_pk_f32_fp4_<3>(p); }
DEV unsigned cvt_pk_fp8_f32(float a, float b, unsigned old, bool hi) { return hi ? (unsigned)__builtin_amdgcn_cvt_pk_fp8_f32(a, b, (int)old, true) : (unsigned)__builtin_amdgcn_cvt_pk_fp8_f32(a, b, (int)old, false); }
DEV f32x4 mfma16(bf16x8 a, bf16x8 b, f32x4 c) { return __builtin_amdgcn_mfma_f32_16x16x32_bf16(a, b, c, 0, 0, 0); }
typedef int i32x8 __attribute__((ext_vector_type(8)));
DEV f32x4 mfma_fp4_fp8(u32x4 a, u32x4 b0, u32x4 b1, f32x4 c) {
    const i32x8 av = {(int)a.x, (int)a.y, (int)a.z, (int)a.w, 0, 0, 0, 0}, bv = {(int)b0.x, (int)b0.y, (int)b0.z, (int)b0.w, (int)b1.x, (int)b1.y, (int)b1.z, (int)b1.w};
    return __builtin_amdgcn_mfma_scale_f32_16x16x128_f8f6f4(av, bv, c, 4, 0, 0, 127, 0, 127);
}
DEV void atomic_add_f32(float* p, float v) { atomicAdd(p, v); }
DEV float fast_exp(float x) { return __expf(x); }
DEV float fast_exp2(float x) { return __builtin_amdgcn_exp2f(x); }
DEV float fast_log(float x) { return __logf(x); }
DEV float fast_rcp(float x) { return __builtin_amdgcn_rcpf(x); }
DEV float fast_rsqrt(float x) { return __builtin_amdgcn_rsqf(x); }
#else
#define DEV static inline
#define LDSP
#endif

#ifndef HOST_EMU
DEV void wave_sync() { __builtin_amdgcn_fence(__ATOMIC_ACQ_REL, "wavefront"); __builtin_amdgcn_wave_barrier(); }
#else
static inline void wave_sync() { emu_bar_wait(emu_wave().bar, 64); }
#endif
DEV float bf2f(bf16_t v) { unsigned u = ((unsigned)v) << 16; return __builtin_bit_cast(float, u); }
DEV bf16_t f2bf(float f) { unsigned u = __builtin_bit_cast(unsigned, f); return (bf16_t)((u + 0x7fffu + ((u >> 16) & 1u)) >> 16); }
#ifndef HOST_EMU
typedef __bf16 bf16x2_hw __attribute__((ext_vector_type(2)));
DEV unsigned pk2(float lo, float hi) { const f32x2 v = {lo, hi}; return __builtin_bit_cast(unsigned, __builtin_convertvector(v, bf16x2_hw)); }
#else
DEV unsigned pk2(float lo, float hi) { return (unsigned)f2bf(lo) | ((unsigned)f2bf(hi) << 16); }
#endif
DEV float bflo(unsigned u) { return __builtin_bit_cast(float, u << 16); }
DEV float bfhi(unsigned u) { return __builtin_bit_cast(float, u & 0xffff0000u); }
DEV float sigmoidf_(float x) { return fast_rcp(1.0f + fast_exp(-x)); }
DEV float siluf_(float x) { return x * sigmoidf_(x); }
DEV float log_sigmoidf_(float x) { return fminf(x, 0.f) - log1pf(fast_exp(-fabsf(x))); }
DEV unsigned sortkey32(float f) { const unsigned u = __builtin_bit_cast(unsigned, f); return (u & 0x80000000u) ? ~u : (u | 0x80000000u); }
DEV unsigned fp4_code(float x) {
    const float a = fabsf(x); unsigned c = (a > 0.25f) + (a > 0.75f) + (a > 1.25f) + (a > 1.75f) + (a > 2.5f) + (a > 3.5f) + (a > 5.0f); return c | (x < 0.f ? 8u : 0u);
}
DEV float wave_sum(float v) { v += xorf<1>(v); v += xorf<2>(v); v += xorf<4>(v); v += xorf<8>(v); v += xorf<16>(v); v += xorf<32>(v); return v; }
DEV float wave_max(float v) { v = fmaxf(v, xorf<1>(v)); v = fmaxf(v, xorf<2>(v)); v = fmaxf(v, xorf<4>(v)); v = fmaxf(v, xorf<8>(v)); v = fmaxf(v, xorf<16>(v)); v = fmaxf(v, xorf<32>(v)); return v; }
DEV float gelu_erf(float v) {
    const float av = fabsf(v), t = fast_rcp(1.0f + 0.2316418882f * av);
    float q = t * 0.5307027145f + (-0.7265760135f); q = q * t + 0.7107068705f; q = q * t + (-0.142248368f); q = q * t + 0.127414796f; q = q * t;
    const float e = fast_exp2(v * v * (-0.72134752044f));
    const float m = v * (q * e);
    return v < 0.f ? m : v - m;
}
#ifndef HOST_EMU
#define DEV_M __device__ __forceinline__
#else
#define DEV_M inline
#endif
namespace pg8 {
#define PG8_LAS __attribute__((address_space(3)))
constexpr int BM = 256, BK = 64, HALF = 128, HTB = HALF * BK * 2  , STAGE_BYTES = 8 * HTB, NXCD = 8, WGM = 8;

__host__ __device__ __forceinline__ int lds_byte(int r, int c) { const int st = (r >> 4) * 2 + (c >> 5), rr = r & 15, cc = c & 31, ob = rr * 64 + cc * 2; return st * 1024 + (ob ^ (((ob >> 9) & 1) << 5)); }
__host__ __device__ __forceinline__ void stage_rc(int b, int& R, int& C) { const int st = b / 1024, sb = b % 1024, swz = sb ^ (((sb >> 9) & 1) << 5); R = (st >> 1) * 16 + swz / 64; C = (st & 1) * 32 + (swz % 64) / 2; }
__host__ __device__ __forceinline__ int perm32(int rho) { const int n = rho >> 4, i = rho & 15; return 8 * (i >> 2) + 4 * n + (i & 3); }

struct Unit { int pm, pn; };
struct Gemm { const bf16_t* A; const bf16_t* Bt; int M, N, K; };

struct StaticOrder {
    int nM, nN, nwg, G, c;
    __host__ __device__ void init(int M, int N, int G_, int c_) { nM = M / BM; nN = N / BM; nwg = nM * nN; G = G_; c = c_; }
    __host__ __device__ bool next(int i, Unit& u) const {
        const long L = (long)i * G + c; if (L >= nwg) return false;
        int wgid = (int)L; { const int q = nwg / NXCD, r = nwg % NXCD, xcd = wgid % NXCD, off = wgid / NXCD; wgid = (xcd < r ? xcd * (q + 1) : r * (q + 1) + (xcd - r) * q) + off; }
        const int nig = WGM * nN, gid = wgid / nig, fm = gid * WGM, gsz = (nM - fm) < WGM ? (nM - fm) : WGM;
        u.pm = fm + ((wgid % nig) % gsz); u.pn = (wgid % nig) / gsz; return true;
    }
    DEV_M void a_ready(const Unit&) const {}
    DEV_M void done(const Unit&) const {}
};


#ifndef HOST_EMU
template <class Epi, class Sched, bool ALIGN_EPI = false, bool SP2 = false>
__device__ __forceinline__ void gemm_phase(PG8_LAS unsigned char* lds, const Gemm g, const Sched& S, const Epi& E, const int tid_in) {
    const int tid = tid_in, wid = __builtin_amdgcn_readfirstlane(tid >> 6), lane = tid & 63, wr = wid >> 2, wc = wid & 3, fr = lane & 15, fq = lane >> 4;
    const int K = g.K, nt = K / BK;
    unsigned voffA[2], voffB[2];
#pragma unroll
    for (int i = 0; i < 2; ++i) { int R, C; stage_rc(tid * 16 + i * 8192, R, C); const int Rb = Epi::PERM ? ((R & ~31) + perm32(R & 31)) : R;
        voffA[i] = (unsigned)(R * K + C) * 2u; voffB[i] = (unsigned)(Rb * K + C) * 2u; }
    const size_t kstep = (size_t)(BK * 2);
    const size_t hstep = (size_t)HALF * K * 2;
    const size_t tstep = 2 * hstep;
    const unsigned ldsw = (unsigned)wid * 1024u;
    const int aoff = lds_byte(wr * 64 + fr, fq * 8), boff = lds_byte(wc * 32 + fr, fq * 8);
#define PG8_SA(b, h) (((b) * 2 + (h)) * HTB)
#define PG8_SB(b, h) ((4 + (b) * 2 + (h)) * HTB)
#define PG8_STAGE(bufoff, gbase, voff) do { _Pragma("unroll") for (int _i = 0; _i < 2; ++_i) \
        __builtin_amdgcn_global_load_lds((const unsigned*)((const char*)(gbase) + (voff)[_i]), (PG8_LAS unsigned*)(lds + (bufoff) + ldsw + _i * 8192), 16, 0, 0); } while (0)
#define PG8_LDA(dst, b, h) do { _Pragma("unroll") for (int m = 0; m < 4; ++m) _Pragma("unroll") for (int k = 0; k < 2; ++k) dst[m][k] = *(const PG8_LAS bf16x8*)(lds + PG8_SA(b, h) + aoff + m * 2048 + k * 1024); } while (0)
#define PG8_LDB(dst, b, h) do { _Pragma("unroll") for (int n = 0; n < 2; ++n) _Pragma("unroll") for (int k = 0; k < 2; ++k) dst[n][k] = *(const PG8_LAS bf16x8*)(lds + PG8_SB(b, h) + boff + n * 2048 + k * 1024); } while (0)
#define PG8_MMA(ai, bj, At, Bt) do { __builtin_amdgcn_s_setprio(1); _Pragma("unroll") for (int m = 0; m < 4; ++m) _Pragma("unroll") for (int n = 0; n < 2; ++n) _Pragma("unroll") for (int k = 0; k < 2; ++k) \
        acc[ai][bj][m][n] = __builtin_amdgcn_mfma_f32_16x16x32_bf16(Bt[n][k], At[m][k], acc[ai][bj][m][n], 0, 0, 0); __builtin_amdgcn_s_setprio(0); } while (0)
#define PG8_WAIT_V(n) asm volatile("s_waitcnt vmcnt(" #n ")" ::: "memory")
#define PG8_WAIT_L(n) asm volatile("s_waitcnt lgkmcnt(" #n ")" ::: "memory")
#define PG8_BAR __builtin_amdgcn_s_barrier()
#define PG8_SCHED __builtin_amdgcn_sched_barrier(0)
    Unit cur, nxt; int ui = 0;
    if (!S.next(0, cur)) return;
    f32x4 acc[2][2][4][2];
#pragma unroll
    for (int a = 0; a < 2; ++a)
#pragma unroll
        for (int b = 0; b < 2; ++b)
#pragma unroll
            for (int m = 0; m < 4; ++m)
#pragma unroll
                for (int n = 0; n < 2; ++n) acc[a][b][m][n] = (f32x4){0.f, 0.f, 0.f, 0.f};
    bf16x8 At[4][2], B0[2][2], B1[2][2];
    const char* cA = (const char*)g.A + (size_t)cur.pm * tstep; const char* cB = (const char*)g.Bt + (size_t)cur.pn * tstep;
    S.a_ready(cur);
    if constexpr (SP2) {
        PG8_STAGE(PG8_SB(0, 0), cB, voffB); PG8_STAGE(PG8_SB(0, 1), cB + hstep, voffB); PG8_STAGE(PG8_SA(0, 0), cA, voffA); PG8_STAGE(PG8_SA(0, 1), cA + hstep, voffA);
        if (wr == 1) PG8_BAR;
        PG8_WAIT_V(2); PG8_BAR;
        PG8_STAGE(PG8_SB(1, 0), cB + kstep, voffB); PG8_STAGE(PG8_SA(1, 0), cA + kstep, voffA); PG8_STAGE(PG8_SB(1, 1), cB + hstep + kstep, voffB);
        PG8_WAIT_V(6); PG8_BAR;
    } else {
        PG8_STAGE(PG8_SB(0, 0), cB, voffB); PG8_STAGE(PG8_SA(0, 0), cA, voffA); PG8_STAGE(PG8_SB(0, 1), cB + hstep, voffB); PG8_STAGE(PG8_SA(0, 1), cA + hstep, voffA);
        if (wr == 1) PG8_BAR;
        PG8_WAIT_V(4); PG8_BAR;
        PG8_STAGE(PG8_SB(1, 0), cB + kstep, voffB); PG8_STAGE(PG8_SA(1, 0), cA + kstep, voffA); PG8_STAGE(PG8_SB(1, 1), cB + hstep + kstep, voffB);
        PG8_WAIT_V(6); PG8_BAR;
    }
    for (;;) {
        const bool has_next = S.next(ui + 1, nxt);
        const char* nA = has_next ? (const char*)g.A + (size_t)nxt.pm * tstep : cA; const char* nB = has_next ? (const char*)g.Bt + (size_t)nxt.pn * tstep : cB;
        for (int t = 0; t < nt; t += 2) {
            const bool last = (t == nt - 2);
            const char* a1 = cA + (size_t)(t + 1) * kstep;
            const char* a2 = last ? nA : cA + (size_t)(t + 2) * kstep; const char* b2 = last ? nB : cB + (size_t)(t + 2) * kstep;
            const char* a3 = a2 + kstep; const char* b3 = b2 + kstep;
            if (last && has_next) S.a_ready(nxt);
            if constexpr (SP2) {
            PG8_LDB(B0, 0, 0); PG8_LDB(B1, 0, 1); PG8_SCHED; PG8_LDA(At, 0, 0); PG8_STAGE(PG8_SA(1, 1), a1 + hstep, voffA);
            PG8_WAIT_V(8); PG8_WAIT_L(0); PG8_BAR; PG8_MMA(0, 0, At, B0); PG8_MMA(0, 1, At, B1); PG8_BAR; PG8_SCHED;
            PG8_LDA(At, 0, 1); PG8_STAGE(PG8_SB(0, 0), b2, voffB); PG8_STAGE(PG8_SB(0, 1), b2 + hstep, voffB); PG8_STAGE(PG8_SA(0, 0), a2, voffA);
            PG8_WAIT_V(8); PG8_WAIT_L(0); PG8_BAR; PG8_MMA(1, 0, At, B0); PG8_MMA(1, 1, At, B1); PG8_BAR; PG8_SCHED;
            PG8_LDB(B0, 1, 0); PG8_LDB(B1, 1, 1); PG8_SCHED; PG8_LDA(At, 1, 0); PG8_STAGE(PG8_SA(0, 1), a2 + hstep, voffA);
            PG8_WAIT_V(8); PG8_WAIT_L(0); PG8_BAR; PG8_MMA(0, 0, At, B0); PG8_MMA(0, 1, At, B1); PG8_BAR; PG8_SCHED;
            PG8_LDA(At, 1, 1); PG8_STAGE(PG8_SB(1, 0), b3, voffB); PG8_STAGE(PG8_SB(1, 1), b3 + hstep, voffB); PG8_STAGE(PG8_SA(1, 0), a3, voffA);
            PG8_WAIT_V(8); PG8_WAIT_L(0); PG8_BAR; PG8_MMA(1, 0, At, B0); PG8_MMA(1, 1, At, B1); PG8_BAR; PG8_SCHED;
            } else {
            PG8_LDB(B0, 0, 0); PG8_SCHED; PG8_LDA(At, 0, 0); PG8_STAGE(PG8_SA(1, 1), a1 + hstep, voffA);
            PG8_WAIT_L(8); PG8_BAR; PG8_WAIT_L(0); PG8_MMA(0, 0, At, B0); PG8_BAR; PG8_SCHED;
            PG8_LDB(B1, 0, 1); PG8_STAGE(PG8_SB(0, 0), b2, voffB);
            PG8_BAR; PG8_WAIT_L(0); PG8_MMA(0, 1, At, B1); PG8_BAR;
            PG8_LDA(At, 0, 1); PG8_STAGE(PG8_SA(0, 0), a2, voffA);
            PG8_BAR; PG8_WAIT_L(0); PG8_MMA(1, 0, At, B0); PG8_BAR; PG8_SCHED;
            PG8_STAGE(PG8_SB(0, 1), b2 + hstep, voffB);
            PG8_WAIT_V(6); PG8_BAR; PG8_MMA(1, 1, At, B1); PG8_BAR;
            PG8_LDB(B0, 1, 0); PG8_SCHED; PG8_LDA(At, 1, 0); PG8_STAGE(PG8_SA(0, 1), a2 + hstep, voffA);
            PG8_WAIT_L(8); PG8_BAR; PG8_WAIT_L(0); PG8_MMA(0, 0, At, B0); PG8_BAR; PG8_SCHED;
            PG8_LDB(B1, 1, 1); PG8_STAGE(PG8_SB(1, 0), b3, voffB);
            PG8_BAR; PG8_WAIT_L(0); PG8_MMA(0, 1, At, B1); PG8_BAR;
            PG8_LDA(At, 1, 1); PG8_STAGE(PG8_SA(1, 0), a3, voffA);
            PG8_BAR; PG8_WAIT_L(0); PG8_MMA(1, 0, At, B0); PG8_BAR; PG8_SCHED;
            PG8_STAGE(PG8_SB(1, 1), b3 + hstep, voffB);
            PG8_WAIT_V(6); PG8_BAR; PG8_MMA(1, 1, At, B1); PG8_BAR;
            }
        }
        if constexpr (ALIGN_EPI) { if (wr == 0) PG8_BAR; }
        if constexpr (!Epi::AFTER_DRAIN) { E(acc, cur, wr, wc, fr, fq); S.done(cur); }
        if (!has_next) break;
#pragma unroll
        for (int a = 0; a < 2; ++a)
#pragma unroll
            for (int b = 0; b < 2; ++b)
#pragma unroll
                for (int m = 0; m < 4; ++m)
#pragma unroll
                    for (int n = 0; n < 2; ++n) acc[a][b][m][n] = (f32x4){0.f, 0.f, 0.f, 0.f};
        cur = nxt; cA = nA; cB = nB; ++ui;
        if constexpr (ALIGN_EPI) { if (wr == 1) PG8_BAR; }
    }
    PG8_WAIT_V(0);
    if constexpr (!ALIGN_EPI) { if (wr == 0) PG8_BAR; }
    PG8_BAR;
    if constexpr (Epi::AFTER_DRAIN) { E.fused(acc, cur, wr, wc, fr, fq, lds, wid, lane); S.done(cur); }
#undef PG8_SA
#undef PG8_SB
#undef PG8_STAGE
#undef PG8_LDA
#undef PG8_LDB
#undef PG8_MMA
#undef PG8_WAIT_V
#undef PG8_WAIT_L
#undef PG8_BAR
#undef PG8_SCHED
}
#else
template <class Epi, class Sched, bool ALIGN_EPI = false, bool SP2 = false>
inline void gemm_phase(void* lds, const Gemm g, const Sched& S, const Epi& E, const int tid_in) {
    const int tid = TID(), wid = tid >> 6, lane = tid & 63, wr = wid >> 2, wc = wid & 3, fr = lane & 15, fq = lane >> 4;
    Unit u;
    for (int ui = 0; S.next(ui, u); ++ui) {
        f32x4 acc[2][2][4][2];
        for (int ai = 0; ai < 2; ++ai) for (int bj = 0; bj < 2; ++bj) for (int m = 0; m < 4; ++m) for (int n = 0; n < 2; ++n) for (int j = 0; j < 4; ++j) {
            const int r = 256 * u.pm + 128 * ai + 64 * wr + 16 * m + fr;
            const int c = 256 * u.pn + 128 * bj + 32 * wc + (Epi::PERM ? (8 * fq + 4 * n + j) : (16 * n + 4 * fq + j));
            const bf16_t* a = g.A + (size_t)r * g.K; const bf16_t* b = g.Bt + (size_t)c * g.K;
            float s = 0.f; for (int k = 0; k < g.K; ++k) s += bf2f(a[k]) * bf2f(b[k]);
            acc[ai][bj][m][n][j] = s;
        }
        E(acc, u, wr, wc, fr, fq);
    }
    block_sync();
}
#endif
#ifndef HOST_EMU
#define EPI_LAUNDER(wr, wc, fr, fq) asm volatile("" : "+s"(wr), "+s"(wc), "+v"(fr), "+v"(fq))
#else
#define EPI_LAUNDER(wr, wc, fr, fq) do {} while (0)
#endif
DEV_M float rstd_of(float ss) { return fast_rsqrt(ss * (1.0f / 1024.0f) + NORM_EPS); }

DEV_M float rss_slots16(const float* p) {
    const f32x4 a = *(const f32x4*)p, b = *(const f32x4*)(p + 4), c = *(const f32x4*)(p + 8), d = *(const f32x4*)(p + 12);
    return (((a[0] + a[1]) + (a[2] + a[3])) + ((b[0] + b[1]) + (b[2] + b[3]))) + (((c[0] + c[1]) + (c[2] + c[3])) + ((d[0] + d[1]) + (d[2] + d[3])));
}
template <int SLOTS, bool HALO = false> struct EpiScaleBf16 {
    static constexpr bool PERM = true, AFTER_DRAIN = false;
    bf16_t* O; int ldc; const float* rss; int ncols; bf16_t* halo;
    DEV_M void operator()(const f32x4 (&acc)[2][2][4][2], const Unit& u, int wr, int wc, int fr, int fq) const {
        EPI_LAUNDER(wr, wc, fr, fq);
        const int row0 = u.pm * BM + wr * 64 + fr, col0 = u.pn * BM + wc * 32 + 8 * fq;
        float scv[2][4];
#pragma unroll
        for (int ai = 0; ai < 2; ++ai)
#pragma unroll
            for (int m = 0; m < 4; ++m) { const int row = row0 + ai * HALF + m * 16; scv[ai][m] = SLOTS == 1 ? rss[row] : 0.f; }
#pragma unroll
        for (int ai = 0; ai < 2; ++ai)
#pragma unroll
            for (int m = 0; m < 4; ++m) {
                const int row = row0 + ai * HALF + m * 16; const float sc = rstd_of(SLOTS == 1 ? scv[ai][m] : rss_slots16(rss + (size_t)row * 16));
                bf16_t* rowp = O + (size_t)row * ldc + col0;
#pragma unroll
                for (int bj = 0; bj < 2; ++bj) {
                    if (col0 + bj * HALF < ncols) {
                        const f32x4 v0 = acc[ai][bj][m][0] * sc, v1 = acc[ai][bj][m][1] * sc;
                        u32x4 w; w.x = pk2(v0[0], v0[1]); w.y = pk2(v0[2], v0[3]); w.z = pk2(v1[0], v1[1]); w.w = pk2(v1[2], v1[3]);
                        *(u32x4*)(rowp + bj * HALF) = w;
                        if (HALO) { const int cc = col0 + bj * HALF - C_MQ; if ((row & 63) >= 61 && cc >= 0 && cc < 512) *(u32x4*)(halo + ((size_t)(row >> 6) * 3 + ((row & 63) - 61)) * 512 + cc) = w; }
                    }
                }
            }
    }
};
struct EpiU {
    static constexpr bool PERM = true, AFTER_DRAIN = false;
    bf16_t* uall;
    DEV_M void operator()(const f32x4 (&acc)[2][2][4][2], const Unit& u, int wr, int wc, int fr, int fq) const {
        EPI_LAUNDER(wr, wc, fr, fq);
        bf16_t* base = uall + (size_t)(u.pm * BM + wr * 64 + fr) * DM + (u.pn & 3) * BM + wc * 32 + 8 * fq;
#pragma unroll
        for (int ai = 0; ai < 2; ++ai)
#pragma unroll
            for (int m = 0; m < 4; ++m)
#pragma unroll
                for (int bj = 0; bj < 2; ++bj) {
                    const f32x4 v0 = acc[ai][bj][m][0], v1 = acc[ai][bj][m][1];
                    u32x4 w; w.x = pk2(v0[0], v0[1]); w.y = pk2(v0[2], v0[3]); w.z = pk2(v1[0], v1[1]); w.w = pk2(v1[2], v1[3]);
                    *(u32x4*)(base + (size_t)(ai * HALF + m * 16) * DM + bj * HALF) = w;
                }
    }
};
struct EpiGate {
    static constexpr bool PERM = true, AFTER_DRAIN = false;
    const bf16_t* uall; bf16_t* merged; const float* rss; int nrows;
    DEV_M void operator()(const f32x4 (&acc)[2][2][4][2], const Unit& u, int wr, int wc, int fr, int fq) const {
        EPI_LAUNDER(wr, wc, fr, fq);
        const int mi = u.pn >> 2, pn = u.pn & 3, row0 = u.pm * BM + wr * 64 + fr, col0 = pn * BM + wc * 32 + 8 * fq;
        const bf16_t* ub = uall + ((size_t)mi * nrows + row0) * DM + col0;
#pragma unroll
        for (int ai = 0; ai < 2; ++ai) {
            u32x4 uv[4][2], pv[4][2]; float sc[4];
#pragma unroll
            for (int m = 0; m < 4; ++m) { const int row = row0 + ai * HALF + m * 16; sc[m] = rss[row];
#pragma unroll
                for (int bj = 0; bj < 2; ++bj) { uv[m][bj] = *(const u32x4*)(ub + (size_t)(ai * HALF + m * 16) * DM + bj * HALF);
                    pv[m][bj] = (u32x4){0u, 0u, 0u, 0u}; if (mi != 0) pv[m][bj] = *(const u32x4*)(merged + (size_t)row * DM + col0 + bj * HALF); } }
#pragma unroll
            for (int m = 0; m < 4; ++m) { const int row = row0 + ai * HALF + m * 16; const float s = rstd_of(sc[m]);
#pragma unroll
                for (int bj = 0; bj < 2; ++bj) {
                    const u32x4 u4 = uv[m][bj], p4 = pv[m][bj];
                    const f32x4 a0 = acc[ai][bj][m][0] * s, a1 = acc[ai][bj][m][1] * s;
                    float r[8];
                    r[0] = sigmoidf_(a0[0]) * bflo(u4.x) + bflo(p4.x); r[1] = sigmoidf_(a0[1]) * bfhi(u4.x) + bfhi(p4.x);
                    r[2] = sigmoidf_(a0[2]) * bflo(u4.y) + bflo(p4.y); r[3] = sigmoidf_(a0[3]) * bfhi(u4.y) + bfhi(p4.y);
                    r[4] = sigmoidf_(a1[0]) * bflo(u4.z) + bflo(p4.z); r[5] = sigmoidf_(a1[1]) * bfhi(u4.z) + bfhi(p4.z);
                    r[6] = sigmoidf_(a1[2]) * bflo(u4.w) + bflo(p4.w); r[7] = sigmoidf_(a1[3]) * bfhi(u4.w) + bfhi(p4.w);
                    u32x4 w; w.x = pk2(r[0], r[1]); w.y = pk2(r[2], r[3]); w.z = pk2(r[4], r[5]); w.w = pk2(r[6], r[7]);
                    *(u32x4*)(merged + (size_t)row * DM + col0 + bj * HALF) = w;
                } }
        }
    }
};
struct EpiOut {
    static constexpr bool PERM = false, AFTER_DRAIN = false;
    const float* xres; float* out; bf16_t* xb; float* rss;
    DEV_M void operator()(const f32x4 (&acc)[2][2][4][2], const Unit& u, int wr, int wc, int fr, int fq) const {
        EPI_LAUNDER(wr, wc, fr, fq);
        const int row0 = u.pm * BM + wr * 64 + fr, col0 = u.pn * BM + wc * 32 + 4 * fq;
#pragma unroll
        for (int ah = 0; ah < 4; ++ah) { const int ai = ah >> 1, m0 = (ah & 1) * 2;
            f32x4 xr[4][2][2];
#pragma unroll
            for (int m = m0; m < m0 + 2; ++m)
#pragma unroll
                for (int bj = 0; bj < 2; ++bj)
#pragma unroll
                    for (int n = 0; n < 2; ++n) xr[m][bj][n] = *(const f32x4*)(xres + (size_t)(row0 + ai * HALF + m * 16) * DM + col0 + bj * HALF + n * 16);
#pragma unroll
            for (int m = m0; m < m0 + 2; ++m) {
                const int row = row0 + ai * HALF + m * 16; const size_t off = (size_t)row * DM + col0; float ss = 0.f;
#pragma unroll
                for (int bj = 0; bj < 2; ++bj)
#pragma unroll
                    for (int n = 0; n < 2; ++n) {
                        const size_t o = off + bj * HALF + n * 16;
                        const f32x4 v = xr[m][bj][n] + acc[ai][bj][m][n];
                        *(f32x4*)(out + o) = v;
                        u32x2 w; w.x = pk2(v[0], v[1]); w.y = pk2(v[2], v[3]);
                        *(u32x2*)(xb + o) = w;
                        ss += (v[0] * v[0] + v[1] * v[1]) + (v[2] * v[2] + v[3] * v[3]);
                    }
                ss += xorf<16>(ss); ss += xorf<32>(ss);
                if (fq == 0) rss[(size_t)row * 16 + u.pn * 4 + wc] = ss;
            }
        }
    }
};
template <bool STACK_A> struct MixOrder {
    int ntiles, G, c, nM;
    DEV_M bool next(int i, Unit& u) const { const long t = (long)(i >> 2) * G + c; if (t >= ntiles) return false; const int m = i & 3;
        u.pm = (int)(t >> 2) + (STACK_A ? m * nM : 0); u.pn = m * 4 + (int)(t & 3); return true; }
    DEV_M void a_ready(const Unit&) const {}
    DEV_M void done(const Unit&) const {}
};
}
#ifndef HOST_EMU
#define GEMM_LDS ((PG8_LAS unsigned char*)smem_raw)
#else
#define GEMM_LDS ((void*)nullptr)
#endif
struct Ctx {
    float* out; unsigned char* ws; LDSP char* lds; int tid, lane, wave, bid, nblk;
};
constexpr int LDS_PTRS = LDS_BYTES - 256;
#ifndef HOST_EMU
DEV const float* inptr(const Ctx& c, int i) { const unsigned long long v = ((volatile LDSP unsigned long long*)(c.lds + LDS_PTRS))[i];
    const unsigned lo = __builtin_amdgcn_readfirstlane((unsigned)v), hi = __builtin_amdgcn_readfirstlane((unsigned)(v >> 32)); return (const float*)(const __attribute__((address_space(1))) float*)(((unsigned long long)hi << 32) | lo); }
#else
static inline const float* inptr(const Ctx& c, int i) { return ((const float* volatile*)(c.lds + LDS_PTRS))[i]; }
#endif
#define CIN(i) inptr(c, (i))
template <class T> DEV T* wsp(const Ctx& c, size_t off) { return (T*)(c.ws + off); }
DEV int orig_col(int n) {
    if (n < 1792) return n;
    if (n < 2048) return 1800 + (n - 1792);
    if (n < 3072) return 2056 + (n - 2048);
    if (n < 4096) return 3092 + (n - 3072);
    if (n < 4104) return 1792 + (n - 4096);
    if (n < 4116) return 3080 + (n - 4104);
    return -1;
}

template <class F> DEV void transpose_wave(const Ctx& c, F src, bf16_t* dst, int ldd, int k0, int n0) {
    LDSP float* tile = (LDSP float*)(c.lds + c.wave * 16640);
#pragma unroll
    for (int kb = 0; kb < 64; kb += 16) {
        float tv[16];
#pragma unroll
        for (int j = 0; j < 16; ++j) tv[j] = src(k0 + kb + j, n0 + c.lane);
#pragma unroll
        for (int j = 0; j < 16; ++j) tile[c.lane * 65 + kb + j] = tv[j];
    }
    wave_sync();
    const int k2 = (c.lane & 31) * 2, nh = c.lane >> 5;
#pragma unroll 8
    for (int j = 0; j < 32; ++j) { const int n = 2 * j + nh; *(unsigned*)(dst + (size_t)(n0 + n) * ldd + k0 + k2) = pk2(tile[n * 65 + k2], tile[n * 65 + k2 + 1]); }
    wave_sync();
}
DEV bf16x8 cvt8(const f32x4 a, const f32x4 b, float s) { const u32x4 w = {pk2(a[0] * s, a[1] * s), pk2(a[2] * s, a[3] * s), pk2(b[0] * s, b[1] * s), pk2(b[2] * s, b[3] * s)}; return __builtin_bit_cast(bf16x8, w); }

DEV void p0_prep(const Ctx& c, int l, int mask = 31) {
    const float* g1 = CIN(1) + (size_t)l * DM;
    const float* g2 = CIN(17) + (size_t)l * DM;
    constexpr int I_IN = (PROJ_N / 64) * 16, I_G = 4 * 16 * 16, I_UP = 4 * 16 * 4, I_OUT = 16 * 16, I_WC = 2 * 32, I_TR = I_IN + I_G + I_UP + I_OUT + I_WC;
    constexpr int I_WQ = 16 * 16 * 8;
    if (mask & 1)
    for (int it = c.bid * NWAVE + c.wave; it < I_TR; it += c.nblk * NWAVE) {
        int r = it;
        if (r < I_IN) {
            const float* w = CIN(2) + (size_t)l * DM * N_IN_ORIG; const int nt = r / 16, kt = r % 16;
            transpose_wave(c, [=](int k, int n) { const int oc = orig_col(n); return oc < 0 ? 0.f : w[(size_t)k * N_IN_ORIG + oc] * g1[k]; }, wsp<bf16_t>(c, WS_WIN), DM, kt * 64, nt * 64);
            continue;
        } r -= I_IN;
        if (r < I_G) {
            const int m = r / 256, nt = (r % 256) / 16, kt = r % 16; const float* w = CIN(15) + ((size_t)l * 4 + m) * DM * DM;
            transpose_wave(c, [=](int k, int n) { return w[(size_t)k * DM + n] * g1[k]; }, wsp<bf16_t>(c, WS_WG) + (size_t)m * DM * DM, DM, kt * 64, nt * 64);
            continue;
        } r -= I_G;
        if (r < I_UP) {
            const int m = r / 64, nt = (r % 64) / 4, kt = r % 4; const float* w = CIN(14) + ((size_t)l * 4 + m) * MW * DM;
            transpose_wave(c, [=](int k, int n) { return w[(size_t)k * DM + n]; }, wsp<bf16_t>(c, WS_WUP) + (size_t)m * DM * MW, MW, kt * 64, nt * 64);
            continue;
        } r -= I_UP;
        if (r < I_OUT) {
            const int nt = r / 16, kt = r % 16; const float* w = CIN(16) + (size_t)l * DM * DM;
            transpose_wave(c, [=](int k, int n) { return w[(size_t)k * DM + n]; }, wsp<bf16_t>(c, WS_WOUT), DM, kt * 64, nt * 64);
            continue;
        } r -= I_OUT;
        {
            const int kv = r / 32, kt = r % 32; const float* w = CIN(12) + ((size_t)l * 2 + kv) * 2048 * 64;
            transpose_wave(c, [=](int k, int n) { return w[(size_t)k * 64 + n]; }, wsp<bf16_t>(c, WS_WCT) + (size_t)kv * 64 * 2048, 2048, kt * 64, 0);
        }
    }
    if (mask & 2)
    for (int it = c.bid * NWAVE + c.wave; it < I_WQ; it += c.nblk * NWAVE) {
        const int keyt = it & 7, kt = (it >> 3) & 15, hp = it >> 7, fr = c.lane & 15, fq = c.lane >> 4;
        const float* keys = CIN(19) + (((size_t)l * 16 + hp) * 128 + keyt * 16 + fr) * 128; const float* wq = CIN(18) + (size_t)l * DM * PEER_N + hp * 128;
        bf16x8 kb[4];
#pragma unroll
        for (int ds = 0; ds < 4; ++ds) kb[ds] = cvt8(*(const f32x4*)(keys + 32 * ds + 8 * fq), *(const f32x4*)(keys + 32 * ds + 8 * fq + 4), 1.0f);
#pragma unroll
        for (int tile = 0; tile < 4; ++tile) { const int k = kt * 64 + tile * 16 + fr; const float gk = g2[k]; const float* wr = wq + (size_t)k * PEER_N;
            f32x4 acc = {0.f, 0.f, 0.f, 0.f};
#pragma unroll
            for (int ds = 0; ds < 4; ++ds) acc = mfma16(cvt8(*(const f32x4*)(wr + 32 * ds + 8 * fq), *(const f32x4*)(wr + 32 * ds + 8 * fq + 4), gk), kb[ds], acc);
            u32x2 w; w.x = pk2(acc[0], acc[1]); w.y = pk2(acc[2], acc[3]);
            *(u32x2*)(wsp<bf16_t>(c, WS_WQ2) + (size_t)(hp * 128 + keyt * 16 + fr) * DM + kt * 64 + tile * 16 + fq * 4) = w; }
    }
    if (mask & 4)
    for (int kv = c.bid; kv < 2; kv += c.nblk) {
        const float* w = CIN(12) + ((size_t)l * 2 + kv) * 2048 * 64; const float* pe = CIN(11) + ((size_t)l * 2 + kv) * 2048;
        LDSP float* red = (LDSP float*)c.lds;
        block_sync();
        const int e = c.tid & 63, part = c.tid >> 6; float s = 0.f;
#pragma unroll 16
        for (int kk = part * 256; kk < part * 256 + 256; ++kk) s += pe[kk] * w[(size_t)kk * 64 + e];
        red[part * 64 + e] = s;
        block_sync();
        if (c.tid < 64) { float t = 0.f; for (int pp = 0; pp < 8; ++pp) t += red[pp * 64 + c.tid]; wsp<float>(c, WS_CBIAS)[kv * 64 + c.tid] = t; }
        block_sync();
    }
    if (l == 0 && (mask & 8)) {
        const float* x = CIN(0); bf16_t* xb = wsp<bf16_t>(c, WS_XB); float* rss = wsp<float>(c, WS_RSS1);
        for (int row = c.bid * NWAVE + c.wave; row < NT; row += c.nblk * NWAVE) {
            const f32x4* xr = (const f32x4*)(x + (size_t)row * DM) + c.lane; float s = 0.f;
            u32x2* o = (u32x2*)(xb + (size_t)row * DM) + c.lane;
#pragma unroll
            for (int j = 0; j < 4; ++j) { const f32x4 v = xr[64 * j]; s += (v[0] * v[0] + v[1] * v[1]) + (v[2] * v[2] + v[3] * v[3]);
                u32x2 w; w.x = pk2(v[0], v[1]); w.y = pk2(v[2], v[3]); o[64 * j] = w; }
            s = wave_sum(s);
            if (c.lane == 0) rss[row] = s;
        }
    }
    if (l == 0 && (mask & 16)) {
        float* cosT = wsp<float>(c, WS_ROPE); float* sinT = cosT + SEQ * 32;
        for (int i = c.bid * NTHR + c.tid; i < SEQ * 32; i += c.nblk * NTHR) {
            const int pos = i >> 5, fi = i & 31;
            const float inv = exp2f(-(float)fi * 0.41524101186092029f);
            const float a = (float)pos * inv, q = rintf(a * 0.63661977236758134f);
            float rr = fmaf(-q, 1.5703125f, a); rr = fmaf(-q, 4.837512969970703125e-4f, rr); rr = fmaf(-q, 7.54978995489188216e-8f, rr);
            const float r2 = rr * rr;
            const float s = rr * (1.0f + r2 * (-1.0f / 6 + r2 * (1.0f / 120 + r2 * (-1.0f / 5040 + r2 * (1.0f / 362880)))));
            const float cc = 1.0f + r2 * (-0.5f + r2 * (1.0f / 24 + r2 * (-1.0f / 720 + r2 * (1.0f / 40320 + r2 * (-1.0f / 3628800)))));
            const int qi = ((int)q) & 3;
            const float co = qi == 0 ? cc : qi == 1 ? -s : qi == 2 ? -cc : s;
            const float si = qi == 0 ? s : qi == 1 ? cc : qi == 2 ? -s : -cc;
            cosT[i] = co; sinT[i] = si;
        }
    }
}
constexpr int LF_STRIDE = 65, LT_STRIDE = 72;
constexpr int LDS_F0 = 0, LDS_F1 = 16640, LDS_F2 = 33280, LDS_T0 = 49920, LDS_TSZ = 64 * LT_STRIDE * 2, LDS_MISC = LDS_T0 + 6 * LDS_TSZ;
DEV LDSP float* ldsF(const Ctx& c, int i) { return (LDSP float*)(c.lds + LDS_F0 + i * 16640); }
DEV LDSP bf16_t* ldsT(const Ctx& c, int i) { return (LDSP bf16_t*)(c.lds + LDS_T0 + i * LDS_TSZ); }
DEV LDSP float* ldsM(const Ctx& c) { return (LDSP float*)(c.lds + LDS_MISC); }

DEV void load_tile_f32(const Ctx& c, LDSP float* F, const bf16_t* proj, int tok0, int col) {
    const int t = c.tid >> 3, d0 = (c.tid & 7) * 8;
    const u32x4 v = *(const u32x4*)(proj + (size_t)(tok0 + t) * PROJ_LD + col + d0);
    LDSP float* f = F + t * LF_STRIDE + d0;
    f[0] = bflo(v.x); f[1] = bfhi(v.x); f[2] = bflo(v.y); f[3] = bfhi(v.y); f[4] = bflo(v.z); f[5] = bfhi(v.z); f[6] = bflo(v.w); f[7] = bfhi(v.w);
}
DEV void load_tile_T(const Ctx& c, LDSP bf16_t* T, const bf16_t* proj, int tok0, int col) {
    const int t = c.tid >> 3, d0 = (c.tid & 7) * 8;
    const u32x4 v = *(const u32x4*)(proj + (size_t)(tok0 + t) * PROJ_LD + col + d0);
    LDSP bf16_t* p = T + d0 * LT_STRIDE + t;
    p[0] = (bf16_t)(v.x & 0xffff); p[LT_STRIDE] = (bf16_t)(v.x >> 16); p[2 * LT_STRIDE] = (bf16_t)(v.y & 0xffff); p[3 * LT_STRIDE] = (bf16_t)(v.y >> 16);
    p[4 * LT_STRIDE] = (bf16_t)(v.z & 0xffff); p[5 * LT_STRIDE] = (bf16_t)(v.z >> 16); p[6 * LT_STRIDE] = (bf16_t)(v.w & 0xffff); p[7 * LT_STRIDE] = (bf16_t)(v.w >> 16);
}
DEV f32x4 mma_tile(const LDSP bf16_t* A, int lda, int r0, const LDSP bf16_t* B, int ldb, int c0, int K, f32x4 acc, int lane) {
    const int fr = lane & 15, fq = lane >> 4;
    for (int k0 = 0; k0 < K; k0 += 32) {
        const bf16x8 a = *(const LDSP bf16x8*)(A + (r0 + fr) * lda + k0 + fq * 8);
        const bf16x8 b = *(const LDSP bf16x8*)(B + (c0 + fr) * ldb + k0 + fq * 8);
        acc = mfma16(a, b, acc);
    }
    return acc;
}
DEV float wave_scan_add(float v, int lane) {
#pragma unroll
    for (int o = 1; o < 64; o <<= 1) { const float t = shfl_f(v, lane - o); if (lane >= o) v += t; }
    return v;
}
DEV float wave_scan_max(float v, int lane) {
#pragma unroll
    for (int o = 1; o < 64; o <<= 1) { const float t = shfl_f(v, lane - o); if (lane >= o) v = fmaxf(v, t); }
    return v;
}
DEV float hgrn_lb(const Ctx& c, int l, int ch) { if (l == 0) return 0.f; const float* lb = CIN(3); return sigmoidf_(lb[MW + ch] - lb[ch]); }
DEV float ret_loggamma(int h) { return log1pf(-exp2f(-5.0f - (float)h)); }

DEV void hgrn_front(const Ctx& c, int l, const bf16_t* proj, int tok0, int h) {
    LDSP float* F0 = ldsF(c, 0); LDSP float* F1 = ldsF(c, 1);
    load_tile_f32(c, F0, proj, tok0, C_HF + h * 64);
    block_sync();
    for (int e = c.tid; e < 4096; e += NTHR) { const int t = e >> 6, d = e & 63; const float fl = F0[t * LF_STRIDE + d], lbv = hgrn_lb(c, l, h * 64 + d);
        const float sg = sigmoidf_(fl), f = lbv + (1.f - lbv) * sg; F0[t * LF_STRIDE + d] = fast_log(f); F1[t * LF_STRIDE + d] = (1.f - lbv) * (1.f - sg); }
    block_sync();
    for (int k = 0; k < 8; ++k) { const int d = c.wave * 8 + k; F0[c.lane * LF_STRIDE + d] = wave_scan_add(F0[c.lane * LF_STRIDE + d], c.lane); }
    block_sync();
}
DEV void rope_tile(const Ctx& c, LDSP float* F, int pos0, float scale) {
    const float* cosT = wsp<float>(c, WS_ROPE); const float* sinT = cosT + SEQ * 32;
    for (int e = c.tid; e < 2048; e += NTHR) { const int t = e >> 5, d = e & 31; const float cs = cosT[(pos0 + t) * 32 + d], sn = sinT[(pos0 + t) * 32 + d];
        const float x1 = F[t * LF_STRIDE + d], x2 = F[t * LF_STRIDE + d + 32];
        F[t * LF_STRIDE + d] = (x1 * cs - x2 * sn) * scale; F[t * LF_STRIDE + d + 32] = (x1 * sn + x2 * cs) * scale; }
}
constexpr int LDS_RAW = 107520, RAW_SZ = 67 * 65 * 4;
DEV void mlstm_conv_both(const Ctx& c, int l, LDSP float* Fq, LDSP float* Fk, const bf16_t* proj, int tok0, int ck, int cg, int h) {
    const float* cw = CIN(5) + (size_t)l * 4 * 512; const float* cb = CIN(6) + (size_t)l * 512; const bf16_t* halo = wsp<bf16_t>(c, WS_HALO);
    LDSP float* Rq = (LDSP float*)(c.lds + LDS_RAW); LDSP float* Rk = (LDSP float*)(c.lds + LDS_RAW + RAW_SZ);
    const int t = c.tid >> 3, d0 = (c.tid & 7) * 8;
    { const u32x4 vq = *(const u32x4*)(proj + (size_t)(tok0 + t) * PROJ_LD + C_MQ + h * 64 + d0), vk = *(const u32x4*)(proj + (size_t)(tok0 + t) * PROJ_LD + C_MK + h * 64 + d0);
      u32x4 hq = {0u, 0u, 0u, 0u}, hk = {0u, 0u, 0u, 0u};
      if (c.tid < 24 && ck > 0) { hq = *(const u32x4*)(halo + ((size_t)(cg - 1) * 3 + t) * 512 + h * 64 + d0); hk = *(const u32x4*)(halo + ((size_t)(cg - 1) * 3 + t) * 512 + 256 + h * 64 + d0); }
      LDSP float* fq = Rq + (t + 3) * 65 + d0; LDSP float* fk = Rk + (t + 3) * 65 + d0;
      fq[0] = bflo(vq.x); fq[1] = bfhi(vq.x); fq[2] = bflo(vq.y); fq[3] = bfhi(vq.y); fq[4] = bflo(vq.z); fq[5] = bfhi(vq.z); fq[6] = bflo(vq.w); fq[7] = bfhi(vq.w);
      fk[0] = bflo(vk.x); fk[1] = bfhi(vk.x); fk[2] = bflo(vk.y); fk[3] = bfhi(vk.y); fk[4] = bflo(vk.z); fk[5] = bfhi(vk.z); fk[6] = bflo(vk.w); fk[7] = bfhi(vk.w);
      if (c.tid < 24) { LDSP float* gq = Rq + t * 65 + d0; LDSP float* gk = Rk + t * 65 + d0;
        gq[0] = bflo(hq.x); gq[1] = bfhi(hq.x); gq[2] = bflo(hq.y); gq[3] = bfhi(hq.y); gq[4] = bflo(hq.z); gq[5] = bfhi(hq.z); gq[6] = bflo(hq.w); gq[7] = bfhi(hq.w);
        gk[0] = bflo(hk.x); gk[1] = bfhi(hk.x); gk[2] = bflo(hk.y); gk[3] = bfhi(hk.y); gk[4] = bflo(hk.z); gk[5] = bfhi(hk.z); gk[6] = bflo(hk.w); gk[7] = bfhi(hk.w); } }
    block_sync();
#pragma unroll
    for (int half = 0; half < 2; ++half) {
        const int ch = half * 256 + h * 64 + d0; LDSP float* R = half ? Rk : Rq; LDSP float* F = half ? Fk : Fq; const float scale = half ? 0.125f : 1.0f;
        f32x4 s0 = *(const f32x4*)(cb + ch), s1 = *(const f32x4*)(cb + ch + 4);
#pragma unroll
        for (int j = 0; j < 4; ++j) { const f32x4 w0 = *(const f32x4*)(cw + j * 512 + ch), w1 = *(const f32x4*)(cw + j * 512 + ch + 4); const LDSP float* rr = R + (t + j) * 65 + d0;
            s0[0] += w0[0] * rr[0]; s0[1] += w0[1] * rr[1]; s0[2] += w0[2] * rr[2]; s0[3] += w0[3] * rr[3]; s1[0] += w1[0] * rr[4]; s1[1] += w1[1] * rr[5]; s1[2] += w1[2] * rr[6]; s1[3] += w1[3] * rr[7]; }
        LDSP float* f = F + t * LF_STRIDE + d0;
        f[0] = siluf_(s0[0]) * scale; f[1] = siluf_(s0[1]) * scale; f[2] = siluf_(s0[2]) * scale; f[3] = siluf_(s0[3]) * scale;
        f[4] = siluf_(s1[0]) * scale; f[5] = siluf_(s1[1]) * scale; f[6] = siluf_(s1[2]) * scale; f[7] = siluf_(s1[3]) * scale;
    }
}
DEV void mlstm_gates(const Ctx& c, int l, const bf16_t* proj, int tok0, int h) {
    LDSP float* M = ldsM(c); const float* gb = CIN(7) + (size_t)l * 8;
    if (c.tid < 64) { const int t = c.tid; M[t] = bf2f(proj[(size_t)(tok0 + t) * PROJ_LD + C_MI + h]) + gb[h];
        M[64 + t] = log_sigmoidf_(bf2f(proj[(size_t)(tok0 + t) * PROJ_LD + C_MF + h]) + gb[4 + h]); }
    block_sync();
    if (c.wave == 0) M[64 + c.lane] = wave_scan_add(M[64 + c.lane], c.lane);
    block_sync();
}
DEV void store_state_tiles(const Ctx& c, bf16_t* dst, const f32x4 (&acc)[2]) {
    const int fr = c.lane & 15, fq = c.lane >> 4;
#pragma unroll
    for (int k = 0; k < 2; ++k) { const int ti = c.wave * 2 + k, rt = ti >> 2, ct = ti & 3;
#pragma unroll
        for (int i = 0; i < 4; ++i) dst[(rt * 16 + fq * 4 + i) * 64 + ct * 16 + fr] = f2bf(acc[k][i]); }
}
DEV void f32_to_tile(const Ctx& c, LDSP bf16_t* T, const LDSP float* F, bool transpose) {
    for (int e = c.tid; e < 4096; e += NTHR) { const int r = e >> 6, q = e & 63; const bf16_t v = f2bf(F[r * LF_STRIDE + q]); if (transpose) T[q * LT_STRIDE + r] = v; else T[r * LT_STRIDE + q] = v; }
}

DEV void recur_local_unit(const Ctx& c, int l, int unit) {
    const int mixer = unit / (BATCH * NH * NC), r = unit % (BATCH * NH * NC), b = r / (NH * NC), h = (r / NC) % NH, ck = r % NC;
    bf16_t* proj = wsp<bf16_t>(c, WS_PROJ); const int tok0 = b * SEQ + ck * 64, pos0 = ck * 64;
    LDSP float* F0 = ldsF(c, 0); LDSP float* F1 = ldsF(c, 1); LDSP float* F2 = ldsF(c, 2); LDSP float* M = ldsM(c);
    LDSP bf16_t* VT = ldsT(c, 0); LDSP bf16_t* KT = ldsT(c, 1);
    bf16_t* dst = wsp<bf16_t>(c, WS_ST + mixer * ST_ONE) + (size_t)r * 4096;
    const int vt = c.tid >> 3, vd0 = (c.tid & 7) * 8;
    int qcol, kcol, vcol;
    if (mixer == 0) {
        qcol = C_HQ; kcol = C_HF; vcol = C_HI;
        load_tile_T(c, VT, proj, tok0, C_HI + h * 64);
        load_tile_f32(c, F2, proj, tok0, C_HQ + h * 64);
        hgrn_front(c, l, proj, tok0, h);
        float qo[8], ko[8];
#pragma unroll
        for (int j = 0; j < 8; ++j) { const int d = vd0 + j; const float bt = F0[vt * LF_STRIDE + d], bm = F0[31 * LF_STRIDE + d], bl = F0[63 * LF_STRIDE + d], kk = F1[vt * LF_STRIDE + d];
            qo[j] = siluf_(F2[vt * LF_STRIDE + d]) * fast_exp(bt - bm); ko[j] = kk * fast_exp(bm - bt); KT[d * LT_STRIDE + vt] = f2bf(kk * fast_exp(bl - bt)); }
        if (c.tid < 64) { wsp<float>(c, WS_GDEC)[(size_t)r * 64 + c.tid] = fast_exp(F0[63 * LF_STRIDE + c.tid]); wsp<float>(c, WS_G31)[(size_t)r * 64 + c.tid] = fast_exp(F0[31 * LF_STRIDE + c.tid]); }
        u32x4 w; w.x = pk2(qo[0], qo[1]); w.y = pk2(qo[2], qo[3]); w.z = pk2(qo[4], qo[5]); w.w = pk2(qo[6], qo[7]); *(u32x4*)(proj + (size_t)(tok0 + vt) * PROJ_LD + C_HQ + h * 64 + vd0) = w;
        w.x = pk2(ko[0], ko[1]); w.y = pk2(ko[2], ko[3]); w.z = pk2(ko[4], ko[5]); w.w = pk2(ko[6], ko[7]); *(u32x4*)(proj + (size_t)(tok0 + vt) * PROJ_LD + C_HF + h * 64 + vd0) = w;
    } else if (mixer == 2) {
        qcol = C_RQ; kcol = C_RK; vcol = C_RV;
        load_tile_T(c, VT, proj, tok0, C_RV + h * 64);
        load_tile_f32(c, F0, proj, tok0, C_RK + h * 64); load_tile_f32(c, F2, proj, tok0, C_RQ + h * 64);
        block_sync();
        rope_tile(c, F0, pos0, 0.125f); rope_tile(c, F2, pos0, 1.0f);
        block_sync();
        const float lg = ret_loggamma(h), gq = fast_exp(lg * (float)(vt - 31)), gk = fast_exp(lg * (float)(31 - vt)), gl = fast_exp(lg * (float)(63 - vt));
        float qo[8], ko[8];
#pragma unroll
        for (int j = 0; j < 8; ++j) { const int d = vd0 + j; const float kk = F0[vt * LF_STRIDE + d]; qo[j] = F2[vt * LF_STRIDE + d] * gq; ko[j] = kk * gk; KT[d * LT_STRIDE + vt] = f2bf(kk * gl); }
        u32x4 w; w.x = pk2(qo[0], qo[1]); w.y = pk2(qo[2], qo[3]); w.z = pk2(qo[4], qo[5]); w.w = pk2(qo[6], qo[7]); *(u32x4*)(proj + (size_t)(tok0 + vt) * PROJ_LD + C_RQ + h * 64 + vd0) = w;
        w.x = pk2(ko[0], ko[1]); w.y = pk2(ko[2], ko[3]); w.z = pk2(ko[4], ko[5]); w.w = pk2(ko[6], ko[7]); *(u32x4*)(proj + (size_t)(tok0 + vt) * PROJ_LD + C_RK + h * 64 + vd0) = w;
    } else {
        qcol = C_MQ; kcol = C_MK; vcol = C_MV;
        load_tile_T(c, VT, proj, tok0, C_MV + h * 64);
        mlstm_gates(c, l, proj, tok0, h);
        mlstm_conv_both(c, l, F2, F0, proj, tok0, ck, b * NC + ck, h);
        if (c.wave == 0) { const int t = c.lane; const float bl = M[127], bt = M[64 + t], li = M[t];
            const float a = wave_max(bl - bt + li); const float pm = wave_scan_max(li - bt, t);
            M[128 + t] = pm; if (t == 0) { M[192] = a; M[193] = bl; }
            float* mts = wsp<float>(c, WS_MTS) + ((size_t)(tok0 + t) * NH + h) * 2; mts[0] = bt; mts[1] = bt + pm; }
        block_sync();
        const float eq = fast_exp(-M[128 + vt]), ek = fast_exp(M[vt] - M[64 + vt]), wk = fast_exp(M[193] - M[64 + vt] + M[vt] - M[192]);
        float qo[8], ko[8];
#pragma unroll
        for (int j = 0; j < 8; ++j) { const int d = vd0 + j; const float kk = F0[vt * LF_STRIDE + d]; qo[j] = F2[vt * LF_STRIDE + d] * eq; ko[j] = kk * ek;
            const float kh = kk * wk; F1[vt * LF_STRIDE + d] = kh; KT[d * LT_STRIDE + vt] = f2bf(kh); }
        block_sync();
        u32x4 w; w.x = pk2(qo[0], qo[1]); w.y = pk2(qo[2], qo[3]); w.z = pk2(qo[4], qo[5]); w.w = pk2(qo[6], qo[7]); *(u32x4*)(proj + (size_t)(tok0 + vt) * PROJ_LD + C_MQ + h * 64 + vd0) = w;
        w.x = pk2(ko[0], ko[1]); w.y = pk2(ko[2], ko[3]); w.z = pk2(ko[4], ko[5]); w.w = pk2(ko[6], ko[7]); *(u32x4*)(proj + (size_t)(tok0 + vt) * PROJ_LD + C_MK + h * 64 + vd0) = w;
        if (c.tid < 64) { float s = 0.f; for (int t = 0; t < 64; ++t) s += F1[t * LF_STRIDE + c.tid]; wsp<float>(c, WS_MNL)[(size_t)r * 64 + c.tid] = s; }
        if (c.tid == 64) { float* sc = wsp<float>(c, WS_MSC) + (size_t)r * 4; sc[0] = M[192]; sc[1] = M[193]; }
    }
    block_sync();
    f32x4 acc[2];
#pragma unroll
    for (int k = 0; k < 2; ++k) { const int ti = c.wave * 2 + k; acc[k] = (f32x4){0.f, 0.f, 0.f, 0.f}; acc[k] = mma_tile(VT, LT_STRIDE, (ti >> 2) * 16, KT, LT_STRIDE, (ti & 3) * 16, 64, acc[k], c.lane); }
    store_state_tiles(c, dst, acc);
    *(u32x4*)(proj + (size_t)(tok0 + vt) * PROJ_LD + vcol + h * 64 + vd0) = *(const LDSP u32x4*)(VT + vt * LT_STRIDE + vd0);
    (void)qcol; (void)kcol;
    block_sync();
}

DEV void recur_scan(const Ctx& c) {
    constexpr int ncol2 = BATCH * NH * 2048;
    constexpr int KB = (NC < 16) ? NC : 16;
    for (int i = c.bid * NTHR + c.tid; i < 3 * ncol2 + BATCH * NH * 64; i += c.nblk * NTHR) {
        if (i < 3 * ncol2) {
            const int mixer = i / ncol2, col = (i % ncol2) * 2, bh = col >> 12, ed = col & 4095, d = ed & 63, h = bh % NH;
            bf16_t* p = wsp<bf16_t>(c, WS_ST + mixer * ST_ONE) + (size_t)bh * NC * 4096 + ed;
            const float* g = wsp<float>(c, WS_GDEC) + (size_t)bh * NC * 64 + d; const float* g31 = wsp<float>(c, WS_G31) + (size_t)bh * NC * 64 + d; const float* sc = wsp<float>(c, WS_MSC) + (size_t)bh * NC * 4;
            const float gr = fast_exp(ret_loggamma(h) * 64.f), gr32 = fast_exp(ret_loggamma(h) * 32.f);
            float s0 = 0.f, s1 = 0.f, m = 0.f;
            for (int kb = 0; kb < NC; kb += KB) {
                unsigned tv[KB]; f32x2 gv[KB]; f32x2 av[KB]; f32x2 hv[KB];
#pragma unroll
                for (int j = 0; j < KB; ++j) { tv[j] = *(const unsigned*)(p + (size_t)(kb + j) * 4096);
                    if (mixer == 0) { gv[j] = *(const f32x2*)(g + (kb + j) * 64); hv[j] = *(const f32x2*)(g31 + (kb + j) * 64); } else if (mixer == 1) av[j] = *(const f32x2*)(sc + (kb + j) * 4); }
#pragma unroll
                for (int j = 0; j < KB; ++j) {
                    const float t0 = bflo(tv[j]), t1 = bfhi(tv[j]);
                    if (mixer == 0) { *(unsigned*)(p + (size_t)(kb + j) * 4096) = pk2(s0 * hv[j][0], s1 * hv[j][1]); s0 = gv[j][0] * s0 + t0; s1 = gv[j][1] * s1 + t1; }
                    else if (mixer == 2) { *(unsigned*)(p + (size_t)(kb + j) * 4096) = pk2(s0 * gr32, s1 * gr32); s0 = gr * s0 + t0; s1 = gr * s1 + t1; }
                    else { *(unsigned*)(p + (size_t)(kb + j) * 4096) = pk2(s0, s1);
                        const float a = av[j][0], bl = av[j][1], mn = fmaxf(bl + m, a), ds = fast_exp(bl + m - mn), dl = fast_exp(a - mn); s0 = ds * s0 + dl * t0; s1 = ds * s1 + dl * t1; m = mn; }
                }
            }
        } else {
            const int j = i - 3 * ncol2, bh = j >> 6, d = j & 63;
            float* p = wsp<float>(c, WS_MNL) + (size_t)bh * NC * 64 + d; float* sc = wsp<float>(c, WS_MSC) + (size_t)bh * NC * 4; float m = 0.f, s = 0.f;
            for (int k = 0; k < NC; ++k) { const float a = sc[k * 4], bl = sc[k * 4 + 1], mn = fmaxf(bl + m, a);
                const float t = p[k * 64]; p[k * 64] = s; if (d == 0) sc[k * 4 + 2] = m; s = fast_exp(bl + m - mn) * s + fast_exp(a - mn) * t; m = mn; }
        }
    }
}

DEV void recur_out_wave(const Ctx& c, int l, int unit) {
    const int mixer = unit / (BATCH * NH * NC), r = unit % (BATCH * NH * NC), b = r / (NH * NC), h = (r / NC) % NH, ck = r % NC;
    const bf16_t* proj = wsp<bf16_t>(c, WS_PROJ); const int tok0 = b * SEQ + ck * 64;
    const bf16_t* st = wsp<bf16_t>(c, WS_ST + mixer * ST_ONE) + (size_t)r * 4096;
    const int fr = c.lane & 15, fq = c.lane >> 4;
    const int qcol = (mixer == 0 ? C_HQ : mixer == 1 ? C_MQ : C_RQ) + h * 64, kcol = (mixer == 0 ? C_HF : mixer == 1 ? C_MK : C_RK) + h * 64;
    const int vcol = (mixer == 0 ? C_HI : mixer == 1 ? C_MV : C_RV) + h * 64, gcol = (mixer == 0 ? C_HG : mixer == 1 ? C_MO : C_RG) + h * 64;
    const float* onorm = (mixer == 0 ? CIN(4) : mixer == 1 ? CIN(8) : CIN(13)) + (size_t)l * MW + h * 64;
    bf16x8 ka[4][2], va[4][2], sa[4][2];
#pragma unroll
    for (int sq = 0; sq < 4; ++sq)
#pragma unroll
        for (int ks = 0; ks < 2; ++ks) {
            ka[sq][ks] = *(const bf16x8*)(proj + (size_t)(tok0 + 16 * sq + fr) * PROJ_LD + kcol + 32 * ks + 8 * fq);
            sa[sq][ks] = *(const bf16x8*)(st + (16 * sq + fr) * 64 + 32 * ks + 8 * fq);
            const bf16_t* vp = proj + (size_t)(tok0 + 16 * sq + fr) * PROJ_LD + vcol + 32 * ks + 4 * fq;
            const u32x2 v0 = *(const u32x2*)vp, v1 = *(const u32x2*)(vp + 16); const u32x4 vv = {v0.x, v0.y, v1.x, v1.y}; va[sq][ks] = __builtin_bit_cast(bf16x8, vv);
        }
    bf16x8 sn[2], vones; float mst = 0.f;
    if (mixer == 1) {
        const float* nst = wsp<float>(c, WS_MNL) + (size_t)r * 64; mst = wsp<float>(c, WS_MSC)[(size_t)r * 4 + 2];
#pragma unroll
        for (int ks = 0; ks < 2; ++ks) { const f32x4 n0 = *(const f32x4*)(nst + 32 * ks + 8 * fq), n1 = *(const f32x4*)(nst + 32 * ks + 8 * fq + 4);
            u32x4 w = {pk2(n0[0], n0[1]), pk2(n0[2], n0[3]), pk2(n1[0], n1[1]), pk2(n1[2], n1[3])}; if (fr != 0) w = (u32x4){0u, 0u, 0u, 0u}; sn[ks] = __builtin_bit_cast(bf16x8, w); }
        const unsigned one2 = (fr == 0) ? 0x3f803f80u : 0u; const u32x4 ow = {one2, one2, one2, one2}; vones = __builtin_bit_cast(bf16x8, ow);
    }
#pragma unroll
    for (int tq = 0; tq < 4; ++tq) {
        const int tok = tok0 + 16 * tq + fr;
        bf16x8 qb[2];
#pragma unroll
        for (int ks = 0; ks < 2; ++ks) qb[ks] = *(const bf16x8*)(proj + (size_t)tok * PROJ_LD + qcol + 32 * ks + 8 * fq);
        f32x4 stt[4];
#pragma unroll
        for (int sq = 0; sq < 4; ++sq) { stt[sq] = (f32x4){0.f, 0.f, 0.f, 0.f};
            if (sq <= tq) { stt[sq] = mfma16(ka[sq][0], qb[0], stt[sq]); stt[sq] = mfma16(ka[sq][1], qb[1], stt[sq]); } }
#pragma unroll
        for (int i = 0; i < 4; ++i) if (4 * fq + i > fr) stt[tq][i] = 0.f;
        f32x4 ot[4], os[4], o5 = {0.f, 0.f, 0.f, 0.f}, s5 = {0.f, 0.f, 0.f, 0.f};
#pragma unroll
        for (int eq = 0; eq < 4; ++eq) { ot[eq] = (f32x4){0.f, 0.f, 0.f, 0.f}; os[eq] = (f32x4){0.f, 0.f, 0.f, 0.f}; }
#pragma unroll
        for (int m = 0; m < 2; ++m) if (2 * m <= tq) {
            const u32x4 pw = {pk2(stt[2 * m][0], stt[2 * m][1]), pk2(stt[2 * m][2], stt[2 * m][3]), pk2(stt[2 * m + 1][0], stt[2 * m + 1][1]), pk2(stt[2 * m + 1][2], stt[2 * m + 1][3])};
            const bf16x8 pb = __builtin_bit_cast(bf16x8, pw);
#pragma unroll
            for (int eq = 0; eq < 4; ++eq) ot[eq] = mfma16(va[eq][m], pb, ot[eq]);
            if (mixer == 1) o5 = mfma16(vones, pb, o5);
        }
        if (mixer != 1) {
#pragma unroll
            for (int eq = 0; eq < 4; ++eq) { ot[eq] = mfma16(sa[eq][0], qb[0], ot[eq]); ot[eq] = mfma16(sa[eq][1], qb[1], ot[eq]); }
        } else {
#pragma unroll
            for (int eq = 0; eq < 4; ++eq) { os[eq] = mfma16(sa[eq][0], qb[0], os[eq]); os[eq] = mfma16(sa[eq][1], qb[1], os[eq]); }
            s5 = mfma16(sn[0], qb[0], s5); s5 = mfma16(sn[1], qb[1], s5);
            const float* mts = wsp<float>(c, WS_MTS) + ((size_t)tok * NH + h) * 2; const float bt = mts[0], ml = mts[1];
            const float inter = bt + mst, mt = fmaxf(inter, ml), rt = fast_exp(ml - mt), stc = fast_exp(mst + ml - mt);
            const float den = shfl_f(rt * o5[0] + stc * s5[0], fr);
            const float inv = fast_rcp(fmaxf(fabsf(den), fast_exp(-mt)));
#pragma unroll
            for (int eq = 0; eq < 4; ++eq) ot[eq] = (ot[eq] * rt + os[eq] * stc) * inv;
        }
        float ss = 0.f;
#pragma unroll
        for (int eq = 0; eq < 4; ++eq) ss += (ot[eq][0] * ot[eq][0] + ot[eq][1] * ot[eq][1]) + (ot[eq][2] * ot[eq][2] + ot[eq][3] * ot[eq][3]);
        ss += xorf<16>(ss); ss += xorf<32>(ss);
        const float rn = fast_rsqrt(ss * (1.0f / 64.0f) + NORM_EPS);
        bf16_t* out = wsp<bf16_t>(c, WS_OUTS) + (size_t)(mixer == 0 ? 0 : mixer == 1 ? 1 : 3) * NT * MW + (size_t)tok * MW + h * 64 + 4 * fq;
#pragma unroll
        for (int eq = 0; eq < 4; ++eq) { const u32x2 gv = *(const u32x2*)(proj + (size_t)tok * PROJ_LD + gcol + 16 * eq + 4 * fq); const f32x4 on = *(const f32x4*)(onorm + 16 * eq + 4 * fq);
            const float g0 = bflo(gv.x), g1 = bfhi(gv.x), g2 = bflo(gv.y), g3 = bfhi(gv.y);
            const float a0 = ot[eq][0] * rn * on[0] * (mixer == 1 ? sigmoidf_(g0) : siluf_(g0)), a1 = ot[eq][1] * rn * on[1] * (mixer == 1 ? sigmoidf_(g1) : siluf_(g1));
            const float a2 = ot[eq][2] * rn * on[2] * (mixer == 1 ? sigmoidf_(g2) : siluf_(g2)), a3 = ot[eq][3] * rn * on[3] * (mixer == 1 ? sigmoidf_(g3) : siluf_(g3));
            u32x2 w; w.x = pk2(a0, a1); w.y = pk2(a2, a3); *(u32x2*)(out + 16 * eq) = w; }
    }
}

DEV void nsa_kprep_item(const Ctx& c, int l, int item) {
    const bf16_t* proj = wsp<bf16_t>(c, WS_PROJ); bf16_t* ksw = wsp<bf16_t>(c, WS_KSW);
    const float* cosT = wsp<float>(c, WS_ROPE); const float* sinT = cosT + SEQ * 32;
    const int tok = item * 32 + (c.tid >> 4), vec = (c.tid >> 2) & 3, br = vec >> 1, g = vec & 1, d0 = (c.tid & 3) * 8;
    const int col = (br == 0 ? C_NKS : C_NKW) + g * 64;
    const u32x4 a = *(const u32x4*)(proj + (size_t)tok * PROJ_LD + col + d0), b2 = *(const u32x4*)(proj + (size_t)tok * PROJ_LD + col + 32 + d0);
    const float x1[8] = {bflo(a.x), bfhi(a.x), bflo(a.y), bfhi(a.y), bflo(a.z), bfhi(a.z), bflo(a.w), bfhi(a.w)};
    const float x2[8] = {bflo(b2.x), bfhi(b2.x), bflo(b2.y), bfhi(b2.y), bflo(b2.z), bfhi(b2.z), bflo(b2.w), bfhi(b2.w)};
    float ss = 0.f;
#pragma unroll
    for (int j = 0; j < 8; ++j) ss += x1[j] * x1[j] + x2[j] * x2[j];
    ss += xorf<1>(ss); ss += xorf<2>(ss);
    const float r = fast_rsqrt(ss * (1.0f / 64.0f) + NORM_EPS); const float* kg = CIN(10) + ((size_t)l * 3 + 1 + br) * 64; const int pos = tok % SEQ;
    float o1[8], o2[8];
#pragma unroll
    for (int j = 0; j < 8; ++j) { const int d = d0 + j; const float y1 = x1[j] * r * kg[d], y2 = x2[j] * r * kg[d + 32], cs = cosT[pos * 32 + d], sn = sinT[pos * 32 + d];
        o1[j] = y1 * cs - y2 * sn; o2[j] = y1 * sn + y2 * cs; }
    bf16_t* o = ksw + (size_t)tok * 256 + vec * 64 + d0;
    u32x4 w; w.x = pk2(o1[0], o1[1]); w.y = pk2(o1[2], o1[3]); w.z = pk2(o1[4], o1[5]); w.w = pk2(o1[6], o1[7]); *(u32x4*)o = w;
    w.x = pk2(o2[0], o2[1]); w.y = pk2(o2[2], o2[3]); w.z = pk2(o2[4], o2[5]); w.w = pk2(o2[6], o2[7]); *(u32x4*)(o + 32) = w;
}
DEV void nsa_compress_unit(const Ctx& c, int l, int unit) {
    const int quarter = unit & 3, kv = (unit >> 2) & 1, g = (unit >> 3) & 1, b = unit >> 4;
    const bf16_t* proj = wsp<bf16_t>(c, WS_PROJ); const bf16_t* wct = wsp<bf16_t>(c, WS_WCT) + (size_t)kv * 64 * 2048;
    const int fr = c.lane & 15, fq = c.lane >> 4, rt = c.wave & 3, kh = c.wave >> 2, n0 = quarter * 64 + rt * 16, n = n0 + fr;
    const int col = (kv == 0 ? C_NKC : C_NVC) + g * 64;
    LDSP float* xch = (LDSP float*)c.lds + (rt * 64 + c.lane) * 17;
    f32x4 acc[4];
#pragma unroll
    for (int et = 0; et < 4; ++et) acc[et] = (f32x4){0.f, 0.f, 0.f, 0.f};
    const bool live = n0 < NCMP_PAD;
    if (live)
    for (int kb = kh * 1024; kb < kh * 1024 + 1024; kb += 128) {
        bf16x8 a[4], bb[4][4];
#pragma unroll
        for (int s4 = 0; s4 < 4; ++s4) { const int kk = kb + s4 * 32 + fq * 8, lrow = kk >> 6, d0 = kk & 63;
            a[s4] = (bf16x8){0, 0, 0, 0, 0, 0, 0, 0};
            if (n < NCMP) a[s4] = *(const bf16x8*)(proj + (size_t)(b * SEQ + 16 * n + lrow) * PROJ_LD + col + d0);
#pragma unroll
            for (int et = 0; et < 4; ++et) bb[s4][et] = *(const bf16x8*)(wct + (size_t)(et * 16 + fr) * 2048 + kk); }
#pragma unroll
        for (int s4 = 0; s4 < 4; ++s4)
#pragma unroll
            for (int et = 0; et < 4; ++et) acc[et] = mfma16(a[s4], bb[s4][et], acc[et]);
    }
    if (kh == 1) {
#pragma unroll
        for (int et = 0; et < 4; ++et)
#pragma unroll
            for (int i = 0; i < 4; ++i) xch[et * 4 + i] = acc[et][i];
    }
    block_sync();
    if (kh == 0 && live) {
        const float* bias = wsp<float>(c, WS_CBIAS) + kv * 64;
        float v[4][4];
#pragma unroll
        for (int et = 0; et < 4; ++et)
#pragma unroll
            for (int i = 0; i < 4; ++i) v[et][i] = acc[et][i] + xch[et * 4 + i] + bias[et * 16 + fr];
        if (kv == 0) {
            const float* kg = CIN(10) + (size_t)l * 3 * 64; bf16_t* kc = wsp<bf16_t>(c, WS_KCMP) + (size_t)(b * 2 + g) * NCMP_PAD * 64;
#pragma unroll
            for (int i = 0; i < 4; ++i) { float ss = 0.f;
#pragma unroll
                for (int et = 0; et < 4; ++et) ss += v[et][i] * v[et][i];
                ss += xorf<1>(ss); ss += xorf<2>(ss); ss += xorf<4>(ss); ss += xorf<8>(ss);
                const float r = fast_rsqrt(ss * (1.0f / 64.0f) + NORM_EPS);
#pragma unroll
                for (int et = 0; et < 4; ++et) kc[(size_t)(n0 + fq * 4 + i) * 64 + et * 16 + fr] = f2bf(v[et][i] * r * kg[et * 16 + fr]); }
        } else {
            bf16_t* vt = wsp<bf16_t>(c, WS_VCMPT) + (size_t)(b * 2 + g) * 64 * NCMP_PAD;
#pragma unroll
            for (int et = 0; et < 4; ++et)
#pragma unroll
                for (int i = 0; i < 4; ++i) vt[(size_t)(et * 16 + fr) * NCMP_PAD + n0 + fq * 4 + i] = f2bf(v[et][i]);
        }
    }
    block_sync();
}

DEV void nsa_vprep_item(const Ctx& c, int item) {
    const int tt = item % NC, r = item / NC, br = r & 1, g = (r >> 1) & 1, b = r >> 2;
    bf16_t* proj = wsp<bf16_t>(c, WS_PROJ); LDSP bf16_t* T = (LDSP bf16_t*)c.lds; const int col = (br == 0 ? C_NVS : C_NVW) + g * 64, tok0 = b * SEQ + tt * 64;
    load_tile_T(c, T, proj, tok0, col);
    block_sync();
    { const int e = c.tid >> 3, t0 = (c.tid & 7) * 8; *(u32x4*)(proj + (size_t)(tok0 + e) * PROJ_LD + col + t0) = *(const LDSP u32x4*)(T + e * LT_STRIDE + t0); }
    block_sync();
}

constexpr int NA_PC = 0, NA_PCLD = 264, NA_BUF = 36864, NA_KLD = 72, NA_VLD = 136, NA_VOFF = 18432, NA_IMP = 73728, NA_SEL = NA_IMP + 16640, NA_GATE = NA_SEL + 512;
constexpr float NEG_BIG = -1.0e30f;

#ifndef HOST_EMU
DEV float fmax_fast(float a, float b) { return __builtin_amdgcn_fmed3f(a, b, __builtin_inff()); }
#else
static inline float fmax_fast(float a, float b) { return a > b ? a : b; }
#endif
constexpr float NEG_HUGE = -3.0e38f;
template <int MODE, bool EDGE>
DEV void nsa_stage(const Ctx& c, int buf, int js, int qt, const bf16x8 (&qr)[2], f32x4 (&ot)[4], float& mrun, float& lrun, unsigned long long selm) {
    const LDSP bf16_t* Kt = (const LDSP bf16_t*)(c.lds + buf * NA_BUF); const LDSP bf16_t* VT = (const LDSP bf16_t*)(c.lds + buf * NA_BUF + NA_VOFF);
    const int fr = c.lane & 15, fq = c.lane >> 4, q = (c.wave & 3) * 16 + fr;
    f32x4 st[8];
#pragma unroll
    for (int kt = 0; kt < 8; ++kt) { st[kt] = (f32x4){0.f, 0.f, 0.f, 0.f};
        st[kt] = mfma16(*(const LDSP bf16x8*)(Kt + (kt * 16 + fr) * NA_KLD + fq * 8), qr[0], st[kt]);
        st[kt] = mfma16(*(const LDSP bf16x8*)(Kt + (kt * 16 + fr) * NA_KLD + 32 + fq * 8), qr[1], st[kt]); }
    if (EDGE) {
#pragma unroll
        for (int kt = 0; kt < 8; ++kt) { const int j = js + (kt >> 2);
#pragma unroll
            for (int i = 0; i < 4; ++i) { const int kk = (kt & 3) * 16 + fq * 4 + i; bool ok;
                if (MODE == 0) ok = (j <= qt) && ((selm >> j) & 1ull) && (j < qt || kk <= q);
                else { const int dlt = (qt - j) * 64 + q - kk; ok = dlt >= 0 && dlt < 512; }
                st[kt][i] = ok ? st[kt][i] : NEG_HUGE; } }
    } else if (MODE == 0) {
        const float b0 = ((selm >> js) & 1ull) ? 0.f : NEG_HUGE, b1 = ((selm >> (js + 1)) & 1ull) ? 0.f : NEG_HUGE;
#pragma unroll
        for (int kt = 0; kt < 8; ++kt) st[kt] += (kt < 4) ? b0 : b1;
    }
    float mx = NEG_HUGE;
#pragma unroll
    for (int kt = 0; kt < 8; ++kt) mx = fmax_fast(mx, fmax_fast(fmax_fast(st[kt][0], st[kt][1]), fmax_fast(st[kt][2], st[kt][3])));
    mx = fmax_fast(mx, xorf<16>(mx)); mx = fmax_fast(mx, xorf<32>(mx));
    const float mn = fmax_fast(mrun, mx), alpha = fast_exp2(mrun - mn); mrun = mn; float ps = 0.f;
#pragma unroll
    for (int kt = 0; kt < 8; ++kt)
#pragma unroll
        for (int i = 0; i < 4; ++i) { const float pv = fast_exp2(st[kt][i] - mn); st[kt][i] = pv; ps += pv; }
    lrun = lrun * alpha + ps;
#pragma unroll
    for (int et = 0; et < 4; ++et) ot[et] *= alpha;
#pragma unroll
    for (int m = 0; m < 4; ++m) {
        const u32x4 pw = {pk2(st[2 * m][0], st[2 * m][1]), pk2(st[2 * m][2], st[2 * m][3]), pk2(st[2 * m + 1][0], st[2 * m + 1][1]), pk2(st[2 * m + 1][2], st[2 * m + 1][3])};
        const bf16x8 pb = __builtin_bit_cast(bf16x8, pw);
#pragma unroll
        for (int et = 0; et < 4; ++et) { const LDSP bf16_t* vrow = VT + (et * 16 + fr) * NA_VLD + 32 * m + 4 * fq;
            const u32x2 v0 = *(const LDSP u32x2*)vrow, v1 = *(const LDSP u32x2*)(vrow + 16);
            const u32x4 vv = {v0.x, v0.y, v1.x, v1.y};
            ot[et] = mfma16(__builtin_bit_cast(bf16x8, vv), pb, ot[et]); }
    }
}

DEV void nsa_attn_unit(const Ctx& c, int l, int unit) {
    const int qt = unit % NSEL, bg = unit / NSEL, g = bg & 1, b = bg >> 1;
    const bf16_t* proj = wsp<bf16_t>(c, WS_PROJ); const bf16_t* ksw = wsp<bf16_t>(c, WS_KSW);
    const float* cosT = wsp<float>(c, WS_ROPE); const float* sinT = cosT + SEQ * 32;
    LDSP bf16_t* Pc = (LDSP bf16_t*)(c.lds + NA_PC); LDSP float* imp = (LDSP float*)(c.lds + NA_IMP); LDSP unsigned long long* selmask = (LDSP unsigned long long*)(c.lds + NA_SEL);
    LDSP float* gates = (LDSP float*)(c.lds + NA_GATE);
    const int fr = c.lane & 15, fq = c.lane >> 4, hg = c.wave >> 2, hd = g * 2 + hg, qw = (c.wave & 3) * 16;
    const int tokq0 = b * SEQ + qt * 64;
    bf16x8 qc[2], qr[2];
    {
        const int tok = tokq0 + qw + fr, pos = qt * 64 + qw + fr;
        const u32x4 v0 = *(const u32x4*)(proj + (size_t)tok * PROJ_LD + C_NQ + hd * 64 + fq * 8), v1 = *(const u32x4*)(proj + (size_t)tok * PROJ_LD + C_NQ + hd * 64 + 32 + fq * 8);
        float x0[8] = {bflo(v0.x), bfhi(v0.x), bflo(v0.y), bfhi(v0.y), bflo(v0.z), bfhi(v0.z), bflo(v0.w), bfhi(v0.w)};
        float x1[8] = {bflo(v1.x), bfhi(v1.x), bflo(v1.y), bfhi(v1.y), bflo(v1.z), bfhi(v1.z), bflo(v1.w), bfhi(v1.w)};
        float ss = 0.f;
#pragma unroll
        for (int j = 0; j < 8; ++j) ss += x0[j] * x0[j] + x1[j] * x1[j];
        ss += xorf<16>(ss); ss += xorf<32>(ss);
        const float r = fast_rsqrt(ss * (1.0f / 64.0f) + NORM_EPS) * 0.125f; const float* qg = CIN(9) + (size_t)l * 64;
#pragma unroll
        for (int j = 0; j < 8; ++j) { const int d = fq * 8 + j; const float y0 = x0[j] * r * qg[d], y1 = x1[j] * r * qg[d + 32];
            const float cs = cosT[pos * 32 + d], sn = sinT[pos * 32 + d];
            qc[0][j] = (short)f2bf(y0); qc[1][j] = (short)f2bf(y1); qr[0][j] = (short)f2bf((y0 * cs - y1 * sn) * 1.44269504f); qr[1][j] = (short)f2bf((y0 * sn + y1 * cs) * 1.44269504f); }
    }
    if (c.tid < 384) { const int row = c.tid / 3, br = c.tid % 3, hh = row >> 6, q = row & 63;
        gates[c.tid] = sigmoidf_(bf2f(proj[(size_t)(tokq0 + q) * PROJ_LD + C_NG + (g * 2 + hh) * 3 + br])); }
    f32x4 ofin[4];
#pragma unroll
    for (int et = 0; et < 4; ++et) ofin[et] = (f32x4){0.f, 0.f, 0.f, 0.f};
    const int nvis = 4 * qt + 3, nkt = (nvis + 15) >> 4, nk32 = ((nkt * 16 + 31) >> 5) << 5;
    {
        const bf16_t* kc = wsp<bf16_t>(c, WS_KCMP) + (size_t)(b * 2 + g) * NCMP_PAD * 64;
        f32x4 s[16];
#pragma unroll
        for (int jt = 0; jt < 16; ++jt) { s[jt] = (f32x4){0.f, 0.f, 0.f, 0.f};
            if (jt < nkt) { s[jt] = mfma16(qc[0], *(const bf16x8*)(kc + (size_t)(jt * 16 + fr) * 64 + fq * 8), s[jt]);
                            s[jt] = mfma16(qc[1], *(const bf16x8*)(kc + (size_t)(jt * 16 + fr) * 64 + 32 + fq * 8), s[jt]); } }
#pragma unroll
        for (int i = 0; i < 4; ++i) {
            const int sp = qt * 64 + qw + fq * 4 + i, lim = (sp >= 31) ? ((sp - 31) >> 4) : -1;
            float mx = NEG_BIG;
#pragma unroll
            for (int jt = 0; jt < 16; ++jt) if (jt < nkt && jt * 16 + fr <= lim) mx = fmaxf(mx, s[jt][i]);
            mx = fmaxf(mx, xorf<1>(mx)); mx = fmaxf(mx, xorf<2>(mx)); mx = fmaxf(mx, xorf<4>(mx)); mx = fmaxf(mx, xorf<8>(mx));
            float ps = 0.f;
#pragma unroll
            for (int jt = 0; jt < 16; ++jt) { float p = 0.f; if (jt < nkt && jt * 16 + fr <= lim) p = fast_exp(s[jt][i] - mx); s[jt][i] = p; ps += p; }
            ps += xorf<1>(ps); ps += xorf<2>(ps); ps += xorf<4>(ps); ps += xorf<8>(ps);
            const float inv = ps > 0.f ? fast_rcp(ps) : 0.f;
            LDSP bf16_t* prow = Pc + (size_t)(hg * 64 + qw + fq * 4 + i) * NA_PCLD;
#pragma unroll
            for (int jt = 0; jt < 16; ++jt) if (jt * 16 < nk32) prow[jt * 16 + fr] = f2bf(s[jt][i] * inv);
        }
        wave_sync();
        const bf16_t* vt = wsp<bf16_t>(c, WS_VCMPT) + (size_t)(b * 2 + g) * 64 * NCMP_PAD;
        f32x4 oc[4];
#pragma unroll
        for (int et = 0; et < 4; ++et) oc[et] = (f32x4){0.f, 0.f, 0.f, 0.f};
        for (int k0 = 0; k0 < nk32; k0 += 32) {
            const bf16x8 pa = *(const LDSP bf16x8*)(Pc + (size_t)(hg * 64 + qw + fr) * NA_PCLD + k0 + fq * 8);
#pragma unroll
            for (int et = 0; et < 4; ++et) oc[et] = mfma16(*(const bf16x8*)(vt + (size_t)(et * 16 + fr) * NCMP_PAD + k0 + fq * 8), pa, oc[et]);
        }
        block_sync();
#pragma unroll
        for (int et = 0; et < 4; ++et) ofin[et] += oc[et] * gates[(hg * 64 + qw + fr) * 3 + 0];
    }
    for (int e = c.tid; e < 4096; e += NTHR) { const int q = e >> 6, j = e & 63; float a = 0.f;
        if (j <= qt) {
#pragma unroll
            for (int dn = -1; dn <= 3; ++dn) { const int n = 4 * j + dn; if (n >= 0 && n < nkt * 16) a += bf2f(Pc[(size_t)q * NA_PCLD + n]) + bf2f(Pc[(size_t)(64 + q) * NA_PCLD + n]); }
            if (j == 0 || j == qt || j == qt - 1) a += 1000.f;
        } else a = NEG_BIG;
        imp[q * 65 + j] = a; }
    block_sync();
    for (int qq = 0; qq < 8; ++qq) { const int q = c.wave * 8 + qq; unsigned long long m = 0ull;
        if (qt < 16) m = (1ull << (qt + 1)) - 1ull;
        else { const unsigned key = (sortkey32(imp[q * 65 + c.lane]) & 0xffffffc0u) | (unsigned)(63 - c.lane); int rank = 0;
#pragma unroll
            for (int i = 0; i < 64; ++i) rank += ((unsigned)bcast_i((int)key, i) > key) ? 1 : 0;
            m = ballot64(rank < 16); }
        if (c.lane == 0) selmask[q] = m; }
    block_sync();
    const unsigned long long selm = selmask[qw + fr];
#pragma unroll
    for (int mode = 0; mode < 2; ++mode) {
        f32x4 ot[4]; float mrun = NEG_BIG, lrun = 0.f;
#pragma unroll
        for (int et = 0; et < 4; ++et) ot[et] = (f32x4){0.f, 0.f, 0.f, 0.f};
        const int j0 = (mode == 0) ? 0 : (qt >= 8 ? qt - 8 : 0), ns = (qt - j0) / 2 + 1;
        const int skey = c.tid >> 2, sd0 = (c.tid & 3) * 16, se = c.tid >> 3, sk0 = (c.tid & 7) * 16;
        u32x4 rk0, rk1, rv0, rv1;
#define NSA_STAGE_LOAD(js_) do { const int jb_ = (js_) + (skey >> 6) > qt ? qt : (js_) + (skey >> 6); const size_t tok_ = (size_t)b * SEQ + jb_ * 64 + (skey & 63); \
            const bf16_t* kp_ = ksw + tok_ * 256 + (mode * 2 + g) * 64 + sd0; rk0 = *(const u32x4*)kp_; rk1 = *(const u32x4*)(kp_ + 8); \
            const int jv_ = (js_) + (sk0 >> 6) > qt ? qt : (js_) + (sk0 >> 6); const bf16_t* vp_ = proj + ((size_t)b * SEQ + jv_ * 64 + se) * PROJ_LD + (mode == 0 ? C_NVS : C_NVW) + g * 64 + (sk0 & 63); rv0 = *(const u32x4*)vp_; rv1 = *(const u32x4*)(vp_ + 8); } while (0)
#define NSA_STAGE_WRITE(buf_) do { LDSP bf16_t* kd_ = (LDSP bf16_t*)(c.lds + (buf_) * NA_BUF) + skey * NA_KLD + sd0; *(LDSP u32x4*)kd_ = rk0; *(LDSP u32x4*)(kd_ + 8) = rk1; \
            LDSP bf16_t* vd_ = (LDSP bf16_t*)(c.lds + (buf_) * NA_BUF + NA_VOFF) + se * NA_VLD + sk0; *(LDSP u32x4*)vd_ = rv0; *(LDSP u32x4*)(vd_ + 8) = rv1; } while (0)
        NSA_STAGE_LOAD(j0); NSA_STAGE_WRITE(0);
        block_sync();
        for (int sidx = 0; sidx < ns; ++sidx) {
            const int js = j0 + 2 * sidx;
            if (sidx + 1 < ns) NSA_STAGE_LOAD(js + 2);
            const bool edge = (mode == 0) ? (js + 1 >= qt) : (sidx == 0 || js + 1 >= qt);
            if (mode == 0) { if (edge) nsa_stage<0, true>(c, sidx & 1, js, qt, qr, ot, mrun, lrun, selm); else nsa_stage<0, false>(c, sidx & 1, js, qt, qr, ot, mrun, lrun, selm); }
            else { if (edge) nsa_stage<1, true>(c, sidx & 1, js, qt, qr, ot, mrun, lrun, selm); else nsa_stage<1, false>(c, sidx & 1, js, qt, qr, ot, mrun, lrun, selm); }
            if (sidx + 1 < ns) NSA_STAGE_WRITE((sidx + 1) & 1);
            block_sync();
        }
#undef NSA_STAGE_LOAD
#undef NSA_STAGE_WRITE
        float ls = lrun; ls += xorf<16>(ls); ls += xorf<32>(ls);
        const float sc = gates[(hg * 64 + qw + fr) * 3 + 1 + mode] * (ls > 0.f ? fast_rcp(ls) : 0.f);
#pragma unroll
        for (int et = 0; et < 4; ++et) ofin[et] += ot[et] * sc;
    }
    bf16_t* out = wsp<bf16_t>(c, WS_OUTS) + (size_t)2 * NT * MW + (size_t)(tokq0 + qw + fr) * MW + hd * 64 + fq * 4;
#pragma unroll
    for (int et = 0; et < 4; ++et) { u32x2 w; w.x = pk2(ofin[et][0], ofin[et][1]); w.y = pk2(ofin[et][2], ofin[et][3]); *(u32x2*)(out + et * 16) = w; }
    block_sync();
}
constexpr int PEER_WSCR = (4 * 256 + 3 * 128) * 4;
constexpr int PEER_X8 = 8 * PEER_WSCR;
constexpr int PEER_TAB = PEER_X8 + 8 * 1024;
#ifndef HOST_EMU
DEV int uniform_i(int v) { return __builtin_amdgcn_readfirstlane(v); }
#else
static inline int uniform_i(int v) { return v; }
#endif
DEV unsigned sortkey16(unsigned b) { return (b & 0x8000u) ? (~b & 0xffffu) : (b | 0x8000u); }
DEV f32x2 dot16_fp8(const f32x2 (&x)[8], const u32x4 q, f32x2 s) {
#pragma unroll
    for (int i = 0; i < 4; ++i) { const f32x2 lo = cvt_pk_f32_fp8(q[i], false), hi = cvt_pk_f32_fp8(q[i], true); s = x[2 * i] * lo + s; s = x[2 * i + 1] * hi + s; }
    return s;
}
DEV void axpy16_fp8(f32x2 (&acc)[8], float w, const u32x4 q) {
    const f32x2 w2 = {w, w};
#pragma unroll
    for (int i = 0; i < 4; ++i) { const f32x2 lo = cvt_pk_f32_fp8(q[i], false), hi = cvt_pk_f32_fp8(q[i], true); acc[2 * i] = w2 * lo + acc[2 * i]; acc[2 * i + 1] = w2 * hi + acc[2 * i + 1]; }
}
DEV f32x2 dot16_fp4(const f32x2 (&x)[8], const u32x2 q, f32x2 s) {
#pragma unroll
    for (int i = 0; i < 2; ++i)
#pragma unroll
        for (int b = 0; b < 4; ++b) s = x[4 * i + b] * cvt_pk_f32_fp4(q[i], b) + s;
    return s;
}
DEV void axpy16_fp4(f32x2 (&acc)[8], float w, const u32x2 q) {
    const f32x2 w2 = {w, w};
#pragma unroll
    for (int i = 0; i < 2; ++i)
#pragma unroll
        for (int b = 0; b < 4; ++b) acc[4 * i + b] = w2 * cvt_pk_f32_fp4(q[i], b) + acc[4 * i + b];
}
DEV void peer_init_tab(const Ctx& c) {
    if (c.tid < 64) { const int t = c.tid; int a, b;
        if (t < 16) { a = 0; b = t; } else if (t < 24) { a = 1; b = t - 16; } else if (t < 29) { a = 2; b = t - 24; } else if (t < 33) { a = 3; b = t - 29; }
        else if (t < 36) { a = 4; b = t - 33; } else if (t < 42) { a = 5 + (t - 36) / 2; b = (t - 36) & 1; } else { a = 8 + (t - 42); b = 0; }
        ((LDSP unsigned char*)(c.lds + PEER_TAB))[t] = (t < 50) ? (unsigned char)((a << 4) | b) : (unsigned char)0xff; }
    block_sync();
}
DEV void peer_token(const Ctx& c, int l, int tok) {
    const int lane = c.lane;
    LDSP float* Wv = (LDSP float*)(c.lds + c.wave * PEER_WSCR); LDSP int* Wi = (LDSP int*)(Wv + 256); LDSP float* Sv = (LDSP float*)(Wi + 256); LDSP int* Si = (LDSP int*)(Sv + 256);
    LDSP int* We = Si + 256; LDSP float* Ws = (LDSP float*)(We + 128); LDSP float* Wg = Ws + 128;
    const bf16_t* sc = wsp<bf16_t>(c, WS_SCORES) + (size_t)tok * PEER_N;
#ifndef DUP_TOPK
#define DUP_TOPK 1
#endif
    for (int rep_ = 0; rep_ < DUP_TOPK; ++rep_) {
    {
        unsigned k[32];
        { const int g = lane >> 2, cq = lane & 3; const bf16_t* sp = sc + g * 128 + cq * 32;
#pragma unroll
          for (int v4 = 0; v4 < 4; ++v4) { const u32x4 w = *(const u32x4*)(sp + 8 * v4);
#pragma unroll
            for (int j = 0; j < 4; ++j) { const unsigned d = w[j]; const int i0 = 8 * v4 + 2 * j;
                k[i0] = (sortkey16(d & 0xffffu) << 16) | (unsigned)(127 - (cq * 32 + i0)); k[i0 + 1] = (sortkey16(d >> 16) << 16) | (unsigned)(127 - (cq * 32 + i0 + 1)); } } }
#define PEER_CX(i_, j_) do { const unsigned a_ = k[i_], b_ = k[j_]; k[i_] = a_ > b_ ? a_ : b_; k[j_] = a_ > b_ ? b_ : a_; } while (0)
#pragma unroll
        for (int size = 2; size <= 16; size <<= 1) {
#pragma unroll
            for (int i = 0; i < 32; ++i) { const int j = i ^ (size - 1); if (j > i) PEER_CX(i, j); }
#pragma unroll
            for (int stride = size >> 2; stride > 0; stride >>= 1) {
#pragma unroll
                for (int i = 0; i < 32; ++i) { const int j = i ^ stride; if (j > i) PEER_CX(i, j); } }
        }
#pragma unroll
        for (int i = 0; i < 16; ++i) { const unsigned a_ = k[i], b_ = k[31 - i]; k[i] = a_ > b_ ? a_ : b_; }
#pragma unroll
        for (int stride = 8; stride > 0; stride >>= 1) {
#pragma unroll
            for (int i = 0; i < 16; ++i) { const int j = i ^ stride; if (j > i) PEER_CX(i, j); } }
#pragma unroll
        for (int lvl = 0; lvl < 2; ++lvl) {
            unsigned pk_[16];
#pragma unroll
            for (int i = 0; i < 16; ++i) pk_[i] = (unsigned)(lvl == 0 ? xori<1>((int)k[i]) : xori<2>((int)k[i]));
#pragma unroll
            for (int i = 0; i < 16; ++i) { const unsigned a_ = k[i], b_ = pk_[15 - i]; k[i] = a_ > b_ ? a_ : b_; }
#pragma unroll
            for (int stride = 8; stride > 0; stride >>= 1) {
#pragma unroll
                for (int i = 0; i < 16; ++i) { const int j = i ^ stride; if (j > i) PEER_CX(i, j); } }
        }
#undef PEER_CX
        { const int g = lane >> 2, cq = lane & 3;
#pragma unroll
          for (int cc = 0; cc < 4; ++cc)
#pragma unroll
            for (int j = 0; j < 4; ++j) if (cc == cq) { const unsigned pk = k[4 * cc + j]; const unsigned k16 = pk >> 16, bits = (k16 & 0x8000u) ? (k16 & 0x7fffu) : (~k16 & 0xffffu);
                Sv[g * 16 + 4 * cc + j] = __builtin_bit_cast(float, bits << 16); Si[g * 16 + 4 * cc + j] = 127 - (int)(pk & 0x7fu); } }
    }
    wave_sync();
    {
        const int h = lane >> 3, cq = lane & 7; const LDSP unsigned char* tab = (const LDSP unsigned char*)(c.lds + PEER_TAB);
        unsigned k[16];
#pragma unroll
        for (int j = 0; j < 8; ++j) { const int ci = cq + 8 * j; unsigned key = 0u;
            if (ci < 50) { const unsigned ab = tab[ci]; const int a = (ab >> 4) & 15, b = ab & 15; const float s = Sv[(2 * h) * 16 + a] + Sv[(2 * h + 1) * 16 + b];
                key = (sortkey32(s) & 0xffffff00u) | (unsigned)(255 - (a * 16 + b)); }
            k[j] = key; }
#define PEER_CX(i_, j_) do { const unsigned a_ = k[i_], b_ = k[j_]; k[i_] = a_ > b_ ? a_ : b_; k[j_] = a_ > b_ ? b_ : a_; } while (0)
#pragma unroll
        for (int size = 2; size <= 8; size <<= 1) {
#pragma unroll
            for (int i = 0; i < 8; ++i) { const int j = i ^ (size - 1); if (j > i) PEER_CX(i, j); }
#pragma unroll
            for (int stride = size >> 2; stride > 0; stride >>= 1) {
#pragma unroll
                for (int i = 0; i < 8; ++i) { const int j = i ^ stride; if (j > i) PEER_CX(i, j); } }
        }
#pragma unroll
        for (int i = 0; i < 8; ++i) k[15 - i] = (unsigned)xori<1>((int)k[i]);
#pragma unroll
        for (int stride = 8; stride > 0; stride >>= 1) {
#pragma unroll
            for (int i = 0; i < 16; ++i) { const int j = i ^ stride; if (j > i) PEER_CX(i, j); } }
#pragma unroll
        for (int lvl = 0; lvl < 2; ++lvl) {
            unsigned pk_[16];
#pragma unroll
            for (int i = 0; i < 16; ++i) pk_[i] = (unsigned)(lvl == 0 ? xori<2>((int)k[i]) : xori<4>((int)k[i]));
#pragma unroll
            for (int i = 0; i < 16; ++i) { const unsigned a_ = k[i], b_ = pk_[15 - i]; k[i] = a_ > b_ ? a_ : b_; }
#pragma unroll
            for (int stride = 8; stride > 0; stride >>= 1) {
#pragma unroll
                for (int i = 0; i < 16; ++i) { const int j = i ^ stride; if (j > i) PEER_CX(i, j); } }
        }
#undef PEER_CX
#pragma unroll
        for (int cc = 0; cc < 8; ++cc)
#pragma unroll
            for (int j = 0; j < 2; ++j) if (cc == cq) { const int pos = 255 - (int)(k[2 * cc + j] & 0xffu), a = pos >> 4, b = pos & 15;
                We[h * 16 + 2 * cc + j] = (Si[(2 * h) * 16 + a] * 128 + Si[(2 * h + 1) * 16 + b]) & 16383; Ws[h * 16 + 2 * cc + j] = Sv[(2 * h) * 16 + a] + Sv[(2 * h + 1) * 16 + b]; }
    }
    wave_sync();
    { const float mx = Ws[(lane >> 3) * 16]; const float e0 = fast_exp(Ws[2 * lane] - mx), e1 = fast_exp(Ws[2 * lane + 1] - mx); float sm = e0 + e1;
      sm += xorf<1>(sm); sm += xorf<2>(sm); sm += xorf<4>(sm); const float inv = fast_rcp(sm); Wg[2 * lane] = e0 * inv; Wg[2 * lane + 1] = e1 * inv; }
    wave_sync();
    }
    const bf16_t* xb = wsp<bf16_t>(c, WS_XB) + (size_t)tok * DM; const unsigned char* PU = wsp<unsigned char>(c, WS_PU); const unsigned char* PV = wsp<unsigned char>(c, WS_PV);
    f32x2 xf[8];
    { const u32x4 x0 = *(const u32x4*)(xb + 16 * lane), x1 = *(const u32x4*)(xb + 16 * lane + 8);
      xf[0] = (f32x2){bflo(x0.x), bfhi(x0.x)}; xf[1] = (f32x2){bflo(x0.y), bfhi(x0.y)}; xf[2] = (f32x2){bflo(x0.z), bfhi(x0.z)}; xf[3] = (f32x2){bflo(x0.w), bfhi(x0.w)};
      xf[4] = (f32x2){bflo(x1.x), bfhi(x1.x)}; xf[5] = (f32x2){bflo(x1.y), bfhi(x1.y)}; xf[6] = (f32x2){bflo(x1.z), bfhi(x1.z)}; xf[7] = (f32x2){bflo(x1.w), bfhi(x1.w)}; }
    const float rstd = pg8::rstd_of(pg8::rss_slots16(wsp<float>(c, WS_RSS2) + (size_t)tok * 16)) * (1.0f / 64.0f);
    f32x2 acc[8];
#pragma unroll
    for (int j = 0; j < 8; ++j) acc[j] = (f32x2){0.f, 0.f};
    LDSP unsigned char* X8 = (LDSP unsigned char*)(c.lds + PEER_X8 + c.wave * 1024);
    { u32x4 xq;
      xq.x = cvt_pk_fp8_f32(xf[1][0], xf[1][1], cvt_pk_fp8_f32(xf[0][0], xf[0][1], 0u, false), true); xq.y = cvt_pk_fp8_f32(xf[3][0], xf[3][1], cvt_pk_fp8_f32(xf[2][0], xf[2][1], 0u, false), true);
      xq.z = cvt_pk_fp8_f32(xf[5][0], xf[5][1], cvt_pk_fp8_f32(xf[4][0], xf[4][1], 0u, false), true); xq.w = cvt_pk_fp8_f32(xf[7][0], xf[7][1], cvt_pk_fp8_f32(xf[6][0], xf[6][1], 0u, false), true);
      *(LDSP u32x4*)(X8 + 16 * lane) = xq;
    }
    wave_sync();
#define PEER_LOADV(buf, base) do { _Pragma("unroll") for (int k_ = 0; k_ < 8; ++k_) { const unsigned o_ = ((unsigned)We[(base) + k_] << 9) + 8u * (unsigned)lane; buf[k_] = *(const u32x2*)(PV + o_); } } while (0)
#define PEER_LOADU(buf, hh) do { const unsigned o_ = ((unsigned)We[(hh) * 16 + (lane & 15)] << 9) + 16u * (unsigned)(lane >> 4); _Pragma("unroll") for (int s_ = 0; s_ < 8; ++s_) buf[s_] = *(const u32x4*)(PU + o_ + 64u * s_); } while (0)
    u32x4 ua[8]; u32x2 bv0[8], bv1[8];
    PEER_LOADU(ua, 0); PEER_LOADV(bv0, 0); PEER_LOADV(bv1, 8);
#ifndef HOST_EMU
#define PEER_SCHED_FENCE() __builtin_amdgcn_sched_barrier(0)
#else
#define PEER_SCHED_FENCE() do {} while (0)
#endif
    for (int h = 0; h < 8; ++h) {
        f32x4 dacc = {0.f, 0.f, 0.f, 0.f};
#pragma unroll
        for (int s = 0; s < 8; ++s) { const LDSP unsigned char* xq = X8 + 128 * s + 16 * (lane >> 4);
            dacc = mfma_fp4_fp8(ua[s], *(const LDSP u32x4*)xq, *(const LDSP u32x4*)(xq + 64), dacc); }
        if (h < 7) PEER_LOADU(ua, h + 1);
        const int srcl = 16 * ((lane & 15) >> 2);
        const float d0 = shfl_f(dacc[0], srcl), d1 = shfl_f(dacc[1], srcl), d2 = shfl_f(dacc[2], srcl), d3 = shfl_f(dacc[3], srcl);
        const float dk = (lane & 2) ? ((lane & 1) ? d3 : d2) : ((lane & 1) ? d1 : d0);
        const float wk = Wg[h * 16 + (lane & 15)] * gelu_erf(dk * rstd) * 0.1f;
#pragma unroll
        for (int k = 0; k < 8; ++k) axpy16_fp4(acc, bcast_f(wk, k), bv0[k]);
        PEER_SCHED_FENCE();
        if (h < 7) PEER_LOADV(bv0, h * 16 + 16);
#pragma unroll
        for (int k = 0; k < 8; ++k) axpy16_fp4(acc, bcast_f(wk, 8 + k), bv1[k]);
        PEER_SCHED_FENCE();
        if (h < 7) PEER_LOADV(bv1, h * 16 + 24);
    }
#undef PEER_SCHED_FENCE
#undef PEER_LOADU
#undef PEER_LOADV
    float* orow = c.out + (size_t)tok * DM + 16 * lane; float ss = 0.f; f32x4 o[4];
#pragma unroll
    for (int j = 0; j < 4; ++j) { o[j] = *(const f32x4*)(orow + 4 * j); o[j] += (f32x4){acc[2 * j][0], acc[2 * j][1], acc[2 * j + 1][0], acc[2 * j + 1][1]}; *(f32x4*)(orow + 4 * j) = o[j]; }
    if (l + 1 < DEPTH) {
        bf16_t* xo = wsp<bf16_t>(c, WS_XB) + (size_t)tok * DM + 16 * lane;
        u32x4 w0, w1; w0.x = pk2(o[0][0], o[0][1]); w0.y = pk2(o[0][2], o[0][3]); w0.z = pk2(o[1][0], o[1][1]); w0.w = pk2(o[1][2], o[1][3]);
        w1.x = pk2(o[2][0], o[2][1]); w1.y = pk2(o[2][2], o[2][3]); w1.z = pk2(o[3][0], o[3][1]); w1.w = pk2(o[3][2], o[3][3]);
        *(u32x4*)xo = w0; *(u32x4*)(xo + 8) = w1;
#pragma unroll
        for (int j = 0; j < 4; ++j) ss += (o[j][0] * o[j][0] + o[j][1] * o[j][1]) + (o[j][2] * o[j][2] + o[j][3] * o[j][3]);
        ss = wave_sum(ss);
        if (lane == 0) wsp<float>(c, WS_RSS1)[tok] = ss;
    }
    wave_sync();
}
DEV void peer_table_rows(const Ctx& c, int l) {
    const float* g2 = CIN(17) + (size_t)l * DM;
    const f32x4 ga = *((const f32x4*)g2 + 4 * c.lane), gb = *((const f32x4*)g2 + 4 * c.lane + 1), gc = *((const f32x4*)g2 + 4 * c.lane + 2), gd = *((const f32x4*)g2 + 4 * c.lane + 3);
    for (int r = c.bid * NWAVE + c.wave; r < 2 * 16384; r += c.nblk * NWAVE) {
        const int tab = r >> 14, e = r & 16383;
        const f32x4* src = (const f32x4*)((tab == 0 ? CIN(20) : CIN(21)) + ((size_t)l * 16384 + e) * DM) + 4 * c.lane;
        f32x4 v0 = src[0], v1 = src[1], v2 = src[2], v3 = src[3];
        if (tab == 0) { v0 *= ga * 64.0f; v1 *= gb * 64.0f; v2 *= gc * 64.0f; v3 *= gd * 64.0f;
        } else { v0 *= 10.0f; v1 *= 10.0f; v2 *= 10.0f; v3 *= 10.0f; }
        {
            u32x2 q;
            q.x = fp4_code(v0[0]) | (fp4_code(v0[1]) << 4) | (fp4_code(v0[2]) << 8) | (fp4_code(v0[3]) << 12) | (fp4_code(v1[0]) << 16) | (fp4_code(v1[1]) << 20) | (fp4_code(v1[2]) << 24) | (fp4_code(v1[3]) << 28);
            q.y = fp4_code(v2[0]) | (fp4_code(v2[1]) << 4) | (fp4_code(v2[2]) << 8) | (fp4_code(v2[3]) << 12) | (fp4_code(v3[0]) << 16) | (fp4_code(v3[1]) << 20) | (fp4_code(v3[2]) << 24) | (fp4_code(v3[3]) << 28);
            *(u32x2*)(wsp<unsigned char>(c, tab == 0 ? WS_PU : WS_PV) + (size_t)e * (DM / 2) + 8 * c.lane) = q;
        }
    }
}
#ifndef HOST_EMU
#define XB_TMO      128
#define XB_XCNT(j)  (256  + 64 * (j))
#define XB_XSUB(j)  (1280 + 64 * (j))
#define XB_XGEN(j)  (2304 + 64 * (j))
#define XB_TOP      3328
#define XB_TOPGEN   3392
#define XCD_BAR_WORDS 3456
#define XB_SPIN_CAP (1u << 18)

__device__ __forceinline__ unsigned xb_ld(unsigned* p)              { return __hip_atomic_load(p, __ATOMIC_RELAXED, __HIP_MEMORY_SCOPE_AGENT); }
__device__ __forceinline__ unsigned xb_add(unsigned* p, unsigned v) { return __hip_atomic_fetch_add(p, v, __ATOMIC_RELAXED, __HIP_MEMORY_SCOPE_AGENT); }
__device__ __forceinline__ unsigned xb_xcc_id() { return (unsigned)__builtin_amdgcn_s_getreg((3 << 11) | 20) & 0xFu; }
#define XB_SPIN(cond, bar) do { unsigned _sp = 0; while (cond) { __builtin_amdgcn_s_sleep(1); \
    if ((++_sp & 255u) == 0u) { if (xb_ld(&(bar)[XB_TMO])) break; if (_sp > XB_SPIN_CAP) { atomicAdd(&(bar)[XB_TMO], 1u); break; } } } } while (0)

struct XcdBarrier {
    unsigned* bar; unsigned x;
    volatile __attribute__((address_space(3))) unsigned* st;
};

__device__ __forceinline__ XcdBarrier xcd_barrier_post(unsigned* bar, volatile __attribute__((address_space(3))) unsigned* st) {
    XcdBarrier b; b.bar = bar; b.x = xb_xcc_id(); b.st = st;
    if (threadIdx.x == 0) (void)xb_add(&bar[XB_XCNT(b.x)], 1u);
    return b;
}
__device__ __forceinline__ void xcd_barrier_complete(unsigned* bar, unsigned x, unsigned& nloc, unsigned& nx) {
    const unsigned G = gridDim.x * gridDim.y * gridDim.z;
    unsigned sum, cnt, mine, sp = 0u;
    for (;;) {
        sum = 0u; cnt = 0u; mine = 0u;
#pragma unroll
        for (unsigned j = 0; j < 16; ++j) { const unsigned c = xb_ld(&bar[XB_XCNT(j)]); sum += c; cnt += (c > 0u) ? 1u : 0u; mine = (j == x) ? c : mine; }
        if (sum == G) break;
        __builtin_amdgcn_s_sleep(1);
        if ((++sp & 255u) == 0u) { if (xb_ld(&bar[XB_TMO])) break; if (sp > XB_SPIN_CAP) { atomicAdd(&bar[XB_TMO], 1u); break; } }
    }
    nloc = mine > 0u ? mine : 1u; nx = cnt > 0u ? cnt : 1u;
}

__device__ __forceinline__ void xcd_barrier(const XcdBarrier& b) {
    asm volatile("s_waitcnt vmcnt(0)" ::: "memory");
    __syncthreads();
    if (threadIdx.x == 0) {
        unsigned* bar = b.bar;
        __builtin_amdgcn_s_waitcnt(0);
        unsigned nloc = b.st[0], nx = b.st[1];
        if (nloc == 0u) { xcd_barrier_complete(bar, b.x, nloc, nx); b.st[0] = nloc; b.st[1] = nx; }
        const unsigned old = xb_add(&bar[XB_XSUB(b.x)], 1u);
        const unsigned gen = old / nloc;
        if (old + 1u == (gen + 1u) * nloc) {
            __builtin_amdgcn_fence(__ATOMIC_RELEASE, "agent");
            asm volatile("s_waitcnt vmcnt(0)" ::: "memory");
            const unsigned og = xb_add(&bar[XB_TOP], 1u);
            const unsigned tg = og / nx;
            if (og + 1u == (tg + 1u) * nx) xb_add(&bar[XB_TOPGEN], 1u);
            else XB_SPIN(xb_ld(&bar[XB_TOPGEN]) == tg, bar);
            __builtin_amdgcn_fence(__ATOMIC_ACQUIRE, "agent");
            xb_add(&bar[XB_XGEN(b.x)], 1u);
            asm volatile("s_waitcnt vmcnt(0)" ::: "memory");
        } else {
            XB_SPIN(xb_ld(&bar[XB_XGEN(b.x)]) == gen, bar);
            __builtin_amdgcn_fence(__ATOMIC_ACQUIRE, "agent");
            asm volatile("s_waitcnt vmcnt(0)" ::: "memory");
        }
    }
    __syncthreads();
}


#endif
#ifndef EXTRA_K
#define EXTRA_K 0
#endif
#ifndef P0X
#define P0X 31
#endif
#ifndef P2X
#define P2X 15
#endif
#ifndef DBG_COPY
#define DBG_COPY 0
#endif
#ifndef DBG_PHASE
#define DBG_PHASE 5
#endif
#ifndef DUP_NSA
#define DUP_NSA 1
#endif
#ifndef DUP_REC
#define DUP_REC 1
#endif
#ifndef DUP_P5
#define DUP_P5 1
#endif
#ifndef DUP_P2
#define DUP_P2 1
#endif
#ifndef DUP_P0
#define DUP_P0 1
#endif
#ifndef DUP_P1
#define DUP_P1 1
#endif
#ifndef DUP_NP
#define DUP_NP 1
#endif
#ifndef HOST_EMU
#define GRID_SYNC() do { if (ph == 1) cg::this_grid().sync(); else { XcdBarrier xb_; xb_.bar = (unsigned*)(lds_ptr_entry(22) + WS_BARRIER); xb_.x = xb_xcc_id(); \
    xb_.st = (volatile __attribute__((address_space(3))) unsigned*)(smem_raw + LDS_PTRS + 192); xcd_barrier(xb_); } } while (0)
#else
#define GRID_SYNC() grid_sync_impl()
#endif

#ifndef HOST_EMU
DEV unsigned char* lds_ptr_entry(int i) {
    int z; asm volatile("s_mov_b32 %0, 0" : "=s"(z)); i += z;
    const unsigned long long v = ((volatile LDSP unsigned long long*)((LDSP unsigned char*)smem_raw + LDS_PTRS))[i];
    const unsigned lo = __builtin_amdgcn_readfirstlane((unsigned)v), hi = __builtin_amdgcn_readfirstlane((unsigned)(v >> 32));
    return (unsigned char*)(__attribute__((address_space(1))) unsigned char*)(((unsigned long long)hi << 32) | lo);
}
#endif
DEV Ctx make_ctx(const Params& p, int wave0) {
#ifndef HOST_EMU
    Ctx c; c.out = p.out; c.ws = p.ws; c.tid = wave0 * 64 + fresh_lane();
#else
    Ctx c; c.out = p.out; c.ws = p.ws; c.tid = TID();
#endif
    c.bid = BID(); c.nblk = NBLK(); int z = 0;
#ifndef HOST_EMU
    asm volatile("" : "+v"(c.tid), "+s"(c.bid), "+s"(c.nblk));
    asm volatile("s_mov_b32 %0, 0" : "=s"(z));
    c.ws = lds_ptr_entry(22); c.out = (float*)lds_ptr_entry(23);
#endif
    c.lds = SMEM_PTR() + z; c.lane = c.tid & 63; c.wave = c.tid >> 6;
#ifndef HOST_EMU
    c.wave = __builtin_amdgcn_readfirstlane(c.wave);
#endif
    return c;
}
#ifndef HOST_EMU
__global__ void __launch_bounds__(NTHR, 2) fwd_kernel(Params p)
#else
void fwd_kernel(Params p)
#endif
{
    {
        LDSP char* lds0 = SMEM_PTR();
        if (TID() == 0) {
#pragma unroll
            for (int i = 0; i < 22; ++i) ((LDSP unsigned long long*)(lds0 + LDS_PTRS))[i] = (unsigned long long)p.in[i];
            ((LDSP unsigned long long*)(lds0 + LDS_PTRS))[22] = (unsigned long long)p.ws; ((LDSP unsigned long long*)(lds0 + LDS_PTRS))[23] = (unsigned long long)p.out;
        }
        block_sync();
    }
#ifndef HOST_EMU
    const int wave0 = __builtin_amdgcn_readfirstlane((int)threadIdx.x >> 6);
#else
    const int wave0 = 0;
#endif
#ifndef HOST_EMU
    volatile __attribute__((address_space(3))) unsigned* xst = (volatile __attribute__((address_space(3))) unsigned*)(smem_raw + LDS_PTRS + 192);
    if (threadIdx.x == 0) { xst[0] = 0u; xst[1] = 0u; }
    __syncthreads();
    (void)xcd_barrier_post((unsigned*)(p.ws + WS_BARRIER), xst);
#endif
    int ph = 0;
#define PHASE_END() do { ++ph; if (DBG_COPY && ph == DBG_PHASE) { GRID_SYNC(); Ctx c = make_ctx(p, wave0); \
        const bf16_t* src = wsp<bf16_t>(c, DBG_COPY == 1 ? WS_OUTS : DBG_COPY == 2 ? WS_ST : DBG_COPY == 3 ? WS_PROJ : DBG_COPY == 4 ? WS_HALO : DBG_COPY >= 6 ? WS_OUTS + (size_t)(DBG_COPY - 6) * NT * MW * 2 : WS_KSW); const size_t nsrc = DBG_COPY >= 6 ? (size_t)NT * MW : DBG_COPY == 2 ? 3 * ST_ONE / 2 : DBG_COPY == 4 ? (size_t)BATCH * NC * 3 * 512 + (size_t)NT * NH * 2 * 2 + (size_t)BATCH * NH * NC * 64 * 2 : (size_t)NT * DM; \
        for (size_t i = (size_t)c.bid * NTHR + c.tid; i < (size_t)NT * DM; i += (size_t)c.nblk * NTHR) c.out[i] = i < nsrc ? bf2f(src[i]) : 0.f; return; } \
        if (ph >= p.phase_hi) return; GRID_SYNC(); if (extra && ph - ph_x0 >= EXTRA_K) return; } while (0)
    int ph_x0 = 0;
    for (int it = 0; it < DEPTH + (EXTRA_K > 0 ? 1 : 0); ++it) {
        const int l = it < DEPTH ? it : 0; const bool extra = it >= DEPTH; if (extra) ph_x0 = ph;
        for (int rep = 0; rep < DUP_P0; ++rep) { Ctx c = make_ctx(p, wave0); p0_prep(c, l, extra ? P0X : 31); }
        PHASE_END();
        for (int rep = 0; rep < DUP_P1; ++rep) {
            Ctx c = make_ctx(p, wave0);
            pg8::Gemm g{wsp<bf16_t>(c, WS_XB), wsp<bf16_t>(c, WS_WIN), NT, PROJ_N, DM}; pg8::StaticOrder S; S.init(NT, PROJ_N, c.nblk, c.bid);
            pg8::EpiScaleBf16<1, true> E{wsp<bf16_t>(c, WS_PROJ), PROJ_LD, wsp<float>(c, WS_RSS1), PROJ_LD, wsp<bf16_t>(c, WS_HALO)};
            pg8::gemm_phase<pg8::EpiScaleBf16<1, true>, pg8::StaticOrder, true, true>(GEMM_LDS, g, S, E, c.tid);
        }
        PHASE_END();
        const int p2m = extra ? P2X : 15;
        if (p2m & 1) for (int rep = 0; rep < DUP_P2; ++rep) { Ctx c = make_ctx(p, wave0); for (int u = c.bid; u < 3 * BATCH * NH * NC; u += c.nblk) recur_local_unit(c, l, u); }
        if (p2m & 2) for (int rep = 0; rep < DUP_NP; ++rep) { Ctx c = make_ctx(p, wave0); for (int u = c.bid; u < BATCH * 16; u += c.nblk) nsa_compress_unit(c, l, u); }
        if (p2m & 4) for (int rep = 0; rep < DUP_NP; ++rep) { Ctx c = make_ctx(p, wave0); for (int it = c.bid; it < NT / 32; it += c.nblk) nsa_kprep_item(c, l, it); }
        if (p2m & 8) for (int rep = 0; rep < DUP_NP; ++rep) { Ctx c = make_ctx(p, wave0); for (int it = c.bid; it < BATCH * 4 * NC; it += c.nblk) nsa_vprep_item(c, it); }
        PHASE_END();
        { Ctx c = make_ctx(p, wave0); recur_scan(c); }
        PHASE_END();
        for (int rep = 0; rep < DUP_NSA; ++rep) { Ctx c = make_ctx(p, wave0);
        for (int u = c.bid; u < BATCH * 2 * NSEL; u += c.nblk) {
            const int nbg = BATCH * 2, bg = u % nbg, qi = u / nbg; int qt = qi;
            if (NSEL == 64) { const int r = qi >> 4, ql = qi & 15; qt = (r == 0) ? 63 - ql : (r == 1) ? ql : (r == 2) ? 47 - ql : 16 + ql; }
            nsa_attn_unit(c, l, bg * NSEL + qt);
        } }
        for (int rep = 0; rep < DUP_REC; ++rep) { Ctx c = make_ctx(p, wave0); for (int u = c.bid * NWAVE + c.wave; u < 3 * BATCH * NH * NC; u += c.nblk * NWAVE) recur_out_wave(c, l, u); }
        PHASE_END();
        { Ctx c = make_ctx(p, wave0); peer_table_rows(c, l); }
        for (int rep = 0; rep < DUP_P5; ++rep) {
            { Ctx c = make_ctx(p, wave0); pg8::MixOrder<true> S{(NT / 256) * 4, c.nblk, c.bid, NT / 256};
              pg8::Gemm g{wsp<bf16_t>(c, WS_OUTS), wsp<bf16_t>(c, WS_WUP), 4 * NT, 4 * DM, MW};
              pg8::EpiU E{wsp<bf16_t>(c, WS_UALL)};
              pg8::gemm_phase<pg8::EpiU, pg8::MixOrder<true>, false, true>(GEMM_LDS, g, S, E, c.tid); }
            GRID_SYNC();
            { Ctx c = make_ctx(p, wave0); pg8::MixOrder<false> S{(NT / 256) * 4, c.nblk, c.bid, NT / 256};
              pg8::Gemm g{wsp<bf16_t>(c, WS_XB), wsp<bf16_t>(c, WS_WG), NT, 4 * DM, DM};
              pg8::EpiGate E{wsp<bf16_t>(c, WS_UALL), wsp<bf16_t>(c, WS_MERGED), wsp<float>(c, WS_RSS1), NT};
              pg8::gemm_phase<pg8::EpiGate, pg8::MixOrder<false>, false, true>(GEMM_LDS, g, S, E, c.tid); }
        }
        PHASE_END();
        {
            Ctx c = make_ctx(p, wave0); const float* xres = (l == 0) ? CIN(0) : c.out;
            pg8::Gemm g{wsp<bf16_t>(c, WS_MERGED), wsp<bf16_t>(c, WS_WOUT), NT, DM, DM}; pg8::StaticOrder S; S.init(NT, DM, c.nblk, c.bid);
            pg8::EpiOut E{xres, c.out, wsp<bf16_t>(c, WS_XB), wsp<float>(c, WS_RSS2)};
            pg8::gemm_phase<pg8::EpiOut, pg8::StaticOrder, true, true>(GEMM_LDS, g, S, E, c.tid);
        }
        PHASE_END();
        {
            Ctx c = make_ctx(p, wave0);
            pg8::Gemm g{wsp<bf16_t>(c, WS_XB), wsp<bf16_t>(c, WS_WQ2), NT, PEER_N, DM}; pg8::StaticOrder S; S.init(NT, PEER_N, c.nblk, c.bid);
            pg8::EpiScaleBf16<16> E{wsp<bf16_t>(c, WS_SCORES), PEER_N, wsp<float>(c, WS_RSS2), PEER_N, nullptr};
            pg8::gemm_phase<pg8::EpiScaleBf16<16>, pg8::StaticOrder, true, true>(GEMM_LDS, g, S, E, c.tid);
        }
        PHASE_END();
        { Ctx c = make_ctx(p, wave0); peer_init_tab(c); for (int t = c.bid * NWAVE + c.wave; t < NT; t += c.nblk * NWAVE) peer_token(c, l, t); }
        PHASE_END();
    }
}

#ifndef HOST_EMU
extern "C" void kernel_launch(void* const* d_in, const int* in_sizes, int n_in, void* d_out, int out_size, void* d_ws, size_t ws_size, hipStream_t stream) {
    static int grid = 0;
    if (grid == 0) {
        if (n_in != 22 || out_size != NT * DM || ws_size < WS_NEED) { fprintf(stderr, "kernel_launch: unexpected shapes (n_in %d out %d ws %zu need %zu)\n", n_in, out_size, ws_size, (size_t)WS_NEED); grid = -1; return; }
        int dev = 0, cus = 0, per_cu = 0;
        hipGetDevice(&dev); hipDeviceGetAttribute(&cus, hipDeviceAttributeMultiprocessorCount, dev);
        if (hipFuncSetAttribute((const void*)fwd_kernel, hipFuncAttributeMaxDynamicSharedMemorySize, LDS_BYTES) != hipSuccess) { fprintf(stderr, "kernel_launch: hipFuncSetAttribute failed\n"); grid = -1; return; }
        if (hipOccupancyMaxActiveBlocksPerMultiprocessor(&per_cu, (const void*)fwd_kernel, NTHR, LDS_BYTES) != hipSuccess || per_cu < 1) { fprintf(stderr, "kernel_launch: occupancy query failed (%d)\n", per_cu); (void)hipGetLastError(); per_cu = 1; }
        grid = cus;
        fprintf(stderr, "kernel_launch: grid %d (per_cu %d)\n", grid, per_cu);
    }
    if (grid < 0) return;
    if (hipMemsetAsync((char*)d_ws + WS_BARRIER, 0, 16384, stream) != hipSuccess) { fprintf(stderr, "kernel_launch: memset failed\n"); return; }
    Params p{};
    for (int i = 0; i < 22; ++i) p.in[i] = (const float*)d_in[i];
    p.out = (float*)d_out; p.ws = (unsigned char*)d_ws; p.phase_lo = 0; p.phase_hi = 1 << 20;
    void* args[] = {&p};
    hipError_t e = hipLaunchCooperativeKernel((const void*)fwd_kernel, dim3(grid), dim3(NTHR), args, LDS_BYTES, stream);
    if (e != hipSuccess) fprintf(stderr, "kernel_launch: cooperative launch failed: %s (grid %d)\n", hipGetErrorString(e), grid);
}
#endif
```

```cpp
#ifndef HOST_EMU
#include <hip/hip_runtime.h>
#include <hip/hip_cooperative_groups.h>
#include <cstdio>
#include <cstdint>
namespace cg = cooperative_groups;
#endif

#ifndef CFG_B
#define CFG_B 8
#endif
#ifndef CFG_S
#define CFG_S 4096
#endif

constexpr int BATCH = CFG_B, SEQ = CFG_S, DM = 1024, DEPTH = 2;
constexpr int NT = BATCH * SEQ;
constexpr int NH = 4, HD = 64, MW = 256, CH = 64, NC = SEQ / CH;
constexpr int N_IN_ORIG = 4116, PROJ_N = 4352, PROJ_LD = 4128;
constexpr int NCMP = (SEQ - 32) / 16 + 1;
constexpr int NCMP_PAD = SEQ / 16;
constexpr int NSEL = SEQ / 64;
constexpr int PEER_N = 2048;
constexpr float NORM_EPS = 1e-6f;
constexpr int NTHR = 512, NWAVE = 8;
constexpr int C_HQ = 0, C_HF = 256, C_HI = 512, C_HG = 768;
constexpr int C_MQ = 1024, C_MK = 1280, C_MV = 1536, C_MO = 1792;
constexpr int C_NQ = 2048, C_NKC = 2304, C_NVC = 2432, C_NKS = 2560, C_NVS = 2688, C_NKW = 2816, C_NVW = 2944;
constexpr int C_RQ = 3072, C_RK = 3328, C_RV = 3584, C_RG = 3840;
constexpr int C_MI = 4096, C_MF = 4100, C_NG = 4104;

typedef unsigned short bf16_t;
#ifndef HOST_EMU
typedef short bf16x8 __attribute__((ext_vector_type(8)));
typedef float f32x4 __attribute__((ext_vector_type(4)));
#endif
typedef unsigned u32x4 __attribute__((ext_vector_type(4)));
typedef unsigned u32x2 __attribute__((ext_vector_type(2)));
typedef float f32x2 __attribute__((ext_vector_type(2)));

constexpr size_t al256(size_t x) { return (x + 255) & ~(size_t)255; }
constexpr size_t WS_WIN = 0;
constexpr size_t WS_WG = WS_WIN + al256((size_t)PROJ_N * DM * 2);
constexpr size_t WS_WUP = WS_WG + al256((size_t)4 * DM * DM * 2);
constexpr size_t WS_WOUT = WS_WUP + al256((size_t)4 * DM * MW * 2);
constexpr size_t WS_WQ2 = WS_WOUT + al256((size_t)DM * DM * 2);
constexpr size_t WS_WCT = WS_WQ2 + al256((size_t)PEER_N * DM * 2);
constexpr size_t WS_CBIAS = WS_WCT + al256((size_t)2 * 64 * 2048 * 2);
constexpr size_t WS_ROPE = WS_CBIAS + 1024;
constexpr size_t WS_RSS1 = WS_ROPE + al256((size_t)SEQ * 64 * 4);
constexpr size_t WS_RSS2 = WS_RSS1 + al256((size_t)NT * 4);
constexpr size_t WS_XB = WS_RSS2 + al256((size_t)NT * 16 * 4);
constexpr size_t WS_OUTS = WS_XB + al256((size_t)NT * DM * 2);
constexpr size_t WS_ST = WS_OUTS + al256((size_t)NT * DM * 2);
constexpr size_t ST_ONE = (size_t)BATCH * NH * NC * 4096 * 2;
constexpr size_t WS_GDEC = WS_ST + al256(3 * ST_ONE);
constexpr size_t WS_MNL = WS_GDEC + al256((size_t)BATCH * NH * NC * 64 * 4);
constexpr size_t WS_MSC = WS_MNL + al256((size_t)BATCH * NH * NC * 64 * 4);
constexpr size_t WS_KCMP = WS_MSC + al256((size_t)BATCH * NH * NC * 4 * 4);
constexpr size_t WS_VCMPT = WS_KCMP + al256((size_t)BATCH * 2 * NCMP_PAD * 64 * 2);
constexpr size_t WS_KSW = WS_VCMPT + al256((size_t)BATCH * 2 * NCMP_PAD * 64 * 2);
constexpr size_t WS_HALO = WS_KSW + al256((size_t)NT * 256 * 2);
constexpr size_t WS_MTS = WS_HALO + al256((size_t)BATCH * NC * 3 * 512 * 2);
constexpr size_t WS_G31 = WS_MTS + al256((size_t)NT * NH * 2 * 4);
constexpr size_t WS_PROJ = WS_G31 + al256((size_t)BATCH * NH * NC * 64 * 4);
constexpr size_t PROJ_BYTES = al256((size_t)NT * PROJ_LD * 2);
constexpr size_t WS_BARRIER = WS_PROJ + PROJ_BYTES;
constexpr size_t WS_END = WS_BARRIER + 16384;
constexpr size_t WS_UALL = WS_PROJ;
constexpr size_t WS_MERGED = WS_OUTS;
constexpr size_t WS_SCORES = WS_PROJ;
constexpr bool TABLES_IN_ST = 3 * ST_ONE >= (size_t)2 * 16384 * DM;
constexpr size_t WS_PU = TABLES_IN_ST ? WS_ST : WS_END;
constexpr size_t WS_PV = WS_PU + al256((size_t)16384 * DM);
static_assert((size_t)4 * NT * DM * 2 <= PROJ_BYTES, "U fits the proj region");
static_assert(WS_END <= (size_t)536870912, "workspace budget");
constexpr size_t WS_NEED = TABLES_IN_ST ? WS_END : WS_PV + (size_t)16384 * DM;

constexpr int LDS_BYTES = 147456;

struct Params {
    const float* in[22];
    float* out;
    unsigned char* ws;
    int phase_lo, phase_hi;
};

#ifndef HOST_EMU
#define DEV __device__ __forceinline__
#define TID() ((int)threadIdx.x)
#define BID() ((int)blockIdx.x)
#define NBLK() ((int)gridDim.x)
extern __shared__ __attribute__((aligned(16))) unsigned char smem_raw[];
#define LDSP __attribute__((address_space(3)))
#define SMEM_PTR() ((LDSP char*)smem_raw)
DEV void block_sync() { __syncthreads(); }
DEV int fresh_lane() { int lane; asm volatile("v_mbcnt_lo_u32_b32 %0, -1, 0\n\tv_mbcnt_hi_u32_b32 %0, -1, %0" : "=v"(lane)); return lane; }
template <int M> DEV int xori(int v) {
    if constexpr (M < 32) return __builtin_amdgcn_ds_swizzle(v, (M << 10) | 0x1f);
    else return __builtin_amdgcn_ds_bpermute((fresh_lane() ^ M) << 2, v);
}
template <int M> DEV float xorf(float v) { return __builtin_bit_cast(float, xori<M>(__builtin_bit_cast(int, v))); }
DEV int shfl_i(int v, int src) { return __builtin_amdgcn_ds_bpermute(src << 2, v); }
DEV float shfl_f(float v, int src) { return __builtin_bit_cast(float, __builtin_amdgcn_ds_bpermute(src << 2, __builtin_bit_cast(int, v))); }
DEV unsigned long long ballot64(bool p) { return __builtin_amdgcn_ballot_w64(p); }
DEV int mbcnt64(unsigned long long m) { return (int)__builtin_amdgcn_mbcnt_hi((unsigned)(m >> 32), __builtin_amdgcn_mbcnt_lo((unsigned)m, 0u)); }
DEV float bcast_f(float v, int j) { return __builtin_bit_cast(float, __builtin_amdgcn_readlane(__builtin_bit_cast(int, v), j)); }
DEV int bcast_i(int v, int j) { return __builtin_amdgcn_readlane(v, j); }
DEV f32x2 cvt_pk_f32_fp8(unsigned p, bool hi) { return hi ? __builtin_amdgcn_cvt_pk_f32_fp8((int)p, true) : __builtin_amdgcn_cvt_pk_f32_fp8((int)p, false); }
template <int SEL> DEV f32x2 cvt_pk_f32_fp4_(unsigned p) { return __builtin_amdgcn_cvt_scalef32_pk_f32_fp4(p, 1.0f, SEL); }
DEV f32x2 cvt_pk_f32_fp4(unsigned p, int bytesel) { return bytesel == 0 ? cvt_pk_f32_fp4_<0>(p) : bytesel == 1 ? cvt_pk_f32_fp4_<1>(p) : bytesel == 2 ? cvt_pk_f32_fp4_<2>(p) : cvt_pk_f32_fp4_<3>(p); }
DEV unsigned cvt_pk_fp8_f32(float a, float b, unsigned old, bool hi) { return hi ? (unsigned)__builtin_amdgcn_cvt_pk_fp8_f32(a, b, (int)old, true) : (unsigned)__builtin_amdgcn_cvt_pk_fp8_f32(a, b, (int)old, false); }
DEV f32x4 mfma16(bf16x8 a, bf16x8 b, f32x4 c) { return __builtin_amdgcn_mfma_f32_16x16x32_bf16(a, b, c, 0, 0, 0); }
typedef int i32x8 __attribute__((ext_vector_type(8)));
DEV f32x4 mfma_fp4_fp8(u32x4 a, u32x4 b0, u32x4 b1, f32x4 c) {
    const i32x8 av = {(int)a.x, (int)a.y, (int)a.z, (int)a.w, 0, 0, 0, 0}, bv = {(int)b0.x, (int)b0.y, (int)b0.z, (int)b0.w, (int)b1.x, (int)b1.y, (int)b1.z, (int)b1.w};
    return __builtin_amdgcn_mfma_scale_f32_16x16x128_f8f6f4(av, bv, c, 4, 0, 0, 127, 0, 127);
}
DEV void atomic_add_f32(float* p, float v) { atomicAdd(p, v); }
DEV float fast_exp(float x) { return __expf(x); }
DEV float fast_exp2(float x) { return __builtin_amdgcn_exp2f(x); }
DEV float fast_log(float x) { return __logf(x); }
DEV float fast_rcp(float x) { return __builtin_amdgcn_rcpf(x); }
DEV float fast_rsqrt(float x) { return __builtin_amdgcn_rsqf(x); }
#else
#define DEV static inline
#define LDSP
#endif

#ifndef HOST_EMU
DEV void wave_sync() { __builtin_amdgcn_fence(__ATOMIC_ACQ_REL, "wavefront"); __builtin_amdgcn_wave_barrier(); }
#else
static inline void wave_sync() { emu_bar_wait(emu_wave().bar, 64); }
#endif
DEV float bf2f(bf16_t v) { unsigned u = ((unsigned)v) << 16; return __builtin_bit_cast(float, u); }
DEV bf16_t f2bf(float f) { unsigned u = __builtin_bit_cast(unsigned, f); return (bf16_t)((u + 0x7fffu + ((u >> 16) & 1u)) >> 16); }
#ifndef HOST_EMU
typedef __bf16 bf16x2_hw __attribute__((ext_vector_type(2)));
DEV unsigned pk2(float lo, float hi) { const f32x2 v = {lo, hi}; return __builtin_bit_cast(unsigned, __builtin_convertvector(v, bf16x2_hw)); }
#else
DEV unsigned pk2(float lo, float hi) { return (unsigned)f2bf(lo) | ((unsigned)f2bf(hi) << 16); }
#endif
DEV float bflo(unsigned u) { return __builtin_bit_cast(float, u << 16); }
DEV float bfhi(unsigned u) { return __builtin_bit_cast(float, u & 0xffff0000u); }
DEV float sigmoidf_(float x) { return fast_rcp(1.0f + fast_exp(-x)); }
DEV float siluf_(float x) { return x * sigmoidf_(x); }
DEV float log_sigmoidf_(float x) { return fminf(x, 0.f) - log1pf(fast_exp(-fabsf(x))); }
DEV unsigned sortkey32(float f) { const unsigned u = __builtin_bit_cast(unsigned, f); return (u & 0x80000000u) ? ~u : (u | 0x80000000u); }
DEV unsigned fp4_code(float x) {
    const float a = fabsf(x); unsigned c = (a > 0.25f) + (a > 0.75f) + (a > 1.25f) + (a > 1.75f) + (a > 2.5f) + (a > 3.5f) + (a > 5.0f); return c | (x < 0.f ? 8u : 0u);
}
DEV float wave_sum(float v) { v += xorf<1>(v); v += xorf<2>(v); v += xorf<4>(v); v += xorf<8>(v); v += xorf<16>(v); v += xorf<32>(v); return v; }
DEV float wave_max(float v) { v = fmaxf(v, xorf<1>(v)); v = fmaxf(v, xorf<2>(v)); v = fmaxf(v, xorf<4>(v)); v = fmaxf(v, xorf<8>(v)); v = fmaxf(v, xorf<16>(v)); v = fmaxf(v, xorf<32>(v)); return v; }
DEV float gelu_erf(float v) {
    const float av = fabsf(v), t = fast_rcp(1.0f + 0.2316418882f * av);
    float q = t * 0.5307027145f + (-0.7265760135f); q = q * t + 0.7107068705f; q = q * t + (-0.142248368f); q = q * t + 0.127414796f; q = q * t;
    const float e = fast_exp2(v * v * (-0.72134752044f));
    const float m = v * (q * e);
    return v < 0.f ? m : v - m;
}
#ifndef HOST_EMU
#define DEV_M __device__ __forceinline__
#else
#define DEV_M inline
#endif
namespace pg8 {
#define PG8_LAS __attribute__((address_space(3)))
constexpr int BM = 256, BK = 64, HALF = 128, HTB = HALF * BK * 2  , STAGE_BYTES = 8 * HTB, NXCD = 8, WGM = 8;

__host__ __device__ __forceinline__ int lds_byte(int r, int c) { const int st = (r >> 4) * 2 + (c >> 5), rr = r & 15, cc = c & 31, ob = rr * 64 + cc * 2; return st * 1024 + (ob ^ (((ob >> 9) & 1) << 5)); }
__host__ __device__ __forceinline__ void stage_rc(int b, int& R, int& C) { const int st = b / 1024, sb = b % 1024, swz = sb ^ (((sb >> 9) & 1) << 5); R = (st >> 1) * 16 + swz / 64; C = (st & 1) * 32 + (swz % 64) / 2; }
__host__ __device__ __forceinline__ int perm32(int rho) { const int n = rho >> 4, i = rho & 15; return 8 * (i >> 2) + 4 * n + (i & 3); }

struct Unit { int pm, pn; };
struct Gemm { const bf16_t* A; const bf16_t* Bt; int M, N, K; };

struct StaticOrder {
    int nM, nN, nwg, G, c;
    __host__ __device__ void init(int M, int N, int G_, int c_) { nM = M / BM; nN = N / BM; nwg = nM * nN; G = G_; c = c_; }
    __host__ __device__ bool next(int i, Unit& u) const {
        const long L = (long)i * G + c; if (L >= nwg) return false;
        int wgid = (int)L; { const int q = nwg / NXCD, r = nwg % NXCD, xcd = wgid % NXCD, off = wgid / NXCD; wgid = (xcd < r ? xcd * (q + 1) : r * (q + 1) + (xcd - r) * q) + off; }
        const int nig = WGM * nN, gid = wgid / nig, fm = gid * WGM, gsz = (nM - fm) < WGM ? (nM - fm) : WGM;
        u.pm = fm + ((wgid % nig) % gsz); u.pn = (wgid % nig) / gsz; return true;
    }
    DEV_M void a_ready(const Unit&) const {}
    DEV_M void done(const Unit&) const {}
};


#ifndef HOST_EMU
template <class Epi, class Sched, bool ALIGN_EPI = false, bool SP2 = false>
__device__ __forceinline__ void gemm_phase(PG8_LAS unsigned char* lds, const Gemm g, const Sched& S, const Epi& E, const int tid_in) {
    const int tid = tid_in, wid = __builtin_amdgcn_readfirstlane(tid >> 6), lane = tid & 63, wr = wid >> 2, wc = wid & 3, fr = lane & 15, fq = lane >> 4;
    const int K = g.K, nt = K / BK;
    unsigned voffA[2], voffB[2];
#pragma unroll
    for (int i = 0; i < 2; ++i) { int R, C; stage_rc(tid * 16 + i * 8192, R, C); const int Rb = Epi::PERM ? ((R & ~31) + perm32(R & 31)) : R;
        voffA[i] = (unsigned)(R * K + C) * 2u; voffB[i] = (unsigned)(Rb * K + C) * 2u; }
    const size_t kstep = (size_t)(BK * 2);
    const size_t hstep = (size_t)HALF * K * 2;
    const size_t tstep = 2 * hstep;
    const unsigned ldsw = (unsigned)wid * 1024u;
    const int aoff = lds_byte(wr * 64 + fr, fq * 8), boff = lds_byte(wc * 32 + fr, fq * 8);
#define PG8_SA(b, h) (((b) * 2 + (h)) * HTB)
#define PG8_SB(b, h) ((4 + (b) * 2 + (h)) * HTB)
#define PG8_STAGE(bufoff, gbase, voff) do { _Pragma("unroll") for (int _i = 0; _i < 2; ++_i) \
        __builtin_amdgcn_global_load_lds((const unsigned*)((const char*)(gbase) + (voff)[_i]), (PG8_LAS unsigned*)(lds + (bufoff) + ldsw + _i * 8192), 16, 0, 0); } while (0)
#define PG8_LDA(dst, b, h) do { _Pragma("unroll") for (int m = 0; m < 4; ++m) _Pragma("unroll") for (int k = 0; k < 2; ++k) dst[m][k] = *(const PG8_LAS bf16x8*)(lds + PG8_SA(b, h) + aoff + m * 2048 + k * 1024); } while (0)
#define PG8_LDB(dst, b, h) do { _Pragma("unroll") for (int n = 0; n < 2; ++n) _Pragma("unroll") for (int k = 0; k < 2; ++k) dst[n][k] = *(const PG8_LAS bf16x8*)(lds + PG8_SB(b, h) + boff + n * 2048 + k * 1024); } while (0)
#define PG8_MMA(ai, bj, At, Bt) do { __builtin_amdgcn_s_setprio(1); _Pragma("unroll") for (int m = 0; m < 4; ++m) _Pragma("unroll") for (int n = 0; n < 2; ++n) _Pragma("unroll") for (int k = 0; k < 2; ++k) \
        acc[ai][bj][m][n] = __builtin_amdgcn_mfma_f32_16x16x32_bf16(Bt[n][k], At[m][k], acc[ai][bj][m][n], 0, 0, 0); __builtin_amdgcn_s_setprio(0); } while (0)
#define PG8_WAIT_V(n) asm volatile("s_waitcnt vmcnt(" #n ")" ::: "memory")
#define PG8_WAIT_L(n) asm volatile("s_waitcnt lgkmcnt(" #n ")" ::: "memory")
#define PG8_BAR __builtin_amdgcn_s_barrier()
#define PG8_SCHED __builtin_amdgcn_sched_barrier(0)
    Unit cur, nxt; int ui = 0;
    if (!S.next(0, cur)) return;
    f32x4 acc[2][2][4][2];
#pragma unroll
    for (int a = 0; a < 2; ++a)
#pragma unroll
        for (int b = 0; b < 2; ++b)
#pragma unroll
            for (int m = 0; m < 4; ++m)
#pragma unroll
                for (int n = 0; n < 2; ++n) acc[a][b][m][n] = (f32x4){0.f, 0.f, 0.f, 0.f};
    bf16x8 At[4][2], B0[2][2], B1[2][2];
    const char* cA = (const char*)g.A + (size_t)cur.pm * tstep; const char* cB = (const char*)g.Bt + (size_t)cur.pn * tstep;
    S.a_ready(cur);
    if constexpr (SP2) {
        PG8_STAGE(PG8_SB(0, 0), cB, voffB); PG8_STAGE(PG8_SB(0, 1), cB + hstep, voffB); PG8_STAGE(PG8_SA(0, 0), cA, voffA); PG8_STAGE(PG8_SA(0, 1), cA + hstep, voffA);
        if (wr == 1) PG8_BAR;
        PG8_WAIT_V(2); PG8_BAR;
        PG8_STAGE(PG8_SB(1, 0), cB + kstep, voffB); PG8_STAGE(PG8_SA(1, 0), cA + kstep, voffA); PG8_STAGE(PG8_SB(1, 1), cB + hstep + kstep, voffB);
        PG8_WAIT_V(6); PG8_BAR;
    } else {
        PG8_STAGE(PG8_SB(0, 0), cB, voffB); PG8_STAGE(PG8_SA(0, 0), cA, voffA); PG8_STAGE(PG8_SB(0, 1), cB + hstep, voffB); PG8_STAGE(PG8_SA(0, 1), cA + hstep, voffA);
        if (wr == 1) PG8_BAR;
        PG8_WAIT_V(4); PG8_BAR;
        PG8_STAGE(PG8_SB(1, 0), cB + kstep, voffB); PG8_STAGE(PG8_SA(1, 0), cA + kstep, voffA); PG8_STAGE(PG8_SB(1, 1), cB + hstep + kstep, voffB);
        PG8_WAIT_V(6); PG8_BAR;
    }
    for (;;) {
        const bool has_next = S.next(ui + 1, nxt);
        const char* nA = has_next ? (const char*)g.A + (size_t)nxt.pm * tstep : cA; const char* nB = has_next ? (const char*)g.Bt + (size_t)nxt.pn * tstep : cB;
        for (int t = 0; t < nt; t += 2) {
            const bool last = (t == nt - 2);
            const char* a1 = cA + (size_t)(t + 1) * kstep;
            const char* a2 = last ? nA : cA + (size_t)(t + 2) * kstep; const char* b2 = last ? nB : cB + (size_t)(t + 2) * kstep;
            const char* a3 = a2 + kstep; const char* b3 = b2 + kstep;
            if (last && has_next) S.a_ready(nxt);
            if constexpr (SP2) {
            PG8_LDB(B0, 0, 0); PG8_LDB(B1, 0, 1); PG8_SCHED; PG8_LDA(At, 0, 0); PG8_STAGE(PG8_SA(1, 1), a1 + hstep, voffA);
            PG8_WAIT_V(8); PG8_WAIT_L(0); PG8_BAR; PG8_MMA(0, 0, At, B0); PG8_MMA(0, 1, At, B1); PG8_BAR; PG8_SCHED;
            PG8_LDA(At, 0, 1); PG8_STAGE(PG8_SB(0, 0), b2, voffB); PG8_STAGE(PG8_SB(0, 1), b2 + hstep, voffB); PG8_STAGE(PG8_SA(0, 0), a2, voffA);
            PG8_WAIT_V(8); PG8_WAIT_L(0); PG8_BAR; PG8_MMA(1, 0, At, B0); PG8_MMA(1, 1, At, B1); PG8_BAR; PG8_SCHED;
            PG8_LDB(B0, 1, 0); PG8_LDB(B1, 1, 1); PG8_SCHED; PG8_LDA(At, 1, 0); PG8_STAGE(PG8_SA(0, 1), a2 + hstep, voffA);
            PG8_WAIT_V(8); PG8_WAIT_L(0); PG8_BAR; PG8_MMA(0, 0, At, B0); PG8_MMA(0, 1, At, B1); PG8_BAR; PG8_SCHED;
            PG8_LDA(At, 1, 1); PG8_STAGE(PG8_SB(1, 0), b3, voffB); PG8_STAGE(PG8_SB(1, 1), b3 + hstep, voffB); PG8_STAGE(PG8_SA(1, 0), a3, voffA);
            PG8_WAIT_V(8); PG8_WAIT_L(0); PG8_BAR; PG8_MMA(1, 0, At, B0); PG8_MMA(1, 1, At, B1); PG8_BAR; PG8_SCHED;
            } else {
            PG8_LDB(B0, 0, 0); PG8_SCHED; PG8_LDA(At, 0, 0); PG8_STAGE(PG8_SA(1, 1), a1 + hstep, voffA);
            PG8_WAIT_L(8); PG8_BAR; PG8_WAIT_L(0); PG8_MMA(0, 0, At, B0); PG8_BAR; PG8_SCHED;
            PG8_LDB(B1, 0, 1); PG8_STAGE(PG8_SB(0, 0), b2, voffB);
            PG8_BAR; PG8_WAIT_L(0); PG8_MMA(0, 1, At, B1); PG8_BAR;
            PG8_LDA(At, 0, 1); PG8_STAGE(PG8_SA(0, 0), a2, voffA);
            PG8_BAR; PG8_WAIT_L(0); PG8_MMA(1, 0, At, B0); PG8_BAR; PG8_SCHED;
            PG8_STAGE(PG8_SB(0, 1), b2 + hstep, voffB);
            PG8_WAIT_V(6); PG8_BAR; PG8_MMA(1, 1, At, B1); PG8_BAR;
            PG8_LDB(B0, 1, 0); PG8_SCHED; PG8_LDA(At, 1, 0); PG8_STAGE(PG8_SA(0, 1), a2 + hstep, voffA);
            PG8_WAIT_L(8); PG8_BAR; PG8_WAIT_L(0); PG8_MMA(0, 0, At, B0); PG8_BAR; PG8_SCHED;
            PG8_LDB(B1, 1, 1); PG8_STAGE(PG8_SB(1, 0), b3, voffB);
            PG8_BAR; PG8_WAIT_L(0); PG8_MMA(0, 1, At, B1); PG8_BAR;
            PG8_LDA(At, 1, 1); PG8_STAGE(PG8_SA(1, 0), a3, voffA);
            PG8_BAR; PG8_WAIT_L(0); PG8_MMA(1, 0, At, B0); PG8_BAR; PG8_SCHED;
            PG8_STAGE(PG8_SB(1, 1), b3 + hstep, voffB);
            PG8_WAIT_V(6); PG8_BAR; PG8_MMA(1, 1, At, B1); PG8_BAR;
            }
        }
        if constexpr (ALIGN_EPI) { if (wr == 0) PG8_BAR; }
        if constexpr (!Epi::AFTER_DRAIN) { E(acc, cur, wr, wc, fr, fq); S.done(cur); }
        if (!has_next) break;
#pragma unroll
        for (int a = 0; a < 2; ++a)
#pragma unroll
            for (int b = 0; b < 2; ++b)
#pragma unroll
                for (int m = 0; m < 4; ++m)
#pragma unroll
                    for (int n = 0; n < 2; ++n) acc[a][b][m][n] = (f32x4){0.f, 0.f, 0.f, 0.f};
        cur = nxt; cA = nA; cB = nB; ++ui;
        if constexpr (ALIGN_EPI) { if (wr == 1) PG8_BAR; }
    }
    PG8_WAIT_V(0);
    if constexpr (!ALIGN_EPI) { if (wr == 0) PG8_BAR; }
    PG8_BAR;
    if constexpr (Epi::AFTER_DRAIN) { E.fused(acc, cur, wr, wc, fr, fq, lds, wid, lane); S.done(cur); }
#undef PG8_SA
#undef PG8_SB
#undef PG8_STAGE
#undef PG8_LDA
#undef PG8_LDB
#undef PG8_MMA
#undef PG8_WAIT_V
#undef PG8_WAIT_L
#undef PG8_BAR
#undef PG8_SCHED
}
#else
template <class Epi, class Sched, bool ALIGN_EPI = false, bool SP2 = false>
inline void gemm_phase(void* lds, const Gemm g, const Sched& S, const Epi& E, const int tid_in) {
    const int tid = TID(), wid = tid >> 6, lane = tid & 63, wr = wid >> 2, wc = wid & 3, fr = lane & 15, fq = lane >> 4;
    Unit u;
    for (int ui = 0; S.next(ui, u); ++ui) {
        f32x4 acc[2][2][4][2];
        for (int ai = 0; ai < 2; ++ai) for (int bj = 0; bj < 2; ++bj) for (int m = 0; m < 4; ++m) for (int n = 0; n < 2; ++n) for (int j = 0; j < 4; ++j) {
            const int r = 256 * u.pm + 128 * ai + 64 * wr + 16 * m + fr;
            const int c = 256 * u.pn + 128 * bj + 32 * wc + (Epi::PERM ? (8 * fq + 4 * n + j) : (16 * n + 4 * fq + j));
            const bf16_t* a = g.A + (size_t)r * g.K; const bf16_t* b = g.Bt + (size_t)c * g.K;
            float s = 0.f; for (int k = 0; k < g.K; ++k) s += bf2f(a[k]) * bf2f(b[k]);
            acc[ai][bj][m][n][j] = s;
        }
        E(acc, u, wr, wc, fr, fq);
    }
    block_sync();
}
#endif
#ifndef HOST_EMU
#define EPI_LAUNDER(wr, wc, fr, fq) asm volatile("" : "+s"(wr), "+s"(wc), "+v"(fr), "+v"(fq))
#else
#define EPI_LAUNDER(wr, wc, fr, fq) do {} while (0)
#endif
DEV_M float rstd_of(float ss) { return fast_rsqrt(ss * (1.0f / 1024.0f) + NORM_EPS); }

DEV_M float rss_slots16(const float* p) {
    const f32x4 a = *(const f32x4*)p, b = *(const f32x4*)(p + 4), c = *(const f32x4*)(p + 8), d = *(const f32x4*)(p + 12);
    return (((a[0] + a[1]) + (a[2] + a[3])) + ((b[0] + b[1]) + (b[2] + b[3]))) + (((c[0] + c[1]) + (c[2] + c[3])) + ((d[0] + d[1]) + (d[2] + d[3])));
}
template <int SLOTS, bool HALO = false> struct EpiScaleBf16 {
    static constexpr bool PERM = true, AFTER_DRAIN = false;
    bf16_t* O; int ldc; const float* rss; int ncols; bf16_t* halo;
    DEV_M void operator()(const f32x4 (&acc)[2][2][4][2], const Unit& u, int wr, int wc, int fr, int fq) const {
        EPI_LAUNDER(wr, wc, fr, fq);
        const int row0 = u.pm * BM + wr * 64 + fr, col0 = u.pn * BM + wc * 32 + 8 * fq;
        float scv[2][4];
#pragma unroll
        for (int ai = 0; ai < 2; ++ai)
#pragma unroll
            for (int m = 0; m < 4; ++m) { const int row = row0 + ai * HALF + m * 16; scv[ai][m] = SLOTS == 1 ? rss[row] : 0.f; }
#pragma unroll
        for (int ai = 0; ai < 2; ++ai)
#pragma unroll
            for (int m = 0; m < 4; ++m) {
                const int row = row0 + ai * HALF + m * 16; const float sc = rstd_of(SLOTS == 1 ? scv[ai][m] : rss_slots16(rss + (size_t)row * 16));
                bf16_t* rowp = O + (size_t)row * ldc + col0;
#pragma unroll
                for (int bj = 0; bj < 2; ++bj) {
                    if (col0 + bj * HALF < ncols) {
                        const f32x4 v0 = acc[ai][bj][m][0] * sc, v1 = acc[ai][bj][m][1] * sc;
                        u32x4 w; w.x = pk2(v0[0], v0[1]); w.y = pk2(v0[2], v0[3]); w.z = pk2(v1[0], v1[1]); w.w = pk2(v1[2], v1[3]);
                        *(u32x4*)(rowp + bj * HALF) = w;
                        if (HALO) { const int cc = col0 + bj * HALF - C_MQ; if ((row & 63) >= 61 && cc >= 0 && cc < 512) *(u32x4*)(halo + ((size_t)(row >> 6) * 3 + ((row & 63) - 61)) * 512 + cc) = w; }
                    }
                }
            }
    }
};
struct EpiU {
    static constexpr bool PERM = true, AFTER_DRAIN = false;
    bf16_t* uall;
    DEV_M void operator()(const f32x4 (&acc)[2][2][4][2], const Unit& u, int wr, int wc, int fr, int fq) const {
        EPI_LAUNDER(wr, wc, fr, fq);
        bf16_t* base = uall + (size_t)(u.pm * BM + wr * 64 + fr) * DM + (u.pn & 3) * BM + wc * 32 + 8 * fq;
#pragma unroll
        for (int ai = 0; ai < 2; ++ai)
#pragma unroll
            for (int m = 0; m < 4; ++m)
#pragma unroll
                for (int bj = 0; bj < 2; ++bj) {
                    const f32x4 v0 = acc[ai][bj][m][0], v1 = acc[ai][bj][m][1];
                    u32x4 w; w.x = pk2(v0[0], v0[1]); w.y = pk2(v0[2], v0[3]); w.z = pk2(v1[0], v1[1]); w.w = pk2(v1[2], v1[3]);
                    *(u32x4*)(base + (size_t)(ai * HALF + m * 16) * DM + bj * HALF) = w;
                }
    }
};
struct EpiGate {
    static constexpr bool PERM = true, AFTER_DRAIN = false;
    const bf16_t* uall; bf16_t* merged; const float* rss; int nrows;
    DEV_M void operator()(const f32x4 (&acc)[2][2][4][2], const Unit& u, int wr, int wc, int fr, int fq) const {
        EPI_LAUNDER(wr, wc, fr, fq);
        const int mi = u.pn >> 2, pn = u.pn & 3, row0 = u.pm * BM + wr * 64 + fr, col0 = pn * BM + wc * 32 + 8 * fq;
        const bf16_t* ub = uall + ((size_t)mi * nrows + row0) * DM + col0;
#pragma unroll
        for (int ai = 0; ai < 2; ++ai) {
            u32x4 uv[4][2], pv[4][2]; float sc[4];
#pragma unroll
            for (int m = 0; m < 4; ++m) { const int row = row0 + ai * HALF + m * 16; sc[m] = rss[row];
#pragma unroll
                for (int bj = 0; bj < 2; ++bj) { uv[m][bj] = *(const u32x4*)(ub + (size_t)(ai * HALF + m * 16) * DM + bj * HALF);
                    pv[m][bj] = (u32x4){0u, 0u, 0u, 0u}; if (mi != 0) pv[m][bj] = *(const u32x4*)(merged + (size_t)row * DM + col0 + bj * HALF); } }
#pragma unroll
            for (int m = 0; m < 4; ++m) { const int row = row0 + ai * HALF + m * 16; const float s = rstd_of(sc[m]);
#pragma unroll
                for (int bj = 0; bj < 2; ++bj) {
                    const u32x4 u4 = uv[m][bj], p4 = pv[m][bj];
                    const f32x4 a0 = acc[ai][bj][m][0] * s, a1 = acc[ai][bj][m][1] * s;
                    float r[8];
                    r[0] = sigmoidf_(a0[0]) * bflo(u4.x) + bflo(p4.x); r[1] = sigmoidf_(a0[1]) * bfhi(u4.x) + bfhi(p4.x);
                    r[2] = sigmoidf_(a0[2]) * bflo(u4.y) + bflo(p4.y); r[3] = sigmoidf_(a0[3]) * bfhi(u4.y) + bfhi(p4.y);
                    r[4] = sigmoidf_(a1[0]) * bflo(u4.z) + bflo(p4.z); r[5] = sigmoidf_(a1[1]) * bfhi(u4.z) + bfhi(p4.z);
                    r[6] = sigmoidf_(a1[2]) * bflo(u4.w) + bflo(p4.w); r[7] = sigmoidf_(a1[3]) * bfhi(u4.w) + bfhi(p4.w);
                    u32x4 w; w.x = pk2(r[0], r[1]); w.y = pk2(r[2], r[3]); w.z = pk2(r[4], r[5]); w.w = pk2(r[6], r[7]);
                    *(u32x4*)(merged + (size_t)row * DM + col0 + bj * HALF) = w;
                } }
        }
    }
};
struct EpiOut {
    static constexpr bool PERM = true, AFTER_DRAIN = false;
    bf16_t* xb; float* rss;
    DEV_M void operator()(const f32x4 (&acc)[2][2][4][2], const Unit& u, int wr, int wc, int fr, int fq) const {
        EPI_LAUNDER(wr, wc, fr, fq);
        const int row0 = u.pm * BM + wr * 64 + fr, col0 = u.pn * BM + wc * 32 + 8 * fq;
#pragma unroll
        for (int ai = 0; ai < 2; ++ai) {
            u32x4 xr[4][2];
#pragma unroll
            for (int m = 0; m < 4; ++m)
#pragma unroll
                for (int bj = 0; bj < 2; ++bj) xr[m][bj] = *(const u32x4*)(xb + (size_t)(row0 + ai * HALF + m * 16) * DM + col0 + bj * HALF);
#pragma unroll
            for (int m = 0; m < 4; ++m) {
                const int row = row0 + ai * HALF + m * 16; float ss = 0.f;
#pragma unroll
                for (int bj = 0; bj < 2; ++bj) {
                    const u32x4 x4 = xr[m][bj];
                    const f32x4 v0 = acc[ai][bj][m][0] + (f32x4){bflo(x4.x), bfhi(x4.x), bflo(x4.y), bfhi(x4.y)}, v1 = acc[ai][bj][m][1] + (f32x4){bflo(x4.z), bfhi(x4.z), bflo(x4.w), bfhi(x4.w)};
                    u32x4 w; w.x = pk2(v0[0], v0[1]); w.y = pk2(v0[2], v0[3]); w.z = pk2(v1[0], v1[1]); w.w = pk2(v1[2], v1[3]);
                    *(u32x4*)(xb + (size_t)row * DM + col0 + bj * HALF) = w;
                    ss += ((v0[0] * v0[0] + v0[1] * v0[1]) + (v0[2] * v0[2] + v0[3] * v0[3])) + ((v1[0] * v1[0] + v1[1] * v1[1]) + (v1[2] * v1[2] + v1[3] * v1[3]));
                }
                ss += xorf<16>(ss); ss += xorf<32>(ss);
                if (fq == 0) rss[(size_t)row * 16 + u.pn * 4 + wc] = ss;
            }
        }
    }
};
template <bool STACK_A> struct MixOrder {
    int ntiles, G, c, nM;
    DEV_M bool next(int i, Unit& u) const { const long t = (long)(i >> 2) * G + c; if (t >= ntiles) return false; const int m = i & 3;
        u.pm = (int)(t >> 2) + (STACK_A ? m * nM : 0); u.pn = m * 4 + (int)(t & 3); return true; }
    DEV_M void a_ready(const Unit&) const {}
    DEV_M void done(const Unit&) const {}
};
}
#ifndef HOST_EMU
#define GEMM_LDS ((PG8_LAS unsigned char*)smem_raw)
#else
#define GEMM_LDS ((void*)nullptr)
#endif
struct Ctx {
    float* out; unsigned char* ws; LDSP char* lds; int tid, lane, wave, bid, nblk;
};
constexpr int LDS_PTRS = LDS_BYTES - 256;
#ifndef HOST_EMU
DEV const float* inptr(const Ctx& c, int i) { const unsigned long long v = ((volatile LDSP unsigned long long*)(c.lds + LDS_PTRS))[i];
    const unsigned lo = __builtin_amdgcn_readfirstlane((unsigned)v), hi = __builtin_amdgcn_readfirstlane((unsigned)(v >> 32)); return (const float*)(const __attribute__((address_space(1))) float*)(((unsigned long long)hi << 32) | lo); }
#else
static inline const float* inptr(const Ctx& c, int i) { return ((const float* volatile*)(c.lds + LDS_PTRS))[i]; }
#endif
#define CIN(i) inptr(c, (i))
template <class T> DEV T* wsp(const Ctx& c, size_t off) { return (T*)(c.ws + off); }
DEV int orig_col(int n) {
    if (n < 1792) return n;
    if (n < 2048) return 1800 + (n - 1792);
    if (n < 3072) return 2056 + (n - 2048);
    if (n < 4096) return 3092 + (n - 3072);
    if (n < 4104) return 1792 + (n - 4096);
    if (n < 4116) return 3080 + (n - 4104);
    return -1;
}

template <class F> DEV void transpose_wave(const Ctx& c, F src, bf16_t* dst, int ldd, int k0, int n0) {
    LDSP float* tile = (LDSP float*)(c.lds + c.wave * 16640);
#pragma unroll
    for (int kb = 0; kb < 64; kb += 16) {
        float tv[16];
#pragma unroll
        for (int j = 0; j < 16; ++j) tv[j] = src(k0 + kb + j, n0 + c.lane);
#pragma unroll
        for (int j = 0; j < 16; ++j) tile[c.lane * 65 + kb + j] = tv[j];
    }
    wave_sync();
    const int k2 = (c.lane & 31) * 2, nh = c.lane >> 5;
#pragma unroll 8
    for (int j = 0; j < 32; ++j) { const int n = 2 * j + nh; *(unsigned*)(dst + (size_t)(n0 + n) * ldd + k0 + k2) = pk2(tile[n * 65 + k2], tile[n * 65 + k2 + 1]); }
    wave_sync();
}
DEV bf16x8 cvt8(const f32x4 a, const f32x4 b, float s) { const u32x4 w = {pk2(a[0] * s, a[1] * s), pk2(a[2] * s, a[3] * s), pk2(b[0] * s, b[1] * s), pk2(b[2] * s, b[3] * s)}; return __builtin_bit_cast(bf16x8, w); }

DEV void p0_prep(const Ctx& c, int l, int mask = 31) {
    const float* g1 = CIN(1) + (size_t)l * DM;
    const float* g2 = CIN(17) + (size_t)l * DM;
    constexpr int I_IN = (PROJ_N / 64) * 16, I_G = 4 * 16 * 16, I_UP = 4 * 16 * 4, I_OUT = 16 * 16, I_WC = 2 * 32, I_TR = I_IN + I_G + I_UP + I_OUT + I_WC;
    constexpr int I_WQ = 16 * 16 * 8;
    if (mask & 1)
    for (int it = c.bid * NWAVE + c.wave; it < I_TR; it += c.nblk * NWAVE) {
        int r = it;
        if (r < I_IN) {
            const float* w = CIN(2) + (size_t)l * DM * N_IN_ORIG; const int nt = r / 16, kt = r % 16;
            transpose_wave(c, [=](int k, int n) { const int oc = orig_col(n); return oc < 0 ? 0.f : w[(size_t)k * N_IN_ORIG + oc] * g1[k]; }, wsp<bf16_t>(c, WS_WIN), DM, kt * 64, nt * 64);
            continue;
        } r -= I_IN;
        if (r < I_G) {
            const int m = r / 256, nt = (r % 256) / 16, kt = r % 16; const float* w = CIN(15) + ((size_t)l * 4 + m) * DM * DM;
            transpose_wave(c, [=](int k, int n) { return w[(size_t)k * DM + n] * g1[k]; }, wsp<bf16_t>(c, WS_WG) + (size_t)m * DM * DM, DM, kt * 64, nt * 64);
            continue;
        } r -= I_G;
        if (r < I_UP) {
            const int m = r / 64, nt = (r % 64) / 4, kt = r % 4; const float* w = CIN(14) + ((size_t)l * 4 + m) * MW * DM;
            transpose_wave(c, [=](int k, int n) { return w[(size_t)k * DM + n]; }, wsp<bf16_t>(c, WS_WUP) + (size_t)m * DM * MW, MW, kt * 64, nt * 64);
            continue;
        } r -= I_UP;
        if (r < I_OUT) {
            const int nt = r / 16, kt = r % 16; const float* w = CIN(16) + (size_t)l * DM * DM;
            transpose_wave(c, [=](int k, int n) { return w[(size_t)k * DM + n]; }, wsp<bf16_t>(c, WS_WOUT), DM, kt * 64, nt * 64);
            continue;
        } r -= I_OUT;
        {
            const int kv = r / 32, kt = r % 32; const float* w = CIN(12) + ((size_t)l * 2 + kv) * 2048 * 64;
            transpose_wave(c, [=](int k, int n) { return w[(size_t)k * 64 + n]; }, wsp<bf16_t>(c, WS_WCT) + (size_t)kv * 64 * 2048, 2048, kt * 64, 0);
        }
    }
    if (mask & 2)
    for (int it = c.bid * NWAVE + c.wave; it < I_WQ; it += c.nblk * NWAVE) {
        const int keyt = it & 7, kt = (it >> 3) & 15, hp = it >> 7, fr = c.lane & 15, fq = c.lane >> 4;
        const float* keys = CIN(19) + (((size_t)l * 16 + hp) * 128 + keyt * 16 + fr) * 128; const float* wq = CIN(18) + (size_t)l * DM * PEER_N + hp * 128;
        bf16x8 kb[4];
#pragma unroll
        for (int ds = 0; ds < 4; ++ds) kb[ds] = cvt8(*(const f32x4*)(keys + 32 * ds + 8 * fq), *(const f32x4*)(keys + 32 * ds + 8 * fq + 4), 1.0f);
#pragma unroll
        for (int tile = 0; tile < 4; ++tile) { const int k = kt * 64 + tile * 16 + fr; const float gk = g2[k]; const float* wr = wq + (size_t)k * PEER_N;
            f32x4 acc = {0.f, 0.f, 0.f, 0.f};
#pragma unroll
            for (int ds = 0; ds < 4; ++ds) acc = mfma16(cvt8(*(const f32x4*)(wr + 32 * ds + 8 * fq), *(const f32x4*)(wr + 32 * ds + 8 * fq + 4), gk), kb[ds], acc);
            u32x2 w; w.x = pk2(acc[0], acc[1]); w.y = pk2(acc[2], acc[3]);
            *(u32x2*)(wsp<bf16_t>(c, WS_WQ2) + (size_t)(hp * 128 + keyt * 16 + fr) * DM + kt * 64 + tile * 16 + fq * 4) = w; }
    }
    if (mask & 4)
    for (int kv = c.bid; kv < 2; kv += c.nblk) {
        const float* w = CIN(12) + ((size_t)l * 2 + kv) * 2048 * 64; const float* pe = CIN(11) + ((size_t)l * 2 + kv) * 2048;
        LDSP float* red = (LDSP float*)c.lds;
        block_sync();
        const int e = c.tid & 63, part = c.tid >> 6; float s = 0.f;
#pragma unroll 16
        for (int kk = part * 256; kk < part * 256 + 256; ++kk) s += pe[kk] * w[(size_t)kk * 64 + e];
        red[part * 64 + e] = s;
        block_sync();
        if (c.tid < 64) { float t = 0.f; for (int pp = 0; pp < 8; ++pp) t += red[pp * 64 + c.tid]; wsp<float>(c, WS_CBIAS)[kv * 64 + c.tid] = t; }
        block_sync();
    }
    if (l == 0 && (mask & 8)) {
        const float* x = CIN(0); bf16_t* xb = wsp<bf16_t>(c, WS_XB); float* rss = wsp<float>(c, WS_RSS1);
        for (int row = c.bid * NWAVE + c.wave; row < NT; row += c.nblk * NWAVE) {
            const f32x4* xr = (const f32x4*)(x + (size_t)row * DM) + c.lane; float s = 0.f;
            u32x2* o = (u32x2*)(xb + (size_t)row * DM) + c.lane;
#pragma unroll
            for (int j = 0; j < 4; ++j) { const f32x4 v = xr[64 * j]; s += (v[0] * v[0] + v[1] * v[1]) + (v[2] * v[2] + v[3] * v[3]);
                u32x2 w; w.x = pk2(v[0], v[1]); w.y = pk2(v[2], v[3]); o[64 * j] = w; }
            s = wave_sum(s);
            if (c.lane == 0) rss[row] = s;
        }
    }
    if (l == 0 && (mask & 16)) {
        float* cosT = wsp<float>(c, WS_ROPE); float* sinT = cosT + SEQ * 32;
        for (int i = c.bid * NTHR + c.tid; i < SEQ * 32; i += c.nblk * NTHR) {
            const int pos = i >> 5, fi = i & 31;
            const float inv = exp2f(-(float)fi * 0.41524101186092029f);
            const float a = (float)pos * inv, q = rintf(a * 0.63661977236758134f);
            float rr = fmaf(-q, 1.5703125f, a); rr = fmaf(-q, 4.837512969970703125e-4f, rr); rr = fmaf(-q, 7.54978995489188216e-8f, rr);
            const float r2 = rr * rr;
            const float s = rr * (1.0f + r2 * (-1.0f / 6 + r2 * (1.0f / 120 + r2 * (-1.0f / 5040 + r2 * (1.0f / 362880)))));
            const float cc = 1.0f + r2 * (-0.5f + r2 * (1.0f / 24 + r2 * (-1.0f / 720 + r2 * (1.0f / 40320 + r2 * (-1.0f / 3628800)))));
            const int qi = ((int)q) & 3;
            const float co = qi == 0 ? cc : qi == 1 ? -s : qi == 2 ? -cc : s;
            const float si = qi == 0 ? s : qi == 1 ? cc : qi == 2 ? -s : -cc;
            cosT[i] = co; sinT[i] = si;
        }
    }
}
constexpr int LF_STRIDE = 65, LT_STRIDE = 72;
constexpr int LDS_F0 = 0, LDS_F1 = 16640, LDS_F2 = 33280, LDS_T0 = 49920, LDS_TSZ = 64 * LT_STRIDE * 2, LDS_MISC = LDS_T0 + 6 * LDS_TSZ;
DEV LDSP float* ldsF(const Ctx& c, int i) { return (LDSP float*)(c.lds + LDS_F0 + i * 16640); }
DEV LDSP bf16_t* ldsT(const Ctx& c, int i) { return (LDSP bf16_t*)(c.lds + LDS_T0 + i * LDS_TSZ); }
DEV LDSP float* ldsM(const Ctx& c) { return (LDSP float*)(c.lds + LDS_MISC); }

DEV void load_tile_f32(const Ctx& c, LDSP float* F, const bf16_t* proj, int tok0, int col) {
    const int t = c.tid >> 3, d0 = (c.tid & 7) * 8;
    const u32x4 v = *(const u32x4*)(proj + (size_t)(tok0 + t) * PROJ_LD + col + d0);
    LDSP float* f = F + t * LF_STRIDE + d0;
    f[0] = bflo(v.x); f[1] = bfhi(v.x); f[2] = bflo(v.y); f[3] = bfhi(v.y); f[4] = bflo(v.z); f[5] = bfhi(v.z); f[6] = bflo(v.w); f[7] = bfhi(v.w);
}
DEV void load_tile_T(const Ctx& c, LDSP bf16_t* T, const bf16_t* proj, int tok0, int col) {
    const int t = c.tid >> 3, d0 = (c.tid & 7) * 8;
    const u32x4 v = *(const u32x4*)(proj + (size_t)(tok0 + t) * PROJ_LD + col + d0);
    LDSP bf16_t* p = T + d0 * LT_STRIDE + t;
    p[0] = (bf16_t)(v.x & 0xffff); p[LT_STRIDE] = (bf16_t)(v.x >> 16); p[2 * LT_STRIDE] = (bf16_t)(v.y & 0xffff); p[3 * LT_STRIDE] = (bf16_t)(v.y >> 16);
    p[4 * LT_STRIDE] = (bf16_t)(v.z & 0xffff); p[5 * LT_STRIDE] = (bf16_t)(v.z >> 16); p[6 * LT_STRIDE] = (bf16_t)(v.w & 0xffff); p[7 * LT_STRIDE] = (bf16_t)(v.w >> 16);
}
DEV f32x4 mma_tile(const LDSP bf16_t* A, int lda, int r0, const LDSP bf16_t* B, int ldb, int c0, int K, f32x4 acc, int lane) {
    const int fr = lane & 15, fq = lane >> 4;
    for (int k0 = 0; k0 < K; k0 += 32) {
        const bf16x8 a = *(const LDSP bf16x8*)(A + (r0 + fr) * lda + k0 + fq * 8);
        const bf16x8 b = *(const LDSP bf16x8*)(B + (c0 + fr) * ldb + k0 + fq * 8);
        acc = mfma16(a, b, acc);
    }
    return acc;
}
DEV float wave_scan_add(float v, int lane) {
#pragma unroll
    for (int o = 1; o < 64; o <<= 1) { const float t = shfl_f(v, lane - o); if (lane >= o) v += t; }
    return v;
}
DEV float wave_scan_max(float v, int lane) {
#pragma unroll
    for (int o = 1; o < 64; o <<= 1) { const float t = shfl_f(v, lane - o); if (lane >= o) v = fmaxf(v, t); }
    return v;
}
DEV float hgrn_lb(const Ctx& c, int l, int ch) { if (l == 0) return 0.f; const float* lb = CIN(3); return sigmoidf_(lb[MW + ch] - lb[ch]); }
DEV float ret_loggamma(int h) { return log1pf(-exp2f(-5.0f - (float)h)); }

DEV void hgrn_front(const Ctx& c, int l, const bf16_t* proj, int tok0, int h) {
    LDSP float* F0 = ldsF(c, 0); LDSP float* F1 = ldsF(c, 1);
    load_tile_f32(c, F0, proj, tok0, C_HF + h * 64);
    block_sync();
    for (int e = c.tid; e < 4096; e += NTHR) { const int t = e >> 6, d = e & 63; const float fl = F0[t * LF_STRIDE + d], lbv = hgrn_lb(c, l, h * 64 + d);
        const float sg = sigmoidf_(fl), f = lbv + (1.f - lbv) * sg; F0[t * LF_STRIDE + d] = fast_log(f); F1[t * LF_STRIDE + d] = (1.f - lbv) * (1.f - sg); }
    block_sync();
    for (int k = 0; k < 8; ++k) { const int d = c.wave * 8 + k; F0[c.lane * LF_STRIDE + d] = wave_scan_add(F0[c.lane * LF_STRIDE + d], c.lane); }
    block_sync();
}
DEV void rope_tile(const Ctx& c, LDSP float* F, int pos0, float scale) {
    const float* cosT = wsp<float>(c, WS_ROPE); const float* sinT = cosT + SEQ * 32;
    for (int e = c.tid; e < 2048; e += NTHR) { const int t = e >> 5, d = e & 31; const float cs = cosT[(pos0 + t) * 32 + d], sn = sinT[(pos0 + t) * 32 + d];
        const float x1 = F[t * LF_STRIDE + d], x2 = F[t * LF_STRIDE + d + 32];
        F[t * LF_STRIDE + d] = (x1 * cs - x2 * sn) * scale; F[t * LF_STRIDE + d + 32] = (x1 * sn + x2 * cs) * scale; }
}
constexpr int LDS_RAW = 107520, RAW_SZ = 67 * 65 * 4;
DEV void mlstm_conv_both(const Ctx& c, int l, LDSP float* Fq, LDSP float* Fk, const bf16_t* proj, int tok0, int ck, int cg, int h) {
    const float* cw = CIN(5) + (size_t)l * 4 * 512; const float* cb = CIN(6) + (size_t)l * 512; const bf16_t* halo = wsp<bf16_t>(c, WS_HALO);
    LDSP float* Rq = (LDSP float*)(c.lds + LDS_RAW); LDSP float* Rk = (LDSP float*)(c.lds + LDS_RAW + RAW_SZ);
    const int t = c.tid >> 3, d0 = (c.tid & 7) * 8;
    { const u32x4 vq = *(const u32x4*)(proj + (size_t)(tok0 + t) * PROJ_LD + C_MQ + h * 64 + d0), vk = *(const u32x4*)(proj + (size_t)(tok0 + t) * PROJ_LD + C_MK + h * 64 + d0);
      u32x4 hq = {0u, 0u, 0u, 0u}, hk = {0u, 0u, 0u, 0u};
      if (c.tid < 24 && ck > 0) { hq = *(const u32x4*)(halo + ((size_t)(cg - 1) * 3 + t) * 512 + h * 64 + d0); hk = *(const u32x4*)(halo + ((size_t)(cg - 1) * 3 + t) * 512 + 256 + h * 64 + d0); }
      LDSP float* fq = Rq + (t + 3) * 65 + d0; LDSP float* fk = Rk + (t + 3) * 65 + d0;
      fq[0] = bflo(vq.x); fq[1] = bfhi(vq.x); fq[2] = bflo(vq.y); fq[3] = bfhi(vq.y); fq[4] = bflo(vq.z); fq[5] = bfhi(vq.z); fq[6] = bflo(vq.w); fq[7] = bfhi(vq.w);
      fk[0] = bflo(vk.x); fk[1] = bfhi(vk.x); fk[2] = bflo(vk.y); fk[3] = bfhi(vk.y); fk[4] = bflo(vk.z); fk[5] = bfhi(vk.z); fk[6] = bflo(vk.w); fk[7] = bfhi(vk.w);
      if (c.tid < 24) { LDSP float* gq = Rq + t * 65 + d0; LDSP float* gk = Rk + t * 65 + d0;
        gq[0] = bflo(hq.x); gq[1] = bfhi(hq.x); gq[2] = bflo(hq.y); gq[3] = bfhi(hq.y); gq[4] = bflo(hq.z); gq[5] = bfhi(hq.z); gq[6] = bflo(hq.w); gq[7] = bfhi(hq.w);
        gk[0] = bflo(hk.x); gk[1] = bfhi(hk.x); gk[2] = bflo(hk.y); gk[3] = bfhi(hk.y); gk[4] = bflo(hk.z); gk[5] = bfhi(hk.z); gk[6] = bflo(hk.w); gk[7] = bfhi(hk.w); } }
    block_sync();
#pragma unroll
    for (int half = 0; half < 2; ++half) {
        const int ch = half * 256 + h * 64 + d0; LDSP float* R = half ? Rk : Rq; LDSP float* F = half ? Fk : Fq; const float scale = half ? 0.125f : 1.0f;
        f32x4 s0 = *(const f32x4*)(cb + ch), s1 = *(const f32x4*)(cb + ch + 4);
#pragma unroll
        for (int j = 0; j < 4; ++j) { const f32x4 w0 = *(const f32x4*)(cw + j * 512 + ch), w1 = *(const f32x4*)(cw + j * 512 + ch + 4); const LDSP float* rr = R + (t + j) * 65 + d0;
            s0[0] += w0[0] * rr[0]; s0[1] += w0[1] * rr[1]; s0[2] += w0[2] * rr[2]; s0[3] += w0[3] * rr[3]; s1[0] += w1[0] * rr[4]; s1[1] += w1[1] * rr[5]; s1[2] += w1[2] * rr[6]; s1[3] += w1[3] * rr[7]; }
        LDSP float* f = F + t * LF_STRIDE + d0;
        f[0] = siluf_(s0[0]) * scale; f[1] = siluf_(s0[1]) * scale; f[2] = siluf_(s0[2]) * scale; f[3] = siluf_(s0[3]) * scale;
        f[4] = siluf_(s1[0]) * scale; f[5] = siluf_(s1[1]) * scale; f[6] = siluf_(s1[2]) * scale; f[7] = siluf_(s1[3]) * scale;
    }
}
DEV void mlstm_gates(const Ctx& c, int l, const bf16_t* proj, int tok0, int h) {
    LDSP float* M = ldsM(c); const float* gb = CIN(7) + (size_t)l * 8;
    if (c.tid < 64) { const int t = c.tid; M[t] = bf2f(proj[(size_t)(tok0 + t) * PROJ_LD + C_MI + h]) + gb[h];
        M[64 + t] = log_sigmoidf_(bf2f(proj[(size_t)(tok0 + t) * PROJ_LD + C_MF + h]) + gb[4 + h]); }
    block_sync();
    if (c.wave == 0) M[64 + c.lane] = wave_scan_add(M[64 + c.lane], c.lane);
    block_sync();
}
DEV void store_state_tiles(const Ctx& c, bf16_t* dst, const f32x4 (&acc)[2]) {
    const int fr = c.lane & 15, fq = c.lane >> 4;
#pragma unroll
    for (int k = 0; k < 2; ++k) { const int ti = c.wave * 2 + k, rt = ti >> 2, ct = ti & 3;
#pragma unroll
        for (int i = 0; i < 4; ++i) dst[(rt * 16 + fq * 4 + i) * 64 + ct * 16 + fr] = f2bf(acc[k][i]); }
}
DEV void f32_to_tile(const Ctx& c, LDSP bf16_t* T, const LDSP float* F, bool transpose) {
    for (int e = c.tid; e < 4096; e += NTHR) { const int r = e >> 6, q = e & 63; const bf16_t v = f2bf(F[r * LF_STRIDE + q]); if (transpose) T[q * LT_STRIDE + r] = v; else T[r * LT_STRIDE + q] = v; }
}

DEV void recur_local_unit(const Ctx& c, int l, int unit) {
    const int mixer = unit / (BATCH * NH * NC), r = unit % (BATCH * NH * NC), b = r / (NH * NC), h = (r / NC) % NH, ck = r % NC;
    bf16_t* proj = wsp<bf16_t>(c, WS_PROJ); const int tok0 = b * SEQ + ck * 64, pos0 = ck * 64;
    LDSP float* F0 = ldsF(c, 0); LDSP float* F1 = ldsF(c, 1); LDSP float* F2 = ldsF(c, 2); LDSP float* M = ldsM(c);
    LDSP bf16_t* VT = ldsT(c, 0); LDSP bf16_t* KT = ldsT(c, 1);
    bf16_t* dst = wsp<bf16_t>(c, WS_ST + mixer * ST_ONE) + (size_t)r * 4096;
    const int vt = c.tid >> 3, vd0 = (c.tid & 7) * 8;
    int qcol, kcol, vcol;
    if (mixer == 0) {
        qcol = C_HQ; kcol = C_HF; vcol = C_HI;
        load_tile_T(c, VT, proj, tok0, C_HI + h * 64);
        load_tile_f32(c, F2, proj, tok0, C_HQ + h * 64);
        hgrn_front(c, l, proj, tok0, h);
        float qo[8], ko[8];
#pragma unroll
        for (int j = 0; j < 8; ++j) { const int d = vd0 + j; const float bt = F0[vt * LF_STRIDE + d], bm = F0[31 * LF_STRIDE + d], bl = F0[63 * LF_STRIDE + d], kk = F1[vt * LF_STRIDE + d];
            qo[j] = siluf_(F2[vt * LF_STRIDE + d]) * fast_exp(bt - bm); ko[j] = kk * fast_exp(bm - bt); KT[d * LT_STRIDE + vt] = f2bf(kk * fast_exp(bl - bt)); }
        if (c.tid < 64) { wsp<float>(c, WS_GDEC)[(size_t)r * 64 + c.tid] = fast_exp(F0[63 * LF_STRIDE + c.tid]); wsp<float>(c, WS_G31)[(size_t)r * 64 + c.tid] = fast_exp(F0[31 * LF_STRIDE + c.tid]); }
        u32x4 w; w.x = pk2(qo[0], qo[1]); w.y = pk2(qo[2], qo[3]); w.z = pk2(qo[4], qo[5]); w.w = pk2(qo[6], qo[7]); *(u32x4*)(proj + (size_t)(tok0 + vt) * PROJ_LD + C_HQ + h * 64 + vd0) = w;
        w.x = pk2(ko[0], ko[1]); w.y = pk2(ko[2], ko[3]); w.z = pk2(ko[4], ko[5]); w.w = pk2(ko[6], ko[7]); *(u32x4*)(proj + (size_t)(tok0 + vt) * PROJ_LD + C_HF + h * 64 + vd0) = w;
    } else if (mixer == 2) {
        qcol = C_RQ; kcol = C_RK; vcol = C_RV;
        load_tile_T(c, VT, proj, tok0, C_RV + h * 64);
        load_tile_f32(c, F0, proj, tok0, C_RK + h * 64); load_tile_f32(c, F2, proj, tok0, C_RQ + h * 64);
        block_sync();
        rope_tile(c, F0, pos0, 0.125f); rope_tile(c, F2, pos0, 1.0f);
        block_sync();
        const float lg = ret_loggamma(h), gq = fast_exp(lg * (float)(vt - 31)), gk = fast_exp(lg * (float)(31 - vt)), gl = fast_exp(lg * (float)(63 - vt));
        float qo[8], ko[8];
#pragma unroll
        for (int j = 0; j < 8; ++j) { const int d = vd0 + j; const float kk = F0[vt * LF_STRIDE + d]; qo[j] = F2[vt * LF_STRIDE + d] * gq; ko[j] = kk * gk; KT[d * LT_STRIDE + vt] = f2bf(kk * gl); }
        u32x4 w; w.x = pk2(qo[0], qo[1]); w.y = pk2(qo[2], qo[3]); w.z = pk2(qo[4], qo[5]); w.w = pk2(qo[6], qo[7]); *(u32x4*)(proj + (size_t)(tok0 + vt) * PROJ_LD + C_RQ + h * 64 + vd0) = w;
        w.x = pk2(ko[0], ko[1]); w.y = pk2(ko[2], ko[3]); w.z = pk2(ko[4], ko[5]); w.w = pk2(ko[6], ko[7]); *(u32x4*)(proj + (size_t)(tok0 + vt) * PROJ_LD + C_RK + h * 64 + vd0) = w;
    } else {
        qcol = C_MQ; kcol = C_MK; vcol = C_MV;
        load_tile_T(c, VT, proj, tok0, C_MV + h * 64);
        mlstm_gates(c, l, proj, tok0, h);
        mlstm_conv_both(c, l, F2, F0, proj, tok0, ck, b * NC + ck, h);
        if (c.wave == 0) { const int t = c.lane; const float bl = M[127], bt = M[64 + t], li = M[t];
            const float a = wave_max(bl - bt + li); const float pm = wave_scan_max(li - bt, t);
            M[128 + t] = pm; if (t == 0) { M[192] = a; M[193] = bl; }
            float* mts = wsp<float>(c, WS_MTS) + ((size_t)(tok0 + t) * NH + h) * 2; mts[0] = bt; mts[1] = bt + pm; }
        block_sync();
        const float eq = fast_exp(-M[128 + vt]), ek = fast_exp(M[vt] - M[64 + vt]), wk = fast_exp(M[193] - M[64 + vt] + M[vt] - M[192]);
        float qo[8], ko[8];
#pragma unroll
        for (int j = 0; j < 8; ++j) { const int d = vd0 + j; const float kk = F0[vt * LF_STRIDE + d]; qo[j] = F2[vt * LF_STRIDE + d] * eq; ko[j] = kk * ek;
            const float kh = kk * wk; F1[vt * LF_STRIDE + d] = kh; KT[d * LT_STRIDE + vt] = f2bf(kh); }
        block_sync();
        u32x4 w; w.x = pk2(qo[0], qo[1]); w.y = pk2(qo[2], qo[3]); w.z = pk2(qo[4], qo[5]); w.w = pk2(qo[6], qo[7]); *(u32x4*)(proj + (size_t)(tok0 + vt) * PROJ_LD + C_MQ + h * 64 + vd0) = w;
        w.x = pk2(ko[0], ko[1]); w.y = pk2(ko[2], ko[3]); w.z = pk2(ko[4], ko[5]); w.w = pk2(ko[6], ko[7]); *(u32x4*)(proj + (size_t)(tok0 + vt) * PROJ_LD + C_MK + h * 64 + vd0) = w;
        if (c.tid < 64) { float s = 0.f; for (int t = 0; t < 64; ++t) s += F1[t * LF_STRIDE + c.tid]; wsp<float>(c, WS_MNL)[(size_t)r * 64 + c.tid] = s; }
        if (c.tid == 64) { float* sc = wsp<float>(c, WS_MSC) + (size_t)r * 4; sc[0] = M[192]; sc[1] = M[193]; }
    }
    block_sync();
    f32x4 acc[2];
#pragma unroll
    for (int k = 0; k < 2; ++k) { const int ti = c.wave * 2 + k; acc[k] = (f32x4){0.f, 0.f, 0.f, 0.f}; acc[k] = mma_tile(VT, LT_STRIDE, (ti >> 2) * 16, KT, LT_STRIDE, (ti & 3) * 16, 64, acc[k], c.lane); }
    store_state_tiles(c, dst, acc);
    *(u32x4*)(proj + (size_t)(tok0 + vt) * PROJ_LD + vcol + h * 64 + vd0) = *(const LDSP u32x4*)(VT + vt * LT_STRIDE + vd0);
    (void)qcol; (void)kcol;
    block_sync();
}

DEV void recur_scan(const Ctx& c) {
    constexpr int ncol2 = BATCH * NH * 2048;
    constexpr int KB = (NC < 16) ? NC : 16;
    for (int i = c.bid * NTHR + c.tid; i < 3 * ncol2 + BATCH * NH * 64; i += c.nblk * NTHR) {
        if (i < 3 * ncol2) {
            const int mixer = i / ncol2, col = (i % ncol2) * 2, bh = col >> 12, ed = col & 4095, d = ed & 63, h = bh % NH;
            bf16_t* p = wsp<bf16_t>(c, WS_ST + mixer * ST_ONE) + (size_t)bh * NC * 4096 + ed;
            const float* g = wsp<float>(c, WS_GDEC) + (size_t)bh * NC * 64 + d; const float* g31 = wsp<float>(c, WS_G31) + (size_t)bh * NC * 64 + d; const float* sc = wsp<float>(c, WS_MSC) + (size_t)bh * NC * 4;
            const float gr = fast_exp(ret_loggamma(h) * 64.f), gr32 = fast_exp(ret_loggamma(h) * 32.f);
            float s0 = 0.f, s1 = 0.f, m = 0.f;
            for (int kb = 0; kb < NC; kb += KB) {
                unsigned tv[KB]; f32x2 gv[KB]; f32x2 av[KB]; f32x2 hv[KB];
#pragma unroll
                for (int j = 0; j < KB; ++j) { tv[j] = *(const unsigned*)(p + (size_t)(kb + j) * 4096);
                    if (mixer == 0) { gv[j] = *(const f32x2*)(g + (kb + j) * 64); hv[j] = *(const f32x2*)(g31 + (kb + j) * 64); } else if (mixer == 1) av[j] = *(const f32x2*)(sc + (kb + j) * 4); }
#pragma unroll
                for (int j = 0; j < KB; ++j) {
                    const float t0 = bflo(tv[j]), t1 = bfhi(tv[j]);
                    if (mixer == 0) { *(unsigned*)(p + (size_t)(kb + j) * 4096) = pk2(s0 * hv[j][0], s1 * hv[j][1]); s0 = gv[j][0] * s0 + t0; s1 = gv[j][1] * s1 + t1; }
                    else if (mixer == 2) { *(unsigned*)(p + (size_t)(kb + j) * 4096) = pk2(s0 * gr32, s1 * gr32); s0 = gr * s0 + t0; s1 = gr * s1 + t1; }
                    else { *(unsigned*)(p + (size_t)(kb + j) * 4096) = pk2(s0, s1);
                        const float a = av[j][0], bl = av[j][1], mn = fmaxf(bl + m, a), ds = fast_exp(bl + m - mn), dl = fast_exp(a - mn); s0 = ds * s0 + dl * t0; s1 = ds * s1 + dl * t1; m = mn; }
                }
            }
        } else {
            const int j = i - 3 * ncol2, bh = j >> 6, d = j & 63;
            float* p = wsp<float>(c, WS_MNL) + (size_t)bh * NC * 64 + d; float* sc = wsp<float>(c, WS_MSC) + (size_t)bh * NC * 4; float m = 0.f, s = 0.f;
            for (int k = 0; k < NC; ++k) { const float a = sc[k * 4], bl = sc[k * 4 + 1], mn = fmaxf(bl + m, a);
                const float t = p[k * 64]; p[k * 64] = s; if (d == 0) sc[k * 4 + 2] = m; s = fast_exp(bl + m - mn) * s + fast_exp(a - mn) * t; m = mn; }
        }
    }
}

DEV void recur_out_wave(const Ctx& c, int l, int unit) {
    const int mixer = unit / (BATCH * NH * NC), r = unit % (BATCH * NH * NC), b = r / (NH * NC), h = (r / NC) % NH, ck = r % NC;
    const bf16_t* proj = wsp<bf16_t>(c, WS_PROJ); const int tok0 = b * SEQ + ck * 64;
    const bf16_t* st = wsp<bf16_t>(c, WS_ST + mixer * ST_ONE) + (size_t)r * 4096;
    const int fr = c.lane & 15, fq = c.lane >> 4;
    const int qcol = (mixer == 0 ? C_HQ : mixer == 1 ? C_MQ : C_RQ) + h * 64, kcol = (mixer == 0 ? C_HF : mixer == 1 ? C_MK : C_RK) + h * 64;
    const int vcol = (mixer == 0 ? C_HI : mixer == 1 ? C_MV : C_RV) + h * 64, gcol = (mixer == 0 ? C_HG : mixer == 1 ? C_MO : C_RG) + h * 64;
    const float* onorm = (mixer == 0 ? CIN(4) : mixer == 1 ? CIN(8) : CIN(13)) + (size_t)l * MW + h * 64;
    bf16x8 ka[4][2], va[4][2], sa[4][2];
#pragma unroll
    for (int sq = 0; sq < 4; ++sq)
#pragma unroll
        for (int ks = 0; ks < 2; ++ks) {
            ka[sq][ks] = *(const bf16x8*)(proj + (size_t)(tok0 + 16 * sq + fr) * PROJ_LD + kcol + 32 * ks + 8 * fq);
            sa[sq][ks] = *(const bf16x8*)(st + (16 * sq + fr) * 64 + 32 * ks + 8 * fq);
            const bf16_t* vp = proj + (size_t)(tok0 + 16 * sq + fr) * PROJ_LD + vcol + 32 * ks + 4 * fq;
            const u32x2 v0 = *(const u32x2*)vp, v1 = *(const u32x2*)(vp + 16); const u32x4 vv = {v0.x, v0.y, v1.x, v1.y}; va[sq][ks] = __builtin_bit_cast(bf16x8, vv);
        }
    bf16x8 sn[2], vones; float mst = 0.f;
    if (mixer == 1) {
        const float* nst = wsp<float>(c, WS_MNL) + (size_t)r * 64; mst = wsp<float>(c, WS_MSC)[(size_t)r * 4 + 2];
#pragma unroll
        for (int ks = 0; ks < 2; ++ks) { const f32x4 n0 = *(const f32x4*)(nst + 32 * ks + 8 * fq), n1 = *(const f32x4*)(nst + 32 * ks + 8 * fq + 4);
            u32x4 w = {pk2(n0[0], n0[1]), pk2(n0[2], n0[3]), pk2(n1[0], n1[1]), pk2(n1[2], n1[3])}; if (fr != 0) w = (u32x4){0u, 0u, 0u, 0u}; sn[ks] = __builtin_bit_cast(bf16x8, w); }
        const unsigned one2 = (fr == 0) ? 0x3f803f80u : 0u; const u32x4 ow = {one2, one2, one2, one2}; vones = __builtin_bit_cast(bf16x8, ow);
    }
#pragma unroll
    for (int tq = 0; tq < 4; ++tq) {
        const int tok = tok0 + 16 * tq + fr;
        bf16x8 qb[2];
#pragma unroll
        for (int ks = 0; ks < 2; ++ks) qb[ks] = *(const bf16x8*)(proj + (size_t)tok * PROJ_LD + qcol + 32 * ks + 8 * fq);
        f32x4 stt[4];
#pragma unroll
        for (int sq = 0; sq < 4; ++sq) { stt[sq] = (f32x4){0.f, 0.f, 0.f, 0.f};
            if (sq <= tq) { stt[sq] = mfma16(ka[sq][0], qb[0], stt[sq]); stt[sq] = mfma16(ka[sq][1], qb[1], stt[sq]); } }
#pragma unroll
        for (int i = 0; i < 4; ++i) if (4 * fq + i > fr) stt[tq][i] = 0.f;
        f32x4 ot[4], os[4], o5 = {0.f, 0.f, 0.f, 0.f}, s5 = {0.f, 0.f, 0.f, 0.f};
#pragma unroll
        for (int eq = 0; eq < 4; ++eq) { ot[eq] = (f32x4){0.f, 0.f, 0.f, 0.f}; os[eq] = (f32x4){0.f, 0.f, 0.f, 0.f}; }
#pragma unroll
        for (int m = 0; m < 2; ++m) if (2 * m <= tq) {
            const u32x4 pw = {pk2(stt[2 * m][0], stt[2 * m][1]), pk2(stt[2 * m][2], stt[2 * m][3]), pk2(stt[2 * m + 1][0], stt[2 * m + 1][1]), pk2(stt[2 * m + 1][2], stt[2 * m + 1][3])};
            const bf16x8 pb = __builtin_bit_cast(bf16x8, pw);
#pragma unroll
            for (int eq = 0; eq < 4; ++eq) ot[eq] = mfma16(va[eq][m], pb, ot[eq]);
            if (mixer == 1) o5 = mfma16(vones, pb, o5);
        }
        if (mixer != 1) {
#pragma unroll
            for (int eq = 0; eq < 4; ++eq) { ot[eq] = mfma16(sa[eq][0], qb[0], ot[eq]); ot[eq] = mfma16(sa[eq][1], qb[1], ot[eq]); }
        } else {
#pragma unroll
            for (int eq = 0; eq < 4; ++eq) { os[eq] = mfma16(sa[eq][0], qb[0], os[eq]); os[eq] = mfma16(sa[eq][1], qb[1], os[eq]); }
            s5 = mfma16(sn[0], qb[0], s5); s5 = mfma16(sn[1], qb[1], s5);
            const float* mts = wsp<float>(c, WS_MTS) + ((size_t)tok * NH + h) * 2; const float bt = mts[0], ml = mts[1];
            const float inter = bt + mst, mt = fmaxf(inter, ml), rt = fast_exp(ml - mt), stc = fast_exp(mst + ml - mt);
            const float den = shfl_f(rt * o5[0] + stc * s5[0], fr);
            const float inv = fast_rcp(fmaxf(fabsf(den), fast_exp(-mt)));
#pragma unroll
            for (int eq = 0; eq < 4; ++eq) ot[eq] = (ot[eq] * rt + os[eq] * stc) * inv;
        }
        float ss = 0.f;
#pragma unroll
        for (int eq = 0; eq < 4; ++eq) ss += (ot[eq][0] * ot[eq][0] + ot[eq][1] * ot[eq][1]) + (ot[eq][2] * ot[eq][2] + ot[eq][3] * ot[eq][3]);
        ss += xorf<16>(ss); ss += xorf<32>(ss);
        const float rn = fast_rsqrt(ss * (1.0f / 64.0f) + NORM_EPS);
        bf16_t* out = wsp<bf16_t>(c, WS_OUTS) + (size_t)(mixer == 0 ? 0 : mixer == 1 ? 1 : 3) * NT * MW + (size_t)tok * MW + h * 64 + 4 * fq;
#pragma unroll
        for (int eq = 0; eq < 4; ++eq) { const u32x2 gv = *(const u32x2*)(proj + (size_t)tok * PROJ_LD + gcol + 16 * eq + 4 * fq); const f32x4 on = *(const f32x4*)(onorm + 16 * eq + 4 * fq);
            const float g0 = bflo(gv.x), g1 = bfhi(gv.x), g2 = bflo(gv.y), g3 = bfhi(gv.y);
            const float a0 = ot[eq][0] * rn * on[0] * (mixer == 1 ? sigmoidf_(g0) : siluf_(g0)), a1 = ot[eq][1] * rn * on[1] * (mixer == 1 ? sigmoidf_(g1) : siluf_(g1));
            const float a2 = ot[eq][2] * rn * on[2] * (mixer == 1 ? sigmoidf_(g2) : siluf_(g2)), a3 = ot[eq][3] * rn * on[3] * (mixer == 1 ? sigmoidf_(g3) : siluf_(g3));
            u32x2 w; w.x = pk2(a0, a1); w.y = pk2(a2, a3); *(u32x2*)(out + 16 * eq) = w; }
    }
}

DEV void nsa_kprep_item(const Ctx& c, int l, int item) {
    const bf16_t* proj = wsp<bf16_t>(c, WS_PROJ); bf16_t* ksw = wsp<bf16_t>(c, WS_KSW);
    const float* cosT = wsp<float>(c, WS_ROPE); const float* sinT = cosT + SEQ * 32;
    const int tok = item * 32 + (c.tid >> 4), vec = (c.tid >> 2) & 3, br = vec >> 1, g = vec & 1, d0 = (c.tid & 3) * 8;
    const int col = (br == 0 ? C_NKS : C_NKW) + g * 64;
    const u32x4 a = *(const u32x4*)(proj + (size_t)tok * PROJ_LD + col + d0), b2 = *(const u32x4*)(proj + (size_t)tok * PROJ_LD + col + 32 + d0);
    const float x1[8] = {bflo(a.x), bfhi(a.x), bflo(a.y), bfhi(a.y), bflo(a.z), bfhi(a.z), bflo(a.w), bfhi(a.w)};
    const float x2[8] = {bflo(b2.x), bfhi(b2.x), bflo(b2.y), bfhi(b2.y), bflo(b2.z), bfhi(b2.z), bflo(b2.w), bfhi(b2.w)};
    float ss = 0.f;
#pragma unroll
    for (int j = 0; j < 8; ++j) ss += x1[j] * x1[j] + x2[j] * x2[j];
    ss += xorf<1>(ss); ss += xorf<2>(ss);
    const float r = fast_rsqrt(ss * (1.0f / 64.0f) + NORM_EPS); const float* kg = CIN(10) + ((size_t)l * 3 + 1 + br) * 64; const int pos = tok % SEQ;
    float o1[8], o2[8];
#pragma unroll
    for (int j = 0; j < 8; ++j) { const int d = d0 + j; const float y1 = x1[j] * r * kg[d], y2 = x2[j] * r * kg[d + 32], cs = cosT[pos * 32 + d], sn = sinT[pos * 32 + d];
        o1[j] = y1 * cs - y2 * sn; o2[j] = y1 * sn + y2 * cs; }
    bf16_t* o = ksw + (size_t)tok * 256 + vec * 64 + d0;
    u32x4 w; w.x = pk2(o1[0], o1[1]); w.y = pk2(o1[2], o1[3]); w.z = pk2(o1[4], o1[5]); w.w = pk2(o1[6], o1[7]); *(u32x4*)o = w;
    w.x = pk2(o2[0], o2[1]); w.y = pk2(o2[2], o2[3]); w.z = pk2(o2[4], o2[5]); w.w = pk2(o2[6], o2[7]); *(u32x4*)(o + 32) = w;
}
DEV void nsa_compress_unit(const Ctx& c, int l, int unit) {
    const int quarter = unit & 3, kv = (unit >> 2) & 1, g = (unit >> 3) & 1, b = unit >> 4;
    const bf16_t* proj = wsp<bf16_t>(c, WS_PROJ); const bf16_t* wct = wsp<bf16_t>(c, WS_WCT) + (size_t)kv * 64 * 2048;
    const int fr = c.lane & 15, fq = c.lane >> 4, rt = c.wave & 3, kh = c.wave >> 2, n0 = quarter * 64 + rt * 16, n = n0 + fr;
    const int col = (kv == 0 ? C_NKC : C_NVC) + g * 64;
    LDSP float* xch = (LDSP float*)c.lds + (rt * 64 + c.lane) * 17;
    f32x4 acc[4];
#pragma unroll
    for (int et = 0; et < 4; ++et) acc[et] = (f32x4){0.f, 0.f, 0.f, 0.f};
    const bool live = n0 < NCMP_PAD;
    if (live)
    for (int kb = kh * 1024; kb < kh * 1024 + 1024; kb += 128) {
        bf16x8 a[4], bb[4][4];
#pragma unroll
        for (int s4 = 0; s4 < 4; ++s4) { const int kk = kb + s4 * 32 + fq * 8, lrow = kk >> 6, d0 = kk & 63;
            a[s4] = (bf16x8){0, 0, 0, 0, 0, 0, 0, 0};
            if (n < NCMP) a[s4] = *(const bf16x8*)(proj + (size_t)(b * SEQ + 16 * n + lrow) * PROJ_LD + col + d0);
#pragma unroll
            for (int et = 0; et < 4; ++et) bb[s4][et] = *(const bf16x8*)(wct + (size_t)(et * 16 + fr) * 2048 + kk); }
#pragma unroll
        for (int s4 = 0; s4 < 4; ++s4)
#pragma unroll
            for (int et = 0; et < 4; ++et) acc[et] = mfma16(a[s4], bb[s4][et], acc[et]);
    }
    if (kh == 1) {
#pragma unroll
        for (int et = 0; et < 4; ++et)
#pragma unroll
            for (int i = 0; i < 4; ++i) xch[et * 4 + i] = acc[et][i];
    }
    block_sync();
    if (kh == 0 && live) {
        const float* bias = wsp<float>(c, WS_CBIAS) + kv * 64;
        float v[4][4];
#pragma unroll
        for (int et = 0; et < 4; ++et)
#pragma unroll
            for (int i = 0; i < 4; ++i) v[et][i] = acc[et][i] + xch[et * 4 + i] + bias[et * 16 + fr];
        if (kv == 0) {
            const float* kg = CIN(10) + (size_t)l * 3 * 64; bf16_t* kc = wsp<bf16_t>(c, WS_KCMP) + (size_t)(b * 2 + g) * NCMP_PAD * 64;
#pragma unroll
            for (int i = 0; i < 4; ++i) { float ss = 0.f;
#pragma unroll
                for (int et = 0; et < 4; ++et) ss += v[et][i] * v[et][i];
                ss += xorf<1>(ss); ss += xorf<2>(ss); ss += xorf<4>(ss); ss += xorf<8>(ss);
                const float r = fast_rsqrt(ss * (1.0f / 64.0f) + NORM_EPS);
#pragma unroll
                for (int et = 0; et < 4; ++et) kc[(size_t)(n0 + fq * 4 + i) * 64 + et * 16 + fr] = f2bf(v[et][i] * r * kg[et * 16 + fr]); }
        } else {
            bf16_t* vt = wsp<bf16_t>(c, WS_VCMPT) + (size_t)(b * 2 + g) * 64 * NCMP_PAD;
#pragma unroll
            for (int et = 0; et < 4; ++et)
#pragma unroll
                for (int i = 0; i < 4; ++i) vt[(size_t)(et * 16 + fr) * NCMP_PAD + n0 + fq * 4 + i] = f2bf(v[et][i]);
        }
    }
    block_sync();
}

DEV void nsa_vprep_item(const Ctx& c, int item) {
    const int tt = item % NC, r = item / NC, br = r & 1, g = (r >> 1) & 1, b = r >> 2;
    bf16_t* proj = wsp<bf16_t>(c, WS_PROJ); LDSP bf16_t* T = (LDSP bf16_t*)c.lds; const int col = (br == 0 ? C_NVS : C_NVW) + g * 64, tok0 = b * SEQ + tt * 64;
    load_tile_T(c, T, proj, tok0, col);
    block_sync();
    { const int e = c.tid >> 3, t0 = (c.tid & 7) * 8; *(u32x4*)(proj + (size_t)(tok0 + e) * PROJ_LD + col + t0) = *(const LDSP u32x4*)(T + e * LT_STRIDE + t0); }
    block_sync();
}

constexpr int NA_PC = 0, NA_PCLD = 264, NA_BUF = 36864, NA_KLD = 72, NA_VLD = 136, NA_VOFF = 18432, NA_IMP = 73728, NA_SEL = NA_IMP + 16640, NA_GATE = NA_SEL + 512;
constexpr float NEG_BIG = -1.0e30f;

#ifndef HOST_EMU
DEV float fmax_fast(float a, float b) { return __builtin_amdgcn_fmed3f(a, b, __builtin_inff()); }
#else
static inline float fmax_fast(float a, float b) { return a > b ? a : b; }
#endif
constexpr float NEG_HUGE = -3.0e38f;
template <int MODE, bool EDGE>
DEV void nsa_stage(const Ctx& c, int buf, int js, int qt, const bf16x8 (&qr)[2], f32x4 (&ot)[4], float& mrun, float& lrun, unsigned long long selm) {
    const LDSP bf16_t* Kt = (const LDSP bf16_t*)(c.lds + buf * NA_BUF); const LDSP bf16_t* VT = (const LDSP bf16_t*)(c.lds + buf * NA_BUF + NA_VOFF);
    const int fr = c.lane & 15, fq = c.lane >> 4, q = (c.wave & 3) * 16 + fr;
    f32x4 st[8];
#pragma unroll
    for (int kt = 0; kt < 8; ++kt) { st[kt] = (f32x4){0.f, 0.f, 0.f, 0.f};
        st[kt] = mfma16(*(const LDSP bf16x8*)(Kt + (kt * 16 + fr) * NA_KLD + fq * 8), qr[0], st[kt]);
        st[kt] = mfma16(*(const LDSP bf16x8*)(Kt + (kt * 16 + fr) * NA_KLD + 32 + fq * 8), qr[1], st[kt]); }
    if (EDGE) {
#pragma unroll
        for (int kt = 0; kt < 8; ++kt) { const int j = js + (kt >> 2);
#pragma unroll
            for (int i = 0; i < 4; ++i) { const int kk = (kt & 3) * 16 + fq * 4 + i; bool ok;
                if (MODE == 0) ok = (j <= qt) && ((selm >> j) & 1ull) && (j < qt || kk <= q);
                else { const int dlt = (qt - j) * 64 + q - kk; ok = dlt >= 0 && dlt < 512; }
                st[kt][i] = ok ? st[kt][i] : NEG_HUGE; } }
    } else if (MODE == 0) {
        const float b0 = ((selm >> js) & 1ull) ? 0.f : NEG_HUGE, b1 = ((selm >> (js + 1)) & 1ull) ? 0.f : NEG_HUGE;
#pragma unroll
        for (int kt = 0; kt < 8; ++kt) st[kt] += (kt < 4) ? b0 : b1;
    }
    float mx = NEG_HUGE;
#pragma unroll
    for (int kt = 0; kt < 8; ++kt) mx = fmax_fast(mx, fmax_fast(fmax_fast(st[kt][0], st[kt][1]), fmax_fast(st[kt][2], st[kt][3])));
    mx = fmax_fast(mx, xorf<16>(mx)); mx = fmax_fast(mx, xorf<32>(mx));
    const float mn = fmax_fast(mrun, mx), alpha = fast_exp2(mrun - mn); mrun = mn; float ps = 0.f;
#pragma unroll
    for (int kt = 0; kt < 8; ++kt)
#pragma unroll
        for (int i = 0; i < 4; ++i) { const float pv = fast_exp2(st[kt][i] - mn); st[kt][i] = pv; ps += pv; }
    lrun = lrun * alpha + ps;
#pragma unroll
    for (int et = 0; et < 4; ++et) ot[et] *= alpha;
#pragma unroll
    for (int m = 0; m < 4; ++m) {
        const u32x4 pw = {pk2(st[2 * m][0], st[2 * m][1]), pk2(st[2 * m][2], st[2 * m][3]), pk2(st[2 * m + 1][0], st[2 * m + 1][1]), pk2(st[2 * m + 1][2], st[2 * m + 1][3])};
        const bf16x8 pb = __builtin_bit_cast(bf16x8, pw);
#pragma unroll
        for (int et = 0; et < 4; ++et) { const LDSP bf16_t* vrow = VT + (et * 16 + fr) * NA_VLD + 32 * m + 4 * fq;
            const u32x2 v0 = *(const LDSP u32x2*)vrow, v1 = *(const LDSP u32x2*)(vrow + 16);
            const u32x4 vv = {v0.x, v0.y, v1.x, v1.y};
            ot[et] = mfma16(__builtin_bit_cast(bf16x8, vv), pb, ot[et]); }
    }
}

DEV void nsa_attn_unit(const Ctx& c, int l, int unit) {
    const int qt = unit % NSEL, bg = unit / NSEL, g = bg & 1, b = bg >> 1;
    const bf16_t* proj = wsp<bf16_t>(c, WS_PROJ); const bf16_t* ksw = wsp<bf16_t>(c, WS_KSW);
    const float* cosT = wsp<float>(c, WS_ROPE); const float* sinT = cosT + SEQ * 32;
    LDSP bf16_t* Pc = (LDSP bf16_t*)(c.lds + NA_PC); LDSP float* imp = (LDSP float*)(c.lds + NA_IMP); LDSP unsigned long long* selmask = (LDSP unsigned long long*)(c.lds + NA_SEL);
    LDSP float* gates = (LDSP float*)(c.lds + NA_GATE);
    const int fr = c.lane & 15, fq = c.lane >> 4, hg = c.wave >> 2, hd = g * 2 + hg, qw = (c.wave & 3) * 16;
    const int tokq0 = b * SEQ + qt * 64;
    bf16x8 qc[2], qr[2];
    {
        const int tok = tokq0 + qw + fr, pos = qt * 64 + qw + fr;
        const u32x4 v0 = *(const u32x4*)(proj + (size_t)tok * PROJ_LD + C_NQ + hd * 64 + fq * 8), v1 = *(const u32x4*)(proj + (size_t)tok * PROJ_LD + C_NQ + hd * 64 + 32 + fq * 8);
        float x0[8] = {bflo(v0.x), bfhi(v0.x), bflo(v0.y), bfhi(v0.y), bflo(v0.z), bfhi(v0.z), bflo(v0.w), bfhi(v0.w)};
        float x1[8] = {bflo(v1.x), bfhi(v1.x), bflo(v1.y), bfhi(v1.y), bflo(v1.z), bfhi(v1.z), bflo(v1.w), bfhi(v1.w)};
        float ss = 0.f;
#pragma unroll
        for (int j = 0; j < 8; ++j) ss += x0[j] * x0[j] + x1[j] * x1[j];
        ss += xorf<16>(ss); ss += xorf<32>(ss);
        const float r = fast_rsqrt(ss * (1.0f / 64.0f) + NORM_EPS) * 0.125f; const float* qg = CIN(9) + (size_t)l * 64;
#pragma unroll
        for (int j = 0; j < 8; ++j) { const int d = fq * 8 + j; const float y0 = x0[j] * r * qg[d], y1 = x1[j] * r * qg[d + 32];
            const float cs = cosT[pos * 32 + d], sn = sinT[pos * 32 + d];
            qc[0][j] = (short)f2bf(y0); qc[1][j] = (short)f2bf(y1); qr[0][j] = (short)f2bf((y0 * cs - y1 * sn) * 1.44269504f); qr[1][j] = (short)f2bf((y0 * sn + y1 * cs) * 1.44269504f); }
    }
    if (c.tid < 384) { const int row = c.tid / 3, br = c.tid % 3, hh = row >> 6, q = row & 63;
        gates[c.tid] = sigmoidf_(bf2f(proj[(size_t)(tokq0 + q) * PROJ_LD + C_NG + (g * 2 + hh) * 3 + br])); }
    f32x4 ofin[4];
#pragma unroll
    for (int et = 0; et < 4; ++et) ofin[et] = (f32x4){0.f, 0.f, 0.f, 0.f};
    const int nvis = 4 * qt + 3, nkt = (nvis + 15) >> 4, nk32 = ((nkt * 16 + 31) >> 5) << 5;
    {
        const bf16_t* kc = wsp<bf16_t>(c, WS_KCMP) + (size_t)(b * 2 + g) * NCMP_PAD * 64;
        f32x4 s[16];
#pragma unroll
        for (int jt = 0; jt < 16; ++jt) { s[jt] = (f32x4){0.f, 0.f, 0.f, 0.f};
            if (jt < nkt) { s[jt] = mfma16(qc[0], *(const bf16x8*)(kc + (size_t)(jt * 16 + fr) * 64 + fq * 8), s[jt]);
                            s[jt] = mfma16(qc[1], *(const bf16x8*)(kc + (size_t)(jt * 16 + fr) * 64 + 32 + fq * 8), s[jt]); } }
#pragma unroll
        for (int i = 0; i < 4; ++i) {
            const int sp = qt * 64 + qw + fq * 4 + i, lim = (sp >= 31) ? ((sp - 31) >> 4) : -1;
            float mx = NEG_BIG;
#pragma unroll
            for (int jt = 0; jt < 16; ++jt) if (jt < nkt && jt * 16 + fr <= lim) mx = fmaxf(mx, s[jt][i]);
            mx = fmaxf(mx, xorf<1>(mx)); mx = fmaxf(mx, xorf<2>(mx)); mx = fmaxf(mx, xorf<4>(mx)); mx = fmaxf(mx, xorf<8>(mx));
            float ps = 0.f;
#pragma unroll
            for (int jt = 0; jt < 16; ++jt) { float p = 0.f; if (jt < nkt && jt * 16 + fr <= lim) p = fast_exp(s[jt][i] - mx); s[jt][i] = p; ps += p; }
            ps += xorf<1>(ps); ps += xorf<2>(ps); ps += xorf<4>(ps); ps += xorf<8>(ps);
            const float inv = ps > 0.f ? fast_rcp(ps) : 0.f;
            LDSP bf16_t* prow = Pc + (size_t)(hg * 64 + qw + fq * 4 + i) * NA_PCLD;
#pragma unroll
            for (int jt = 0; jt < 16; ++jt) if (jt * 16 < nk32) prow[jt * 16 + fr] = f2bf(s[jt][i] * inv);
        }
        wave_sync();
        const bf16_t* vt = wsp<bf16_t>(c, WS_VCMPT) + (size_t)(b * 2 + g) * 64 * NCMP_PAD;
        f32x4 oc[4];
#pragma unroll
        for (int et = 0; et < 4; ++et) oc[et] = (f32x4){0.f, 0.f, 0.f, 0.f};
        for (int k0 = 0; k0 < nk32; k0 += 32) {
            const bf16x8 pa = *(const LDSP bf16x8*)(Pc + (size_t)(hg * 64 + qw + fr) * NA_PCLD + k0 + fq * 8);
#pragma unroll
            for (int et = 0; et < 4; ++et) oc[et] = mfma16(*(const bf16x8*)(vt + (size_t)(et * 16 + fr) * NCMP_PAD + k0 + fq * 8), pa, oc[et]);
        }
        block_sync();
#pragma unroll
        for (int et = 0; et < 4; ++et) ofin[et] += oc[et] * gates[(hg * 64 + qw + fr) * 3 + 0];
    }
    for (int e = c.tid; e < 4096; e += NTHR) { const int q = e >> 6, j = e & 63; float a = 0.f;
        if (j <= qt) {
#pragma unroll
            for (int dn = -1; dn <= 3; ++dn) { const int n = 4 * j + dn; if (n >= 0 && n < nkt * 16) a += bf2f(Pc[(size_t)q * NA_PCLD + n]) + bf2f(Pc[(size_t)(64 + q) * NA_PCLD + n]); }
            if (j == 0 || j == qt || j == qt - 1) a += 1000.f;
        } else a = NEG_BIG;
        imp[q * 65 + j] = a; }
    block_sync();
    for (int qq = 0; qq < 8; ++qq) { const int q = c.wave * 8 + qq; unsigned long long m = 0ull;
        if (qt < 16) m = (1ull << (qt + 1)) - 1ull;
        else { const unsigned key = (sortkey32(imp[q * 65 + c.lane]) & 0xffffffc0u) | (unsigned)(63 - c.lane); int rank = 0;
#pragma unroll
            for (int i = 0; i < 64; ++i) rank += ((unsigned)bcast_i((int)key, i) > key) ? 1 : 0;
            m = ballot64(rank < 16); }
        if (c.lane == 0) selmask[q] = m; }
    block_sync();
    const unsigned long long selm = selmask[qw + fr];
#pragma unroll
    for (int mode = 0; mode < 2; ++mode) {
        f32x4 ot[4]; float mrun = NEG_BIG, lrun = 0.f;
#pragma unroll
        for (int et = 0; et < 4; ++et) ot[et] = (f32x4){0.f, 0.f, 0.f, 0.f};
        const int j0 = (mode == 0) ? 0 : (qt >= 8 ? qt - 8 : 0), ns = (qt - j0) / 2 + 1;
        const int skey = c.tid >> 2, sd0 = (c.tid & 3) * 16, se = c.tid >> 3, sk0 = (c.tid & 7) * 16;
        u32x4 rk0, rk1, rv0, rv1;
#define NSA_STAGE_LOAD(js_) do { const int jb_ = (js_) + (skey >> 6) > qt ? qt : (js_) + (skey >> 6); const size_t tok_ = (size_t)b * SEQ + jb_ * 64 + (skey & 63); \
            const bf16_t* kp_ = ksw + tok_ * 256 + (mode * 2 + g) * 64 + sd0; rk0 = *(const u32x4*)kp_; rk1 = *(const u32x4*)(kp_ + 8); \
            const int jv_ = (js_) + (sk0 >> 6) > qt ? qt : (js_) + (sk0 >> 6); const bf16_t* vp_ = proj + ((size_t)b * SEQ + jv_ * 64 + se) * PROJ_LD + (mode == 0 ? C_NVS : C_NVW) + g * 64 + (sk0 & 63); rv0 = *(const u32x4*)vp_; rv1 = *(const u32x4*)(vp_ + 8); } while (0)
#define NSA_STAGE_WRITE(buf_) do { LDSP bf16_t* kd_ = (LDSP bf16_t*)(c.lds + (buf_) * NA_BUF) + skey * NA_KLD + sd0; *(LDSP u32x4*)kd_ = rk0; *(LDSP u32x4*)(kd_ + 8) = rk1; \
            LDSP bf16_t* vd_ = (LDSP bf16_t*)(c.lds + (buf_) * NA_BUF + NA_VOFF) + se * NA_VLD + sk0; *(LDSP u32x4*)vd_ = rv0; *(LDSP u32x4*)(vd_ + 8) = rv1; } while (0)
        NSA_STAGE_LOAD(j0); NSA_STAGE_WRITE(0);
        block_sync();
        for (int sidx = 0; sidx < ns; ++sidx) {
            const int js = j0 + 2 * sidx;
            if (sidx + 1 < ns) NSA_STAGE_LOAD(js + 2);
            const bool edge = (mode == 0) ? (js + 1 >= qt) : (sidx == 0 || js + 1 >= qt);
            if (mode == 0) { if (edge) nsa_stage<0, true>(c, sidx & 1, js, qt, qr, ot, mrun, lrun, selm); else nsa_stage<0, false>(c, sidx & 1, js, qt, qr, ot, mrun, lrun, selm); }
            else { if (edge) nsa_stage<1, true>(c, sidx & 1, js, qt, qr, ot, mrun, lrun, selm); else nsa_stage<1, false>(c, sidx & 1, js, qt, qr, ot, mrun, lrun, selm); }
            if (sidx + 1 < ns) NSA_STAGE_WRITE((sidx + 1) & 1);
            block_sync();
        }
#undef NSA_STAGE_LOAD
#undef NSA_STAGE_WRITE
        float ls = lrun; ls += xorf<16>(ls); ls += xorf<32>(ls);
        const float sc = gates[(hg * 64 + qw + fr) * 3 + 1 + mode] * (ls > 0.f ? fast_rcp(ls) : 0.f);
#pragma unroll
        for (int et = 0; et < 4; ++et) ofin[et] += ot[et] * sc;
    }
    bf16_t* out = wsp<bf16_t>(c, WS_OUTS) + (size_t)2 * NT * MW + (size_t)(tokq0 + qw + fr) * MW + hd * 64 + fq * 4;
#pragma unroll
    for (int et = 0; et < 4; ++et) { u32x2 w; w.x = pk2(ofin[et][0], ofin[et][1]); w.y = pk2(ofin[et][2], ofin[et][3]); *(u32x2*)(out + et * 16) = w; }
    block_sync();
}
constexpr int PEER_WSCR = (4 * 256 + 3 * 128) * 4;
constexpr int PEER_X8 = 8 * PEER_WSCR;
constexpr int PEER_TAB = PEER_X8 + 8 * 1024;
#ifndef HOST_EMU
DEV int uniform_i(int v) { return __builtin_amdgcn_readfirstlane(v); }
#else
static inline int uniform_i(int v) { return v; }
#endif
DEV unsigned sortkey16(unsigned b) { return (b & 0x8000u) ? (~b & 0xffffu) : (b | 0x8000u); }
DEV f32x2 dot16_fp8(const f32x2 (&x)[8], const u32x4 q, f32x2 s) {
#pragma unroll
    for (int i = 0; i < 4; ++i) { const f32x2 lo = cvt_pk_f32_fp8(q[i], false), hi = cvt_pk_f32_fp8(q[i], true); s = x[2 * i] * lo + s; s = x[2 * i + 1] * hi + s; }
    return s;
}
DEV void axpy16_fp8(f32x2 (&acc)[8], float w, const u32x4 q) {
    const f32x2 w2 = {w, w};
#pragma unroll
    for (int i = 0; i < 4; ++i) { const f32x2 lo = cvt_pk_f32_fp8(q[i], false), hi = cvt_pk_f32_fp8(q[i], true); acc[2 * i] = w2 * lo + acc[2 * i]; acc[2 * i + 1] = w2 * hi + acc[2 * i + 1]; }
}
DEV f32x2 dot16_fp4(const f32x2 (&x)[8], const u32x2 q, f32x2 s) {
#pragma unroll
    for (int i = 0; i < 2; ++i)
#pragma unroll
        for (int b = 0; b < 4; ++b) s = x[4 * i + b] * cvt_pk_f32_fp4(q[i], b) + s;
    return s;
}
DEV void axpy16_fp4(f32x2 (&acc)[8], float w, const u32x2 q) {
    const f32x2 w2 = {w, w};
#pragma unroll
    for (int i = 0; i < 2; ++i)
#pragma unroll
        for (int b = 0; b < 4; ++b) acc[4 * i + b] = w2 * cvt_pk_f32_fp4(q[i], b) + acc[4 * i + b];
}
DEV void peer_init_tab(const Ctx& c) {
    if (c.tid < 64) { const int t = c.tid; int a, b;
        if (t < 16) { a = 0; b = t; } else if (t < 24) { a = 1; b = t - 16; } else if (t < 29) { a = 2; b = t - 24; } else if (t < 33) { a = 3; b = t - 29; }
        else if (t < 36) { a = 4; b = t - 33; } else if (t < 42) { a = 5 + (t - 36) / 2; b = (t - 36) & 1; } else { a = 8 + (t - 42); b = 0; }
        ((LDSP unsigned char*)(c.lds + PEER_TAB))[t] = (t < 50) ? (unsigned char)((a << 4) | b) : (unsigned char)0xff; }
    block_sync();
}
DEV void peer_token(const Ctx& c, int l, int tok) {
    const int lane = c.lane;
    LDSP float* Wv = (LDSP float*)(c.lds + c.wave * PEER_WSCR); LDSP int* Wi = (LDSP int*)(Wv + 256); LDSP float* Sv = (LDSP float*)(Wi + 256); LDSP int* Si = (LDSP int*)(Sv + 256);
    LDSP int* We = Si + 256; LDSP float* Ws = (LDSP float*)(We + 128); LDSP float* Wg = Ws + 128;
    const bf16_t* sc = wsp<bf16_t>(c, WS_SCORES) + (size_t)tok * PEER_N;
#ifndef DUP_TOPK
#define DUP_TOPK 1
#endif
    for (int rep_ = 0; rep_ < DUP_TOPK; ++rep_) {
    {
        unsigned k[32];
        { const int g = lane >> 2, cq = lane & 3; const bf16_t* sp = sc + g * 128 + cq * 32;
#pragma unroll
          for (int v4 = 0; v4 < 4; ++v4) { const u32x4 w = *(const u32x4*)(sp + 8 * v4);
#pragma unroll
            for (int j = 0; j < 4; ++j) { const unsigned d = w[j]; const int i0 = 8 * v4 + 2 * j;
                k[i0] = (sortkey16(d & 0xffffu) << 16) | (unsigned)(127 - (cq * 32 + i0)); k[i0 + 1] = (sortkey16(d >> 16) << 16) | (unsigned)(127 - (cq * 32 + i0 + 1)); } } }
#define PEER_CX(i_, j_) do { const unsigned a_ = k[i_], b_ = k[j_]; k[i_] = a_ > b_ ? a_ : b_; k[j_] = a_ > b_ ? b_ : a_; } while (0)
#pragma unroll
        for (int size = 2; size <= 16; size <<= 1) {
#pragma unroll
            for (int i = 0; i < 32; ++i) { const int j = i ^ (size - 1); if (j > i) PEER_CX(i, j); }
#pragma unroll
            for (int stride = size >> 2; stride > 0; stride >>= 1) {
#pragma unroll
                for (int i = 0; i < 32; ++i) { const int j = i ^ stride; if (j > i) PEER_CX(i, j); } }
        }
#pragma unroll
        for (int i = 0; i < 16; ++i) { const unsigned a_ = k[i], b_ = k[31 - i]; k[i] = a_ > b_ ? a_ : b_; }
#pragma unroll
        for (int stride = 8; stride > 0; stride >>= 1) {
#pragma unroll
            for (int i = 0; i < 16; ++i) { const int j = i ^ stride; if (j > i) PEER_CX(i, j); } }
#pragma unroll
        for (int lvl = 0; lvl < 2; ++lvl) {
            unsigned pk_[16];
#pragma unroll
            for (int i = 0; i < 16; ++i) pk_[i] = (unsigned)(lvl == 0 ? xori<1>((int)k[i]) : xori<2>((int)k[i]));
#pragma unroll
            for (int i = 0; i < 16; ++i) { const unsigned a_ = k[i], b_ = pk_[15 - i]; k[i] = a_ > b_ ? a_ : b_; }
#pragma unroll
            for (int stride = 8; stride > 0; stride >>= 1) {
#pragma unroll
                for (int i = 0; i < 16; ++i) { const int j = i ^ stride; if (j > i) PEER_CX(i, j); } }
        }
#undef PEER_CX
        { const int g = lane >> 2, cq = lane & 3;
#pragma unroll
          for (int cc = 0; cc < 4; ++cc)
#pragma unroll
            for (int j = 0; j < 4; ++j) if (cc == cq) { const unsigned pk = k[4 * cc + j]; const unsigned k16 = pk >> 16, bits = (k16 & 0x8000u) ? (k16 & 0x7fffu) : (~k16 & 0xffffu);
                Sv[g * 16 + 4 * cc + j] = __builtin_bit_cast(float, bits << 16); Si[g * 16 + 4 * cc + j] = 127 - (int)(pk & 0x7fu); } }
    }
    wave_sync();
    {
        const int h = lane >> 3, cq = lane & 7; const LDSP unsigned char* tab = (const LDSP unsigned char*)(c.lds + PEER_TAB);
        unsigned k[16];
#pragma unroll
        for (int j = 0; j < 8; ++j) { const int ci = cq + 8 * j; unsigned key = 0u;
            if (ci < 50) { const unsigned ab = tab[ci]; const int a = (ab >> 4) & 15, b = ab & 15; const float s = Sv[(2 * h) * 16 + a] + Sv[(2 * h + 1) * 16 + b];
                key = (sortkey32(s) & 0xffffff00u) | (unsigned)(255 - (a * 16 + b)); }
            k[j] = key; }
#define PEER_CX(i_, j_) do { const unsigned a_ = k[i_], b_ = k[j_]; k[i_] = a_ > b_ ? a_ : b_; k[j_] = a_ > b_ ? b_ : a_; } while (0)
#pragma unroll
        for (int size = 2; size <= 8; size <<= 1) {
#pragma unroll
            for (int i = 0; i < 8; ++i) { const int j = i ^ (size - 1); if (j > i) PEER_CX(i, j); }
#pragma unroll
            for (int stride = size >> 2; stride > 0; stride >>= 1) {
#pragma unroll
                for (int i = 0; i < 8; ++i) { const int j = i ^ stride; if (j > i) PEER_CX(i, j); } }
        }
#pragma unroll
        for (int i = 0; i < 8; ++i) k[15 - i] = (unsigned)xori<1>((int)k[i]);
#pragma unroll
        for (int stride = 8; stride > 0; stride >>= 1) {
#pragma unroll
            for (int i = 0; i < 16; ++i) { const int j = i ^ stride; if (j > i) PEER_CX(i, j); } }
#pragma unroll
        for (int lvl = 0; lvl < 2; ++lvl) {
            unsigned pk_[16];
#pragma unroll
            for (int i = 0; i < 16; ++i) pk_[i] = (unsigned)(lvl == 0 ? xori<2>((int)k[i]) : xori<4>((int)k[i]));
#pragma unroll
            for (int i = 0; i < 16; ++i) { const unsigned a_ = k[i], b_ = pk_[15 - i]; k[i] = a_ > b_ ? a_ : b_; }
#pragma unroll
            for (int stride = 8; stride > 0; stride >>= 1) {
#pragma unroll
                for (int i = 0; i < 16; ++i) { const int j = i ^ stride; if (j > i) PEER_CX(i, j); } }
        }
#undef PEER_CX
#pragma unroll
        for (int cc = 0; cc < 8; ++cc)
#pragma unroll
            for (int j = 0; j < 2; ++j) if (cc == cq) { const int pos = 255 - (int)(k[2 * cc + j] & 0xffu), a = pos >> 4, b = pos & 15;
                We[h * 16 + 2 * cc + j] = (Si[(2 * h) * 16 + a] * 128 + Si[(2 * h + 1) * 16 + b]) & 16383; Ws[h * 16 + 2 * cc + j] = Sv[(2 * h) * 16 + a] + Sv[(2 * h + 1) * 16 + b]; }
    }
    wave_sync();
    { const float mx = Ws[(lane >> 3) * 16]; const float e0 = fast_exp(Ws[2 * lane] - mx), e1 = fast_exp(Ws[2 * lane + 1] - mx); float sm = e0 + e1;
      sm += xorf<1>(sm); sm += xorf<2>(sm); sm += xorf<4>(sm); const float inv = fast_rcp(sm); Wg[2 * lane] = e0 * inv; Wg[2 * lane + 1] = e1 * inv; }
    wave_sync();
    }
    const bf16_t* xb = wsp<bf16_t>(c, WS_XB) + (size_t)tok * DM; const unsigned char* PU = wsp<unsigned char>(c, WS_PU); const unsigned char* PV = wsp<unsigned char>(c, WS_PV);
    f32x2 xf[8];
    const u32x4 x0 = *(const u32x4*)(xb + 16 * lane), x1 = *(const u32x4*)(xb + 16 * lane + 8);
    { xf[0] = (f32x2){bflo(x0.x), bfhi(x0.x)}; xf[1] = (f32x2){bflo(x0.y), bfhi(x0.y)}; xf[2] = (f32x2){bflo(x0.z), bfhi(x0.z)}; xf[3] = (f32x2){bflo(x0.w), bfhi(x0.w)};
      xf[4] = (f32x2){bflo(x1.x), bfhi(x1.x)}; xf[5] = (f32x2){bflo(x1.y), bfhi(x1.y)}; xf[6] = (f32x2){bflo(x1.z), bfhi(x1.z)}; xf[7] = (f32x2){bflo(x1.w), bfhi(x1.w)}; }
    const float rstd = pg8::rstd_of(pg8::rss_slots16(wsp<float>(c, WS_RSS2) + (size_t)tok * 16)) * (1.0f / 64.0f);
    f32x2 acc[8];
#pragma unroll
    for (int j = 0; j < 8; ++j) acc[j] = (f32x2){0.f, 0.f};
    LDSP unsigned char* X8 = (LDSP unsigned char*)(c.lds + PEER_X8 + c.wave * 1024);
    { u32x4 xq;
      xq.x = cvt_pk_fp8_f32(xf[1][0], xf[1][1], cvt_pk_fp8_f32(xf[0][0], xf[0][1], 0u, false), true); xq.y = cvt_pk_fp8_f32(xf[3][0], xf[3][1], cvt_pk_fp8_f32(xf[2][0], xf[2][1], 0u, false), true);
      xq.z = cvt_pk_fp8_f32(xf[5][0], xf[5][1], cvt_pk_fp8_f32(xf[4][0], xf[4][1], 0u, false), true); xq.w = cvt_pk_fp8_f32(xf[7][0], xf[7][1], cvt_pk_fp8_f32(xf[6][0], xf[6][1], 0u, false), true);
      *(LDSP u32x4*)(X8 + 16 * lane) = xq;
    }
    wave_sync();
#define PEER_LOADV(buf, base) do { _Pragma("unroll") for (int k_ = 0; k_ < 8; ++k_) { const unsigned o_ = ((unsigned)We[(base) + k_] << 9) + 8u * (unsigned)lane; buf[k_] = *(const u32x2*)(PV + o_); } } while (0)
#define PEER_LOADU(buf, hh) do { const unsigned o_ = ((unsigned)We[(hh) * 16 + (lane & 15)] << 9) + 16u * (unsigned)(lane >> 4); _Pragma("unroll") for (int s_ = 0; s_ < 8; ++s_) buf[s_] = *(const u32x4*)(PU + o_ + 64u * s_); } while (0)
    u32x4 ua[8]; u32x2 bv0[8], bv1[8];
    PEER_LOADU(ua, 0); PEER_LOADV(bv0, 0); PEER_LOADV(bv1, 8);
#ifndef HOST_EMU
#define PEER_SCHED_FENCE() __builtin_amdgcn_sched_barrier(0)
#else
#define PEER_SCHED_FENCE() do {} while (0)
#endif
    for (int h = 0; h < 8; ++h) {
        f32x4 dacc = {0.f, 0.f, 0.f, 0.f};
#pragma unroll
        for (int s = 0; s < 8; ++s) { const LDSP unsigned char* xq = X8 + 128 * s + 16 * (lane >> 4);
            dacc = mfma_fp4_fp8(ua[s], *(const LDSP u32x4*)xq, *(const LDSP u32x4*)(xq + 64), dacc); }
        if (h < 7) PEER_LOADU(ua, h + 1);
        const int srcl = 16 * ((lane & 15) >> 2);
        const float d0 = shfl_f(dacc[0], srcl), d1 = shfl_f(dacc[1], srcl), d2 = shfl_f(dacc[2], srcl), d3 = shfl_f(dacc[3], srcl);
        const float dk = (lane & 2) ? ((lane & 1) ? d3 : d2) : ((lane & 1) ? d1 : d0);
        const float wk = Wg[h * 16 + (lane & 15)] * gelu_erf(dk * rstd) * 0.1f;
#pragma unroll
        for (int k = 0; k < 8; ++k) axpy16_fp4(acc, bcast_f(wk, k), bv0[k]);
        PEER_SCHED_FENCE();
        if (h < 7) PEER_LOADV(bv0, h * 16 + 16);
#pragma unroll
        for (int k = 0; k < 8; ++k) axpy16_fp4(acc, bcast_f(wk, 8 + k), bv1[k]);
        PEER_SCHED_FENCE();
        if (h < 7) PEER_LOADV(bv1, h * 16 + 24);
    }
#undef PEER_SCHED_FENCE
#undef PEER_LOADU
#undef PEER_LOADV
    float ss = 0.f; f32x4 o[4];
    o[0] = (f32x4){bflo(x0.x) + acc[0][0], bfhi(x0.x) + acc[0][1], bflo(x0.y) + acc[1][0], bfhi(x0.y) + acc[1][1]};
    o[1] = (f32x4){bflo(x0.z) + acc[2][0], bfhi(x0.z) + acc[2][1], bflo(x0.w) + acc[3][0], bfhi(x0.w) + acc[3][1]};
    o[2] = (f32x4){bflo(x1.x) + acc[4][0], bfhi(x1.x) + acc[4][1], bflo(x1.y) + acc[5][0], bfhi(x1.y) + acc[5][1]};
    o[3] = (f32x4){bflo(x1.z) + acc[6][0], bfhi(x1.z) + acc[6][1], bflo(x1.w) + acc[7][0], bfhi(x1.w) + acc[7][1]};
    if (l + 1 < DEPTH) {
        bf16_t* xo = wsp<bf16_t>(c, WS_XB) + (size_t)tok * DM + 16 * lane;
        u32x4 w0, w1; w0.x = pk2(o[0][0], o[0][1]); w0.y = pk2(o[0][2], o[0][3]); w0.z = pk2(o[1][0], o[1][1]); w0.w = pk2(o[1][2], o[1][3]);
        w1.x = pk2(o[2][0], o[2][1]); w1.y = pk2(o[2][2], o[2][3]); w1.z = pk2(o[3][0], o[3][1]); w1.w = pk2(o[3][2], o[3][3]);
        *(u32x4*)xo = w0; *(u32x4*)(xo + 8) = w1;
#pragma unroll
        for (int j = 0; j < 4; ++j) ss += (o[j][0] * o[j][0] + o[j][1] * o[j][1]) + (o[j][2] * o[j][2] + o[j][3] * o[j][3]);
        ss = wave_sum(ss);
        if (lane == 0) wsp<float>(c, WS_RSS1)[tok] = ss;
    } else {
        float* orow = c.out + (size_t)tok * DM + 16 * lane;
#pragma unroll
        for (int j = 0; j < 4; ++j) *(f32x4*)(orow + 4 * j) = o[j];
    }
    wave_sync();
}
DEV void peer_table_rows(const Ctx& c, int l) {
    const float* g2 = CIN(17) + (size_t)l * DM;
    const f32x4 ga = *((const f32x4*)g2 + 4 * c.lane), gb = *((const f32x4*)g2 + 4 * c.lane + 1), gc = *((const f32x4*)g2 + 4 * c.lane + 2), gd = *((const f32x4*)g2 + 4 * c.lane + 3);
    for (int r = c.bid * NWAVE + c.wave; r < 2 * 16384; r += c.nblk * NWAVE) {
        const int tab = r >> 14, e = r & 16383;
        const f32x4* src = (const f32x4*)((tab == 0 ? CIN(20) : CIN(21)) + ((size_t)l * 16384 + e) * DM) + 4 * c.lane;
        f32x4 v0 = src[0], v1 = src[1], v2 = src[2], v3 = src[3];
        if (tab == 0) { v0 *= ga * 64.0f; v1 *= gb * 64.0f; v2 *= gc * 64.0f; v3 *= gd * 64.0f;
        } else { v0 *= 10.0f; v1 *= 10.0f; v2 *= 10.0f; v3 *= 10.0f; }
        {
            u32x2 q;
            q.x = fp4_code(v0[0]) | (fp4_code(v0[1]) << 4) | (fp4_code(v0[2]) << 8) | (fp4_code(v0[3]) << 12) | (fp4_code(v1[0]) << 16) | (fp4_code(v1[1]) << 20) | (fp4_code(v1[2]) << 24) | (fp4_code(v1[3]) << 28);
            q.y = fp4_code(v2[0]) | (fp4_code(v2[1]) << 4) | (fp4_code(v2[2]) << 8) | (fp4_code(v2[3]) << 12) | (fp4_code(v3[0]) << 16) | (fp4_code(v3[1]) << 20) | (fp4_code(v3[2]) << 24) | (fp4_code(v3[3]) << 28);
            *(u32x2*)(wsp<unsigned char>(c, tab == 0 ? WS_PU : WS_PV) + (size_t)e * (DM / 2) + 8 * c.lane) = q;
        }
    }
}
#ifndef HOST_EMU
#define XB_TMO      128
#define XB_XCNT(j)  (256  + 64 * (j))
#define XB_XSUB(j)  (1280 + 64 * (j))
#define XB_XGEN(j)  (2304 + 64 * (j))
#define XB_TOP      3328
#define XB_TOPGEN   3392
#define XCD_BAR_WORDS 3456
#define XB_SPIN_CAP (1u << 18)

__device__ __forceinline__ unsigned xb_ld(unsigned* p)              { return __hip_atomic_load(p, __ATOMIC_RELAXED, __HIP_MEMORY_SCOPE_AGENT); }
__device__ __forceinline__ unsigned xb_add(unsigned* p, unsigned v) { return __hip_atomic_fetch_add(p, v, __ATOMIC_RELAXED, __HIP_MEMORY_SCOPE_AGENT); }
__device__ __forceinline__ unsigned xb_xcc_id() { return (unsigned)__builtin_amdgcn_s_getreg((3 << 11) | 20) & 0xFu; }
#define XB_SPIN(cond, bar) do { unsigned _sp = 0; while (cond) { __builtin_amdgcn_s_sleep(1); \
    if ((++_sp & 255u) == 0u) { if (xb_ld(&(bar)[XB_TMO])) break; if (_sp > XB_SPIN_CAP) { atomicAdd(&(bar)[XB_TMO], 1u); break; } } } } while (0)

struct XcdBarrier {
    unsigned* bar; unsigned x;
    volatile __attribute__((address_space(3))) unsigned* st;
};

__device__ __forceinline__ XcdBarrier xcd_barrier_post(unsigned* bar, volatile __attribute__((address_space(3))) unsigned* st) {
    XcdBarrier b; b.bar = bar; b.x = xb_xcc_id(); b.st = st;
    if (threadIdx.x == 0) (void)xb_add(&bar[XB_XCNT(b.x)], 1u);
    return b;
}
__device__ __forceinline__ void xcd_barrier_complete(unsigned* bar, unsigned x, unsigned& nloc, unsigned& nx) {
    const unsigned G = gridDim.x * gridDim.y * gridDim.z;
    unsigned sum, cnt, mine, sp = 0u;
    for (;;) {
        sum = 0u; cnt = 0u; mine = 0u;
#pragma unroll
        for (unsigned j = 0; j < 16; ++j) { const unsigned c = xb_ld(&bar[XB_XCNT(j)]); sum += c; cnt += (c > 0u) ? 1u : 0u; mine = (j == x) ? c : mine; }
        if (sum == G) break;
        __builtin_amdgcn_s_sleep(1);
        if ((++sp & 255u) == 0u) { if (xb_ld(&bar[XB_TMO])) break; if (sp > XB_SPIN_CAP) { atomicAdd(&bar[XB_TMO], 1u); break; } }
    }
    nloc = mine > 0u ? mine : 1u; nx = cnt > 0u ? cnt : 1u;
}

__device__ __forceinline__ void xcd_barrier(const XcdBarrier& b) {
    asm volatile("s_waitcnt vmcnt(0)" ::: "memory");
    __syncthreads();
    if (threadIdx.x == 0) {
        unsigned* bar = b.bar;
        __builtin_amdgcn_s_waitcnt(0);
        unsigned nloc = b.st[0], nx = b.st[1];
        if (nloc == 0u) { xcd_barrier_complete(bar, b.x, nloc, nx); b.st[0] = nloc; b.st[1] = nx; }
        const unsigned old = xb_add(&bar[XB_XSUB(b.x)], 1u);
        const unsigned gen = old / nloc;
        if (old + 1u == (gen + 1u) * nloc) {
            __builtin_amdgcn_fence(__ATOMIC_RELEASE, "agent");
            asm volatile("s_waitcnt vmcnt(0)" ::: "memory");
            const unsigned og = xb_add(&bar[XB_TOP], 1u);
            const unsigned tg = og / nx;
            if (og + 1u == (tg + 1u) * nx) xb_add(&bar[XB_TOPGEN], 1u);
            else XB_SPIN(xb_ld(&bar[XB_TOPGEN]) == tg, bar);
            __builtin_amdgcn_fence(__ATOMIC_ACQUIRE, "agent");
            xb_add(&bar[XB_XGEN(b.x)], 1u);
            asm volatile("s_waitcnt vmcnt(0)" ::: "memory");
        } else {
            XB_SPIN(xb_ld(&bar[XB_XGEN(b.x)]) == gen, bar);
            __builtin_amdgcn_fence(__ATOMIC_ACQUIRE, "agent");
            asm volatile("s_waitcnt vmcnt(0)" ::: "memory");
        }
    }
    __syncthreads();
}


#endif
#ifndef EXTRA_K
#define EXTRA_K 0
#endif
#ifndef P0X
#define P0X 31
#endif
#ifndef P2X
#define P2X 15
#endif
#ifndef DBG_COPY
#define DBG_COPY 0
#endif
#ifndef DBG_PHASE
#define DBG_PHASE 5
#endif
#ifndef DUP_NSA
#define DUP_NSA 1
#endif
#ifndef DUP_REC
#define DUP_REC 1
#endif
#ifndef DUP_P5
#define DUP_P5 1
#endif
#ifndef DUP_P2
#define DUP_P2 1
#endif
#ifndef DUP_P0
#define DUP_P0 1
#endif
#ifndef DUP_P1
#define DUP_P1 1
#endif
#ifndef DUP_NP
#define DUP_NP 1
#endif
#ifndef HOST_EMU
#define GRID_SYNC() do { if (ph == 1) cg::this_grid().sync(); else { XcdBarrier xb_; xb_.bar = (unsigned*)(lds_ptr_entry(22) + WS_BARRIER); xb_.x = xb_xcc_id(); \
    xb_.st = (volatile __attribute__((address_space(3))) unsigned*)(smem_raw + LDS_PTRS + 192); xcd_barrier(xb_); } } while (0)
#else
#define GRID_SYNC() grid_sync_impl()
#endif

#ifndef HOST_EMU
DEV unsigned char* lds_ptr_entry(int i) {
    int z; asm volatile("s_mov_b32 %0, 0" : "=s"(z)); i += z;
    const unsigned long long v = ((volatile LDSP unsigned long long*)((LDSP unsigned char*)smem_raw + LDS_PTRS))[i];
    const unsigned lo = __builtin_amdgcn_readfirstlane((unsigned)v), hi = __builtin_amdgcn_readfirstlane((unsigned)(v >> 32));
    return (unsigned char*)(__attribute__((address_space(1))) unsigned char*)(((unsigned long long)hi << 32) | lo);
}
#endif
DEV Ctx make_ctx(const Params& p, int wave0, bool dummy_out = false) {
#ifndef HOST_EMU
    Ctx c; c.out = p.out; c.ws = p.ws; c.tid = wave0 * 64 + fresh_lane();
#else
    Ctx c; c.out = p.out; c.ws = p.ws; c.tid = TID();
#endif
    c.bid = BID(); c.nblk = NBLK(); int z = 0;
#ifndef HOST_EMU
    asm volatile("" : "+v"(c.tid), "+s"(c.bid), "+s"(c.nblk));
    asm volatile("s_mov_b32 %0, 0" : "=s"(z));
    c.ws = lds_ptr_entry(22); c.out = (float*)lds_ptr_entry(23);
#endif
    if (dummy_out) c.out = (float*)(c.ws + WS_PROJ + (size_t)136 * 1024 * 1024);
    c.lds = SMEM_PTR() + z; c.lane = c.tid & 63; c.wave = c.tid >> 6;
#ifndef HOST_EMU
    c.wave = __builtin_amdgcn_readfirstlane(c.wave);
#endif
    return c;
}
#ifndef HOST_EMU
__global__ void __launch_bounds__(NTHR, 2) fwd_kernel(Params p)
#else
void fwd_kernel(Params p)
#endif
{
    {
        LDSP char* lds0 = SMEM_PTR();
        if (TID() == 0) {
#pragma unroll
            for (int i = 0; i < 22; ++i) ((LDSP unsigned long long*)(lds0 + LDS_PTRS))[i] = (unsigned long long)p.in[i];
            ((LDSP unsigned long long*)(lds0 + LDS_PTRS))[22] = (unsigned long long)p.ws; ((LDSP unsigned long long*)(lds0 + LDS_PTRS))[23] = (unsigned long long)p.out;
        }
        block_sync();
    }
#ifndef HOST_EMU
    const int wave0 = __builtin_amdgcn_readfirstlane((int)threadIdx.x >> 6);
#else
    const int wave0 = 0;
#endif
#ifndef HOST_EMU
    volatile __attribute__((address_space(3))) unsigned* xst = (volatile __attribute__((address_space(3))) unsigned*)(smem_raw + LDS_PTRS + 192);
    if (threadIdx.x == 0) { xst[0] = 0u; xst[1] = 0u; }
    __syncthreads();
    (void)xcd_barrier_post((unsigned*)(p.ws + WS_BARRIER), xst);
#endif
    int ph = 0;
#define PHASE_END() do { ++ph; if (DBG_COPY && ph == DBG_PHASE) { GRID_SYNC(); Ctx c = make_ctx(p, wave0); \
        const bf16_t* src = wsp<bf16_t>(c, DBG_COPY == 1 ? WS_OUTS : DBG_COPY == 2 ? WS_ST : DBG_COPY == 3 ? WS_PROJ : DBG_COPY == 4 ? WS_HALO : DBG_COPY >= 6 ? WS_OUTS + (size_t)(DBG_COPY - 6) * NT * MW * 2 : WS_KSW); const size_t nsrc = DBG_COPY >= 6 ? (size_t)NT * MW : DBG_COPY == 2 ? 3 * ST_ONE / 2 : DBG_COPY == 4 ? (size_t)BATCH * NC * 3 * 512 + (size_t)NT * NH * 2 * 2 + (size_t)BATCH * NH * NC * 64 * 2 : (size_t)NT * DM; \
        for (size_t i = (size_t)c.bid * NTHR + c.tid; i < (size_t)NT * DM; i += (size_t)c.nblk * NTHR) c.out[i] = i < nsrc ? bf2f(src[i]) : 0.f; return; } \
        if (ph >= p.phase_hi) return; GRID_SYNC(); if (extra && ph - ph_x0 >= EXTRA_K) return; } while (0)
    int ph_x0 = 0;
    for (int it = 0; it < DEPTH + (EXTRA_K > 0 ? 1 : 0); ++it) {
        const int l = it < DEPTH ? it : 0; const bool extra = it >= DEPTH; if (extra) ph_x0 = ph;
        for (int rep = 0; rep < DUP_P0; ++rep) { Ctx c = make_ctx(p, wave0); p0_prep(c, l, extra ? P0X : 31); }
        PHASE_END();
        for (int rep = 0; rep < DUP_P1; ++rep) {
            Ctx c = make_ctx(p, wave0);
            pg8::Gemm g{wsp<bf16_t>(c, WS_XB), wsp<bf16_t>(c, WS_WIN), NT, PROJ_N, DM}; pg8::StaticOrder S; S.init(NT, PROJ_N, c.nblk, c.bid);
            pg8::EpiScaleBf16<1, true> E{wsp<bf16_t>(c, WS_PROJ), PROJ_LD, wsp<float>(c, WS_RSS1), PROJ_LD, wsp<bf16_t>(c, WS_HALO)};
            pg8::gemm_phase<pg8::EpiScaleBf16<1, true>, pg8::StaticOrder, true, true>(GEMM_LDS, g, S, E, c.tid);
        }
        PHASE_END();
        const int p2m = extra ? P2X : 15;
        if (p2m & 1) for (int rep = 0; rep < DUP_P2; ++rep) { Ctx c = make_ctx(p, wave0); for (int u = c.bid; u < 3 * BATCH * NH * NC; u += c.nblk) recur_local_unit(c, l, u); }
        if (p2m & 2) for (int rep = 0; rep < DUP_NP; ++rep) { Ctx c = make_ctx(p, wave0); for (int u = c.bid; u < BATCH * 16; u += c.nblk) nsa_compress_unit(c, l, u); }
        if (p2m & 4) for (int rep = 0; rep < DUP_NP; ++rep) { Ctx c = make_ctx(p, wave0); for (int it = c.bid; it < NT / 32; it += c.nblk) nsa_kprep_item(c, l, it); }
        if (p2m & 8) for (int rep = 0; rep < DUP_NP; ++rep) { Ctx c = make_ctx(p, wave0); for (int it = c.bid; it < BATCH * 4 * NC; it += c.nblk) nsa_vprep_item(c, it); }
        PHASE_END();
        { Ctx c = make_ctx(p, wave0); recur_scan(c); }
        PHASE_END();
        for (int rep = 0; rep < DUP_NSA; ++rep) { Ctx c = make_ctx(p, wave0);
        for (int u = c.bid; u < BATCH * 2 * NSEL; u += c.nblk) {
            const int nbg = BATCH * 2, bg = u % nbg, qi = u / nbg; int qt = qi;
            if (NSEL == 64) { const int r = qi >> 4, ql = qi & 15; qt = (r == 0) ? 63 - ql : (r == 1) ? ql : (r == 2) ? 47 - ql : 16 + ql; }
            nsa_attn_unit(c, l, bg * NSEL + qt);
        } }
        for (int rep = 0; rep < DUP_REC; ++rep) { Ctx c = make_ctx(p, wave0); for (int u = c.bid * NWAVE + c.wave; u < 3 * BATCH * NH * NC; u += c.nblk * NWAVE) recur_out_wave(c, l, u); }
        PHASE_END();
        { Ctx c = make_ctx(p, wave0); peer_table_rows(c, l); }
        for (int rep = 0; rep < DUP_P5; ++rep) {
            { Ctx c = make_ctx(p, wave0); pg8::MixOrder<true> S{(NT / 256) * 4, c.nblk, c.bid, NT / 256};
              pg8::Gemm g{wsp<bf16_t>(c, WS_OUTS), wsp<bf16_t>(c, WS_WUP), 4 * NT, 4 * DM, MW};
              pg8::EpiU E{wsp<bf16_t>(c, WS_UALL)};
              pg8::gemm_phase<pg8::EpiU, pg8::MixOrder<true>, false, true>(GEMM_LDS, g, S, E, c.tid); }
            GRID_SYNC();
            { Ctx c = make_ctx(p, wave0); pg8::MixOrder<false> S{(NT / 256) * 4, c.nblk, c.bid, NT / 256};
              pg8::Gemm g{wsp<bf16_t>(c, WS_XB), wsp<bf16_t>(c, WS_WG), NT, 4 * DM, DM};
              pg8::EpiGate E{wsp<bf16_t>(c, WS_UALL), wsp<bf16_t>(c, WS_MERGED), wsp<float>(c, WS_RSS1), NT};
              pg8::gemm_phase<pg8::EpiGate, pg8::MixOrder<false>, false, true>(GEMM_LDS, g, S, E, c.tid); }
        }
        PHASE_END();
        {
            Ctx c = make_ctx(p, wave0, extra);
            pg8::Gemm g{wsp<bf16_t>(c, WS_MERGED), wsp<bf16_t>(c, WS_WOUT), NT, DM, DM}; pg8::StaticOrder S; S.init(NT, DM, c.nblk, c.bid);
            pg8::EpiOut E{wsp<bf16_t>(c, WS_XB), wsp<float>(c, WS_RSS2)};
            pg8::gemm_phase<pg8::EpiOut, pg8::StaticOrder, true, true>(GEMM_LDS, g, S, E, c.tid);
        }
        PHASE_END();
        {
            Ctx c = make_ctx(p, wave0);
            pg8::Gemm g{wsp<bf16_t>(c, WS_XB), wsp<bf16_t>(c, WS_WQ2), NT, PEER_N, DM}; pg8::StaticOrder S; S.init(NT, PEER_N, c.nblk, c.bid);
            pg8::EpiScaleBf16<16> E{wsp<bf16_t>(c, WS_SCORES), PEER_N, wsp<float>(c, WS_RSS2), PEER_N, nullptr};
            pg8::gemm_phase<pg8::EpiScaleBf16<16>, pg8::StaticOrder, true, true>(GEMM_LDS, g, S, E, c.tid);
        }
        PHASE_END();
        { Ctx c = make_ctx(p, wave0, extra); peer_init_tab(c); for (int t = c.bid * NWAVE + c.wave; t < NT; t += c.nblk * NWAVE) peer_token(c, l, t); }
        PHASE_END();
    }
}

#ifndef HOST_EMU
extern "C" void kernel_launch(void* const* d_in, const int* in_sizes, int n_in, void* d_out, int out_size, void* d_ws, size_t ws_size, hipStream_t stream) {
    static int grid = 0;
    if (grid == 0) {
        if (n_in != 22 || out_size != NT * DM || ws_size < WS_NEED) { fprintf(stderr, "kernel_launch: unexpected shapes (n_in %d out %d ws %zu need %zu)\n", n_in, out_size, ws_size, (size_t)WS_NEED); grid = -1; return; }
        int dev = 0, cus = 0, per_cu = 0;
        hipGetDevice(&dev); hipDeviceGetAttribute(&cus, hipDeviceAttributeMultiprocessorCount, dev);
        if (hipFuncSetAttribute((const void*)fwd_kernel, hipFuncAttributeMaxDynamicSharedMemorySize, LDS_BYTES) != hipSuccess) { fprintf(stderr, "kernel_launch: hipFuncSetAttribute failed\n"); grid = -1; return; }
        if (hipOccupancyMaxActiveBlocksPerMultiprocessor(&per_cu, (const void*)fwd_kernel, NTHR, LDS_BYTES) != hipSuccess || per_cu < 1) { fprintf(stderr, "kernel_launch: occupancy query failed (%d)\n", per_cu); (void)hipGetLastError(); per_cu = 1; }
        grid = cus;
        fprintf(stderr, "kernel_launch: grid %d (per_cu %d)\n", grid, per_cu);
    }
    if (grid < 0) return;
    if (hipMemsetAsync((char*)d_ws + WS_BARRIER, 0, 16384, stream) != hipSuccess) { fprintf(stderr, "kernel_launch: memset failed\n"); return; }
    Params p{};
    for (int i = 0; i < 22; ++i) p.in[i] = (const float*)d_in[i];
    p.out = (float*)d_out; p.ws = (unsigned char*)d_ws; p.phase_lo = 0; p.phase_hi = 1 << 20;
    void* args[] = {&p};
    hipError_t e = hipLaunchCooperativeKernel((const void*)fwd_kernel, dim3(grid), dim3(NTHR), args, LDS_BYTES, stream);
    if (e != hipSuccess) fprintf(stderr, "kernel_launch: cooperative launch failed: %s (grid %d)\n", hipGetErrorString(e), grid);
}
#endif
```

```cpp
#ifndef HOST_EMU
#include <hip/hip_runtime.h>
#include <hip/hip_cooperative_groups.h>
#include <cstdio>
#include <cstdint>
namespace cg = cooperative_groups;
#endif

#ifndef CFG_B
#define CFG_B 8
#endif
#ifndef CFG_S
#define CFG_S 4096
#endif

constexpr int BATCH = CFG_B, SEQ = CFG_S, DM = 1024, DEPTH = 2;
constexpr int NT = BATCH * SEQ;
constexpr int NH = 4, HD = 64, MW = 256, CH = 64, NC = SEQ / CH;
constexpr int N_IN_ORIG = 4116, PROJ_N = 4352, PROJ_LD = 4128;
constexpr int NCMP = (SEQ - 32) / 16 + 1;
constexpr int NCMP_PAD = SEQ / 16;
constexpr int NSEL = SEQ / 64;
constexpr int PEER_N = 2048;
constexpr float NORM_EPS = 1e-6f;
constexpr int NTHR = 512, NWAVE = 8;
constexpr int C_HQ = 0, C_HF = 256, C_HI = 512, C_HG = 768;
constexpr int C_MQ = 1024, C_MK = 1280, C_MV = 1536, C_MO = 1792;
constexpr int C_NQ = 2048, C_NKC = 2304, C_NVC = 2432, C_NKS = 2560, C_NVS = 2688, C_NKW = 2816, C_NVW = 2944;
constexpr int C_RQ = 3072, C_RK = 3328, C_RV = 3584, C_RG = 3840;
constexpr int C_MI = 4096, C_MF = 4100, C_NG = 4104;

typedef unsigned short bf16_t;
#ifndef HOST_EMU
typedef short bf16x8 __attribute__((ext_vector_type(8)));
typedef float f32x4 __attribute__((ext_vector_type(4)));
#endif
typedef unsigned u32x4 __attribute__((ext_vector_type(4)));
typedef unsigned u32x2 __attribute__((ext_vector_type(2)));
typedef float f32x2 __attribute__((ext_vector_type(2)));

constexpr size_t al256(size_t x) { return (x + 255) & ~(size_t)255; }
constexpr size_t WS_WIN = 0;
constexpr size_t WS_WG = WS_WIN + al256((size_t)PROJ_N * DM * 2);
constexpr size_t WS_WUP = WS_WG + al256((size_t)4 * DM * DM * 2);
constexpr size_t WS_WOUT = WS_WUP + al256((size_t)4 * DM * MW * 2);
constexpr size_t WS_WQ2 = WS_WOUT + al256((size_t)DM * DM * 2);
constexpr size_t WS_WCT = WS_WQ2 + al256((size_t)PEER_N * DM * 2);
constexpr size_t WS_CBIAS = WS_WCT + al256((size_t)2 * 64 * 2048 * 2);
constexpr size_t WS_CBPART = WS_CBIAS + 1024;
constexpr size_t WS_ROPE = WS_CBPART + 32768;
constexpr size_t WS_RSS1 = WS_ROPE + al256((size_t)SEQ * 64 * 4);
constexpr size_t WS_RSS2 = WS_RSS1 + al256((size_t)NT * 4);
constexpr size_t WS_XB = WS_RSS2 + al256((size_t)NT * 16 * 4);
constexpr size_t WS_OUTS = WS_XB + al256((size_t)NT * DM * 2);
constexpr size_t WS_ST = WS_OUTS + al256((size_t)NT * DM * 2);
constexpr size_t ST_ONE = (size_t)BATCH * NH * NC * 4096 * 2;
constexpr size_t WS_GDEC = WS_ST + al256(3 * ST_ONE);
constexpr size_t WS_MNL = WS_GDEC + al256((size_t)BATCH * NH * NC * 64 * 4);
constexpr size_t WS_MSC = WS_MNL + al256((size_t)BATCH * NH * NC * 64 * 4);
constexpr size_t WS_KCMP = WS_MSC + al256((size_t)BATCH * NH * NC * 4 * 4);
constexpr size_t WS_VCMPT = WS_KCMP + al256((size_t)BATCH * 2 * NCMP_PAD * 64 * 2);
constexpr size_t WS_KSW = WS_VCMPT + al256((size_t)BATCH * 2 * NCMP_PAD * 64 * 2);
constexpr size_t WS_HALO = WS_KSW + al256((size_t)NT * 256 * 2);
constexpr size_t WS_MTS = WS_HALO + al256((size_t)BATCH * NC * 3 * 512 * 2);
constexpr size_t WS_G31 = WS_MTS + al256((size_t)NT * NH * 2 * 4);
constexpr size_t WS_PROJ = WS_G31 + al256((size_t)BATCH * NH * NC * 64 * 4);
constexpr size_t PROJ_BYTES = al256((size_t)NT * PROJ_LD * 2);
constexpr size_t WS_BARRIER = WS_PROJ + PROJ_BYTES;
constexpr size_t WS_END = WS_BARRIER + 16384;
constexpr size_t WS_UALL = WS_PROJ;
constexpr size_t WS_MERGED = WS_OUTS;
constexpr size_t WS_SCORES = WS_PROJ;
constexpr bool TABLES_IN_ST = 3 * ST_ONE >= (size_t)2 * 16384 * DM;
constexpr size_t WS_PU = TABLES_IN_ST ? WS_ST : WS_END;
constexpr size_t WS_PV = WS_PU + al256((size_t)16384 * DM);
static_assert((size_t)4 * NT * DM * 2 <= PROJ_BYTES, "U fits the proj region");
static_assert(WS_END <= (size_t)536870912, "workspace budget");
constexpr size_t WS_NEED = TABLES_IN_ST ? WS_END : WS_PV + (size_t)16384 * DM;

constexpr int LDS_BYTES = 147456;

struct Params {
    const float* in[22];
    float* out;
    unsigned char* ws;
    int phase_lo, phase_hi;
};

#ifndef HOST_EMU
#define DEV __device__ __forceinline__
#define TID() ((int)threadIdx.x)
#define BID() ((int)blockIdx.x)
#define NBLK() ((int)gridDim.x)
extern __shared__ __attribute__((aligned(16))) unsigned char smem_raw[];
#define LDSP __attribute__((address_space(3)))
#define SMEM_PTR() ((LDSP char*)smem_raw)
DEV void block_sync() { __syncthreads(); }
DEV int fresh_lane() { int lane; asm volatile("v_mbcnt_lo_u32_b32 %0, -1, 0\n\tv_mbcnt_hi_u32_b32 %0, -1, %0" : "=v"(lane)); return lane; }
template <int M> DEV int xori(int v) {
    if constexpr (M < 32) return __builtin_amdgcn_ds_swizzle(v, (M << 10) | 0x1f);
    else return __builtin_amdgcn_ds_bpermute((fresh_lane() ^ M) << 2, v);
}
template <int M> DEV float xorf(float v) { return __builtin_bit_cast(float, xori<M>(__builtin_bit_cast(int, v))); }
DEV int shfl_i(int v, int src) { return __builtin_amdgcn_ds_bpermute(src << 2, v); }
DEV float shfl_f(float v, int src) { return __builtin_bit_cast(float, __builtin_amdgcn_ds_bpermute(src << 2, __builtin_bit_cast(int, v))); }
DEV unsigned long long ballot64(bool p) { return __builtin_amdgcn_ballot_w64(p); }
DEV int mbcnt64(unsigned long long m) { return (int)__builtin_amdgcn_mbcnt_hi((unsigned)(m >> 32), __builtin_amdgcn_mbcnt_lo((unsigned)m, 0u)); }
DEV float bcast_f(float v, int j) { return __builtin_bit_cast(float, __builtin_amdgcn_readlane(__builtin_bit_cast(int, v), j)); }
DEV int bcast_i(int v, int j) { return __builtin_amdgcn_readlane(v, j); }
DEV f32x2 cvt_pk_f32_fp8(unsigned p, bool hi) { return hi ? __builtin_amdgcn_cvt_pk_f32_fp8((int)p, true) : __builtin_amdgcn_cvt_pk_f32_fp8((int)p, false); }
template <int SEL> DEV f32x2 cvt_pk_f32_fp4_(unsigned p) { return __builtin_amdgcn_cvt_scalef32_pk_f32_fp4(p, 1.0f, SEL); }
DEV f32x2 cvt_pk_f32_fp4(unsigned p, int bytesel) { return bytesel == 0 ? cvt_pk_f32_fp4_<0>(p) : bytesel == 1 ? cvt_pk_f32_fp4_<1>(p) : bytesel == 2 ? cvt_pk_f32_fp4_<2>(p) : cvt_pk_f32_fp4_<3>(p); }
DEV unsigned cvt_pk_fp8_f32(float a, float b, unsigned old, bool hi) { return hi ? (unsigned)__builtin_amdgcn_cvt_pk_fp8_f32(a, b, (int)old, true) : (unsigned)__builtin_amdgcn_cvt_pk_fp8_f32(a, b, (int)old, false); }
DEV f32x4 mfma16(bf16x8 a, bf16x8 b, f32x4 c) { return __builtin_amdgcn_mfma_f32_16x16x32_bf16(a, b, c, 0, 0, 0); }
typedef int i32x8 __attribute__((ext_vector_type(8)));
DEV f32x4 mfma_fp4_fp8(u32x4 a, u32x4 b0, u32x4 b1, f32x4 c) {
    const i32x8 av = {(int)a.x, (int)a.y, (int)a.z, (int)a.w, 0, 0, 0, 0}, bv = {(int)b0.x, (int)b0.y, (int)b0.z, (int)b0.w, (int)b1.x, (int)b1.y, (int)b1.z, (int)b1.w};
    return __builtin_amdgcn_mfma_scale_f32_16x16x128_f8f6f4(av, bv, c, 4, 0, 0, 127, 0, 127);
}
DEV void atomic_add_f32(float* p, float v) { atomicAdd(p, v); }
DEV float fast_exp(float x) { return __expf(x); }
DEV float fast_exp2(float x) { return __builtin_amdgcn_exp2f(x); }
DEV float fast_log(float x) { return __logf(x); }
DEV float fast_rcp(float x) { return __builtin_amdgcn_rcpf(x); }
DEV float fast_rsqrt(float x) { return __builtin_amdgcn_rsqf(x); }
#else
#define DEV static inline
#define LDSP
#endif

#ifndef HOST_EMU
DEV void wave_sync() { __builtin_amdgcn_fence(__ATOMIC_ACQ_REL, "wavefront"); __builtin_amdgcn_wave_barrier(); }
#else
static inline void wave_sync() { emu_bar_wait(emu_wave().bar, 64); }
#endif
DEV float bf2f(bf16_t v) { unsigned u = ((unsigned)v) << 16; return __builtin_bit_cast(float, u); }
DEV bf16_t f2bf(float f) { unsigned u = __builtin_bit_cast(unsigned, f); return (bf16_t)((u + 0x7fffu + ((u >> 16) & 1u)) >> 16); }
#ifndef HOST_EMU
typedef __bf16 bf16x2_hw __attribute__((ext_vector_type(2)));
DEV unsigned pk2(float lo, float hi) { const f32x2 v = {lo, hi}; return __builtin_bit_cast(unsigned, __builtin_convertvector(v, bf16x2_hw)); }
#else
DEV unsigned pk2(float lo, float hi) { return (unsigned)f2bf(lo) | ((unsigned)f2bf(hi) << 16); }
#endif
DEV float bflo(unsigned u) { return __builtin_bit_cast(float, u << 16); }
DEV float bfhi(unsigned u) { return __builtin_bit_cast(float, u & 0xffff0000u); }
DEV float sigmoidf_(float x) { return fast_rcp(1.0f + fast_exp(-x)); }
DEV float siluf_(float x) { return x * sigmoidf_(x); }
DEV float log_sigmoidf_(float x) { return fminf(x, 0.f) - log1pf(fast_exp(-fabsf(x))); }
DEV unsigned sortkey32(float f) { const unsigned u = __builtin_bit_cast(unsigned, f); return (u & 0x80000000u) ? ~u : (u | 0x80000000u); }
DEV unsigned fp4_code(float x) {
    const float a = fabsf(x); unsigned c = (a > 0.25f) + (a > 0.75f) + (a > 1.25f) + (a > 1.75f) + (a > 2.5f) + (a > 3.5f) + (a > 5.0f); return c | (x < 0.f ? 8u : 0u);
}
DEV float wave_sum(float v) { v += xorf<1>(v); v += xorf<2>(v); v += xorf<4>(v); v += xorf<8>(v); v += xorf<16>(v); v += xorf<32>(v); return v; }
DEV float wave_max(float v) { v = fmaxf(v, xorf<1>(v)); v = fmaxf(v, xorf<2>(v)); v = fmaxf(v, xorf<4>(v)); v = fmaxf(v, xorf<8>(v)); v = fmaxf(v, xorf<16>(v)); v = fmaxf(v, xorf<32>(v)); return v; }
DEV float gelu_erf(float v) {
    const float av = fabsf(v), t = fast_rcp(1.0f + 0.2316418882f * av);
    float q = t * 0.5307027145f + (-0.7265760135f); q = q * t + 0.7107068705f; q = q * t + (-0.142248368f); q = q * t + 0.127414796f; q = q * t;
    const float e = fast_exp2(v * v * (-0.72134752044f));
    const float m = v * (q * e);
    return v < 0.f ? m : v - m;
}
#ifndef HOST_EMU
#define DEV_M __device__ __forceinline__
#else
#define DEV_M inline
#endif
namespace pg8 {
#define PG8_LAS __attribute__((address_space(3)))
constexpr int BM = 256, BK = 64, HALF = 128, HTB = HALF * BK * 2  , STAGE_BYTES = 8 * HTB, NXCD = 8, WGM = 8;

__host__ __device__ __forceinline__ int lds_byte(int r, int c) { const int st = (r >> 4) * 2 + (c >> 5), rr = r & 15, cc = c & 31, ob = rr * 64 + cc * 2; return st * 1024 + (ob ^ (((ob >> 9) & 1) << 5)); }
__host__ __device__ __forceinline__ void stage_rc(int b, int& R, int& C) { const int st = b / 1024, sb = b % 1024, swz = sb ^ (((sb >> 9) & 1) << 5); R = (st >> 1) * 16 + swz / 64; C = (st & 1) * 32 + (swz % 64) / 2; }
__host__ __device__ __forceinline__ int perm32(int rho) { const int n = rho >> 4, i = rho & 15; return 8 * (i >> 2) + 4 * n + (i & 3); }

struct Unit { int pm, pn; };
struct Gemm { const bf16_t* A; const bf16_t* Bt; int M, N, K; };

struct StaticOrder {
    int nM, nN, nwg, G, c;
    __host__ __device__ void init(int M, int N, int G_, int c_) { nM = M / BM; nN = N / BM; nwg = nM * nN; G = G_; c = c_; }
    __host__ __device__ bool next(int i, Unit& u) const {
        const long L = (long)i * G + c; if (L >= nwg) return false;
        int wgid = (int)L; { const int q = nwg / NXCD, r = nwg % NXCD, xcd = wgid % NXCD, off = wgid / NXCD; wgid = (xcd < r ? xcd * (q + 1) : r * (q + 1) + (xcd - r) * q) + off; }
        const int nig = WGM * nN, gid = wgid / nig, fm = gid * WGM, gsz = (nM - fm) < WGM ? (nM - fm) : WGM;
        u.pm = fm + ((wgid % nig) % gsz); u.pn = (wgid % nig) / gsz; return true;
    }
    DEV_M void a_ready(const Unit&) const {}
    DEV_M void done(const Unit&) const {}
};


#ifndef HOST_EMU
template <class Epi, class Sched, bool ALIGN_EPI = false, bool SP2 = false>
__device__ __forceinline__ void gemm_phase(PG8_LAS unsigned char* lds, const Gemm g, const Sched& S, const Epi& E, const int tid_in) {
    const int tid = tid_in, wid = __builtin_amdgcn_readfirstlane(tid >> 6), lane = tid & 63, wr = wid >> 2, wc = wid & 3, fr = lane & 15, fq = lane >> 4;
    const int K = g.K, nt = K / BK;
    unsigned voffA[2], voffB[2];
#pragma unroll
    for (int i = 0; i < 2; ++i) { int R, C; stage_rc(tid * 16 + i * 8192, R, C); const int Rb = Epi::PERM ? ((R & ~31) + perm32(R & 31)) : R;
        voffA[i] = (unsigned)(R * K + C) * 2u; voffB[i] = (unsigned)(Rb * K + C) * 2u; }
    const size_t kstep = (size_t)(BK * 2);
    const size_t hstep = (size_t)HALF * K * 2;
    const size_t tstep = 2 * hstep;
    const unsigned ldsw = (unsigned)wid * 1024u;
    const int aoff = lds_byte(wr * 64 + fr, fq * 8), boff = lds_byte(wc * 32 + fr, fq * 8);
#define PG8_SA(b, h) (((b) * 2 + (h)) * HTB)
#define PG8_SB(b, h) ((4 + (b) * 2 + (h)) * HTB)
#define PG8_STAGE(bufoff, gbase, voff) do { _Pragma("unroll") for (int _i = 0; _i < 2; ++_i) \
        __builtin_amdgcn_global_load_lds((const unsigned*)((const char*)(gbase) + (voff)[_i]), (PG8_LAS unsigned*)(lds + (bufoff) + ldsw + _i * 8192), 16, 0, 0); } while (0)
#define PG8_LDA(dst, b, h) do { _Pragma("unroll") for (int m = 0; m < 4; ++m) _Pragma("unroll") for (int k = 0; k < 2; ++k) dst[m][k] = *(const PG8_LAS bf16x8*)(lds + PG8_SA(b, h) + aoff + m * 2048 + k * 1024); } while (0)
#define PG8_LDB(dst, b, h) do { _Pragma("unroll") for (int n = 0; n < 2; ++n) _Pragma("unroll") for (int k = 0; k < 2; ++k) dst[n][k] = *(const PG8_LAS bf16x8*)(lds + PG8_SB(b, h) + boff + n * 2048 + k * 1024); } while (0)
#define PG8_MMA(ai, bj, At, Bt) do { __builtin_amdgcn_s_setprio(1); _Pragma("unroll") for (int m = 0; m < 4; ++m) _Pragma("unroll") for (int n = 0; n < 2; ++n) _Pragma("unroll") for (int k = 0; k < 2; ++k) \
        acc[ai][bj][m][n] = __builtin_amdgcn_mfma_f32_16x16x32_bf16(Bt[n][k], At[m][k], acc[ai][bj][m][n], 0, 0, 0); __builtin_amdgcn_s_setprio(0); } while (0)
#define PG8_WAIT_V(n) asm volatile("s_waitcnt vmcnt(" #n ")" ::: "memory")
#define PG8_WAIT_L(n) asm volatile("s_waitcnt lgkmcnt(" #n ")" ::: "memory")
#define PG8_BAR __builtin_amdgcn_s_barrier()
#define PG8_SCHED __builtin_amdgcn_sched_barrier(0)
    Unit cur, nxt; int ui = 0;
    if (!S.next(0, cur)) return;
    f32x4 acc[2][2][4][2];
#pragma unroll
    for (int a = 0; a < 2; ++a)
#pragma unroll
        for (int b = 0; b < 2; ++b)
#pragma unroll
            for (int m = 0; m < 4; ++m)
#pragma unroll
                for (int n = 0; n < 2; ++n) acc[a][b][m][n] = (f32x4){0.f, 0.f, 0.f, 0.f};
    bf16x8 At[4][2], B0[2][2], B1[2][2];
    const char* cA = (const char*)g.A + (size_t)cur.pm * tstep; const char* cB = (const char*)g.Bt + (size_t)cur.pn * tstep;
    S.a_ready(cur);
    if constexpr (SP2) {
        PG8_STAGE(PG8_SB(0, 0), cB, voffB); PG8_STAGE(PG8_SB(0, 1), cB + hstep, voffB); PG8_STAGE(PG8_SA(0, 0), cA, voffA); PG8_STAGE(PG8_SA(0, 1), cA + hstep, voffA);
        if (wr == 1) PG8_BAR;
        PG8_WAIT_V(2); PG8_BAR;
        PG8_STAGE(PG8_SB(1, 0), cB + kstep, voffB); PG8_STAGE(PG8_SA(1, 0), cA + kstep, voffA); PG8_STAGE(PG8_SB(1, 1), cB + hstep + kstep, voffB);
        PG8_WAIT_V(6); PG8_BAR;
    } else {
        PG8_STAGE(PG8_SB(0, 0), cB, voffB); PG8_STAGE(PG8_SA(0, 0), cA, voffA); PG8_STAGE(PG8_SB(0, 1), cB + hstep, voffB); PG8_STAGE(PG8_SA(0, 1), cA + hstep, voffA);
        if (wr == 1) PG8_BAR;
        PG8_WAIT_V(4); PG8_BAR;
        PG8_STAGE(PG8_SB(1, 0), cB + kstep, voffB); PG8_STAGE(PG8_SA(1, 0), cA + kstep, voffA); PG8_STAGE(PG8_SB(1, 1), cB + hstep + kstep, voffB);
        PG8_WAIT_V(6); PG8_BAR;
    }
    for (;;) {
        const bool has_next = S.next(ui + 1, nxt);
        const char* nA = has_next ? (const char*)g.A + (size_t)nxt.pm * tstep : cA; const char* nB = has_next ? (const char*)g.Bt + (size_t)nxt.pn * tstep : cB;
        for (int t = 0; t < nt; t += 2) {
            const bool last = (t == nt - 2);
            const char* a1 = cA + (size_t)(t + 1) * kstep;
            const char* a2 = last ? nA : cA + (size_t)(t + 2) * kstep; const char* b2 = last ? nB : cB + (size_t)(t + 2) * kstep;
            const char* a3 = a2 + kstep; const char* b3 = b2 + kstep;
            if (last && has_next) S.a_ready(nxt);
            if constexpr (SP2) {
            PG8_LDB(B0, 0, 0); PG8_LDB(B1, 0, 1); PG8_SCHED; PG8_LDA(At, 0, 0); PG8_STAGE(PG8_SA(1, 1), a1 + hstep, voffA);
            PG8_WAIT_V(8); PG8_WAIT_L(0); PG8_BAR; PG8_MMA(0, 0, At, B0); PG8_MMA(0, 1, At, B1); PG8_BAR; PG8_SCHED;
            PG8_LDA(At, 0, 1); PG8_STAGE(PG8_SB(0, 0), b2, voffB); PG8_STAGE(PG8_SB(0, 1), b2 + hstep, voffB); PG8_STAGE(PG8_SA(0, 0), a2, voffA);
            PG8_WAIT_V(8); PG8_WAIT_L(0); PG8_BAR; PG8_MMA(1, 0, At, B0); PG8_MMA(1, 1, At, B1); PG8_BAR; PG8_SCHED;
            PG8_LDB(B0, 1, 0); PG8_LDB(B1, 1, 1); PG8_SCHED; PG8_LDA(At, 1, 0); PG8_STAGE(PG8_SA(0, 1), a2 + hstep, voffA);
            PG8_WAIT_V(8); PG8_WAIT_L(0); PG8_BAR; PG8_MMA(0, 0, At, B0); PG8_MMA(0, 1, At, B1); PG8_BAR; PG8_SCHED;
            PG8_LDA(At, 1, 1); PG8_STAGE(PG8_SB(1, 0), b3, voffB); PG8_STAGE(PG8_SB(1, 1), b3 + hstep, voffB); PG8_STAGE(PG8_SA(1, 0), a3, voffA);
            PG8_WAIT_V(8); PG8_WAIT_L(0); PG8_BAR; PG8_MMA(1, 0, At, B0); PG8_MMA(1, 1, At, B1); PG8_BAR; PG8_SCHED;
            } else {
            PG8_LDB(B0, 0, 0); PG8_SCHED; PG8_LDA(At, 0, 0); PG8_STAGE(PG8_SA(1, 1), a1 + hstep, voffA);
            PG8_WAIT_L(8); PG8_BAR; PG8_WAIT_L(0); PG8_MMA(0, 0, At, B0); PG8_BAR; PG8_SCHED;
            PG8_LDB(B1, 0, 1); PG8_STAGE(PG8_SB(0, 0), b2, voffB);
            PG8_BAR; PG8_WAIT_L(0); PG8_MMA(0, 1, At, B1); PG8_BAR;
            PG8_LDA(At, 0, 1); PG8_STAGE(PG8_SA(0, 0), a2, voffA);
            PG8_BAR; PG8_WAIT_L(0); PG8_MMA(1, 0, At, B0); PG8_BAR; PG8_SCHED;
            PG8_STAGE(PG8_SB(0, 1), b2 + hstep, voffB);
            PG8_WAIT_V(6); PG8_BAR; PG8_MMA(1, 1, At, B1); PG8_BAR;
            PG8_LDB(B0, 1, 0); PG8_SCHED; PG8_LDA(At, 1, 0); PG8_STAGE(PG8_SA(0, 1), a2 + hstep, voffA);
            PG8_WAIT_L(8); PG8_BAR; PG8_WAIT_L(0); PG8_MMA(0, 0, At, B0); PG8_BAR; PG8_SCHED;
            PG8_LDB(B1, 1, 1); PG8_STAGE(PG8_SB(1, 0), b3, voffB);
            PG8_BAR; PG8_WAIT_L(0); PG8_MMA(0, 1, At, B1); PG8_BAR;
            PG8_LDA(At, 1, 1); PG8_STAGE(PG8_SA(1, 0), a3, voffA);
            PG8_BAR; PG8_WAIT_L(0); PG8_MMA(1, 0, At, B0); PG8_BAR; PG8_SCHED;
            PG8_STAGE(PG8_SB(1, 1), b3 + hstep, voffB);
            PG8_WAIT_V(6); PG8_BAR; PG8_MMA(1, 1, At, B1); PG8_BAR;
            }
        }
        if constexpr (ALIGN_EPI) { if (wr == 0) PG8_BAR; }
        if constexpr (!Epi::AFTER_DRAIN) { E(acc, cur, wr, wc, fr, fq); S.done(cur); }
        if (!has_next) break;
#pragma unroll
        for (int a = 0; a < 2; ++a)
#pragma unroll
            for (int b = 0; b < 2; ++b)
#pragma unroll
                for (int m = 0; m < 4; ++m)
#pragma unroll
                    for (int n = 0; n < 2; ++n) acc[a][b][m][n] = (f32x4){0.f, 0.f, 0.f, 0.f};
        cur = nxt; cA = nA; cB = nB; ++ui;
        if constexpr (ALIGN_EPI) { if (wr == 1) PG8_BAR; }
    }
    PG8_WAIT_V(0);
    if constexpr (!ALIGN_EPI) { if (wr == 0) PG8_BAR; }
    PG8_BAR;
    if constexpr (Epi::AFTER_DRAIN) { E.fused(acc, cur, wr, wc, fr, fq, lds, wid, lane); S.done(cur); }
#undef PG8_SA
#undef PG8_SB
#undef PG8_STAGE
#undef PG8_LDA
#undef PG8_LDB
#undef PG8_MMA
#undef PG8_WAIT_V
#undef PG8_WAIT_L
#undef PG8_BAR
#undef PG8_SCHED
}
#else
template <class Epi, class Sched, bool ALIGN_EPI = false, bool SP2 = false>
inline void gemm_phase(void* lds, const Gemm g, const Sched& S, const Epi& E, const int tid_in) {
    const int tid = TID(), wid = tid >> 6, lane = tid & 63, wr = wid >> 2, wc = wid & 3, fr = lane & 15, fq = lane >> 4;
    Unit u;
    for (int ui = 0; S.next(ui, u); ++ui) {
        f32x4 acc[2][2][4][2];
        for (int ai = 0; ai < 2; ++ai) for (int bj = 0; bj < 2; ++bj) for (int m = 0; m < 4; ++m) for (int n = 0; n < 2; ++n) for (int j = 0; j < 4; ++j) {
            const int r = 256 * u.pm + 128 * ai + 64 * wr + 16 * m + fr;
            const int c = 256 * u.pn + 128 * bj + 32 * wc + (Epi::PERM ? (8 * fq + 4 * n + j) : (16 * n + 4 * fq + j));
            const bf16_t* a = g.A + (size_t)r * g.K; const bf16_t* b = g.Bt + (size_t)c * g.K;
            float s = 0.f; for (int k = 0; k < g.K; ++k) s += bf2f(a[k]) * bf2f(b[k]);
            acc[ai][bj][m][n][j] = s;
        }
        E(acc, u, wr, wc, fr, fq);
    }
    block_sync();
}
#endif
#ifndef HOST_EMU
#define EPI_LAUNDER(wr, wc, fr, fq) asm volatile("" : "+s"(wr), "+s"(wc), "+v"(fr), "+v"(fq))
#else
#define EPI_LAUNDER(wr, wc, fr, fq) do {} while (0)
#endif
DEV_M float rstd_of(float ss) { return fast_rsqrt(ss * (1.0f / 1024.0f) + NORM_EPS); }

DEV_M float rss_slots16(const float* p) {
    const f32x4 a = *(const f32x4*)p, b = *(const f32x4*)(p + 4), c = *(const f32x4*)(p + 8), d = *(const f32x4*)(p + 12);
    return (((a[0] + a[1]) + (a[2] + a[3])) + ((b[0] + b[1]) + (b[2] + b[3]))) + (((c[0] + c[1]) + (c[2] + c[3])) + ((d[0] + d[1]) + (d[2] + d[3])));
}
template <int SLOTS, bool HALO = false> struct EpiScaleBf16 {
    static constexpr bool PERM = true, AFTER_DRAIN = false;
    bf16_t* O; int ldc; const float* rss; int ncols; bf16_t* halo;
    DEV_M void operator()(const f32x4 (&acc)[2][2][4][2], const Unit& u, int wr, int wc, int fr, int fq) const {
        EPI_LAUNDER(wr, wc, fr, fq);
        const int row0 = u.pm * BM + wr * 64 + fr, col0 = u.pn * BM + wc * 32 + 8 * fq;
        float scv[2][4];
#pragma unroll
        for (int ai = 0; ai < 2; ++ai)
#pragma unroll
            for (int m = 0; m < 4; ++m) { const int row = row0 + ai * HALF + m * 16; scv[ai][m] = SLOTS == 1 ? rss[row] : 0.f; }
#pragma unroll
        for (int ai = 0; ai < 2; ++ai)
#pragma unroll
            for (int m = 0; m < 4; ++m) {
                const int row = row0 + ai * HALF + m * 16; const float sc = rstd_of(SLOTS == 1 ? scv[ai][m] : rss_slots16(rss + (size_t)row * 16));
                bf16_t* rowp = O + (size_t)row * ldc + col0;
#pragma unroll
                for (int bj = 0; bj < 2; ++bj) {
                    if (col0 + bj * HALF < ncols) {
                        const f32x4 v0 = acc[ai][bj][m][0] * sc, v1 = acc[ai][bj][m][1] * sc;
                        u32x4 w; w.x = pk2(v0[0], v0[1]); w.y = pk2(v0[2], v0[3]); w.z = pk2(v1[0], v1[1]); w.w = pk2(v1[2], v1[3]);
                        *(u32x4*)(rowp + bj * HALF) = w;
                        if (HALO) { const int cc = col0 + bj * HALF - C_MQ; if ((row & 63) >= 61 && cc >= 0 && cc < 512) *(u32x4*)(halo + ((size_t)(row >> 6) * 3 + ((row & 63) - 61)) * 512 + cc) = w; }
                    }
                }
            }
    }
};
struct EpiU {
    static constexpr bool PERM = true, AFTER_DRAIN = false;
    bf16_t* uall;
    DEV_M void operator()(const f32x4 (&acc)[2][2][4][2], const Unit& u, int wr, int wc, int fr, int fq) const {
        EPI_LAUNDER(wr, wc, fr, fq);
        bf16_t* base = uall + (size_t)(u.pm * BM + wr * 64 + fr) * DM + (u.pn & 3) * BM + wc * 32 + 8 * fq;
#pragma unroll
        for (int ai = 0; ai < 2; ++ai)
#pragma unroll
            for (int m = 0; m < 4; ++m)
#pragma unroll
                for (int bj = 0; bj < 2; ++bj) {
                    const f32x4 v0 = acc[ai][bj][m][0], v1 = acc[ai][bj][m][1];
                    u32x4 w; w.x = pk2(v0[0], v0[1]); w.y = pk2(v0[2], v0[3]); w.z = pk2(v1[0], v1[1]); w.w = pk2(v1[2], v1[3]);
                    *(u32x4*)(base + (size_t)(ai * HALF + m * 16) * DM + bj * HALF) = w;
                }
    }
};
struct EpiGate {
    static constexpr bool PERM = true, AFTER_DRAIN = false;
    const bf16_t* uall; bf16_t* merged; const float* rss; int nrows;
    DEV_M void operator()(const f32x4 (&acc)[2][2][4][2], const Unit& u, int wr, int wc, int fr, int fq) const {
        EPI_LAUNDER(wr, wc, fr, fq);
        const int mi = u.pn >> 2, pn = u.pn & 3, row0 = u.pm * BM + wr * 64 + fr, col0 = pn * BM + wc * 32 + 8 * fq;
        const bf16_t* ub = uall + ((size_t)mi * nrows + row0) * DM + col0;
#pragma unroll
        for (int ai = 0; ai < 2; ++ai) {
            u32x4 uv[4][2], pv[4][2]; float sc[4];
#pragma unroll
            for (int m = 0; m < 4; ++m) { const int row = row0 + ai * HALF + m * 16; sc[m] = rss[row];
#pragma unroll
                for (int bj = 0; bj < 2; ++bj) { uv[m][bj] = *(const u32x4*)(ub + (size_t)(ai * HALF + m * 16) * DM + bj * HALF);
                    pv[m][bj] = (u32x4){0u, 0u, 0u, 0u}; if (mi != 0) pv[m][bj] = *(const u32x4*)(merged + (size_t)row * DM + col0 + bj * HALF); } }
#pragma unroll
            for (int m = 0; m < 4; ++m) { const int row = row0 + ai * HALF + m * 16; const float s = rstd_of(sc[m]);
#pragma unroll
                for (int bj = 0; bj < 2; ++bj) {
                    const u32x4 u4 = uv[m][bj], p4 = pv[m][bj];
                    const f32x4 a0 = acc[ai][bj][m][0] * s, a1 = acc[ai][bj][m][1] * s;
                    float r[8];
                    r[0] = sigmoidf_(a0[0]) * bflo(u4.x) + bflo(p4.x); r[1] = sigmoidf_(a0[1]) * bfhi(u4.x) + bfhi(p4.x);
                    r[2] = sigmoidf_(a0[2]) * bflo(u4.y) + bflo(p4.y); r[3] = sigmoidf_(a0[3]) * bfhi(u4.y) + bfhi(p4.y);
                    r[4] = sigmoidf_(a1[0]) * bflo(u4.z) + bflo(p4.z); r[5] = sigmoidf_(a1[1]) * bfhi(u4.z) + bfhi(p4.z);
                    r[6] = sigmoidf_(a1[2]) * bflo(u4.w) + bflo(p4.w); r[7] = sigmoidf_(a1[3]) * bfhi(u4.w) + bfhi(p4.w);
                    u32x4 w; w.x = pk2(r[0], r[1]); w.y = pk2(r[2], r[3]); w.z = pk2(r[4], r[5]); w.w = pk2(r[6], r[7]);
                    *(u32x4*)(merged + (size_t)row * DM + col0 + bj * HALF) = w;
                } }
        }
    }
};
struct EpiOut {
    static constexpr bool PERM = true, AFTER_DRAIN = false;
    bf16_t* xb; float* rss;
    DEV_M void operator()(const f32x4 (&acc)[2][2][4][2], const Unit& u, int wr, int wc, int fr, int fq) const {
        EPI_LAUNDER(wr, wc, fr, fq);
        const int row0 = u.pm * BM + wr * 64 + fr, col0 = u.pn * BM + wc * 32 + 8 * fq;
#pragma unroll
        for (int ai = 0; ai < 2; ++ai) {
            u32x4 xr[4][2];
#pragma unroll
            for (int m = 0; m < 4; ++m)
#pragma unroll
                for (int bj = 0; bj < 2; ++bj) xr[m][bj] = *(const u32x4*)(xb + (size_t)(row0 + ai * HALF + m * 16) * DM + col0 + bj * HALF);
#pragma unroll
            for (int m = 0; m < 4; ++m) {
                const int row = row0 + ai * HALF + m * 16; float ss = 0.f;
#pragma unroll
                for (int bj = 0; bj < 2; ++bj) {
                    const u32x4 x4 = xr[m][bj];
                    const f32x4 v0 = acc[ai][bj][m][0] + (f32x4){bflo(x4.x), bfhi(x4.x), bflo(x4.y), bfhi(x4.y)}, v1 = acc[ai][bj][m][1] + (f32x4){bflo(x4.z), bfhi(x4.z), bflo(x4.w), bfhi(x4.w)};
                    u32x4 w; w.x = pk2(v0[0], v0[1]); w.y = pk2(v0[2], v0[3]); w.z = pk2(v1[0], v1[1]); w.w = pk2(v1[2], v1[3]);
                    *(u32x4*)(xb + (size_t)row * DM + col0 + bj * HALF) = w;
                    ss += ((v0[0] * v0[0] + v0[1] * v0[1]) + (v0[2] * v0[2] + v0[3] * v0[3])) + ((v1[0] * v1[0] + v1[1] * v1[1]) + (v1[2] * v1[2] + v1[3] * v1[3]));
                }
                ss += xorf<16>(ss); ss += xorf<32>(ss);
                if (fq == 0) rss[(size_t)row * 16 + u.pn * 4 + wc] = ss;
            }
        }
    }
};
template <bool STACK_A> struct MixOrder {
    int ntiles, G, c, nM;
    DEV_M bool next(int i, Unit& u) const { const long t = (long)(i >> 2) * G + c; if (t >= ntiles) return false; const int m = i & 3;
        u.pm = (int)(t >> 2) + (STACK_A ? m * nM : 0); u.pn = m * 4 + (int)(t & 3); return true; }
    DEV_M void a_ready(const Unit&) const {}
    DEV_M void done(const Unit&) const {}
};
}
#ifndef HOST_EMU
#define GEMM_LDS ((PG8_LAS unsigned char*)smem_raw)
#else
#define GEMM_LDS ((void*)nullptr)
#endif
struct Ctx {
    float* out; unsigned char* ws; LDSP char* lds; int tid, lane, wave, bid, nblk;
};
constexpr int LDS_PTRS = LDS_BYTES - 256;
#ifndef HOST_EMU
DEV const float* inptr(const Ctx& c, int i) { const unsigned long long v = ((volatile LDSP unsigned long long*)(c.lds + LDS_PTRS))[i];
    const unsigned lo = __builtin_amdgcn_readfirstlane((unsigned)v), hi = __builtin_amdgcn_readfirstlane((unsigned)(v >> 32)); return (const float*)(const __attribute__((address_space(1))) float*)(((unsigned long long)hi << 32) | lo); }
#else
static inline const float* inptr(const Ctx& c, int i) { return ((const float* volatile*)(c.lds + LDS_PTRS))[i]; }
#endif
#define CIN(i) inptr(c, (i))
template <class T> DEV T* wsp(const Ctx& c, size_t off) { return (T*)(c.ws + off); }
DEV int orig_col(int n) {
    if (n < 1792) return n;
    if (n < 2048) return 1800 + (n - 1792);
    if (n < 3072) return 2056 + (n - 2048);
    if (n < 4096) return 3092 + (n - 3072);
    if (n < 4104) return 1792 + (n - 4096);
    if (n < 4116) return 3080 + (n - 4104);
    return -1;
}

template <class F> DEV void transpose_wave(const Ctx& c, F src, bf16_t* dst, int ldd, int k0, int n0) {
    LDSP float* tile = (LDSP float*)(c.lds + c.wave * 16640);
#pragma unroll
    for (int kb = 0; kb < 64; kb += 16) {
        float tv[16];
#pragma unroll
        for (int j = 0; j < 16; ++j) tv[j] = src(k0 + kb + j, n0 + c.lane);
#pragma unroll
        for (int j = 0; j < 16; ++j) tile[c.lane * 65 + kb + j] = tv[j];
    }
    wave_sync();
    const int k2 = (c.lane & 31) * 2, nh = c.lane >> 5;
#pragma unroll 8
    for (int j = 0; j < 32; ++j) { const int n = 2 * j + nh; *(unsigned*)(dst + (size_t)(n0 + n) * ldd + k0 + k2) = pk2(tile[n * 65 + k2], tile[n * 65 + k2 + 1]); }
    wave_sync();
}
DEV bf16x8 cvt8(const f32x4 a, const f32x4 b, float s) { const u32x4 w = {pk2(a[0] * s, a[1] * s), pk2(a[2] * s, a[3] * s), pk2(b[0] * s, b[1] * s), pk2(b[2] * s, b[3] * s)}; return __builtin_bit_cast(bf16x8, w); }

DEV void cbias_reduce(const Ctx& c) {
    const float* part = wsp<float>(c, WS_CBPART);
    for (int kv = 0; kv < 2; ++kv) { float s = 0.f;
#pragma unroll 16
        for (int j = 0; j < 64; ++j) s += part[(size_t)(kv * 64 + j) * 64 + c.lane];
        wsp<float>(c, WS_CBIAS)[kv * 64 + c.lane] = s; }
}
DEV void p0_prep(const Ctx& c, int l, int mask = 31) {
    const float* g1 = CIN(1) + (size_t)l * DM;
    const float* g2 = CIN(17) + (size_t)l * DM;
    constexpr int I_IN = (PROJ_N / 64) * 16, I_G = 4 * 16 * 16, I_UP = 4 * 16 * 4, I_OUT = 16 * 16, I_WC = 2 * 32, I_TR = I_IN + I_G + I_UP + I_OUT + I_WC;
    constexpr int I_WQ = 16 * 16 * 8;
    if (mask & 1)
    for (int it = c.bid * NWAVE + c.wave; it < I_TR; it += c.nblk * NWAVE) {
        int r = it;
        if (r < I_IN) {
            const float* w = CIN(2) + (size_t)l * DM * N_IN_ORIG; const int nt = r / 16, kt = r % 16;
            transpose_wave(c, [=](int k, int n) { const int oc = orig_col(n); return oc < 0 ? 0.f : w[(size_t)k * N_IN_ORIG + oc] * g1[k]; }, wsp<bf16_t>(c, WS_WIN), DM, kt * 64, nt * 64);
            continue;
        } r -= I_IN;
        if (r < I_G) {
            const int m = r / 256, nt = (r % 256) / 16, kt = r % 16; const float* w = CIN(15) + ((size_t)l * 4 + m) * DM * DM;
            transpose_wave(c, [=](int k, int n) { return w[(size_t)k * DM + n] * g1[k]; }, wsp<bf16_t>(c, WS_WG) + (size_t)m * DM * DM, DM, kt * 64, nt * 64);
            continue;
        } r -= I_G;
        if (r < I_UP) {
            const int m = r / 64, nt = (r % 64) / 4, kt = r % 4; const float* w = CIN(14) + ((size_t)l * 4 + m) * MW * DM;
            transpose_wave(c, [=](int k, int n) { return w[(size_t)k * DM + n]; }, wsp<bf16_t>(c, WS_WUP) + (size_t)m * DM * MW, MW, kt * 64, nt * 64);
            continue;
        } r -= I_UP;
        if (r < I_OUT) {
            const int nt = r / 16, kt = r % 16; const float* w = CIN(16) + (size_t)l * DM * DM;
            transpose_wave(c, [=](int k, int n) { return w[(size_t)k * DM + n]; }, wsp<bf16_t>(c, WS_WOUT), DM, kt * 64, nt * 64);
            continue;
        } r -= I_OUT;
        {
            const int kv = r / 32, kt = r % 32; const float* w = CIN(12) + ((size_t)l * 2 + kv) * 2048 * 64;
            transpose_wave(c, [=](int k, int n) { return w[(size_t)k * 64 + n]; }, wsp<bf16_t>(c, WS_WCT) + (size_t)kv * 64 * 2048, 2048, kt * 64, 0);
        }
    }
    if (mask & 2)
    for (int it = c.bid * NWAVE + c.wave; it < I_WQ; it += c.nblk * NWAVE) {
        const int keyt = it & 7, kt = (it >> 3) & 15, hp = it >> 7, fr = c.lane & 15, fq = c.lane >> 4;
        const float* keys = CIN(19) + (((size_t)l * 16 + hp) * 128 + keyt * 16 + fr) * 128; const float* wq = CIN(18) + (size_t)l * DM * PEER_N + hp * 128;
        bf16x8 kb[4];
#pragma unroll
        for (int ds = 0; ds < 4; ++ds) kb[ds] = cvt8(*(const f32x4*)(keys + 32 * ds + 8 * fq), *(const f32x4*)(keys + 32 * ds + 8 * fq + 4), 1.0f);
#pragma unroll
        for (int tile = 0; tile < 4; ++tile) { const int k = kt * 64 + tile * 16 + fr; const float gk = g2[k]; const float* wr = wq + (size_t)k * PEER_N;
            f32x4 acc = {0.f, 0.f, 0.f, 0.f};
#pragma unroll
            for (int ds = 0; ds < 4; ++ds) acc = mfma16(cvt8(*(const f32x4*)(wr + 32 * ds + 8 * fq), *(const f32x4*)(wr + 32 * ds + 8 * fq + 4), gk), kb[ds], acc);
            u32x2 w; w.x = pk2(acc[0], acc[1]); w.y = pk2(acc[2], acc[3]);
            *(u32x2*)(wsp<bf16_t>(c, WS_WQ2) + (size_t)(hp * 128 + keyt * 16 + fr) * DM + kt * 64 + tile * 16 + fq * 4) = w; }
    }
    if (mask & 4)
    for (int it = (c.nblk - 1 - c.bid) * NWAVE + c.wave; it < 128; it += c.nblk * NWAVE) {
        const int kv = it >> 6, ch = it & 63;
        const float* w = CIN(12) + (((size_t)l * 2 + kv) * 2048 + ch * 32) * 64 + c.lane; const float pv = (CIN(11) + ((size_t)l * 2 + kv) * 2048 + ch * 32)[c.lane & 31];
        float wv[32];
#pragma unroll
        for (int j = 0; j < 32; ++j) wv[j] = w[j * 64];
        float s = 0.f;
#pragma unroll
        for (int j = 0; j < 32; ++j) s += bcast_f(pv, j) * wv[j];
        wsp<float>(c, WS_CBPART)[(size_t)(kv * 64 + ch) * 64 + c.lane] = s;
    }
    if (l == 0 && (mask & 8)) {
        const float* x = CIN(0); bf16_t* xb = wsp<bf16_t>(c, WS_XB); float* rss = wsp<float>(c, WS_RSS1);
        const int rstride = c.nblk * NWAVE;
        for (int row = c.bid * NWAVE + c.wave; row < NT; row += 4 * rstride) {
            f32x4 v[4][4];
#pragma unroll
            for (int r = 0; r < 4; ++r) { const int rr = row + r * rstride; if (rr < NT) {
#pragma unroll
                for (int j = 0; j < 4; ++j) v[r][j] = ((const f32x4*)(x + (size_t)rr * DM) + c.lane)[64 * j]; } }
#pragma unroll
            for (int r = 0; r < 4; ++r) { const int rr = row + r * rstride; if (rr < NT) {
                u32x2* o = (u32x2*)(xb + (size_t)rr * DM) + c.lane; float s = 0.f;
#pragma unroll
                for (int j = 0; j < 4; ++j) { const f32x4 t = v[r][j]; s += (t[0] * t[0] + t[1] * t[1]) + (t[2] * t[2] + t[3] * t[3]);
                    u32x2 w; w.x = pk2(t[0], t[1]); w.y = pk2(t[2], t[3]); o[64 * j] = w; }
                s = wave_sum(s);
                if (c.lane == 0) rss[rr] = s; } }
        }
    }
    if (l == 0 && (mask & 16)) {
        float* cosT = wsp<float>(c, WS_ROPE); float* sinT = cosT + SEQ * 32;
        for (int i = c.bid * NTHR + c.tid; i < SEQ * 32; i += c.nblk * NTHR) {
            const int pos = i >> 5, fi = i & 31;
            const float inv = exp2f(-(float)fi * 0.41524101186092029f);
            const float a = (float)pos * inv, q = rintf(a * 0.63661977236758134f);
            float rr = fmaf(-q, 1.5703125f, a); rr = fmaf(-q, 4.837512969970703125e-4f, rr); rr = fmaf(-q, 7.54978995489188216e-8f, rr);
            const float r2 = rr * rr;
            const float s = rr * (1.0f + r2 * (-1.0f / 6 + r2 * (1.0f / 120 + r2 * (-1.0f / 5040 + r2 * (1.0f / 362880)))));
            const float cc = 1.0f + r2 * (-0.5f + r2 * (1.0f / 24 + r2 * (-1.0f / 720 + r2 * (1.0f / 40320 + r2 * (-1.0f / 3628800)))));
            const int qi = ((int)q) & 3;
            const float co = qi == 0 ? cc : qi == 1 ? -s : qi == 2 ? -cc : s;
            const float si = qi == 0 ? s : qi == 1 ? cc : qi == 2 ? -s : -cc;
            cosT[i] = co; sinT[i] = si;
        }
    }
}
constexpr int LF_STRIDE = 65, LT_STRIDE = 72;
constexpr int LDS_F0 = 0, LDS_F1 = 16640, LDS_F2 = 33280, LDS_T0 = 49920, LDS_TSZ = 64 * LT_STRIDE * 2, LDS_MISC = LDS_T0 + 6 * LDS_TSZ;
DEV LDSP float* ldsF(const Ctx& c, int i) { return (LDSP float*)(c.lds + LDS_F0 + i * 16640); }
DEV LDSP bf16_t* ldsT(const Ctx& c, int i) { return (LDSP bf16_t*)(c.lds + LDS_T0 + i * LDS_TSZ); }
DEV LDSP float* ldsM(const Ctx& c) { return (LDSP float*)(c.lds + LDS_MISC); }

DEV void load_tile_f32(const Ctx& c, LDSP float* F, const bf16_t* proj, int tok0, int col) {
    const int t = c.tid >> 3, d0 = (c.tid & 7) * 8;
    const u32x4 v = *(const u32x4*)(proj + (size_t)(tok0 + t) * PROJ_LD + col + d0);
    LDSP float* f = F + t * LF_STRIDE + d0;
    f[0] = bflo(v.x); f[1] = bfhi(v.x); f[2] = bflo(v.y); f[3] = bfhi(v.y); f[4] = bflo(v.z); f[5] = bfhi(v.z); f[6] = bflo(v.w); f[7] = bfhi(v.w);
}
DEV void load_tile_T(const Ctx& c, LDSP bf16_t* T, const bf16_t* proj, int tok0, int col) {
    const int t = c.tid >> 3, d0 = (c.tid & 7) * 8;
    const u32x4 v = *(const u32x4*)(proj + (size_t)(tok0 + t) * PROJ_LD + col + d0);
    LDSP bf16_t* p = T + d0 * LT_STRIDE + t;
    p[0] = (bf16_t)(v.x & 0xffff); p[LT_STRIDE] = (bf16_t)(v.x >> 16); p[2 * LT_STRIDE] = (bf16_t)(v.y & 0xffff); p[3 * LT_STRIDE] = (bf16_t)(v.y >> 16);
    p[4 * LT_STRIDE] = (bf16_t)(v.z & 0xffff); p[5 * LT_STRIDE] = (bf16_t)(v.z >> 16); p[6 * LT_STRIDE] = (bf16_t)(v.w & 0xffff); p[7 * LT_STRIDE] = (bf16_t)(v.w >> 16);
}
DEV f32x4 mma_tile(const LDSP bf16_t* A, int lda, int r0, const LDSP bf16_t* B, int ldb, int c0, int K, f32x4 acc, int lane) {
    const int fr = lane & 15, fq = lane >> 4;
    for (int k0 = 0; k0 < K; k0 += 32) {
        const bf16x8 a = *(const LDSP bf16x8*)(A + (r0 + fr) * lda + k0 + fq * 8);
        const bf16x8 b = *(const LDSP bf16x8*)(B + (c0 + fr) * ldb + k0 + fq * 8);
        acc = mfma16(a, b, acc);
    }
    return acc;
}
DEV float wave_scan_add(float v, int lane) {
#pragma unroll
    for (int o = 1; o < 64; o <<= 1) { const float t = shfl_f(v, lane - o); if (lane >= o) v += t; }
    return v;
}
DEV float wave_scan_max(float v, int lane) {
#pragma unroll
    for (int o = 1; o < 64; o <<= 1) { const float t = shfl_f(v, lane - o); if (lane >= o) v = fmaxf(v, t); }
    return v;
}
DEV float hgrn_lb(const Ctx& c, int l, int ch) { if (l == 0) return 0.f; const float* lb = CIN(3); return sigmoidf_(lb[MW + ch] - lb[ch]); }
DEV float ret_loggamma(int h) { return log1pf(-exp2f(-5.0f - (float)h)); }

DEV void hgrn_front(const Ctx& c, int l, const bf16_t* proj, int tok0, int h) {
    LDSP float* F0 = ldsF(c, 0); LDSP float* F1 = ldsF(c, 1);
    load_tile_f32(c, F0, proj, tok0, C_HF + h * 64);
    block_sync();
    for (int e = c.tid; e < 4096; e += NTHR) { const int t = e >> 6, d = e & 63; const float fl = F0[t * LF_STRIDE + d], lbv = hgrn_lb(c, l, h * 64 + d);
        const float sg = sigmoidf_(fl), f = lbv + (1.f - lbv) * sg; F0[t * LF_STRIDE + d] = fast_log(f); F1[t * LF_STRIDE + d] = (1.f - lbv) * (1.f - sg); }
    block_sync();
    for (int k = 0; k < 8; ++k) { const int d = c.wave * 8 + k; F0[c.lane * LF_STRIDE + d] = wave_scan_add(F0[c.lane * LF_STRIDE + d], c.lane); }
    block_sync();
}
DEV void rope_tile(const Ctx& c, LDSP float* F, int pos0, float scale) {
    const float* cosT = wsp<float>(c, WS_ROPE); const float* sinT = cosT + SEQ * 32;
    for (int e = c.tid; e < 2048; e += NTHR) { const int t = e >> 5, d = e & 31; const float cs = cosT[(pos0 + t) * 32 + d], sn = sinT[(pos0 + t) * 32 + d];
        const float x1 = F[t * LF_STRIDE + d], x2 = F[t * LF_STRIDE + d + 32];
        F[t * LF_STRIDE + d] = (x1 * cs - x2 * sn) * scale; F[t * LF_STRIDE + d + 32] = (x1 * sn + x2 * cs) * scale; }
}
constexpr int LDS_RAW = 107520, RAW_SZ = 67 * 65 * 4;
DEV void mlstm_conv_both(const Ctx& c, int l, LDSP float* Fq, LDSP float* Fk, const bf16_t* proj, int tok0, int ck, int cg, int h) {
    const float* cw = CIN(5) + (size_t)l * 4 * 512; const float* cb = CIN(6) + (size_t)l * 512; const bf16_t* halo = wsp<bf16_t>(c, WS_HALO);
    LDSP float* Rq = (LDSP float*)(c.lds + LDS_RAW); LDSP float* Rk = (LDSP float*)(c.lds + LDS_RAW + RAW_SZ);
    const int t = c.tid >> 3, d0 = (c.tid & 7) * 8;
    { const u32x4 vq = *(const u32x4*)(proj + (size_t)(tok0 + t) * PROJ_LD + C_MQ + h * 64 + d0), vk = *(const u32x4*)(proj + (size_t)(tok0 + t) * PROJ_LD + C_MK + h * 64 + d0);
      u32x4 hq = {0u, 0u, 0u, 0u}, hk = {0u, 0u, 0u, 0u};
      if (c.tid < 24 && ck > 0) { hq = *(const u32x4*)(halo + ((size_t)(cg - 1) * 3 + t) * 512 + h * 64 + d0); hk = *(const u32x4*)(halo + ((size_t)(cg - 1) * 3 + t) * 512 + 256 + h * 64 + d0); }
      LDSP float* fq = Rq + (t + 3) * 65 + d0; LDSP float* fk = Rk + (t + 3) * 65 + d0;
      fq[0] = bflo(vq.x); fq[1] = bfhi(vq.x); fq[2] = bflo(vq.y); fq[3] = bfhi(vq.y); fq[4] = bflo(vq.z); fq[5] = bfhi(vq.z); fq[6] = bflo(vq.w); fq[7] = bfhi(vq.w);
      fk[0] = bflo(vk.x); fk[1] = bfhi(vk.x); fk[2] = bflo(vk.y); fk[3] = bfhi(vk.y); fk[4] = bflo(vk.z); fk[5] = bfhi(vk.z); fk[6] = bflo(vk.w); fk[7] = bfhi(vk.w);
      if (c.tid < 24) { LDSP float* gq = Rq + t * 65 + d0; LDSP float* gk = Rk + t * 65 + d0;
        gq[0] = bflo(hq.x); gq[1] = bfhi(hq.x); gq[2] = bflo(hq.y); gq[3] = bfhi(hq.y); gq[4] = bflo(hq.z); gq[5] = bfhi(hq.z); gq[6] = bflo(hq.w); gq[7] = bfhi(hq.w);
        gk[0] = bflo(hk.x); gk[1] = bfhi(hk.x); gk[2] = bflo(hk.y); gk[3] = bfhi(hk.y); gk[4] = bflo(hk.z); gk[5] = bfhi(hk.z); gk[6] = bflo(hk.w); gk[7] = bfhi(hk.w); } }
    block_sync();
#pragma unroll
    for (int half = 0; half < 2; ++half) {
        const int ch = half * 256 + h * 64 + d0; LDSP float* R = half ? Rk : Rq; LDSP float* F = half ? Fk : Fq; const float scale = half ? 0.125f : 1.0f;
        f32x4 s0 = *(const f32x4*)(cb + ch), s1 = *(const f32x4*)(cb + ch + 4);
#pragma unroll
        for (int j = 0; j < 4; ++j) { const f32x4 w0 = *(const f32x4*)(cw + j * 512 + ch), w1 = *(const f32x4*)(cw + j * 512 + ch + 4); const LDSP float* rr = R + (t + j) * 65 + d0;
            s0[0] += w0[0] * rr[0]; s0[1] += w0[1] * rr[1]; s0[2] += w0[2] * rr[2]; s0[3] += w0[3] * rr[3]; s1[0] += w1[0] * rr[4]; s1[1] += w1[1] * rr[5]; s1[2] += w1[2] * rr[6]; s1[3] += w1[3] * rr[7]; }
        LDSP float* f = F + t * LF_STRIDE + d0;
        f[0] = siluf_(s0[0]) * scale; f[1] = siluf_(s0[1]) * scale; f[2] = siluf_(s0[2]) * scale; f[3] = siluf_(s0[3]) * scale;
        f[4] = siluf_(s1[0]) * scale; f[5] = siluf_(s1[1]) * scale; f[6] = siluf_(s1[2]) * scale; f[7] = siluf_(s1[3]) * scale;
    }
}
DEV void mlstm_gates(const Ctx& c, int l, const bf16_t* proj, int tok0, int h) {
    LDSP float* M = ldsM(c); const float* gb = CIN(7) + (size_t)l * 8;
    if (c.tid < 64) { const int t = c.tid; M[t] = bf2f(proj[(size_t)(tok0 + t) * PROJ_LD + C_MI + h]) + gb[h];
        M[64 + t] = log_sigmoidf_(bf2f(proj[(size_t)(tok0 + t) * PROJ_LD + C_MF + h]) + gb[4 + h]); }
    block_sync();
    if (c.wave == 0) M[64 + c.lane] = wave_scan_add(M[64 + c.lane], c.lane);
    block_sync();
}
DEV void store_state_tiles(const Ctx& c, bf16_t* dst, const f32x4 (&acc)[2]) {
    const int fr = c.lane & 15, fq = c.lane >> 4;
#pragma unroll
    for (int k = 0; k < 2; ++k) { const int ti = c.wave * 2 + k, rt = ti >> 2, ct = ti & 3;
#pragma unroll
        for (int i = 0; i < 4; ++i) dst[(rt * 16 + fq * 4 + i) * 64 + ct * 16 + fr] = f2bf(acc[k][i]); }
}
DEV void f32_to_tile(const Ctx& c, LDSP bf16_t* T, const LDSP float* F, bool transpose) {
    for (int e = c.tid; e < 4096; e += NTHR) { const int r = e >> 6, q = e & 63; const bf16_t v = f2bf(F[r * LF_STRIDE + q]); if (transpose) T[q * LT_STRIDE + r] = v; else T[r * LT_STRIDE + q] = v; }
}

DEV void recur_local_unit(const Ctx& c, int l, int unit) {
    const int mixer = unit / (BATCH * NH * NC), r = unit % (BATCH * NH * NC), b = r / (NH * NC), h = (r / NC) % NH, ck = r % NC;
    bf16_t* proj = wsp<bf16_t>(c, WS_PROJ); const int tok0 = b * SEQ + ck * 64, pos0 = ck * 64;
    LDSP float* F0 = ldsF(c, 0); LDSP float* F1 = ldsF(c, 1); LDSP float* F2 = ldsF(c, 2); LDSP float* M = ldsM(c);
    LDSP bf16_t* VT = ldsT(c, 0); LDSP bf16_t* KT = ldsT(c, 1);
    bf16_t* dst = wsp<bf16_t>(c, WS_ST + mixer * ST_ONE) + (size_t)r * 4096;
    const int vt = c.tid >> 3, vd0 = (c.tid & 7) * 8;
    int qcol, kcol, vcol;
    if (mixer == 0) {
        qcol = C_HQ; kcol = C_HF; vcol = C_HI;
        load_tile_T(c, VT, proj, tok0, C_HI + h * 64);
        load_tile_f32(c, F2, proj, tok0, C_HQ + h * 64);
        hgrn_front(c, l, proj, tok0, h);
        float qo[8], ko[8];
#pragma unroll
        for (int j = 0; j < 8; ++j) { const int d = vd0 + j; const float bt = F0[vt * LF_STRIDE + d], bm = F0[31 * LF_STRIDE + d], bl = F0[63 * LF_STRIDE + d], kk = F1[vt * LF_STRIDE + d];
            qo[j] = siluf_(F2[vt * LF_STRIDE + d]) * fast_exp(bt - bm); ko[j] = kk * fast_exp(bm - bt); KT[d * LT_STRIDE + vt] = f2bf(kk * fast_exp(bl - bt)); }
        if (c.tid < 64) { wsp<float>(c, WS_GDEC)[(size_t)r * 64 + c.tid] = fast_exp(F0[63 * LF_STRIDE + c.tid]); wsp<float>(c, WS_G31)[(size_t)r * 64 + c.tid] = fast_exp(F0[31 * LF_STRIDE + c.tid]); }
        u32x4 w; w.x = pk2(qo[0], qo[1]); w.y = pk2(qo[2], qo[3]); w.z = pk2(qo[4], qo[5]); w.w = pk2(qo[6], qo[7]); *(u32x4*)(proj + (size_t)(tok0 + vt) * PROJ_LD + C_HQ + h * 64 + vd0) = w;
        w.x = pk2(ko[0], ko[1]); w.y = pk2(ko[2], ko[3]); w.z = pk2(ko[4], ko[5]); w.w = pk2(ko[6], ko[7]); *(u32x4*)(proj + (size_t)(tok0 + vt) * PROJ_LD + C_HF + h * 64 + vd0) = w;
    } else if (mixer == 2) {
        qcol = C_RQ; kcol = C_RK; vcol = C_RV;
        load_tile_T(c, VT, proj, tok0, C_RV + h * 64);
        load_tile_f32(c, F0, proj, tok0, C_RK + h * 64); load_tile_f32(c, F2, proj, tok0, C_RQ + h * 64);
        block_sync();
        rope_tile(c, F0, pos0, 0.125f); rope_tile(c, F2, pos0, 1.0f);
        block_sync();
        const float lg = ret_loggamma(h), gq = fast_exp(lg * (float)(vt - 31)), gk = fast_exp(lg * (float)(31 - vt)), gl = fast_exp(lg * (float)(63 - vt));
        float qo[8], ko[8];
#pragma unroll
        for (int j = 0; j < 8; ++j) { const int d = vd0 + j; const float kk = F0[vt * LF_STRIDE + d]; qo[j] = F2[vt * LF_STRIDE + d] * gq; ko[j] = kk * gk; KT[d * LT_STRIDE + vt] = f2bf(kk * gl); }
        u32x4 w; w.x = pk2(qo[0], qo[1]); w.y = pk2(qo[2], qo[3]); w.z = pk2(qo[4], qo[5]); w.w = pk2(qo[6], qo[7]); *(u32x4*)(proj + (size_t)(tok0 + vt) * PROJ_LD + C_RQ + h * 64 + vd0) = w;
        w.x = pk2(ko[0], ko[1]); w.y = pk2(ko[2], ko[3]); w.z = pk2(ko[4], ko[5]); w.w = pk2(ko[6], ko[7]); *(u32x4*)(proj + (size_t)(tok0 + vt) * PROJ_LD + C_RK + h * 64 + vd0) = w;
    } else {
        qcol = C_MQ; kcol = C_MK; vcol = C_MV;
        load_tile_T(c, VT, proj, tok0, C_MV + h * 64);
        mlstm_gates(c, l, proj, tok0, h);
        mlstm_conv_both(c, l, F2, F0, proj, tok0, ck, b * NC + ck, h);
        if (c.wave == 0) { const int t = c.lane; const float bl = M[127], bt = M[64 + t], li = M[t];
            const float a = wave_max(bl - bt + li); const float pm = wave_scan_max(li - bt, t);
            M[128 + t] = pm; if (t == 0) { M[192] = a; M[193] = bl; }
            float* mts = wsp<float>(c, WS_MTS) + ((size_t)(tok0 + t) * NH + h) * 2; mts[0] = bt; mts[1] = bt + pm; }
        block_sync();
        const float eq = fast_exp(-M[128 + vt]), ek = fast_exp(M[vt] - M[64 + vt]), wk = fast_exp(M[193] - M[64 + vt] + M[vt] - M[192]);
        float qo[8], ko[8];
#pragma unroll
        for (int j = 0; j < 8; ++j) { const int d = vd0 + j; const float kk = F0[vt * LF_STRIDE + d]; qo[j] = F2[vt * LF_STRIDE + d] * eq; ko[j] = kk * ek;
            const float kh = kk * wk; F1[vt * LF_STRIDE + d] = kh; KT[d * LT_STRIDE + vt] = f2bf(kh); }
        block_sync();
        u32x4 w; w.x = pk2(qo[0], qo[1]); w.y = pk2(qo[2], qo[3]); w.z = pk2(qo[4], qo[5]); w.w = pk2(qo[6], qo[7]); *(u32x4*)(proj + (size_t)(tok0 + vt) * PROJ_LD + C_MQ + h * 64 + vd0) = w;
        w.x = pk2(ko[0], ko[1]); w.y = pk2(ko[2], ko[3]); w.z = pk2(ko[4], ko[5]); w.w = pk2(ko[6], ko[7]); *(u32x4*)(proj + (size_t)(tok0 + vt) * PROJ_LD + C_MK + h * 64 + vd0) = w;
        if (c.tid < 64) { float s = 0.f; for (int t = 0; t < 64; ++t) s += F1[t * LF_STRIDE + c.tid]; wsp<float>(c, WS_MNL)[(size_t)r * 64 + c.tid] = s; }
        if (c.tid == 64) { float* sc = wsp<float>(c, WS_MSC) + (size_t)r * 4; sc[0] = M[192]; sc[1] = M[193]; }
    }
    block_sync();
    f32x4 acc[2];
#pragma unroll
    for (int k = 0; k < 2; ++k) { const int ti = c.wave * 2 + k; acc[k] = (f32x4){0.f, 0.f, 0.f, 0.f}; acc[k] = mma_tile(VT, LT_STRIDE, (ti >> 2) * 16, KT, LT_STRIDE, (ti & 3) * 16, 64, acc[k], c.lane); }
    store_state_tiles(c, dst, acc);
    *(u32x4*)(proj + (size_t)(tok0 + vt) * PROJ_LD + vcol + h * 64 + vd0) = *(const LDSP u32x4*)(VT + vt * LT_STRIDE + vd0);
    (void)qcol; (void)kcol;
    block_sync();
}

DEV void recur_scan(const Ctx& c) {
    constexpr int ncol2 = BATCH * NH * 2048;
    constexpr int KB = (NC < 16) ? NC : 16;
    for (int i = c.bid * NTHR + c.tid; i < 3 * ncol2 + BATCH * NH * 64; i += c.nblk * NTHR) {
        if (i < 3 * ncol2) {
            const int mixer = i / ncol2, col = (i % ncol2) * 2, bh = col >> 12, ed = col & 4095, d = ed & 63, h = bh % NH;
            bf16_t* p = wsp<bf16_t>(c, WS_ST + mixer * ST_ONE) + (size_t)bh * NC * 4096 + ed;
            const float* g = wsp<float>(c, WS_GDEC) + (size_t)bh * NC * 64 + d; const float* g31 = wsp<float>(c, WS_G31) + (size_t)bh * NC * 64 + d; const float* sc = wsp<float>(c, WS_MSC) + (size_t)bh * NC * 4;
            const float gr = fast_exp(ret_loggamma(h) * 64.f), gr32 = fast_exp(ret_loggamma(h) * 32.f);
            float s0 = 0.f, s1 = 0.f, m = 0.f;
            for (int kb = 0; kb < NC; kb += KB) {
                unsigned tv[KB]; f32x2 gv[KB]; f32x2 av[KB]; f32x2 hv[KB];
#pragma unroll
                for (int j = 0; j < KB; ++j) { tv[j] = *(const unsigned*)(p + (size_t)(kb + j) * 4096);
                    if (mixer == 0) { gv[j] = *(const f32x2*)(g + (kb + j) * 64); hv[j] = *(const f32x2*)(g31 + (kb + j) * 64); } else if (mixer == 1) av[j] = *(const f32x2*)(sc + (kb + j) * 4); }
#pragma unroll
                for (int j = 0; j < KB; ++j) {
                    const float t0 = bflo(tv[j]), t1 = bfhi(tv[j]);
                    if (mixer == 0) { *(unsigned*)(p + (size_t)(kb + j) * 4096) = pk2(s0 * hv[j][0], s1 * hv[j][1]); s0 = gv[j][0] * s0 + t0; s1 = gv[j][1] * s1 + t1; }
                    else if (mixer == 2) { *(unsigned*)(p + (size_t)(kb + j) * 4096) = pk2(s0 * gr32, s1 * gr32); s0 = gr * s0 + t0; s1 = gr * s1 + t1; }
                    else { *(unsigned*)(p + (size_t)(kb + j) * 4096) = pk2(s0, s1);
                        const float a = av[j][0], bl = av[j][1], mn = fmaxf(bl + m, a), ds = fast_exp(bl + m - mn), dl = fast_exp(a - mn); s0 = ds * s0 + dl * t0; s1 = ds * s1 + dl * t1; m = mn; }
                }
            }
        } else {
            const int j = i - 3 * ncol2, bh = j >> 6, d = j & 63;
            float* p = wsp<float>(c, WS_MNL) + (size_t)bh * NC * 64 + d; float* sc = wsp<float>(c, WS_MSC) + (size_t)bh * NC * 4; float m = 0.f, s = 0.f;
            for (int k = 0; k < NC; ++k) { const float a = sc[k * 4], bl = sc[k * 4 + 1], mn = fmaxf(bl + m, a);
                const float t = p[k * 64]; p[k * 64] = s; if (d == 0) sc[k * 4 + 2] = m; s = fast_exp(bl + m - mn) * s + fast_exp(a - mn) * t; m = mn; }
        }
    }
}

DEV void recur_out_wave(const Ctx& c, int l, int unit) {
    const int mixer = unit / (BATCH * NH * NC), r = unit % (BATCH * NH * NC), b = r / (NH * NC), h = (r / NC) % NH, ck = r % NC;
    const bf16_t* proj = wsp<bf16_t>(c, WS_PROJ); const int tok0 = b * SEQ + ck * 64;
    const bf16_t* st = wsp<bf16_t>(c, WS_ST + mixer * ST_ONE) + (size_t)r * 4096;
    const int fr = c.lane & 15, fq = c.lane >> 4;
    const int qcol = (mixer == 0 ? C_HQ : mixer == 1 ? C_MQ : C_RQ) + h * 64, kcol = (mixer == 0 ? C_HF : mixer == 1 ? C_MK : C_RK) + h * 64;
    const int vcol = (mixer == 0 ? C_HI : mixer == 1 ? C_MV : C_RV) + h * 64, gcol = (mixer == 0 ? C_HG : mixer == 1 ? C_MO : C_RG) + h * 64;
    const float* onorm = (mixer == 0 ? CIN(4) : mixer == 1 ? CIN(8) : CIN(13)) + (size_t)l * MW + h * 64;
    bf16x8 ka[4][2], va[4][2], sa[4][2];
#pragma unroll
    for (int sq = 0; sq < 4; ++sq)
#pragma unroll
        for (int ks = 0; ks < 2; ++ks) {
            ka[sq][ks] = *(const bf16x8*)(proj + (size_t)(tok0 + 16 * sq + fr) * PROJ_LD + kcol + 32 * ks + 8 * fq);
            sa[sq][ks] = *(const bf16x8*)(st + (16 * sq + fr) * 64 + 32 * ks + 8 * fq);
            const bf16_t* vp = proj + (size_t)(tok0 + 16 * sq + fr) * PROJ_LD + vcol + 32 * ks + 4 * fq;
            const u32x2 v0 = *(const u32x2*)vp, v1 = *(const u32x2*)(vp + 16); const u32x4 vv = {v0.x, v0.y, v1.x, v1.y}; va[sq][ks] = __builtin_bit_cast(bf16x8, vv);
        }
    bf16x8 sn[2], vones; float mst = 0.f;
    if (mixer == 1) {
        const float* nst = wsp<float>(c, WS_MNL) + (size_t)r * 64; mst = wsp<float>(c, WS_MSC)[(size_t)r * 4 + 2];
#pragma unroll
        for (int ks = 0; ks < 2; ++ks) { const f32x4 n0 = *(const f32x4*)(nst + 32 * ks + 8 * fq), n1 = *(const f32x4*)(nst + 32 * ks + 8 * fq + 4);
            u32x4 w = {pk2(n0[0], n0[1]), pk2(n0[2], n0[3]), pk2(n1[0], n1[1]), pk2(n1[2], n1[3])}; if (fr != 0) w = (u32x4){0u, 0u, 0u, 0u}; sn[ks] = __builtin_bit_cast(bf16x8, w); }
        const unsigned one2 = (fr == 0) ? 0x3f803f80u : 0u; const u32x4 ow = {one2, one2, one2, one2}; vones = __builtin_bit_cast(bf16x8, ow);
    }
#pragma unroll
    for (int tq = 0; tq < 4; ++tq) {
        const int tok = tok0 + 16 * tq + fr;
        bf16x8 qb[2];
#pragma unroll
        for (int ks = 0; ks < 2; ++ks) qb[ks] = *(const bf16x8*)(proj + (size_t)tok * PROJ_LD + qcol + 32 * ks + 8 * fq);
        f32x4 stt[4];
#pragma unroll
        for (int sq = 0; sq < 4; ++sq) { stt[sq] = (f32x4){0.f, 0.f, 0.f, 0.f};
            if (sq <= tq) { stt[sq] = mfma16(ka[sq][0], qb[0], stt[sq]); stt[sq] = mfma16(ka[sq][1], qb[1], stt[sq]); } }
#pragma unroll
        for (int i = 0; i < 4; ++i) if (4 * fq + i > fr) stt[tq][i] = 0.f;
        f32x4 ot[4], os[4], o5 = {0.f, 0.f, 0.f, 0.f}, s5 = {0.f, 0.f, 0.f, 0.f};
#pragma unroll
        for (int eq = 0; eq < 4; ++eq) { ot[eq] = (f32x4){0.f, 0.f, 0.f, 0.f}; os[eq] = (f32x4){0.f, 0.f, 0.f, 0.f}; }
#pragma unroll
        for (int m = 0; m < 2; ++m) if (2 * m <= tq) {
            const u32x4 pw = {pk2(stt[2 * m][0], stt[2 * m][1]), pk2(stt[2 * m][2], stt[2 * m][3]), pk2(stt[2 * m + 1][0], stt[2 * m + 1][1]), pk2(stt[2 * m + 1][2], stt[2 * m + 1][3])};
            const bf16x8 pb = __builtin_bit_cast(bf16x8, pw);
#pragma unroll
            for (int eq = 0; eq < 4; ++eq) ot[eq] = mfma16(va[eq][m], pb, ot[eq]);
            if (mixer == 1) o5 = mfma16(vones, pb, o5);
        }
        if (mixer != 1) {
#pragma unroll
            for (int eq = 0; eq < 4; ++eq) { ot[eq] = mfma16(sa[eq][0], qb[0], ot[eq]); ot[eq] = mfma16(sa[eq][1], qb[1], ot[eq]); }
        } else {
#pragma unroll
            for (int eq = 0; eq < 4; ++eq) { os[eq] = mfma16(sa[eq][0], qb[0], os[eq]); os[eq] = mfma16(sa[eq][1], qb[1], os[eq]); }
            s5 = mfma16(sn[0], qb[0], s5); s5 = mfma16(sn[1], qb[1], s5);
            const float* mts = wsp<float>(c, WS_MTS) + ((size_t)tok * NH + h) * 2; const float bt = mts[0], ml = mts[1];
            const float inter = bt + mst, mt = fmaxf(inter, ml), rt = fast_exp(ml - mt), stc = fast_exp(mst + ml - mt);
            const float den = shfl_f(rt * o5[0] + stc * s5[0], fr);
            const float inv = fast_rcp(fmaxf(fabsf(den), fast_exp(-mt)));
#pragma unroll
            for (int eq = 0; eq < 4; ++eq) ot[eq] = (ot[eq] * rt + os[eq] * stc) * inv;
        }
        float ss = 0.f;
#pragma unroll
        for (int eq = 0; eq < 4; ++eq) ss += (ot[eq][0] * ot[eq][0] + ot[eq][1] * ot[eq][1]) + (ot[eq][2] * ot[eq][2] + ot[eq][3] * ot[eq][3]);
        ss += xorf<16>(ss); ss += xorf<32>(ss);
        const float rn = fast_rsqrt(ss * (1.0f / 64.0f) + NORM_EPS);
        bf16_t* out = wsp<bf16_t>(c, WS_OUTS) + (size_t)(mixer == 0 ? 0 : mixer == 1 ? 1 : 3) * NT * MW + (size_t)tok * MW + h * 64 + 4 * fq;
#pragma unroll
        for (int eq = 0; eq < 4; ++eq) { const u32x2 gv = *(const u32x2*)(proj + (size_t)tok * PROJ_LD + gcol + 16 * eq + 4 * fq); const f32x4 on = *(const f32x4*)(onorm + 16 * eq + 4 * fq);
            const float g0 = bflo(gv.x), g1 = bfhi(gv.x), g2 = bflo(gv.y), g3 = bfhi(gv.y);
            const float a0 = ot[eq][0] * rn * on[0] * (mixer == 1 ? sigmoidf_(g0) : siluf_(g0)), a1 = ot[eq][1] * rn * on[1] * (mixer == 1 ? sigmoidf_(g1) : siluf_(g1));
            const float a2 = ot[eq][2] * rn * on[2] * (mixer == 1 ? sigmoidf_(g2) : siluf_(g2)), a3 = ot[eq][3] * rn * on[3] * (mixer == 1 ? sigmoidf_(g3) : siluf_(g3));
            u32x2 w; w.x = pk2(a0, a1); w.y = pk2(a2, a3); *(u32x2*)(out + 16 * eq) = w; }
    }
}

DEV void nsa_kprep_item(const Ctx& c, int l, int item) {
    const bf16_t* proj = wsp<bf16_t>(c, WS_PROJ); bf16_t* ksw = wsp<bf16_t>(c, WS_KSW);
    const float* cosT = wsp<float>(c, WS_ROPE); const float* sinT = cosT + SEQ * 32;
    const int tok = item * 32 + (c.tid >> 4), vec = (c.tid >> 2) & 3, br = vec >> 1, g = vec & 1, d0 = (c.tid & 3) * 8;
    const int col = (br == 0 ? C_NKS : C_NKW) + g * 64;
    const u32x4 a = *(const u32x4*)(proj + (size_t)tok * PROJ_LD + col + d0), b2 = *(const u32x4*)(proj + (size_t)tok * PROJ_LD + col + 32 + d0);
    const float x1[8] = {bflo(a.x), bfhi(a.x), bflo(a.y), bfhi(a.y), bflo(a.z), bfhi(a.z), bflo(a.w), bfhi(a.w)};
    const float x2[8] = {bflo(b2.x), bfhi(b2.x), bflo(b2.y), bfhi(b2.y), bflo(b2.z), bfhi(b2.z), bflo(b2.w), bfhi(b2.w)};
    float ss = 0.f;
#pragma unroll
    for (int j = 0; j < 8; ++j) ss += x1[j] * x1[j] + x2[j] * x2[j];
    ss += xorf<1>(ss); ss += xorf<2>(ss);
    const float r = fast_rsqrt(ss * (1.0f / 64.0f) + NORM_EPS); const float* kg = CIN(10) + ((size_t)l * 3 + 1 + br) * 64; const int pos = tok % SEQ;
    float o1[8], o2[8];
#pragma unroll
    for (int j = 0; j < 8; ++j) { const int d = d0 + j; const float y1 = x1[j] * r * kg[d], y2 = x2[j] * r * kg[d + 32], cs = cosT[pos * 32 + d], sn = sinT[pos * 32 + d];
        o1[j] = y1 * cs - y2 * sn; o2[j] = y1 * sn + y2 * cs; }
    bf16_t* o = ksw + (size_t)tok * 256 + vec * 64 + d0;
    u32x4 w; w.x = pk2(o1[0], o1[1]); w.y = pk2(o1[2], o1[3]); w.z = pk2(o1[4], o1[5]); w.w = pk2(o1[6], o1[7]); *(u32x4*)o = w;
    w.x = pk2(o2[0], o2[1]); w.y = pk2(o2[2], o2[3]); w.z = pk2(o2[4], o2[5]); w.w = pk2(o2[6], o2[7]); *(u32x4*)(o + 32) = w;
}
DEV void nsa_compress_unit(const Ctx& c, int l, int unit) {
    const int quarter = unit & 3, kv = (unit >> 2) & 1, g = (unit >> 3) & 1, b = unit >> 4;
    const bf16_t* proj = wsp<bf16_t>(c, WS_PROJ); const bf16_t* wct = wsp<bf16_t>(c, WS_WCT) + (size_t)kv * 64 * 2048;
    const int fr = c.lane & 15, fq = c.lane >> 4, rt = c.wave & 3, kh = c.wave >> 2, n0 = quarter * 64 + rt * 16, n = n0 + fr;
    const int col = (kv == 0 ? C_NKC : C_NVC) + g * 64;
    LDSP float* xch = (LDSP float*)c.lds + (rt * 64 + c.lane) * 17;
    f32x4 acc[4];
#pragma unroll
    for (int et = 0; et < 4; ++et) acc[et] = (f32x4){0.f, 0.f, 0.f, 0.f};
    const bool live = n0 < NCMP_PAD;
    if (live)
    for (int kb = kh * 1024; kb < kh * 1024 + 1024; kb += 128) {
        bf16x8 a[4], bb[4][4];
#pragma unroll
        for (int s4 = 0; s4 < 4; ++s4) { const int kk = kb + s4 * 32 + fq * 8, lrow = kk >> 6, d0 = kk & 63;
            a[s4] = (bf16x8){0, 0, 0, 0, 0, 0, 0, 0};
            if (n < NCMP) a[s4] = *(const bf16x8*)(proj + (size_t)(b * SEQ + 16 * n + lrow) * PROJ_LD + col + d0);
#pragma unroll
            for (int et = 0; et < 4; ++et) bb[s4][et] = *(const bf16x8*)(wct + (size_t)(et * 16 + fr) * 2048 + kk); }
#pragma unroll
        for (int s4 = 0; s4 < 4; ++s4)
#pragma unroll
            for (int et = 0; et < 4; ++et) acc[et] = mfma16(a[s4], bb[s4][et], acc[et]);
    }
    if (kh == 1) {
#pragma unroll
        for (int et = 0; et < 4; ++et)
#pragma unroll
            for (int i = 0; i < 4; ++i) xch[et * 4 + i] = acc[et][i];
    }
    block_sync();
    if (kh == 0 && live) {
        const float* bias = wsp<float>(c, WS_CBIAS) + kv * 64;
        float v[4][4];
#pragma unroll
        for (int et = 0; et < 4; ++et)
#pragma unroll
            for (int i = 0; i < 4; ++i) v[et][i] = acc[et][i] + xch[et * 4 + i] + bias[et * 16 + fr];
        if (kv == 0) {
            const float* kg = CIN(10) + (size_t)l * 3 * 64; bf16_t* kc = wsp<bf16_t>(c, WS_KCMP) + (size_t)(b * 2 + g) * NCMP_PAD * 64;
#pragma unroll
            for (int i = 0; i < 4; ++i) { float ss = 0.f;
#pragma unroll
                for (int et = 0; et < 4; ++et) ss += v[et][i] * v[et][i];
                ss += xorf<1>(ss); ss += xorf<2>(ss); ss += xorf<4>(ss); ss += xorf<8>(ss);
                const float r = fast_rsqrt(ss * (1.0f / 64.0f) + NORM_EPS);
#pragma unroll
                for (int et = 0; et < 4; ++et) kc[(size_t)(n0 + fq * 4 + i) * 64 + et * 16 + fr] = f2bf(v[et][i] * r * kg[et * 16 + fr]); }
        } else {
            bf16_t* vt = wsp<bf16_t>(c, WS_VCMPT) + (size_t)(b * 2 + g) * 64 * NCMP_PAD;
#pragma unroll
            for (int et = 0; et < 4; ++et)
#pragma unroll
                for (int i = 0; i < 4; ++i) vt[(size_t)(et * 16 + fr) * NCMP_PAD + n0 + fq * 4 + i] = f2bf(v[et][i]);
        }
    }
    block_sync();
}

DEV void nsa_vprep_item(const Ctx& c, int item) {
    const int tt = item % NC, r = item / NC, br = r & 1, g = (r >> 1) & 1, b = r >> 2;
    bf16_t* proj = wsp<bf16_t>(c, WS_PROJ); LDSP bf16_t* T = (LDSP bf16_t*)c.lds; const int col = (br == 0 ? C_NVS : C_NVW) + g * 64, tok0 = b * SEQ + tt * 64;
    load_tile_T(c, T, proj, tok0, col);
    block_sync();
    { const int e = c.tid >> 3, t0 = (c.tid & 7) * 8; *(u32x4*)(proj + (size_t)(tok0 + e) * PROJ_LD + col + t0) = *(const LDSP u32x4*)(T + e * LT_STRIDE + t0); }
    block_sync();
}

constexpr int NA_PC = 0, NA_PCLD = 264, NA_BUF = 36864, NA_KLD = 72, NA_VLD = 136, NA_VOFF = 18432, NA_IMP = 73728, NA_SEL = NA_IMP + 16640, NA_GATE = NA_SEL + 512;
constexpr float NEG_BIG = -1.0e30f;

#ifndef HOST_EMU
DEV float fmax_fast(float a, float b) { return __builtin_amdgcn_fmed3f(a, b, __builtin_inff()); }
#else
static inline float fmax_fast(float a, float b) { return a > b ? a : b; }
#endif
constexpr float NEG_HUGE = -3.0e38f;
template <int MODE, bool EDGE>
DEV void nsa_stage(const Ctx& c, int buf, int js, int qt, const bf16x8 (&qr)[2], f32x4 (&ot)[4], float& mrun, float& lrun, unsigned long long selm) {
    const LDSP bf16_t* Kt = (const LDSP bf16_t*)(c.lds + buf * NA_BUF); const LDSP bf16_t* VT = (const LDSP bf16_t*)(c.lds + buf * NA_BUF + NA_VOFF);
    const int fr = c.lane & 15, fq = c.lane >> 4, q = (c.wave & 3) * 16 + fr;
    f32x4 st[8];
#pragma unroll
    for (int kt = 0; kt < 8; ++kt) { st[kt] = (f32x4){0.f, 0.f, 0.f, 0.f};
        st[kt] = mfma16(*(const LDSP bf16x8*)(Kt + (kt * 16 + fr) * NA_KLD + fq * 8), qr[0], st[kt]);
        st[kt] = mfma16(*(const LDSP bf16x8*)(Kt + (kt * 16 + fr) * NA_KLD + 32 + fq * 8), qr[1], st[kt]); }
    if (EDGE) {
#pragma unroll
        for (int kt = 0; kt < 8; ++kt) { const int j = js + (kt >> 2);
#pragma unroll
            for (int i = 0; i < 4; ++i) { const int kk = (kt & 3) * 16 + fq * 4 + i; bool ok;
                if (MODE == 0) ok = (j <= qt) && ((selm >> j) & 1ull) && (j < qt || kk <= q);
                else { const int dlt = (qt - j) * 64 + q - kk; ok = dlt >= 0 && dlt < 512; }
                st[kt][i] = ok ? st[kt][i] : NEG_HUGE; } }
    } else if (MODE == 0) {
        const float b0 = ((selm >> js) & 1ull) ? 0.f : NEG_HUGE, b1 = ((selm >> (js + 1)) & 1ull) ? 0.f : NEG_HUGE;
#pragma unroll
        for (int kt = 0; kt < 8; ++kt) st[kt] += (kt < 4) ? b0 : b1;
    }
    float mx = NEG_HUGE;
#pragma unroll
    for (int kt = 0; kt < 8; ++kt) mx = fmax_fast(mx, fmax_fast(fmax_fast(st[kt][0], st[kt][1]), fmax_fast(st[kt][2], st[kt][3])));
    mx = fmax_fast(mx, xorf<16>(mx)); mx = fmax_fast(mx, xorf<32>(mx));
    const float mn = fmax_fast(mrun, mx), alpha = fast_exp2(mrun - mn); mrun = mn; float ps = 0.f;
#pragma unroll
    for (int kt = 0; kt < 8; ++kt)
#pragma unroll
        for (int i = 0; i < 4; ++i) { const float pv = fast_exp2(st[kt][i] - mn); st[kt][i] = pv; ps += pv; }
    lrun = lrun * alpha + ps;
#pragma unroll
    for (int et = 0; et < 4; ++et) ot[et] *= alpha;
#pragma unroll
    for (int m = 0; m < 4; ++m) {
        const u32x4 pw = {pk2(st[2 * m][0], st[2 * m][1]), pk2(st[2 * m][2], st[2 * m][3]), pk2(st[2 * m + 1][0], st[2 * m + 1][1]), pk2(st[2 * m + 1][2], st[2 * m + 1][3])};
        const bf16x8 pb = __builtin_bit_cast(bf16x8, pw);
#pragma unroll
        for (int et = 0; et < 4; ++et) { const LDSP bf16_t* vrow = VT + (et * 16 + fr) * NA_VLD + 32 * m + 4 * fq;
            const u32x2 v0 = *(const LDSP u32x2*)vrow, v1 = *(const LDSP u32x2*)(vrow + 16);
            const u32x4 vv = {v0.x, v0.y, v1.x, v1.y};
            ot[et] = mfma16(__builtin_bit_cast(bf16x8, vv), pb, ot[et]); }
    }
}

DEV void nsa_attn_unit(const Ctx& c, int l, int unit) {
    const int qt = unit % NSEL, bg = unit / NSEL, g = bg & 1, b = bg >> 1;
    const bf16_t* proj = wsp<bf16_t>(c, WS_PROJ); const bf16_t* ksw = wsp<bf16_t>(c, WS_KSW);
    const float* cosT = wsp<float>(c, WS_ROPE); const float* sinT = cosT + SEQ * 32;
    LDSP bf16_t* Pc = (LDSP bf16_t*)(c.lds + NA_PC); LDSP float* imp = (LDSP float*)(c.lds + NA_IMP); LDSP unsigned long long* selmask = (LDSP unsigned long long*)(c.lds + NA_SEL);
    LDSP float* gates = (LDSP float*)(c.lds + NA_GATE);
    const int fr = c.lane & 15, fq = c.lane >> 4, hg = c.wave >> 2, hd = g * 2 + hg, qw = (c.wave & 3) * 16;
    const int tokq0 = b * SEQ + qt * 64;
    bf16x8 qc[2], qr[2];
    {
        const int tok = tokq0 + qw + fr, pos = qt * 64 + qw + fr;
        const u32x4 v0 = *(const u32x4*)(proj + (size_t)tok * PROJ_LD + C_NQ + hd * 64 + fq * 8), v1 = *(const u32x4*)(proj + (size_t)tok * PROJ_LD + C_NQ + hd * 64 + 32 + fq * 8);
        float x0[8] = {bflo(v0.x), bfhi(v0.x), bflo(v0.y), bfhi(v0.y), bflo(v0.z), bfhi(v0.z), bflo(v0.w), bfhi(v0.w)};
        float x1[8] = {bflo(v1.x), bfhi(v1.x), bflo(v1.y), bfhi(v1.y), bflo(v1.z), bfhi(v1.z), bflo(v1.w), bfhi(v1.w)};
        float ss = 0.f;
#pragma unroll
        for (int j = 0; j < 8; ++j) ss += x0[j] * x0[j] + x1[j] * x1[j];
        ss += xorf<16>(ss); ss += xorf<32>(ss);
        const float r = fast_rsqrt(ss * (1.0f / 64.0f) + NORM_EPS) * 0.125f; const float* qg = CIN(9) + (size_t)l * 64;
#pragma unroll
        for (int j = 0; j < 8; ++j) { const int d = fq * 8 + j; const float y0 = x0[j] * r * qg[d], y1 = x1[j] * r * qg[d + 32];
            const float cs = cosT[pos * 32 + d], sn = sinT[pos * 32 + d];
            qc[0][j] = (short)f2bf(y0); qc[1][j] = (short)f2bf(y1); qr[0][j] = (short)f2bf((y0 * cs - y1 * sn) * 1.44269504f); qr[1][j] = (short)f2bf((y0 * sn + y1 * cs) * 1.44269504f); }
    }
    if (c.tid < 384) { const int row = c.tid / 3, br = c.tid % 3, hh = row >> 6, q = row & 63;
        gates[c.tid] = sigmoidf_(bf2f(proj[(size_t)(tokq0 + q) * PROJ_LD + C_NG + (g * 2 + hh) * 3 + br])); }
    f32x4 ofin[4];
#pragma unroll
    for (int et = 0; et < 4; ++et) ofin[et] = (f32x4){0.f, 0.f, 0.f, 0.f};
    const int nvis = 4 * qt + 3, nkt = (nvis + 15) >> 4, nk32 = ((nkt * 16 + 31) >> 5) << 5;
    {
        const bf16_t* kc = wsp<bf16_t>(c, WS_KCMP) + (size_t)(b * 2 + g) * NCMP_PAD * 64;
        f32x4 s[16];
#pragma unroll
        for (int jt = 0; jt < 16; ++jt) { s[jt] = (f32x4){0.f, 0.f, 0.f, 0.f};
            if (jt < nkt) { s[jt] = mfma16(qc[0], *(const bf16x8*)(kc + (size_t)(jt * 16 + fr) * 64 + fq * 8), s[jt]);
                            s[jt] = mfma16(qc[1], *(const bf16x8*)(kc + (size_t)(jt * 16 + fr) * 64 + 32 + fq * 8), s[jt]); } }
#pragma unroll
        for (int i = 0; i < 4; ++i) {
            const int sp = qt * 64 + qw + fq * 4 + i, lim = (sp >= 31) ? ((sp - 31) >> 4) : -1;
            float mx = NEG_BIG;
#pragma unroll
            for (int jt = 0; jt < 16; ++jt) if (jt < nkt && jt * 16 + fr <= lim) mx = fmaxf(mx, s[jt][i]);
            mx = fmaxf(mx, xorf<1>(mx)); mx = fmaxf(mx, xorf<2>(mx)); mx = fmaxf(mx, xorf<4>(mx)); mx = fmaxf(mx, xorf<8>(mx));
            float ps = 0.f;
#pragma unroll
            for (int jt = 0; jt < 16; ++jt) { float p = 0.f; if (jt < nkt && jt * 16 + fr <= lim) p = fast_exp(s[jt][i] - mx); s[jt][i] = p; ps += p; }
            ps += xorf<1>(ps); ps += xorf<2>(ps); ps += xorf<4>(ps); ps += xorf<8>(ps);
            const float inv = ps > 0.f ? fast_rcp(ps) : 0.f;
            LDSP bf16_t* prow = Pc + (size_t)(hg * 64 + qw + fq * 4 + i) * NA_PCLD;
#pragma unroll
            for (int jt = 0; jt < 16; ++jt) if (jt * 16 < nk32) prow[jt * 16 + fr] = f2bf(s[jt][i] * inv);
        }
        wave_sync();
        const bf16_t* vt = wsp<bf16_t>(c, WS_VCMPT) + (size_t)(b * 2 + g) * 64 * NCMP_PAD;
        f32x4 oc[4];
#pragma unroll
        for (int et = 0; et < 4; ++et) oc[et] = (f32x4){0.f, 0.f, 0.f, 0.f};
        for (int k0 = 0; k0 < nk32; k0 += 32) {
            const bf16x8 pa = *(const LDSP bf16x8*)(Pc + (size_t)(hg * 64 + qw + fr) * NA_PCLD + k0 + fq * 8);
#pragma unroll
            for (int et = 0; et < 4; ++et) oc[et] = mfma16(*(const bf16x8*)(vt + (size_t)(et * 16 + fr) * NCMP_PAD + k0 + fq * 8), pa, oc[et]);
        }
        block_sync();
#pragma unroll
        for (int et = 0; et < 4; ++et) ofin[et] += oc[et] * gates[(hg * 64 + qw + fr) * 3 + 0];
    }
    for (int e = c.tid; e < 4096; e += NTHR) { const int q = e >> 6, j = e & 63; float a = 0.f;
        if (j <= qt) {
#pragma unroll
            for (int dn = -1; dn <= 3; ++dn) { const int n = 4 * j + dn; if (n >= 0 && n < nkt * 16) a += bf2f(Pc[(size_t)q * NA_PCLD + n]) + bf2f(Pc[(size_t)(64 + q) * NA_PCLD + n]); }
            if (j == 0 || j == qt || j == qt - 1) a += 1000.f;
        } else a = NEG_BIG;
        imp[q * 65 + j] = a; }
    block_sync();
    for (int qq = 0; qq < 8; ++qq) { const int q = c.wave * 8 + qq; unsigned long long m = 0ull;
        if (qt < 16) m = (1ull << (qt + 1)) - 1ull;
        else { const unsigned key = (sortkey32(imp[q * 65 + c.lane]) & 0xffffffc0u) | (unsigned)(63 - c.lane); int rank = 0;
#pragma unroll
            for (int i = 0; i < 64; ++i) rank += ((unsigned)bcast_i((int)key, i) > key) ? 1 : 0;
            m = ballot64(rank < 16); }
        if (c.lane == 0) selmask[q] = m; }
    block_sync();
    const unsigned long long selm = selmask[qw + fr];
#pragma unroll
    for (int mode = 0; mode < 2; ++mode) {
        f32x4 ot[4]; float mrun = NEG_BIG, lrun = 0.f;
#pragma unroll
        for (int et = 0; et < 4; ++et) ot[et] = (f32x4){0.f, 0.f, 0.f, 0.f};
        const int j0 = (mode == 0) ? 0 : (qt >= 8 ? qt - 8 : 0), ns = (qt - j0) / 2 + 1;
        const int skey = c.tid >> 2, sd0 = (c.tid & 3) * 16, se = c.tid >> 3, sk0 = (c.tid & 7) * 16;
        u32x4 rk0, rk1, rv0, rv1;
#define NSA_STAGE_LOAD(js_) do { const int jb_ = (js_) + (skey >> 6) > qt ? qt : (js_) + (skey >> 6); const size_t tok_ = (size_t)b * SEQ + jb_ * 64 + (skey & 63); \
            const bf16_t* kp_ = ksw + tok_ * 256 + (mode * 2 + g) * 64 + sd0; rk0 = *(const u32x4*)kp_; rk1 = *(const u32x4*)(kp_ + 8); \
            const int jv_ = (js_) + (sk0 >> 6) > qt ? qt : (js_) + (sk0 >> 6); const bf16_t* vp_ = proj + ((size_t)b * SEQ + jv_ * 64 + se) * PROJ_LD + (mode == 0 ? C_NVS : C_NVW) + g * 64 + (sk0 & 63); rv0 = *(const u32x4*)vp_; rv1 = *(const u32x4*)(vp_ + 8); } while (0)
#define NSA_STAGE_WRITE(buf_) do { LDSP bf16_t* kd_ = (LDSP bf16_t*)(c.lds + (buf_) * NA_BUF) + skey * NA_KLD + sd0; *(LDSP u32x4*)kd_ = rk0; *(LDSP u32x4*)(kd_ + 8) = rk1; \
            LDSP bf16_t* vd_ = (LDSP bf16_t*)(c.lds + (buf_) * NA_BUF + NA_VOFF) + se * NA_VLD + sk0; *(LDSP u32x4*)vd_ = rv0; *(LDSP u32x4*)(vd_ + 8) = rv1; } while (0)
        NSA_STAGE_LOAD(j0); NSA_STAGE_WRITE(0);
        block_sync();
        for (int sidx = 0; sidx < ns; ++sidx) {
            const int js = j0 + 2 * sidx;
            if (sidx + 1 < ns) NSA_STAGE_LOAD(js + 2);
            const bool edge = (mode == 0) ? (js + 1 >= qt) : (sidx == 0 || js + 1 >= qt);
            if (mode == 0) { if (edge) nsa_stage<0, true>(c, sidx & 1, js, qt, qr, ot, mrun, lrun, selm); else nsa_stage<0, false>(c, sidx & 1, js, qt, qr, ot, mrun, lrun, selm); }
            else { if (edge) nsa_stage<1, true>(c, sidx & 1, js, qt, qr, ot, mrun, lrun, selm); else nsa_stage<1, false>(c, sidx & 1, js, qt, qr, ot, mrun, lrun, selm); }
            if (sidx + 1 < ns) NSA_STAGE_WRITE((sidx + 1) & 1);
            block_sync();
        }
#undef NSA_STAGE_LOAD
#undef NSA_STAGE_WRITE
        float ls = lrun; ls += xorf<16>(ls); ls += xorf<32>(ls);
        const float sc = gates[(hg * 64 + qw + fr) * 3 + 1 + mode] * (ls > 0.f ? fast_rcp(ls) : 0.f);
#pragma unroll
        for (int et = 0; et < 4; ++et) ofin[et] += ot[et] * sc;
    }
    bf16_t* out = wsp<bf16_t>(c, WS_OUTS) + (size_t)2 * NT * MW + (size_t)(tokq0 + qw + fr) * MW + hd * 64 + fq * 4;
#pragma unroll
    for (int et = 0; et < 4; ++et) { u32x2 w; w.x = pk2(ofin[et][0], ofin[et][1]); w.y = pk2(ofin[et][2], ofin[et][3]); *(u32x2*)(out + et * 16) = w; }
    block_sync();
}
constexpr int PEER_WSCR = (4 * 256 + 3 * 128) * 4;
constexpr int PEER_X8 = 8 * PEER_WSCR;
constexpr int PEER_TAB = PEER_X8 + 8 * 1024;
#ifndef HOST_EMU
DEV int uniform_i(int v) { return __builtin_amdgcn_readfirstlane(v); }
#else
static inline int uniform_i(int v) { return v; }
#endif
DEV unsigned sortkey16(unsigned b) { return (b & 0x8000u) ? (~b & 0xffffu) : (b | 0x8000u); }
DEV f32x2 dot16_fp8(const f32x2 (&x)[8], const u32x4 q, f32x2 s) {
#pragma unroll
    for (int i = 0; i < 4; ++i) { const f32x2 lo = cvt_pk_f32_fp8(q[i], false), hi = cvt_pk_f32_fp8(q[i], true); s = x[2 * i] * lo + s; s = x[2 * i + 1] * hi + s; }
    return s;
}
DEV void axpy16_fp8(f32x2 (&acc)[8], float w, const u32x4 q) {
    const f32x2 w2 = {w, w};
#pragma unroll
    for (int i = 0; i < 4; ++i) { const f32x2 lo = cvt_pk_f32_fp8(q[i], false), hi = cvt_pk_f32_fp8(q[i], true); acc[2 * i] = w2 * lo + acc[2 * i]; acc[2 * i + 1] = w2 * hi + acc[2 * i + 1]; }
}
DEV f32x2 dot16_fp4(const f32x2 (&x)[8], const u32x2 q, f32x2 s) {
#pragma unroll
    for (int i = 0; i < 2; ++i)
#pragma unroll
        for (int b = 0; b < 4; ++b) s = x[4 * i + b] * cvt_pk_f32_fp4(q[i], b) + s;
    return s;
}
DEV void axpy16_fp4(f32x2 (&acc)[8], float w, const u32x2 q) {
    const f32x2 w2 = {w, w};
#pragma unroll
    for (int i = 0; i < 2; ++i)
#pragma unroll
        for (int b = 0; b < 4; ++b) acc[4 * i + b] = w2 * cvt_pk_f32_fp4(q[i], b) + acc[4 * i + b];
}
DEV void peer_init_tab(const Ctx& c) {
    if (c.tid < 64) { const int t = c.tid; int a, b;
        if (t < 16) { a = 0; b = t; } else if (t < 24) { a = 1; b = t - 16; } else if (t < 29) { a = 2; b = t - 24; } else if (t < 33) { a = 3; b = t - 29; }
        else if (t < 36) { a = 4; b = t - 33; } else if (t < 42) { a = 5 + (t - 36) / 2; b = (t - 36) & 1; } else { a = 8 + (t - 42); b = 0; }
        ((LDSP unsigned char*)(c.lds + PEER_TAB))[t] = (t < 50) ? (unsigned char)((a << 4) | b) : (unsigned char)0xff; }
    block_sync();
}
#ifndef PV_ALIAS
#define PV_ALIAS 0
#endif
DEV void peer_token(const Ctx& c, int l, int tok, bool alias = false) {
    const int lane = c.lane;
    LDSP float* Wv = (LDSP float*)(c.lds + c.wave * PEER_WSCR); LDSP int* Wi = (LDSP int*)(Wv + 256); LDSP float* Sv = (LDSP float*)(Wi + 256); LDSP int* Si = (LDSP int*)(Sv + 256);
    LDSP int* We = Si + 256; LDSP float* Ws = (LDSP float*)(We + 128); LDSP float* Wg = Ws + 128;
    const bf16_t* sc = wsp<bf16_t>(c, WS_SCORES) + (size_t)tok * PEER_N;
#ifndef DUP_TOPK
#define DUP_TOPK 1
#endif
    for (int rep_ = 0; rep_ < DUP_TOPK; ++rep_) {
    {
        unsigned k[32];
        { const int g = lane >> 2, cq = lane & 3; const bf16_t* sp = sc + g * 128 + cq * 32;
#pragma unroll
          for (int v4 = 0; v4 < 4; ++v4) { const u32x4 w = *(const u32x4*)(sp + 8 * v4);
#pragma unroll
            for (int j = 0; j < 4; ++j) { const unsigned d = w[j]; const int i0 = 8 * v4 + 2 * j;
                k[i0] = (sortkey16(d & 0xffffu) << 16) | (unsigned)(127 - (cq * 32 + i0)); k[i0 + 1] = (sortkey16(d >> 16) << 16) | (unsigned)(127 - (cq * 32 + i0 + 1)); } } }
#define PEER_CX(i_, j_) do { const unsigned a_ = k[i_], b_ = k[j_]; k[i_] = a_ > b_ ? a_ : b_; k[j_] = a_ > b_ ? b_ : a_; } while (0)
#pragma unroll
        for (int size = 2; size <= 16; size <<= 1) {
#pragma unroll
            for (int i = 0; i < 32; ++i) { const int j = i ^ (size - 1); if (j > i) PEER_CX(i, j); }
#pragma unroll
            for (int stride = size >> 2; stride > 0; stride >>= 1) {
#pragma unroll
                for (int i = 0; i < 32; ++i) { const int j = i ^ stride; if (j > i) PEER_CX(i, j); } }
        }
#pragma unroll
        for (int i = 0; i < 16; ++i) { const unsigned a_ = k[i], b_ = k[31 - i]; k[i] = a_ > b_ ? a_ : b_; }
#pragma unroll
        for (int stride = 8; stride > 0; stride >>= 1) {
#pragma unroll
            for (int i = 0; i < 16; ++i) { const int j = i ^ stride; if (j > i) PEER_CX(i, j); } }
#pragma unroll
        for (int lvl = 0; lvl < 2; ++lvl) {
            unsigned pk_[16];
#pragma unroll
            for (int i = 0; i < 16; ++i) pk_[i] = (unsigned)(lvl == 0 ? xori<1>((int)k[i]) : xori<2>((int)k[i]));
#pragma unroll
            for (int i = 0; i < 16; ++i) { const unsigned a_ = k[i], b_ = pk_[15 - i]; k[i] = a_ > b_ ? a_ : b_; }
#pragma unroll
            for (int stride = 8; stride > 0; stride >>= 1) {
#pragma unroll
                for (int i = 0; i < 16; ++i) { const int j = i ^ stride; if (j > i) PEER_CX(i, j); } }
        }
#undef PEER_CX
        { const int g = lane >> 2, cq = lane & 3;
#pragma unroll
          for (int cc = 0; cc < 4; ++cc)
#pragma unroll
            for (int j = 0; j < 4; ++j) if (cc == cq) { const unsigned pk = k[4 * cc + j]; const unsigned k16 = pk >> 16, bits = (k16 & 0x8000u) ? (k16 & 0x7fffu) : (~k16 & 0xffffu);
                Sv[g * 16 + 4 * cc + j] = __builtin_bit_cast(float, bits << 16); Si[g * 16 + 4 * cc + j] = 127 - (int)(pk & 0x7fu); } }
    }
    wave_sync();
    {
        const int h = lane >> 3, cq = lane & 7; const LDSP unsigned char* tab = (const LDSP unsigned char*)(c.lds + PEER_TAB);
        unsigned k[16];
#pragma unroll
        for (int j = 0; j < 8; ++j) { const int ci = cq + 8 * j; unsigned key = 0u;
            if (ci < 50) { const unsigned ab = tab[ci]; const int a = (ab >> 4) & 15, b = ab & 15; const float s = Sv[(2 * h) * 16 + a] + Sv[(2 * h + 1) * 16 + b];
                key = (sortkey32(s) & 0xffffff00u) | (unsigned)(255 - (a * 16 + b)); }
            k[j] = key; }
#define PEER_CX(i_, j_) do { const unsigned a_ = k[i_], b_ = k[j_]; k[i_] = a_ > b_ ? a_ : b_; k[j_] = a_ > b_ ? b_ : a_; } while (0)
#pragma unroll
        for (int size = 2; size <= 8; size <<= 1) {
#pragma unroll
            for (int i = 0; i < 8; ++i) { const int j = i ^ (size - 1); if (j > i) PEER_CX(i, j); }
#pragma unroll
            for (int stride = size >> 2; stride > 0; stride >>= 1) {
#pragma unroll
                for (int i = 0; i < 8; ++i) { const int j = i ^ stride; if (j > i) PEER_CX(i, j); } }
        }
#pragma unroll
        for (int i = 0; i < 8; ++i) k[15 - i] = (unsigned)xori<1>((int)k[i]);
#pragma unroll
        for (int stride = 8; stride > 0; stride >>= 1) {
#pragma unroll
            for (int i = 0; i < 16; ++i) { const int j = i ^ stride; if (j > i) PEER_CX(i, j); } }
#pragma unroll
        for (int lvl = 0; lvl < 2; ++lvl) {
            unsigned pk_[16];
#pragma unroll
            for (int i = 0; i < 16; ++i) pk_[i] = (unsigned)(lvl == 0 ? xori<2>((int)k[i]) : xori<4>((int)k[i]));
#pragma unroll
            for (int i = 0; i < 16; ++i) { const unsigned a_ = k[i], b_ = pk_[15 - i]; k[i] = a_ > b_ ? a_ : b_; }
#pragma unroll
            for (int stride = 8; stride > 0; stride >>= 1) {
#pragma unroll
                for (int i = 0; i < 16; ++i) { const int j = i ^ stride; if (j > i) PEER_CX(i, j); } }
        }
#undef PEER_CX
#pragma unroll
        for (int cc = 0; cc < 8; ++cc)
#pragma unroll
            for (int j = 0; j < 2; ++j) if (cc == cq) { const int pos = 255 - (int)(k[2 * cc + j] & 0xffu), a = pos >> 4, b = pos & 15;
                We[h * 16 + 2 * cc + j] = (Si[(2 * h) * 16 + a] * 128 + Si[(2 * h + 1) * 16 + b]) & 16383; Ws[h * 16 + 2 * cc + j] = Sv[(2 * h) * 16 + a] + Sv[(2 * h + 1) * 16 + b]; }
    }
    wave_sync();
    { const float mx = Ws[(lane >> 3) * 16]; const float e0 = fast_exp(Ws[2 * lane] - mx), e1 = fast_exp(Ws[2 * lane + 1] - mx); float sm = e0 + e1;
      sm += xorf<1>(sm); sm += xorf<2>(sm); sm += xorf<4>(sm); const float inv = fast_rcp(sm); Wg[2 * lane] = e0 * inv; Wg[2 * lane + 1] = e1 * inv; }
    wave_sync();
    }
    const bf16_t* xb = wsp<bf16_t>(c, WS_XB) + (size_t)tok * DM; const unsigned char* PU = wsp<unsigned char>(c, WS_PU); const unsigned char* PV = wsp<unsigned char>(c, (PV_ALIAS && alias) ? WS_PU : WS_PV);
    f32x2 xf[8];
    const u32x4 x0 = *(const u32x4*)(xb + 16 * lane), x1 = *(const u32x4*)(xb + 16 * lane + 8);
    { xf[0] = (f32x2){bflo(x0.x), bfhi(x0.x)}; xf[1] = (f32x2){bflo(x0.y), bfhi(x0.y)}; xf[2] = (f32x2){bflo(x0.z), bfhi(x0.z)}; xf[3] = (f32x2){bflo(x0.w), bfhi(x0.w)};
      xf[4] = (f32x2){bflo(x1.x), bfhi(x1.x)}; xf[5] = (f32x2){bflo(x1.y), bfhi(x1.y)}; xf[6] = (f32x2){bflo(x1.z), bfhi(x1.z)}; xf[7] = (f32x2){bflo(x1.w), bfhi(x1.w)}; }
    const float rstd = pg8::rstd_of(pg8::rss_slots16(wsp<float>(c, WS_RSS2) + (size_t)tok * 16)) * (1.0f / 64.0f);
    f32x2 acc[8];
#pragma unroll
    for (int j = 0; j < 8; ++j) acc[j] = (f32x2){0.f, 0.f};
    LDSP unsigned char* X8 = (LDSP unsigned char*)(c.lds + PEER_X8 + c.wave * 1024);
    { u32x4 xq;
      xq.x = cvt_pk_fp8_f32(xf[1][0], xf[1][1], cvt_pk_fp8_f32(xf[0][0], xf[0][1], 0u, false), true); xq.y = cvt_pk_fp8_f32(xf[3][0], xf[3][1], cvt_pk_fp8_f32(xf[2][0], xf[2][1], 0u, false), true);
      xq.z = cvt_pk_fp8_f32(xf[5][0], xf[5][1], cvt_pk_fp8_f32(xf[4][0], xf[4][1], 0u, false), true); xq.w = cvt_pk_fp8_f32(xf[7][0], xf[7][1], cvt_pk_fp8_f32(xf[6][0], xf[6][1], 0u, false), true);
      *(LDSP u32x4*)(X8 + 16 * lane) = xq;
    }
    wave_sync();
#define PEER_LOADV(buf, base) do { _Pragma("unroll") for (int k_ = 0; k_ < 8; ++k_) { const unsigned o_ = ((unsigned)We[(base) + k_] << 9) + 8u * (unsigned)lane; buf[k_] = *(const u32x2*)(PV + o_); } } while (0)
#define PEER_LOADU(buf, hh) do { const unsigned o_ = ((unsigned)We[(hh) * 16 + (lane & 15)] << 9) + 16u * (unsigned)(lane >> 4); _Pragma("unroll") for (int s_ = 0; s_ < 8; ++s_) buf[s_] = *(const u32x4*)(PU + o_ + 64u * s_); } while (0)
    u32x4 ua[8]; u32x2 bv0[8], bv1[8];
    PEER_LOADU(ua, 0); PEER_LOADV(bv0, 0); PEER_LOADV(bv1, 8);
#ifndef HOST_EMU
#define PEER_SCHED_FENCE() __builtin_amdgcn_sched_barrier(0)
#else
#define PEER_SCHED_FENCE() do {} while (0)
#endif
    for (int h = 0; h < 8; ++h) {
        f32x4 dacc = {0.f, 0.f, 0.f, 0.f};
#pragma unroll
        for (int s = 0; s < 8; ++s) { const LDSP unsigned char* xq = X8 + 128 * s + 16 * (lane >> 4);
            dacc = mfma_fp4_fp8(ua[s], *(const LDSP u32x4*)xq, *(const LDSP u32x4*)(xq + 64), dacc); }
        if (h < 7) PEER_LOADU(ua, h + 1);
        const int srcl = 16 * ((lane & 15) >> 2);
        const float d0 = shfl_f(dacc[0], srcl), d1 = shfl_f(dacc[1], srcl), d2 = shfl_f(dacc[2], srcl), d3 = shfl_f(dacc[3], srcl);
        const float dk = (lane & 2) ? ((lane & 1) ? d3 : d2) : ((lane & 1) ? d1 : d0);
        const float wk = Wg[h * 16 + (lane & 15)] * gelu_erf(dk * rstd) * 0.1f;
#pragma unroll
        for (int k = 0; k < 8; ++k) axpy16_fp4(acc, bcast_f(wk, k), bv0[k]);
        PEER_SCHED_FENCE();
        if (h < 7) PEER_LOADV(bv0, h * 16 + 16);
#pragma unroll
        for (int k = 0; k < 8; ++k) axpy16_fp4(acc, bcast_f(wk, 8 + k), bv1[k]);
        PEER_SCHED_FENCE();
        if (h < 7) PEER_LOADV(bv1, h * 16 + 24);
    }
#undef PEER_SCHED_FENCE
#undef PEER_LOADU
#undef PEER_LOADV
    float ss = 0.f; f32x4 o[4];
    o[0] = (f32x4){bflo(x0.x) + acc[0][0], bfhi(x0.x) + acc[0][1], bflo(x0.y) + acc[1][0], bfhi(x0.y) + acc[1][1]};
    o[1] = (f32x4){bflo(x0.z) + acc[2][0], bfhi(x0.z) + acc[2][1], bflo(x0.w) + acc[3][0], bfhi(x0.w) + acc[3][1]};
    o[2] = (f32x4){bflo(x1.x) + acc[4][0], bfhi(x1.x) + acc[4][1], bflo(x1.y) + acc[5][0], bfhi(x1.y) + acc[5][1]};
    o[3] = (f32x4){bflo(x1.z) + acc[6][0], bfhi(x1.z) + acc[6][1], bflo(x1.w) + acc[7][0], bfhi(x1.w) + acc[7][1]};
    if (l + 1 < DEPTH) {
        bf16_t* xo = wsp<bf16_t>(c, WS_XB) + (size_t)tok * DM + 16 * lane;
        u32x4 w0, w1; w0.x = pk2(o[0][0], o[0][1]); w0.y = pk2(o[0][2], o[0][3]); w0.z = pk2(o[1][0], o[1][1]); w0.w = pk2(o[1][2], o[1][3]);
        w1.x = pk2(o[2][0], o[2][1]); w1.y = pk2(o[2][2], o[2][3]); w1.z = pk2(o[3][0], o[3][1]); w1.w = pk2(o[3][2], o[3][3]);
        *(u32x4*)xo = w0; *(u32x4*)(xo + 8) = w1;
#pragma unroll
        for (int j = 0; j < 4; ++j) ss += (o[j][0] * o[j][0] + o[j][1] * o[j][1]) + (o[j][2] * o[j][2] + o[j][3] * o[j][3]);
        ss = wave_sum(ss);
        if (lane == 0) wsp<float>(c, WS_RSS1)[tok] = ss;
    } else {
        float* orow = c.out + (size_t)tok * DM + 16 * lane;
#pragma unroll
        for (int j = 0; j < 4; ++j) *(f32x4*)(orow + 4 * j) = o[j];
    }
    wave_sync();
}
DEV void peer_table_rows(const Ctx& c, int l) {
    const float* g2 = CIN(17) + (size_t)l * DM;
    const f32x4 ga = *((const f32x4*)g2 + 4 * c.lane), gb = *((const f32x4*)g2 + 4 * c.lane + 1), gc = *((const f32x4*)g2 + 4 * c.lane + 2), gd = *((const f32x4*)g2 + 4 * c.lane + 3);
    for (int r = c.bid * NWAVE + c.wave; r < 2 * 16384; r += c.nblk * NWAVE) {
        const int tab = r >> 14, e = r & 16383;
        const f32x4* src = (const f32x4*)((tab == 0 ? CIN(20) : CIN(21)) + ((size_t)l * 16384 + e) * DM) + 4 * c.lane;
        f32x4 v0 = src[0], v1 = src[1], v2 = src[2], v3 = src[3];
        if (tab == 0) { v0 *= ga * 64.0f; v1 *= gb * 64.0f; v2 *= gc * 64.0f; v3 *= gd * 64.0f;
        } else { v0 *= 10.0f; v1 *= 10.0f; v2 *= 10.0f; v3 *= 10.0f; }
        {
            u32x2 q;
            q.x = fp4_code(v0[0]) | (fp4_code(v0[1]) << 4) | (fp4_code(v0[2]) << 8) | (fp4_code(v0[3]) << 12) | (fp4_code(v1[0]) << 16) | (fp4_code(v1[1]) << 20) | (fp4_code(v1[2]) << 24) | (fp4_code(v1[3]) << 28);
            q.y = fp4_code(v2[0]) | (fp4_code(v2[1]) << 4) | (fp4_code(v2[2]) << 8) | (fp4_code(v2[3]) << 12) | (fp4_code(v3[0]) << 16) | (fp4_code(v3[1]) << 20) | (fp4_code(v3[2]) << 24) | (fp4_code(v3[3]) << 28);
            *(u32x2*)(wsp<unsigned char>(c, tab == 0 ? WS_PU : WS_PV) + (size_t)e * (DM / 2) + 8 * c.lane) = q;
        }
    }
}
#ifndef HOST_EMU
#define XB_TMO      128
#define XB_XCNT(j)  (256  + 64 * (j))
#define XB_XSUB(j)  (1280 + 64 * (j))
#define XB_XGEN(j)  (2304 + 64 * (j))
#define XB_TOP      3328
#define XB_TOPGEN   3392
#define XCD_BAR_WORDS 3456
#define XB_SPIN_CAP (1u << 18)

__device__ __forceinline__ unsigned xb_ld(unsigned* p)              { return __hip_atomic_load(p, __ATOMIC_RELAXED, __HIP_MEMORY_SCOPE_AGENT); }
__device__ __forceinline__ unsigned xb_add(unsigned* p, unsigned v) { return __hip_atomic_fetch_add(p, v, __ATOMIC_RELAXED, __HIP_MEMORY_SCOPE_AGENT); }
__device__ __forceinline__ unsigned xb_xcc_id() { return (unsigned)__builtin_amdgcn_s_getreg((3 << 11) | 20) & 0xFu; }
#define XB_SPIN(cond, bar) do { unsigned _sp = 0; while (cond) { __builtin_amdgcn_s_sleep(1); \
    if ((++_sp & 255u) == 0u) { if (xb_ld(&(bar)[XB_TMO])) break; if (_sp > XB_SPIN_CAP) { atomicAdd(&(bar)[XB_TMO], 1u); break; } } } } while (0)

struct XcdBarrier {
    unsigned* bar; unsigned x;
    volatile __attribute__((address_space(3))) unsigned* st;
};

__device__ __forceinline__ XcdBarrier xcd_barrier_post(unsigned* bar, volatile __attribute__((address_space(3))) unsigned* st) {
    XcdBarrier b; b.bar = bar; b.x = xb_xcc_id(); b.st = st;
    if (threadIdx.x == 0) (void)xb_add(&bar[XB_XCNT(b.x)], 1u);
    return b;
}
__device__ __forceinline__ void xcd_barrier_complete(unsigned* bar, unsigned x, unsigned& nloc, unsigned& nx) {
    const unsigned G = gridDim.x * gridDim.y * gridDim.z;
    unsigned sum, cnt, mine, sp = 0u;
    for (;;) {
        sum = 0u; cnt = 0u; mine = 0u;
#pragma unroll
        for (unsigned j = 0; j < 16; ++j) { const unsigned c = xb_ld(&bar[XB_XCNT(j)]); sum += c; cnt += (c > 0u) ? 1u : 0u; mine = (j == x) ? c : mine; }
        if (sum == G) break;
        __builtin_amdgcn_s_sleep(1);
        if ((++sp & 255u) == 0u) { if (xb_ld(&bar[XB_TMO])) break; if (sp > XB_SPIN_CAP) { atomicAdd(&bar[XB_TMO], 1u); break; } }
    }
    nloc = mine > 0u ? mine : 1u; nx = cnt > 0u ? cnt : 1u;
}

__device__ __forceinline__ void xcd_barrier(const XcdBarrier& b) {
    asm volatile("s_waitcnt vmcnt(0)" ::: "memory");
    __syncthreads();
    if (threadIdx.x == 0) {
        unsigned* bar = b.bar;
        __builtin_amdgcn_s_waitcnt(0);
        unsigned nloc = b.st[0], nx = b.st[1];
        if (nloc == 0u) { xcd_barrier_complete(bar, b.x, nloc, nx); b.st[0] = nloc; b.st[1] = nx; }
        const unsigned old = xb_add(&bar[XB_XSUB(b.x)], 1u);
        const unsigned gen = old / nloc;
        if (old + 1u == (gen + 1u) * nloc) {
            __builtin_amdgcn_fence(__ATOMIC_RELEASE, "agent");
            asm volatile("s_waitcnt vmcnt(0)" ::: "memory");
            const unsigned og = xb_add(&bar[XB_TOP], 1u);
            const unsigned tg = og / nx;
            if (og + 1u == (tg + 1u) * nx) xb_add(&bar[XB_TOPGEN], 1u);
            else XB_SPIN(xb_ld(&bar[XB_TOPGEN]) == tg, bar);
            __builtin_amdgcn_fence(__ATOMIC_ACQUIRE, "agent");
            xb_add(&bar[XB_XGEN(b.x)], 1u);
            asm volatile("s_waitcnt vmcnt(0)" ::: "memory");
        } else {
            XB_SPIN(xb_ld(&bar[XB_XGEN(b.x)]) == gen, bar);
            __builtin_amdgcn_fence(__ATOMIC_ACQUIRE, "agent");
            asm volatile("s_waitcnt vmcnt(0)" ::: "memory");
        }
    }
    __syncthreads();
}


#endif
#ifndef EXTRA_K
#define EXTRA_K 0
#endif
#ifndef P0X
#define P0X 31
#endif
#ifndef P2X
#define P2X 15
#endif
#ifndef DBG_COPY
#define DBG_COPY 0
#endif
#ifndef DBG_PHASE
#define DBG_PHASE 5
#endif
#ifndef DUP_NSA
#define DUP_NSA 1
#endif
#ifndef DUP_REC
#define DUP_REC 1
#endif
#ifndef DUP_P5
#define DUP_P5 1
#endif
#ifndef DUP_P2
#define DUP_P2 1
#endif
#ifndef DUP_P0
#define DUP_P0 1
#endif
#ifndef DUP_P1
#define DUP_P1 1
#endif
#ifndef DUP_NP
#define DUP_NP 1
#endif
#ifndef HOST_EMU
#define GRID_SYNC() do { if (ph == 1) cg::this_grid().sync(); else { XcdBarrier xb_; xb_.bar = (unsigned*)(lds_ptr_entry(22) + WS_BARRIER); xb_.x = xb_xcc_id(); \
    xb_.st = (volatile __attribute__((address_space(3))) unsigned*)(smem_raw + LDS_PTRS + 192); xcd_barrier(xb_); } } while (0)
#else
#define GRID_SYNC() grid_sync_impl()
#endif

#ifndef HOST_EMU
DEV unsigned char* lds_ptr_entry(int i) {
    int z; asm volatile("s_mov_b32 %0, 0" : "=s"(z)); i += z;
    const unsigned long long v = ((volatile LDSP unsigned long long*)((LDSP unsigned char*)smem_raw + LDS_PTRS))[i];
    const unsigned lo = __builtin_amdgcn_readfirstlane((unsigned)v), hi = __builtin_amdgcn_readfirstlane((unsigned)(v >> 32));
    return (unsigned char*)(__attribute__((address_space(1))) unsigned char*)(((unsigned long long)hi << 32) | lo);
}
#endif
DEV Ctx make_ctx(const Params& p, int wave0, bool dummy_out = false) {
#ifndef HOST_EMU
    Ctx c; c.out = p.out; c.ws = p.ws; c.tid = wave0 * 64 + fresh_lane();
#else
    Ctx c; c.out = p.out; c.ws = p.ws; c.tid = TID();
#endif
    c.bid = BID(); c.nblk = NBLK(); int z = 0;
#ifndef HOST_EMU
    asm volatile("" : "+v"(c.tid), "+s"(c.bid), "+s"(c.nblk));
    asm volatile("s_mov_b32 %0, 0" : "=s"(z));
    c.ws = lds_ptr_entry(22); c.out = (float*)lds_ptr_entry(23);
#endif
    if (dummy_out) c.out = (float*)(c.ws + WS_PROJ + (size_t)136 * 1024 * 1024);
    c.lds = SMEM_PTR() + z; c.lane = c.tid & 63; c.wave = c.tid >> 6;
#ifndef HOST_EMU
    c.wave = __builtin_amdgcn_readfirstlane(c.wave);
#endif
    return c;
}
#ifndef HOST_EMU
__global__ void __launch_bounds__(NTHR, 2) fwd_kernel(Params p)
#else
void fwd_kernel(Params p)
#endif
{
    {
        LDSP char* lds0 = SMEM_PTR();
        if (TID() == 0) {
#pragma unroll
            for (int i = 0; i < 22; ++i) ((LDSP unsigned long long*)(lds0 + LDS_PTRS))[i] = (unsigned long long)p.in[i];
            ((LDSP unsigned long long*)(lds0 + LDS_PTRS))[22] = (unsigned long long)p.ws; ((LDSP unsigned long long*)(lds0 + LDS_PTRS))[23] = (unsigned long long)p.out;
        }
        block_sync();
    }
#ifndef HOST_EMU
    const int wave0 = __builtin_amdgcn_readfirstlane((int)threadIdx.x >> 6);
#else
    const int wave0 = 0;
#endif
#ifndef HOST_EMU
    volatile __attribute__((address_space(3))) unsigned* xst = (volatile __attribute__((address_space(3))) unsigned*)(smem_raw + LDS_PTRS + 192);
    if (threadIdx.x == 0) { xst[0] = 0u; xst[1] = 0u; }
    __syncthreads();
    (void)xcd_barrier_post((unsigned*)(p.ws + WS_BARRIER), xst);
#endif
    int ph = 0;
#define PHASE_END() do { ++ph; if (DBG_COPY && ph == DBG_PHASE) { GRID_SYNC(); Ctx c = make_ctx(p, wave0); \
        const bf16_t* src = wsp<bf16_t>(c, DBG_COPY == 1 ? WS_OUTS : DBG_COPY == 2 ? WS_ST : DBG_COPY == 3 ? WS_PROJ : DBG_COPY == 4 ? WS_HALO : DBG_COPY >= 6 ? WS_OUTS + (size_t)(DBG_COPY - 6) * NT * MW * 2 : WS_KSW); const size_t nsrc = DBG_COPY >= 6 ? (size_t)NT * MW : DBG_COPY == 2 ? 3 * ST_ONE / 2 : DBG_COPY == 4 ? (size_t)BATCH * NC * 3 * 512 + (size_t)NT * NH * 2 * 2 + (size_t)BATCH * NH * NC * 64 * 2 : (size_t)NT * DM; \
        for (size_t i = (size_t)c.bid * NTHR + c.tid; i < (size_t)NT * DM; i += (size_t)c.nblk * NTHR) c.out[i] = i < nsrc ? bf2f(src[i]) : 0.f; return; } \
        if (ph >= p.phase_hi) return; GRID_SYNC(); if (extra && ph - ph_x0 >= EXTRA_K) return; } while (0)
    int ph_x0 = 0;
    for (int it = 0; it < DEPTH + (EXTRA_K > 0 ? 1 : 0); ++it) {
        const int l = it < DEPTH ? it : 0; const bool extra = it >= DEPTH; if (extra) ph_x0 = ph;
        for (int rep = 0; rep < DUP_P0; ++rep) { Ctx c = make_ctx(p, wave0); p0_prep(c, l, extra ? P0X : 31); }
        PHASE_END();
        for (int rep = 0; rep < DUP_P1; ++rep) {
            Ctx c = make_ctx(p, wave0);
            if (rep == 0 && c.bid == c.nblk - 1 && c.wave == 0) cbias_reduce(c);
            pg8::Gemm g{wsp<bf16_t>(c, WS_XB), wsp<bf16_t>(c, WS_WIN), NT, PROJ_N, DM}; pg8::StaticOrder S; S.init(NT, PROJ_N, c.nblk, c.bid);
            pg8::EpiScaleBf16<1, true> E{wsp<bf16_t>(c, WS_PROJ), PROJ_LD, wsp<float>(c, WS_RSS1), PROJ_LD, wsp<bf16_t>(c, WS_HALO)};
            pg8::gemm_phase<pg8::EpiScaleBf16<1, true>, pg8::StaticOrder, true, true>(GEMM_LDS, g, S, E, c.tid);
        }
        PHASE_END();
        const int p2m = extra ? P2X : 15;
        if (p2m & 1) for (int rep = 0; rep < DUP_P2; ++rep) { Ctx c = make_ctx(p, wave0); for (int u = c.bid; u < 3 * BATCH * NH * NC; u += c.nblk) recur_local_unit(c, l, u); }
        if (p2m & 2) for (int rep = 0; rep < DUP_NP; ++rep) { Ctx c = make_ctx(p, wave0); for (int u = c.bid; u < BATCH * 16; u += c.nblk) nsa_compress_unit(c, l, u); }
        if (p2m & 4) for (int rep = 0; rep < DUP_NP; ++rep) { Ctx c = make_ctx(p, wave0); for (int it = c.bid; it < NT / 32; it += c.nblk) nsa_kprep_item(c, l, it); }
        if (p2m & 8) for (int rep = 0; rep < DUP_NP; ++rep) { Ctx c = make_ctx(p, wave0); for (int it = c.bid; it < BATCH * 4 * NC; it += c.nblk) nsa_vprep_item(c, it); }
        PHASE_END();
        { Ctx c = make_ctx(p, wave0); recur_scan(c); }
        PHASE_END();
        for (int rep = 0; rep < DUP_NSA; ++rep) { Ctx c = make_ctx(p, wave0);
        for (int u = c.bid; u < BATCH * 2 * NSEL; u += c.nblk) {
            const int nbg = BATCH * 2, bg = u % nbg, qi = u / nbg; int qt = qi;
            if (NSEL == 64) { const int r = qi >> 4, ql = qi & 15; qt = (r == 0) ? 63 - ql : (r == 1) ? ql : (r == 2) ? 47 - ql : 16 + ql; }
            nsa_attn_unit(c, l, bg * NSEL + qt);
        } }
        for (int rep = 0; rep < DUP_REC; ++rep) { Ctx c = make_ctx(p, wave0); for (int u = c.bid * NWAVE + c.wave; u < 3 * BATCH * NH * NC; u += c.nblk * NWAVE) recur_out_wave(c, l, u); }
        PHASE_END();
        { Ctx c = make_ctx(p, wave0); peer_table_rows(c, l); }
        for (int rep = 0; rep < DUP_P5; ++rep) {
            { Ctx c = make_ctx(p, wave0); pg8::MixOrder<true> S{(NT / 256) * 4, c.nblk, c.bid, NT / 256};
              pg8::Gemm g{wsp<bf16_t>(c, WS_OUTS), wsp<bf16_t>(c, WS_WUP), 4 * NT, 4 * DM, MW};
              pg8::EpiU E{wsp<bf16_t>(c, WS_UALL)};
              pg8::gemm_phase<pg8::EpiU, pg8::MixOrder<true>, false, true>(GEMM_LDS, g, S, E, c.tid); }
            GRID_SYNC();
            { Ctx c = make_ctx(p, wave0); pg8::MixOrder<false> S{(NT / 256) * 4, c.nblk, c.bid, NT / 256};
              pg8::Gemm g{wsp<bf16_t>(c, WS_XB), wsp<bf16_t>(c, WS_WG), NT, 4 * DM, DM};
              pg8::EpiGate E{wsp<bf16_t>(c, WS_UALL), wsp<bf16_t>(c, WS_MERGED), wsp<float>(c, WS_RSS1), NT};
              pg8::gemm_phase<pg8::EpiGate, pg8::MixOrder<false>, false, true>(GEMM_LDS, g, S, E, c.tid); }
        }
        PHASE_END();
        {
            Ctx c = make_ctx(p, wave0, extra);
            pg8::Gemm g{wsp<bf16_t>(c, WS_MERGED), wsp<bf16_t>(c, WS_WOUT), NT, DM, DM}; pg8::StaticOrder S; S.init(NT, DM, c.nblk, c.bid);
            pg8::EpiOut E{wsp<bf16_t>(c, WS_XB), wsp<float>(c, WS_RSS2)};
            pg8::gemm_phase<pg8::EpiOut, pg8::StaticOrder, true, true>(GEMM_LDS, g, S, E, c.tid);
        }
        PHASE_END();
        {
            Ctx c = make_ctx(p, wave0);
            pg8::Gemm g{wsp<bf16_t>(c, WS_XB), wsp<bf16_t>(c, WS_WQ2), NT, PEER_N, DM}; pg8::StaticOrder S; S.init(NT, PEER_N, c.nblk, c.bid);
            pg8::EpiScaleBf16<16> E{wsp<bf16_t>(c, WS_SCORES), PEER_N, wsp<float>(c, WS_RSS2), PEER_N, nullptr};
            pg8::gemm_phase<pg8::EpiScaleBf16<16>, pg8::StaticOrder, true, true>(GEMM_LDS, g, S, E, c.tid);
        }
        PHASE_END();
        { Ctx c = make_ctx(p, wave0, extra); peer_init_tab(c); for (int t = c.bid * NWAVE + c.wave; t < NT; t += c.nblk * NWAVE) peer_token(c, l, t, extra); }
        PHASE_END();
    }
}

#ifndef HOST_EMU
extern "C" void kernel_launch(void* const* d_in, const int* in_sizes, int n_in, void* d_out, int out_size, void* d_ws, size_t ws_size, hipStream_t stream) {
    static int grid = 0;
    if (grid == 0) {
        if (n_in != 22 || out_size != NT * DM || ws_size < WS_NEED) { fprintf(stderr, "kernel_launch: unexpected shapes (n_in %d out %d ws %zu need %zu)\n", n_in, out_size, ws_size, (size_t)WS_NEED); grid = -1; return; }
        int dev = 0, cus = 0, per_cu = 0;
        hipGetDevice(&dev); hipDeviceGetAttribute(&cus, hipDeviceAttributeMultiprocessorCount, dev);
        if (hipFuncSetAttribute((const void*)fwd_kernel, hipFuncAttributeMaxDynamicSharedMemorySize, LDS_BYTES) != hipSuccess) { fprintf(stderr, "kernel_launch: hipFuncSetAttribute failed\n"); grid = -1; return; }
        if (hipOccupancyMaxActiveBlocksPerMultiprocessor(&per_cu, (const void*)fwd_kernel, NTHR, LDS_BYTES) != hipSuccess || per_cu < 1) { fprintf(stderr, "kernel_launch: occupancy query failed (%d)\n", per_cu); (void)hipGetLastError(); per_cu = 1; }
        grid = cus;
        fprintf(stderr, "kernel_launch: grid %d (per_cu %d)\n", grid, per_cu);
    }
    if (grid < 0) return;
    if (hipMemsetAsync((char*)d_ws + WS_BARRIER, 0, 16384, stream) != hipSuccess) { fprintf(stderr, "kernel_launch: memset failed\n"); return; }
    Params p{};
    for (int i = 0; i < 22; ++i) p.in[i] = (const float*)d_in[i];
    p.out = (float*)d_out; p.ws = (unsigned char*)d_ws; p.phase_lo = 0; p.phase_hi = 1 << 20;
    void* args[] = {&p};
    hipError_t e = hipLaunchCooperativeKernel((const void*)fwd_kernel, dim3(grid), dim3(NTHR), args, LDS_BYTES, stream);
    if (e != hipSuccess) fprintf(stderr, "kernel_launch: cooperative launch failed: %s (grid %d)\n", hipGetErrorString(e), grid);
}
#endif
```

```cpp
#ifndef HOST_EMU
#include <hip/hip_runtime.h>
#include <hip/hip_cooperative_groups.h>
#include <cstdio>
#include <cstdint>
namespace cg = cooperative_groups;
#endif

#ifndef CFG_B
#define CFG_B 8
#endif
#ifndef CFG_S
#define CFG_S 4096
#endif

constexpr int BATCH = CFG_B, SEQ = CFG_S, DM = 1024, DEPTH = 2;
constexpr int NT = BATCH * SEQ;
constexpr int NH = 4, HD = 64, MW = 256, CH = 64, NC = SEQ / CH;
constexpr int N_IN_ORIG = 4116, PROJ_N = 4352, PROJ_LD = 4128;
constexpr int NCMP = (SEQ - 32) / 16 + 1;
constexpr int NCMP_PAD = SEQ / 16;
constexpr int NSEL = SEQ / 64;
constexpr int PEER_N = 2048;
constexpr float NORM_EPS = 1e-6f;
constexpr int NTHR = 512, NWAVE = 8;
constexpr int C_HQ = 0, C_HF = 256, C_HI = 512, C_HG = 768;
constexpr int C_MQ = 1024, C_MK = 1280, C_MV = 1536, C_MO = 1792;
constexpr int C_NQ = 2048, C_NKC = 2304, C_NVC = 2432, C_NKS = 2560, C_NVS = 2688, C_NKW = 2816, C_NVW = 2944;
constexpr int C_RQ = 3072, C_RK = 3328, C_RV = 3584, C_RG = 3840;
constexpr int C_MI = 4096, C_MF = 4100, C_NG = 4104;

typedef unsigned short bf16_t;
#ifndef HOST_EMU
typedef short bf16x8 __attribute__((ext_vector_type(8)));
typedef float f32x4 __attribute__((ext_vector_type(4)));
#endif
typedef unsigned u32x4 __attribute__((ext_vector_type(4)));
typedef unsigned u32x2 __attribute__((ext_vector_type(2)));
typedef float f32x2 __attribute__((ext_vector_type(2)));

constexpr size_t al256(size_t x) { return (x + 255) & ~(size_t)255; }
constexpr size_t WS_WIN = 0;
constexpr size_t WS_WG = WS_WIN + al256((size_t)PROJ_N * DM * 2);
constexpr size_t WS_WUP = WS_WG + al256((size_t)4 * DM * DM * 2);
constexpr size_t WS_WOUT = WS_WUP + al256((size_t)4 * DM * MW * 2);
constexpr size_t WS_WQ2 = WS_WOUT + al256((size_t)DM * DM * 2);
constexpr size_t WS_WCT = WS_WQ2 + al256((size_t)PEER_N * DM * 2);
constexpr size_t WS_CBIAS = WS_WCT + al256((size_t)2 * 64 * 2048 * 2);
constexpr size_t WS_CBPART = WS_CBIAS + 1024;
constexpr size_t WS_ROPE = WS_CBPART + 32768;
constexpr size_t WS_RSS1 = WS_ROPE + al256((size_t)SEQ * 64 * 4);
constexpr size_t WS_RSS2 = WS_RSS1 + al256((size_t)NT * 4);
constexpr size_t WS_XB = WS_RSS2 + al256((size_t)NT * 16 * 4);
constexpr size_t WS_OUTS = WS_XB + al256((size_t)NT * DM * 2);
constexpr size_t WS_ST = WS_OUTS + al256((size_t)NT * DM * 2);
constexpr size_t ST_ONE = (size_t)BATCH * NH * NC * 4096 * 2;
constexpr size_t WS_GDEC = WS_ST + al256(3 * ST_ONE);
constexpr size_t WS_MNL = WS_GDEC + al256((size_t)BATCH * NH * NC * 64 * 4);
constexpr size_t WS_MSC = WS_MNL + al256((size_t)BATCH * NH * NC * 64 * 4);
constexpr size_t WS_KCMP = WS_MSC + al256((size_t)BATCH * NH * NC * 4 * 4);
constexpr size_t WS_VCMPT = WS_KCMP + al256((size_t)BATCH * 2 * NCMP_PAD * 64 * 2);
constexpr size_t WS_KSW = WS_VCMPT + al256((size_t)BATCH * 2 * NCMP_PAD * 64 * 2);
constexpr size_t WS_HALO = WS_KSW + al256((size_t)NT * 256 * 2);
constexpr size_t WS_MTS = WS_HALO + al256((size_t)BATCH * NC * 3 * 512 * 2);
constexpr size_t WS_G31 = WS_MTS + al256((size_t)NT * NH * 2 * 4);
constexpr size_t WS_PROJ = WS_G31 + al256((size_t)BATCH * NH * NC * 64 * 4);
constexpr size_t PROJ_BYTES = al256((size_t)NT * PROJ_LD * 2);
constexpr size_t WS_BARRIER = WS_PROJ + PROJ_BYTES;
constexpr size_t WS_END = WS_BARRIER + 16384;
constexpr size_t WS_UALL = WS_PROJ;
constexpr size_t WS_MERGED = WS_OUTS;
constexpr size_t WS_SCORES = WS_PROJ;
constexpr bool TABLES_IN_ST = 3 * ST_ONE >= (size_t)2 * 16384 * DM;
constexpr size_t WS_PU = TABLES_IN_ST ? WS_ST : WS_END;
constexpr size_t WS_PV = WS_PU + al256((size_t)16384 * DM);
static_assert((size_t)4 * NT * DM * 2 <= PROJ_BYTES, "U fits the proj region");
static_assert(WS_END <= (size_t)536870912, "workspace budget");
constexpr size_t WS_NEED = TABLES_IN_ST ? WS_END : WS_PV + (size_t)16384 * DM;

constexpr int LDS_BYTES = 147456;

struct Params {
    const float* in[22];
    float* out;
    unsigned char* ws;
    int phase_lo, phase_hi;
};

#ifndef HOST_EMU
#define DEV __device__ __forceinline__
#define TID() ((int)threadIdx.x)
#define BID() ((int)blockIdx.x)
#define NBLK() ((int)gridDim.x)
extern __shared__ __attribute__((aligned(16))) unsigned char smem_raw[];
#define LDSP __attribute__((address_space(3)))
#define SMEM_PTR() ((LDSP char*)smem_raw)
DEV void block_sync() { __syncthreads(); }
DEV int fresh_lane() { int lane; asm volatile("v_mbcnt_lo_u32_b32 %0, -1, 0\n\tv_mbcnt_hi_u32_b32 %0, -1, %0" : "=v"(lane)); return lane; }
template <int M> DEV int xori(int v) {
    if constexpr (M < 32) return __builtin_amdgcn_ds_swizzle(v, (M << 10) | 0x1f);
    else return __builtin_amdgcn_ds_bpermute((fresh_lane() ^ M) << 2, v);
}
template <int M> DEV float xorf(float v) { return __builtin_bit_cast(float, xori<M>(__builtin_bit_cast(int, v))); }
DEV int shfl_i(int v, int src) { return __builtin_amdgcn_ds_bpermute(src << 2, v); }
DEV float shfl_f(float v, int src) { return __builtin_bit_cast(float, __builtin_amdgcn_ds_bpermute(src << 2, __builtin_bit_cast(int, v))); }
DEV unsigned long long ballot64(bool p) { return __builtin_amdgcn_ballot_w64(p); }
DEV int mbcnt64(unsigned long long m) { return (int)__builtin_amdgcn_mbcnt_hi((unsigned)(m >> 32), __builtin_amdgcn_mbcnt_lo((unsigned)m, 0u)); }
DEV float bcast_f(float v, int j) { return __builtin_bit_cast(float, __builtin_amdgcn_readlane(__builtin_bit_cast(int, v), j)); }
DEV int bcast_i(int v, int j) { return __builtin_amdgcn_readlane(v, j); }
DEV f32x2 cvt_pk_f32_fp8(unsigned p, bool hi) { return hi ? __builtin_amdgcn_cvt_pk_f32_fp8((int)p, true) : __builtin_amdgcn_cvt_pk_f32_fp8((int)p, false); }
template <int SEL> DEV f32x2 cvt_pk_f32_fp4_(unsigned p) { return __builtin_amdgcn_cvt_scalef32_pk_f32_fp4(p, 1.0f, SEL); }
DEV f32x2 cvt_pk_f32_fp4(unsigned p, int bytesel) { return bytesel == 0 ? cvt_pk_f32_fp4_<0>(p) : bytesel == 1 ? cvt_pk_f32_fp4_<1>(p) : bytesel == 2 ? cvt_pk_f32_fp4_<2>(p) : cvt_pk_f32_fp4_<3>(p); }
DEV unsigned cvt_pk_fp8_f32(float a, float b, unsigned old, bool hi) { return hi ? (unsigned)__builtin_amdgcn_cvt_pk_fp8_f32(a, b, (int)old, true) : (unsigned)__builtin_amdgcn_cvt_pk_fp8_f32(a, b, (int)old, false); }
DEV f32x4 mfma16(bf16x8 a, bf16x8 b, f32x4 c) { return __builtin_amdgcn_mfma_f32_16x16x32_bf16(a, b, c, 0, 0, 0); }
typedef int i32x8 __attribute__((ext_vector_type(8)));
DEV f32x4 mfma_fp4_fp8(u32x4 a, u32x4 b0, u32x4 b1, f32x4 c) {
    const i32x8 av = {(int)a.x, (int)a.y, (int)a.z, (int)a.w, 0, 0, 0, 0}, bv = {(int)b0.x, (int)b0.y, (int)b0.z, (int)b0.w, (int)b1.x, (int)b1.y, (int)b1.z, (int)b1.w};
    return __builtin_amdgcn_mfma_scale_f32_16x16x128_f8f6f4(av, bv, c, 4, 0, 0, 127, 0, 127);
}
DEV void atomic_add_f32(float* p, float v) { atomicAdd(p, v); }
DEV float fast_exp(float x) { return __expf(x); }
DEV float fast_exp2(float x) { return __builtin_amdgcn_exp2f(x); }
DEV float fast_log(float x) { return __logf(x); }
DEV float fast_rcp(float x) { return __builtin_amdgcn_rcpf(x); }
DEV float fast_rsqrt(float x) { return __builtin_amdgcn_rsqf(x); }
#else
#define DEV static inline
#define LDSP
#endif

#ifndef HOST_EMU
DEV void wave_sync() { __builtin_amdgcn_fence(__ATOMIC_ACQ_REL, "wavefront"); __builtin_amdgcn_wave_barrier(); }
#else
static inline void wave_sync() { emu_bar_wait(emu_wave().bar, 64); }
#endif
DEV float bf2f(bf16_t v) { unsigned u = ((unsigned)v) << 16; return __builtin_bit_cast(float, u); }
DEV bf16_t f2bf(float f) { unsigned u = __builtin_bit_cast(unsigned, f); return (bf16_t)((u + 0x7fffu + ((u >> 16) & 1u)) >> 16); }
#ifndef HOST_EMU
typedef __bf16 bf16x2_hw __attribute__((ext_vector_type(2)));
DEV unsigned pk2(float lo, float hi) { const f32x2 v = {lo, hi}; return __builtin_bit_cast(unsigned, __builtin_convertvector(v, bf16x2_hw)); }
#else
DEV unsigned pk2(float lo, float hi) { return (unsigned)f2bf(lo) | ((unsigned)f2bf(hi) << 16); }
#endif
DEV float bflo(unsigned u) { return __builtin_bit_cast(float, u << 16); }
DEV float bfhi(unsigned u) { return __builtin_bit_cast(float, u & 0xffff0000u); }
DEV float sigmoidf_(float x) { return fast_rcp(1.0f + fast_exp(-x)); }
DEV float siluf_(float x) { return x * sigmoidf_(x); }
DEV float log_sigmoidf_(float x) { return fminf(x, 0.f) - log1pf(fast_exp(-fabsf(x))); }
DEV unsigned sortkey32(float f) { const unsigned u = __builtin_bit_cast(unsigned, f); return (u & 0x80000000u) ? ~u : (u | 0x80000000u); }
DEV unsigned fp4_code(float x) {
    const float a = fabsf(x); unsigned c = (a > 0.25f) + (a > 0.75f) + (a > 1.25f) + (a > 1.75f) + (a > 2.5f) + (a > 3.5f) + (a > 5.0f); return c | (x < 0.f ? 8u : 0u);
}
DEV float wave_sum(float v) { v += xorf<1>(v); v += xorf<2>(v); v += xorf<4>(v); v += xorf<8>(v); v += xorf<16>(v); v += xorf<32>(v); return v; }
DEV float wave_max(float v) { v = fmaxf(v, xorf<1>(v)); v = fmaxf(v, xorf<2>(v)); v = fmaxf(v, xorf<4>(v)); v = fmaxf(v, xorf<8>(v)); v = fmaxf(v, xorf<16>(v)); v = fmaxf(v, xorf<32>(v)); return v; }
DEV float gelu_erf(float v) {
    const float av = fabsf(v), t = fast_rcp(1.0f + 0.2316418882f * av);
    float q = t * 0.5307027145f + (-0.7265760135f); q = q * t + 0.7107068705f; q = q * t + (-0.142248368f); q = q * t + 0.127414796f; q = q * t;
    const float e = fast_exp2(v * v * (-0.72134752044f));
    const float m = v * (q * e);
    return v < 0.f ? m : v - m;
}
#ifndef HOST_EMU
#define DEV_M __device__ __forceinline__
#else
#define DEV_M inline
#endif
namespace pg8 {
#define PG8_LAS __attribute__((address_space(3)))
constexpr int BM = 256, BK = 64, HALF = 128, HTB = HALF * BK * 2  , STAGE_BYTES = 8 * HTB, NXCD = 8, WGM = 8;

__host__ __device__ __forceinline__ int lds_byte(int r, int c) { const int st = (r >> 4) * 2 + (c >> 5), rr = r & 15, cc = c & 31, ob = rr * 64 + cc * 2; return st * 1024 + (ob ^ (((ob >> 9) & 1) << 5)); }
__host__ __device__ __forceinline__ void stage_rc(int b, int& R, int& C) { const int st = b / 1024, sb = b % 1024, swz = sb ^ (((sb >> 9) & 1) << 5); R = (st >> 1) * 16 + swz / 64; C = (st & 1) * 32 + (swz % 64) / 2; }
__host__ __device__ __forceinline__ int perm32(int rho) { const int n = rho >> 4, i = rho & 15; return 8 * (i >> 2) + 4 * n + (i & 3); }

struct Unit { int pm, pn; };
struct Gemm { const bf16_t* A; const bf16_t* Bt; int M, N, K; };

struct StaticOrder {
    int nM, nN, nwg, G, c;
    __host__ __device__ void init(int M, int N, int G_, int c_) { nM = M / BM; nN = N / BM; nwg = nM * nN; G = G_; c = c_; }
    __host__ __device__ bool next(int i, Unit& u) const {
        const long L = (long)i * G + c; if (L >= nwg) return false;
        int wgid = (int)L; { const int q = nwg / NXCD, r = nwg % NXCD, xcd = wgid % NXCD, off = wgid / NXCD; wgid = (xcd < r ? xcd * (q + 1) : r * (q + 1) + (xcd - r) * q) + off; }
        const int nig = WGM * nN, gid = wgid / nig, fm = gid * WGM, gsz = (nM - fm) < WGM ? (nM - fm) : WGM;
        u.pm = fm + ((wgid % nig) % gsz); u.pn = (wgid % nig) / gsz; return true;
    }
    DEV_M void a_ready(const Unit&) const {}
    DEV_M void done(const Unit&) const {}
};


#ifndef HOST_EMU
template <class Epi, class Sched, bool ALIGN_EPI = false, bool SP2 = false>
__device__ __forceinline__ void gemm_phase(PG8_LAS unsigned char* lds, const Gemm g, const Sched& S, const Epi& E, const int tid_in) {
    const int tid = tid_in, wid = __builtin_amdgcn_readfirstlane(tid >> 6), lane = tid & 63, wr = wid >> 2, wc = wid & 3, fr = lane & 15, fq = lane >> 4;
    const int K = g.K, nt = K / BK;
    unsigned voffA[2], voffB[2];
#pragma unroll
    for (int i = 0; i < 2; ++i) { int R, C; stage_rc(tid * 16 + i * 8192, R, C); const int Rb = Epi::PERM ? ((R & ~31) + perm32(R & 31)) : R;
        voffA[i] = (unsigned)(R * K + C) * 2u; voffB[i] = (unsigned)(Rb * K + C) * 2u; }
    const size_t kstep = (size_t)(BK * 2);
    const size_t hstep = (size_t)HALF * K * 2;
    const size_t tstep = 2 * hstep;
    const unsigned ldsw = (unsigned)wid * 1024u;
    const int aoff = lds_byte(wr * 64 + fr, fq * 8), boff = lds_byte(wc * 32 + fr, fq * 8);
#define PG8_SA(b, h) (((b) * 2 + (h)) * HTB)
#define PG8_SB(b, h) ((4 + (b) * 2 + (h)) * HTB)
#define PG8_STAGE(bufoff, gbase, voff) do { _Pragma("unroll") for (int _i = 0; _i < 2; ++_i) \
        __builtin_amdgcn_global_load_lds((const unsigned*)((const char*)(gbase) + (voff)[_i]), (PG8_LAS unsigned*)(lds + (bufoff) + ldsw + _i * 8192), 16, 0, 0); } while (0)
#define PG8_LDA(dst, b, h) do { _Pragma("unroll") for (int m = 0; m < 4; ++m) _Pragma("unroll") for (int k = 0; k < 2; ++k) dst[m][k] = *(const PG8_LAS bf16x8*)(lds + PG8_SA(b, h) + aoff + m * 2048 + k * 1024); } while (0)
#define PG8_LDB(dst, b, h) do { _Pragma("unroll") for (int n = 0; n < 2; ++n) _Pragma("unroll") for (int k = 0; k < 2; ++k) dst[n][k] = *(const PG8_LAS bf16x8*)(lds + PG8_SB(b, h) + boff + n * 2048 + k * 1024); } while (0)
#define PG8_MMA(ai, bj, At, Bt) do { __builtin_amdgcn_s_setprio(1); _Pragma("unroll") for (int m = 0; m < 4; ++m) _Pragma("unroll") for (int n = 0; n < 2; ++n) _Pragma("unroll") for (int k = 0; k < 2; ++k) \
        acc[ai][bj][m][n] = __builtin_amdgcn_mfma_f32_16x16x32_bf16(Bt[n][k], At[m][k], acc[ai][bj][m][n], 0, 0, 0); __builtin_amdgcn_s_setprio(0); } while (0)
#define PG8_WAIT_V(n) asm volatile("s_waitcnt vmcnt(" #n ")" ::: "memory")
#define PG8_WAIT_L(n) asm volatile("s_waitcnt lgkmcnt(" #n ")" ::: "memory")
#define PG8_BAR __builtin_amdgcn_s_barrier()
#define PG8_SCHED __builtin_amdgcn_sched_barrier(0)
    Unit cur, nxt; int ui = 0;
    if (!S.next(0, cur)) return;
    f32x4 acc[2][2][4][2];
#pragma unroll
    for (int a = 0; a < 2; ++a)
#pragma unroll
        for (int b = 0; b < 2; ++b)
#pragma unroll
            for (int m = 0; m < 4; ++m)
#pragma unroll
                for (int n = 0; n < 2; ++n) acc[a][b][m][n] = (f32x4){0.f, 0.f, 0.f, 0.f};
    bf16x8 At[4][2], B0[2][2], B1[2][2];
    const char* cA = (const char*)g.A + (size_t)cur.pm * tstep; const char* cB = (const char*)g.Bt + (size_t)cur.pn * tstep;
    S.a_ready(cur);
    if constexpr (SP2) {
        PG8_STAGE(PG8_SB(0, 0), cB, voffB); PG8_STAGE(PG8_SB(0, 1), cB + hstep, voffB); PG8_STAGE(PG8_SA(0, 0), cA, voffA); PG8_STAGE(PG8_SA(0, 1), cA + hstep, voffA);
        if (wr == 1) PG8_BAR;
        PG8_WAIT_V(2); PG8_BAR;
        PG8_STAGE(PG8_SB(1, 0), cB + kstep, voffB); PG8_STAGE(PG8_SA(1, 0), cA + kstep, voffA); PG8_STAGE(PG8_SB(1, 1), cB + hstep + kstep, voffB);
        PG8_WAIT_V(6); PG8_BAR;
    } else {
        PG8_STAGE(PG8_SB(0, 0), cB, voffB); PG8_STAGE(PG8_SA(0, 0), cA, voffA); PG8_STAGE(PG8_SB(0, 1), cB + hstep, voffB); PG8_STAGE(PG8_SA(0, 1), cA + hstep, voffA);
        if (wr == 1) PG8_BAR;
        PG8_WAIT_V(4); PG8_BAR;
        PG8_STAGE(PG8_SB(1, 0), cB + kstep, voffB); PG8_STAGE(PG8_SA(1, 0), cA + kstep, voffA); PG8_STAGE(PG8_SB(1, 1), cB + hstep + kstep, voffB);
        PG8_WAIT_V(6); PG8_BAR;
    }
    for (;;) {
        const bool has_next = S.next(ui + 1, nxt);
        const char* nA = has_next ? (const char*)g.A + (size_t)nxt.pm * tstep : cA; const char* nB = has_next ? (const char*)g.Bt + (size_t)nxt.pn * tstep : cB;
        for (int t = 0; t < nt; t += 2) {
            const bool last = (t == nt - 2);
            const char* a1 = cA + (size_t)(t + 1) * kstep;
            const char* a2 = last ? nA : cA + (size_t)(t + 2) * kstep; const char* b2 = last ? nB : cB + (size_t)(t + 2) * kstep;
            const char* a3 = a2 + kstep; const char* b3 = b2 + kstep;
            if (last && has_next) S.a_ready(nxt);
            if constexpr (SP2) {
            PG8_LDB(B0, 0, 0); PG8_LDB(B1, 0, 1); PG8_SCHED; PG8_LDA(At, 0, 0); PG8_STAGE(PG8_SA(1, 1), a1 + hstep, voffA);
            PG8_WAIT_V(8); PG8_WAIT_L(0); PG8_BAR; PG8_MMA(0, 0, At, B0); PG8_MMA(0, 1, At, B1); PG8_BAR; PG8_SCHED;
            PG8_LDA(At, 0, 1); PG8_STAGE(PG8_SB(0, 0), b2, voffB); PG8_STAGE(PG8_SB(0, 1), b2 + hstep, voffB); PG8_STAGE(PG8_SA(0, 0), a2, voffA);
            PG8_WAIT_V(8); PG8_WAIT_L(0); PG8_BAR; PG8_MMA(1, 0, At, B0); PG8_MMA(1, 1, At, B1); PG8_BAR; PG8_SCHED;
            PG8_LDB(B0, 1, 0); PG8_LDB(B1, 1, 1); PG8_SCHED; PG8_LDA(At, 1, 0); PG8_STAGE(PG8_SA(0, 1), a2 + hstep, voffA);
            PG8_WAIT_V(8); PG8_WAIT_L(0); PG8_BAR; PG8_MMA(0, 0, At, B0); PG8_MMA(0, 1, At, B1); PG8_BAR; PG8_SCHED;
            PG8_LDA(At, 1, 1); PG8_STAGE(PG8_SB(1, 0), b3, voffB); PG8_STAGE(PG8_SB(1, 1), b3 + hstep, voffB); PG8_STAGE(PG8_SA(1, 0), a3, voffA);
            PG8_WAIT_V(8); PG8_WAIT_L(0); PG8_BAR; PG8_MMA(1, 0, At, B0); PG8_MMA(1, 1, At, B1); PG8_BAR; PG8_SCHED;
            } else {
            PG8_LDB(B0, 0, 0); PG8_SCHED; PG8_LDA(At, 0, 0); PG8_STAGE(PG8_SA(1, 1), a1 + hstep, voffA);
            PG8_WAIT_L(8); PG8_BAR; PG8_WAIT_L(0); PG8_MMA(0, 0, At, B0); PG8_BAR; PG8_SCHED;
            PG8_LDB(B1, 0, 1); PG8_STAGE(PG8_SB(0, 0), b2, voffB);
            PG8_BAR; PG8_WAIT_L(0); PG8_MMA(0, 1, At, B1); PG8_BAR;
            PG8_LDA(At, 0, 1); PG8_STAGE(PG8_SA(0, 0), a2, voffA);
            PG8_BAR; PG8_WAIT_L(0); PG8_MMA(1, 0, At, B0); PG8_BAR; PG8_SCHED;
            PG8_STAGE(PG8_SB(0, 1), b2 + hstep, voffB);
            PG8_WAIT_V(6); PG8_BAR; PG8_MMA(1, 1, At, B1); PG8_BAR;
            PG8_LDB(B0, 1, 0); PG8_SCHED; PG8_LDA(At, 1, 0); PG8_STAGE(PG8_SA(0, 1), a2 + hstep, voffA);
            PG8_WAIT_L(8); PG8_BAR; PG8_WAIT_L(0); PG8_MMA(0, 0, At, B0); PG8_BAR; PG8_SCHED;
            PG8_LDB(B1, 1, 1); PG8_STAGE(PG8_SB(1, 0), b3, voffB);
            PG8_BAR; PG8_WAIT_L(0); PG8_MMA(0, 1, At, B1); PG8_BAR;
            PG8_LDA(At, 1, 1); PG8_STAGE(PG8_SA(1, 0), a3, voffA);
            PG8_BAR; PG8_WAIT_L(0); PG8_MMA(1, 0, At, B0); PG8_BAR; PG8_SCHED;
            PG8_STAGE(PG8_SB(1, 1), b3 + hstep, voffB);
            PG8_WAIT_V(6); PG8_BAR; PG8_MMA(1, 1, At, B1); PG8_BAR;
            }
        }
        if constexpr (ALIGN_EPI) { if (wr == 0) PG8_BAR; }
        if constexpr (!Epi::AFTER_DRAIN) { E(acc, cur, wr, wc, fr, fq); S.done(cur); }
        if (!has_next) break;
#pragma unroll
        for (int a = 0; a < 2; ++a)
#pragma unroll
            for (int b = 0; b < 2; ++b)
#pragma unroll
                for (int m = 0; m < 4; ++m)
#pragma unroll
                    for (int n = 0; n < 2; ++n) acc[a][b][m][n] = (f32x4){0.f, 0.f, 0.f, 0.f};
        cur = nxt; cA = nA; cB = nB; ++ui;
        if constexpr (ALIGN_EPI) { if (wr == 1) PG8_BAR; }
    }
    PG8_WAIT_V(0);
    if constexpr (!ALIGN_EPI) { if (wr == 0) PG8_BAR; }
    PG8_BAR;
    if constexpr (Epi::AFTER_DRAIN) { E.fused(acc, cur, wr, wc, fr, fq, lds, wid, lane); S.done(cur); }
#undef PG8_SA
#undef PG8_SB
#undef PG8_STAGE
#undef PG8_LDA
#undef PG8_LDB
#undef PG8_MMA
#undef PG8_WAIT_V
#undef PG8_WAIT_L
#undef PG8_BAR
#undef PG8_SCHED
}
#else
template <class Epi, class Sched, bool ALIGN_EPI = false, bool SP2 = false>
inline void gemm_phase(void* lds, const Gemm g, const Sched& S, const Epi& E, const int tid_in) {
    const int tid = TID(), wid = tid >> 6, lane = tid & 63, wr = wid >> 2, wc = wid & 3, fr = lane & 15, fq = lane >> 4;
    Unit u;
    for (int ui = 0; S.next(ui, u); ++ui) {
        f32x4 acc[2][2][4][2];
        for (int ai = 0; ai < 2; ++ai) for (int bj = 0; bj < 2; ++bj) for (int m = 0; m < 4; ++m) for (int n = 0; n < 2; ++n) for (int j = 0; j < 4; ++j) {
            const int r = 256 * u.pm + 128 * ai + 64 * wr + 16 * m + fr;
            const int c = 256 * u.pn + 128 * bj + 32 * wc + (Epi::PERM ? (8 * fq + 4 * n + j) : (16 * n + 4 * fq + j));
            const bf16_t* a = g.A + (size_t)r * g.K; const bf16_t* b = g.Bt + (size_t)c * g.K;
            float s = 0.f; for (int k = 0; k < g.K; ++k) s += bf2f(a[k]) * bf2f(b[k]);
            acc[ai][bj][m][n][j] = s;
        }
        E(acc, u, wr, wc, fr, fq);
    }
    block_sync();
}
#endif
#ifndef HOST_EMU
#define EPI_LAUNDER(wr, wc, fr, fq) asm volatile("" : "+s"(wr), "+s"(wc), "+v"(fr), "+v"(fq))
#else
#define EPI_LAUNDER(wr, wc, fr, fq) do {} while (0)
#endif
DEV_M float rstd_of(float ss) { return fast_rsqrt(ss * (1.0f / 1024.0f) + NORM_EPS); }

DEV_M float rss_slots16(const float* p) {
    const f32x4 a = *(const f32x4*)p, b = *(const f32x4*)(p + 4), c = *(const f32x4*)(p + 8), d = *(const f32x4*)(p + 12);
    return (((a[0] + a[1]) + (a[2] + a[3])) + ((b[0] + b[1]) + (b[2] + b[3]))) + (((c[0] + c[1]) + (c[2] + c[3])) + ((d[0] + d[1]) + (d[2] + d[3])));
}
template <int SLOTS, bool HALO = false> struct EpiScaleBf16 {
    static constexpr bool PERM = true, AFTER_DRAIN = false;
    bf16_t* O; int ldc; const float* rss; int ncols; bf16_t* halo;
    DEV_M void operator()(const f32x4 (&acc)[2][2][4][2], const Unit& u, int wr, int wc, int fr, int fq) const {
        EPI_LAUNDER(wr, wc, fr, fq);
        const int row0 = u.pm * BM + wr * 64 + fr, col0 = u.pn * BM + wc * 32 + 8 * fq;
        float scv[2][4];
#pragma unroll
        for (int ai = 0; ai < 2; ++ai)
#pragma unroll
            for (int m = 0; m < 4; ++m) { const int row = row0 + ai * HALF + m * 16; scv[ai][m] = SLOTS == 1 ? rss[row] : 0.f; }
#pragma unroll
        for (int ai = 0; ai < 2; ++ai)
#pragma unroll
            for (int m = 0; m < 4; ++m) {
                const int row = row0 + ai * HALF + m * 16; const float sc = rstd_of(SLOTS == 1 ? scv[ai][m] : rss_slots16(rss + (size_t)row * 16));
                bf16_t* rowp = O + (size_t)row * ldc + col0;
#pragma unroll
                for (int bj = 0; bj < 2; ++bj) {
                    if (col0 + bj * HALF < ncols) {
                        const f32x4 v0 = acc[ai][bj][m][0] * sc, v1 = acc[ai][bj][m][1] * sc;
                        u32x4 w; w.x = pk2(v0[0], v0[1]); w.y = pk2(v0[2], v0[3]); w.z = pk2(v1[0], v1[1]); w.w = pk2(v1[2], v1[3]);
                        *(u32x4*)(rowp + bj * HALF) = w;
                        if (HALO) { const int cc = col0 + bj * HALF - C_MQ; if ((row & 63) >= 61 && cc >= 0 && cc < 512) *(u32x4*)(halo + ((size_t)(row >> 6) * 3 + ((row & 63) - 61)) * 512 + cc) = w; }
                    }
                }
            }
    }
};
struct EpiU {
    static constexpr bool PERM = true, AFTER_DRAIN = false;
    bf16_t* uall;
    DEV_M void operator()(const f32x4 (&acc)[2][2][4][2], const Unit& u, int wr, int wc, int fr, int fq) const {
        EPI_LAUNDER(wr, wc, fr, fq);
        bf16_t* base = uall + (size_t)(u.pm * BM + wr * 64 + fr) * DM + (u.pn & 3) * BM + wc * 32 + 8 * fq;
#pragma unroll
        for (int ai = 0; ai < 2; ++ai)
#pragma unroll
            for (int m = 0; m < 4; ++m)
#pragma unroll
                for (int bj = 0; bj < 2; ++bj) {
                    const f32x4 v0 = acc[ai][bj][m][0], v1 = acc[ai][bj][m][1];
                    u32x4 w; w.x = pk2(v0[0], v0[1]); w.y = pk2(v0[2], v0[3]); w.z = pk2(v1[0], v1[1]); w.w = pk2(v1[2], v1[3]);
                    *(u32x4*)(base + (size_t)(ai * HALF + m * 16) * DM + bj * HALF) = w;
                }
    }
};
struct EpiGate {
    static constexpr bool PERM = true, AFTER_DRAIN = false;
    const bf16_t* uall; bf16_t* merged; const float* rss; int nrows;
    DEV_M void operator()(const f32x4 (&acc)[2][2][4][2], const Unit& u, int wr, int wc, int fr, int fq) const {
        EPI_LAUNDER(wr, wc, fr, fq);
        const int mi = u.pn >> 2, pn = u.pn & 3, row0 = u.pm * BM + wr * 64 + fr, col0 = pn * BM + wc * 32 + 8 * fq;
        const bf16_t* ub = uall + ((size_t)mi * nrows + row0) * DM + col0;
#pragma unroll
        for (int ai = 0; ai < 2; ++ai) {
            u32x4 uv[4][2], pv[4][2]; float sc[4];
#pragma unroll
            for (int m = 0; m < 4; ++m) { const int row = row0 + ai * HALF + m * 16; sc[m] = rss[row];
#pragma unroll
                for (int bj = 0; bj < 2; ++bj) { uv[m][bj] = *(const u32x4*)(ub + (size_t)(ai * HALF + m * 16) * DM + bj * HALF);
                    pv[m][bj] = (u32x4){0u, 0u, 0u, 0u}; if (mi != 0) pv[m][bj] = *(const u32x4*)(merged + (size_t)row * DM + col0 + bj * HALF); } }
#pragma unroll
            for (int m = 0; m < 4; ++m) { const int row = row0 + ai * HALF + m * 16; const float s = rstd_of(sc[m]);
#pragma unroll
                for (int bj = 0; bj < 2; ++bj) {
                    const u32x4 u4 = uv[m][bj], p4 = pv[m][bj];
                    const f32x4 a0 = acc[ai][bj][m][0] * s, a1 = acc[ai][bj][m][1] * s;
                    float r[8];
                    r[0] = sigmoidf_(a0[0]) * bflo(u4.x) + bflo(p4.x); r[1] = sigmoidf_(a0[1]) * bfhi(u4.x) + bfhi(p4.x);
                    r[2] = sigmoidf_(a0[2]) * bflo(u4.y) + bflo(p4.y); r[3] = sigmoidf_(a0[3]) * bfhi(u4.y) + bfhi(p4.y);
                    r[4] = sigmoidf_(a1[0]) * bflo(u4.z) + bflo(p4.z); r[5] = sigmoidf_(a1[1]) * bfhi(u4.z) + bfhi(p4.z);
                    r[6] = sigmoidf_(a1[2]) * bflo(u4.w) + bflo(p4.w); r[7] = sigmoidf_(a1[3]) * bfhi(u4.w) + bfhi(p4.w);
                    u32x4 w; w.x = pk2(r[0], r[1]); w.y = pk2(r[2], r[3]); w.z = pk2(r[4], r[5]); w.w = pk2(r[6], r[7]);
                    *(u32x4*)(merged + (size_t)row * DM + col0 + bj * HALF) = w;
                } }
        }
    }
};
struct EpiOut {
    static constexpr bool PERM = true, AFTER_DRAIN = false;
    bf16_t* xb; float* rss;
    DEV_M void operator()(const f32x4 (&acc)[2][2][4][2], const Unit& u, int wr, int wc, int fr, int fq) const {
        EPI_LAUNDER(wr, wc, fr, fq);
        const int row0 = u.pm * BM + wr * 64 + fr, col0 = u.pn * BM + wc * 32 + 8 * fq;
#pragma unroll
        for (int ai = 0; ai < 2; ++ai) {
            u32x4 xr[4][2];
#pragma unroll
            for (int m = 0; m < 4; ++m)
#pragma unroll
                for (int bj = 0; bj < 2; ++bj) xr[m][bj] = *(const u32x4*)(xb + (size_t)(row0 + ai * HALF + m * 16) * DM + col0 + bj * HALF);
#pragma unroll
            for (int m = 0; m < 4; ++m) {
                const int row = row0 + ai * HALF + m * 16; float ss = 0.f;
#pragma unroll
                for (int bj = 0; bj < 2; ++bj) {
                    const u32x4 x4 = xr[m][bj];
                    const f32x4 v0 = acc[ai][bj][m][0] + (f32x4){bflo(x4.x), bfhi(x4.x), bflo(x4.y), bfhi(x4.y)}, v1 = acc[ai][bj][m][1] + (f32x4){bflo(x4.z), bfhi(x4.z), bflo(x4.w), bfhi(x4.w)};
                    u32x4 w; w.x = pk2(v0[0], v0[1]); w.y = pk2(v0[2], v0[3]); w.z = pk2(v1[0], v1[1]); w.w = pk2(v1[2], v1[3]);
                    *(u32x4*)(xb + (size_t)row * DM + col0 + bj * HALF) = w;
                    ss += ((v0[0] * v0[0] + v0[1] * v0[1]) + (v0[2] * v0[2] + v0[3] * v0[3])) + ((v1[0] * v1[0] + v1[1] * v1[1]) + (v1[2] * v1[2] + v1[3] * v1[3]));
                }
                ss += xorf<16>(ss); ss += xorf<32>(ss);
                if (fq == 0) rss[(size_t)row * 16 + u.pn * 4 + wc] = ss;
            }
        }
    }
};
template <bool STACK_A> struct MixOrder {
    int ntiles, G, c, nM;
    DEV_M bool next(int i, Unit& u) const { const long t = (long)(i >> 2) * G + c; if (t >= ntiles) return false; const int m = i & 3;
        u.pm = (int)(t >> 2) + (STACK_A ? m * nM : 0); u.pn = m * 4 + (int)(t & 3); return true; }
    DEV_M void a_ready(const Unit&) const {}
    DEV_M void done(const Unit&) const {}
};
}
#ifndef HOST_EMU
#define GEMM_LDS ((PG8_LAS unsigned char*)smem_raw)
#else
#define GEMM_LDS ((void*)nullptr)
#endif
struct Ctx {
    float* out; unsigned char* ws; LDSP char* lds; int tid, lane, wave, bid, nblk;
};
constexpr int LDS_PTRS = LDS_BYTES - 256;
#ifndef HOST_EMU
DEV const float* inptr(const Ctx& c, int i) { const unsigned long long v = ((volatile LDSP unsigned long long*)(c.lds + LDS_PTRS))[i];
    const unsigned lo = __builtin_amdgcn_readfirstlane((unsigned)v), hi = __builtin_amdgcn_readfirstlane((unsigned)(v >> 32)); return (const float*)(const __attribute__((address_space(1))) float*)(((unsigned long long)hi << 32) | lo); }
#else
static inline const float* inptr(const Ctx& c, int i) { return ((const float* volatile*)(c.lds + LDS_PTRS))[i]; }
#endif
#define CIN(i) inptr(c, (i))
template <class T> DEV T* wsp(const Ctx& c, size_t off) { return (T*)(c.ws + off); }
DEV int orig_col(int n) {
    if (n < 1792) return n;
    if (n < 2048) return 1800 + (n - 1792);
    if (n < 3072) return 2056 + (n - 2048);
    if (n < 4096) return 3092 + (n - 3072);
    if (n < 4104) return 1792 + (n - 4096);
    if (n < 4116) return 3080 + (n - 4104);
    return -1;
}

template <class F> DEV void transpose_wave(const Ctx& c, F src, bf16_t* dst, int ldd, int k0, int n0) {
    LDSP float* tile = (LDSP float*)(c.lds + c.wave * 16640);
#pragma unroll
    for (int kb = 0; kb < 64; kb += 16) {
        float tv[16];
#pragma unroll
        for (int j = 0; j < 16; ++j) tv[j] = src(k0 + kb + j, n0 + c.lane);
#pragma unroll
        for (int j = 0; j < 16; ++j) tile[c.lane * 65 + kb + j] = tv[j];
    }
    wave_sync();
    const int k2 = (c.lane & 31) * 2, nh = c.lane >> 5;
#pragma unroll 8
    for (int j = 0; j < 32; ++j) { const int n = 2 * j + nh; *(unsigned*)(dst + (size_t)(n0 + n) * ldd + k0 + k2) = pk2(tile[n * 65 + k2], tile[n * 65 + k2 + 1]); }
    wave_sync();
}
DEV bf16x8 cvt8(const f32x4 a, const f32x4 b, float s) { const u32x4 w = {pk2(a[0] * s, a[1] * s), pk2(a[2] * s, a[3] * s), pk2(b[0] * s, b[1] * s), pk2(b[2] * s, b[3] * s)}; return __builtin_bit_cast(bf16x8, w); }

DEV void cbias_reduce(const Ctx& c) {
    const float* part = wsp<float>(c, WS_CBPART);
    for (int kv = 0; kv < 2; ++kv) { float s = 0.f;
#pragma unroll 16
        for (int j = 0; j < 64; ++j) s += part[(size_t)(kv * 64 + j) * 64 + c.lane];
        wsp<float>(c, WS_CBIAS)[kv * 64 + c.lane] = s; }
}
DEV void p0_prep(const Ctx& c, int l, int mask = 31) {
    const float* g1 = CIN(1) + (size_t)l * DM;
    const float* g2 = CIN(17) + (size_t)l * DM;
    constexpr int I_IN = (PROJ_N / 64) * 16, I_G = 4 * 16 * 16, I_UP = 4 * 16 * 4, I_OUT = 16 * 16, I_WC = 2 * 32, I_TR = I_IN + I_G + I_UP + I_OUT + I_WC;
    constexpr int I_WQ = 16 * 16 * 8;
    if (mask & 1)
    for (int it = c.bid * NWAVE + c.wave; it < I_TR; it += c.nblk * NWAVE) {
        int r = it;
        if (r < I_IN) {
            const float* w = CIN(2) + (size_t)l * DM * N_IN_ORIG; const int nt = r / 16, kt = r % 16;
            transpose_wave(c, [=](int k, int n) { const int oc = orig_col(n); return oc < 0 ? 0.f : w[(size_t)k * N_IN_ORIG + oc] * g1[k]; }, wsp<bf16_t>(c, WS_WIN), DM, kt * 64, nt * 64);
            continue;
        } r -= I_IN;
        if (r < I_G) {
            const int m = r / 256, nt = (r % 256) / 16, kt = r % 16; const float* w = CIN(15) + ((size_t)l * 4 + m) * DM * DM;
            transpose_wave(c, [=](int k, int n) { return w[(size_t)k * DM + n] * g1[k]; }, wsp<bf16_t>(c, WS_WG) + (size_t)m * DM * DM, DM, kt * 64, nt * 64);
            continue;
        } r -= I_G;
        if (r < I_UP) {
            const int m = r / 64, nt = (r % 64) / 4, kt = r % 4; const float* w = CIN(14) + ((size_t)l * 4 + m) * MW * DM;
            transpose_wave(c, [=](int k, int n) { return w[(size_t)k * DM + n]; }, wsp<bf16_t>(c, WS_WUP) + (size_t)m * DM * MW, MW, kt * 64, nt * 64);
            continue;
        } r -= I_UP;
        if (r < I_OUT) {
            const int nt = r / 16, kt = r % 16; const float* w = CIN(16) + (size_t)l * DM * DM;
            transpose_wave(c, [=](int k, int n) { return w[(size_t)k * DM + n]; }, wsp<bf16_t>(c, WS_WOUT), DM, kt * 64, nt * 64);
            continue;
        } r -= I_OUT;
        {
            const int kv = r / 32, kt = r % 32; const float* w = CIN(12) + ((size_t)l * 2 + kv) * 2048 * 64;
            transpose_wave(c, [=](int k, int n) { return w[(size_t)k * 64 + n]; }, wsp<bf16_t>(c, WS_WCT) + (size_t)kv * 64 * 2048, 2048, kt * 64, 0);
        }
    }
    if (mask & 2)
    for (int it = c.bid * NWAVE + c.wave; it < I_WQ; it += c.nblk * NWAVE) {
        const int keyt = it & 7, kt = (it >> 3) & 15, hp = it >> 7, fr = c.lane & 15, fq = c.lane >> 4;
        const float* keys = CIN(19) + (((size_t)l * 16 + hp) * 128 + keyt * 16 + fr) * 128; const float* wq = CIN(18) + (size_t)l * DM * PEER_N + hp * 128;
        bf16x8 kb[4];
#pragma unroll
        for (int ds = 0; ds < 4; ++ds) kb[ds] = cvt8(*(const f32x4*)(keys + 32 * ds + 8 * fq), *(const f32x4*)(keys + 32 * ds + 8 * fq + 4), 1.0f);
#pragma unroll
        for (int tile = 0; tile < 4; ++tile) { const int k = kt * 64 + tile * 16 + fr; const float gk = g2[k]; const float* wr = wq + (size_t)k * PEER_N;
            f32x4 acc = {0.f, 0.f, 0.f, 0.f};
#pragma unroll
            for (int ds = 0; ds < 4; ++ds) acc = mfma16(cvt8(*(const f32x4*)(wr + 32 * ds + 8 * fq), *(const f32x4*)(wr + 32 * ds + 8 * fq + 4), gk), kb[ds], acc);
            u32x2 w; w.x = pk2(acc[0], acc[1]); w.y = pk2(acc[2], acc[3]);
            *(u32x2*)(wsp<bf16_t>(c, WS_WQ2) + (size_t)(hp * 128 + keyt * 16 + fr) * DM + kt * 64 + tile * 16 + fq * 4) = w; }
    }
    if (mask & 4)
    for (int it = (c.nblk - 1 - c.bid) * NWAVE + c.wave; it < 128; it += c.nblk * NWAVE) {
        const int kv = it >> 6, ch = it & 63;
        const float* w = CIN(12) + (((size_t)l * 2 + kv) * 2048 + ch * 32) * 64 + c.lane; const float pv = (CIN(11) + ((size_t)l * 2 + kv) * 2048 + ch * 32)[c.lane & 31];
        float wv[32];
#pragma unroll
        for (int j = 0; j < 32; ++j) wv[j] = w[j * 64];
        float s = 0.f;
#pragma unroll
        for (int j = 0; j < 32; ++j) s += bcast_f(pv, j) * wv[j];
        wsp<float>(c, WS_CBPART)[(size_t)(kv * 64 + ch) * 64 + c.lane] = s;
    }
    if (l == 0 && (mask & 8)) {
        const float* x = CIN(0); bf16_t* xb = wsp<bf16_t>(c, WS_XB); float* rss = wsp<float>(c, WS_RSS1);
        const int rstride = c.nblk * NWAVE;
        for (int row = c.bid * NWAVE + c.wave; row < NT; row += 4 * rstride) {
            f32x4 v[4][4];
#pragma unroll
            for (int r = 0; r < 4; ++r) { const int rr = row + r * rstride; if (rr < NT) {
#pragma unroll
                for (int j = 0; j < 4; ++j) v[r][j] = ((const f32x4*)(x + (size_t)rr * DM) + c.lane)[64 * j]; } }
#pragma unroll
            for (int r = 0; r < 4; ++r) { const int rr = row + r * rstride; if (rr < NT) {
                u32x2* o = (u32x2*)(xb + (size_t)rr * DM) + c.lane; float s = 0.f;
#pragma unroll
                for (int j = 0; j < 4; ++j) { const f32x4 t = v[r][j]; s += (t[0] * t[0] + t[1] * t[1]) + (t[2] * t[2] + t[3] * t[3]);
                    u32x2 w; w.x = pk2(t[0], t[1]); w.y = pk2(t[2], t[3]); o[64 * j] = w; }
                s = wave_sum(s);
                if (c.lane == 0) rss[rr] = s; } }
        }
    }
    if (l == 0 && (mask & 16)) {
        float* cosT = wsp<float>(c, WS_ROPE); float* sinT = cosT + SEQ * 32;
        for (int i = c.bid * NTHR + c.tid; i < SEQ * 32; i += c.nblk * NTHR) {
            const int pos = i >> 5, fi = i & 31;
            const float inv = exp2f(-(float)fi * 0.41524101186092029f);
            const float a = (float)pos * inv, q = rintf(a * 0.63661977236758134f);
            float rr = fmaf(-q, 1.5703125f, a); rr = fmaf(-q, 4.837512969970703125e-4f, rr); rr = fmaf(-q, 7.54978995489188216e-8f, rr);
            const float r2 = rr * rr;
            const float s = rr * (1.0f + r2 * (-1.0f / 6 + r2 * (1.0f / 120 + r2 * (-1.0f / 5040 + r2 * (1.0f / 362880)))));
            const float cc = 1.0f + r2 * (-0.5f + r2 * (1.0f / 24 + r2 * (-1.0f / 720 + r2 * (1.0f / 40320 + r2 * (-1.0f / 3628800)))));
            const int qi = ((int)q) & 3;
            const float co = qi == 0 ? cc : qi == 1 ? -s : qi == 2 ? -cc : s;
            const float si = qi == 0 ? s : qi == 1 ? cc : qi == 2 ? -s : -cc;
            cosT[i] = co; sinT[i] = si;
        }
    }
}
constexpr int LF_STRIDE = 65, LT_STRIDE = 72;
constexpr int LDS_F0 = 0, LDS_F1 = 16640, LDS_F2 = 33280, LDS_T0 = 49920, LDS_TSZ = 64 * LT_STRIDE * 2, LDS_MISC = LDS_T0 + 6 * LDS_TSZ;
DEV LDSP float* ldsF(const Ctx& c, int i) { return (LDSP float*)(c.lds + LDS_F0 + i * 16640); }
DEV LDSP bf16_t* ldsT(const Ctx& c, int i) { return (LDSP bf16_t*)(c.lds + LDS_T0 + i * LDS_TSZ); }
DEV LDSP float* ldsM(const Ctx& c) { return (LDSP float*)(c.lds + LDS_MISC); }

DEV void load_tile_f32(const Ctx& c, LDSP float* F, const bf16_t* proj, int tok0, int col) {
    const int t = c.tid >> 3, d0 = (c.tid & 7) * 8;
    const u32x4 v = *(const u32x4*)(proj + (size_t)(tok0 + t) * PROJ_LD + col + d0);
    LDSP float* f = F + t * LF_STRIDE + d0;
    f[0] = bflo(v.x); f[1] = bfhi(v.x); f[2] = bflo(v.y); f[3] = bfhi(v.y); f[4] = bflo(v.z); f[5] = bfhi(v.z); f[6] = bflo(v.w); f[7] = bfhi(v.w);
}
DEV void load_tile_T(const Ctx& c, LDSP bf16_t* T, const bf16_t* proj, int tok0, int col) {
    const int t = c.tid >> 3, d0 = (c.tid & 7) * 8;
    const u32x4 v = *(const u32x4*)(proj + (size_t)(tok0 + t) * PROJ_LD + col + d0);
    LDSP bf16_t* p = T + d0 * LT_STRIDE + t;
    p[0] = (bf16_t)(v.x & 0xffff); p[LT_STRIDE] = (bf16_t)(v.x >> 16); p[2 * LT_STRIDE] = (bf16_t)(v.y & 0xffff); p[3 * LT_STRIDE] = (bf16_t)(v.y >> 16);
    p[4 * LT_STRIDE] = (bf16_t)(v.z & 0xffff); p[5 * LT_STRIDE] = (bf16_t)(v.z >> 16); p[6 * LT_STRIDE] = (bf16_t)(v.w & 0xffff); p[7 * LT_STRIDE] = (bf16_t)(v.w >> 16);
}
DEV f32x4 mma_tile(const LDSP bf16_t* A, int lda, int r0, const LDSP bf16_t* B, int ldb, int c0, int K, f32x4 acc, int lane) {
    const int fr = lane & 15, fq = lane >> 4;
    for (int k0 = 0; k0 < K; k0 += 32) {
        const bf16x8 a = *(const LDSP bf16x8*)(A + (r0 + fr) * lda + k0 + fq * 8);
        const bf16x8 b = *(const LDSP bf16x8*)(B + (c0 + fr) * ldb + k0 + fq * 8);
        acc = mfma16(a, b, acc);
    }
    return acc;
}
DEV float wave_scan_add(float v, int lane) {
#pragma unroll
    for (int o = 1; o < 64; o <<= 1) { const float t = shfl_f(v, lane - o); if (lane >= o) v += t; }
    return v;
}
DEV float wave_scan_max(float v, int lane) {
#pragma unroll
    for (int o = 1; o < 64; o <<= 1) { const float t = shfl_f(v, lane - o); if (lane >= o) v = fmaxf(v, t); }
    return v;
}
DEV float hgrn_lb(const Ctx& c, int l, int ch) { if (l == 0) return 0.f; const float* lb = CIN(3); return sigmoidf_(lb[MW + ch] - lb[ch]); }
DEV float ret_loggamma(int h) { return log1pf(-exp2f(-5.0f - (float)h)); }

DEV void hgrn_front(const Ctx& c, int l, const bf16_t* proj, int tok0, int h) {
    LDSP float* F0 = ldsF(c, 0); LDSP float* F1 = ldsF(c, 1);
    load_tile_f32(c, F0, proj, tok0, C_HF + h * 64);
    block_sync();
    for (int e = c.tid; e < 4096; e += NTHR) { const int t = e >> 6, d = e & 63; const float fl = F0[t * LF_STRIDE + d], lbv = hgrn_lb(c, l, h * 64 + d);
        const float sg = sigmoidf_(fl), f = lbv + (1.f - lbv) * sg; F0[t * LF_STRIDE + d] = fast_log(f); F1[t * LF_STRIDE + d] = (1.f - lbv) * (1.f - sg); }
    block_sync();
    for (int k = 0; k < 8; ++k) { const int d = c.wave * 8 + k; F0[c.lane * LF_STRIDE + d] = wave_scan_add(F0[c.lane * LF_STRIDE + d], c.lane); }
    block_sync();
}
DEV void rope_tile(const Ctx& c, LDSP float* F, int pos0, float scale) {
    const float* cosT = wsp<float>(c, WS_ROPE); const float* sinT = cosT + SEQ * 32;
    for (int e = c.tid; e < 2048; e += NTHR) { const int t = e >> 5, d = e & 31; const float cs = cosT[(pos0 + t) * 32 + d], sn = sinT[(pos0 + t) * 32 + d];
        const float x1 = F[t * LF_STRIDE + d], x2 = F[t * LF_STRIDE + d + 32];
        F[t * LF_STRIDE + d] = (x1 * cs - x2 * sn) * scale; F[t * LF_STRIDE + d + 32] = (x1 * sn + x2 * cs) * scale; }
}
constexpr int LDS_RAW = 107520, RAW_SZ = 67 * 65 * 4;
DEV void mlstm_conv_both(const Ctx& c, int l, LDSP float* Fq, LDSP float* Fk, const bf16_t* proj, int tok0, int ck, int cg, int h) {
    const float* cw = CIN(5) + (size_t)l * 4 * 512; const float* cb = CIN(6) + (size_t)l * 512; const bf16_t* halo = wsp<bf16_t>(c, WS_HALO);
    LDSP float* Rq = (LDSP float*)(c.lds + LDS_RAW); LDSP float* Rk = (LDSP float*)(c.lds + LDS_RAW + RAW_SZ);
    const int t = c.tid >> 3, d0 = (c.tid & 7) * 8;
    { const u32x4 vq = *(const u32x4*)(proj + (size_t)(tok0 + t) * PROJ_LD + C_MQ + h * 64 + d0), vk = *(const u32x4*)(proj + (size_t)(tok0 + t) * PROJ_LD + C_MK + h * 64 + d0);
      u32x4 hq = {0u, 0u, 0u, 0u}, hk = {0u, 0u, 0u, 0u};
      if (c.tid < 24 && ck > 0) { hq = *(const u32x4*)(halo + ((size_t)(cg - 1) * 3 + t) * 512 + h * 64 + d0); hk = *(const u32x4*)(halo + ((size_t)(cg - 1) * 3 + t) * 512 + 256 + h * 64 + d0); }
      LDSP float* fq = Rq + (t + 3) * 65 + d0; LDSP float* fk = Rk + (t + 3) * 65 + d0;
      fq[0] = bflo(vq.x); fq[1] = bfhi(vq.x); fq[2] = bflo(vq.y); fq[3] = bfhi(vq.y); fq[4] = bflo(vq.z); fq[5] = bfhi(vq.z); fq[6] = bflo(vq.w); fq[7] = bfhi(vq.w);
      fk[0] = bflo(vk.x); fk[1] = bfhi(vk.x); fk[2] = bflo(vk.y); fk[3] = bfhi(vk.y); fk[4] = bflo(vk.z); fk[5] = bfhi(vk.z); fk[6] = bflo(vk.w); fk[7] = bfhi(vk.w);
      if (c.tid < 24) { LDSP float* gq = Rq + t * 65 + d0; LDSP float* gk = Rk + t * 65 + d0;
        gq[0] = bflo(hq.x); gq[1] = bfhi(hq.x); gq[2] = bflo(hq.y); gq[3] = bfhi(hq.y); gq[4] = bflo(hq.z); gq[5] = bfhi(hq.z); gq[6] = bflo(hq.w); gq[7] = bfhi(hq.w);
        gk[0] = bflo(hk.x); gk[1] = bfhi(hk.x); gk[2] = bflo(hk.y); gk[3] = bfhi(hk.y); gk[4] = bflo(hk.z); gk[5] = bfhi(hk.z); gk[6] = bflo(hk.w); gk[7] = bfhi(hk.w); } }
    block_sync();
#pragma unroll
    for (int half = 0; half < 2; ++half) {
        const int ch = half * 256 + h * 64 + d0; LDSP float* R = half ? Rk : Rq; LDSP float* F = half ? Fk : Fq; const float scale = half ? 0.125f : 1.0f;
        f32x4 s0 = *(const f32x4*)(cb + ch), s1 = *(const f32x4*)(cb + ch + 4);
#pragma unroll
        for (int j = 0; j < 4; ++j) { const f32x4 w0 = *(const f32x4*)(cw + j * 512 + ch), w1 = *(const f32x4*)(cw + j * 512 + ch + 4); const LDSP float* rr = R + (t + j) * 65 + d0;
            s0[0] += w0[0] * rr[0]; s0[1] += w0[1] * rr[1]; s0[2] += w0[2] * rr[2]; s0[3] += w0[3] * rr[3]; s1[0] += w1[0] * rr[4]; s1[1] += w1[1] * rr[5]; s1[2] += w1[2] * rr[6]; s1[3] += w1[3] * rr[7]; }
        LDSP float* f = F + t * LF_STRIDE + d0;
        f[0] = siluf_(s0[0]) * scale; f[1] = siluf_(s0[1]) * scale; f[2] = siluf_(s0[2]) * scale; f[3] = siluf_(s0[3]) * scale;
        f[4] = siluf_(s1[0]) * scale; f[5] = siluf_(s1[1]) * scale; f[6] = siluf_(s1[2]) * scale; f[7] = siluf_(s1[3]) * scale;
    }
}
DEV void mlstm_gates(const Ctx& c, int l, const bf16_t* proj, int tok0, int h) {
    LDSP float* M = ldsM(c); const float* gb = CIN(7) + (size_t)l * 8;
    if (c.tid < 64) { const int t = c.tid; M[t] = bf2f(proj[(size_t)(tok0 + t) * PROJ_LD + C_MI + h]) + gb[h];
        M[64 + t] = log_sigmoidf_(bf2f(proj[(size_t)(tok0 + t) * PROJ_LD + C_MF + h]) + gb[4 + h]); }
    block_sync();
    if (c.wave == 0) M[64 + c.lane] = wave_scan_add(M[64 + c.lane], c.lane);
    block_sync();
}
DEV void store_state_tiles(const Ctx& c, bf16_t* dst, const f32x4 (&acc)[2]) {
    const int fr = c.lane & 15, fq = c.lane >> 4;
#pragma unroll
    for (int k = 0; k < 2; ++k) { const int ti = c.wave * 2 + k, rt = ti >> 2, ct = ti & 3;
#pragma unroll
        for (int i = 0; i < 4; ++i) dst[(rt * 16 + fq * 4 + i) * 64 + ct * 16 + fr] = f2bf(acc[k][i]); }
}
DEV void f32_to_tile(const Ctx& c, LDSP bf16_t* T, const LDSP float* F, bool transpose) {
    for (int e = c.tid; e < 4096; e += NTHR) { const int r = e >> 6, q = e & 63; const bf16_t v = f2bf(F[r * LF_STRIDE + q]); if (transpose) T[q * LT_STRIDE + r] = v; else T[r * LT_STRIDE + q] = v; }
}

DEV void recur_local_unit(const Ctx& c, int l, int unit) {
    const int mixer = unit / (BATCH * NH * NC), r = unit % (BATCH * NH * NC), b = r / (NH * NC), h = (r / NC) % NH, ck = r % NC;
    bf16_t* proj = wsp<bf16_t>(c, WS_PROJ); const int tok0 = b * SEQ + ck * 64, pos0 = ck * 64;
    LDSP float* F0 = ldsF(c, 0); LDSP float* F1 = ldsF(c, 1); LDSP float* F2 = ldsF(c, 2); LDSP float* M = ldsM(c);
    LDSP bf16_t* VT = ldsT(c, 0); LDSP bf16_t* KT = ldsT(c, 1);
    bf16_t* dst = wsp<bf16_t>(c, WS_ST + mixer * ST_ONE) + (size_t)r * 4096;
    const int vt = c.tid >> 3, vd0 = (c.tid & 7) * 8;
    int qcol, kcol, vcol;
    if (mixer == 0) {
        qcol = C_HQ; kcol = C_HF; vcol = C_HI;
        load_tile_T(c, VT, proj, tok0, C_HI + h * 64);
        load_tile_f32(c, F2, proj, tok0, C_HQ + h * 64);
        hgrn_front(c, l, proj, tok0, h);
        float qo[8], ko[8];
#pragma unroll
        for (int j = 0; j < 8; ++j) { const int d = vd0 + j; const float bt = F0[vt * LF_STRIDE + d], bm = F0[31 * LF_STRIDE + d], bl = F0[63 * LF_STRIDE + d], kk = F1[vt * LF_STRIDE + d];
            qo[j] = siluf_(F2[vt * LF_STRIDE + d]) * fast_exp(bt - bm); ko[j] = kk * fast_exp(bm - bt); KT[d * LT_STRIDE + vt] = f2bf(kk * fast_exp(bl - bt)); }
        if (c.tid < 64) { wsp<float>(c, WS_GDEC)[(size_t)r * 64 + c.tid] = fast_exp(F0[63 * LF_STRIDE + c.tid]); wsp<float>(c, WS_G31)[(size_t)r * 64 + c.tid] = fast_exp(F0[31 * LF_STRIDE + c.tid]); }
        u32x4 w; w.x = pk2(qo[0], qo[1]); w.y = pk2(qo[2], qo[3]); w.z = pk2(qo[4], qo[5]); w.w = pk2(qo[6], qo[7]); *(u32x4*)(proj + (size_t)(tok0 + vt) * PROJ_LD + C_HQ + h * 64 + vd0) = w;
        w.x = pk2(ko[0], ko[1]); w.y = pk2(ko[2], ko[3]); w.z = pk2(ko[4], ko[5]); w.w = pk2(ko[6], ko[7]); *(u32x4*)(proj + (size_t)(tok0 + vt) * PROJ_LD + C_HF + h * 64 + vd0) = w;
    } else if (mixer == 2) {
        qcol = C_RQ; kcol = C_RK; vcol = C_RV;
        load_tile_T(c, VT, proj, tok0, C_RV + h * 64);
        load_tile_f32(c, F0, proj, tok0, C_RK + h * 64); load_tile_f32(c, F2, proj, tok0, C_RQ + h * 64);
        block_sync();
        rope_tile(c, F0, pos0, 0.125f); rope_tile(c, F2, pos0, 1.0f);
        block_sync();
        const float lg = ret_loggamma(h), gq = fast_exp(lg * (float)(vt - 31)), gk = fast_exp(lg * (float)(31 - vt)), gl = fast_exp(lg * (float)(63 - vt));
        float qo[8], ko[8];
#pragma unroll
        for (int j = 0; j < 8; ++j) { const int d = vd0 + j; const float kk = F0[vt * LF_STRIDE + d]; qo[j] = F2[vt * LF_STRIDE + d] * gq; ko[j] = kk * gk; KT[d * LT_STRIDE + vt] = f2bf(kk * gl); }
        u32x4 w; w.x = pk2(qo[0], qo[1]); w.y = pk2(qo[2], qo[3]); w.z = pk2(qo[4], qo[5]); w.w = pk2(qo[6], qo[7]); *(u32x4*)(proj + (size_t)(tok0 + vt) * PROJ_LD + C_RQ + h * 64 + vd0) = w;
        w.x = pk2(ko[0], ko[1]); w.y = pk2(ko[2], ko[3]); w.z = pk2(ko[4], ko[5]); w.w = pk2(ko[6], ko[7]); *(u32x4*)(proj + (size_t)(tok0 + vt) * PROJ_LD + C_RK + h * 64 + vd0) = w;
    } else {
        qcol = C_MQ; kcol = C_MK; vcol = C_MV;
        load_tile_T(c, VT, proj, tok0, C_MV + h * 64);
        mlstm_gates(c, l, proj, tok0, h);
        mlstm_conv_both(c, l, F2, F0, proj, tok0, ck, b * NC + ck, h);
        if (c.wave == 0) { const int t = c.lane; const float bl = M[127], bt = M[64 + t], li = M[t];
            const float a = wave_max(bl - bt + li); const float pm = wave_scan_max(li - bt, t);
            M[128 + t] = pm; if (t == 0) { M[192] = a; M[193] = bl; }
            float* mts = wsp<float>(c, WS_MTS) + ((size_t)(tok0 + t) * NH + h) * 2; mts[0] = bt; mts[1] = bt + pm; }
        block_sync();
        const float eq = fast_exp(-M[128 + vt]), ek = fast_exp(M[vt] - M[64 + vt]), wk = fast_exp(M[193] - M[64 + vt] + M[vt] - M[192]);
        float qo[8], ko[8];
#pragma unroll
        for (int j = 0; j < 8; ++j) { const int d = vd0 + j; const float kk = F0[vt * LF_STRIDE + d]; qo[j] = F2[vt * LF_STRIDE + d] * eq; ko[j] = kk * ek;
            const float kh = kk * wk; F1[vt * LF_STRIDE + d] = kh; KT[d * LT_STRIDE + vt] = f2bf(kh); }
        block_sync();
        u32x4 w; w.x = pk2(qo[0], qo[1]); w.y = pk2(qo[2], qo[3]); w.z = pk2(qo[4], qo[5]); w.w = pk2(qo[6], qo[7]); *(u32x4*)(proj + (size_t)(tok0 + vt) * PROJ_LD + C_MQ + h * 64 + vd0) = w;
        w.x = pk2(ko[0], ko[1]); w.y = pk2(ko[2], ko[3]); w.z = pk2(ko[4], ko[5]); w.w = pk2(ko[6], ko[7]); *(u32x4*)(proj + (size_t)(tok0 + vt) * PROJ_LD + C_MK + h * 64 + vd0) = w;
        if (c.tid < 64) { float s = 0.f; for (int t = 0; t < 64; ++t) s += F1[t * LF_STRIDE + c.tid]; wsp<float>(c, WS_MNL)[(size_t)r * 64 + c.tid] = s; }
        if (c.tid == 64) { float* sc = wsp<float>(c, WS_MSC) + (size_t)r * 4; sc[0] = M[192]; sc[1] = M[193]; }
    }
    block_sync();
    f32x4 acc[2];
#pragma unroll
    for (int k = 0; k < 2; ++k) { const int ti = c.wave * 2 + k; acc[k] = (f32x4){0.f, 0.f, 0.f, 0.f}; acc[k] = mma_tile(VT, LT_STRIDE, (ti >> 2) * 16, KT, LT_STRIDE, (ti & 3) * 16, 64, acc[k], c.lane); }
    store_state_tiles(c, dst, acc);
    *(u32x4*)(proj + (size_t)(tok0 + vt) * PROJ_LD + vcol + h * 64 + vd0) = *(const LDSP u32x4*)(VT + vt * LT_STRIDE + vd0);
    (void)qcol; (void)kcol;
    block_sync();
}

DEV void recur_scan(const Ctx& c) {
    constexpr int ncol2 = BATCH * NH * 2048;
    constexpr int KB = (NC < 16) ? NC : 16;
    for (int i = c.bid * NTHR + c.tid; i < 3 * ncol2 + BATCH * NH * 64; i += c.nblk * NTHR) {
        if (i < 3 * ncol2) {
            const int mixer = i / ncol2, col = (i % ncol2) * 2, bh = col >> 12, ed = col & 4095, d = ed & 63, h = bh % NH;
            bf16_t* p = wsp<bf16_t>(c, WS_ST + mixer * ST_ONE) + (size_t)bh * NC * 4096 + ed;
            const float* g = wsp<float>(c, WS_GDEC) + (size_t)bh * NC * 64 + d; const float* g31 = wsp<float>(c, WS_G31) + (size_t)bh * NC * 64 + d; const float* sc = wsp<float>(c, WS_MSC) + (size_t)bh * NC * 4;
            const float gr = fast_exp(ret_loggamma(h) * 64.f), gr32 = fast_exp(ret_loggamma(h) * 32.f);
            float s0 = 0.f, s1 = 0.f, m = 0.f;
            for (int kb = 0; kb < NC; kb += KB) {
                unsigned tv[KB]; f32x2 gv[KB]; f32x2 av[KB]; f32x2 hv[KB];
#pragma unroll
                for (int j = 0; j < KB; ++j) { tv[j] = *(const unsigned*)(p + (size_t)(kb + j) * 4096);
                    if (mixer == 0) { gv[j] = *(const f32x2*)(g + (kb + j) * 64); hv[j] = *(const f32x2*)(g31 + (kb + j) * 64); } else if (mixer == 1) av[j] = *(const f32x2*)(sc + (kb + j) * 4); }
#pragma unroll
                for (int j = 0; j < KB; ++j) {
                    const float t0 = bflo(tv[j]), t1 = bfhi(tv[j]);
                    if (mixer == 0) { *(unsigned*)(p + (size_t)(kb + j) * 4096) = pk2(s0 * hv[j][0], s1 * hv[j][1]); s0 = gv[j][0] * s0 + t0; s1 = gv[j][1] * s1 + t1; }
                    else if (mixer == 2) { *(unsigned*)(p + (size_t)(kb + j) * 4096) = pk2(s0 * gr32, s1 * gr32); s0 = gr * s0 + t0; s1 = gr * s1 + t1; }
                    else { *(unsigned*)(p + (size_t)(kb + j) * 4096) = pk2(s0, s1);
                        const float a = av[j][0], bl = av[j][1], mn = fmaxf(bl + m, a), ds = fast_exp(bl + m - mn), dl = fast_exp(a - mn); s0 = ds * s0 + dl * t0; s1 = ds * s1 + dl * t1; m = mn; }
                }
            }
        } else {
            const int j = i - 3 * ncol2, bh = j >> 6, d = j & 63;
            float* p = wsp<float>(c, WS_MNL) + (size_t)bh * NC * 64 + d; float* sc = wsp<float>(c, WS_MSC) + (size_t)bh * NC * 4; float m = 0.f, s = 0.f;
            for (int k = 0; k < NC; ++k) { const float a = sc[k * 4], bl = sc[k * 4 + 1], mn = fmaxf(bl + m, a);
                const float t = p[k * 64]; p[k * 64] = s; if (d == 0) sc[k * 4 + 2] = m; s = fast_exp(bl + m - mn) * s + fast_exp(a - mn) * t; m = mn; }
        }
    }
}

DEV void recur_out_wave(const Ctx& c, int l, int unit) {
    const int mixer = unit / (BATCH * NH * NC), r = unit % (BATCH * NH * NC), b = r / (NH * NC), h = (r / NC) % NH, ck = r % NC;
    const bf16_t* proj = wsp<bf16_t>(c, WS_PROJ); const int tok0 = b * SEQ + ck * 64;
    const bf16_t* st = wsp<bf16_t>(c, WS_ST + mixer * ST_ONE) + (size_t)r * 4096;
    const int fr = c.lane & 15, fq = c.lane >> 4;
    const int qcol = (mixer == 0 ? C_HQ : mixer == 1 ? C_MQ : C_RQ) + h * 64, kcol = (mixer == 0 ? C_HF : mixer == 1 ? C_MK : C_RK) + h * 64;
    const int vcol = (mixer == 0 ? C_HI : mixer == 1 ? C_MV : C_RV) + h * 64, gcol = (mixer == 0 ? C_HG : mixer == 1 ? C_MO : C_RG) + h * 64;
    const float* onorm = (mixer == 0 ? CIN(4) : mixer == 1 ? CIN(8) : CIN(13)) + (size_t)l * MW + h * 64;
    bf16x8 ka[4][2], va[4][2], sa[4][2];
#pragma unroll
    for (int sq = 0; sq < 4; ++sq)
#pragma unroll
        for (int ks = 0; ks < 2; ++ks) {
            ka[sq][ks] = *(const bf16x8*)(proj + (size_t)(tok0 + 16 * sq + fr) * PROJ_LD + kcol + 32 * ks + 8 * fq);
            sa[sq][ks] = *(const bf16x8*)(st + (16 * sq + fr) * 64 + 32 * ks + 8 * fq);
            const bf16_t* vp = proj + (size_t)(tok0 + 16 * sq + fr) * PROJ_LD + vcol + 32 * ks + 4 * fq;
            const u32x2 v0 = *(const u32x2*)vp, v1 = *(const u32x2*)(vp + 16); const u32x4 vv = {v0.x, v0.y, v1.x, v1.y}; va[sq][ks] = __builtin_bit_cast(bf16x8, vv);
        }
    bf16x8 sn[2], vones; float mst = 0.f;
    if (mixer == 1) {
        const float* nst = wsp<float>(c, WS_MNL) + (size_t)r * 64; mst = wsp<float>(c, WS_MSC)[(size_t)r * 4 + 2];
#pragma unroll
        for (int ks = 0; ks < 2; ++ks) { const f32x4 n0 = *(const f32x4*)(nst + 32 * ks + 8 * fq), n1 = *(const f32x4*)(nst + 32 * ks + 8 * fq + 4);
            u32x4 w = {pk2(n0[0], n0[1]), pk2(n0[2], n0[3]), pk2(n1[0], n1[1]), pk2(n1[2], n1[3])}; if (fr != 0) w = (u32x4){0u, 0u, 0u, 0u}; sn[ks] = __builtin_bit_cast(bf16x8, w); }
        const unsigned one2 = (fr == 0) ? 0x3f803f80u : 0u; const u32x4 ow = {one2, one2, one2, one2}; vones = __builtin_bit_cast(bf16x8, ow);
    }
#pragma unroll
    for (int tq = 0; tq < 4; ++tq) {
        const int tok = tok0 + 16 * tq + fr;
        bf16x8 qb[2];
#pragma unroll
        for (int ks = 0; ks < 2; ++ks) qb[ks] = *(const bf16x8*)(proj + (size_t)tok * PROJ_LD + qcol + 32 * ks + 8 * fq);
        f32x4 stt[4];
#pragma unroll
        for (int sq = 0; sq < 4; ++sq) { stt[sq] = (f32x4){0.f, 0.f, 0.f, 0.f};
            if (sq <= tq) { stt[sq] = mfma16(ka[sq][0], qb[0], stt[sq]); stt[sq] = mfma16(ka[sq][1], qb[1], stt[sq]); } }
#pragma unroll
        for (int i = 0; i < 4; ++i) if (4 * fq + i > fr) stt[tq][i] = 0.f;
        f32x4 ot[4], os[4], o5 = {0.f, 0.f, 0.f, 0.f}, s5 = {0.f, 0.f, 0.f, 0.f};
#pragma unroll
        for (int eq = 0; eq < 4; ++eq) { ot[eq] = (f32x4){0.f, 0.f, 0.f, 0.f}; os[eq] = (f32x4){0.f, 0.f, 0.f, 0.f}; }
#pragma unroll
        for (int m = 0; m < 2; ++m) if (2 * m <= tq) {
            const u32x4 pw = {pk2(stt[2 * m][0], stt[2 * m][1]), pk2(stt[2 * m][2], stt[2 * m][3]), pk2(stt[2 * m + 1][0], stt[2 * m + 1][1]), pk2(stt[2 * m + 1][2], stt[2 * m + 1][3])};
            const bf16x8 pb = __builtin_bit_cast(bf16x8, pw);
#pragma unroll
            for (int eq = 0; eq < 4; ++eq) ot[eq] = mfma16(va[eq][m], pb, ot[eq]);
            if (mixer == 1) o5 = mfma16(vones, pb, o5);
        }
        if (mixer != 1) {
#pragma unroll
            for (int eq = 0; eq < 4; ++eq) { ot[eq] = mfma16(sa[eq][0], qb[0], ot[eq]); ot[eq] = mfma16(sa[eq][1], qb[1], ot[eq]); }
        } else {
#pragma unroll
            for (int eq = 0; eq < 4; ++eq) { os[eq] = mfma16(sa[eq][0], qb[0], os[eq]); os[eq] = mfma16(sa[eq][1], qb[1], os[eq]); }
            s5 = mfma16(sn[0], qb[0], s5); s5 = mfma16(sn[1], qb[1], s5);
            const float* mts = wsp<float>(c, WS_MTS) + ((size_t)tok * NH + h) * 2; const float bt = mts[0], ml = mts[1];
            const float inter = bt + mst, mt = fmaxf(inter, ml), rt = fast_exp(ml - mt), stc = fast_exp(mst + ml - mt);
            const float den = shfl_f(rt * o5[0] + stc * s5[0], fr);
            const float inv = fast_rcp(fmaxf(fabsf(den), fast_exp(-mt)));
#pragma unroll
            for (int eq = 0; eq < 4; ++eq) ot[eq] = (ot[eq] * rt + os[eq] * stc) * inv;
        }
        float ss = 0.f;
#pragma unroll
        for (int eq = 0; eq < 4; ++eq) ss += (ot[eq][0] * ot[eq][0] + ot[eq][1] * ot[eq][1]) + (ot[eq][2] * ot[eq][2] + ot[eq][3] * ot[eq][3]);
        ss += xorf<16>(ss); ss += xorf<32>(ss);
        const float rn = fast_rsqrt(ss * (1.0f / 64.0f) + NORM_EPS);
        bf16_t* out = wsp<bf16_t>(c, WS_OUTS) + (size_t)(mixer == 0 ? 0 : mixer == 1 ? 1 : 3) * NT * MW + (size_t)tok * MW + h * 64 + 4 * fq;
#pragma unroll
        for (int eq = 0; eq < 4; ++eq) { const u32x2 gv = *(const u32x2*)(proj + (size_t)tok * PROJ_LD + gcol + 16 * eq + 4 * fq); const f32x4 on = *(const f32x4*)(onorm + 16 * eq + 4 * fq);
            const float g0 = bflo(gv.x), g1 = bfhi(gv.x), g2 = bflo(gv.y), g3 = bfhi(gv.y);
            const float a0 = ot[eq][0] * rn * on[0] * (mixer == 1 ? sigmoidf_(g0) : siluf_(g0)), a1 = ot[eq][1] * rn * on[1] * (mixer == 1 ? sigmoidf_(g1) : siluf_(g1));
            const float a2 = ot[eq][2] * rn * on[2] * (mixer == 1 ? sigmoidf_(g2) : siluf_(g2)), a3 = ot[eq][3] * rn * on[3] * (mixer == 1 ? sigmoidf_(g3) : siluf_(g3));
            u32x2 w; w.x = pk2(a0, a1); w.y = pk2(a2, a3); *(u32x2*)(out + 16 * eq) = w; }
    }
}

DEV void nsa_kprep_item(const Ctx& c, int l, int item) {
    const bf16_t* proj = wsp<bf16_t>(c, WS_PROJ); bf16_t* ksw = wsp<bf16_t>(c, WS_KSW);
    const float* cosT = wsp<float>(c, WS_ROPE); const float* sinT = cosT + SEQ * 32;
    const int tok = item * 32 + (c.tid >> 4), vec = (c.tid >> 2) & 3, br = vec >> 1, g = vec & 1, d0 = (c.tid & 3) * 8;
    const int col = (br == 0 ? C_NKS : C_NKW) + g * 64;
    const u32x4 a = *(const u32x4*)(proj + (size_t)tok * PROJ_LD + col + d0), b2 = *(const u32x4*)(proj + (size_t)tok * PROJ_LD + col + 32 + d0);
    const float x1[8] = {bflo(a.x), bfhi(a.x), bflo(a.y), bfhi(a.y), bflo(a.z), bfhi(a.z), bflo(a.w), bfhi(a.w)};
    const float x2[8] = {bflo(b2.x), bfhi(b2.x), bflo(b2.y), bfhi(b2.y), bflo(b2.z), bfhi(b2.z), bflo(b2.w), bfhi(b2.w)};
    float ss = 0.f;
#pragma unroll
    for (int j = 0; j < 8; ++j) ss += x1[j] * x1[j] + x2[j] * x2[j];
    ss += xorf<1>(ss); ss += xorf<2>(ss);
    const float r = fast_rsqrt(ss * (1.0f / 64.0f) + NORM_EPS); const float* kg = CIN(10) + ((size_t)l * 3 + 1 + br) * 64; const int pos = tok % SEQ;
    float o1[8], o2[8];
#pragma unroll
    for (int j = 0; j < 8; ++j) { const int d = d0 + j; const float y1 = x1[j] * r * kg[d], y2 = x2[j] * r * kg[d + 32], cs = cosT[pos * 32 + d], sn = sinT[pos * 32 + d];
        o1[j] = y1 * cs - y2 * sn; o2[j] = y1 * sn + y2 * cs; }
    bf16_t* o = ksw + (size_t)tok * 256 + vec * 64 + d0;
    u32x4 w; w.x = pk2(o1[0], o1[1]); w.y = pk2(o1[2], o1[3]); w.z = pk2(o1[4], o1[5]); w.w = pk2(o1[6], o1[7]); *(u32x4*)o = w;
    w.x = pk2(o2[0], o2[1]); w.y = pk2(o2[2], o2[3]); w.z = pk2(o2[4], o2[5]); w.w = pk2(o2[6], o2[7]); *(u32x4*)(o + 32) = w;
}
DEV void nsa_compress_unit(const Ctx& c, int l, int unit) {
    const int quarter = unit & 3, kv = (unit >> 2) & 1, g = (unit >> 3) & 1, b = unit >> 4;
    const bf16_t* proj = wsp<bf16_t>(c, WS_PROJ); const bf16_t* wct = wsp<bf16_t>(c, WS_WCT) + (size_t)kv * 64 * 2048;
    const int fr = c.lane & 15, fq = c.lane >> 4, rt = c.wave & 3, kh = c.wave >> 2, n0 = quarter * 64 + rt * 16, n = n0 + fr;
    const int col = (kv == 0 ? C_NKC : C_NVC) + g * 64;
    LDSP float* xch = (LDSP float*)c.lds + (rt * 64 + c.lane) * 17;
    f32x4 acc[4];
#pragma unroll
    for (int et = 0; et < 4; ++et) acc[et] = (f32x4){0.f, 0.f, 0.f, 0.f};
    const bool live = n0 < NCMP_PAD;
    if (live)
    for (int kb = kh * 1024; kb < kh * 1024 + 1024; kb += 128) {
        bf16x8 a[4], bb[4][4];
#pragma unroll
        for (int s4 = 0; s4 < 4; ++s4) { const int kk = kb + s4 * 32 + fq * 8, lrow = kk >> 6, d0 = kk & 63;
            a[s4] = (bf16x8){0, 0, 0, 0, 0, 0, 0, 0};
            if (n < NCMP) a[s4] = *(const bf16x8*)(proj + (size_t)(b * SEQ + 16 * n + lrow) * PROJ_LD + col + d0);
#pragma unroll
            for (int et = 0; et < 4; ++et) bb[s4][et] = *(const bf16x8*)(wct + (size_t)(et * 16 + fr) * 2048 + kk); }
#pragma unroll
        for (int s4 = 0; s4 < 4; ++s4)
#pragma unroll
            for (int et = 0; et < 4; ++et) acc[et] = mfma16(a[s4], bb[s4][et], acc[et]);
    }
    if (kh == 1) {
#pragma unroll
        for (int et = 0; et < 4; ++et)
#pragma unroll
            for (int i = 0; i < 4; ++i) xch[et * 4 + i] = acc[et][i];
    }
    block_sync();
    if (kh == 0 && live) {
        const float* bias = wsp<float>(c, WS_CBIAS) + kv * 64;
        float v[4][4];
#pragma unroll
        for (int et = 0; et < 4; ++et)
#pragma unroll
            for (int i = 0; i < 4; ++i) v[et][i] = acc[et][i] + xch[et * 4 + i] + bias[et * 16 + fr];
        if (kv == 0) {
            const float* kg = CIN(10) + (size_t)l * 3 * 64; bf16_t* kc = wsp<bf16_t>(c, WS_KCMP) + (size_t)(b * 2 + g) * NCMP_PAD * 64;
#pragma unroll
            for (int i = 0; i < 4; ++i) { float ss = 0.f;
#pragma unroll
                for (int et = 0; et < 4; ++et) ss += v[et][i] * v[et][i];
                ss += xorf<1>(ss); ss += xorf<2>(ss); ss += xorf<4>(ss); ss += xorf<8>(ss);
                const float r = fast_rsqrt(ss * (1.0f / 64.0f) + NORM_EPS);
#pragma unroll
                for (int et = 0; et < 4; ++et) kc[(size_t)(n0 + fq * 4 + i) * 64 + et * 16 + fr] = f2bf(v[et][i] * r * kg[et * 16 + fr]); }
        } else {
            bf16_t* vt = wsp<bf16_t>(c, WS_VCMPT) + (size_t)(b * 2 + g) * 64 * NCMP_PAD;
#pragma unroll
            for (int et = 0; et < 4; ++et)
#pragma unroll
                for (int i = 0; i < 4; ++i) vt[(size_t)(et * 16 + fr) * NCMP_PAD + n0 + fq * 4 + i] = f2bf(v[et][i]);
        }
    }
    block_sync();
}

DEV void nsa_vprep_item(const Ctx& c, int item) {
    const int tt = item % NC, r = item / NC, br = r & 1, g = (r >> 1) & 1, b = r >> 2;
    bf16_t* proj = wsp<bf16_t>(c, WS_PROJ); LDSP bf16_t* T = (LDSP bf16_t*)c.lds; const int col = (br == 0 ? C_NVS : C_NVW) + g * 64, tok0 = b * SEQ + tt * 64;
    load_tile_T(c, T, proj, tok0, col);
    block_sync();
    { const int e = c.tid >> 3, t0 = (c.tid & 7) * 8, k0 = (t0 & 32) + ((t0 >> 3) & 3) * 4; const u32x2 lo = *(const LDSP u32x2*)(T + e * LT_STRIDE + k0), hi = *(const LDSP u32x2*)(T + e * LT_STRIDE + k0 + 16);
      *(u32x4*)(proj + (size_t)(tok0 + e) * PROJ_LD + col + t0) = (u32x4){lo.x, lo.y, hi.x, hi.y}; }
    block_sync();
}

constexpr int NA_PC = 0, NA_PCLD = 272, NA_KLD = 80, NA_VLD = 144, NA_VOFF = 128 * NA_KLD * 2, NA_BUF = NA_VOFF + 64 * NA_VLD * 2, NA_IMP = 2 * NA_BUF, NA_SEL = NA_IMP + 16640, NA_GATE = NA_SEL + 512;
static_assert(128 * NA_PCLD * 2 <= NA_IMP && NA_GATE + 2048 <= LDS_PTRS, "NSA LDS layout");
constexpr float NEG_BIG = -1.0e30f;

#ifndef HOST_EMU
DEV float fmax_fast(float a, float b) { return __builtin_amdgcn_fmed3f(a, b, __builtin_inff()); }
#else
static inline float fmax_fast(float a, float b) { return a > b ? a : b; }
#endif
constexpr float NEG_HUGE = -3.0e38f;
template <int MODE, bool EDGE, bool FAST>
DEV void nsa_stage(const Ctx& c, int buf, int js, int qt, const bf16x8 (&qr)[2], f32x4 (&ot)[5], float& mrun, float& lrun, unsigned long long selm) {
    const LDSP bf16_t* Kt = (const LDSP bf16_t*)(c.lds + buf * NA_BUF); const LDSP bf16_t* VT = (const LDSP bf16_t*)(c.lds + buf * NA_BUF + NA_VOFF);
    const int fr = c.lane & 15, fq = c.lane >> 4, q = (c.wave & 3) * 16 + fr;
    f32x4 st[8];
    if (FAST && !EDGE && MODE == 0) {
        const float b0 = ((selm >> js) & 1ull) ? 0.f : NEG_HUGE, b1 = ((selm >> (js + 1)) & 1ull) ? 0.f : NEG_HUGE;
        const f32x4 bq0 = {b0, b0, b0, b0}, bq1 = {b1, b1, b1, b1};
#pragma unroll
        for (int kt = 0; kt < 8; ++kt) { st[kt] = mfma16(*(const LDSP bf16x8*)(Kt + (kt * 16 + fr) * NA_KLD + fq * 8), qr[0], kt < 4 ? bq0 : bq1);
            st[kt] = mfma16(*(const LDSP bf16x8*)(Kt + (kt * 16 + fr) * NA_KLD + 32 + fq * 8), qr[1], st[kt]); }
    } else {
#pragma unroll
    for (int kt = 0; kt < 8; ++kt) { st[kt] = (f32x4){0.f, 0.f, 0.f, 0.f};
        st[kt] = mfma16(*(const LDSP bf16x8*)(Kt + (kt * 16 + fr) * NA_KLD + fq * 8), qr[0], st[kt]);
        st[kt] = mfma16(*(const LDSP bf16x8*)(Kt + (kt * 16 + fr) * NA_KLD + 32 + fq * 8), qr[1], st[kt]); }
    }
    if (EDGE) {
#pragma unroll
        for (int kt = 0; kt < 8; ++kt) { const int j = js + (kt >> 2);
#pragma unroll
            for (int i = 0; i < 4; ++i) { const int kk = (kt & 3) * 16 + fq * 4 + i; bool ok;
                if (MODE == 0) ok = (j <= qt) && ((selm >> j) & 1ull) && (j < qt || kk <= q);
                else { const int dlt = (qt - j) * 64 + q - kk; ok = dlt >= 0 && dlt < 512; }
                st[kt][i] = ok ? st[kt][i] : NEG_HUGE; } }
    } else if (MODE == 0 && !FAST) {
        const float b0 = ((selm >> js) & 1ull) ? 0.f : NEG_HUGE, b1 = ((selm >> (js + 1)) & 1ull) ? 0.f : NEG_HUGE;
#pragma unroll
        for (int kt = 0; kt < 8; ++kt) st[kt] += (kt < 4) ? b0 : b1;
    }
    if (FAST) {
#pragma unroll
        for (int kt = 0; kt < 8; ++kt)
#pragma unroll
            for (int i = 0; i < 4; ++i) st[kt][i] = fast_exp2(st[kt][i]);
    } else {
    float mx = NEG_HUGE;
#pragma unroll
    for (int kt = 0; kt < 8; ++kt) mx = fmax_fast(mx, fmax_fast(fmax_fast(st[kt][0], st[kt][1]), fmax_fast(st[kt][2], st[kt][3])));
    mx = fmax_fast(mx, xorf<16>(mx)); mx = fmax_fast(mx, xorf<32>(mx));
    const float mn = fmax_fast(mrun, mx), alpha = fast_exp2(mrun - mn); mrun = mn; float ps = 0.f;
#pragma unroll
    for (int kt = 0; kt < 8; ++kt)
#pragma unroll
        for (int i = 0; i < 4; ++i) { const float pv = fast_exp2(st[kt][i] - mn); st[kt][i] = pv; ps += pv; }
    lrun = lrun * alpha + ps;
#pragma unroll
    for (int et = 0; et < 4; ++et) ot[et] *= alpha;
    }
    const unsigned onew = (fr == 0) ? 0x3f803f80u : 0u; const u32x4 ones4 = {onew, onew, onew, onew};
#pragma unroll
    for (int m = 0; m < 4; ++m) {
        const u32x4 pw = {pk2(st[2 * m][0], st[2 * m][1]), pk2(st[2 * m][2], st[2 * m][3]), pk2(st[2 * m + 1][0], st[2 * m + 1][1]), pk2(st[2 * m + 1][2], st[2 * m + 1][3])};
        const bf16x8 pb = __builtin_bit_cast(bf16x8, pw);
#pragma unroll
        for (int et = 0; et < 4; ++et) ot[et] = mfma16(*(const LDSP bf16x8*)(VT + (et * 16 + fr) * NA_VLD + 32 * m + 8 * fq), pb, ot[et]);
        if (FAST) ot[4] = mfma16(__builtin_bit_cast(bf16x8, ones4), pb, ot[4]);
    }
}

#ifndef NSA_X
#define NSA_X 0
#endif
DEV void nsa_attn_unit(const Ctx& c, int l, int unit, int xm = 0) {
    const int qt = unit % NSEL, bg = unit / NSEL, g = bg & 1, b = bg >> 1;
    const bf16_t* proj = wsp<bf16_t>(c, WS_PROJ); const bf16_t* ksw = wsp<bf16_t>(c, WS_KSW);
    const float* cosT = wsp<float>(c, WS_ROPE); const float* sinT = cosT + SEQ * 32;
    LDSP bf16_t* Pc = (LDSP bf16_t*)(c.lds + NA_PC); LDSP float* imp = (LDSP float*)(c.lds + NA_IMP); LDSP unsigned long long* selmask = (LDSP unsigned long long*)(c.lds + NA_SEL);
    LDSP float* gates = (LDSP float*)(c.lds + NA_GATE);
    const int fr = c.lane & 15, fq = c.lane >> 4, hg = c.wave >> 2, hd = g * 2 + hg, qw = (c.wave & 3) * 16;
    const int tokq0 = b * SEQ + qt * 64;
    bf16x8 qc[2], qr[2];
    {
        const int tok = tokq0 + qw + fr, pos = qt * 64 + qw + fr;
        const u32x4 v0 = *(const u32x4*)(proj + (size_t)tok * PROJ_LD + C_NQ + hd * 64 + fq * 8), v1 = *(const u32x4*)(proj + (size_t)tok * PROJ_LD + C_NQ + hd * 64 + 32 + fq * 8);
        float x0[8] = {bflo(v0.x), bfhi(v0.x), bflo(v0.y), bfhi(v0.y), bflo(v0.z), bfhi(v0.z), bflo(v0.w), bfhi(v0.w)};
        float x1[8] = {bflo(v1.x), bfhi(v1.x), bflo(v1.y), bfhi(v1.y), bflo(v1.z), bfhi(v1.z), bflo(v1.w), bfhi(v1.w)};
        float ss = 0.f;
#pragma unroll
        for (int j = 0; j < 8; ++j) ss += x0[j] * x0[j] + x1[j] * x1[j];
        ss += xorf<16>(ss); ss += xorf<32>(ss);
        const float r = fast_rsqrt(ss * (1.0f / 64.0f) + NORM_EPS) * 0.125f; const float* qg = CIN(9) + (size_t)l * 64;
#pragma unroll
        for (int j = 0; j < 8; ++j) { const int d = fq * 8 + j; const float y0 = x0[j] * r * qg[d], y1 = x1[j] * r * qg[d + 32];
            const float cs = cosT[pos * 32 + d], sn = sinT[pos * 32 + d];
            qc[0][j] = (short)f2bf(y0); qc[1][j] = (short)f2bf(y1); qr[0][j] = (short)f2bf((y0 * cs - y1 * sn) * 1.44269504f); qr[1][j] = (short)f2bf((y0 * sn + y1 * cs) * 1.44269504f); }
    }
    bool fastp;
    { const float* qg = CIN(9) + (size_t)l * 64; const float* kg = CIN(10) + ((size_t)l * 3 + 1) * 64;
      float gq = fabsf(qg[c.lane]), gk = fmaxf(fabsf(kg[c.lane]), fabsf(kg[64 + c.lane]));
      gq = wave_max(gq); gk = wave_max(gk);
      fastp = ballot64(11.6f * gq * gk <= 96.0f) != 0ull; }
    if (c.tid < 384) { const int row = c.tid / 3, br = c.tid % 3, hh = row >> 6, q = row & 63;
        gates[c.tid] = sigmoidf_(bf2f(proj[(size_t)(tokq0 + q) * PROJ_LD + C_NG + (g * 2 + hh) * 3 + br])); }
    f32x4 ofin[4];
#pragma unroll
    for (int et = 0; et < 4; ++et) ofin[et] = (f32x4){0.f, 0.f, 0.f, 0.f};
    const int nvis = 4 * qt + 3, nkt = (nvis + 15) >> 4, nk32 = ((nkt * 16 + 31) >> 5) << 5;
    if (!(xm & 8)) {
        const bf16_t* kc = wsp<bf16_t>(c, WS_KCMP) + (size_t)(b * 2 + g) * NCMP_PAD * 64;
        f32x4 s[16];
#pragma unroll
        for (int jt = 0; jt < 16; ++jt) { s[jt] = (f32x4){0.f, 0.f, 0.f, 0.f};
            if (jt < nkt) { s[jt] = mfma16(qc[0], *(const bf16x8*)(kc + (size_t)(jt * 16 + fr) * 64 + fq * 8), s[jt]);
                            s[jt] = mfma16(qc[1], *(const bf16x8*)(kc + (size_t)(jt * 16 + fr) * 64 + 32 + fq * 8), s[jt]); } }
#pragma unroll
        for (int i = 0; i < 4; ++i) {
            const int sp = qt * 64 + qw + fq * 4 + i, lim = (sp >= 31) ? ((sp - 31) >> 4) : -1;
            float mx = NEG_BIG;
#pragma unroll
            for (int jt = 0; jt < 16; ++jt) if (jt < nkt && jt * 16 + fr <= lim) mx = fmaxf(mx, s[jt][i]);
            mx = fmaxf(mx, xorf<1>(mx)); mx = fmaxf(mx, xorf<2>(mx)); mx = fmaxf(mx, xorf<4>(mx)); mx = fmaxf(mx, xorf<8>(mx));
            float ps = 0.f;
#pragma unroll
            for (int jt = 0; jt < 16; ++jt) { float p = 0.f; if (jt < nkt && jt * 16 + fr <= lim) p = fast_exp(s[jt][i] - mx); s[jt][i] = p; ps += p; }
            ps += xorf<1>(ps); ps += xorf<2>(ps); ps += xorf<4>(ps); ps += xorf<8>(ps);
            const float inv = ps > 0.f ? fast_rcp(ps) : 0.f;
            LDSP bf16_t* prow = Pc + (size_t)(hg * 64 + qw + fq * 4 + i) * NA_PCLD;
#pragma unroll
            for (int jt = 0; jt < 16; ++jt) if (jt * 16 < nk32) prow[jt * 16 + fr] = f2bf(s[jt][i] * inv);
        }
        wave_sync();
        const bf16_t* vt = wsp<bf16_t>(c, WS_VCMPT) + (size_t)(b * 2 + g) * 64 * NCMP_PAD;
        f32x4 oc[4];
#pragma unroll
        for (int et = 0; et < 4; ++et) oc[et] = (f32x4){0.f, 0.f, 0.f, 0.f};
        for (int k0 = 0; k0 < nk32; k0 += 128) {
            bf16x8 va[4][4], pa[4];
#pragma unroll
            for (int s4 = 0; s4 < 4; ++s4) if (k0 + 32 * s4 < nk32) {
                pa[s4] = *(const LDSP bf16x8*)(Pc + (size_t)(hg * 64 + qw + fr) * NA_PCLD + k0 + 32 * s4 + fq * 8);
#pragma unroll
                for (int et = 0; et < 4; ++et) va[s4][et] = *(const bf16x8*)(vt + (size_t)(et * 16 + fr) * NCMP_PAD + k0 + 32 * s4 + fq * 8); }
#pragma unroll
            for (int s4 = 0; s4 < 4; ++s4) if (k0 + 32 * s4 < nk32) {
#pragma unroll
                for (int et = 0; et < 4; ++et) oc[et] = mfma16(va[s4][et], pa[s4], oc[et]); }
        }
        block_sync();
#pragma unroll
        for (int et = 0; et < 4; ++et) ofin[et] += oc[et] * gates[(hg * 64 + qw + fr) * 3 + 0];
    }
    if (!(xm & 16))
    for (int e = c.tid; e < 4096; e += NTHR) { const int q = e >> 6, j = e & 63; float a = 0.f;
        if (j <= qt) {
#pragma unroll
            for (int dn = -1; dn <= 3; ++dn) { const int n = 4 * j + dn; if (n >= 0 && n < nkt * 16) a += bf2f(Pc[(size_t)q * NA_PCLD + n]) + bf2f(Pc[(size_t)(64 + q) * NA_PCLD + n]); }
            if (j == 0 || j == qt || j == qt - 1) a += 1000.f;
        } else a = NEG_BIG;
        imp[q * 65 + j] = a; }
    block_sync();
    if (!(xm & 32))
    for (int qq = 0; qq < 8; ++qq) { const int q = c.wave * 8 + qq; unsigned long long m = 0ull;
        if (qt < 16) m = (1ull << (qt + 1)) - 1ull;
        else { const unsigned key = (sortkey32(imp[q * 65 + c.lane]) & 0xffffffc0u) | (unsigned)(63 - c.lane); int rank = 0;
#pragma unroll
            for (int i = 0; i < 64; ++i) rank += ((unsigned)bcast_i((int)key, i) > key) ? 1 : 0;
            m = ballot64(rank < 16); }
        if (c.lane == 0) selmask[q] = m; }
    block_sync();
    const unsigned long long selm = selmask[qw + fr];
#pragma unroll
    for (int mode = 0; mode < 2; ++mode) {
        if (xm & 64) break;
        f32x4 ot[5]; float mrun = NEG_BIG, lrun = 0.f;
#pragma unroll
        for (int et = 0; et < 5; ++et) ot[et] = (f32x4){0.f, 0.f, 0.f, 0.f};
        const int j0 = (mode == 0) ? 0 : (qt >= 8 ? qt - 8 : 0), ns = (qt - j0) / 2 + 1;
        const int skey = c.tid >> 2, sd0 = (c.tid & 3) * 16, se = c.tid >> 3, sk0 = (c.tid & 7) * 16;
        u32x4 rk0, rk1, rv0, rv1;
#define NSA_STAGE_LOAD(js_) do { const int jb_ = (js_) + (skey >> 6) > qt ? qt : (js_) + (skey >> 6); const size_t tok_ = (size_t)b * SEQ + jb_ * 64 + (skey & 63); \
            const bf16_t* kp_ = ksw + tok_ * 256 + (mode * 2 + g) * 64 + sd0; rk0 = *(const u32x4*)kp_; rk1 = *(const u32x4*)(kp_ + 8); \
            const int jv_ = (js_) + (sk0 >> 6) > qt ? qt : (js_) + (sk0 >> 6); const bf16_t* vp_ = proj + ((size_t)b * SEQ + jv_ * 64 + se) * PROJ_LD + (mode == 0 ? C_NVS : C_NVW) + g * 64 + (sk0 & 63); rv0 = *(const u32x4*)vp_; rv1 = *(const u32x4*)(vp_ + 8); } while (0)
#define NSA_STAGE_WRITE(buf_) do { LDSP bf16_t* kd_ = (LDSP bf16_t*)(c.lds + (buf_) * NA_BUF) + skey * NA_KLD + sd0; *(LDSP u32x4*)kd_ = rk0; *(LDSP u32x4*)(kd_ + 8) = rk1; \
            LDSP bf16_t* vd_ = (LDSP bf16_t*)(c.lds + (buf_) * NA_BUF + NA_VOFF) + se * NA_VLD + sk0; *(LDSP u32x4*)vd_ = rv0; *(LDSP u32x4*)(vd_ + 8) = rv1; } while (0)
        NSA_STAGE_LOAD(j0); NSA_STAGE_WRITE(0);
        block_sync();
        for (int sidx = 0; sidx < ns; ++sidx) {
            const int js = j0 + 2 * sidx;
            if (sidx + 1 < ns && !(xm & 2)) NSA_STAGE_LOAD(js + 2);
            const bool edge = (mode == 0) ? (js + 1 >= qt) : (sidx == 0 || js + 1 >= qt);
            if (!(xm & 1)) {
            if (fastp) {
                if (mode == 0) { if (edge) nsa_stage<0, true, true>(c, sidx & 1, js, qt, qr, ot, mrun, lrun, selm); else nsa_stage<0, false, true>(c, sidx & 1, js, qt, qr, ot, mrun, lrun, selm); }
                else { if (edge) nsa_stage<1, true, true>(c, sidx & 1, js, qt, qr, ot, mrun, lrun, selm); else nsa_stage<1, false, true>(c, sidx & 1, js, qt, qr, ot, mrun, lrun, selm); }
            } else {
                if (mode == 0) { if (edge) nsa_stage<0, true, false>(c, sidx & 1, js, qt, qr, ot, mrun, lrun, selm); else nsa_stage<0, false, false>(c, sidx & 1, js, qt, qr, ot, mrun, lrun, selm); }
                else { if (edge) nsa_stage<1, true, false>(c, sidx & 1, js, qt, qr, ot, mrun, lrun, selm); else nsa_stage<1, false, false>(c, sidx & 1, js, qt, qr, ot, mrun, lrun, selm); }
            }
            }
            if (sidx + 1 < ns && !(xm & 2)) NSA_STAGE_WRITE((sidx + 1) & 1);
            if (!(xm & 4)) block_sync();
        }
#undef NSA_STAGE_LOAD
#undef NSA_STAGE_WRITE
        float ls = fastp ? ot[4][0] : lrun; ls += xorf<16>(ls); ls += xorf<32>(ls);
        const float sc = gates[(hg * 64 + qw + fr) * 3 + 1 + mode] * (ls > 0.f ? fast_rcp(ls) : 0.f);
#pragma unroll
        for (int et = 0; et < 4; ++et) ofin[et] += ot[et] * sc;
    }
    bf16_t* out = wsp<bf16_t>(c, WS_OUTS) + (size_t)2 * NT * MW + (size_t)(tokq0 + qw + fr) * MW + hd * 64 + fq * 4;
#pragma unroll
    for (int et = 0; et < 4; ++et) { u32x2 w; w.x = pk2(ofin[et][0], ofin[et][1]); w.y = pk2(ofin[et][2], ofin[et][3]); *(u32x2*)(out + et * 16) = w; }
    block_sync();
}
constexpr int PEER_WSCR = (4 * 256 + 3 * 128) * 4;
constexpr int PEER_X8 = 8 * PEER_WSCR;
constexpr int PEER_TAB = PEER_X8 + 8 * 1024;
#ifndef HOST_EMU
DEV int uniform_i(int v) { return __builtin_amdgcn_readfirstlane(v); }
#else
static inline int uniform_i(int v) { return v; }
#endif
DEV unsigned sortkey16(unsigned b) { return (b & 0x8000u) ? (~b & 0xffffu) : (b | 0x8000u); }
DEV f32x2 dot16_fp8(const f32x2 (&x)[8], const u32x4 q, f32x2 s) {
#pragma unroll
    for (int i = 0; i < 4; ++i) { const f32x2 lo = cvt_pk_f32_fp8(q[i], false), hi = cvt_pk_f32_fp8(q[i], true); s = x[2 * i] * lo + s; s = x[2 * i + 1] * hi + s; }
    return s;
}
DEV void axpy16_fp8(f32x2 (&acc)[8], float w, const u32x4 q) {
    const f32x2 w2 = {w, w};
#pragma unroll
    for (int i = 0; i < 4; ++i) { const f32x2 lo = cvt_pk_f32_fp8(q[i], false), hi = cvt_pk_f32_fp8(q[i], true); acc[2 * i] = w2 * lo + acc[2 * i]; acc[2 * i + 1] = w2 * hi + acc[2 * i + 1]; }
}
DEV f32x2 dot16_fp4(const f32x2 (&x)[8], const u32x2 q, f32x2 s) {
#pragma unroll
    for (int i = 0; i < 2; ++i)
#pragma unroll
        for (int b = 0; b < 4; ++b) s = x[4 * i + b] * cvt_pk_f32_fp4(q[i], b) + s;
    return s;
}
DEV void axpy16_fp4(f32x2 (&acc)[8], float w, const u32x2 q) {
    const f32x2 w2 = {w, w};
#pragma unroll
    for (int i = 0; i < 2; ++i)
#pragma unroll
        for (int b = 0; b < 4; ++b) acc[4 * i + b] = w2 * cvt_pk_f32_fp4(q[i], b) + acc[4 * i + b];
}
DEV void peer_init_tab(const Ctx& c) {
    if (c.tid < 64) { const int t = c.tid; int a, b;
        if (t < 16) { a = 0; b = t; } else if (t < 24) { a = 1; b = t - 16; } else if (t < 29) { a = 2; b = t - 24; } else if (t < 33) { a = 3; b = t - 29; }
        else if (t < 36) { a = 4; b = t - 33; } else if (t < 42) { a = 5 + (t - 36) / 2; b = (t - 36) & 1; } else { a = 8 + (t - 42); b = 0; }
        ((LDSP unsigned char*)(c.lds + PEER_TAB))[t] = (t < 50) ? (unsigned char)((a << 4) | b) : (unsigned char)0xff; }
    block_sync();
}
#ifndef PV_ALIAS
#define PV_ALIAS 0
#endif
DEV void peer_token(const Ctx& c, int l, int tok, bool alias = false) {
    const int lane = c.lane;
    LDSP float* Wv = (LDSP float*)(c.lds + c.wave * PEER_WSCR); LDSP int* Wi = (LDSP int*)(Wv + 256); LDSP float* Sv = (LDSP float*)(Wi + 256); LDSP int* Si = (LDSP int*)(Sv + 256);
    LDSP int* We = Si + 256; LDSP float* Ws = (LDSP float*)(We + 128); LDSP float* Wg = Ws + 128;
    const bf16_t* sc = wsp<bf16_t>(c, WS_SCORES) + (size_t)tok * PEER_N;
#ifndef DUP_TOPK
#define DUP_TOPK 1
#endif
    for (int rep_ = 0; rep_ < DUP_TOPK; ++rep_) {
    {
        unsigned k[32];
        { const int g = lane >> 2, cq = lane & 3; const bf16_t* sp = sc + g * 128 + cq * 32;
#pragma unroll
          for (int v4 = 0; v4 < 4; ++v4) { const u32x4 w = *(const u32x4*)(sp + 8 * v4);
#pragma unroll
            for (int j = 0; j < 4; ++j) { const unsigned d = w[j]; const int i0 = 8 * v4 + 2 * j;
                k[i0] = (sortkey16(d & 0xffffu) << 16) | (unsigned)(127 - (cq * 32 + i0)); k[i0 + 1] = (sortkey16(d >> 16) << 16) | (unsigned)(127 - (cq * 32 + i0 + 1)); } } }
#define PEER_CX(i_, j_) do { const unsigned a_ = k[i_], b_ = k[j_]; k[i_] = a_ > b_ ? a_ : b_; k[j_] = a_ > b_ ? b_ : a_; } while (0)
#pragma unroll
        for (int size = 2; size <= 16; size <<= 1) {
#pragma unroll
            for (int i = 0; i < 32; ++i) { const int j = i ^ (size - 1); if (j > i) PEER_CX(i, j); }
#pragma unroll
            for (int stride = size >> 2; stride > 0; stride >>= 1) {
#pragma unroll
                for (int i = 0; i < 32; ++i) { const int j = i ^ stride; if (j > i) PEER_CX(i, j); } }
        }
#pragma unroll
        for (int i = 0; i < 16; ++i) { const unsigned a_ = k[i], b_ = k[31 - i]; k[i] = a_ > b_ ? a_ : b_; }
#pragma unroll
        for (int stride = 8; stride > 0; stride >>= 1) {
#pragma unroll
            for (int i = 0; i < 16; ++i) { const int j = i ^ stride; if (j > i) PEER_CX(i, j); } }
#pragma unroll
        for (int lvl = 0; lvl < 2; ++lvl) {
            unsigned pk_[16];
#pragma unroll
            for (int i = 0; i < 16; ++i) pk_[i] = (unsigned)(lvl == 0 ? xori<1>((int)k[i]) : xori<2>((int)k[i]));
#pragma unroll
            for (int i = 0; i < 16; ++i) { const unsigned a_ = k[i], b_ = pk_[15 - i]; k[i] = a_ > b_ ? a_ : b_; }
#pragma unroll
            for (int stride = 8; stride > 0; stride >>= 1) {
#pragma unroll
                for (int i = 0; i < 16; ++i) { const int j = i ^ stride; if (j > i) PEER_CX(i, j); } }
        }
#undef PEER_CX
        { const int g = lane >> 2, cq = lane & 3;
#pragma unroll
          for (int cc = 0; cc < 4; ++cc)
#pragma unroll
            for (int j = 0; j < 4; ++j) if (cc == cq) { const unsigned pk = k[4 * cc + j]; const unsigned k16 = pk >> 16, bits = (k16 & 0x8000u) ? (k16 & 0x7fffu) : (~k16 & 0xffffu);
                Sv[g * 16 + 4 * cc + j] = __builtin_bit_cast(float, bits << 16); Si[g * 16 + 4 * cc + j] = 127 - (int)(pk & 0x7fu); } }
    }
    wave_sync();
    {
        const int h = lane >> 3, cq = lane & 7; const LDSP unsigned char* tab = (const LDSP unsigned char*)(c.lds + PEER_TAB);
        unsigned k[16];
#pragma unroll
        for (int j = 0; j < 8; ++j) { const int ci = cq + 8 * j; unsigned key = 0u;
            if (ci < 50) { const unsigned ab = tab[ci]; const int a = (ab >> 4) & 15, b = ab & 15; const float s = Sv[(2 * h) * 16 + a] + Sv[(2 * h + 1) * 16 + b];
                key = (sortkey32(s) & 0xffffff00u) | (unsigned)(255 - (a * 16 + b)); }
            k[j] = key; }
#define PEER_CX(i_, j_) do { const unsigned a_ = k[i_], b_ = k[j_]; k[i_] = a_ > b_ ? a_ : b_; k[j_] = a_ > b_ ? b_ : a_; } while (0)
#pragma unroll
        for (int size = 2; size <= 8; size <<= 1) {
#pragma unroll
            for (int i = 0; i < 8; ++i) { const int j = i ^ (size - 1); if (j > i) PEER_CX(i, j); }
#pragma unroll
            for (int stride = size >> 2; stride > 0; stride >>= 1) {
#pragma unroll
                for (int i = 0; i < 8; ++i) { const int j = i ^ stride; if (j > i) PEER_CX(i, j); } }
        }
#pragma unroll
        for (int i = 0; i < 8; ++i) k[15 - i] = (unsigned)xori<1>((int)k[i]);
#pragma unroll
        for (int stride = 8; stride > 0; stride >>= 1) {
#pragma unroll
            for (int i = 0; i < 16; ++i) { const int j = i ^ stride; if (j > i) PEER_CX(i, j); } }
#pragma unroll
        for (int lvl = 0; lvl < 2; ++lvl) {
            unsigned pk_[16];
#pragma unroll
            for (int i = 0; i < 16; ++i) pk_[i] = (unsigned)(lvl == 0 ? xori<2>((int)k[i]) : xori<4>((int)k[i]));
#pragma unroll
            for (int i = 0; i < 16; ++i) { const unsigned a_ = k[i], b_ = pk_[15 - i]; k[i] = a_ > b_ ? a_ : b_; }
#pragma unroll
            for (int stride = 8; stride > 0; stride >>= 1) {
#pragma unroll
                for (int i = 0; i < 16; ++i) { const int j = i ^ stride; if (j > i) PEER_CX(i, j); } }
        }
#undef PEER_CX
#pragma unroll
        for (int cc = 0; cc < 8; ++cc)
#pragma unroll
            for (int j = 0; j < 2; ++j) if (cc == cq) { const int pos = 255 - (int)(k[2 * cc + j] & 0xffu), a = pos >> 4, b = pos & 15;
                We[h * 16 + 2 * cc + j] = (Si[(2 * h) * 16 + a] * 128 + Si[(2 * h + 1) * 16 + b]) & 16383; Ws[h * 16 + 2 * cc + j] = Sv[(2 * h) * 16 + a] + Sv[(2 * h + 1) * 16 + b]; }
    }
    wave_sync();
    { const float mx = Ws[(lane >> 3) * 16]; const float e0 = fast_exp(Ws[2 * lane] - mx), e1 = fast_exp(Ws[2 * lane + 1] - mx); float sm = e0 + e1;
      sm += xorf<1>(sm); sm += xorf<2>(sm); sm += xorf<4>(sm); const float inv = fast_rcp(sm); Wg[2 * lane] = e0 * inv; Wg[2 * lane + 1] = e1 * inv; }
    wave_sync();
    }
    const bf16_t* xb = wsp<bf16_t>(c, WS_XB) + (size_t)tok * DM; const unsigned char* PU = wsp<unsigned char>(c, WS_PU); const unsigned char* PV = wsp<unsigned char>(c, (PV_ALIAS && alias) ? WS_PU : WS_PV);
    f32x2 xf[8];
    const u32x4 x0 = *(const u32x4*)(xb + 16 * lane), x1 = *(const u32x4*)(xb + 16 * lane + 8);
    { xf[0] = (f32x2){bflo(x0.x), bfhi(x0.x)}; xf[1] = (f32x2){bflo(x0.y), bfhi(x0.y)}; xf[2] = (f32x2){bflo(x0.z), bfhi(x0.z)}; xf[3] = (f32x2){bflo(x0.w), bfhi(x0.w)};
      xf[4] = (f32x2){bflo(x1.x), bfhi(x1.x)}; xf[5] = (f32x2){bflo(x1.y), bfhi(x1.y)}; xf[6] = (f32x2){bflo(x1.z), bfhi(x1.z)}; xf[7] = (f32x2){bflo(x1.w), bfhi(x1.w)}; }
    const float rstd = pg8::rstd_of(pg8::rss_slots16(wsp<float>(c, WS_RSS2) + (size_t)tok * 16)) * (1.0f / 64.0f);
    f32x2 acc[8];
#pragma unroll
    for (int j = 0; j < 8; ++j) acc[j] = (f32x2){0.f, 0.f};
    LDSP unsigned char* X8 = (LDSP unsigned char*)(c.lds + PEER_X8 + c.wave * 1024);
    { u32x4 xq;
      xq.x = cvt_pk_fp8_f32(xf[1][0], xf[1][1], cvt_pk_fp8_f32(xf[0][0], xf[0][1], 0u, false), true); xq.y = cvt_pk_fp8_f32(xf[3][0], xf[3][1], cvt_pk_fp8_f32(xf[2][0], xf[2][1], 0u, false), true);
      xq.z = cvt_pk_fp8_f32(xf[5][0], xf[5][1], cvt_pk_fp8_f32(xf[4][0], xf[4][1], 0u, false), true); xq.w = cvt_pk_fp8_f32(xf[7][0], xf[7][1], cvt_pk_fp8_f32(xf[6][0], xf[6][1], 0u, false), true);
      *(LDSP u32x4*)(X8 + 16 * lane) = xq;
    }
    wave_sync();
#define PEER_LOADV(buf, base) do { _Pragma("unroll") for (int k_ = 0; k_ < 8; ++k_) { const unsigned o_ = ((unsigned)We[(base) + k_] << 9) + 8u * (unsigned)lane; buf[k_] = *(const u32x2*)(PV + o_); } } while (0)
#define PEER_LOADU(buf, hh) do { const unsigned o_ = ((unsigned)We[(hh) * 16 + (lane & 15)] << 9) + 16u * (unsigned)(lane >> 4); _Pragma("unroll") for (int s_ = 0; s_ < 8; ++s_) buf[s_] = *(const u32x4*)(PU + o_ + 64u * s_); } while (0)
    u32x4 ua[8]; u32x2 bv0[8], bv1[8];
    PEER_LOADU(ua, 0); PEER_LOADV(bv0, 0); PEER_LOADV(bv1, 8);
#ifndef HOST_EMU
#define PEER_SCHED_FENCE() __builtin_amdgcn_sched_barrier(0)
#else
#define PEER_SCHED_FENCE() do {} while (0)
#endif
    for (int h = 0; h < 8; ++h) {
        f32x4 dacc = {0.f, 0.f, 0.f, 0.f};
#pragma unroll
        for (int s = 0; s < 8; ++s) { const LDSP unsigned char* xq = X8 + 128 * s + 16 * (lane >> 4);
            dacc = mfma_fp4_fp8(ua[s], *(const LDSP u32x4*)xq, *(const LDSP u32x4*)(xq + 64), dacc); }
        if (h < 7) PEER_LOADU(ua, h + 1);
        const int srcl = 16 * ((lane & 15) >> 2);
        const float d0 = shfl_f(dacc[0], srcl), d1 = shfl_f(dacc[1], srcl), d2 = shfl_f(dacc[2], srcl), d3 = shfl_f(dacc[3], srcl);
        const float dk = (lane & 2) ? ((lane & 1) ? d3 : d2) : ((lane & 1) ? d1 : d0);
        const float wk = Wg[h * 16 + (lane & 15)] * gelu_erf(dk * rstd) * 0.1f;
#pragma unroll
        for (int k = 0; k < 8; ++k) axpy16_fp4(acc, bcast_f(wk, k), bv0[k]);
        PEER_SCHED_FENCE();
        if (h < 7) PEER_LOADV(bv0, h * 16 + 16);
#pragma unroll
        for (int k = 0; k < 8; ++k) axpy16_fp4(acc, bcast_f(wk, 8 + k), bv1[k]);
        PEER_SCHED_FENCE();
        if (h < 7) PEER_LOADV(bv1, h * 16 + 24);
    }
#undef PEER_SCHED_FENCE
#undef PEER_LOADU
#undef PEER_LOADV
    float ss = 0.f; f32x4 o[4];
    o[0] = (f32x4){bflo(x0.x) + acc[0][0], bfhi(x0.x) + acc[0][1], bflo(x0.y) + acc[1][0], bfhi(x0.y) + acc[1][1]};
    o[1] = (f32x4){bflo(x0.z) + acc[2][0], bfhi(x0.z) + acc[2][1], bflo(x0.w) + acc[3][0], bfhi(x0.w) + acc[3][1]};
    o[2] = (f32x4){bflo(x1.x) + acc[4][0], bfhi(x1.x) + acc[4][1], bflo(x1.y) + acc[5][0], bfhi(x1.y) + acc[5][1]};
    o[3] = (f32x4){bflo(x1.z) + acc[6][0], bfhi(x1.z) + acc[6][1], bflo(x1.w) + acc[7][0], bfhi(x1.w) + acc[7][1]};
    if (l + 1 < DEPTH) {
        bf16_t* xo = wsp<bf16_t>(c, WS_XB) + (size_t)tok * DM + 16 * lane;
        u32x4 w0, w1; w0.x = pk2(o[0][0], o[0][1]); w0.y = pk2(o[0][2], o[0][3]); w0.z = pk2(o[1][0], o[1][1]); w0.w = pk2(o[1][2], o[1][3]);
        w1.x = pk2(o[2][0], o[2][1]); w1.y = pk2(o[2][2], o[2][3]); w1.z = pk2(o[3][0], o[3][1]); w1.w = pk2(o[3][2], o[3][3]);
        *(u32x4*)xo = w0; *(u32x4*)(xo + 8) = w1;
#pragma unroll
        for (int j = 0; j < 4; ++j) ss += (o[j][0] * o[j][0] + o[j][1] * o[j][1]) + (o[j][2] * o[j][2] + o[j][3] * o[j][3]);
        ss = wave_sum(ss);
        if (lane == 0) wsp<float>(c, WS_RSS1)[tok] = ss;
    } else {
        float* orow = c.out + (size_t)tok * DM + 16 * lane;
#pragma unroll
        for (int j = 0; j < 4; ++j) *(f32x4*)(orow + 4 * j) = o[j];
    }
    wave_sync();
}
DEV void peer_table_rows(const Ctx& c, int l) {
    const float* g2 = CIN(17) + (size_t)l * DM;
    const f32x4 ga = *((const f32x4*)g2 + 4 * c.lane), gb = *((const f32x4*)g2 + 4 * c.lane + 1), gc = *((const f32x4*)g2 + 4 * c.lane + 2), gd = *((const f32x4*)g2 + 4 * c.lane + 3);
    for (int r = c.bid * NWAVE + c.wave; r < 2 * 16384; r += c.nblk * NWAVE) {
        const int tab = r >> 14, e = r & 16383;
        const f32x4* src = (const f32x4*)((tab == 0 ? CIN(20) : CIN(21)) + ((size_t)l * 16384 + e) * DM) + 4 * c.lane;
        f32x4 v0 = src[0], v1 = src[1], v2 = src[2], v3 = src[3];
        if (tab == 0) { v0 *= ga * 64.0f; v1 *= gb * 64.0f; v2 *= gc * 64.0f; v3 *= gd * 64.0f;
        } else { v0 *= 10.0f; v1 *= 10.0f; v2 *= 10.0f; v3 *= 10.0f; }
        {
            u32x2 q;
            q.x = fp4_code(v0[0]) | (fp4_code(v0[1]) << 4) | (fp4_code(v0[2]) << 8) | (fp4_code(v0[3]) << 12) | (fp4_code(v1[0]) << 16) | (fp4_code(v1[1]) << 20) | (fp4_code(v1[2]) << 24) | (fp4_code(v1[3]) << 28);
            q.y = fp4_code(v2[0]) | (fp4_code(v2[1]) << 4) | (fp4_code(v2[2]) << 8) | (fp4_code(v2[3]) << 12) | (fp4_code(v3[0]) << 16) | (fp4_code(v3[1]) << 20) | (fp4_code(v3[2]) << 24) | (fp4_code(v3[3]) << 28);
            *(u32x2*)(wsp<unsigned char>(c, tab == 0 ? WS_PU : WS_PV) + (size_t)e * (DM / 2) + 8 * c.lane) = q;
        }
    }
}
#ifndef HOST_EMU
#define XB_TMO      128
#define XB_XCNT(j)  (256  + 64 * (j))
#define XB_XSUB(j)  (1280 + 64 * (j))
#define XB_XGEN(j)  (2304 + 64 * (j))
#define XB_TOP      3328
#define XB_TOPGEN   3392
#define XCD_BAR_WORDS 3456
#define XB_SPIN_CAP (1u << 18)

__device__ __forceinline__ unsigned xb_ld(unsigned* p)              { return __hip_atomic_load(p, __ATOMIC_RELAXED, __HIP_MEMORY_SCOPE_AGENT); }
__device__ __forceinline__ unsigned xb_add(unsigned* p, unsigned v) { return __hip_atomic_fetch_add(p, v, __ATOMIC_RELAXED, __HIP_MEMORY_SCOPE_AGENT); }
__device__ __forceinline__ unsigned xb_xcc_id() { return (unsigned)__builtin_amdgcn_s_getreg((3 << 11) | 20) & 0xFu; }
#define XB_SPIN(cond, bar) do { unsigned _sp = 0; while (cond) { __builtin_amdgcn_s_sleep(1); \
    if ((++_sp & 255u) == 0u) { if (xb_ld(&(bar)[XB_TMO])) break; if (_sp > XB_SPIN_CAP) { atomicAdd(&(bar)[XB_TMO], 1u); break; } } } } while (0)

struct XcdBarrier {
    unsigned* bar; unsigned x;
    volatile __attribute__((address_space(3))) unsigned* st;
};

__device__ __forceinline__ XcdBarrier xcd_barrier_post(unsigned* bar, volatile __attribute__((address_space(3))) unsigned* st) {
    XcdBarrier b; b.bar = bar; b.x = xb_xcc_id(); b.st = st;
    if (threadIdx.x == 0) (void)xb_add(&bar[XB_XCNT(b.x)], 1u);
    return b;
}
__device__ __forceinline__ void xcd_barrier_complete(unsigned* bar, unsigned x, unsigned& nloc, unsigned& nx) {
    const unsigned G = gridDim.x * gridDim.y * gridDim.z;
    unsigned sum, cnt, mine, sp = 0u;
    for (;;) {
        sum = 0u; cnt = 0u; mine = 0u;
#pragma unroll
        for (unsigned j = 0; j < 16; ++j) { const unsigned c = xb_ld(&bar[XB_XCNT(j)]); sum += c; cnt += (c > 0u) ? 1u : 0u; mine = (j == x) ? c : mine; }
        if (sum == G) break;
        __builtin_amdgcn_s_sleep(1);
        if ((++sp & 255u) == 0u) { if (xb_ld(&bar[XB_TMO])) break; if (sp > XB_SPIN_CAP) { atomicAdd(&bar[XB_TMO], 1u); break; } }
    }
    nloc = mine > 0u ? mine : 1u; nx = cnt > 0u ? cnt : 1u;
}

__device__ __forceinline__ void xcd_barrier(const XcdBarrier& b) {
    asm volatile("s_waitcnt vmcnt(0)" ::: "memory");
    __syncthreads();
    if (threadIdx.x == 0) {
        unsigned* bar = b.bar;
        __builtin_amdgcn_s_waitcnt(0);
        unsigned nloc = b.st[0], nx = b.st[1];
        if (nloc == 0u) { xcd_barrier_complete(bar, b.x, nloc, nx); b.st[0] = nloc; b.st[1] = nx; }
        const unsigned old = xb_add(&bar[XB_XSUB(b.x)], 1u);
        const unsigned gen = old / nloc;
        if (old + 1u == (gen + 1u) * nloc) {
            __builtin_amdgcn_fence(__ATOMIC_RELEASE, "agent");
            asm volatile("s_waitcnt vmcnt(0)" ::: "memory");
            const unsigned og = xb_add(&bar[XB_TOP], 1u);
            const unsigned tg = og / nx;
            if (og + 1u == (tg + 1u) * nx) xb_add(&bar[XB_TOPGEN], 1u);
            else XB_SPIN(xb_ld(&bar[XB_TOPGEN]) == tg, bar);
            __builtin_amdgcn_fence(__ATOMIC_ACQUIRE, "agent");
            xb_add(&bar[XB_XGEN(b.x)], 1u);
            asm volatile("s_waitcnt vmcnt(0)" ::: "memory");
        } else {
            XB_SPIN(xb_ld(&bar[XB_XGEN(b.x)]) == gen, bar);
            __builtin_amdgcn_fence(__ATOMIC_ACQUIRE, "agent");
            asm volatile("s_waitcnt vmcnt(0)" ::: "memory");
        }
    }
    __syncthreads();
}


#endif
#ifndef EXTRA_K
#define EXTRA_K 0
#endif
#ifndef P0X
#define P0X 31
#endif
#ifndef P2X
#define P2X 15
#endif
#ifndef DBG_COPY
#define DBG_COPY 0
#endif
#ifndef DBG_PHASE
#define DBG_PHASE 5
#endif
#ifndef DUP_NSA
#define DUP_NSA 1
#endif
#ifndef DUP_REC
#define DUP_REC 1
#endif
#ifndef DUP_P5
#define DUP_P5 1
#endif
#ifndef DUP_P2
#define DUP_P2 1
#endif
#ifndef DUP_P0
#define DUP_P0 1
#endif
#ifndef DUP_P1
#define DUP_P1 1
#endif
#ifndef DUP_NP
#define DUP_NP 1
#endif
#ifndef HOST_EMU
#define GRID_SYNC() do { if (ph == 1) cg::this_grid().sync(); else { XcdBarrier xb_; xb_.bar = (unsigned*)(lds_ptr_entry(22) + WS_BARRIER); xb_.x = xb_xcc_id(); \
    xb_.st = (volatile __attribute__((address_space(3))) unsigned*)(smem_raw + LDS_PTRS + 192); xcd_barrier(xb_); } } while (0)
#else
#define GRID_SYNC() grid_sync_impl()
#endif

#ifndef HOST_EMU
DEV unsigned char* lds_ptr_entry(int i) {
    int z; asm volatile("s_mov_b32 %0, 0" : "=s"(z)); i += z;
    const unsigned long long v = ((volatile LDSP unsigned long long*)((LDSP unsigned char*)smem_raw + LDS_PTRS))[i];
    const unsigned lo = __builtin_amdgcn_readfirstlane((unsigned)v), hi = __builtin_amdgcn_readfirstlane((unsigned)(v >> 32));
    return (unsigned char*)(__attribute__((address_space(1))) unsigned char*)(((unsigned long long)hi << 32) | lo);
}
#endif
DEV Ctx make_ctx(const Params& p, int wave0, bool dummy_out = false) {
#ifndef HOST_EMU
    Ctx c; c.out = p.out; c.ws = p.ws; c.tid = wave0 * 64 + fresh_lane();
#else
    Ctx c; c.out = p.out; c.ws = p.ws; c.tid = TID();
#endif
    c.bid = BID(); c.nblk = NBLK(); int z = 0;
#ifndef HOST_EMU
    asm volatile("" : "+v"(c.tid), "+s"(c.bid), "+s"(c.nblk));
    asm volatile("s_mov_b32 %0, 0" : "=s"(z));
    c.ws = lds_ptr_entry(22); c.out = (float*)lds_ptr_entry(23);
#endif
    if (dummy_out) c.out = (float*)(c.ws + WS_PROJ + (size_t)136 * 1024 * 1024);
    c.lds = SMEM_PTR() + z; c.lane = c.tid & 63; c.wave = c.tid >> 6;
#ifndef HOST_EMU
    c.wave = __builtin_amdgcn_readfirstlane(c.wave);
#endif
    return c;
}
#ifndef HOST_EMU
__global__ void __launch_bounds__(NTHR, 2) fwd_kernel(Params p)
#else
void fwd_kernel(Params p)
#endif
{
    {
        LDSP char* lds0 = SMEM_PTR();
        if (TID() == 0) {
#pragma unroll
            for (int i = 0; i < 22; ++i) ((LDSP unsigned long long*)(lds0 + LDS_PTRS))[i] = (unsigned long long)p.in[i];
            ((LDSP unsigned long long*)(lds0 + LDS_PTRS))[22] = (unsigned long long)p.ws; ((LDSP unsigned long long*)(lds0 + LDS_PTRS))[23] = (unsigned long long)p.out;
        }
        block_sync();
    }
#ifndef HOST_EMU
    const int wave0 = __builtin_amdgcn_readfirstlane((int)threadIdx.x >> 6);
#else
    const int wave0 = 0;
#endif
#ifndef HOST_EMU
    volatile __attribute__((address_space(3))) unsigned* xst = (volatile __attribute__((address_space(3))) unsigned*)(smem_raw + LDS_PTRS + 192);
    if (threadIdx.x == 0) { xst[0] = 0u; xst[1] = 0u; }
    __syncthreads();
    (void)xcd_barrier_post((unsigned*)(p.ws + WS_BARRIER), xst);
#endif
    int ph = 0;
#define PHASE_END() do { ++ph; if (DBG_COPY && ph == DBG_PHASE) { GRID_SYNC(); Ctx c = make_ctx(p, wave0); \
        const bf16_t* src = wsp<bf16_t>(c, DBG_COPY == 1 ? WS_OUTS : DBG_COPY == 2 ? WS_ST : DBG_COPY == 3 ? WS_PROJ : DBG_COPY == 4 ? WS_HALO : DBG_COPY >= 6 ? WS_OUTS + (size_t)(DBG_COPY - 6) * NT * MW * 2 : WS_KSW); const size_t nsrc = DBG_COPY >= 6 ? (size_t)NT * MW : DBG_COPY == 2 ? 3 * ST_ONE / 2 : DBG_COPY == 4 ? (size_t)BATCH * NC * 3 * 512 + (size_t)NT * NH * 2 * 2 + (size_t)BATCH * NH * NC * 64 * 2 : (size_t)NT * DM; \
        for (size_t i = (size_t)c.bid * NTHR + c.tid; i < (size_t)NT * DM; i += (size_t)c.nblk * NTHR) c.out[i] = i < nsrc ? bf2f(src[i]) : 0.f; return; } \
        if (ph >= p.phase_hi) return; GRID_SYNC(); if (extra && ph - ph_x0 >= EXTRA_K) return; } while (0)
    int ph_x0 = 0;
    for (int it = 0; it < DEPTH + (EXTRA_K > 0 ? 1 : 0); ++it) {
        const int l = it < DEPTH ? it : 0; const bool extra = it >= DEPTH; if (extra) ph_x0 = ph;
        for (int rep = 0; rep < DUP_P0; ++rep) { Ctx c = make_ctx(p, wave0); p0_prep(c, l, extra ? P0X : 31); }
        PHASE_END();
        for (int rep = 0; rep < DUP_P1; ++rep) {
            Ctx c = make_ctx(p, wave0);
            if (rep == 0 && c.bid == c.nblk - 1 && c.wave == 0) cbias_reduce(c);
            pg8::Gemm g{wsp<bf16_t>(c, WS_XB), wsp<bf16_t>(c, WS_WIN), NT, PROJ_N, DM}; pg8::StaticOrder S; S.init(NT, PROJ_N, c.nblk, c.bid);
            pg8::EpiScaleBf16<1, true> E{wsp<bf16_t>(c, WS_PROJ), PROJ_LD, wsp<float>(c, WS_RSS1), PROJ_LD, wsp<bf16_t>(c, WS_HALO)};
            pg8::gemm_phase<pg8::EpiScaleBf16<1, true>, pg8::StaticOrder, true, true>(GEMM_LDS, g, S, E, c.tid);
        }
        PHASE_END();
        const int p2m = extra ? P2X : 15;
        if (p2m & 1) for (int rep = 0; rep < DUP_P2; ++rep) { Ctx c = make_ctx(p, wave0); for (int u = c.bid; u < 3 * BATCH * NH * NC; u += c.nblk) recur_local_unit(c, l, u); }
        if (p2m & 2) for (int rep = 0; rep < DUP_NP; ++rep) { Ctx c = make_ctx(p, wave0); for (int u = c.bid; u < BATCH * 16; u += c.nblk) nsa_compress_unit(c, l, u); }
        if (p2m & 4) for (int rep = 0; rep < DUP_NP; ++rep) { Ctx c = make_ctx(p, wave0); for (int it = c.bid; it < NT / 32; it += c.nblk) nsa_kprep_item(c, l, it); }
        if (p2m & 8) for (int rep = 0; rep < DUP_NP; ++rep) { Ctx c = make_ctx(p, wave0); for (int it = c.bid; it < BATCH * 4 * NC; it += c.nblk) nsa_vprep_item(c, it); }
        PHASE_END();
        { Ctx c = make_ctx(p, wave0); recur_scan(c); }
        PHASE_END();
        for (int rep = 0; rep < DUP_NSA; ++rep) { Ctx c = make_ctx(p, wave0);
        for (int u = c.bid; u < BATCH * 2 * NSEL; u += c.nblk) {
            const int nbg = BATCH * 2, bg = u % nbg, qi = u / nbg; int qt = qi;
            if (NSEL == 64) { const int r = qi >> 4, ql = qi & 15; qt = (r == 0) ? 63 - ql : (r == 1) ? ql : (r == 2) ? 47 - ql : 16 + ql; }
            nsa_attn_unit(c, l, bg * NSEL + qt, rep ? NSA_X : 0);
        } }
        for (int rep = 0; rep < DUP_REC; ++rep) { Ctx c = make_ctx(p, wave0); for (int u = c.bid * NWAVE + c.wave; u < 3 * BATCH * NH * NC; u += c.nblk * NWAVE) recur_out_wave(c, l, u); }
        PHASE_END();
        { Ctx c = make_ctx(p, wave0); peer_table_rows(c, l); }
        for (int rep = 0; rep < DUP_P5; ++rep) {
            { Ctx c = make_ctx(p, wave0); pg8::MixOrder<true> S{(NT / 256) * 4, c.nblk, c.bid, NT / 256};
              pg8::Gemm g{wsp<bf16_t>(c, WS_OUTS), wsp<bf16_t>(c, WS_WUP), 4 * NT, 4 * DM, MW};
              pg8::EpiU E{wsp<bf16_t>(c, WS_UALL)};
              pg8::gemm_phase<pg8::EpiU, pg8::MixOrder<true>, false, true>(GEMM_LDS, g, S, E, c.tid); }
            GRID_SYNC();
            { Ctx c = make_ctx(p, wave0); pg8::MixOrder<false> S{(NT / 256) * 4, c.nblk, c.bid, NT / 256};
              pg8::Gemm g{wsp<bf16_t>(c, WS_XB), wsp<bf16_t>(c, WS_WG), NT, 4 * DM, DM};
              pg8::EpiGate E{wsp<bf16_t>(c, WS_UALL), wsp<bf16_t>(c, WS_MERGED), wsp<float>(c, WS_RSS1), NT};
              pg8::gemm_phase<pg8::EpiGate, pg8::MixOrder<false>, false, true>(GEMM_LDS, g, S, E, c.tid); }
        }
        PHASE_END();
        {
            Ctx c = make_ctx(p, wave0, extra);
            pg8::Gemm g{wsp<bf16_t>(c, WS_MERGED), wsp<bf16_t>(c, WS_WOUT), NT, DM, DM}; pg8::StaticOrder S; S.init(NT, DM, c.nblk, c.bid);
            pg8::EpiOut E{wsp<bf16_t>(c, WS_XB), wsp<float>(c, WS_RSS2)};
            pg8::gemm_phase<pg8::EpiOut, pg8::StaticOrder, true, true>(GEMM_LDS, g, S, E, c.tid);
        }
        PHASE_END();
        {
            Ctx c = make_ctx(p, wave0);
            pg8::Gemm g{wsp<bf16_t>(c, WS_XB), wsp<bf16_t>(c, WS_WQ2), NT, PEER_N, DM}; pg8::StaticOrder S; S.init(NT, PEER_N, c.nblk, c.bid);
            pg8::EpiScaleBf16<16> E{wsp<bf16_t>(c, WS_SCORES), PEER_N, wsp<float>(c, WS_RSS2), PEER_N, nullptr};
            pg8::gemm_phase<pg8::EpiScaleBf16<16>, pg8::StaticOrder, true, true>(GEMM_LDS, g, S, E, c.tid);
        }
        PHASE_END();
        { Ctx c = make_ctx(p, wave0, extra); peer_init_tab(c); for (int t = c.bid * NWAVE + c.wave; t < NT; t += c.nblk * NWAVE) peer_token(c, l, t, extra); }
        PHASE_END();
    }
}

#ifndef HOST_EMU
extern "C" void kernel_launch(void* const* d_in, const int* in_sizes, int n_in, void* d_out, int out_size, void* d_ws, size_t ws_size, hipStream_t stream) {
    static int grid = 0;
    if (grid == 0) {
        if (n_in != 22 || out_size != NT * DM || ws_size < WS_NEED) { fprintf(stderr, "kernel_launch: unexpected shapes (n_in %d out %d ws %zu need %zu)\n", n_in, out_size, ws_size, (size_t)WS_NEED); grid = -1; return; }
        int dev = 0, cus = 0, per_cu = 0;
        hipGetDevice(&dev); hipDeviceGetAttribute(&cus, hipDeviceAttributeMultiprocessorCount, dev);
        if (hipFuncSetAttribute((const void*)fwd_kernel, hipFuncAttributeMaxDynamicSharedMemorySize, LDS_BYTES) != hipSuccess) { fprintf(stderr, "kernel_launch: hipFuncSetAttribute failed\n"); grid = -1; return; }
        if (hipOccupancyMaxActiveBlocksPerMultiprocessor(&per_cu, (const void*)fwd_kernel, NTHR, LDS_BYTES) != hipSuccess || per_cu < 1) { fprintf(stderr, "kernel_launch: occupancy query failed (%d)\n", per_cu); (void)hipGetLastError(); per_cu = 1; }
        grid = cus;
        fprintf(stderr, "kernel_launch: grid %d (per_cu %d)\n", grid, per_cu);
    }
    if (grid < 0) return;
    if (hipMemsetAsync((char*)d_ws + WS_BARRIER, 0, 16384, stream) != hipSuccess) { fprintf(stderr, "kernel_launch: memset failed\n"); return; }
    Params p{};
    for (int i = 0; i < 22; ++i) p.in[i] = (const float*)d_in[i];
    p.out = (float*)d_out; p.ws = (unsigned char*)d_ws; p.phase_lo = 0; p.phase_hi = 1 << 20;
    void* args[] = {&p};
    hipError_t e = hipLaunchCooperativeKernel((const void*)fwd_kernel, dim3(grid), dim3(NTHR), args, LDS_BYTES, stream);
    if (e != hipSuccess) fprintf(stderr, "kernel_launch: cooperative launch failed: %s (grid %d)\n", hipGetErrorString(e), grid);
}
#endif
```
